# Optimizing an MI355X kernel written in HIP

```python
import math
import jax, jax.numpy as jnp
from jax import lax
import numpy as np

D_MODEL = 1024
BATCH = 8
SEQ = 4096
DEPTH = 1

D_MIX = D_MODEL
N_DN_HEADS = 4
DN_HEAD_DIM = 128
D_DN = N_DN_HEADS * DN_HEAD_DIM
CONV_K = 4
CHUNK = 64
POOL_WINDOWS = (2, 4, 8, 16)
N_POOL_GROUPS = len(POOL_WINDOWS)
D_POOL = D_MIX - D_DN
POOL_GROUP_DIM = D_POOL // N_POOL_GROUPS
D_IN_PROJ = 4 * D_DN + 2 * N_DN_HEADS + D_POOL
SPLITS = (3 * D_DN, 4 * D_DN, 4 * D_DN + N_DN_HEADS, 4 * D_DN + 2 * N_DN_HEADS)
N_EXPERTS = 32
TOP_K = 4
D_EXPERT = D_MODEL
SWIGLU_LIMIT = 7.0
SWIGLU_ALPHA = 1.702
MOE_BLOCK = 256
RMS_EPS = 1e-6
L2_EPS = 1e-6

kernel_name = 'hybrid_deltanet_pool_moe_block'


def _rmsnorm(x, w):
    xf = x.astype(jnp.float32)
    y = xf * lax.rsqrt(jnp.mean(xf * xf, axis=-1, keepdims=True) + RMS_EPS)
    return (y * w.astype(jnp.float32)).astype(x.dtype)


def _l2norm(x):
    return x * lax.rsqrt(jnp.sum(x * x, axis=-1, keepdims=True) + L2_EPS)


def _causal_depthwise_conv(x, w):
    c = x.shape[-1]
    return lax.conv_general_dilated(
        x, w.astype(x.dtype)[:, None, :], window_strides=(1,),
        padding=[(CONV_K - 1, 0)], dimension_numbers=('NWC', 'WIO', 'NWC'),
        feature_group_count=c)


def _chunk_gated_delta_rule(q, k, v, g, beta):
    b, t, h, dk = q.shape
    dv = v.shape[-1]
    n = t // CHUNK

    def heads_chunks(u):
        u = jnp.moveaxis(u, 2, 1)
        return u.reshape(b, h, n, CHUNK, *u.shape[3:])

    q = heads_chunks(q) * (dk ** -0.5)
    k = heads_chunks(k)
    v = heads_chunks(v)
    beta = heads_chunks(beta)
    g = jnp.cumsum(heads_chunks(g), axis=-1)
    pos = jnp.arange(CHUNK)
    causal = pos[:, None] >= pos[None, :]
    strict = pos[:, None] > pos[None, :]
    decay = jnp.exp(jnp.where(causal, g[..., :, None] - g[..., None, :], -jnp.inf))
    k_beta = k * beta[..., None]
    a_mat = jnp.where(strict, jnp.einsum('bhnid,bhnjd->bhnij', k_beta, k) * decay, 0.0)
    eye = jnp.broadcast_to(jnp.eye(CHUNK, dtype=q.dtype), a_mat.shape)
    t_mat = lax.linalg.triangular_solve(a_mat, eye, left_side=True, lower=True, unit_diagonal=True)
    u = jnp.einsum('bhnij,bhnjd->bhnid', t_mat, v * beta[..., None])
    w = jnp.einsum('bhnij,bhnjd->bhnid', t_mat, k_beta * jnp.exp(g)[..., None])
    qk = jnp.where(causal, jnp.einsum('bhnid,bhnjd->bhnij', q, k) * decay, 0.0)
    q_dec = q * jnp.exp(g)[..., None]
    k_dec = k * jnp.exp(g[..., -1:] - g)[..., None]
    g_tot = jnp.exp(g[..., -1])

    def step(state, inp):
        qd, kd, u_c, w_c, qk_c, gt = inp
        v_new = u_c - jnp.einsum('bhid,bhde->bhie', w_c, state)
        o = jnp.einsum('bhid,bhde->bhie', qd, state) + jnp.einsum('bhij,bhje->bhie', qk_c, v_new)
        state = state * gt[..., None, None] + jnp.einsum('bhid,bhie->bhde', kd, v_new)
        return state, o

    xs = tuple(jnp.moveaxis(a, 2, 0) for a in (q_dec, k_dec, u, w, qk, g_tot))
    s0 = jnp.zeros((b, h, dk, dv), q.dtype)
    _, o = lax.scan(step, s0, xs)
    o = jnp.moveaxis(o, 0, 2).reshape(b, h, t, dv)
    return jnp.moveaxis(o, 1, 2)


def _multiscale_pool(p, pool_w, pool_scale):
    b, t, _ = p.shape
    pf = p.astype(jnp.float32).reshape(b, t, N_POOL_GROUPS, POOL_GROUP_DIM)
    cs = jnp.cumsum(pf, axis=1)
    pos = jnp.arange(1, t + 1, dtype=jnp.float32)
    means = []
    for gi, win in enumerate(POOL_WINDOWS):
        c = cs[:, :, gi]
        lag = jnp.pad(c, ((0, 0), (win, 0), (0, 0)))[:, :t]
        cnt = jnp.minimum(pos, float(win))[None, :, None]
        means.append((c - lag) / cnt)
    mixed = jnp.stack(means, axis=2) - pf
    y = jnp.einsum('btgc,gcd->btgd', mixed, pool_w.astype(jnp.float32))
    return (y.reshape(b, t, D_POOL) * pool_scale.astype(jnp.float32)).astype(p.dtype)


def _moe(h, w_router, b_router, w_gate_up, b_gate_up, w_down, b_down):
    d = h.shape[-1]
    xt = h.reshape(-1, d)
    n_tok = xt.shape[0]
    logits = (xt @ w_router + b_router).astype(jnp.float32)
    top_val, top_idx = lax.top_k(logits, TOP_K)
    gates = jax.nn.softmax(top_val, axis=-1)
    n_assign = n_tok * TOP_K
    flat_e = top_idx.reshape(-1)
    flat_tok = jnp.arange(n_assign, dtype=jnp.int32) // TOP_K
    flat_w = gates.reshape(-1)
    order = jnp.argsort(flat_e)
    sorted_e = flat_e[order]
    counts = jnp.bincount(flat_e, length=N_EXPERTS)
    padded = ((counts + MOE_BLOCK - 1) // MOE_BLOCK) * MOE_BLOCK
    pad_end = jnp.cumsum(padded)
    pad_start = pad_end - padded
    start = jnp.cumsum(counts) - counts
    rank = jnp.arange(n_assign, dtype=jnp.int32) - start[sorted_e]
    dest = pad_start[sorted_e] + rank
    n_blocks = -(-n_assign // MOE_BLOCK) + N_EXPERTS
    n_rows = n_blocks * MOE_BLOCK
    row_tok = jnp.zeros((n_rows,), jnp.int32).at[dest].set(flat_tok[order])
    row_w = jnp.zeros((n_rows,), jnp.float32).at[dest].set(flat_w[order])
    block_start = jnp.arange(n_blocks, dtype=jnp.int32) * MOE_BLOCK
    block_e = jnp.minimum(jnp.searchsorted(pad_end, block_start, side='right'), N_EXPERTS - 1)

    def expert_block(args):
        e, tok, wt = args
        xb = xt[tok]
        gu = xb @ w_gate_up[e] + b_gate_up[e]
        gate = jnp.minimum(gu[:, :D_EXPERT], SWIGLU_LIMIT)
        up = jnp.clip(gu[:, D_EXPERT:], -SWIGLU_LIMIT, SWIGLU_LIMIT)
        act = (up + 1.0) * gate * jax.nn.sigmoid(SWIGLU_ALPHA * gate)
        yb = act @ w_down[e] + b_down[e]
        return yb * wt.astype(yb.dtype)[:, None]

    y = lax.map(expert_block, (block_e, row_tok.reshape(n_blocks, MOE_BLOCK),
                               row_w.reshape(n_blocks, MOE_BLOCK)))
    out = jax.ops.segment_sum(y.reshape(n_rows, d), row_tok, num_segments=n_tok)
    return out.reshape(h.shape).astype(h.dtype)


def setup_inputs(seed: int = 0) -> dict:
    key = jax.random.key(seed)
    ks = jax.random.split(key, 18)
    L = DEPTH
    f32 = jnp.float32

    def nrm(k, shape, scale):
        return jax.random.normal(k, shape, f32) * scale

    x = nrm(ks[0], (BATCH, SEQ, D_MODEL), 1.0)
    attn_norm_w = 1.0 + nrm(ks[1], (L, D_MODEL), 0.02)
    w_in = nrm(ks[2], (L, D_MODEL, D_IN_PROJ), D_MODEL ** -0.5)
    conv_w = nrm(ks[3], (L, CONV_K, 3 * D_DN), CONV_K ** -0.5)
    a_log = jnp.log(jax.random.uniform(ks[4], (L, N_DN_HEADS), f32, 1.0, 16.0))
    dt = jnp.exp(jax.random.uniform(ks[5], (L, N_DN_HEADS), f32, math.log(1e-3), math.log(1e-1)))
    dt_bias = dt + jnp.log(-jnp.expm1(-dt))
    dn_norm_w = 1.0 + nrm(ks[6], (L, DN_HEAD_DIM), 0.02)
    pool_w = nrm(ks[7], (L, N_POOL_GROUPS, POOL_GROUP_DIM, POOL_GROUP_DIM), POOL_GROUP_DIM ** -0.5)
    pool_scale = 1.0 + nrm(ks[8], (L, D_POOL), 0.1)
    w_out = nrm(ks[9], (L, D_MIX, D_MODEL), D_MIX ** -0.5)
    ffn_norm_w = 1.0 + nrm(ks[10], (L, D_MODEL), 0.02)
    w_router = nrm(ks[11], (L, D_MODEL, N_EXPERTS), D_MODEL ** -0.5)
    b_router = nrm(ks[12], (L, N_EXPERTS), 0.01)
    w_gate_up = nrm(ks[13], (L, N_EXPERTS, D_MODEL, 2 * D_EXPERT), D_MODEL ** -0.5)
    b_gate_up = nrm(ks[14], (L, N_EXPERTS, 2 * D_EXPERT), 0.01)
    w_down = nrm(ks[15], (L, N_EXPERTS, D_EXPERT, D_MODEL), D_EXPERT ** -0.5)
    b_down = nrm(ks[16], (L, N_EXPERTS, D_MODEL), 0.01)
    final_norm_w = 1.0 + nrm(ks[17], (D_MODEL,), 0.02)
    return {'x': x, 'attn_norm_w': attn_norm_w, 'w_in': w_in, 'conv_w': conv_w,
            'a_log': a_log, 'dt_bias': dt_bias, 'dn_norm_w': dn_norm_w,
            'pool_w': pool_w, 'pool_scale': pool_scale, 'w_out': w_out,
            'ffn_norm_w': ffn_norm_w, 'w_router': w_router, 'b_router': b_router,
            'w_gate_up': w_gate_up, 'b_gate_up': b_gate_up, 'w_down': w_down,
            'b_down': b_down, 'final_norm_w': final_norm_w}


def reference(x, attn_norm_w, w_in, conv_w, a_log, dt_bias, dn_norm_w, pool_w, pool_scale,
              w_out, ffn_norm_w, w_router, b_router, w_gate_up, b_gate_up, w_down, b_down,
              final_norm_w):
    b, t, _ = x.shape
    f32 = jnp.float32
    for l in range(DEPTH):
        h = _rmsnorm(x, attn_norm_w[l])
        proj = h @ w_in[l]
        qkv, z, beta_logit, a_in, p = jnp.split(proj, list(SPLITS), axis=-1)
        qkv = jax.nn.silu(_causal_depthwise_conv(qkv, conv_w[l])).astype(f32)
        q, k, v = jnp.split(qkv, 3, axis=-1)
        q = _l2norm(q.reshape(b, t, N_DN_HEADS, DN_HEAD_DIM))
        k = _l2norm(k.reshape(b, t, N_DN_HEADS, DN_HEAD_DIM))
        v = v.reshape(b, t, N_DN_HEADS, DN_HEAD_DIM)
        beta = jax.nn.sigmoid(beta_logit.astype(f32))
        g = -jnp.exp(a_log[l].astype(f32)) * jax.nn.softplus(a_in.astype(f32) + dt_bias[l].astype(f32))
        o = _chunk_gated_delta_rule(q, k, v, g, beta)
        o = _rmsnorm(o, dn_norm_w[l]) * jax.nn.silu(z.astype(f32).reshape(b, t, N_DN_HEADS, DN_HEAD_DIM))
        dn_out = o.reshape(b, t, D_DN).astype(x.dtype)
        pool_out = _multiscale_pool(p, pool_w[l], pool_scale[l])
        x = x + jnp.concatenate([dn_out, pool_out], axis=-1) @ w_out[l]
        x = x + _moe(_rmsnorm(x, ffn_norm_w[l]), w_router[l], b_router[l],
                     w_gate_up[l], b_gate_up[l], w_down[l], b_down[l])
    return _rmsnorm(x, final_norm_w)
```

```cpp
#include <hip/hip_runtime.h>
#include <cstdio>
#include <cstdint>

#ifndef MK_PER_PHASE
#define MK_PER_PHASE 0
#endif

constexpr int NB = 8, SEQ = 4096, DM = 1024, NTOK = NB * SEQ;
constexpr int NH = 4, HD = 128, DDN = 512, DPOOL = 512, DIN = 2568, NPROJ = 2560;
constexpr int NE = 32, TOPK = 4, DE = 1024, NASSIGN = NTOK * TOPK;
constexpr int LISTCAP = NTOK;
constexpr int ACT_ROWS = NASSIGN + NE * 256;

constexpr size_t MiB = 1u << 20;
constexpr size_t WS_CTL = 0, CTL_ZERO_BYTES = 1 * MiB;
constexpr size_t WS_WIN = 1 * MiB;
constexpr size_t WS_WOUT = 6 * MiB;
constexpr size_t WS_WPOOL = 8 * MiB;
constexpr size_t WS_WR = 8 * MiB + 512 * 1024;
constexpr size_t WS_BGU = 8 * MiB + 768 * 1024;
constexpr size_t WS_RS1 = 9 * MiB;
constexpr size_t WS_BETA = 9 * MiB + 128 * 1024;
constexpr size_t WS_G = 9 * MiB + 640 * 1024;
constexpr size_t WS_RS2 = 10 * MiB + 256 * 1024;
constexpr size_t WS_GATEW = 10 * MiB + 512 * 1024;
constexpr size_t WS_LIST = 11 * MiB;
constexpr size_t WS_WGU = 16 * MiB;
constexpr size_t WS_WD = 144 * MiB;
constexpr size_t WS_XB = 208 * MiB;
constexpr size_t WS_PROJ = 272 * MiB;
constexpr size_t WS_QKV = 432 * MiB;
constexpr size_t WS_O = 624 * MiB;
constexpr size_t WS_MIXED = 688 * MiB;
constexpr size_t WS_CONCAT = 720 * MiB;
constexpr size_t WS_X1B = 208 * MiB;
constexpr size_t WS_ACT = 272 * MiB;
constexpr size_t WS_SLAB = 544 * MiB;
constexpr size_t WS_END = 800 * MiB;
static_assert(WS_ACT + (size_t)ACT_ROWS * 2048 <= WS_SLAB, "act fits");
static_assert(WS_SLAB + (size_t)NASSIGN * 2048 <= WS_END, "slab fits");

constexpr int CW_BAR = 4096;
constexpr int CW_CNT = 16384;

constexpr int RING_BYTES = 131072;
constexpr int LDSCTL_OFF = RING_BYTES, MISC_OFF = LDSCTL_OFF + 320, TAB_OFF = LDSCTL_OFF + 1024;
constexpr int LDS_BYTES = 147456;
constexpr int NWAVES = 8;

#define GAS __attribute__((address_space(1)))
#define LAS __attribute__((address_space(3)))
typedef unsigned short bf16;
typedef unsigned v4u __attribute__((ext_vector_type(4)));
typedef unsigned v2u __attribute__((ext_vector_type(2)));
typedef float f32x4 __attribute__((ext_vector_type(4)));
typedef float f32x2 __attribute__((ext_vector_type(2)));
typedef short bf16x8 __attribute__((ext_vector_type(8)));
typedef GAS unsigned gu32;
#define RLX_AGENT __ATOMIC_RELAXED, __HIP_MEMORY_SCOPE_AGENT
#define LDS_WAIT() asm volatile("s_waitcnt lgkmcnt(0)" ::: "memory")
#define VM_WAIT() asm volatile("s_waitcnt vmcnt(0)" ::: "memory")

__device__ __forceinline__ unsigned f2bf(float f) { unsigned u = __builtin_bit_cast(unsigned, f); return (u + 0x7fffu + ((u >> 16) & 1u)) >> 16; }
__device__ __forceinline__ unsigned pk2(float lo, float hi) { return f2bf(lo) | (f2bf(hi) << 16); }
__device__ __forceinline__ float bflo(unsigned u) { return __builtin_bit_cast(float, u << 16); }
__device__ __forceinline__ float bfhi(unsigned u) { return __builtin_bit_cast(float, u & 0xffff0000u); }
__device__ __forceinline__ float wave_sum(float v) {
#pragma unroll
    for (int o = 1; o < 64; o <<= 1) v += __shfl_xor(v, o);
    return v;
}
__device__ __forceinline__ float sigmoidf_(float x) { return 1.f / (1.f + __expf(-x)); }
__device__ __forceinline__ float siluf_(float x) { return x / (1.f + __expf(-x)); }

namespace pg8 {
constexpr int BM = 256, BK = 64, HALF = 128, HTB = HALF * BK * 2, STAGE_BYTES = 8 * HTB;
__device__ __forceinline__ int lds_byte(int r, int c) { const int st = (r >> 4) * 2 + (c >> 5), rr = r & 15, cc = c & 31, ob = rr * 64 + cc * 2; return st * 1024 + (ob ^ (((ob >> 9) & 1) << 5)); }
__device__ __forceinline__ void stage_rc(int b, int& R, int& C) { const int st = b / 1024, sb = b % 1024, swz = sb ^ (((sb >> 9) & 1) << 5); R = (st >> 1) * 16 + swz / 64; C = (st & 1) * 32 + (swz % 64) / 2; }
__device__ __forceinline__ int perm32(int rho) { const int n = rho >> 4, i = rho & 15; return 8 * (i >> 2) + 4 * n + (i & 3); }
__device__ __forceinline__ unsigned cvt_pk_bf16(float lo, float hi) { unsigned r; asm volatile("v_cvt_pk_bf16_f32 %0, %1, %2" : "=v"(r) : "v"(lo), "v"(hi)); return r; }

struct Unit { int rt, pn, e, rb, rows; };

struct Sched {
    int nM, nN, nwg, G, c;
    __device__ __forceinline__ void init(int nM_, int nN_, int G_, int c_) { nM = nM_; nN = nN_; nwg = nM * nN; G = G_; c = c_; }
    __device__ __forceinline__ bool next(int i, int& pm, int& pn) const {
        const long L = (long)i * G + c; if (L >= nwg) return false;
        int wgid = (int)L; { const int q = nwg / 8, r = nwg % 8, xcd = wgid % 8, off = wgid / 8; wgid = (xcd < r ? xcd * (q + 1) : r * (q + 1) + (xcd - r) * q) + off; }
        const int nig = 8 * nN, gid = wgid / nig, fm = gid * 8, gsz = (nM - fm) < 8 ? (nM - fm) : 8;
        pm = fm + ((wgid % nig) % gsz); pn = (wgid % nig) / gsz; return true;
    }
};

template <class P>
__device__ __forceinline__ void gemm_phase(LAS unsigned char* lds, const P& p) {
    const int tid = threadIdx.x, wid = __builtin_amdgcn_readfirstlane(tid >> 6), lane = tid & 63, wr = wid >> 2, wc = wid & 3, fr = lane & 15, fq = lane >> 4;
    const int K = p.K, nt = K / BK;
    int R[2], C[2]; unsigned voffB[2];
#pragma unroll
    for (int i = 0; i < 2; ++i) { stage_rc(tid * 16 + i * 8192, R[i], C[i]); const int Rb = (R[i] & ~31) + perm32(R[i] & 31); voffB[i] = (unsigned)(Rb * K + C[i]) * 2u; }
    const size_t kstep = (size_t)(BK * 2);
    const size_t hstep = (size_t)HALF * K * 2;
    const unsigned ldsw = (unsigned)wid * 1024u;
    const int aoff = lds_byte(wr * 64 + fr, fq * 8), boff = lds_byte(wc * 32 + fr, fq * 8);
#define PG8_SA(b, h) (((b) * 2 + (h)) * HTB)
#define PG8_SB(b, h) ((4 + (b) * 2 + (h)) * HTB)
#define PG8_STAGE(bufoff, gbase, voff) do { _Pragma("unroll") for (int _i = 0; _i < 2; ++_i) \
        __builtin_amdgcn_global_load_lds((const unsigned*)((const char*)(gbase) + (voff)[_i]), (LAS unsigned*)(lds + (bufoff) + ldsw + _i * 8192), 16, 0, 0); } while (0)
#define PG8_LDA(dst, b, h) do { _Pragma("unroll") for (int m = 0; m < 4; ++m) _Pragma("unroll") for (int k = 0; k < 2; ++k) dst[m][k] = *(const LAS bf16x8*)(lds + PG8_SA(b, h) + aoff + m * 2048 + k * 1024); } while (0)
#define PG8_LDB(dst, b, h) do { _Pragma("unroll") for (int n = 0; n < 2; ++n) _Pragma("unroll") for (int k = 0; k < 2; ++k) dst[n][k] = *(const LAS bf16x8*)(lds + PG8_SB(b, h) + boff + n * 2048 + k * 1024); } while (0)
#define PG8_MMA(ai, bj, At, Bt) do { __builtin_amdgcn_s_setprio(1); _Pragma("unroll") for (int m = 0; m < 4; ++m) _Pragma("unroll") for (int n = 0; n < 2; ++n) _Pragma("unroll") for (int k = 0; k < 2; ++k) \
        acc[ai][bj][m][n] = __builtin_amdgcn_mfma_f32_16x16x32_bf16(Bt[n][k], At[m][k], acc[ai][bj][m][n], 0, 0, 0); __builtin_amdgcn_s_setprio(0); } while (0)
#define PG8_WAIT_V(n) asm volatile("s_waitcnt vmcnt(" #n ")" ::: "memory")
#define PG8_WAIT_L(n) asm volatile("s_waitcnt lgkmcnt(" #n ")" ::: "memory")
#define PG8_BAR __builtin_amdgcn_s_barrier()
#define PG8_SCHED __builtin_amdgcn_sched_barrier(0)
    Unit cur, nxt; int ui = 0;
    if (!p.next(0, cur)) return;
    f32x4 acc[2][2][4][2];
#pragma unroll
    for (int a = 0; a < 2; ++a)
#pragma unroll
        for (int b = 0; b < 2; ++b)
#pragma unroll
            for (int m = 0; m < 4; ++m)
#pragma unroll
                for (int n = 0; n < 2; ++n) acc[a][b][m][n] = (f32x4){0.f, 0.f, 0.f, 0.f};
    bf16x8 At[4][2], B0[2][2], B1[2][2];
    unsigned oA[2][2], nO[2][2];
    p.a_off(cur, R, C, oA);
    const char* cA = p.a_base(cur); const char* cB = p.b_base(cur);
    PG8_STAGE(PG8_SB(0, 0), cB, voffB); PG8_STAGE(PG8_SB(0, 1), cB + hstep, voffB); PG8_STAGE(PG8_SA(0, 0), cA, oA[0]); PG8_STAGE(PG8_SA(0, 1), cA, oA[1]);
    if (wr == 1) PG8_BAR;
    PG8_WAIT_V(2); PG8_BAR;
    PG8_STAGE(PG8_SB(1, 0), cB + kstep, voffB); PG8_STAGE(PG8_SA(1, 0), cA + kstep, oA[0]); PG8_STAGE(PG8_SB(1, 1), cB + hstep + kstep, voffB);
    PG8_WAIT_V(6); PG8_BAR;
    for (;;) {
        const bool has_next = p.next(ui + 1, nxt);
        const char* nA = cA; const char* nB = cB;
#pragma unroll
        for (int h = 0; h < 2; ++h)
#pragma unroll
            for (int i = 0; i < 2; ++i) nO[h][i] = oA[h][i];
        if (has_next) { nA = p.a_base(nxt); nB = p.b_base(nxt); p.a_off(nxt, R, C, nO); }
        asm volatile("" : "+v"(nO[0][0]), "+v"(nO[0][1]), "+v"(nO[1][0]), "+v"(nO[1][1]));
        for (int t = 0; t < nt; t += 2) {
            const bool last = (t == nt - 2);
            const char* a1 = cA + (size_t)(t + 1) * kstep;
            const char* a2 = last ? nA : cA + (size_t)(t + 2) * kstep; const char* b2 = last ? nB : cB + (size_t)(t + 2) * kstep;
            const char* a3 = a2 + kstep; const char* b3 = b2 + kstep;
            unsigned o2[2][2];
#pragma unroll
            for (int h = 0; h < 2; ++h)
#pragma unroll
                for (int i = 0; i < 2; ++i) o2[h][i] = last ? nO[h][i] : oA[h][i];
            PG8_LDB(B0, 0, 0); PG8_LDB(B1, 0, 1); PG8_SCHED; PG8_LDA(At, 0, 0); PG8_STAGE(PG8_SA(1, 1), a1, oA[1]);
            PG8_WAIT_V(8); PG8_WAIT_L(0); PG8_BAR; PG8_MMA(0, 0, At, B0); PG8_MMA(0, 1, At, B1); PG8_BAR; PG8_SCHED;
            PG8_LDA(At, 0, 1); PG8_STAGE(PG8_SB(0, 0), b2, voffB); PG8_STAGE(PG8_SB(0, 1), b2 + hstep, voffB); PG8_STAGE(PG8_SA(0, 0), a2, o2[0]);
            PG8_WAIT_V(8); PG8_WAIT_L(0); PG8_BAR; PG8_MMA(1, 0, At, B0); PG8_MMA(1, 1, At, B1); PG8_BAR; PG8_SCHED;
            PG8_LDB(B0, 1, 0); PG8_LDB(B1, 1, 1); PG8_SCHED; PG8_LDA(At, 1, 0); PG8_STAGE(PG8_SA(0, 1), a2, o2[1]);
            PG8_WAIT_V(8); PG8_WAIT_L(0); PG8_BAR; PG8_MMA(0, 0, At, B0); PG8_MMA(0, 1, At, B1); PG8_BAR; PG8_SCHED;
            PG8_LDA(At, 1, 1); PG8_STAGE(PG8_SB(1, 0), b3, voffB); PG8_STAGE(PG8_SB(1, 1), b3 + hstep, voffB); PG8_STAGE(PG8_SA(1, 0), a3, o2[0]);
            PG8_WAIT_V(8); PG8_WAIT_L(0); PG8_BAR; PG8_MMA(1, 0, At, B0); PG8_MMA(1, 1, At, B1); PG8_BAR; PG8_SCHED;
        }
        if (wr == 0) PG8_BAR;
        p.epi(acc, cur, wr, wc, fr, fq);
        if (!has_next) break;
#pragma unroll
        for (int a = 0; a < 2; ++a)
#pragma unroll
            for (int b = 0; b < 2; ++b)
#pragma unroll
                for (int m = 0; m < 4; ++m)
#pragma unroll
                    for (int n = 0; n < 2; ++n) acc[a][b][m][n] = (f32x4){0.f, 0.f, 0.f, 0.f};
        cur = nxt; cA = nA; cB = nB; ++ui;
#pragma unroll
        for (int h = 0; h < 2; ++h)
#pragma unroll
            for (int i = 0; i < 2; ++i) oA[h][i] = nO[h][i];
        if (wr == 1) PG8_BAR;
    }
    PG8_WAIT_V(0);
    PG8_BAR;
#undef PG8_SA
#undef PG8_SB
#undef PG8_STAGE
#undef PG8_LDA
#undef PG8_LDB
#undef PG8_MMA
#undef PG8_WAIT_V
#undef PG8_WAIT_L
#undef PG8_BAR
#undef PG8_SCHED
}
}

#define XB_TMO      128
#define XB_XCNT(j)  (256  + 64 * (j))
#define XB_XSUB(j)  (1280 + 64 * (j))
#define XB_XGEN(j)  (2304 + 64 * (j))
#define XB_TOP      3328
#define XB_TOPGEN   3392
#define XCD_BAR_WORDS 3456
#define XB_SPIN_CAP (1u << 18)
__device__ __forceinline__ unsigned xb_ld(unsigned* p)              { return __hip_atomic_load(p, __ATOMIC_RELAXED, __HIP_MEMORY_SCOPE_AGENT); }
__device__ __forceinline__ unsigned xb_add(unsigned* p, unsigned v) { return __hip_atomic_fetch_add(p, v, __ATOMIC_RELAXED, __HIP_MEMORY_SCOPE_AGENT); }
__device__ __forceinline__ unsigned xb_xcc_id() { return (unsigned)__builtin_amdgcn_s_getreg((3 << 11) | 20) & 0xFu; }
#define XB_SPIN(cond, bar) do { unsigned _sp = 0; while (cond) { __builtin_amdgcn_s_sleep(1); \
    if ((++_sp & 255u) == 0u) { if (xb_ld(&(bar)[XB_TMO])) break; if (_sp > XB_SPIN_CAP) { atomicAdd(&(bar)[XB_TMO], 1u); break; } } } } while (0)
struct XcdBarrier { unsigned* bar; unsigned x; volatile LAS unsigned* st; };
__device__ __forceinline__ XcdBarrier xcd_barrier_post(unsigned* bar, volatile LAS unsigned* st) {
    XcdBarrier b; b.bar = bar; b.x = xb_xcc_id(); b.st = st;
    if (threadIdx.x == 0) (void)xb_add(&bar[XB_XCNT(b.x)], 1u);
    return b;
}
__device__ __forceinline__ void xcd_barrier_complete(unsigned* bar, unsigned x, unsigned& nloc, unsigned& nx) {
    const unsigned G = gridDim.x * gridDim.y * gridDim.z;
    unsigned sum, cnt, mine, sp = 0u;
    for (;;) {
        sum = 0u; cnt = 0u; mine = 0u;
#pragma unroll
        for (unsigned j = 0; j < 16; ++j) { const unsigned c = xb_ld(&bar[XB_XCNT(j)]); sum += c; cnt += (c > 0u) ? 1u : 0u; mine = (j == x) ? c : mine; }
        if (sum == G) break;
        __builtin_amdgcn_s_sleep(1);
        if ((++sp & 255u) == 0u) { if (xb_ld(&bar[XB_TMO])) break; if (sp > XB_SPIN_CAP) { atomicAdd(&bar[XB_TMO], 1u); break; } }
    }
    nloc = mine > 0u ? mine : 1u; nx = cnt > 0u ? cnt : 1u;
}
__device__ __forceinline__ void xcd_barrier(const XcdBarrier& b) {
    asm volatile("s_waitcnt vmcnt(0)" ::: "memory");
    __syncthreads();
    if (threadIdx.x == 0) {
        unsigned* bar = b.bar;
        __builtin_amdgcn_s_waitcnt(0);
        unsigned nloc = b.st[0], nx = b.st[1];
        if (nloc == 0u) { xcd_barrier_complete(bar, b.x, nloc, nx); b.st[0] = nloc; b.st[1] = nx; }
        const unsigned old = xb_add(&bar[XB_XSUB(b.x)], 1u);
        const unsigned gen = old / nloc;
        if (old + 1u == (gen + 1u) * nloc) {
            __builtin_amdgcn_fence(__ATOMIC_RELEASE, "agent");
            asm volatile("s_waitcnt vmcnt(0)" ::: "memory");
            const unsigned og = xb_add(&bar[XB_TOP], 1u);
            const unsigned tg = og / nx;
            if (og + 1u == (tg + 1u) * nx) xb_add(&bar[XB_TOPGEN], 1u);
            else XB_SPIN(xb_ld(&bar[XB_TOPGEN]) == tg, bar);
            __builtin_amdgcn_fence(__ATOMIC_ACQUIRE, "agent");
            xb_add(&bar[XB_XGEN(b.x)], 1u);
            asm volatile("s_waitcnt vmcnt(0)" ::: "memory");
        } else {
            XB_SPIN(xb_ld(&bar[XB_XGEN(b.x)]) == gen, bar);
            __builtin_amdgcn_fence(__ATOMIC_ACQUIRE, "agent");
            asm volatile("s_waitcnt vmcnt(0)" ::: "memory");
        }
    }
    __syncthreads();
}

struct Frame {
    LAS unsigned char* lds;
    int tid, lane, wave, vcu, G;
    const float* in[18];
    float* out;
    unsigned char* ws;
};
using pg8::Unit;
using pg8::cvt_pk_bf16;

struct ProbBase {
    int K; pg8::Sched S;
    __device__ __forceinline__ void lin_off(const int (&R)[2], const int (&C)[2], unsigned (&off)[2][2]) const {
#pragma unroll
        for (int h = 0; h < 2; ++h)
#pragma unroll
            for (int i = 0; i < 2; ++i) off[h][i] = (unsigned)((h * 128 + R[i]) * K + C[i]) * 2u;
    }
};
struct ProbIn : ProbBase {
    const bf16* A; const bf16* Bt; bf16* O; const float* rs;
    __device__ __forceinline__ bool next(int i, Unit& u) const { int pm, pn; if (!S.next(i, pm, pn)) return false; u.rt = pm; u.pn = pn; u.e = 0; u.rb = pm; u.rows = 256; return true; }
    __device__ __forceinline__ const char* a_base(const Unit& u) const { return (const char*)A + (size_t)u.rt * 256 * K * 2; }
    __device__ __forceinline__ const char* b_base(const Unit& u) const { return (const char*)Bt + (size_t)u.pn * 256 * K * 2; }
    __device__ __forceinline__ void a_off(const Unit&, const int (&R)[2], const int (&C)[2], unsigned (&off)[2][2]) const { lin_off(R, C, off); }
    __device__ __forceinline__ void epi(const f32x4 (&acc)[2][2][4][2], const Unit& u, int wr, int wc, int fr, int fq) const {
        const int row0 = u.rt * 256 + wr * 64 + fr, col0 = u.pn * 256 + wc * 32 + 8 * fq;
#pragma unroll
        for (int ai = 0; ai < 2; ++ai)
#pragma unroll
            for (int m = 0; m < 4; ++m) { const int row = row0 + ai * 128 + m * 16; const float sc = rs[row]; bf16* rowp = O + (size_t)row * NPROJ + col0;
#pragma unroll
                for (int bj = 0; bj < 2; ++bj) { const f32x4 v0 = acc[ai][bj][m][0] * sc, v1 = acc[ai][bj][m][1] * sc; v4u w;
                    w.x = cvt_pk_bf16(v0[0], v0[1]); w.y = cvt_pk_bf16(v0[2], v0[3]); w.z = cvt_pk_bf16(v1[0], v1[1]); w.w = cvt_pk_bf16(v1[2], v1[3]);
                    *(v4u*)(rowp + bj * 128) = w; } }
    }
};
struct ProbPool : ProbBase {
    const bf16* A; const bf16* Bt; bf16* O;
    __device__ __forceinline__ bool next(int i, Unit& u) const { int pm, pn; if (!S.next(i, pm, pn)) return false; u.rt = pm; u.pn = pn; u.e = 0; u.rb = pm; u.rows = 256; return true; }
    __device__ __forceinline__ const char* a_base(const Unit& u) const { return (const char*)A + (size_t)u.rt * 256 * K * 2; }
    __device__ __forceinline__ const char* b_base(const Unit& u) const { return (const char*)Bt + (size_t)u.pn * 256 * K * 2; }
    __device__ __forceinline__ void a_off(const Unit&, const int (&R)[2], const int (&C)[2], unsigned (&off)[2][2]) const { lin_off(R, C, off); }
    __device__ __forceinline__ void epi(const f32x4 (&acc)[2][2][4][2], const Unit& u, int wr, int wc, int fr, int fq) const {
        const int row0 = u.rt * 256 + wr * 64 + fr, col0 = 512 + u.pn * 256 + wc * 32 + 8 * fq;
#pragma unroll
        for (int ai = 0; ai < 2; ++ai)
#pragma unroll
            for (int m = 0; m < 4; ++m) { const int row = row0 + ai * 128 + m * 16; bf16* rowp = O + (size_t)row * DM + col0;
#pragma unroll
                for (int bj = 0; bj < 2; ++bj) { const f32x4 v0 = acc[ai][bj][m][0], v1 = acc[ai][bj][m][1]; v4u w;
                    w.x = cvt_pk_bf16(v0[0], v0[1]); w.y = cvt_pk_bf16(v0[2], v0[3]); w.z = cvt_pk_bf16(v1[0], v1[1]); w.w = cvt_pk_bf16(v1[2], v1[3]);
                    *(v4u*)(rowp + bj * 128) = w; } }
    }
};
struct ProbOut : ProbBase {
    const bf16* A; const bf16* Bt; const float* X; float* O;
    __device__ __forceinline__ bool next(int i, Unit& u) const { int pm, pn; if (!S.next(i, pm, pn)) return false; u.rt = pm; u.pn = pn; u.e = 0; u.rb = pm; u.rows = 256; return true; }
    __device__ __forceinline__ const char* a_base(const Unit& u) const { return (const char*)A + (size_t)u.rt * 256 * K * 2; }
    __device__ __forceinline__ const char* b_base(const Unit& u) const { return (const char*)Bt + (size_t)u.pn * 256 * K * 2; }
    __device__ __forceinline__ void a_off(const Unit&, const int (&R)[2], const int (&C)[2], unsigned (&off)[2][2]) const { lin_off(R, C, off); }
    __device__ __forceinline__ void epi(const f32x4 (&acc)[2][2][4][2], const Unit& u, int wr, int wc, int fr, int fq) const {
        const int row0 = u.rt * 256 + wr * 64 + fr, col0 = u.pn * 256 + wc * 32 + 8 * fq;
#pragma unroll
        for (int ai = 0; ai < 2; ++ai)
#pragma unroll
            for (int m = 0; m < 4; ++m) { const size_t off = (size_t)(row0 + ai * 128 + m * 16) * DM + col0;
#pragma unroll
                for (int bj = 0; bj < 2; ++bj)
#pragma unroll
                    for (int n = 0; n < 2; ++n) { const f32x4 xv = *(const f32x4*)(X + off + bj * 128 + 4 * n); *(f32x4*)(O + off + bj * 128 + 4 * n) = xv + acc[ai][bj][m][n]; } }
    }
};
struct MoeTab { const LAS int* pref; const LAS int* cnt; };
__device__ __forceinline__ void moe_decode(const MoeTab& T, int rt, Unit& u) {
    int e = 0;
#pragma unroll 1
    for (int j = 1; j < NE; ++j) if (T.pref[j] <= rt) e = j;
    u.e = e; u.rb = rt - T.pref[e]; const int left = T.cnt[e] - u.rb * 256; u.rows = left < 256 ? left : 256;
}
struct ProbGU : ProbBase {
    MoeTab T; const bf16* A; const bf16* Bt; bf16* O; const int* list; const float* rs2; const float* bgu;
    __device__ __forceinline__ bool next(int i, Unit& u) const { int pm, pn; if (!S.next(i, pm, pn)) return false; u.rt = pm; u.pn = pn; moe_decode(T, pm, u); return true; }
    __device__ __forceinline__ const char* a_base(const Unit&) const { return (const char*)A; }
    __device__ __forceinline__ const char* b_base(const Unit& u) const { return (const char*)Bt + ((size_t)u.e * 2048 + (size_t)u.pn * 256) * K * 2; }
    __device__ __forceinline__ void a_off(const Unit& u, const int (&R)[2], const int (&C)[2], unsigned (&off)[2][2]) const {
        const int* lp = list + (size_t)u.e * LISTCAP + u.rb * 256;
#pragma unroll
        for (int h = 0; h < 2; ++h)
#pragma unroll
            for (int i = 0; i < 2; ++i) { const int r = h * 128 + R[i]; const int ent = (r < u.rows) ? lp[r] : 0; off[h][i] = (unsigned)(ent >> 2) * (unsigned)(K * 2) + (unsigned)C[i] * 2u; }
    }
    __device__ __forceinline__ void epi(const f32x4 (&acc)[2][2][4][2], const Unit& u, int wr, int wc, int fr, int fq) const {
        const int* lp = list + (size_t)u.e * LISTCAP + u.rb * 256;
        const int j0 = wc * 32 + 8 * fq;
        const float* bg = bgu + (size_t)u.e * 2048 + u.pn * 256 + j0;
        f32x4 bgv[2], buv[2];
#pragma unroll
        for (int n = 0; n < 2; ++n) { bgv[n] = *(const f32x4*)(bg + 4 * n); buv[n] = *(const f32x4*)(bg + 128 + 4 * n); }
#pragma unroll
        for (int ai = 0; ai < 2; ++ai)
#pragma unroll
            for (int m = 0; m < 4; ++m) { const int r = ai * 128 + wr * 64 + m * 16 + fr;
                if (r < u.rows) { const int ent = lp[r]; const float sc = rs2[ent >> 2]; unsigned w[4];
#pragma unroll
                    for (int n = 0; n < 2; ++n) { float a[4];
#pragma unroll
                        for (int q = 0; q < 4; ++q) { float gt = acc[ai][0][m][n][q] * sc + bgv[n][q], up = acc[ai][1][m][n][q] * sc + buv[n][q];
                            gt = fminf(gt, 7.f); up = fminf(fmaxf(up, -7.f), 7.f); a[q] = (up + 1.f) * gt / (1.f + __expf(-1.702f * gt)); }
                        w[2 * n] = cvt_pk_bf16(a[0], a[1]); w[2 * n + 1] = cvt_pk_bf16(a[2], a[3]); }
                    *(v4u*)(O + (size_t)(u.rt * 256 + r) * DE + u.pn * 128 + j0) = (v4u){w[0], w[1], w[2], w[3]}; } }
    }
};
struct ProbDown : ProbBase {
    MoeTab T; const bf16* A; const bf16* Bt; bf16* O; const int* list; const float* gw; const float* bd;
    __device__ __forceinline__ bool next(int i, Unit& u) const { int pm, pn; if (!S.next(i, pm, pn)) return false; u.rt = pm; u.pn = pn; moe_decode(T, pm, u); return true; }
    __device__ __forceinline__ const char* a_base(const Unit& u) const { return (const char*)A + (size_t)u.rt * 256 * K * 2; }
    __device__ __forceinline__ const char* b_base(const Unit& u) const { return (const char*)Bt + ((size_t)u.e * 1024 + (size_t)u.pn * 256) * K * 2; }
    __device__ __forceinline__ void a_off(const Unit&, const int (&R)[2], const int (&C)[2], unsigned (&off)[2][2]) const { lin_off(R, C, off); }
    __device__ __forceinline__ void epi(const f32x4 (&acc)[2][2][4][2], const Unit& u, int wr, int wc, int fr, int fq) const {
        const int* lp = list + (size_t)u.e * LISTCAP + u.rb * 256;
        const int c0 = u.pn * 256 + wc * 32 + 8 * fq;
        const float* bp = bd + (size_t)u.e * DM + c0;
        f32x4 bv[2][2];
#pragma unroll
        for (int bj = 0; bj < 2; ++bj)
#pragma unroll
            for (int n = 0; n < 2; ++n) bv[bj][n] = *(const f32x4*)(bp + bj * 128 + 4 * n);
#pragma unroll
        for (int ai = 0; ai < 2; ++ai)
#pragma unroll
            for (int m = 0; m < 4; ++m) { const int r = ai * 128 + wr * 64 + m * 16 + fr;
                if (r < u.rows) { const int ent = lp[r]; const float g = gw[ent]; bf16* rowp = O + (size_t)ent * DM + c0;
#pragma unroll
                    for (int bj = 0; bj < 2; ++bj) { const f32x4 v0 = (acc[ai][bj][m][0] + bv[bj][0]) * g, v1 = (acc[ai][bj][m][1] + bv[bj][1]) * g; v4u w;
                        w.x = cvt_pk_bf16(v0[0], v0[1]); w.y = cvt_pk_bf16(v0[2], v0[3]); w.z = cvt_pk_bf16(v1[0], v1[1]); w.w = cvt_pk_bf16(v1[2], v1[3]);
                        *(v4u*)(rowp + bj * 128) = w; } } }
    }
};

__device__ __forceinline__ void tr_item(const float* W, int ldw, int k0, int nsrc0, bf16* WT, size_t drow0, int ldk, int dk0, const float* ks, const float* ns, LAS float* scr, int lane) {
    const int nl = lane & 31;
    const float nsc = ns ? ns[nsrc0 + nl] : 1.f;
#pragma unroll 8
    for (int i = 0; i < 32; ++i) { const int kk = 2 * i + (lane >> 5); float v = W[(size_t)(k0 + kk) * ldw + nsrc0 + nl] * nsc; if (ks) v *= ks[k0 + kk]; scr[kk * 33 + nl] = v; }
    LDS_WAIT(); asm volatile("" ::: "memory");
    const int c = lane & 7;
#pragma unroll
    for (int j = 0; j < 4; ++j) { const int n = (lane >> 3) + 8 * j; const LAS float* s = scr + (8 * c) * 33 + n;
        v4u o; o.x = pk2(s[0 * 33], s[1 * 33]); o.y = pk2(s[2 * 33], s[3 * 33]); o.z = pk2(s[4 * 33], s[5 * 33]); o.w = pk2(s[6 * 33], s[7 * 33]);
        *(v4u*)(WT + (drow0 + n) * (size_t)ldk + dk0 + k0 + 8 * c) = o; }
    LDS_WAIT(); asm volatile("" ::: "memory");
}

__device__ __forceinline__ void phase_prep(Frame& F) {
    const float* x = F.in[0]; const float* anw = F.in[1]; const float* w_in = F.in[2]; const float* a_log = F.in[4]; const float* dt_bias = F.in[5];
    const float* pool_w = F.in[7]; const float* pool_scale = F.in[8]; const float* w_out = F.in[9]; const float* fnw = F.in[10];
    const float* w_router = F.in[11]; const float* w_gu = F.in[13]; const float* b_gu = F.in[14]; const float* w_d = F.in[15];
    bf16* WinT = (bf16*)(F.ws + WS_WIN); bf16* WoutT = (bf16*)(F.ws + WS_WOUT); bf16* WpoolT = (bf16*)(F.ws + WS_WPOOL);
    bf16* WguT = (bf16*)(F.ws + WS_WGU); bf16* WdT = (bf16*)(F.ws + WS_WD);
    float* Wr = (float*)(F.ws + WS_WR); float* bguP = (float*)(F.ws + WS_BGU);
    bf16* xb = (bf16*)(F.ws + WS_XB); float* rs1 = (float*)(F.ws + WS_RS1); float* betaA = (float*)(F.ws + WS_BETA); float* gA = (float*)(F.ws + WS_G);
    LAS float* scr = (LAS float*)(F.lds + F.wave * 8704);
    LAS float* W8T = (LAS float*)(F.lds + 69632);
    const int gw = F.vcu * NWAVES + F.wave, NGW = F.G * NWAVES;
    const int gt = F.vcu * 512 + F.tid, NGT = F.G * 512;
    for (int idx = F.tid; idx < 8192; idx += 512) { const int k = idx >> 3, c = idx & 7; W8T[c * 1024 + k] = anw[k] * w_in[(size_t)k * DIN + 2048 + c]; }
    __syncthreads();
    constexpr int I_IN1 = 16 * 64, I_IN2 = 16 * 16, I_OUT = 16 * 32, I_POOL = 4 * 2 * 4, I_GU = 32 * 16 * 16 * 4, I_D = 32 * 16 * 32;
    constexpr int NITEMS = I_IN1 + I_IN2 + I_OUT + I_POOL + I_GU + I_D;
    for (int it = gw; it < NITEMS; it += NGW) {
        int r = it;
        if (r < I_IN1) { const int kb = r / 64, nb = r % 64; tr_item(w_in, DIN, kb * 64, nb * 32, WinT, (size_t)nb * 32, DM, 0, anw, nullptr, scr, F.lane); continue; } r -= I_IN1;
        if (r < I_IN2) { const int kb = r / 16, nb = r % 16; tr_item(w_in, DIN, kb * 64, 2056 + nb * 32, WinT, (size_t)2048 + nb * 32, DM, 0, anw, nullptr, scr, F.lane); continue; } r -= I_IN2;
        if (r < I_OUT) { const int kb = r / 32, nb = r % 32; tr_item(w_out, DM, kb * 64, nb * 32, WoutT, (size_t)nb * 32, DM, 0, nullptr, nullptr, scr, F.lane); continue; } r -= I_OUT;
        if (r < I_POOL) { const int g = r / 8, kb = (r % 8) / 4, nb = r % 4; tr_item(pool_w + (size_t)g * 128 * 128, 128, kb * 64, nb * 32, WpoolT, (size_t)g * 128 + nb * 32, 512, g * 128, nullptr, pool_scale + g * 128, scr, F.lane); continue; } r -= I_POOL;
        if (r < I_GU) { const int e = r / 1024, r2 = r % 1024, seg = r2 / 64, kb = (r2 % 64) / 4, nb = r2 % 4; const int t = seg >> 1, half = seg & 1;
            tr_item(w_gu + (size_t)e * DM * 2048, 2048, kb * 64, half * 1024 + t * 128 + nb * 32, WguT, (size_t)e * 2048 + t * 256 + half * 128 + nb * 32, DM, 0, fnw, nullptr, scr, F.lane); continue; } r -= I_GU;
        { const int e = r / 512, r2 = r % 512, kb = r2 / 32, nb = r2 % 32; tr_item(w_d + (size_t)e * DE * DM, DM, kb * 64, nb * 32, WdT, (size_t)e * 1024 + nb * 32, DE, 0, nullptr, nullptr, scr, F.lane); }
    }
    for (int idx = gt; idx < NE * 2048; idx += NGT) { const int e = idx >> 11, r = idx & 2047, t = r >> 8, j = r & 255, half = j >> 7, jj = j & 127; bguP[idx] = b_gu[(size_t)e * 2048 + half * 1024 + t * 128 + jj]; }
    for (int idx = gt; idx < NE * DM; idx += NGT) { const int e = idx >> 10, k = idx & 1023; Wr[idx] = fnw[k] * w_router[(size_t)k * NE + e]; }
    for (int idx = gt; idx < 512 * 64; idx += NGT) { const int n = idx >> 6, ch = idx & 63; if ((n >> 7) != (ch >> 4)) *(v4u*)(WpoolT + (size_t)n * 512 + ch * 8) = (v4u){0u, 0u, 0u, 0u}; }
    for (int m = gw; m < NTOK; m += NGW) {
        const f32x4* xr = (const f32x4*)(x + (size_t)m * DM) + F.lane;
        f32x4 v[4]; float ss = 0.f; float d8[8];
#pragma unroll
        for (int c = 0; c < 8; ++c) d8[c] = 0.f;
#pragma unroll
        for (int j = 0; j < 4; ++j) { v[j] = xr[64 * j]; ss += (v[j].x * v[j].x + v[j].y * v[j].y) + (v[j].z * v[j].z + v[j].w * v[j].w); }
#pragma unroll
        for (int c = 0; c < 8; ++c)
#pragma unroll
            for (int j = 0; j < 4; ++j) { const f32x4 w = *(const LAS f32x4*)(W8T + c * 1024 + 256 * j + 4 * F.lane); d8[c] += (v[j].x * w.x + v[j].y * w.y) + (v[j].z * w.z + v[j].w * w.w); }
        ss = wave_sum(ss);
#pragma unroll
        for (int c = 0; c < 8; ++c) d8[c] = wave_sum(d8[c]);
        const float rs = 1.f / sqrtf(ss * (1.f / DM) + 1e-6f);
        unsigned long long* o8 = (unsigned long long*)(xb + (size_t)m * DM) + F.lane;
#pragma unroll
        for (int j = 0; j < 4; ++j) o8[64 * j] = (unsigned long long)pk2(v[j].x, v[j].y) | ((unsigned long long)pk2(v[j].z, v[j].w) << 32);
        if (F.lane == 0) rs1[m] = rs;
        if (F.lane < 4) {
            float bl = 0.f, al = 0.f;
#pragma unroll
            for (int c = 0; c < 4; ++c) { bl = (F.lane == c) ? d8[c] : bl; al = (F.lane == c) ? d8[4 + c] : al; }
            bl *= rs; al *= rs;
            betaA[(size_t)m * 4 + F.lane] = 1.f / (1.f + expf(-bl));
            const float z = al + dt_bias[F.lane]; const float sp = z > 20.f ? z : log1pf(expf(z));
            gA[(size_t)m * 4 + F.lane] = -expf(a_log[F.lane]) * sp;
        }
    }
}

__device__ __forceinline__ void phase_conv(Frame& F) {
    const float* conv_w = F.in[3];
    const bf16* proj = (const bf16*)(F.ws + WS_PROJ);
    float* qkv = (float*)(F.ws + WS_QKV); bf16* mixed = (bf16*)(F.ws + WS_MIXED);
    const int gw = F.vcu * NWAVES + F.wave, NGW = F.G * NWAVES;
    for (int m = gw; m < NTOK; m += NGW) {
        const int t = m % SEQ;
#pragma unroll 1
        for (int ph = 0; ph < 12; ++ph) {
            const int part = ph >> 2, h = ph & 3; const int c = part * 512 + h * 128 + 2 * F.lane;
            float y0 = 0.f, y1 = 0.f;
#pragma unroll
            for (int j = 0; j < 4; ++j) { const int tt = t - 3 + j; if (tt >= 0) { const unsigned u = *(const unsigned*)(proj + (size_t)(m - 3 + j) * NPROJ + c); const f32x2 w = *(const f32x2*)(conv_w + j * 1536 + c); y0 += w.x * bflo(u); y1 += w.y * bfhi(u); } }
            y0 = siluf_(y0); y1 = siluf_(y1);
            if (part < 2) { const float ss = wave_sum(y0 * y0 + y1 * y1); float sc = 1.f / sqrtf(ss + 1e-6f); if (part == 0) sc *= 0.08838834764831845f; y0 *= sc; y1 *= sc; }
            *(f32x2*)(qkv + (size_t)part * NTOK * 512 + (size_t)m * 512 + h * 128 + 2 * F.lane) = (f32x2){y0, y1};
        }
        { const int ch = 8 * F.lane, gi = F.lane >> 4, win = 2 << gi; const int cnt = (t + 1) < win ? (t + 1) : win;
            float s[8];
#pragma unroll
            for (int q = 0; q < 8; ++q) s[q] = 0.f;
            v4u p0 = (v4u){0u, 0u, 0u, 0u};
            for (int j = 0; j < cnt; ++j) { const v4u u = *(const v4u*)(proj + (size_t)(m - j) * NPROJ + 2048 + ch); if (j == 0) p0 = u;
                s[0] += bflo(u.x); s[1] += bfhi(u.x); s[2] += bflo(u.y); s[3] += bfhi(u.y); s[4] += bflo(u.z); s[5] += bfhi(u.z); s[6] += bflo(u.w); s[7] += bfhi(u.w); }
            const float ic = 1.f / (float)cnt;
            v4u o; o.x = pk2(s[0] * ic - bflo(p0.x), s[1] * ic - bfhi(p0.x)); o.y = pk2(s[2] * ic - bflo(p0.y), s[3] * ic - bfhi(p0.y));
            o.z = pk2(s[4] * ic - bflo(p0.z), s[5] * ic - bfhi(p0.z)); o.w = pk2(s[6] * ic - bflo(p0.w), s[7] * ic - bfhi(p0.w));
            *(v4u*)(mixed + (size_t)m * 512 + ch) = o; }
    }
}

__device__ __forceinline__ void phase_recur(Frame& F) {
    if ((int)blockIdx.x >= NB * NH) return;
    const int bh = blockIdx.x, b = bh >> 2, h = bh & 3;
    const float* qkv = (const float*)(F.ws + WS_QKV); const float* betaA = (const float*)(F.ws + WS_BETA); const float* gA = (const float*)(F.ws + WS_G);
    float* oB = (float*)(F.ws + WS_O);
    LAS float* rb = (LAS float*)F.lds;
    const int e = F.tid;
    float S[128];
#pragma unroll
    for (int d = 0; d < 128; ++d) S[d] = 0.f;
    const size_t m0 = (size_t)b * SEQ;
    float nq = 0.f, nk = 0.f, nv = 0.f, nbeta = 0.f, ng = 0.f;
    if (e < 128) { nq = qkv[(m0) * 512 + h * 128 + e]; nk = qkv[(size_t)NTOK * 512 + m0 * 512 + h * 128 + e]; nv = qkv[(size_t)2 * NTOK * 512 + m0 * 512 + h * 128 + e]; nbeta = betaA[m0 * 4 + h]; ng = gA[m0 * 4 + h]; }
    for (int t = 0; t < SEQ; ++t) {
        LAS float* buf = rb + (t & 1) * 392;
        if (e < 128) { buf[e] = nq; buf[128 + e] = nk; if (e == 0) { buf[384] = nbeta; buf[385] = ng; } }
        const float vcur = nv;
        if (e < 128 && t + 1 < SEQ) { const size_t m = m0 + t + 1; nq = qkv[m * 512 + h * 128 + e]; nk = qkv[(size_t)NTOK * 512 + m * 512 + h * 128 + e]; nv = qkv[(size_t)2 * NTOK * 512 + m * 512 + h * 128 + e]; nbeta = betaA[m * 4 + h]; ng = gA[m * 4 + h]; }
        __syncthreads();
        if (e < 128) {
            const float alpha = __expf(buf[385]), beta = buf[384];
            float kS = 0.f;
#pragma unroll
            for (int d4 = 0; d4 < 32; ++d4) { const f32x4 kk = *(const LAS f32x4*)(buf + 128 + 4 * d4); kS += (kk.x * S[4 * d4] + kk.y * S[4 * d4 + 1]) + (kk.z * S[4 * d4 + 2] + kk.w * S[4 * d4 + 3]); if ((d4 & 3) == 3) __builtin_amdgcn_sched_barrier(0); }
            const float delta = beta * (vcur - alpha * kS);
            float o = 0.f;
#pragma unroll
            for (int d4 = 0; d4 < 32; ++d4) { const f32x4 kk = *(const LAS f32x4*)(buf + 128 + 4 * d4); const f32x4 qq = *(const LAS f32x4*)(buf + 4 * d4);
                S[4 * d4] = alpha * S[4 * d4] + kk.x * delta; S[4 * d4 + 1] = alpha * S[4 * d4 + 1] + kk.y * delta; S[4 * d4 + 2] = alpha * S[4 * d4 + 2] + kk.z * delta; S[4 * d4 + 3] = alpha * S[4 * d4 + 3] + kk.w * delta;
                o += (qq.x * S[4 * d4] + qq.y * S[4 * d4 + 1]) + (qq.z * S[4 * d4 + 2] + qq.w * S[4 * d4 + 3]); if ((d4 & 3) == 3) __builtin_amdgcn_sched_barrier(0); }
            oB[(m0 + t) * 512 + h * 128 + e] = o;
        }
    }
    VM_WAIT(); __syncthreads();
    const float* dnw = F.in[6]; const bf16* proj = (const bf16*)(F.ws + WS_PROJ); bf16* concat = (bf16*)(F.ws + WS_CONCAT);
    for (int t = F.wave; t < SEQ; t += NWAVES) {
        const size_t m = m0 + t; const f32x2 ov = *(const f32x2*)(oB + m * 512 + h * 128 + 2 * F.lane);
        const float ss = wave_sum(ov.x * ov.x + ov.y * ov.y); const float rs = 1.f / sqrtf(ss * (1.f / 128.f) + 1e-6f);
        const unsigned zu = *(const unsigned*)(proj + m * NPROJ + 1536 + h * 128 + 2 * F.lane); const f32x2 dw = *(const f32x2*)(dnw + 2 * F.lane);
        const float r0 = ov.x * rs * dw.x * siluf_(bflo(zu)), r1 = ov.y * rs * dw.y * siluf_(bfhi(zu));
        *(unsigned*)(concat + m * DM + h * 128 + 2 * F.lane) = pk2(r0, r1);
    }
}

__device__ __forceinline__ void phase_route(Frame& F) {
    const float* x1 = F.out; const float* Wr = (const float*)(F.ws + WS_WR); const float* b_router = F.in[12];
    bf16* x1b = (bf16*)(F.ws + WS_X1B); float* rs2A = (float*)(F.ws + WS_RS2); float* gatew = (float*)(F.ws + WS_GATEW); int* list = (int*)(F.ws + WS_LIST);
    unsigned* cntw = (unsigned*)(F.ws + WS_CTL) + CW_CNT;
    LAS float* WrL = (LAS float*)F.lds;
    for (int idx = F.tid; idx < NE * DM / 4; idx += 512) *(LAS f32x4*)(WrL + 4 * idx) = *(const f32x4*)(Wr + 4 * idx);
    __syncthreads();
    const int gw = F.vcu * NWAVES + F.wave, NGW = F.G * NWAVES;
    for (int m = gw; m < NTOK; m += NGW) {
        const f32x4* xr = (const f32x4*)(x1 + (size_t)m * DM) + F.lane;
        f32x4 v[4]; float ss = 0.f;
#pragma unroll
        for (int j = 0; j < 4; ++j) { v[j] = xr[64 * j]; ss += (v[j].x * v[j].x + v[j].y * v[j].y) + (v[j].z * v[j].z + v[j].w * v[j].w); }
        ss = wave_sum(ss);
        const float rs = 1.f / sqrtf(ss * (1.f / DM) + 1e-6f);
        unsigned long long* o8 = (unsigned long long*)(x1b + (size_t)m * DM) + F.lane;
#pragma unroll
        for (int j = 0; j < 4; ++j) o8[64 * j] = (unsigned long long)pk2(v[j].x, v[j].y) | ((unsigned long long)pk2(v[j].z, v[j].w) << 32);
        float mylg = -3.0e38f;
#pragma unroll 1
        for (int e = 0; e < NE; ++e) { float a = 0.f;
#pragma unroll
            for (int j = 0; j < 4; ++j) { const f32x4 w = *(const LAS f32x4*)(WrL + e * 1024 + 256 * j + 4 * F.lane); a += (v[j].x * w.x + v[j].y * w.y) + (v[j].z * w.z + v[j].w * w.w); }
            const float tot = wave_sum(a) * rs + b_router[e]; if (F.lane == e) mylg = tot; }
        int te[4]; float tv[4];
#pragma unroll
        for (int s = 0; s < 4; ++s) { float bv = mylg; int bi = F.lane;
#pragma unroll
            for (int o = 1; o < 64; o <<= 1) { const float ov = __shfl_xor(bv, o); const int oi = __shfl_xor(bi, o); if (ov > bv || (ov == bv && oi < bi)) { bv = ov; bi = oi; } }
            te[s] = bi; tv[s] = bv; if (F.lane == bi) mylg = -3.0e38f; }
        const float e1 = __expf(tv[1] - tv[0]), e2 = __expf(tv[2] - tv[0]), e3 = __expf(tv[3] - tv[0]); const float inv = 1.f / (1.f + e1 + e2 + e3);
        if (F.lane == 0) rs2A[m] = rs;
        if (F.lane < 4) {
            const int s = F.lane; const int ee = s == 0 ? te[0] : s == 1 ? te[1] : s == 2 ? te[2] : te[3]; const float gg = (s == 0 ? 1.f : s == 1 ? e1 : s == 2 ? e2 : e3) * inv;
            const unsigned pos = __hip_atomic_fetch_add(cntw + 64 * ee, 1u, RLX_AGENT);
            list[(size_t)ee * LISTCAP + pos] = m * 4 + s; gatew[(size_t)m * 4 + s] = gg;
        }
    }
}

__device__ __forceinline__ int moe_tables(Frame& F, MoeTab& T) {
    LAS int* pref = (LAS int*)(F.lds + TAB_OFF); LAS int* cnt = pref + 40;
    unsigned* cntw = (unsigned*)(F.ws + WS_CTL) + CW_CNT;
    if (F.tid == 0) { int acc = 0; for (int e = 0; e < NE; ++e) { const int c = (int)__hip_atomic_load(cntw + 64 * e, RLX_AGENT); cnt[e] = c; pref[e] = acc; acc += (c + 255) >> 8; } pref[NE] = acc; }
    __syncthreads();
    T.pref = pref; T.cnt = cnt;
    return pref[NE];
}

__device__ __forceinline__ void phase_final(Frame& F) {
    const float* fw = F.in[17]; const bf16* slab = (const bf16*)(F.ws + WS_SLAB); float* out = F.out;
    const int gw = F.vcu * NWAVES + F.wave, NGW = F.G * NWAVES;
    for (int m = gw; m < NTOK; m += NGW) {
        f32x4* xr = (f32x4*)(out + (size_t)m * DM) + F.lane;
        f32x4 v[4]; float ss = 0.f;
#pragma unroll
        for (int j = 0; j < 4; ++j) v[j] = xr[64 * j];
#pragma unroll
        for (int s = 0; s < 4; ++s) { const v2u* sp = (const v2u*)(slab + ((size_t)m * 4 + s) * DM) + F.lane;
#pragma unroll
            for (int j = 0; j < 4; ++j) { const v2u u = sp[64 * j]; v[j].x += bflo(u.x); v[j].y += bfhi(u.x); v[j].z += bflo(u.y); v[j].w += bfhi(u.y); } }
#pragma unroll
        for (int j = 0; j < 4; ++j) ss += (v[j].x * v[j].x + v[j].y * v[j].y) + (v[j].z * v[j].z + v[j].w * v[j].w);
        ss = wave_sum(ss);
        const float rs = 1.f / sqrtf(ss * (1.f / DM) + 1e-6f);
#pragma unroll
        for (int j = 0; j < 4; ++j) { const f32x4 w = *((const f32x4*)fw + 64 * j + F.lane); xr[64 * j] = v[j] * rs * w; }
    }
}

struct Args { const float* in[18]; float* out; unsigned char* ws; int ph_lo, ph_hi; };
constexpr int NPHASE = 9;

__global__ void __launch_bounds__(NWAVES * 64, 2) mk_fwd(Args args) {
    extern __shared__ __attribute__((aligned(16))) unsigned char lds_raw[];
    Frame F;
    F.lds = (LAS unsigned char*)lds_raw;
    F.tid = threadIdx.x; F.lane = F.tid & 63; F.wave = __builtin_amdgcn_readfirstlane(F.tid >> 6);
    F.G = gridDim.x; { const int bx = blockIdx.x; F.vcu = (F.G % 8 == 0) ? (bx % 8) * (F.G / 8) + bx / 8 : bx; }
#pragma unroll
    for (int i = 0; i < 18; ++i) F.in[i] = args.in[i];
    F.out = args.out; F.ws = args.ws;
    volatile LAS unsigned* MISC = (volatile LAS unsigned*)(F.lds + MISC_OFF);
    for (int u = F.tid; u < (LDS_BYTES - LDSCTL_OFF) / 4; u += NWAVES * 64) ((LAS unsigned*)(F.lds + LDSCTL_OFF))[u] = 0u;
    __syncthreads();
    unsigned* ctl = (unsigned*)(F.ws + WS_CTL);
#if !MK_PER_PHASE
    XcdBarrier bar = xcd_barrier_post(ctl + CW_BAR, MISC + 8);
#define GRID_BAR() xcd_barrier(bar)
#else
#define GRID_BAR() do {} while (0)
#endif
    const int lo = args.ph_lo, hi = args.ph_hi;
#define IN(k) (lo <= (k) && (k) < hi)
#define SEAM(k) do { if (IN(k) && IN((k) + 1)) GRID_BAR(); } while (0)

    if (IN(0)) { phase_prep(F); } SEAM(0);
    if (IN(1)) {
        ProbIn P; P.K = DM; P.S.init(NTOK / 256, NPROJ / 256, F.G, (int)blockIdx.x);
        P.A = (const bf16*)(F.ws + WS_XB); P.Bt = (const bf16*)(F.ws + WS_WIN); P.O = (bf16*)(F.ws + WS_PROJ); P.rs = (const float*)(F.ws + WS_RS1);
        pg8::gemm_phase(F.lds, P);
    } SEAM(1);
    if (IN(2)) { phase_conv(F); } SEAM(2);
    if (IN(3)) {
        { ProbPool P; P.K = 512; P.S.init(NTOK / 256, 2, F.G, (int)blockIdx.x);
          P.A = (const bf16*)(F.ws + WS_MIXED); P.Bt = (const bf16*)(F.ws + WS_WPOOL); P.O = (bf16*)(F.ws + WS_CONCAT);
          pg8::gemm_phase(F.lds, P); }
        __syncthreads();
        phase_recur(F);
    } SEAM(3);
    if (IN(4)) {
        ProbOut P; P.K = DM; P.S.init(NTOK / 256, DM / 256, F.G, (int)blockIdx.x);
        P.A = (const bf16*)(F.ws + WS_CONCAT); P.Bt = (const bf16*)(F.ws + WS_WOUT); P.X = F.in[0]; P.O = F.out;
        pg8::gemm_phase(F.lds, P);
    } SEAM(4);
    if (IN(5)) { phase_route(F); } SEAM(5);
    if (IN(6)) {
        ProbGU P; const int RT = moe_tables(F, P.T);
        P.K = DM; P.S.init(RT, 8, F.G, (int)blockIdx.x);
        P.A = (const bf16*)(F.ws + WS_X1B); P.Bt = (const bf16*)(F.ws + WS_WGU); P.O = (bf16*)(F.ws + WS_ACT); P.list = (const int*)(F.ws + WS_LIST);
        P.rs2 = (const float*)(F.ws + WS_RS2); P.bgu = (const float*)(F.ws + WS_BGU);
        pg8::gemm_phase(F.lds, P);
    } SEAM(6);
    if (IN(7)) {
        ProbDown P; const int RT = moe_tables(F, P.T);
        P.K = DE; P.S.init(RT, 4, F.G, (int)blockIdx.x);
        P.A = (const bf16*)(F.ws + WS_ACT); P.Bt = (const bf16*)(F.ws + WS_WD); P.O = (bf16*)(F.ws + WS_SLAB); P.list = (const int*)(F.ws + WS_LIST);
        P.gw = (const float*)(F.ws + WS_GATEW); P.bd = F.in[16];
        pg8::gemm_phase(F.lds, P);
    } SEAM(7);
    if (IN(8)) { phase_final(F); }
#undef IN
#undef SEAM
}

extern "C" void kernel_launch(void* const* d_in, const int* in_sizes, int n_in, void* d_out, int out_size, void* d_ws, size_t ws_size, hipStream_t stream) {
    static int grid = 0;
    if (grid == 0) {
        if (n_in != 18 || in_sizes[0] != NTOK * DM || out_size != NTOK * DM || ws_size < WS_END) { fprintf(stderr, "kernel_launch: unexpected shapes (n_in %d, in0 %d, out %d, ws %zu)\n", n_in, n_in > 0 ? in_sizes[0] : -1, out_size, ws_size); grid = -1; return; }
        int dev = 0, cus = 0, per_cu = 0;
        if (hipGetDevice(&dev) != hipSuccess || hipDeviceGetAttribute(&cus, hipDeviceAttributeMultiprocessorCount, dev) != hipSuccess) { grid = -1; return; }
        if (hipFuncSetAttribute((const void*)mk_fwd, hipFuncAttributeMaxDynamicSharedMemorySize, LDS_BYTES) != hipSuccess) { fprintf(stderr, "kernel_launch: hipFuncSetAttribute failed\n"); grid = -1; return; }
        if (hipOccupancyMaxActiveBlocksPerMultiprocessor(&per_cu, (const void*)mk_fwd, NWAVES * 64, LDS_BYTES) != hipSuccess || per_cu < 1) { fprintf(stderr, "kernel_launch: occupancy query says %d\n", per_cu); per_cu = 1; }
        (void)hipGetLastError();
        grid = cus;
    }
    if (grid < 0) return;
    (void)hipMemsetAsync((char*)d_ws + WS_CTL, 0, CTL_ZERO_BYTES, stream);
    Args a{};
    for (int i = 0; i < 18; ++i) a.in[i] = (const float*)d_in[i];
    a.out = (float*)d_out; a.ws = (unsigned char*)d_ws;
#if MK_PER_PHASE
    for (int p = 0; p < NPHASE; ++p) { a.ph_lo = p; a.ph_hi = p + 1; hipLaunchKernelGGL(mk_fwd, dim3(grid), dim3(NWAVES * 64), LDS_BYTES, stream, a); }
#else
    a.ph_lo = 0; a.ph_hi = NPHASE;
    hipLaunchKernelGGL(mk_fwd, dim3(grid), dim3(NWAVES * 64), LDS_BYTES, stream, a);
#endif
}
```

```cpp
#include <hip/hip_runtime.h>
#include <cstdio>
#include <cstdint>

#ifndef MK_PER_PHASE
#define MK_PER_PHASE 0
#endif

constexpr int NB = 8, SEQ = 4096, DM = 1024, NTOK = NB * SEQ;
constexpr int NH = 4, HD = 128, DDN = 512, DPOOL = 512, DIN = 2568, NPROJ = 2560;
constexpr int NE = 32, TOPK = 4, DE = 1024, NASSIGN = NTOK * TOPK;
constexpr int LISTCAP = NTOK;
constexpr int ACT_ROWS = NASSIGN + NE * 256;

constexpr size_t MiB = 1u << 20;
constexpr size_t WS_CTL = 0, CTL_ZERO_BYTES = 1 * MiB;
constexpr size_t WS_WIN = 1 * MiB;
constexpr size_t WS_WOUT = 6 * MiB;
constexpr size_t WS_WPOOL = 8 * MiB;
constexpr size_t WS_WR = 8 * MiB + 512 * 1024;
constexpr size_t WS_BGU = 8 * MiB + 768 * 1024;
constexpr size_t WS_RS1 = 9 * MiB;
constexpr size_t WS_BETA = 9 * MiB + 128 * 1024;
constexpr size_t WS_G = 9 * MiB + 640 * 1024;
constexpr size_t WS_RS2 = 10 * MiB + 256 * 1024;
constexpr size_t WS_GATEW = 10 * MiB + 512 * 1024;
constexpr size_t WS_LIST = 11 * MiB;
constexpr size_t WS_WGU = 16 * MiB;
constexpr size_t WS_WD = 144 * MiB;
constexpr size_t WS_XB = 208 * MiB;
constexpr size_t WS_PROJ = 272 * MiB;
constexpr size_t WS_CHUNK = 432 * MiB;
constexpr size_t WS_UC = 544 * MiB;
constexpr size_t WS_GTOT = 576 * MiB;
constexpr int CH_WF = 0, CH_QD = 16384, CH_KT = 32768, CH_QK = 49152, CH_BYTES = 57344, UC_BYTES = 16384;
constexpr size_t WS_MIXED = 688 * MiB;
constexpr size_t WS_CONCAT = 720 * MiB;
constexpr size_t WS_X1B = 208 * MiB;
constexpr size_t WS_ACT = 272 * MiB;
constexpr size_t WS_SLAB = 544 * MiB;
constexpr size_t WS_END = 800 * MiB;
static_assert(WS_ACT + (size_t)ACT_ROWS * 2048 <= WS_SLAB, "act fits");
static_assert(WS_SLAB + (size_t)NASSIGN * 2048 <= WS_END, "slab fits");

constexpr int CW_BAR = 4096;
constexpr int CW_CNT = 16384;

constexpr int LDS_BYTES = 147456;
constexpr int LDSCTL_OFF = LDS_BYTES - 1024, MISC_OFF = LDSCTL_OFF + 320, TAB_OFF = LDSCTL_OFF + 512;
constexpr int NWAVES = 8;

#define GAS __attribute__((address_space(1)))
#define LAS __attribute__((address_space(3)))
typedef unsigned short bf16;
typedef unsigned v4u __attribute__((ext_vector_type(4)));
typedef unsigned v2u __attribute__((ext_vector_type(2)));
typedef float f32x4 __attribute__((ext_vector_type(4)));
typedef float f32x2 __attribute__((ext_vector_type(2)));
typedef short bf16x8 __attribute__((ext_vector_type(8)));
typedef GAS unsigned gu32;
#define RLX_AGENT __ATOMIC_RELAXED, __HIP_MEMORY_SCOPE_AGENT
#define LDS_WAIT() asm volatile("s_waitcnt lgkmcnt(0)" ::: "memory")
#define VM_WAIT() asm volatile("s_waitcnt vmcnt(0)" ::: "memory")

__device__ __forceinline__ unsigned f2bf(float f) { unsigned u = __builtin_bit_cast(unsigned, f); return (u + 0x7fffu + ((u >> 16) & 1u)) >> 16; }
__device__ __forceinline__ unsigned pk2(float lo, float hi) { return f2bf(lo) | (f2bf(hi) << 16); }
__device__ __forceinline__ float bflo(unsigned u) { return __builtin_bit_cast(float, u << 16); }
__device__ __forceinline__ float bfhi(unsigned u) { return __builtin_bit_cast(float, u & 0xffff0000u); }
__device__ __forceinline__ float wave_sum(float v) {
#pragma unroll
    for (int o = 1; o < 64; o <<= 1) v += __shfl_xor(v, o);
    return v;
}
__device__ __forceinline__ float sigmoidf_(float x) { return 1.f / (1.f + __expf(-x)); }
__device__ __forceinline__ float siluf_(float x) { return x / (1.f + __expf(-x)); }

namespace pg8 {
constexpr int BM = 256, BK = 64, HALF = 128, HTB = HALF * BK * 2, STAGE_BYTES = 8 * HTB;
__device__ __forceinline__ int lds_byte(int r, int c) { const int st = (r >> 4) * 2 + (c >> 5), rr = r & 15, cc = c & 31, ob = rr * 64 + cc * 2; return st * 1024 + (ob ^ (((ob >> 9) & 1) << 5)); }
__device__ __forceinline__ void stage_rc(int b, int& R, int& C) { const int st = b / 1024, sb = b % 1024, swz = sb ^ (((sb >> 9) & 1) << 5); R = (st >> 1) * 16 + swz / 64; C = (st & 1) * 32 + (swz % 64) / 2; }
__device__ __forceinline__ int perm32(int rho) { const int n = rho >> 4, i = rho & 15; return 8 * (i >> 2) + 4 * n + (i & 3); }
typedef __bf16 bf16x2_t __attribute__((ext_vector_type(2)));
__device__ __forceinline__ unsigned cvt_pk_bf16(float lo, float hi) { const f32x2 v = {lo, hi}; const bf16x2_t b = __builtin_convertvector(v, bf16x2_t); return __builtin_bit_cast(unsigned, b); }

struct Unit { int rt, pn, e, rb, rows; };

struct Sched {
    int nM, nN, nwg, G, c;
    __device__ __forceinline__ void init(int nM_, int nN_, int G_, int c_) { nM = nM_; nN = nN_; nwg = nM * nN; G = G_; c = c_; }
    __device__ __forceinline__ bool next(int i, int& pm, int& pn) const {
        const long L = (long)i * G + c; if (L >= nwg) return false;
        int wgid = (int)L; { const int q = nwg / 8, r = nwg % 8, xcd = wgid % 8, off = wgid / 8; wgid = (xcd < r ? xcd * (q + 1) : r * (q + 1) + (xcd - r) * q) + off; }
        const int nig = 8 * nN, gid = wgid / nig, fm = gid * 8, gsz = (nM - fm) < 8 ? (nM - fm) : 8;
        pm = fm + ((wgid % nig) % gsz); pn = (wgid % nig) / gsz; return true;
    }
};

template <class P>
__device__ __forceinline__ void gemm_phase(LAS unsigned char* lds, const P& p) {
    const int tid = threadIdx.x, wid = __builtin_amdgcn_readfirstlane(tid >> 6), lane = tid & 63, wr = wid >> 2, wc = wid & 3, fr = lane & 15, fq = lane >> 4;
    const int K = p.K, nt = K / BK;
    int R[2], C[2]; unsigned voffB[2];
#pragma unroll
    for (int i = 0; i < 2; ++i) { stage_rc(tid * 16 + i * 8192, R[i], C[i]); const int Rb = (R[i] & ~31) + perm32(R[i] & 31); voffB[i] = (unsigned)(Rb * K + C[i]) * 2u; }
    const size_t kstep = (size_t)(BK * 2);
    const size_t hstep = (size_t)HALF * K * 2;
    const unsigned ldsw = (unsigned)wid * 1024u;
    const int aoff = lds_byte(wr * 64 + fr, fq * 8), boff = lds_byte(wc * 32 + fr, fq * 8);
#define PG8_SA(b, h) (((b) * 2 + (h)) * HTB)
#define PG8_SB(b, h) ((4 + (b) * 2 + (h)) * HTB)
#define PG8_STAGE(bufoff, gbase, voff) do { _Pragma("unroll") for (int _i = 0; _i < 2; ++_i) \
        __builtin_amdgcn_global_load_lds((const unsigned*)((const char*)(gbase) + (voff)[_i]), (LAS unsigned*)(lds + (bufoff) + ldsw + _i * 8192), 16, 0, 0); } while (0)
#define PG8_LDA(dst, b, h) do { _Pragma("unroll") for (int m = 0; m < 4; ++m) _Pragma("unroll") for (int k = 0; k < 2; ++k) dst[m][k] = *(const LAS bf16x8*)(lds + PG8_SA(b, h) + aoff + m * 2048 + k * 1024); } while (0)
#define PG8_LDB(dst, b, h) do { _Pragma("unroll") for (int n = 0; n < 2; ++n) _Pragma("unroll") for (int k = 0; k < 2; ++k) dst[n][k] = *(const LAS bf16x8*)(lds + PG8_SB(b, h) + boff + n * 2048 + k * 1024); } while (0)
#define PG8_MMA(ai, bj, At, Bt) do { __builtin_amdgcn_s_setprio(1); _Pragma("unroll") for (int m = 0; m < 4; ++m) _Pragma("unroll") for (int n = 0; n < 2; ++n) _Pragma("unroll") for (int k = 0; k < 2; ++k) \
        acc[ai][bj][m][n] = __builtin_amdgcn_mfma_f32_16x16x32_bf16(Bt[n][k], At[m][k], acc[ai][bj][m][n], 0, 0, 0); __builtin_amdgcn_s_setprio(0); } while (0)
#define PG8_WAIT_V(n) asm volatile("s_waitcnt vmcnt(" #n ")" ::: "memory")
#define PG8_WAIT_L(n) asm volatile("s_waitcnt lgkmcnt(" #n ")" ::: "memory")
#define PG8_BAR __builtin_amdgcn_s_barrier()
#define PG8_SCHED __builtin_amdgcn_sched_barrier(0)
    Unit cur, nxt; int ui = 0;
    if (!p.next(0, cur)) return;
    f32x4 acc[2][2][4][2];
#pragma unroll
    for (int a = 0; a < 2; ++a)
#pragma unroll
        for (int b = 0; b < 2; ++b)
#pragma unroll
            for (int m = 0; m < 4; ++m)
#pragma unroll
                for (int n = 0; n < 2; ++n) acc[a][b][m][n] = (f32x4){0.f, 0.f, 0.f, 0.f};
    bf16x8 At[4][2], B0[2][2], B1[2][2];
    unsigned oA[2][2], nO[2][2];
    p.a_off(cur, R, C, oA);
    const char* cA = p.a_base(cur); const char* cB = p.b_base(cur);
    PG8_STAGE(PG8_SB(0, 0), cB, voffB); PG8_STAGE(PG8_SB(0, 1), cB + hstep, voffB); PG8_STAGE(PG8_SA(0, 0), cA, oA[0]); PG8_STAGE(PG8_SA(0, 1), cA, oA[1]);
    if (wr == 1) PG8_BAR;
    PG8_WAIT_V(2); PG8_BAR;
    PG8_STAGE(PG8_SB(1, 0), cB + kstep, voffB); PG8_STAGE(PG8_SA(1, 0), cA + kstep, oA[0]); PG8_STAGE(PG8_SB(1, 1), cB + hstep + kstep, voffB);
    PG8_WAIT_V(6); PG8_BAR;
    for (;;) {
        const bool has_next = p.next(ui + 1, nxt);
        const char* nA = cA; const char* nB = cB;
#pragma unroll
        for (int h = 0; h < 2; ++h)
#pragma unroll
            for (int i = 0; i < 2; ++i) nO[h][i] = oA[h][i];
        if (has_next) { nA = p.a_base(nxt); nB = p.b_base(nxt); p.a_off(nxt, R, C, nO); }
        asm volatile("" : "+v"(nO[0][0]), "+v"(nO[0][1]), "+v"(nO[1][0]), "+v"(nO[1][1]));
        for (int t = 0; t < nt; t += 2) {
            const bool last = (t == nt - 2);
            const char* a1 = cA + (size_t)(t + 1) * kstep;
            const char* a2 = last ? nA : cA + (size_t)(t + 2) * kstep; const char* b2 = last ? nB : cB + (size_t)(t + 2) * kstep;
            const char* a3 = a2 + kstep; const char* b3 = b2 + kstep;
            unsigned o2[2][2];
#pragma unroll
            for (int h = 0; h < 2; ++h)
#pragma unroll
                for (int i = 0; i < 2; ++i) o2[h][i] = last ? nO[h][i] : oA[h][i];
            PG8_LDB(B0, 0, 0); PG8_LDB(B1, 0, 1); PG8_SCHED; PG8_LDA(At, 0, 0); PG8_STAGE(PG8_SA(1, 1), a1, oA[1]);
            PG8_WAIT_V(8); PG8_WAIT_L(0); PG8_BAR; PG8_MMA(0, 0, At, B0); PG8_MMA(0, 1, At, B1); PG8_BAR; PG8_SCHED;
            PG8_LDA(At, 0, 1); PG8_STAGE(PG8_SB(0, 0), b2, voffB); PG8_STAGE(PG8_SB(0, 1), b2 + hstep, voffB); PG8_STAGE(PG8_SA(0, 0), a2, o2[0]);
            PG8_WAIT_V(8); PG8_WAIT_L(0); PG8_BAR; PG8_MMA(1, 0, At, B0); PG8_MMA(1, 1, At, B1); PG8_BAR; PG8_SCHED;
            PG8_LDB(B0, 1, 0); PG8_LDB(B1, 1, 1); PG8_SCHED; PG8_LDA(At, 1, 0); PG8_STAGE(PG8_SA(0, 1), a2, o2[1]);
            PG8_WAIT_V(8); PG8_WAIT_L(0); PG8_BAR; PG8_MMA(0, 0, At, B0); PG8_MMA(0, 1, At, B1); PG8_BAR; PG8_SCHED;
            PG8_LDA(At, 1, 1); PG8_STAGE(PG8_SB(1, 0), b3, voffB); PG8_STAGE(PG8_SB(1, 1), b3 + hstep, voffB); PG8_STAGE(PG8_SA(1, 0), a3, o2[0]);
            PG8_WAIT_V(8); PG8_WAIT_L(0); PG8_BAR; PG8_MMA(1, 0, At, B0); PG8_MMA(1, 1, At, B1); PG8_BAR; PG8_SCHED;
        }
        if (wr == 0) PG8_BAR;
        p.epi(acc, cur, wr, wc, fr, fq);
        if (!has_next) break;
#pragma unroll
        for (int a = 0; a < 2; ++a)
#pragma unroll
            for (int b = 0; b < 2; ++b)
#pragma unroll
                for (int m = 0; m < 4; ++m)
#pragma unroll
                    for (int n = 0; n < 2; ++n) acc[a][b][m][n] = (f32x4){0.f, 0.f, 0.f, 0.f};
        cur = nxt; cA = nA; cB = nB; ++ui;
#pragma unroll
        for (int h = 0; h < 2; ++h)
#pragma unroll
            for (int i = 0; i < 2; ++i) oA[h][i] = nO[h][i];
        if (wr == 1) PG8_BAR;
    }
    PG8_WAIT_V(0);
    PG8_BAR;
#undef PG8_SA
#undef PG8_SB
#undef PG8_STAGE
#undef PG8_LDA
#undef PG8_LDB
#undef PG8_MMA
#undef PG8_WAIT_V
#undef PG8_WAIT_L
#undef PG8_BAR
#undef PG8_SCHED
}
}

#define XB_TMO      128
#define XB_XCNT(j)  (256  + 64 * (j))
#define XB_XSUB(j)  (1280 + 64 * (j))
#define XB_XGEN(j)  (2304 + 64 * (j))
#define XB_TOP      3328
#define XB_TOPGEN   3392
#define XCD_BAR_WORDS 3456
#define XB_SPIN_CAP (1u << 18)
__device__ __forceinline__ unsigned xb_ld(unsigned* p)              { return __hip_atomic_load(p, __ATOMIC_RELAXED, __HIP_MEMORY_SCOPE_AGENT); }
__device__ __forceinline__ unsigned xb_add(unsigned* p, unsigned v) { return __hip_atomic_fetch_add(p, v, __ATOMIC_RELAXED, __HIP_MEMORY_SCOPE_AGENT); }
__device__ __forceinline__ unsigned xb_xcc_id() { return (unsigned)__builtin_amdgcn_s_getreg((3 << 11) | 20) & 0xFu; }
#define XB_SPIN(cond, bar) do { unsigned _sp = 0; while (cond) { __builtin_amdgcn_s_sleep(1); \
    if ((++_sp & 255u) == 0u) { if (xb_ld(&(bar)[XB_TMO])) break; if (_sp > XB_SPIN_CAP) { atomicAdd(&(bar)[XB_TMO], 1u); break; } } } } while (0)
struct XcdBarrier { unsigned* bar; unsigned x; volatile LAS unsigned* st; };
__device__ __forceinline__ XcdBarrier xcd_barrier_post(unsigned* bar, volatile LAS unsigned* st) {
    XcdBarrier b; b.bar = bar; b.x = xb_xcc_id(); b.st = st;
    if (threadIdx.x == 0) (void)xb_add(&bar[XB_XCNT(b.x)], 1u);
    return b;
}
__device__ __forceinline__ void xcd_barrier_complete(unsigned* bar, unsigned x, unsigned& nloc, unsigned& nx) {
    const unsigned G = gridDim.x * gridDim.y * gridDim.z;
    unsigned sum, cnt, mine, sp = 0u;
    for (;;) {
        sum = 0u; cnt = 0u; mine = 0u;
#pragma unroll
        for (unsigned j = 0; j < 16; ++j) { const unsigned c = xb_ld(&bar[XB_XCNT(j)]); sum += c; cnt += (c > 0u) ? 1u : 0u; mine = (j == x) ? c : mine; }
        if (sum == G) break;
        __builtin_amdgcn_s_sleep(1);
        if ((++sp & 255u) == 0u) { if (xb_ld(&bar[XB_TMO])) break; if (sp > XB_SPIN_CAP) { atomicAdd(&bar[XB_TMO], 1u); break; } }
    }
    nloc = mine > 0u ? mine : 1u; nx = cnt > 0u ? cnt : 1u;
}
__device__ __forceinline__ void xcd_barrier(const XcdBarrier& b) {
    asm volatile("s_waitcnt vmcnt(0)" ::: "memory");
    __syncthreads();
    if (threadIdx.x == 0) {
        unsigned* bar = b.bar;
        __builtin_amdgcn_s_waitcnt(0);
        unsigned nloc = b.st[0], nx = b.st[1];
        if (nloc == 0u) { xcd_barrier_complete(bar, b.x, nloc, nx); b.st[0] = nloc; b.st[1] = nx; }
        const unsigned old = xb_add(&bar[XB_XSUB(b.x)], 1u);
        const unsigned gen = old / nloc;
        if (old + 1u == (gen + 1u) * nloc) {
            __builtin_amdgcn_fence(__ATOMIC_RELEASE, "agent");
            asm volatile("s_waitcnt vmcnt(0)" ::: "memory");
            const unsigned og = xb_add(&bar[XB_TOP], 1u);
            const unsigned tg = og / nx;
            if (og + 1u == (tg + 1u) * nx) xb_add(&bar[XB_TOPGEN], 1u);
            else XB_SPIN(xb_ld(&bar[XB_TOPGEN]) == tg, bar);
            __builtin_amdgcn_fence(__ATOMIC_ACQUIRE, "agent");
            xb_add(&bar[XB_XGEN(b.x)], 1u);
            asm volatile("s_waitcnt vmcnt(0)" ::: "memory");
        } else {
            XB_SPIN(xb_ld(&bar[XB_XGEN(b.x)]) == gen, bar);
            __builtin_amdgcn_fence(__ATOMIC_ACQUIRE, "agent");
            asm volatile("s_waitcnt vmcnt(0)" ::: "memory");
        }
    }
    __syncthreads();
}

struct Frame {
    LAS unsigned char* lds;
    int tid, lane, wave, vcu, G;
    const float* in[18];
    float* out;
    unsigned char* ws;
};
using pg8::Unit;
using pg8::cvt_pk_bf16;

struct ProbBase {
    int K; pg8::Sched S;
    __device__ __forceinline__ void lin_off(const int (&R)[2], const int (&C)[2], unsigned (&off)[2][2]) const {
#pragma unroll
        for (int h = 0; h < 2; ++h)
#pragma unroll
            for (int i = 0; i < 2; ++i) off[h][i] = (unsigned)((h * 128 + R[i]) * K + C[i]) * 2u;
    }
};
struct ProbIn : ProbBase {
    const bf16* A; const bf16* Bt; bf16* O; const float* rs;
    __device__ __forceinline__ bool next(int i, Unit& u) const { int pm, pn; if (!S.next(i, pm, pn)) return false; u.rt = pm; u.pn = pn; u.e = 0; u.rb = pm; u.rows = 256; return true; }
    __device__ __forceinline__ const char* a_base(const Unit& u) const { return (const char*)A + (size_t)u.rt * 256 * K * 2; }
    __device__ __forceinline__ const char* b_base(const Unit& u) const { return (const char*)Bt + (size_t)u.pn * 256 * K * 2; }
    __device__ __forceinline__ void a_off(const Unit&, const int (&R)[2], const int (&C)[2], unsigned (&off)[2][2]) const { lin_off(R, C, off); }
    __device__ __forceinline__ void epi(const f32x4 (&acc)[2][2][4][2], const Unit& u, int wr, int wc, int fr, int fq) const {
        const int row0 = u.rt * 256 + wr * 64 + fr, col0 = u.pn * 256 + wc * 32 + 8 * fq;
#pragma unroll
        for (int ai = 0; ai < 2; ++ai)
#pragma unroll
            for (int m = 0; m < 4; ++m) { const int row = row0 + ai * 128 + m * 16; const float sc = rs[row]; bf16* rowp = O + (size_t)row * NPROJ + col0;
#pragma unroll
                for (int bj = 0; bj < 2; ++bj) { const f32x4 v0 = acc[ai][bj][m][0] * sc, v1 = acc[ai][bj][m][1] * sc; v4u w;
                    w.x = cvt_pk_bf16(v0[0], v0[1]); w.y = cvt_pk_bf16(v0[2], v0[3]); w.z = cvt_pk_bf16(v1[0], v1[1]); w.w = cvt_pk_bf16(v1[2], v1[3]);
                    *(v4u*)(rowp + bj * 128) = w; } }
    }
};
struct ProbPool : ProbBase {
    const bf16* A; const bf16* Bt; bf16* O;
    __device__ __forceinline__ bool next(int i, Unit& u) const { int pm, pn; if (!S.next(i, pm, pn)) return false; u.rt = pm; u.pn = pn; u.e = 0; u.rb = pm; u.rows = 256; return true; }
    __device__ __forceinline__ const char* a_base(const Unit& u) const { return (const char*)A + (size_t)u.rt * 256 * K * 2; }
    __device__ __forceinline__ const char* b_base(const Unit& u) const { return (const char*)Bt + (size_t)u.pn * 256 * K * 2; }
    __device__ __forceinline__ void a_off(const Unit&, const int (&R)[2], const int (&C)[2], unsigned (&off)[2][2]) const { lin_off(R, C, off); }
    __device__ __forceinline__ void epi(const f32x4 (&acc)[2][2][4][2], const Unit& u, int wr, int wc, int fr, int fq) const {
        const int row0 = u.rt * 256 + wr * 64 + fr, col0 = 512 + u.pn * 256 + wc * 32 + 8 * fq;
#pragma unroll
        for (int ai = 0; ai < 2; ++ai)
#pragma unroll
            for (int m = 0; m < 4; ++m) { const int row = row0 + ai * 128 + m * 16; bf16* rowp = O + (size_t)row * DM + col0;
#pragma unroll
                for (int bj = 0; bj < 2; ++bj) { const f32x4 v0 = acc[ai][bj][m][0], v1 = acc[ai][bj][m][1]; v4u w;
                    w.x = cvt_pk_bf16(v0[0], v0[1]); w.y = cvt_pk_bf16(v0[2], v0[3]); w.z = cvt_pk_bf16(v1[0], v1[1]); w.w = cvt_pk_bf16(v1[2], v1[3]);
                    *(v4u*)(rowp + bj * 128) = w; } }
    }
};
struct ProbOut : ProbBase {
    const bf16* A; const bf16* Bt; const float* X; float* O;
    __device__ __forceinline__ bool next(int i, Unit& u) const { int pm, pn; if (!S.next(i, pm, pn)) return false; u.rt = pm; u.pn = pn; u.e = 0; u.rb = pm; u.rows = 256; return true; }
    __device__ __forceinline__ const char* a_base(const Unit& u) const { return (const char*)A + (size_t)u.rt * 256 * K * 2; }
    __device__ __forceinline__ const char* b_base(const Unit& u) const { return (const char*)Bt + (size_t)u.pn * 256 * K * 2; }
    __device__ __forceinline__ void a_off(const Unit&, const int (&R)[2], const int (&C)[2], unsigned (&off)[2][2]) const { lin_off(R, C, off); }
    __device__ __forceinline__ void epi(const f32x4 (&acc)[2][2][4][2], const Unit& u, int wr, int wc, int fr, int fq) const {
        const int row0 = u.rt * 256 + wr * 64 + fr, col0 = u.pn * 256 + wc * 32 + 8 * fq;
#pragma unroll
        for (int ai = 0; ai < 2; ++ai)
#pragma unroll
            for (int m = 0; m < 4; ++m) { const size_t off = (size_t)(row0 + ai * 128 + m * 16) * DM + col0;
#pragma unroll
                for (int bj = 0; bj < 2; ++bj)
#pragma unroll
                    for (int n = 0; n < 2; ++n) { const f32x4 xv = *(const f32x4*)(X + off + bj * 128 + 4 * n); *(f32x4*)(O + off + bj * 128 + 4 * n) = xv + acc[ai][bj][m][n]; } }
    }
};
struct MoeTab { const LAS int* pref; const LAS int* cnt; };
__device__ __forceinline__ void moe_decode(const MoeTab& T, int rt, Unit& u) {
    int e = 0;
#pragma unroll 1
    for (int j = 1; j < NE; ++j) if (T.pref[j] <= rt) e = j;
    u.e = e; u.rb = rt - T.pref[e]; const int left = T.cnt[e] - u.rb * 256; u.rows = left < 256 ? left : 256;
}
struct ProbGU : ProbBase {
    MoeTab T; const bf16* A; const bf16* Bt; bf16* O; const int* list; const float* rs2; const float* bgu;
    __device__ __forceinline__ bool next(int i, Unit& u) const { int pm, pn; if (!S.next(i, pm, pn)) return false; u.rt = pm; u.pn = pn; moe_decode(T, pm, u); return true; }
    __device__ __forceinline__ const char* a_base(const Unit&) const { return (const char*)A; }
    __device__ __forceinline__ const char* b_base(const Unit& u) const { return (const char*)Bt + ((size_t)u.e * 2048 + (size_t)u.pn * 256) * K * 2; }
    __device__ __forceinline__ void a_off(const Unit& u, const int (&R)[2], const int (&C)[2], unsigned (&off)[2][2]) const {
        const int* lp = list + (size_t)u.e * LISTCAP + u.rb * 256;
#pragma unroll
        for (int h = 0; h < 2; ++h)
#pragma unroll
            for (int i = 0; i < 2; ++i) { const int r = h * 128 + R[i]; const int ent = (r < u.rows) ? lp[r] : 0; off[h][i] = (unsigned)(ent >> 2) * (unsigned)(K * 2) + (unsigned)C[i] * 2u; }
    }
    __device__ __forceinline__ void epi(const f32x4 (&acc)[2][2][4][2], const Unit& u, int wr, int wc, int fr, int fq) const {
        const int* lp = list + (size_t)u.e * LISTCAP + u.rb * 256;
        const int j0 = wc * 32 + 8 * fq;
        const float* bg = bgu + (size_t)u.e * 2048 + u.pn * 256 + j0;
        f32x4 bgv[2], buv[2];
#pragma unroll
        for (int n = 0; n < 2; ++n) { bgv[n] = *(const f32x4*)(bg + 4 * n); buv[n] = *(const f32x4*)(bg + 128 + 4 * n); }
#pragma unroll
        for (int ai = 0; ai < 2; ++ai)
#pragma unroll
            for (int m = 0; m < 4; ++m) { const int r = ai * 128 + wr * 64 + m * 16 + fr;
                if (r < u.rows) { const int ent = lp[r]; const float sc = rs2[ent >> 2]; unsigned w[4];
#pragma unroll
                    for (int n = 0; n < 2; ++n) { float a[4];
#pragma unroll
                        for (int q = 0; q < 4; ++q) { float gt = acc[ai][0][m][n][q] * sc + bgv[n][q], up = acc[ai][1][m][n][q] * sc + buv[n][q];
                            gt = fminf(gt, 7.f); up = fminf(fmaxf(up, -7.f), 7.f); a[q] = (up + 1.f) * gt / (1.f + __expf(-1.702f * gt)); }
                        w[2 * n] = cvt_pk_bf16(a[0], a[1]); w[2 * n + 1] = cvt_pk_bf16(a[2], a[3]); }
                    *(v4u*)(O + (size_t)(u.rt * 256 + r) * DE + u.pn * 128 + j0) = (v4u){w[0], w[1], w[2], w[3]}; } }
    }
};
struct ProbDown : ProbBase {
    MoeTab T; const bf16* A; const bf16* Bt; bf16* O; const int* list; const float* gw; const float* bd;
    __device__ __forceinline__ bool next(int i, Unit& u) const { int pm, pn; if (!S.next(i, pm, pn)) return false; u.rt = pm; u.pn = pn; moe_decode(T, pm, u); return true; }
    __device__ __forceinline__ const char* a_base(const Unit& u) const { return (const char*)A + (size_t)u.rt * 256 * K * 2; }
    __device__ __forceinline__ const char* b_base(const Unit& u) const { return (const char*)Bt + ((size_t)u.e * 1024 + (size_t)u.pn * 256) * K * 2; }
    __device__ __forceinline__ void a_off(const Unit&, const int (&R)[2], const int (&C)[2], unsigned (&off)[2][2]) const { lin_off(R, C, off); }
    __device__ __forceinline__ void epi(const f32x4 (&acc)[2][2][4][2], const Unit& u, int wr, int wc, int fr, int fq) const {
        const int* lp = list + (size_t)u.e * LISTCAP + u.rb * 256;
        const int c0 = u.pn * 256 + wc * 32 + 8 * fq;
        const float* bp = bd + (size_t)u.e * DM + c0;
        f32x4 bv[2][2];
#pragma unroll
        for (int bj = 0; bj < 2; ++bj)
#pragma unroll
            for (int n = 0; n < 2; ++n) bv[bj][n] = *(const f32x4*)(bp + bj * 128 + 4 * n);
#pragma unroll
        for (int ai = 0; ai < 2; ++ai)
#pragma unroll
            for (int m = 0; m < 4; ++m) { const int r = ai * 128 + wr * 64 + m * 16 + fr;
                if (r < u.rows) { const int ent = lp[r]; const float g = gw[ent]; bf16* rowp = O + (size_t)ent * DM + c0;
#pragma unroll
                    for (int bj = 0; bj < 2; ++bj) { const f32x4 v0 = (acc[ai][bj][m][0] + bv[bj][0]) * g, v1 = (acc[ai][bj][m][1] + bv[bj][1]) * g; v4u w;
                        w.x = cvt_pk_bf16(v0[0], v0[1]); w.y = cvt_pk_bf16(v0[2], v0[3]); w.z = cvt_pk_bf16(v1[0], v1[1]); w.w = cvt_pk_bf16(v1[2], v1[3]);
                        *(v4u*)(rowp + bj * 128) = w; } } }
    }
};

__device__ __forceinline__ void tr_item(const float* W, int ldw, int k0, int nsrc0, bf16* WT, size_t drow0, int ldk, int dk0, const float* ks, const float* ns, LAS float* scr, int lane) {
    const int nl = lane & 31;
    const float nsc = ns ? ns[nsrc0 + nl] : 1.f;
#pragma unroll 8
    for (int i = 0; i < 32; ++i) { const int kk = 2 * i + (lane >> 5); float v = W[(size_t)(k0 + kk) * ldw + nsrc0 + nl] * nsc; if (ks) v *= ks[k0 + kk]; scr[kk * 33 + nl] = v; }
    LDS_WAIT(); asm volatile("" ::: "memory");
    const int c = lane & 7;
#pragma unroll
    for (int j = 0; j < 4; ++j) { const int n = (lane >> 3) + 8 * j; const LAS float* s = scr + (8 * c) * 33 + n;
        v4u o; o.x = pk2(s[0 * 33], s[1 * 33]); o.y = pk2(s[2 * 33], s[3 * 33]); o.z = pk2(s[4 * 33], s[5 * 33]); o.w = pk2(s[6 * 33], s[7 * 33]);
        *(v4u*)(WT + (drow0 + n) * (size_t)ldk + dk0 + k0 + 8 * c) = o; }
    LDS_WAIT(); asm volatile("" ::: "memory");
}

__device__ __forceinline__ void phase_prep(Frame& F) {
    const float* x = F.in[0]; const float* anw = F.in[1]; const float* w_in = F.in[2]; const float* a_log = F.in[4]; const float* dt_bias = F.in[5];
    const float* pool_w = F.in[7]; const float* pool_scale = F.in[8]; const float* w_out = F.in[9]; const float* fnw = F.in[10];
    const float* w_router = F.in[11]; const float* w_gu = F.in[13]; const float* b_gu = F.in[14]; const float* w_d = F.in[15];
    bf16* WinT = (bf16*)(F.ws + WS_WIN); bf16* WoutT = (bf16*)(F.ws + WS_WOUT); bf16* WpoolT = (bf16*)(F.ws + WS_WPOOL);
    bf16* WguT = (bf16*)(F.ws + WS_WGU); bf16* WdT = (bf16*)(F.ws + WS_WD);
    float* Wr = (float*)(F.ws + WS_WR); float* bguP = (float*)(F.ws + WS_BGU);
    bf16* xb = (bf16*)(F.ws + WS_XB); float* rs1 = (float*)(F.ws + WS_RS1); float* betaA = (float*)(F.ws + WS_BETA); float* gA = (float*)(F.ws + WS_G);
    LAS float* scr = (LAS float*)(F.lds + F.wave * 8704);
    LAS float* W8T = (LAS float*)(F.lds + 69632);
    const int gw = F.vcu * NWAVES + F.wave, NGW = F.G * NWAVES;
    const int gt = F.vcu * 512 + F.tid, NGT = F.G * 512;
    for (int idx = F.tid; idx < 8192; idx += 512) { const int k = idx >> 3, c = idx & 7; W8T[c * 1024 + k] = anw[k] * w_in[(size_t)k * DIN + 2048 + c]; }
    __syncthreads();
    constexpr int I_IN1 = 16 * 64, I_IN2 = 16 * 16, I_OUT = 16 * 32, I_POOL = 4 * 2 * 4, I_GU = 32 * 16 * 16 * 4, I_D = 32 * 16 * 32;
    constexpr int NITEMS = I_IN1 + I_IN2 + I_OUT + I_POOL + I_GU + I_D;
    for (int it = gw; it < NITEMS; it += NGW) {
        int r = it;
        if (r < I_IN1) { const int kb = r / 64, nb = r % 64; tr_item(w_in, DIN, kb * 64, nb * 32, WinT, (size_t)nb * 32, DM, 0, anw, nullptr, scr, F.lane); continue; } r -= I_IN1;
        if (r < I_IN2) { const int kb = r / 16, nb = r % 16; tr_item(w_in, DIN, kb * 64, 2056 + nb * 32, WinT, (size_t)2048 + nb * 32, DM, 0, anw, nullptr, scr, F.lane); continue; } r -= I_IN2;
        if (r < I_OUT) { const int kb = r / 32, nb = r % 32; tr_item(w_out, DM, kb * 64, nb * 32, WoutT, (size_t)nb * 32, DM, 0, nullptr, nullptr, scr, F.lane); continue; } r -= I_OUT;
        if (r < I_POOL) { const int g = r / 8, kb = (r % 8) / 4, nb = r % 4; tr_item(pool_w + (size_t)g * 128 * 128, 128, kb * 64, nb * 32, WpoolT, (size_t)g * 128 + nb * 32, 512, g * 128, nullptr, pool_scale + g * 128, scr, F.lane); continue; } r -= I_POOL;
        if (r < I_GU) { const int e = r / 1024, r2 = r % 1024, seg = r2 / 64, kb = (r2 % 64) / 4, nb = r2 % 4; const int t = seg >> 1, half = seg & 1;
            tr_item(w_gu + (size_t)e * DM * 2048, 2048, kb * 64, half * 1024 + t * 128 + nb * 32, WguT, (size_t)e * 2048 + t * 256 + half * 128 + nb * 32, DM, 0, fnw, nullptr, scr, F.lane); continue; } r -= I_GU;
        { const int e = r / 512, r2 = r % 512, kb = r2 / 32, nb = r2 % 32; tr_item(w_d + (size_t)e * DE * DM, DM, kb * 64, nb * 32, WdT, (size_t)e * 1024 + nb * 32, DE, 0, nullptr, nullptr, scr, F.lane); }
    }
    for (int idx = gt; idx < NE * 2048; idx += NGT) { const int e = idx >> 11, r = idx & 2047, t = r >> 8, j = r & 255, half = j >> 7, jj = j & 127; bguP[idx] = b_gu[(size_t)e * 2048 + half * 1024 + t * 128 + jj]; }
    for (int idx = gt; idx < NE * DM; idx += NGT) { const int e = idx >> 10, k = idx & 1023; Wr[idx] = fnw[k] * w_router[(size_t)k * NE + e]; }
    for (int idx = gt; idx < 512 * 64; idx += NGT) { const int n = idx >> 6, ch = idx & 63; if ((n >> 7) != (ch >> 4)) *(v4u*)(WpoolT + (size_t)n * 512 + ch * 8) = (v4u){0u, 0u, 0u, 0u}; }
    for (int m = gw; m < NTOK; m += NGW) {
        const f32x4* xr = (const f32x4*)(x + (size_t)m * DM) + F.lane;
        f32x4 v[4]; float ss = 0.f; float d8[8];
#pragma unroll
        for (int c = 0; c < 8; ++c) d8[c] = 0.f;
#pragma unroll
        for (int j = 0; j < 4; ++j) { v[j] = xr[64 * j]; ss += (v[j].x * v[j].x + v[j].y * v[j].y) + (v[j].z * v[j].z + v[j].w * v[j].w); }
#pragma unroll
        for (int c = 0; c < 8; ++c)
#pragma unroll
            for (int j = 0; j < 4; ++j) { const f32x4 w = *(const LAS f32x4*)(W8T + c * 1024 + 256 * j + 4 * F.lane); d8[c] += (v[j].x * w.x + v[j].y * w.y) + (v[j].z * w.z + v[j].w * w.w); }
        ss = wave_sum(ss);
#pragma unroll
        for (int c = 0; c < 8; ++c) d8[c] = wave_sum(d8[c]);
        const float rs = 1.f / sqrtf(ss * (1.f / DM) + 1e-6f);
        unsigned long long* o8 = (unsigned long long*)(xb + (size_t)m * DM) + F.lane;
#pragma unroll
        for (int j = 0; j < 4; ++j) o8[64 * j] = (unsigned long long)pk2(v[j].x, v[j].y) | ((unsigned long long)pk2(v[j].z, v[j].w) << 32);
        if (F.lane == 0) rs1[m] = rs;
        if (F.lane < 4) {
            float bl = 0.f, al = 0.f;
#pragma unroll
            for (int c = 0; c < 4; ++c) { bl = (F.lane == c) ? d8[c] : bl; al = (F.lane == c) ? d8[4 + c] : al; }
            bl *= rs; al *= rs;
            betaA[(size_t)m * 4 + F.lane] = 1.f / (1.f + expf(-bl));
            const float z = al + dt_bias[F.lane]; const float sp = z > 20.f ? z : log1pf(expf(z));
            gA[(size_t)m * 4 + F.lane] = -expf(a_log[F.lane]) * sp;
        }
    }
}

__device__ __forceinline__ void phase_mix(Frame& F) {
    const bf16* proj = (const bf16*)(F.ws + WS_PROJ); bf16* mixed = (bf16*)(F.ws + WS_MIXED);
    const int gw = F.vcu * NWAVES + F.wave, NGW = F.G * NWAVES;
    for (int m = gw; m < NTOK; m += NGW) {
        const int t = m % SEQ;
        const int ch = 8 * F.lane, gi = F.lane >> 4, win = 2 << gi; const int cnt = (t + 1) < win ? (t + 1) : win;
        float s[8];
#pragma unroll
        for (int q = 0; q < 8; ++q) s[q] = 0.f;
        v4u p0 = (v4u){0u, 0u, 0u, 0u};
        for (int j = 0; j < cnt; ++j) { const v4u u = *(const v4u*)(proj + (size_t)(m - j) * NPROJ + 2048 + ch); if (j == 0) p0 = u;
            s[0] += bflo(u.x); s[1] += bfhi(u.x); s[2] += bflo(u.y); s[3] += bfhi(u.y); s[4] += bflo(u.z); s[5] += bfhi(u.z); s[6] += bflo(u.w); s[7] += bfhi(u.w); }
        const float ic = 1.f / (float)cnt;
        v4u o; o.x = pk2(s[0] * ic - bflo(p0.x), s[1] * ic - bfhi(p0.x)); o.y = pk2(s[2] * ic - bflo(p0.y), s[3] * ic - bfhi(p0.y));
        o.z = pk2(s[4] * ic - bflo(p0.z), s[5] * ic - bfhi(p0.z)); o.w = pk2(s[6] * ic - bflo(p0.w), s[7] * ic - bfhi(p0.w));
        *(v4u*)(mixed + (size_t)m * 512 + ch) = o;
    }
}

typedef float f32x16 __attribute__((ext_vector_type(16)));
__device__ __forceinline__ bf16x8 pack8(const f32x4 a, const f32x4 b) {
    v4u w; w.x = cvt_pk_bf16(a[0], a[1]); w.y = cvt_pk_bf16(a[2], a[3]); w.z = cvt_pk_bf16(b[0], b[1]); w.w = cvt_pk_bf16(b[2], b[3]);
    return __builtin_bit_cast(bf16x8, w);
}
__device__ __forceinline__ void fmac_(float& acc, float a, float b) { asm("v_fmac_f32 %0, %1, %2" : "+v"(acc) : "v"(a), "v"(b)); }
__device__ __forceinline__ float bf2f(unsigned short u) { return __builtin_bit_cast(float, (unsigned)u << 16); }

constexpr int CP_QN = 0, CP_KN = 17408, CP_VA = 34816, CP_QKL = 51200, CP_SC = 59392, CP_HALF = 61440;
__device__ __forceinline__ void phase_chunk(Frame& F) {
    const float* conv_w = F.in[3];
    const bf16* proj = (const bf16*)(F.ws + WS_PROJ);
    const float* betaA = (const float*)(F.ws + WS_BETA); const float* gA = (const float*)(F.ws + WS_G);
    float* gtotA = (float*)(F.ws + WS_GTOT);
    const int half = F.wave >> 2, hw = F.wave & 3, ht = F.tid & 255, lane = F.lane;
    LAS unsigned char* L = F.lds + half * CP_HALF;
    LAS bf16* qn = (LAS bf16*)(L + CP_QN); LAS bf16* kn = (LAS bf16*)(L + CP_KN); LAS bf16* vn = (LAS bf16*)(L + CP_VA);
    LAS float* Am = (LAS float*)(L + CP_VA); LAS bf16* qkL = (LAS bf16*)(L + CP_QKL); LAS float* sc = (LAS float*)(L + CP_SC);
    const int r16 = lane & 15, gq = lane >> 4;
#pragma unroll 1
    for (int it = 0; it < 4; ++it) {
        const int unit = (it * (int)gridDim.x + (int)blockIdx.x) * 2 + half;
        const bool live = unit < NB * NH * 64;
        const int bh = unit >> 6, n = unit & 63, b = bh >> 2, h = bh & 3;
        const size_t m0 = (size_t)b * SEQ + (size_t)n * 64;
        unsigned char* chunk = F.ws + WS_CHUNK + (size_t)unit * CH_BYTES;
        if (live && hw == 0) {
            const float gi = gA[(m0 + lane) * 4 + h], bi = betaA[(m0 + lane) * 4 + h];
            float c = gi;
#pragma unroll
            for (int o = 1; o < 64; o <<= 1) { const float tt = __shfl_up(c, o); if (lane >= o) c += tt; }
            const float gl = __shfl(c, 63);
            sc[lane] = bi; sc[64 + lane] = c; sc[128 + lane] = __expf(c); sc[192 + lane] = __expf(gl - c);
            if (lane == 63) gtotA[unit] = __expf(c);
        }
        if (live) {
            const int rq = ht >> 4, cg = ht & 15;
#pragma unroll 1
            for (int p = 0; p < 3; ++p) {
                const int col = p * 512 + h * 128 + 8 * cg;
                float xin[7][8];
#pragma unroll
                for (int jj = 0; jj < 7; ++jj) { const int trow = n * 64 + 4 * rq - 3 + jj; v4u u = (v4u){0u, 0u, 0u, 0u};
                    if (trow >= 0) u = *(const v4u*)(proj + ((size_t)b * SEQ + trow) * NPROJ + col);
                    xin[jj][0] = bflo(u.x); xin[jj][1] = bfhi(u.x); xin[jj][2] = bflo(u.y); xin[jj][3] = bfhi(u.y); xin[jj][4] = bflo(u.z); xin[jj][5] = bfhi(u.z); xin[jj][6] = bflo(u.w); xin[jj][7] = bfhi(u.w); }
                float wv[4][8];
#pragma unroll
                for (int j = 0; j < 4; ++j) { const f32x4 w0 = *(const f32x4*)(conv_w + j * 1536 + col), w1 = *(const f32x4*)(conv_w + j * 1536 + col + 4);
                    wv[j][0] = w0.x; wv[j][1] = w0.y; wv[j][2] = w0.z; wv[j][3] = w0.w; wv[j][4] = w1.x; wv[j][5] = w1.y; wv[j][6] = w1.z; wv[j][7] = w1.w; }
#pragma unroll
                for (int rr = 0; rr < 4; ++rr) {
                    float y[8]; float ss = 0.f;
#pragma unroll
                    for (int q = 0; q < 8; ++q) { float a = 0.f;
#pragma unroll
                        for (int j = 0; j < 4; ++j) a += wv[j][q] * xin[rr + j][q];
                        y[q] = siluf_(a); ss += y[q] * y[q]; }
                    float scl = 1.f;
                    if (p < 2) { ss += __shfl_xor(ss, 1); ss += __shfl_xor(ss, 2); ss += __shfl_xor(ss, 4); ss += __shfl_xor(ss, 8); scl = 1.f / sqrtf(ss + 1e-6f); if (p == 0) scl *= 0.08838834764831845f; }
                    v4u o; o.x = pk2(y[0] * scl, y[1] * scl); o.y = pk2(y[2] * scl, y[3] * scl); o.z = pk2(y[4] * scl, y[5] * scl); o.w = pk2(y[6] * scl, y[7] * scl);
                    const int row = 4 * rq + rr;
                    if (p == 0) *(LAS v4u*)(qn + row * 136 + 8 * cg) = o; else if (p == 1) *(LAS v4u*)(kn + row * 136 + 8 * cg) = o; else *(LAS v4u*)(vn + row * 128 + 8 * cg) = o;
                }
            }
        }
        __syncthreads();
        const int which = ht >> 7, c = ht & 127;
        float U[64];
        if (live) {
#pragma unroll
            for (int i = 0; i < 64; ++i) { const float bi = sc[i]; const float tv = which ? bf2f(kn[i * 136 + c]) * sc[128 + i] : bf2f(vn[i * 128 + c]); U[i] = tv * bi; }
        } else {
#pragma unroll
            for (int i = 0; i < 64; ++i) U[i] = 0.f;
        }
        __syncthreads();
        if (live) {
            const int ti = hw >> 1, tj = hw & 1, r = lane & 31, hh = lane >> 5;
            f32x16 KK, QK;
#pragma unroll
            for (int q = 0; q < 16; ++q) { KK[q] = 0.f; QK[q] = 0.f; }
#pragma unroll
            for (int ks = 0; ks < 8; ++ks) {
                const bf16x8 ak = *(const LAS bf16x8*)(kn + (ti * 32 + r) * 136 + 16 * ks + 8 * hh);
                const bf16x8 aq = *(const LAS bf16x8*)(qn + (ti * 32 + r) * 136 + 16 * ks + 8 * hh);
                const bf16x8 bb = *(const LAS bf16x8*)(kn + (tj * 32 + r) * 136 + 16 * ks + 8 * hh);
                KK = __builtin_amdgcn_mfma_f32_32x32x16_bf16(ak, bb, KK, 0, 0, 0);
                QK = __builtin_amdgcn_mfma_f32_32x32x16_bf16(aq, bb, QK, 0, 0, 0);
            }
            const int j = tj * 32 + r; const float gcj = sc[64 + j];
#pragma unroll
            for (int reg = 0; reg < 16; ++reg) { const int i = ti * 32 + (reg & 3) + 8 * (reg >> 2) + 4 * hh;
                const float dec = (i >= j) ? __expf(sc[64 + i] - gcj) : 0.f;
                Am[i * 64 + j] = (i > j) ? sc[i] * KK[reg] * dec : 0.f;
                qkL[i * 64 + j] = (bf16)f2bf((i >= j) ? QK[reg] * dec : 0.f); }
        }
        __syncthreads();
        if (live) {
#pragma unroll
            for (int fi = 0; fi < 4; ++fi) { const int f = hw * 4 + fi, mb = f >> 2, ks = f & 3, row = 16 * mb + r16; const float s = sc[128 + row];
                const v2u lo = *(const LAS v2u*)(qn + row * 136 + 32 * ks + 4 * gq), hi = *(const LAS v2u*)(qn + row * 136 + 32 * ks + 16 + 4 * gq);
                v4u o; o.x = pk2(bflo(lo.x) * s, bfhi(lo.x) * s); o.y = pk2(bflo(lo.y) * s, bfhi(lo.y) * s); o.z = pk2(bflo(hi.x) * s, bfhi(hi.x) * s); o.w = pk2(bflo(hi.y) * s, bfhi(hi.y) * s);
                *(v4u*)(chunk + CH_QD + (f * 64 + lane) * 16) = o; }
#pragma unroll
            for (int fi = 0; fi < 4; ++fi) { const int f = hw * 4 + fi, db = f >> 1, ksp = f & 1, dcol = 16 * db + r16; float e[8];
#pragma unroll
                for (int j = 0; j < 8; ++j) { const int i = 32 * ksp + 16 * (j >> 2) + 4 * gq + (j & 3); e[j] = bf2f(kn[i * 136 + dcol]) * sc[192 + i]; }
                v4u o; o.x = pk2(e[0], e[1]); o.y = pk2(e[2], e[3]); o.z = pk2(e[4], e[5]); o.w = pk2(e[6], e[7]);
                *(v4u*)(chunk + CH_KT + (f * 64 + lane) * 16) = o; }
#pragma unroll
            for (int fi = 0; fi < 2; ++fi) { const int f = hw * 2 + fi, mb = f >> 1, ksp = f & 1, row = 16 * mb + r16;
                const v2u lo = *(const LAS v2u*)(qkL + row * 64 + 32 * ksp + 4 * gq), hi = *(const LAS v2u*)(qkL + row * 64 + 32 * ksp + 16 + 4 * gq);
                *(v4u*)(chunk + CH_QK + (f * 64 + lane) * 16) = (v4u){lo.x, lo.y, hi.x, hi.y}; }
#pragma unroll
            for (int i = 1; i < 64; ++i) {
                float s0 = 0.f, s1 = 0.f, s2 = 0.f, s3 = 0.f;
#pragma unroll
                for (int j4 = 0; j4 < (i + 3) / 4; ++j4) { const f32x4 a = *(const LAS f32x4*)(Am + i * 64 + 4 * j4);
                    fmac_(s0, a.x, U[4 * j4]); if (4 * j4 + 1 < i) fmac_(s1, a.y, U[4 * j4 + 1]); if (4 * j4 + 2 < i) fmac_(s2, a.z, U[4 * j4 + 2]); if (4 * j4 + 3 < i) fmac_(s3, a.w, U[4 * j4 + 3]); }
                U[i] -= (s0 + s1) + (s2 + s3);
                __builtin_amdgcn_sched_barrier(0);
            }
        }
        __syncthreads();
        if (live) {
            if (which == 0) {
                const int w8 = c >> 4, cl = c & 15;
                unsigned char* ub = F.ws + WS_UC + (size_t)unit * UC_BYTES;
#pragma unroll
                for (int g = 0; g < 4; ++g) {
                    v4u lo, hi;
                    lo.x = pk2(U[4 * g], U[4 * g + 1]); lo.y = pk2(U[4 * g + 2], U[4 * g + 3]); lo.z = pk2(U[16 + 4 * g], U[16 + 4 * g + 1]); lo.w = pk2(U[16 + 4 * g + 2], U[16 + 4 * g + 3]);
                    hi.x = pk2(U[32 + 4 * g], U[32 + 4 * g + 1]); hi.y = pk2(U[32 + 4 * g + 2], U[32 + 4 * g + 3]); hi.z = pk2(U[48 + 4 * g], U[48 + 4 * g + 1]); hi.w = pk2(U[48 + 4 * g + 2], U[48 + 4 * g + 3]);
                    v4u* dst = (v4u*)(ub + ((w8 * 64 + g * 16 + cl) * 32)); dst[0] = lo; dst[1] = hi;
                }
            } else {
#pragma unroll
                for (int i = 0; i < 64; ++i) qn[i * 136 + c] = (bf16)f2bf(U[i]);
            }
        }
        __syncthreads();
        if (live) {
#pragma unroll
            for (int fi = 0; fi < 4; ++fi) { const int f = hw * 4 + fi, mb = f >> 2, ks = f & 3, row = 16 * mb + r16;
                const v2u lo = *(const LAS v2u*)(qn + row * 136 + 32 * ks + 4 * gq), hi = *(const LAS v2u*)(qn + row * 136 + 32 * ks + 16 + 4 * gq);
                *(v4u*)(chunk + CH_WF + (f * 64 + lane) * 16) = (v4u){lo.x, lo.y, hi.x, hi.y}; }
        }
        __syncthreads();
    }
}

constexpr int SC_OST = 2 * CH_BYTES;
__device__ __forceinline__ void phase_scan(Frame& F) {
    const int bh = blockIdx.x, b = bh >> 2, h = bh & 3, w = F.wave, lane = F.lane, cl = lane & 15, gq = lane >> 4;
    const float* dnw = F.in[6]; const bf16* proj = (const bf16*)(F.ws + WS_PROJ); bf16* concat = (bf16*)(F.ws + WS_CONCAT);
    const float* gtotA = (const float*)(F.ws + WS_GTOT);
    const int unit0 = bh * 64;
    const unsigned char* cbase = F.ws + WS_CHUNK + (size_t)unit0 * CH_BYTES;
    const unsigned char* ubase = F.ws + WS_UC + (size_t)unit0 * UC_BYTES + (w * 64 + lane) * 32;
    LAS bf16* Ost = (LAS bf16*)(F.lds + SC_OST);
    f32x4 Sacc[8]; bf16x8 Sb[4];
#pragma unroll
    for (int d = 0; d < 8; ++d) Sacc[d] = (f32x4){0.f, 0.f, 0.f, 0.f};
#pragma unroll
    for (int k = 0; k < 4; ++k) Sb[k] = (bf16x8){0, 0, 0, 0, 0, 0, 0, 0};
#define SCAN_ISSUE(nn) do { const unsigned char* s_ = cbase + (size_t)(nn) * CH_BYTES + (w * 7) * 1024 + lane * 16; LAS unsigned char* d_ = F.lds + ((nn) & 1) * CH_BYTES + (w * 7) * 1024; \
        _Pragma("unroll") for (int k_ = 0; k_ < 7; ++k_) __builtin_amdgcn_global_load_lds((const unsigned*)(s_ + k_ * 1024), (LAS unsigned*)(d_ + k_ * 1024), 16, 0, 0); } while (0)
    SCAN_ISSUE(0);
    v4u nu0 = *(const v4u*)(ubase), nu1 = *(const v4u*)(ubase + 16);
    const int prow = F.tid >> 3, pseg = F.tid & 7;
    f32x4 dw[4];
#pragma unroll
    for (int q = 0; q < 4; ++q) dw[q] = *(const f32x4*)(dnw + 16 * pseg + 4 * q);
#pragma unroll 1
    for (int n = 0; n < 64; ++n) {
        VM_WAIT(); __syncthreads();
        const v4u cu0 = nu0, cu1 = nu1; const float gt = gtotA[unit0 + n];
        if (n + 1 < 64) { SCAN_ISSUE(n + 1); nu0 = *(const v4u*)(ubase + (size_t)(n + 1) * UC_BYTES); nu1 = *(const v4u*)(ubase + (size_t)(n + 1) * UC_BYTES + 16); }
        const LAS unsigned char* B = F.lds + (n & 1) * CH_BYTES;
#define FRAG(off, f) (*(const LAS bf16x8*)(B + (off) + ((f) * 64 + lane) * 16))
        f32x4 P[4];
#pragma unroll
        for (int mb = 0; mb < 4; ++mb) { P[mb] = (f32x4){0.f, 0.f, 0.f, 0.f};
#pragma unroll
            for (int ks = 0; ks < 4; ++ks) P[mb] = __builtin_amdgcn_mfma_f32_16x16x32_bf16(FRAG(CH_WF, mb * 4 + ks), Sb[ks], P[mb], 0, 0, 0); }
        f32x4 vnw[4];
        vnw[0] = (f32x4){bflo(cu0.x), bfhi(cu0.x), bflo(cu0.y), bfhi(cu0.y)} - P[0];
        vnw[1] = (f32x4){bflo(cu0.z), bfhi(cu0.z), bflo(cu0.w), bfhi(cu0.w)} - P[1];
        vnw[2] = (f32x4){bflo(cu1.x), bfhi(cu1.x), bflo(cu1.y), bfhi(cu1.y)} - P[2];
        vnw[3] = (f32x4){bflo(cu1.z), bfhi(cu1.z), bflo(cu1.w), bfhi(cu1.w)} - P[3];
        bf16x8 Vb[2]; Vb[0] = pack8(vnw[0], vnw[1]); Vb[1] = pack8(vnw[2], vnw[3]);
        f32x4 O[4];
#pragma unroll
        for (int mb = 0; mb < 4; ++mb) { O[mb] = (f32x4){0.f, 0.f, 0.f, 0.f};
#pragma unroll
            for (int ks = 0; ks < 4; ++ks) O[mb] = __builtin_amdgcn_mfma_f32_16x16x32_bf16(FRAG(CH_QD, mb * 4 + ks), Sb[ks], O[mb], 0, 0, 0);
#pragma unroll
            for (int ksp = 0; ksp < 2; ++ksp) O[mb] = __builtin_amdgcn_mfma_f32_16x16x32_bf16(FRAG(CH_QK, mb * 2 + ksp), Vb[ksp], O[mb], 0, 0, 0); }
#pragma unroll
        for (int db = 0; db < 8; ++db) { Sacc[db] = Sacc[db] * gt;
#pragma unroll
            for (int ksp = 0; ksp < 2; ++ksp) Sacc[db] = __builtin_amdgcn_mfma_f32_16x16x32_bf16(FRAG(CH_KT, db * 2 + ksp), Vb[ksp], Sacc[db], 0, 0, 0); }
#pragma unroll
        for (int ks = 0; ks < 4; ++ks) Sb[ks] = pack8(Sacc[2 * ks], Sacc[2 * ks + 1]);
#pragma unroll
        for (int mb = 0; mb < 4; ++mb)
#pragma unroll
            for (int rp = 0; rp < 4; ++rp) Ost[(16 * mb + 4 * gq + rp) * 136 + 16 * w + cl] = (bf16)f2bf(O[mb][rp]);
#undef FRAG
        __syncthreads();
        { const size_t m = (size_t)b * SEQ + (size_t)n * 64 + prow;
          const v4u o0 = *(const LAS v4u*)(Ost + prow * 136 + 16 * pseg), o1 = *(const LAS v4u*)(Ost + prow * 136 + 16 * pseg + 8);
          const v4u z0 = *(const v4u*)(proj + m * NPROJ + 1536 + h * 128 + 16 * pseg), z1 = *(const v4u*)(proj + m * NPROJ + 1536 + h * 128 + 16 * pseg + 8);
          float ov[16], zv[16];
          ov[0] = bflo(o0.x); ov[1] = bfhi(o0.x); ov[2] = bflo(o0.y); ov[3] = bfhi(o0.y); ov[4] = bflo(o0.z); ov[5] = bfhi(o0.z); ov[6] = bflo(o0.w); ov[7] = bfhi(o0.w);
          ov[8] = bflo(o1.x); ov[9] = bfhi(o1.x); ov[10] = bflo(o1.y); ov[11] = bfhi(o1.y); ov[12] = bflo(o1.z); ov[13] = bfhi(o1.z); ov[14] = bflo(o1.w); ov[15] = bfhi(o1.w);
          zv[0] = bflo(z0.x); zv[1] = bfhi(z0.x); zv[2] = bflo(z0.y); zv[3] = bfhi(z0.y); zv[4] = bflo(z0.z); zv[5] = bfhi(z0.z); zv[6] = bflo(z0.w); zv[7] = bfhi(z0.w);
          zv[8] = bflo(z1.x); zv[9] = bfhi(z1.x); zv[10] = bflo(z1.y); zv[11] = bfhi(z1.y); zv[12] = bflo(z1.z); zv[13] = bfhi(z1.z); zv[14] = bflo(z1.w); zv[15] = bfhi(z1.w);
          float ss = 0.f;
#pragma unroll
          for (int q = 0; q < 16; ++q) ss += ov[q] * ov[q];
          ss += __shfl_xor(ss, 1); ss += __shfl_xor(ss, 2); ss += __shfl_xor(ss, 4);
          const float rs = 1.f / sqrtf(ss * (1.f / 128.f) + 1e-6f);
          float rr[16];
#pragma unroll
          for (int q = 0; q < 16; ++q) rr[q] = ov[q] * rs * dw[q >> 2][q & 3] * siluf_(zv[q]);
          v4u w0, w1; w0.x = pk2(rr[0], rr[1]); w0.y = pk2(rr[2], rr[3]); w0.z = pk2(rr[4], rr[5]); w0.w = pk2(rr[6], rr[7]);
          w1.x = pk2(rr[8], rr[9]); w1.y = pk2(rr[10], rr[11]); w1.z = pk2(rr[12], rr[13]); w1.w = pk2(rr[14], rr[15]);
          v4u* dst = (v4u*)(concat + m * DM + h * 128 + 16 * pseg); dst[0] = w0; dst[1] = w1; }
    }
#undef SCAN_ISSUE
    VM_WAIT(); __syncthreads();
}

__device__ __forceinline__ void phase_route(Frame& F) {
    const float* x1 = F.out; const float* Wr = (const float*)(F.ws + WS_WR); const float* b_router = F.in[12];
    bf16* x1b = (bf16*)(F.ws + WS_X1B); float* rs2A = (float*)(F.ws + WS_RS2); float* gatew = (float*)(F.ws + WS_GATEW); int* list = (int*)(F.ws + WS_LIST);
    unsigned* cntw = (unsigned*)(F.ws + WS_CTL) + CW_CNT;
    LAS float* WrL = (LAS float*)F.lds;
    for (int idx = F.tid; idx < NE * DM / 4; idx += 512) *(LAS f32x4*)(WrL + 4 * idx) = *(const f32x4*)(Wr + 4 * idx);
    __syncthreads();
    const int gw = F.vcu * NWAVES + F.wave, NGW = F.G * NWAVES;
    for (int m = gw; m < NTOK; m += NGW) {
        const f32x4* xr = (const f32x4*)(x1 + (size_t)m * DM) + F.lane;
        f32x4 v[4]; float ss = 0.f;
#pragma unroll
        for (int j = 0; j < 4; ++j) { v[j] = xr[64 * j]; ss += (v[j].x * v[j].x + v[j].y * v[j].y) + (v[j].z * v[j].z + v[j].w * v[j].w); }
        ss = wave_sum(ss);
        const float rs = 1.f / sqrtf(ss * (1.f / DM) + 1e-6f);
        unsigned long long* o8 = (unsigned long long*)(x1b + (size_t)m * DM) + F.lane;
#pragma unroll
        for (int j = 0; j < 4; ++j) o8[64 * j] = (unsigned long long)pk2(v[j].x, v[j].y) | ((unsigned long long)pk2(v[j].z, v[j].w) << 32);
        float mylg = -3.0e38f;
#pragma unroll 1
        for (int e = 0; e < NE; ++e) { float a = 0.f;
#pragma unroll
            for (int j = 0; j < 4; ++j) { const f32x4 w = *(const LAS f32x4*)(WrL + e * 1024 + 256 * j + 4 * F.lane); a += (v[j].x * w.x + v[j].y * w.y) + (v[j].z * w.z + v[j].w * w.w); }
            const float tot = wave_sum(a) * rs + b_router[e]; if (F.lane == e) mylg = tot; }
        int te[4]; float tv[4];
#pragma unroll
        for (int s = 0; s < 4; ++s) { float bv = mylg; int bi = F.lane;
#pragma unroll
            for (int o = 1; o < 64; o <<= 1) { const float ov = __shfl_xor(bv, o); const int oi = __shfl_xor(bi, o); if (ov > bv || (ov == bv && oi < bi)) { bv = ov; bi = oi; } }
            te[s] = bi; tv[s] = bv; if (F.lane == bi) mylg = -3.0e38f; }
        const float e1 = __expf(tv[1] - tv[0]), e2 = __expf(tv[2] - tv[0]), e3 = __expf(tv[3] - tv[0]); const float inv = 1.f / (1.f + e1 + e2 + e3);
        if (F.lane == 0) rs2A[m] = rs;
        if (F.lane < 4) {
            const int s = F.lane; const int ee = s == 0 ? te[0] : s == 1 ? te[1] : s == 2 ? te[2] : te[3]; const float gg = (s == 0 ? 1.f : s == 1 ? e1 : s == 2 ? e2 : e3) * inv;
            const unsigned pos = __hip_atomic_fetch_add(cntw + 64 * ee, 1u, RLX_AGENT);
            list[(size_t)ee * LISTCAP + pos] = m * 4 + s; gatew[(size_t)m * 4 + s] = gg;
        }
    }
}

__device__ __forceinline__ int moe_tables(Frame& F, MoeTab& T) {
    LAS int* pref = (LAS int*)(F.lds + TAB_OFF); LAS int* cnt = pref + 40;
    unsigned* cntw = (unsigned*)(F.ws + WS_CTL) + CW_CNT;
    if (F.tid == 0) { int acc = 0; for (int e = 0; e < NE; ++e) { const int c = (int)__hip_atomic_load(cntw + 64 * e, RLX_AGENT); cnt[e] = c; pref[e] = acc; acc += (c + 255) >> 8; } pref[NE] = acc; }
    __syncthreads();
    T.pref = pref; T.cnt = cnt;
    return pref[NE];
}

__device__ __forceinline__ void phase_final(Frame& F) {
    const float* fw = F.in[17]; const bf16* slab = (const bf16*)(F.ws + WS_SLAB); float* out = F.out;
    const int gw = F.vcu * NWAVES + F.wave, NGW = F.G * NWAVES;
    for (int m = gw; m < NTOK; m += NGW) {
        f32x4* xr = (f32x4*)(out + (size_t)m * DM) + F.lane;
        f32x4 v[4]; float ss = 0.f;
#pragma unroll
        for (int j = 0; j < 4; ++j) v[j] = xr[64 * j];
#pragma unroll
        for (int s = 0; s < 4; ++s) { const v2u* sp = (const v2u*)(slab + ((size_t)m * 4 + s) * DM) + F.lane;
#pragma unroll
            for (int j = 0; j < 4; ++j) { const v2u u = sp[64 * j]; v[j].x += bflo(u.x); v[j].y += bfhi(u.x); v[j].z += bflo(u.y); v[j].w += bfhi(u.y); } }
#pragma unroll
        for (int j = 0; j < 4; ++j) ss += (v[j].x * v[j].x + v[j].y * v[j].y) + (v[j].z * v[j].z + v[j].w * v[j].w);
        ss = wave_sum(ss);
        const float rs = 1.f / sqrtf(ss * (1.f / DM) + 1e-6f);
#pragma unroll
        for (int j = 0; j < 4; ++j) { const f32x4 w = *((const f32x4*)fw + 64 * j + F.lane); xr[64 * j] = v[j] * rs * w; }
    }
}

struct Args { const float* in[18]; float* out; unsigned char* ws; int ph_lo, ph_hi; };
constexpr int NPHASE = 9;

__global__ void __launch_bounds__(NWAVES * 64, 2) mk_fwd(Args args) {
    extern __shared__ __attribute__((aligned(16))) unsigned char lds_raw[];
    Frame F;
    F.lds = (LAS unsigned char*)lds_raw;
    F.tid = threadIdx.x; F.lane = F.tid & 63; F.wave = __builtin_amdgcn_readfirstlane(F.tid >> 6);
    F.G = gridDim.x; { const int bx = blockIdx.x; F.vcu = (F.G % 8 == 0) ? (bx % 8) * (F.G / 8) + bx / 8 : bx; }
#pragma unroll
    for (int i = 0; i < 18; ++i) F.in[i] = args.in[i];
    F.out = args.out; F.ws = args.ws;
    volatile LAS unsigned* MISC = (volatile LAS unsigned*)(F.lds + MISC_OFF);
    for (int u = F.tid; u < (LDS_BYTES - LDSCTL_OFF) / 4; u += NWAVES * 64) ((LAS unsigned*)(F.lds + LDSCTL_OFF))[u] = 0u;
    __syncthreads();
    unsigned* ctl = (unsigned*)(F.ws + WS_CTL);
#if !MK_PER_PHASE
    XcdBarrier bar = xcd_barrier_post(ctl + CW_BAR, MISC + 8);
#define GRID_BAR() xcd_barrier(bar)
#else
#define GRID_BAR() do {} while (0)
#endif
    const int lo = args.ph_lo, hi = args.ph_hi;
#define IN(k) (lo <= (k) && (k) < hi)
#define SEAM(k) do { if (IN(k) && IN((k) + 1)) GRID_BAR(); } while (0)

    if (IN(0)) { phase_prep(F); } SEAM(0);
    if (IN(1)) {
        ProbIn P; P.K = DM; P.S.init(NTOK / 256, NPROJ / 256, F.G, (int)blockIdx.x);
        P.A = (const bf16*)(F.ws + WS_XB); P.Bt = (const bf16*)(F.ws + WS_WIN); P.O = (bf16*)(F.ws + WS_PROJ); P.rs = (const float*)(F.ws + WS_RS1);
        pg8::gemm_phase(F.lds, P);
    } SEAM(1);
    if (IN(2)) { phase_mix(F); __syncthreads(); phase_chunk(F); } SEAM(2);
    if (IN(3)) {
        const int nscan = NB * NH;
        if (F.G >= 2 * nscan) {
            if ((int)blockIdx.x < nscan) phase_scan(F);
            else { ProbPool P; P.K = 512; P.S.init(NTOK / 256, 2, F.G - nscan, (int)blockIdx.x - nscan);
                   P.A = (const bf16*)(F.ws + WS_MIXED); P.Bt = (const bf16*)(F.ws + WS_WPOOL); P.O = (bf16*)(F.ws + WS_CONCAT);
                   pg8::gemm_phase(F.lds, P); }
        } else {
            { ProbPool P; P.K = 512; P.S.init(NTOK / 256, 2, F.G, (int)blockIdx.x);
              P.A = (const bf16*)(F.ws + WS_MIXED); P.Bt = (const bf16*)(F.ws + WS_WPOOL); P.O = (bf16*)(F.ws + WS_CONCAT);
              pg8::gemm_phase(F.lds, P); }
            __syncthreads();
            for (int bhh = blockIdx.x; bhh < nscan; bhh += F.G) {   }
        }
    } SEAM(3);
    if (IN(4)) {
        ProbOut P; P.K = DM; P.S.init(NTOK / 256, DM / 256, F.G, (int)blockIdx.x);
        P.A = (const bf16*)(F.ws + WS_CONCAT); P.Bt = (const bf16*)(F.ws + WS_WOUT); P.X = F.in[0]; P.O = F.out;
        pg8::gemm_phase(F.lds, P);
    } SEAM(4);
    if (IN(5)) { phase_route(F); } SEAM(5);
    if (IN(6)) {
        ProbGU P; const int RT = moe_tables(F, P.T);
        P.K = DM; P.S.init(RT, 8, F.G, (int)blockIdx.x);
        P.A = (const bf16*)(F.ws + WS_X1B); P.Bt = (const bf16*)(F.ws + WS_WGU); P.O = (bf16*)(F.ws + WS_ACT); P.list = (const int*)(F.ws + WS_LIST);
        P.rs2 = (const float*)(F.ws + WS_RS2); P.bgu = (const float*)(F.ws + WS_BGU);
        pg8::gemm_phase(F.lds, P);
    } SEAM(6);
    if (IN(7)) {
        ProbDown P; const int RT = moe_tables(F, P.T);
        P.K = DE; P.S.init(RT, 4, F.G, (int)blockIdx.x);
        P.A = (const bf16*)(F.ws + WS_ACT); P.Bt = (const bf16*)(F.ws + WS_WD); P.O = (bf16*)(F.ws + WS_SLAB); P.list = (const int*)(F.ws + WS_LIST);
        P.gw = (const float*)(F.ws + WS_GATEW); P.bd = F.in[16];
        pg8::gemm_phase(F.lds, P);
    } SEAM(7);
    if (IN(8)) { phase_final(F); }
#undef IN
#undef SEAM
}

extern "C" void kernel_launch(void* const* d_in, const int* in_sizes, int n_in, void* d_out, int out_size, void* d_ws, size_t ws_size, hipStream_t stream) {
    static int grid = 0;
    if (grid == 0) {
        if (n_in != 18 || in_sizes[0] != NTOK * DM || out_size != NTOK * DM || ws_size < WS_END) { fprintf(stderr, "kernel_launch: unexpected shapes (n_in %d, in0 %d, out %d, ws %zu)\n", n_in, n_in > 0 ? in_sizes[0] : -1, out_size, ws_size); grid = -1; return; }
        int dev = 0, cus = 0, per_cu = 0;
        if (hipGetDevice(&dev) != hipSuccess || hipDeviceGetAttribute(&cus, hipDeviceAttributeMultiprocessorCount, dev) != hipSuccess) { grid = -1; return; }
        if (hipFuncSetAttribute((const void*)mk_fwd, hipFuncAttributeMaxDynamicSharedMemorySize, LDS_BYTES) != hipSuccess) { fprintf(stderr, "kernel_launch: hipFuncSetAttribute failed\n"); grid = -1; return; }
        if (hipOccupancyMaxActiveBlocksPerMultiprocessor(&per_cu, (const void*)mk_fwd, NWAVES * 64, LDS_BYTES) != hipSuccess || per_cu < 1) { fprintf(stderr, "kernel_launch: occupancy query says %d\n", per_cu); per_cu = 1; }
        (void)hipGetLastError();
        grid = cus;
    }
    if (grid < 0) return;
    (void)hipMemsetAsync((char*)d_ws + WS_CTL, 0, CTL_ZERO_BYTES, stream);
    Args a{};
    for (int i = 0; i < 18; ++i) a.in[i] = (const float*)d_in[i];
    a.out = (float*)d_out; a.ws = (unsigned char*)d_ws;
#if MK_PER_PHASE
    for (int p = 0; p < NPHASE; ++p) { a.ph_lo = p; a.ph_hi = p + 1; hipLaunchKernelGGL(mk_fwd, dim3(grid), dim3(NWAVES * 64), LDS_BYTES, stream, a); }
#else
    a.ph_lo = 0; a.ph_hi = NPHASE;
    hipLaunchKernelGGL(mk_fwd, dim3(grid), dim3(NWAVES * 64), LDS_BYTES, stream, a);
#endif
}
```

```cpp
#include <hip/hip_runtime.h>
#include <cstdio>
#include <cstdint>

#ifndef REP_MASK
#define REP_MASK 0
#endif
#ifndef REP_CNT
#define REP_CNT 1
#endif
#ifndef MK_PER_PHASE
#define MK_PER_PHASE 0
#endif

constexpr int NB = 8, SEQ = 4096, DM = 1024, NTOK = NB * SEQ;
constexpr int NH = 4, HD = 128, DDN = 512, DPOOL = 512, DIN = 2568, NPROJ = 2560;
constexpr int NE = 32, TOPK = 4, DE = 1024, NASSIGN = NTOK * TOPK;
constexpr int LISTCAP = NTOK;
constexpr int ACT_ROWS = NASSIGN + NE * 256;

constexpr size_t MiB = 1u << 20;
constexpr size_t WS_CTL = 0, CTL_ZERO_BYTES = 1 * MiB;
constexpr size_t WS_WIN = 1 * MiB;
constexpr size_t WS_WOUT = 6 * MiB;
constexpr size_t WS_WPOOL = 8 * MiB;
constexpr size_t WS_WR = 8 * MiB + 512 * 1024;
constexpr size_t WS_BGU = 8 * MiB + 768 * 1024;
constexpr size_t WS_RS1 = 9 * MiB;
constexpr size_t WS_BETA = 9 * MiB + 128 * 1024;
constexpr size_t WS_G = 9 * MiB + 640 * 1024;
constexpr size_t WS_RS2 = 10 * MiB + 256 * 1024;
constexpr size_t WS_GATEW = 10 * MiB + 512 * 1024;
constexpr size_t WS_LIST = 11 * MiB;
constexpr size_t WS_WGU = 16 * MiB;
constexpr size_t WS_WD = 144 * MiB;
constexpr size_t WS_XB = 208 * MiB;
constexpr size_t WS_PROJ = 272 * MiB;
constexpr size_t WS_CHUNK = 432 * MiB;
constexpr size_t WS_UC = 544 * MiB;
constexpr size_t WS_GTOT = 576 * MiB;
constexpr size_t WS_ORAW = 577 * MiB;
constexpr int CH_WF = 0, CH_QD = 16384, CH_KT = 32768, CH_QK = 49152, CH_BYTES = 57344, UC_BYTES = 16384;
constexpr size_t WS_MIXED = 688 * MiB;
constexpr size_t WS_CONCAT = 720 * MiB;
constexpr size_t WS_X1B = 208 * MiB;
constexpr size_t WS_ACT = 272 * MiB;
constexpr size_t WS_SLAB = 544 * MiB;
constexpr size_t WS_END = 800 * MiB;
static_assert(WS_ACT + (size_t)ACT_ROWS * 2048 <= WS_SLAB, "act fits");
static_assert(WS_SLAB + (size_t)NASSIGN * 2048 <= WS_END, "slab fits");

constexpr int CW_BAR = 4096;
constexpr int CW_CNT = 16384;

constexpr int LDS_BYTES = 147456;
constexpr int LDSCTL_OFF = LDS_BYTES - 1024, MISC_OFF = LDSCTL_OFF + 320, TAB_OFF = LDSCTL_OFF + 512;
constexpr int NWAVES = 8;

#define GAS __attribute__((address_space(1)))
#define LAS __attribute__((address_space(3)))
typedef unsigned short bf16;
typedef unsigned v4u __attribute__((ext_vector_type(4)));
typedef unsigned v2u __attribute__((ext_vector_type(2)));
typedef float f32x4 __attribute__((ext_vector_type(4)));
typedef float f32x2 __attribute__((ext_vector_type(2)));
typedef short bf16x8 __attribute__((ext_vector_type(8)));
typedef GAS unsigned gu32;
#define RLX_AGENT __ATOMIC_RELAXED, __HIP_MEMORY_SCOPE_AGENT
#define LDS_WAIT() asm volatile("s_waitcnt lgkmcnt(0)" ::: "memory")
#define VM_WAIT() asm volatile("s_waitcnt vmcnt(0)" ::: "memory")

__device__ __forceinline__ unsigned f2bf(float f) { unsigned u = __builtin_bit_cast(unsigned, f); return (u + 0x7fffu + ((u >> 16) & 1u)) >> 16; }
__device__ __forceinline__ unsigned pk2(float lo, float hi) { return f2bf(lo) | (f2bf(hi) << 16); }
__device__ __forceinline__ float bflo(unsigned u) { return __builtin_bit_cast(float, u << 16); }
__device__ __forceinline__ float bfhi(unsigned u) { return __builtin_bit_cast(float, u & 0xffff0000u); }
__device__ __forceinline__ float wave_sum(float v) {
#pragma unroll
    for (int o = 1; o < 64; o <<= 1) v += __shfl_xor(v, o);
    return v;
}
__device__ __forceinline__ float frcp_(float x) { return __builtin_amdgcn_rcpf(x); }
__device__ __forceinline__ float frsq_(float x) { return __builtin_amdgcn_rsqf(x); }
__device__ __forceinline__ float fexp_(float x) { return __builtin_amdgcn_exp2f(x * 1.4426950408889634f); }
__device__ __forceinline__ float sigmoidf_(float x) { return frcp_(1.f + fexp_(-x)); }
__device__ __forceinline__ float siluf_(float x) { return x * frcp_(1.f + fexp_(-x)); }

namespace pg8 {
constexpr int BM = 256, BK = 64, HALF = 128, HTB = HALF * BK * 2, STAGE_BYTES = 8 * HTB;
__device__ __forceinline__ int lds_byte(int r, int c) { const int st = (r >> 4) * 2 + (c >> 5), rr = r & 15, cc = c & 31, ob = rr * 64 + cc * 2; return st * 1024 + (ob ^ (((ob >> 9) & 1) << 5)); }
__device__ __forceinline__ void stage_rc(int b, int& R, int& C) { const int st = b / 1024, sb = b % 1024, swz = sb ^ (((sb >> 9) & 1) << 5); R = (st >> 1) * 16 + swz / 64; C = (st & 1) * 32 + (swz % 64) / 2; }
__device__ __forceinline__ int perm32(int rho) { const int n = rho >> 4, i = rho & 15; return 8 * (i >> 2) + 4 * n + (i & 3); }
typedef __bf16 bf16x2_t __attribute__((ext_vector_type(2)));
__device__ __forceinline__ unsigned cvt_pk_bf16(float lo, float hi) { const f32x2 v = {lo, hi}; const bf16x2_t b = __builtin_convertvector(v, bf16x2_t); return __builtin_bit_cast(unsigned, b); }

struct Unit { int rt, pn, e, rb, rows; };

struct Sched {
    int nM, nN, nwg, G, c;
    __device__ __forceinline__ void init(int nM_, int nN_, int G_, int c_) { nM = nM_; nN = nN_; nwg = nM * nN; G = G_; c = c_; }
    __device__ __forceinline__ bool next(int i, int& pm, int& pn) const {
        const long L = (long)i * G + c; if (L >= nwg) return false;
        int wgid = (int)L; { const int q = nwg / 8, r = nwg % 8, xcd = wgid % 8, off = wgid / 8; wgid = (xcd < r ? xcd * (q + 1) : r * (q + 1) + (xcd - r) * q) + off; }
        const int nig = 8 * nN, gid = wgid / nig, fm = gid * 8, gsz = (nM - fm) < 8 ? (nM - fm) : 8;
        pm = fm + ((wgid % nig) % gsz); pn = (wgid % nig) / gsz; return true;
    }
};

template <class P>
__device__ __forceinline__ void gemm_phase(LAS unsigned char* lds, const P& p) {
    const int tid = threadIdx.x, wid = __builtin_amdgcn_readfirstlane(tid >> 6), lane = tid & 63, wr = wid >> 2, wc = wid & 3, fr = lane & 15, fq = lane >> 4;
    const int K = p.K, nt = K / BK;
    int R[2], C[2]; unsigned voffB[2];
#pragma unroll
    for (int i = 0; i < 2; ++i) { stage_rc(tid * 16 + i * 8192, R[i], C[i]); const int Rb = (R[i] & ~31) + perm32(R[i] & 31); voffB[i] = (unsigned)(Rb * K + C[i]) * 2u; }
    const size_t kstep = (size_t)(BK * 2);
    const size_t hstep = (size_t)HALF * K * 2;
    const unsigned ldsw = (unsigned)wid * 1024u;
    const int aoff = lds_byte(wr * 64 + fr, fq * 8), boff = lds_byte(wc * 32 + fr, fq * 8);
#define PG8_SA(b, h) (((b) * 2 + (h)) * HTB)
#define PG8_SB(b, h) ((4 + (b) * 2 + (h)) * HTB)
#define PG8_STAGE(bufoff, gbase, voff) do { _Pragma("unroll") for (int _i = 0; _i < 2; ++_i) \
        __builtin_amdgcn_global_load_lds((const unsigned*)((const char*)(gbase) + (voff)[_i]), (LAS unsigned*)(lds + (bufoff) + ldsw + _i * 8192), 16, 0, 0); } while (0)
#define PG8_LDA(dst, b, h) do { _Pragma("unroll") for (int m = 0; m < 4; ++m) _Pragma("unroll") for (int k = 0; k < 2; ++k) dst[m][k] = *(const LAS bf16x8*)(lds + PG8_SA(b, h) + aoff + m * 2048 + k * 1024); } while (0)
#define PG8_LDB(dst, b, h) do { _Pragma("unroll") for (int n = 0; n < 2; ++n) _Pragma("unroll") for (int k = 0; k < 2; ++k) dst[n][k] = *(const LAS bf16x8*)(lds + PG8_SB(b, h) + boff + n * 2048 + k * 1024); } while (0)
#define PG8_MMA(ai, bj, At, Bt) do { __builtin_amdgcn_s_setprio(1); _Pragma("unroll") for (int m = 0; m < 4; ++m) _Pragma("unroll") for (int n = 0; n < 2; ++n) _Pragma("unroll") for (int k = 0; k < 2; ++k) \
        acc[ai][bj][m][n] = __builtin_amdgcn_mfma_f32_16x16x32_bf16(Bt[n][k], At[m][k], acc[ai][bj][m][n], 0, 0, 0); __builtin_amdgcn_s_setprio(0); } while (0)
#define PG8_WAIT_V(n) asm volatile("s_waitcnt vmcnt(" #n ")" ::: "memory")
#define PG8_WAIT_L(n) asm volatile("s_waitcnt lgkmcnt(" #n ")" ::: "memory")
#define PG8_BAR __builtin_amdgcn_s_barrier()
#define PG8_SCHED __builtin_amdgcn_sched_barrier(0)
    Unit cur, nxt; int ui = 0;
    if (!p.next(0, cur)) return;
    f32x4 acc[2][2][4][2];
#pragma unroll
    for (int a = 0; a < 2; ++a)
#pragma unroll
        for (int b = 0; b < 2; ++b)
#pragma unroll
            for (int m = 0; m < 4; ++m)
#pragma unroll
                for (int n = 0; n < 2; ++n) acc[a][b][m][n] = (f32x4){0.f, 0.f, 0.f, 0.f};
    bf16x8 At[4][2], B0[2][2], B1[2][2];
    unsigned oA[2][2], nO[2][2];
    p.a_off(cur, R, C, oA);
    const char* cA = p.a_base(cur); const char* cB = p.b_base(cur);
    PG8_STAGE(PG8_SB(0, 0), cB, voffB); PG8_STAGE(PG8_SB(0, 1), cB + hstep, voffB); PG8_STAGE(PG8_SA(0, 0), cA, oA[0]); PG8_STAGE(PG8_SA(0, 1), cA, oA[1]);
    if (wr == 1) PG8_BAR;
    PG8_WAIT_V(2); PG8_BAR;
    PG8_STAGE(PG8_SB(1, 0), cB + kstep, voffB); PG8_STAGE(PG8_SA(1, 0), cA + kstep, oA[0]); PG8_STAGE(PG8_SB(1, 1), cB + hstep + kstep, voffB);
    PG8_WAIT_V(6); PG8_BAR;
    for (;;) {
        const bool has_next = p.next(ui + 1, nxt);
        const char* nA = cA; const char* nB = cB;
#pragma unroll
        for (int h = 0; h < 2; ++h)
#pragma unroll
            for (int i = 0; i < 2; ++i) nO[h][i] = oA[h][i];
        if (has_next) { nA = p.a_base(nxt); nB = p.b_base(nxt); p.a_off(nxt, R, C, nO); }
        asm volatile("" : "+v"(nO[0][0]), "+v"(nO[0][1]), "+v"(nO[1][0]), "+v"(nO[1][1]));
        for (int t = 0; t < nt; t += 2) {
            const bool last = (t == nt - 2);
            const char* a1 = cA + (size_t)(t + 1) * kstep;
            const char* a2 = last ? nA : cA + (size_t)(t + 2) * kstep; const char* b2 = last ? nB : cB + (size_t)(t + 2) * kstep;
            const char* a3 = a2 + kstep; const char* b3 = b2 + kstep;
            unsigned o2[2][2];
#pragma unroll
            for (int h = 0; h < 2; ++h)
#pragma unroll
                for (int i = 0; i < 2; ++i) o2[h][i] = last ? nO[h][i] : oA[h][i];
            PG8_LDB(B0, 0, 0); PG8_LDB(B1, 0, 1); PG8_SCHED; PG8_LDA(At, 0, 0); PG8_STAGE(PG8_SA(1, 1), a1, oA[1]);
            PG8_WAIT_V(8); PG8_WAIT_L(0); PG8_BAR; PG8_MMA(0, 0, At, B0); PG8_MMA(0, 1, At, B1); PG8_BAR; PG8_SCHED;
            PG8_LDA(At, 0, 1); PG8_STAGE(PG8_SB(0, 0), b2, voffB); PG8_STAGE(PG8_SB(0, 1), b2 + hstep, voffB); PG8_STAGE(PG8_SA(0, 0), a2, o2[0]);
            PG8_WAIT_V(8); PG8_WAIT_L(0); PG8_BAR; PG8_MMA(1, 0, At, B0); PG8_MMA(1, 1, At, B1); PG8_BAR; PG8_SCHED;
            PG8_LDB(B0, 1, 0); PG8_LDB(B1, 1, 1); PG8_SCHED; PG8_LDA(At, 1, 0); PG8_STAGE(PG8_SA(0, 1), a2, o2[1]);
            PG8_WAIT_V(8); PG8_WAIT_L(0); PG8_BAR; PG8_MMA(0, 0, At, B0); PG8_MMA(0, 1, At, B1); PG8_BAR; PG8_SCHED;
            PG8_LDA(At, 1, 1); PG8_STAGE(PG8_SB(1, 0), b3, voffB); PG8_STAGE(PG8_SB(1, 1), b3 + hstep, voffB); PG8_STAGE(PG8_SA(1, 0), a3, o2[0]);
            PG8_WAIT_V(8); PG8_WAIT_L(0); PG8_BAR; PG8_MMA(1, 0, At, B0); PG8_MMA(1, 1, At, B1); PG8_BAR; PG8_SCHED;
        }
        if (wr == 0) PG8_BAR;
        p.epi(acc, cur, wr, wc, fr, fq);
        if (!has_next) break;
#pragma unroll
        for (int a = 0; a < 2; ++a)
#pragma unroll
            for (int b = 0; b < 2; ++b)
#pragma unroll
                for (int m = 0; m < 4; ++m)
#pragma unroll
                    for (int n = 0; n < 2; ++n) acc[a][b][m][n] = (f32x4){0.f, 0.f, 0.f, 0.f};
        cur = nxt; cA = nA; cB = nB; ++ui;
#pragma unroll
        for (int h = 0; h < 2; ++h)
#pragma unroll
            for (int i = 0; i < 2; ++i) oA[h][i] = nO[h][i];
        if (wr == 1) PG8_BAR;
    }
    PG8_WAIT_V(0);
    PG8_BAR;
#undef PG8_SA
#undef PG8_SB
#undef PG8_STAGE
#undef PG8_LDA
#undef PG8_LDB
#undef PG8_MMA
#undef PG8_WAIT_V
#undef PG8_WAIT_L
#undef PG8_BAR
#undef PG8_SCHED
}
}

#define XB_TMO      128
#define XB_XCNT(j)  (256  + 64 * (j))
#define XB_XSUB(j)  (1280 + 64 * (j))
#define XB_XGEN(j)  (2304 + 64 * (j))
#define XB_TOP      3328
#define XB_TOPGEN   3392
#define XCD_BAR_WORDS 3456
#define XB_SPIN_CAP (1u << 18)
__device__ __forceinline__ unsigned xb_ld(unsigned* p)              { return __hip_atomic_load(p, __ATOMIC_RELAXED, __HIP_MEMORY_SCOPE_AGENT); }
__device__ __forceinline__ unsigned xb_add(unsigned* p, unsigned v) { return __hip_atomic_fetch_add(p, v, __ATOMIC_RELAXED, __HIP_MEMORY_SCOPE_AGENT); }
__device__ __forceinline__ unsigned xb_xcc_id() { return (unsigned)__builtin_amdgcn_s_getreg((3 << 11) | 20) & 0xFu; }
#define XB_SPIN(cond, bar) do { unsigned _sp = 0; while (cond) { __builtin_amdgcn_s_sleep(1); \
    if ((++_sp & 255u) == 0u) { if (xb_ld(&(bar)[XB_TMO])) break; if (_sp > XB_SPIN_CAP) { atomicAdd(&(bar)[XB_TMO], 1u); break; } } } } while (0)
struct XcdBarrier { unsigned* bar; unsigned x; volatile LAS unsigned* st; };
__device__ __forceinline__ XcdBarrier xcd_barrier_post(unsigned* bar, volatile LAS unsigned* st) {
    XcdBarrier b; b.bar = bar; b.x = xb_xcc_id(); b.st = st;
    if (threadIdx.x == 0) (void)xb_add(&bar[XB_XCNT(b.x)], 1u);
    return b;
}
__device__ __forceinline__ void xcd_barrier_complete(unsigned* bar, unsigned x, unsigned& nloc, unsigned& nx) {
    const unsigned G = gridDim.x * gridDim.y * gridDim.z;
    unsigned sum, cnt, mine, sp = 0u;
    for (;;) {
        sum = 0u; cnt = 0u; mine = 0u;
#pragma unroll
        for (unsigned j = 0; j < 16; ++j) { const unsigned c = xb_ld(&bar[XB_XCNT(j)]); sum += c; cnt += (c > 0u) ? 1u : 0u; mine = (j == x) ? c : mine; }
        if (sum == G) break;
        __builtin_amdgcn_s_sleep(1);
        if ((++sp & 255u) == 0u) { if (xb_ld(&bar[XB_TMO])) break; if (sp > XB_SPIN_CAP) { atomicAdd(&bar[XB_TMO], 1u); break; } }
    }
    nloc = mine > 0u ? mine : 1u; nx = cnt > 0u ? cnt : 1u;
}
__device__ __forceinline__ void xcd_barrier(const XcdBarrier& b) {
    asm volatile("s_waitcnt vmcnt(0)" ::: "memory");
    __syncthreads();
    if (threadIdx.x == 0) {
        unsigned* bar = b.bar;
        __builtin_amdgcn_s_waitcnt(0);
        unsigned nloc = b.st[0], nx = b.st[1];
        if (nloc == 0u) { xcd_barrier_complete(bar, b.x, nloc, nx); b.st[0] = nloc; b.st[1] = nx; }
        const unsigned old = xb_add(&bar[XB_XSUB(b.x)], 1u);
        const unsigned gen = old / nloc;
        if (old + 1u == (gen + 1u) * nloc) {
            __builtin_amdgcn_fence(__ATOMIC_RELEASE, "agent");
            asm volatile("s_waitcnt vmcnt(0)" ::: "memory");
            const unsigned og = xb_add(&bar[XB_TOP], 1u);
            const unsigned tg = og / nx;
            if (og + 1u == (tg + 1u) * nx) xb_add(&bar[XB_TOPGEN], 1u);
            else XB_SPIN(xb_ld(&bar[XB_TOPGEN]) == tg, bar);
            __builtin_amdgcn_fence(__ATOMIC_ACQUIRE, "agent");
            xb_add(&bar[XB_XGEN(b.x)], 1u);
            asm volatile("s_waitcnt vmcnt(0)" ::: "memory");
        } else {
            XB_SPIN(xb_ld(&bar[XB_XGEN(b.x)]) == gen, bar);
            __builtin_amdgcn_fence(__ATOMIC_ACQUIRE, "agent");
            asm volatile("s_waitcnt vmcnt(0)" ::: "memory");
        }
    }
    __syncthreads();
}

struct Frame {
    LAS unsigned char* lds;
    int tid, lane, wave, vcu, G;
    const float* in[18];
    float* out;
    unsigned char* ws;
};
using pg8::Unit;
using pg8::cvt_pk_bf16;

struct ProbBase {
    int K; pg8::Sched S;
    __device__ __forceinline__ void lin_off(const int (&R)[2], const int (&C)[2], unsigned (&off)[2][2]) const {
#pragma unroll
        for (int h = 0; h < 2; ++h)
#pragma unroll
            for (int i = 0; i < 2; ++i) off[h][i] = (unsigned)((h * 128 + R[i]) * K + C[i]) * 2u;
    }
};
struct ProbIn : ProbBase {
    const bf16* A; const bf16* Bt; bf16* O; const float* rs;
    __device__ __forceinline__ bool next(int i, Unit& u) const { int pm, pn; if (!S.next(i, pm, pn)) return false; u.rt = pm; u.pn = pn; u.e = 0; u.rb = pm; u.rows = 256; return true; }
    __device__ __forceinline__ const char* a_base(const Unit& u) const { return (const char*)A + (size_t)u.rt * 256 * K * 2; }
    __device__ __forceinline__ const char* b_base(const Unit& u) const { return (const char*)Bt + (size_t)u.pn * 256 * K * 2; }
    __device__ __forceinline__ void a_off(const Unit&, const int (&R)[2], const int (&C)[2], unsigned (&off)[2][2]) const { lin_off(R, C, off); }
    __device__ __forceinline__ void epi(const f32x4 (&acc)[2][2][4][2], const Unit& u, int wr, int wc, int fr, int fq) const {
        const int row0 = u.rt * 256 + wr * 64 + fr, col0 = u.pn * 256 + wc * 32 + 8 * fq;
#pragma unroll
        for (int ai = 0; ai < 2; ++ai)
#pragma unroll
            for (int m = 0; m < 4; ++m) { const int row = row0 + ai * 128 + m * 16; const float sc = rs[row]; bf16* rowp = O + (size_t)row * NPROJ + col0;
#pragma unroll
                for (int bj = 0; bj < 2; ++bj) { const f32x4 v0 = acc[ai][bj][m][0] * sc, v1 = acc[ai][bj][m][1] * sc; v4u w;
                    w.x = cvt_pk_bf16(v0[0], v0[1]); w.y = cvt_pk_bf16(v0[2], v0[3]); w.z = cvt_pk_bf16(v1[0], v1[1]); w.w = cvt_pk_bf16(v1[2], v1[3]);
                    *(v4u*)(rowp + bj * 128) = w; } }
    }
};
struct ProbPool : ProbBase {
    const bf16* A; const bf16* Bt; bf16* O;
    __device__ __forceinline__ bool next(int i, Unit& u) const { int pm, pn; if (!S.next(i, pm, pn)) return false; u.rt = pm; u.pn = pn; u.e = 0; u.rb = pm; u.rows = 256; return true; }
    __device__ __forceinline__ const char* a_base(const Unit& u) const { return (const char*)A + (size_t)u.rt * 256 * K * 2; }
    __device__ __forceinline__ const char* b_base(const Unit& u) const { return (const char*)Bt + (size_t)u.pn * 256 * K * 2; }
    __device__ __forceinline__ void a_off(const Unit&, const int (&R)[2], const int (&C)[2], unsigned (&off)[2][2]) const { lin_off(R, C, off); }
    __device__ __forceinline__ void epi(const f32x4 (&acc)[2][2][4][2], const Unit& u, int wr, int wc, int fr, int fq) const {
        const int row0 = u.rt * 256 + wr * 64 + fr, col0 = 512 + u.pn * 256 + wc * 32 + 8 * fq;
#pragma unroll
        for (int ai = 0; ai < 2; ++ai)
#pragma unroll
            for (int m = 0; m < 4; ++m) { const int row = row0 + ai * 128 + m * 16; bf16* rowp = O + (size_t)row * DM + col0;
#pragma unroll
                for (int bj = 0; bj < 2; ++bj) { const f32x4 v0 = acc[ai][bj][m][0], v1 = acc[ai][bj][m][1]; v4u w;
                    w.x = cvt_pk_bf16(v0[0], v0[1]); w.y = cvt_pk_bf16(v0[2], v0[3]); w.z = cvt_pk_bf16(v1[0], v1[1]); w.w = cvt_pk_bf16(v1[2], v1[3]);
                    *(v4u*)(rowp + bj * 128) = w; } }
    }
};
struct ProbOut : ProbBase {
    const bf16* A; const bf16* Bt; const float* X; float* O;
    __device__ __forceinline__ bool next(int i, Unit& u) const { int pm, pn; if (!S.next(i, pm, pn)) return false; u.rt = pm; u.pn = pn; u.e = 0; u.rb = pm; u.rows = 256; return true; }
    __device__ __forceinline__ const char* a_base(const Unit& u) const { return (const char*)A + (size_t)u.rt * 256 * K * 2; }
    __device__ __forceinline__ const char* b_base(const Unit& u) const { return (const char*)Bt + (size_t)u.pn * 256 * K * 2; }
    __device__ __forceinline__ void a_off(const Unit&, const int (&R)[2], const int (&C)[2], unsigned (&off)[2][2]) const { lin_off(R, C, off); }
    __device__ __forceinline__ void epi(const f32x4 (&acc)[2][2][4][2], const Unit& u, int wr, int wc, int fr, int fq) const {
        const int row0 = u.rt * 256 + wr * 64 + fr, col0 = u.pn * 256 + wc * 32 + 8 * fq;
#pragma unroll
        for (int ai = 0; ai < 2; ++ai)
#pragma unroll
            for (int m = 0; m < 4; ++m) { const size_t off = (size_t)(row0 + ai * 128 + m * 16) * DM + col0;
#pragma unroll
                for (int bj = 0; bj < 2; ++bj)
#pragma unroll
                    for (int n = 0; n < 2; ++n) { const f32x4 xv = *(const f32x4*)(X + off + bj * 128 + 4 * n); *(f32x4*)(O + off + bj * 128 + 4 * n) = xv + acc[ai][bj][m][n]; } }
    }
};
struct MoeTab { const LAS int* pref; const LAS int* cnt; };
__device__ __forceinline__ void moe_decode(const MoeTab& T, int rt, Unit& u) {
    int e = 0;
#pragma unroll 1
    for (int j = 1; j < NE; ++j) if (T.pref[j] <= rt) e = j;
    u.e = e; u.rb = rt - T.pref[e]; const int left = T.cnt[e] - u.rb * 256; u.rows = left < 256 ? left : 256;
}
struct ProbGU : ProbBase {
    MoeTab T; const bf16* A; const bf16* Bt; bf16* O; const int* list; const float* rs2; const float* bgu;
    __device__ __forceinline__ bool next(int i, Unit& u) const { int pm, pn; if (!S.next(i, pm, pn)) return false; u.rt = pm; u.pn = pn; moe_decode(T, pm, u); return true; }
    __device__ __forceinline__ const char* a_base(const Unit&) const { return (const char*)A; }
    __device__ __forceinline__ const char* b_base(const Unit& u) const { return (const char*)Bt + ((size_t)u.e * 2048 + (size_t)u.pn * 256) * K * 2; }
    __device__ __forceinline__ void a_off(const Unit& u, const int (&R)[2], const int (&C)[2], unsigned (&off)[2][2]) const {
        const int* lp = list + (size_t)u.e * LISTCAP + u.rb * 256;
#pragma unroll
        for (int h = 0; h < 2; ++h)
#pragma unroll
            for (int i = 0; i < 2; ++i) { const int r = h * 128 + R[i]; const int ent = (r < u.rows) ? lp[r] : 0; off[h][i] = (unsigned)(ent >> 2) * (unsigned)(K * 2) + (unsigned)C[i] * 2u; }
    }
    __device__ __forceinline__ void epi(const f32x4 (&acc)[2][2][4][2], const Unit& u, int wr, int wc, int fr, int fq) const {
        const int* lp = list + (size_t)u.e * LISTCAP + u.rb * 256;
        const int j0 = wc * 32 + 8 * fq;
        const float* bg = bgu + (size_t)u.e * 2048 + u.pn * 256 + j0;
        f32x4 bgv[2], buv[2];
#pragma unroll
        for (int n = 0; n < 2; ++n) { bgv[n] = *(const f32x4*)(bg + 4 * n); buv[n] = *(const f32x4*)(bg + 128 + 4 * n); }
#pragma unroll
        for (int ai = 0; ai < 2; ++ai)
#pragma unroll
            for (int m = 0; m < 4; ++m) { const int r = ai * 128 + wr * 64 + m * 16 + fr;
                if (r < u.rows) { const int ent = lp[r]; const float sc = rs2[ent >> 2]; unsigned w[4];
#pragma unroll
                    for (int n = 0; n < 2; ++n) { float a[4];
#pragma unroll
                        for (int q = 0; q < 4; ++q) { float gt = acc[ai][0][m][n][q] * sc + bgv[n][q], up = acc[ai][1][m][n][q] * sc + buv[n][q];
                            gt = fminf(gt, 7.f); up = fminf(fmaxf(up, -7.f), 7.f); a[q] = (up + 1.f) * gt * frcp_(1.f + fexp_(-1.702f * gt)); }
                        w[2 * n] = cvt_pk_bf16(a[0], a[1]); w[2 * n + 1] = cvt_pk_bf16(a[2], a[3]); }
                    *(v4u*)(O + (size_t)(u.rt * 256 + r) * DE + u.pn * 128 + j0) = (v4u){w[0], w[1], w[2], w[3]}; } }
    }
};
struct ProbDown : ProbBase {
    MoeTab T; const bf16* A; const bf16* Bt; bf16* O; const int* list; const float* gw; const float* bd;
    __device__ __forceinline__ bool next(int i, Unit& u) const { int pm, pn; if (!S.next(i, pm, pn)) return false; u.rt = pm; u.pn = pn; moe_decode(T, pm, u); return true; }
    __device__ __forceinline__ const char* a_base(const Unit& u) const { return (const char*)A + (size_t)u.rt * 256 * K * 2; }
    __device__ __forceinline__ const char* b_base(const Unit& u) const { return (const char*)Bt + ((size_t)u.e * 1024 + (size_t)u.pn * 256) * K * 2; }
    __device__ __forceinline__ void a_off(const Unit&, const int (&R)[2], const int (&C)[2], unsigned (&off)[2][2]) const { lin_off(R, C, off); }
    __device__ __forceinline__ void epi(const f32x4 (&acc)[2][2][4][2], const Unit& u, int wr, int wc, int fr, int fq) const {
        const int* lp = list + (size_t)u.e * LISTCAP + u.rb * 256;
        const int c0 = u.pn * 256 + wc * 32 + 8 * fq;
        const float* bp = bd + (size_t)u.e * DM + c0;
        f32x4 bv[2][2];
#pragma unroll
        for (int bj = 0; bj < 2; ++bj)
#pragma unroll
            for (int n = 0; n < 2; ++n) bv[bj][n] = *(const f32x4*)(bp + bj * 128 + 4 * n);
#pragma unroll
        for (int ai = 0; ai < 2; ++ai)
#pragma unroll
            for (int m = 0; m < 4; ++m) { const int r = ai * 128 + wr * 64 + m * 16 + fr;
                if (r < u.rows) { const int ent = lp[r]; const float g = gw[ent]; bf16* rowp = O + (size_t)ent * DM + c0;
#pragma unroll
                    for (int bj = 0; bj < 2; ++bj) { const f32x4 v0 = (acc[ai][bj][m][0] + bv[bj][0]) * g, v1 = (acc[ai][bj][m][1] + bv[bj][1]) * g; v4u w;
                        w.x = cvt_pk_bf16(v0[0], v0[1]); w.y = cvt_pk_bf16(v0[2], v0[3]); w.z = cvt_pk_bf16(v1[0], v1[1]); w.w = cvt_pk_bf16(v1[2], v1[3]);
                        *(v4u*)(rowp + bj * 128) = w; } } }
    }
};

__device__ __forceinline__ void tr_item(const float* W, int ldw, int k0, int nsrc0, bf16* WT, size_t drow0, int ldk, int dk0, const float* ks, const float* ns, LAS float* scr, int lane) {
    const int nl = lane & 31;
    const float nsc = ns ? ns[nsrc0 + nl] : 1.f;
#pragma unroll
    for (int i = 0; i < 32; ++i) { const int kk = 2 * i + (lane >> 5); float v = W[(size_t)(k0 + kk) * ldw + nsrc0 + nl] * nsc; if (ks) v *= ks[k0 + kk]; scr[kk * 33 + nl] = v; }
    LDS_WAIT(); asm volatile("" ::: "memory");
    const int c = lane & 7;
#pragma unroll
    for (int j = 0; j < 4; ++j) { const int n = (lane >> 3) + 8 * j; const LAS float* s = scr + (8 * c) * 33 + n;
        v4u o; o.x = pk2(s[0 * 33], s[1 * 33]); o.y = pk2(s[2 * 33], s[3 * 33]); o.z = pk2(s[4 * 33], s[5 * 33]); o.w = pk2(s[6 * 33], s[7 * 33]);
        *(v4u*)(WT + (drow0 + n) * (size_t)ldk + dk0 + k0 + 8 * c) = o; }
    LDS_WAIT(); asm volatile("" ::: "memory");
}

__device__ __forceinline__ void phase_prep(Frame& F) {
    const float* x = F.in[0]; const float* anw = F.in[1]; const float* w_in = F.in[2]; const float* a_log = F.in[4]; const float* dt_bias = F.in[5];
    const float* pool_w = F.in[7]; const float* pool_scale = F.in[8]; const float* w_out = F.in[9]; const float* fnw = F.in[10];
    const float* w_router = F.in[11]; const float* w_gu = F.in[13]; const float* b_gu = F.in[14]; const float* w_d = F.in[15];
    bf16* WinT = (bf16*)(F.ws + WS_WIN); bf16* WoutT = (bf16*)(F.ws + WS_WOUT); bf16* WpoolT = (bf16*)(F.ws + WS_WPOOL);
    bf16* WguT = (bf16*)(F.ws + WS_WGU); bf16* WdT = (bf16*)(F.ws + WS_WD);
    bf16* WrI = (bf16*)(F.ws + WS_WR); float* bguP = (float*)(F.ws + WS_BGU);
    bf16* xb = (bf16*)(F.ws + WS_XB); float* rs1 = (float*)(F.ws + WS_RS1); float* betaA = (float*)(F.ws + WS_BETA); float* gA = (float*)(F.ws + WS_G);
    LAS float* scr = (LAS float*)(F.lds + F.wave * 8704);
    LAS float* W8T = (LAS float*)(F.lds + 69632);
    const int gw = F.vcu * NWAVES + F.wave, NGW = F.G * NWAVES;
    const int gt = F.vcu * 512 + F.tid, NGT = F.G * 512;
    for (int idx = F.tid; idx < 8192; idx += 512) { const int k = idx >> 3, c = idx & 7; W8T[c * 1024 + k] = anw[k] * w_in[(size_t)k * DIN + 2048 + c]; }
    __syncthreads();
    constexpr int I_IN1 = 16 * 64, I_IN2 = 16 * 16, I_OUT = 16 * 32, I_POOL = 4 * 2 * 4, I_GU = 32 * 16 * 16 * 4, I_D = 32 * 16 * 32;
    constexpr int NITEMS = I_IN1 + I_IN2 + I_OUT + I_POOL + I_GU + I_D;
    for (int it = gw; it < NITEMS; it += NGW) {
        int r = it;
        if (r < I_IN1) { const int kb = r / 64, nb = r % 64; tr_item(w_in, DIN, kb * 64, nb * 32, WinT, (size_t)nb * 32, DM, 0, anw, nullptr, scr, F.lane); continue; } r -= I_IN1;
        if (r < I_IN2) { const int kb = r / 16, nb = r % 16; tr_item(w_in, DIN, kb * 64, 2056 + nb * 32, WinT, (size_t)2048 + nb * 32, DM, 0, anw, nullptr, scr, F.lane); continue; } r -= I_IN2;
        if (r < I_OUT) { const int kb = r / 32, nb = r % 32; tr_item(w_out, DM, kb * 64, nb * 32, WoutT, (size_t)nb * 32, DM, 0, nullptr, nullptr, scr, F.lane); continue; } r -= I_OUT;
        if (r < I_POOL) { const int g = r / 8, kb = (r % 8) / 4, nb = r % 4; tr_item(pool_w + (size_t)g * 128 * 128, 128, kb * 64, nb * 32, WpoolT, (size_t)g * 128 + nb * 32, 512, g * 128, nullptr, pool_scale + g * 128, scr, F.lane); continue; } r -= I_POOL;
        if (r < I_GU) { const int e = r / 1024, r2 = r % 1024, seg = r2 / 64, kb = (r2 % 64) / 4, nb = r2 % 4; const int t = seg >> 1, half = seg & 1;
            tr_item(w_gu + (size_t)e * DM * 2048, 2048, kb * 64, half * 1024 + t * 128 + nb * 32, WguT, (size_t)e * 2048 + t * 256 + half * 128 + nb * 32, DM, 0, fnw, nullptr, scr, F.lane); continue; } r -= I_GU;
        { const int e = r / 512, r2 = r % 512, kb = r2 / 32, nb = r2 % 32; tr_item(w_d + (size_t)e * DE * DM, DM, kb * 64, nb * 32, WdT, (size_t)e * 1024 + nb * 32, DE, 0, nullptr, nullptr, scr, F.lane); }
    }
    for (int idx = gt; idx < NE * 2048; idx += NGT) { const int e = idx >> 11, r = idx & 2047, t = r >> 8, j = r & 255, half = j >> 7, jj = j & 127; bguP[idx] = b_gu[(size_t)e * 2048 + half * 1024 + t * 128 + jj]; }
    for (int idx = gt; idx < 64 * 64 * 8; idx += NGT) { const int j = idx & 7, ln = (idx >> 3) & 63, fr2 = idx >> 9, nb = fr2 & 1, ks = fr2 >> 1;
        const int k = 32 * ks + 8 * (ln >> 4) + j, e = 16 * nb + (ln & 15); const float v = fnw[k] * w_router[(size_t)k * NE + e];
        const unsigned hb = f2bf(v); const float hf = __builtin_bit_cast(float, hb << 16); const unsigned lb = f2bf(v - hf);
        WrI[((size_t)(fr2 * 2 + 0) * 64 + ln) * 8 + j] = (bf16)hb; WrI[((size_t)(fr2 * 2 + 1) * 64 + ln) * 8 + j] = (bf16)lb; }
    for (int idx = gt; idx < 512 * 64; idx += NGT) { const int n = idx >> 6, ch = idx & 63; if ((n >> 7) != (ch >> 4)) *(v4u*)(WpoolT + (size_t)n * 512 + ch * 8) = (v4u){0u, 0u, 0u, 0u}; }
    for (int m = gw; m < NTOK; m += NGW) {
        const f32x4* xr = (const f32x4*)(x + (size_t)m * DM) + F.lane;
        f32x4 v[4]; float ss = 0.f; float d8[8];
#pragma unroll
        for (int c = 0; c < 8; ++c) d8[c] = 0.f;
#pragma unroll
        for (int j = 0; j < 4; ++j) { v[j] = xr[64 * j]; ss += (v[j].x * v[j].x + v[j].y * v[j].y) + (v[j].z * v[j].z + v[j].w * v[j].w); }
#pragma unroll
        for (int c = 0; c < 8; ++c)
#pragma unroll
            for (int j = 0; j < 4; ++j) { const f32x4 w = *(const LAS f32x4*)(W8T + c * 1024 + 256 * j + 4 * F.lane); d8[c] += (v[j].x * w.x + v[j].y * w.y) + (v[j].z * w.z + v[j].w * w.w); }
        ss = wave_sum(ss);
#pragma unroll
        for (int c = 0; c < 8; ++c) d8[c] = wave_sum(d8[c]);
        const float rs = 1.f / sqrtf(ss * (1.f / DM) + 1e-6f);
        unsigned long long* o8 = (unsigned long long*)(xb + (size_t)m * DM) + F.lane;
#pragma unroll
        for (int j = 0; j < 4; ++j) o8[64 * j] = (unsigned long long)pk2(v[j].x, v[j].y) | ((unsigned long long)pk2(v[j].z, v[j].w) << 32);
        if (F.lane == 0) rs1[m] = rs;
        if (F.lane < 4) {
            float bl = 0.f, al = 0.f;
#pragma unroll
            for (int c = 0; c < 4; ++c) { bl = (F.lane == c) ? d8[c] : bl; al = (F.lane == c) ? d8[4 + c] : al; }
            bl *= rs; al *= rs;
            betaA[(size_t)m * 4 + F.lane] = 1.f / (1.f + expf(-bl));
            const float z = al + dt_bias[F.lane]; const float sp = z > 20.f ? z : log1pf(expf(z));
            gA[(size_t)m * 4 + F.lane] = -expf(a_log[F.lane]) * sp;
        }
    }
}

__device__ __forceinline__ void phase_mix(Frame& F) {
    const bf16* proj = (const bf16*)(F.ws + WS_PROJ); bf16* mixed = (bf16*)(F.ws + WS_MIXED);
    const int gw = F.vcu * NWAVES + F.wave, NGW = F.G * NWAVES;
    const int ch = 8 * F.lane, gi = F.lane >> 4, win = 2 << gi, hal = win - 1;
    for (int rbk = gw; rbk < NTOK / 16; rbk += NGW) {
        const int m0 = rbk * 16, t0 = m0 % SEQ;
        v4u X[31];
#pragma unroll
        for (int k = 0; k < 31; ++k) { X[k] = (v4u){0u, 0u, 0u, 0u}; if (k >= 15 - hal && t0 - 15 + k >= 0) X[k] = *(const v4u*)(proj + (size_t)(m0 - 15 + k) * NPROJ + 2048 + ch); }
        float s[8];
#pragma unroll
        for (int q = 0; q < 8; ++q) s[q] = 0.f;
#pragma unroll
        for (int k = 0; k < 15; ++k) { s[0] += bflo(X[k].x); s[1] += bfhi(X[k].x); s[2] += bflo(X[k].y); s[3] += bfhi(X[k].y); s[4] += bflo(X[k].z); s[5] += bfhi(X[k].z); s[6] += bflo(X[k].w); s[7] += bfhi(X[k].w); }
#pragma unroll
        for (int r = 0; r < 16; ++r) {
            const v4u u = X[15 + r];
            const float p[8] = {bflo(u.x), bfhi(u.x), bflo(u.y), bfhi(u.y), bflo(u.z), bfhi(u.z), bflo(u.w), bfhi(u.w)};
#pragma unroll
            for (int q = 0; q < 8; ++q) s[q] += p[q];
            const int tt = t0 + r + 1; const float ic = 1.f / (float)(tt < win ? tt : win);
            v4u o; o.x = pk2(s[0] * ic - p[0], s[1] * ic - p[1]); o.y = pk2(s[2] * ic - p[2], s[3] * ic - p[3]); o.z = pk2(s[4] * ic - p[4], s[5] * ic - p[5]); o.w = pk2(s[6] * ic - p[6], s[7] * ic - p[7]);
            *(v4u*)(mixed + (size_t)(m0 + r) * 512 + ch) = o;
            const v4u od = gi == 0 ? X[14 + r] : gi == 1 ? X[12 + r] : gi == 2 ? X[8 + r] : X[r];
            s[0] -= bflo(od.x); s[1] -= bfhi(od.x); s[2] -= bflo(od.y); s[3] -= bfhi(od.y); s[4] -= bflo(od.z); s[5] -= bfhi(od.z); s[6] -= bflo(od.w); s[7] -= bfhi(od.w);
        }
    }
}

typedef float f32x16 __attribute__((ext_vector_type(16)));
__device__ __forceinline__ bf16x8 pack8(const f32x4 a, const f32x4 b) {
    v4u w; w.x = cvt_pk_bf16(a[0], a[1]); w.y = cvt_pk_bf16(a[2], a[3]); w.z = cvt_pk_bf16(b[0], b[1]); w.w = cvt_pk_bf16(b[2], b[3]);
    return __builtin_bit_cast(bf16x8, w);
}
__device__ __forceinline__ void fmac_(float& acc, float a, float b) { asm("v_fmac_f32 %0, %1, %2" : "+v"(acc) : "v"(a), "v"(b)); }
__device__ __forceinline__ float bf2f(unsigned short u) { return __builtin_bit_cast(float, (unsigned)u << 16); }

constexpr int CP_QN = 0, CP_KN = 17408, CP_VA = 34816, CP_QKL = 51200, CP_SC = 59392, CP_HALF = 61440;
__device__ __forceinline__ void phase_chunk(Frame& F) {
    const float* conv_w = F.in[3];
    const bf16* proj = (const bf16*)(F.ws + WS_PROJ);
    const float* betaA = (const float*)(F.ws + WS_BETA); const float* gA = (const float*)(F.ws + WS_G);
    float* gtotA = (float*)(F.ws + WS_GTOT);
    const int half = F.wave >> 2, hw = F.wave & 3, ht = F.tid & 255, lane = F.lane;
    LAS unsigned char* L = F.lds + half * CP_HALF;
    LAS bf16* qn = (LAS bf16*)(L + CP_QN); LAS bf16* kn = (LAS bf16*)(L + CP_KN); LAS bf16* vn = (LAS bf16*)(L + CP_VA);
    LAS float* Am = (LAS float*)(L + CP_VA); LAS bf16* qkL = (LAS bf16*)(L + CP_QKL); LAS float* sc = (LAS float*)(L + CP_SC);
    const int r16 = lane & 15, gq = lane >> 4;
#pragma unroll 1
    for (int it = 0; it < 4; ++it) {
        const int unit = (it * (int)gridDim.x + (int)blockIdx.x) * 2 + half;
        const bool live = unit < NB * NH * 64;
        const int bh = unit >> 6, n = unit & 63, b = bh >> 2, h = bh & 3;
        const size_t m0 = (size_t)b * SEQ + (size_t)n * 64;
        unsigned char* chunk = F.ws + WS_CHUNK + (size_t)unit * CH_BYTES;
        if (live && hw == 0) {
            const float gi = gA[(m0 + lane) * 4 + h], bi = betaA[(m0 + lane) * 4 + h];
            float c = gi;
#pragma unroll
            for (int o = 1; o < 64; o <<= 1) { const float tt = __shfl_up(c, o); if (lane >= o) c += tt; }
            const float gl = __shfl(c, 63);
            sc[lane] = bi; sc[64 + lane] = c; sc[128 + lane] = __expf(c); sc[192 + lane] = __expf(gl - c);
            if (lane == 63) gtotA[unit] = __expf(c);
        }
        if (live) {
            const int rq = ht >> 4, cg = ht & 15;
#pragma unroll 1
            for (int p = 0; p < 3; ++p) {
                const int col = p * 512 + h * 128 + 8 * cg;
                float xin[7][8];
#pragma unroll
                for (int jj = 0; jj < 7; ++jj) { const int trow = n * 64 + 4 * rq - 3 + jj; v4u u = (v4u){0u, 0u, 0u, 0u};
                    if (trow >= 0) u = *(const v4u*)(proj + ((size_t)b * SEQ + trow) * NPROJ + col);
                    xin[jj][0] = bflo(u.x); xin[jj][1] = bfhi(u.x); xin[jj][2] = bflo(u.y); xin[jj][3] = bfhi(u.y); xin[jj][4] = bflo(u.z); xin[jj][5] = bfhi(u.z); xin[jj][6] = bflo(u.w); xin[jj][7] = bfhi(u.w); }
                float wv[4][8];
#pragma unroll
                for (int j = 0; j < 4; ++j) { const f32x4 w0 = *(const f32x4*)(conv_w + j * 1536 + col), w1 = *(const f32x4*)(conv_w + j * 1536 + col + 4);
                    wv[j][0] = w0.x; wv[j][1] = w0.y; wv[j][2] = w0.z; wv[j][3] = w0.w; wv[j][4] = w1.x; wv[j][5] = w1.y; wv[j][6] = w1.z; wv[j][7] = w1.w; }
#pragma unroll
                for (int rr = 0; rr < 4; ++rr) {
                    float y[8]; float ss = 0.f;
#pragma unroll
                    for (int q = 0; q < 8; ++q) { float a = 0.f;
#pragma unroll
                        for (int j = 0; j < 4; ++j) a += wv[j][q] * xin[rr + j][q];
                        y[q] = siluf_(a); ss += y[q] * y[q]; }
                    float scl = 1.f;
                    if (p < 2) { ss += __shfl_xor(ss, 1); ss += __shfl_xor(ss, 2); ss += __shfl_xor(ss, 4); ss += __shfl_xor(ss, 8); scl = frsq_(ss + 1e-6f); if (p == 0) scl *= 0.08838834764831845f; }
                    v4u o; o.x = pk2(y[0] * scl, y[1] * scl); o.y = pk2(y[2] * scl, y[3] * scl); o.z = pk2(y[4] * scl, y[5] * scl); o.w = pk2(y[6] * scl, y[7] * scl);
                    const int row = 4 * rq + rr;
                    if (p == 0) *(LAS v4u*)(qn + row * 136 + 8 * cg) = o; else if (p == 1) *(LAS v4u*)(kn + row * 136 + 8 * cg) = o; else *(LAS v4u*)(vn + row * 128 + 8 * cg) = o;
                }
            }
        }
        __syncthreads();
        const int which = ht >> 7, c = ht & 127;
        float U[64];
        if (live) {
#pragma unroll
            for (int i = 0; i < 64; ++i) { const float bi = sc[i]; const float tv = which ? bf2f(kn[i * 136 + c]) * sc[128 + i] : bf2f(vn[i * 128 + c]); U[i] = tv * bi; }
        } else {
#pragma unroll
            for (int i = 0; i < 64; ++i) U[i] = 0.f;
        }
        __syncthreads();
        if (live) {
            const int ti = hw >> 1, tj = hw & 1, r = lane & 31, hh = lane >> 5;
            f32x16 KK, QK;
#pragma unroll
            for (int q = 0; q < 16; ++q) { KK[q] = 0.f; QK[q] = 0.f; }
#pragma unroll
            for (int ks = 0; ks < 8; ++ks) {
                const bf16x8 ak = *(const LAS bf16x8*)(kn + (ti * 32 + r) * 136 + 16 * ks + 8 * hh);
                const bf16x8 aq = *(const LAS bf16x8*)(qn + (ti * 32 + r) * 136 + 16 * ks + 8 * hh);
                const bf16x8 bb = *(const LAS bf16x8*)(kn + (tj * 32 + r) * 136 + 16 * ks + 8 * hh);
                KK = __builtin_amdgcn_mfma_f32_32x32x16_bf16(ak, bb, KK, 0, 0, 0);
                QK = __builtin_amdgcn_mfma_f32_32x32x16_bf16(aq, bb, QK, 0, 0, 0);
            }
            const int j = tj * 32 + r; const float gcj = sc[64 + j];
#pragma unroll
            for (int reg = 0; reg < 16; ++reg) { const int i = ti * 32 + (reg & 3) + 8 * (reg >> 2) + 4 * hh;
                const float dec = (i >= j) ? __expf(sc[64 + i] - gcj) : 0.f;
                Am[i * 64 + j] = (i > j) ? sc[i] * KK[reg] * dec : 0.f;
                qkL[i * 64 + j] = (bf16)f2bf((i >= j) ? QK[reg] * dec : 0.f); }
        }
        __syncthreads();
        if (live) {
#pragma unroll
            for (int fi = 0; fi < 4; ++fi) { const int f = hw * 4 + fi, mb = f >> 2, ks = f & 3, row = 16 * mb + r16; const float s = sc[128 + row];
                const v2u lo = *(const LAS v2u*)(qn + row * 136 + 32 * ks + 4 * gq), hi = *(const LAS v2u*)(qn + row * 136 + 32 * ks + 16 + 4 * gq);
                v4u o; o.x = pk2(bflo(lo.x) * s, bfhi(lo.x) * s); o.y = pk2(bflo(lo.y) * s, bfhi(lo.y) * s); o.z = pk2(bflo(hi.x) * s, bfhi(hi.x) * s); o.w = pk2(bflo(hi.y) * s, bfhi(hi.y) * s);
                *(v4u*)(chunk + CH_QD + (f * 64 + lane) * 16) = o; }
#pragma unroll
            for (int fi = 0; fi < 4; ++fi) { const int f = hw * 4 + fi, db = f >> 1, ksp = f & 1, dcol = 16 * db + r16; float e[8];
#pragma unroll
                for (int j = 0; j < 8; ++j) { const int i = 32 * ksp + 16 * (j >> 2) + 4 * gq + (j & 3); e[j] = bf2f(kn[i * 136 + dcol]) * sc[192 + i]; }
                v4u o; o.x = pk2(e[0], e[1]); o.y = pk2(e[2], e[3]); o.z = pk2(e[4], e[5]); o.w = pk2(e[6], e[7]);
                *(v4u*)(chunk + CH_KT + (f * 64 + lane) * 16) = o; }
#pragma unroll
            for (int fi = 0; fi < 2; ++fi) { const int f = hw * 2 + fi, mb = f >> 1, ksp = f & 1, row = 16 * mb + r16;
                const v2u lo = *(const LAS v2u*)(qkL + row * 64 + 32 * ksp + 4 * gq), hi = *(const LAS v2u*)(qkL + row * 64 + 32 * ksp + 16 + 4 * gq);
                *(v4u*)(chunk + CH_QK + (f * 64 + lane) * 16) = (v4u){lo.x, lo.y, hi.x, hi.y}; }
#pragma unroll
            for (int i = 1; i < 64; ++i) {
                float s0 = 0.f, s1 = 0.f, s2 = 0.f, s3 = 0.f;
#pragma unroll
                for (int j4 = 0; j4 < (i + 3) / 4; ++j4) { const f32x4 a = *(const LAS f32x4*)(Am + i * 64 + 4 * j4);
                    fmac_(s0, a.x, U[4 * j4]); if (4 * j4 + 1 < i) fmac_(s1, a.y, U[4 * j4 + 1]); if (4 * j4 + 2 < i) fmac_(s2, a.z, U[4 * j4 + 2]); if (4 * j4 + 3 < i) fmac_(s3, a.w, U[4 * j4 + 3]); }
                U[i] -= (s0 + s1) + (s2 + s3);
                __builtin_amdgcn_sched_barrier(0);
            }
        }
        __syncthreads();
        if (live) {
            if (which == 0) {
                const int w8 = c >> 4, cl = c & 15;
                unsigned char* ub = F.ws + WS_UC + (size_t)unit * UC_BYTES;
#pragma unroll
                for (int g = 0; g < 4; ++g) {
                    v4u lo, hi;
                    lo.x = pk2(U[4 * g], U[4 * g + 1]); lo.y = pk2(U[4 * g + 2], U[4 * g + 3]); lo.z = pk2(U[16 + 4 * g], U[16 + 4 * g + 1]); lo.w = pk2(U[16 + 4 * g + 2], U[16 + 4 * g + 3]);
                    hi.x = pk2(U[32 + 4 * g], U[32 + 4 * g + 1]); hi.y = pk2(U[32 + 4 * g + 2], U[32 + 4 * g + 3]); hi.z = pk2(U[48 + 4 * g], U[48 + 4 * g + 1]); hi.w = pk2(U[48 + 4 * g + 2], U[48 + 4 * g + 3]);
                    v4u* dst = (v4u*)(ub + ((w8 * 64 + g * 16 + cl) * 32)); dst[0] = lo; dst[1] = hi;
                }
            } else {
#pragma unroll
                for (int i = 0; i < 64; ++i) qn[i * 136 + c] = (bf16)f2bf(U[i]);
            }
        }
        __syncthreads();
        if (live) {
#pragma unroll
            for (int fi = 0; fi < 4; ++fi) { const int f = hw * 4 + fi, mb = f >> 2, ks = f & 3, row = 16 * mb + r16;
                const v2u lo = *(const LAS v2u*)(qn + row * 136 + 32 * ks + 4 * gq), hi = *(const LAS v2u*)(qn + row * 136 + 32 * ks + 16 + 4 * gq);
                *(v4u*)(chunk + CH_WF + (f * 64 + lane) * 16) = (v4u){lo.x, lo.y, hi.x, hi.y}; }
        }
        __syncthreads();
    }
}

__device__ __forceinline__ void phase_scan(Frame& F) {
    const int bh = blockIdx.x, b = bh >> 2, h = bh & 3, w = F.wave, lane = F.lane, cl = lane & 15, gq = lane >> 4;
    const float* gtotA = (const float*)(F.ws + WS_GTOT);
    const int unit0 = bh * 64;
    const unsigned char* cbase = F.ws + WS_CHUNK + (size_t)unit0 * CH_BYTES;
    const unsigned char* ubase = F.ws + WS_UC + (size_t)unit0 * UC_BYTES + (w * 64 + lane) * 32;
    bf16* op = (bf16*)(F.ws + WS_ORAW) + ((size_t)b * SEQ + cl) * 512 + h * 128 + 16 * w + 4 * gq;
    f32x4 Sacc[8]; bf16x8 Sb[4];
#pragma unroll
    for (int d = 0; d < 8; ++d) Sacc[d] = (f32x4){0.f, 0.f, 0.f, 0.f};
#pragma unroll
    for (int k = 0; k < 4; ++k) Sb[k] = (bf16x8){0, 0, 0, 0, 0, 0, 0, 0};
#define SCAN_ISSUE(nn) do { const unsigned char* s_ = cbase + (size_t)(nn) * CH_BYTES + (w * 7) * 1024 + lane * 16; LAS unsigned char* d_ = F.lds + ((nn) & 1) * CH_BYTES + (w * 7) * 1024; \
        _Pragma("unroll") for (int k_ = 0; k_ < 7; ++k_) __builtin_amdgcn_global_load_lds((const unsigned*)(s_ + k_ * 1024), (LAS unsigned*)(d_ + k_ * 1024), 16, 0, 0); } while (0)
    SCAN_ISSUE(0);
    v4u nu0 = *(const v4u*)(ubase), nu1 = *(const v4u*)(ubase + 16);
    float ngt = gtotA[unit0];
    v2u Ow[4];
#pragma unroll
    for (int mb = 0; mb < 4; ++mb) Ow[mb] = (v2u){0u, 0u};
#pragma unroll 1
    for (int n = 0; n < 64; ++n) {
        VM_WAIT(); __syncthreads();
        const v4u cu0 = nu0, cu1 = nu1; const float gt = ngt;
        if (n + 1 < 64) { SCAN_ISSUE(n + 1); nu0 = *(const v4u*)(ubase + (size_t)(n + 1) * UC_BYTES); nu1 = *(const v4u*)(ubase + (size_t)(n + 1) * UC_BYTES + 16); ngt = gtotA[unit0 + n + 1]; }
        if (n > 0) {
#pragma unroll
            for (int mb = 0; mb < 4; ++mb) *(v2u*)(op + (size_t)((n - 1) * 64 + 16 * mb) * 512) = Ow[mb];
        }
        const LAS unsigned char* B = F.lds + (n & 1) * CH_BYTES;
#define FRAG(off, f) (*(const LAS bf16x8*)(B + (off) + ((f) * 64 + lane) * 16))
        f32x4 P[4];
#pragma unroll
        for (int mb = 0; mb < 4; ++mb) { P[mb] = (f32x4){0.f, 0.f, 0.f, 0.f};
#pragma unroll
            for (int ks = 0; ks < 4; ++ks) P[mb] = __builtin_amdgcn_mfma_f32_16x16x32_bf16(FRAG(CH_WF, mb * 4 + ks), Sb[ks], P[mb], 0, 0, 0); }
        f32x4 vnw[4];
        vnw[0] = (f32x4){bflo(cu0.x), bfhi(cu0.x), bflo(cu0.y), bfhi(cu0.y)} - P[0];
        vnw[1] = (f32x4){bflo(cu0.z), bfhi(cu0.z), bflo(cu0.w), bfhi(cu0.w)} - P[1];
        vnw[2] = (f32x4){bflo(cu1.x), bfhi(cu1.x), bflo(cu1.y), bfhi(cu1.y)} - P[2];
        vnw[3] = (f32x4){bflo(cu1.z), bfhi(cu1.z), bflo(cu1.w), bfhi(cu1.w)} - P[3];
        bf16x8 Vb[2]; Vb[0] = pack8(vnw[0], vnw[1]); Vb[1] = pack8(vnw[2], vnw[3]);
#pragma unroll
        for (int db = 0; db < 8; ++db) { Sacc[db] = Sacc[db] * gt;
#pragma unroll
            for (int ksp = 0; ksp < 2; ++ksp) Sacc[db] = __builtin_amdgcn_mfma_f32_16x16x32_bf16(FRAG(CH_KT, db * 2 + ksp), Vb[ksp], Sacc[db], 0, 0, 0); }
#pragma unroll
        for (int mb = 0; mb < 4; ++mb) { f32x4 OT = (f32x4){0.f, 0.f, 0.f, 0.f};
#pragma unroll
            for (int ks = 0; ks < 4; ++ks) OT = __builtin_amdgcn_mfma_f32_16x16x32_bf16(Sb[ks], FRAG(CH_QD, mb * 4 + ks), OT, 0, 0, 0);
#pragma unroll
            for (int ksp = 0; ksp < 2; ++ksp) OT = __builtin_amdgcn_mfma_f32_16x16x32_bf16(Vb[ksp], FRAG(CH_QK, mb * 2 + ksp), OT, 0, 0, 0);
            Ow[mb] = (v2u){cvt_pk_bf16(OT[0], OT[1]), cvt_pk_bf16(OT[2], OT[3])}; }
#pragma unroll
        for (int ks = 0; ks < 4; ++ks) Sb[ks] = pack8(Sacc[2 * ks], Sacc[2 * ks + 1]);
#undef FRAG
    }
#undef SCAN_ISSUE
#pragma unroll
    for (int mb = 0; mb < 4; ++mb) *(v2u*)(op + (size_t)(63 * 64 + 16 * mb) * 512) = Ow[mb];
    VM_WAIT(); __syncthreads();
}

__device__ __forceinline__ void phase_onorm(Frame& F) {
    const float* dnw = F.in[6]; const bf16* proj = (const bf16*)(F.ws + WS_PROJ); const bf16* oraw = (const bf16*)(F.ws + WS_ORAW); bf16* concat = (bf16*)(F.ws + WS_CONCAT);
    const int gw = F.vcu * NWAVES + F.wave, NGW = F.G * NWAVES, lane = F.lane;
    const int cc = 8 * (lane & 15);
    const f32x4 d0 = *(const f32x4*)(dnw + cc), d1 = *(const f32x4*)(dnw + cc + 4);
    for (int m = gw; m < NTOK; m += NGW) {
        const v4u o = *(const v4u*)(oraw + (size_t)m * 512 + 8 * lane);
        const v4u z = *(const v4u*)(proj + (size_t)m * NPROJ + 1536 + 8 * lane);
        const float ov[8] = {bflo(o.x), bfhi(o.x), bflo(o.y), bfhi(o.y), bflo(o.z), bfhi(o.z), bflo(o.w), bfhi(o.w)};
        const float zv[8] = {bflo(z.x), bfhi(z.x), bflo(z.y), bfhi(z.y), bflo(z.z), bfhi(z.z), bflo(z.w), bfhi(z.w)};
        float ss = 0.f;
#pragma unroll
        for (int q = 0; q < 8; ++q) ss += ov[q] * ov[q];
        ss += __shfl_xor(ss, 1); ss += __shfl_xor(ss, 2); ss += __shfl_xor(ss, 4); ss += __shfl_xor(ss, 8);
        const float rs = frsq_(ss * (1.f / 128.f) + 1e-6f);
        const float dv[8] = {d0.x, d0.y, d0.z, d0.w, d1.x, d1.y, d1.z, d1.w};
        float r[8];
#pragma unroll
        for (int q = 0; q < 8; ++q) r[q] = ov[q] * rs * dv[q] * siluf_(zv[q]);
        *(v4u*)(concat + (size_t)m * DM + 8 * lane) = (v4u){cvt_pk_bf16(r[0], r[1]), cvt_pk_bf16(r[2], r[3]), cvt_pk_bf16(r[4], r[5]), cvt_pk_bf16(r[6], r[7])};
    }
}

__device__ __forceinline__ void phase_route(Frame& F) {
    const float* x1 = F.out; const float* b_router = F.in[12];
    bf16* x1b = (bf16*)(F.ws + WS_X1B); float* rs2A = (float*)(F.ws + WS_RS2); float* gatew = (float*)(F.ws + WS_GATEW); int* list = (int*)(F.ws + WS_LIST);
    unsigned* cntw = (unsigned*)(F.ws + WS_CTL) + CW_CNT;
    LAS unsigned char* WI = F.lds;
    LAS unsigned* lcnt = (LAS unsigned*)(F.lds + TAB_OFF);
    { const v4u* src = (const v4u*)(F.ws + WS_WR);
      for (int idx = F.tid; idx < 131072 / 16; idx += 512) *(LAS v4u*)(WI + 16 * idx) = src[idx]; }
    const int lane = F.lane, c = lane & 15, g = lane >> 4;
    const int gw = F.vcu * NWAVES + F.wave, NGW = F.G * NWAVES, NT = NTOK / 16;
    const float bia0 = b_router[c], bia1 = b_router[16 + c];
    for (int t0 = 0; t0 < NT; t0 += NGW) {
        const int tile = t0 + gw; const bool live = tile < NT;
        if (F.tid < 64) lcnt[F.tid] = 0u;
        __syncthreads();
        int my_e = 0; float my_g = 0.f; unsigned my_rank = 0u; int my_ent = 0;
        if (live) {
            const int m0 = tile * 16;
            const float* xrow = x1 + (size_t)(m0 + c) * DM + 8 * g;
            bf16* xbrow = x1b + (size_t)(m0 + c) * DM + 8 * g;
            f32x4 acc0 = (f32x4){0.f, 0.f, 0.f, 0.f}, acc1 = acc0; float ssq = 0.f;
#pragma unroll 1
            for (int kb = 0; kb < 4; ++kb) {
                f32x4 xa[8], xb4[8];
#pragma unroll
                for (int q = 0; q < 8; ++q) { xa[q] = *(const f32x4*)(xrow + 32 * (kb * 8 + q)); xb4[q] = *(const f32x4*)(xrow + 32 * (kb * 8 + q) + 4); }
#pragma unroll
                for (int q = 0; q < 8; ++q) { const int ks = kb * 8 + q; const f32x4 a = xa[q], b = xb4[q];
                    ssq += (a.x * a.x + a.y * a.y) + (a.z * a.z + a.w * a.w) + (b.x * b.x + b.y * b.y) + (b.z * b.z + b.w * b.w);
                    v4u h; h.x = cvt_pk_bf16(a.x, a.y); h.y = cvt_pk_bf16(a.z, a.w); h.z = cvt_pk_bf16(b.x, b.y); h.w = cvt_pk_bf16(b.z, b.w);
                    v4u l; l.x = cvt_pk_bf16(a.x - bflo(h.x), a.y - bfhi(h.x)); l.y = cvt_pk_bf16(a.z - bflo(h.y), a.w - bfhi(h.y)); l.z = cvt_pk_bf16(b.x - bflo(h.z), b.y - bfhi(h.z)); l.w = cvt_pk_bf16(b.z - bflo(h.w), b.w - bfhi(h.w));
                    *(v4u*)(xbrow + 32 * ks) = h;
                    const bf16x8 ah = __builtin_bit_cast(bf16x8, h), al = __builtin_bit_cast(bf16x8, l);
                    const LAS unsigned char* fb = WI + (size_t)(ks * 4) * 1024 + lane * 16;
                    const bf16x8 b0h = *(const LAS bf16x8*)(fb), b0l = *(const LAS bf16x8*)(fb + 1024), b1h = *(const LAS bf16x8*)(fb + 2048), b1l = *(const LAS bf16x8*)(fb + 3072);
                    acc0 = __builtin_amdgcn_mfma_f32_16x16x32_bf16(ah, b0h, acc0, 0, 0, 0); acc0 = __builtin_amdgcn_mfma_f32_16x16x32_bf16(ah, b0l, acc0, 0, 0, 0); acc0 = __builtin_amdgcn_mfma_f32_16x16x32_bf16(al, b0h, acc0, 0, 0, 0);
                    acc1 = __builtin_amdgcn_mfma_f32_16x16x32_bf16(ah, b1h, acc1, 0, 0, 0); acc1 = __builtin_amdgcn_mfma_f32_16x16x32_bf16(ah, b1l, acc1, 0, 0, 0); acc1 = __builtin_amdgcn_mfma_f32_16x16x32_bf16(al, b1h, acc1, 0, 0, 0); }
            }
            ssq += __shfl_xor(ssq, 16); ssq += __shfl_xor(ssq, 32);
            const float rsr = frsq_(ssq * (1.f / DM) + 1e-6f);
            if (g == 0) rs2A[m0 + c] = rsr;
            float ge_[4]; int ee_[4];
#pragma unroll
            for (int reg = 0; reg < 4; ++reg) {
                const float rsw = __shfl(rsr, 4 * g + reg);
                float v0 = acc0[reg] * rsw + bia0, v1 = acc1[reg] * rsw + bia1;
                float tv[4]; int te[4];
#pragma unroll
                for (int s = 0; s < 4; ++s) {
                    float bv; int bi; if (v1 > v0) { bv = v1; bi = 16 + c; } else { bv = v0; bi = c; }
#pragma unroll
                    for (int o = 1; o < 16; o <<= 1) { const float ov = __shfl_xor(bv, o); const int oi = __shfl_xor(bi, o); if (ov > bv || (ov == bv && oi < bi)) { bv = ov; bi = oi; } }
                    tv[s] = bv; te[s] = bi; if (bi == c) v0 = -3.0e38f; if (bi == 16 + c) v1 = -3.0e38f;
                }
                const float e1 = fexp_(tv[1] - tv[0]), e2 = fexp_(tv[2] - tv[0]), e3 = fexp_(tv[3] - tv[0]); const float inv = frcp_(1.f + e1 + e2 + e3);
                const int s_ = c & 3; const float gsel = (s_ == 0 ? 1.f : s_ == 1 ? e1 : s_ == 2 ? e2 : e3) * inv; const int esel = s_ == 0 ? te[0] : s_ == 1 ? te[1] : s_ == 2 ? te[2] : te[3];
                ge_[reg] = gsel; ee_[reg] = esel;
            }
            const int rsel = c >> 2;
            my_g = rsel == 0 ? ge_[0] : rsel == 1 ? ge_[1] : rsel == 2 ? ge_[2] : ge_[3];
            my_e = rsel == 0 ? ee_[0] : rsel == 1 ? ee_[1] : rsel == 2 ? ee_[2] : ee_[3];
            my_ent = (m0 + 4 * g + rsel) * 4 + (c & 3);
            my_rank = __hip_atomic_fetch_add(lcnt + my_e, 1u, __ATOMIC_RELAXED, __HIP_MEMORY_SCOPE_WORKGROUP);
        }
        __syncthreads();
        if (F.tid < NE) { const unsigned n = lcnt[F.tid]; lcnt[32 + F.tid] = n ? __hip_atomic_fetch_add(cntw + 64 * F.tid, n, RLX_AGENT) : 0u; }
        __syncthreads();
        if (live) { const unsigned pos = lcnt[32 + my_e] + my_rank; list[(size_t)my_e * LISTCAP + pos] = my_ent; gatew[my_ent] = my_g; }
        __syncthreads();
    }
}

__device__ __forceinline__ int moe_tables(Frame& F, MoeTab& T) {
    LAS int* pref = (LAS int*)(F.lds + TAB_OFF); LAS int* cnt = pref + 40;
    unsigned* cntw = (unsigned*)(F.ws + WS_CTL) + CW_CNT;
    if (F.tid == 0) { int acc = 0; for (int e = 0; e < NE; ++e) { const int c = (int)__hip_atomic_load(cntw + 64 * e, RLX_AGENT); cnt[e] = c; pref[e] = acc; acc += (c + 255) >> 8; } pref[NE] = acc; }
    __syncthreads();
    T.pref = pref; T.cnt = cnt;
    return pref[NE];
}

__device__ __forceinline__ void phase_final(Frame& F) {
    const float* fw = F.in[17]; const bf16* slab = (const bf16*)(F.ws + WS_SLAB); float* out = F.out;
    const int gw = F.vcu * NWAVES + F.wave, NGW = F.G * NWAVES, lane = F.lane;
    f32x4 wv[4];
#pragma unroll
    for (int j = 0; j < 2; ++j) { wv[2 * j] = *(const f32x4*)(fw + 512 * j + 8 * lane); wv[2 * j + 1] = *(const f32x4*)(fw + 512 * j + 8 * lane + 4); }
    for (int m = gw; m < NTOK; m += NGW) {
        float* orow = out + (size_t)m * DM + 8 * lane;
        f32x4 v[4]; v4u sl[4][2];
#pragma unroll
        for (int j = 0; j < 2; ++j) { v[2 * j] = *(const f32x4*)(orow + 512 * j); v[2 * j + 1] = *(const f32x4*)(orow + 512 * j + 4); }
#pragma unroll
        for (int s = 0; s < 4; ++s)
#pragma unroll
            for (int j = 0; j < 2; ++j) sl[s][j] = *(const v4u*)(slab + ((size_t)m * 4 + s) * DM + 512 * j + 8 * lane);
#pragma unroll
        for (int s = 0; s < 4; ++s)
#pragma unroll
            for (int j = 0; j < 2; ++j) { const v4u u = sl[s][j];
                v[2 * j].x += bflo(u.x); v[2 * j].y += bfhi(u.x); v[2 * j].z += bflo(u.y); v[2 * j].w += bfhi(u.y);
                v[2 * j + 1].x += bflo(u.z); v[2 * j + 1].y += bfhi(u.z); v[2 * j + 1].z += bflo(u.w); v[2 * j + 1].w += bfhi(u.w); }
        float ss = 0.f;
#pragma unroll
        for (int j = 0; j < 4; ++j) ss += (v[j].x * v[j].x + v[j].y * v[j].y) + (v[j].z * v[j].z + v[j].w * v[j].w);
        ss = wave_sum(ss);
        const float rs = frsq_(ss * (1.f / DM) + 1e-6f);
#pragma unroll
        for (int j = 0; j < 2; ++j) { *(f32x4*)(orow + 512 * j) = v[2 * j] * rs * wv[2 * j]; *(f32x4*)(orow + 512 * j + 4) = v[2 * j + 1] * rs * wv[2 * j + 1]; }
    }
}

struct Args { const float* in[18]; float* out; unsigned char* ws; int ph_lo, ph_hi; };
constexpr int NPHASE = 11;

__global__ void __launch_bounds__(NWAVES * 64, 2) mk_fwd(Args args) {
    extern __shared__ __attribute__((aligned(16))) unsigned char lds_raw[];
    Frame F;
    F.lds = (LAS unsigned char*)lds_raw;
    F.tid = threadIdx.x; F.lane = F.tid & 63; F.wave = __builtin_amdgcn_readfirstlane(F.tid >> 6);
    F.G = gridDim.x; { const int bx = blockIdx.x; F.vcu = (F.G % 8 == 0) ? (bx % 8) * (F.G / 8) + bx / 8 : bx; }
#pragma unroll
    for (int i = 0; i < 18; ++i) F.in[i] = args.in[i];
    F.out = args.out; F.ws = args.ws;
    volatile LAS unsigned* MISC = (volatile LAS unsigned*)(F.lds + MISC_OFF);
    for (int u = F.tid; u < (LDS_BYTES - LDSCTL_OFF) / 4; u += NWAVES * 64) ((LAS unsigned*)(F.lds + LDSCTL_OFF))[u] = 0u;
    __syncthreads();
    unsigned* ctl = (unsigned*)(F.ws + WS_CTL);
#if !MK_PER_PHASE
    XcdBarrier bar = xcd_barrier_post(ctl + CW_BAR, MISC + 8);
#define GRID_BAR() xcd_barrier(bar)
#else
#define GRID_BAR() do {} while (0)
#endif
    const int lo = args.ph_lo, hi = args.ph_hi;
#define IN(k) (lo <= (k) && (k) < hi)
#define SEAM(k) do { if (IN(k) && IN((k) + 1)) GRID_BAR(); } while (0)

#define RUNPH(k, ...) do { if (IN(k)) { __VA_ARGS__; } SEAM(k); } while (0)
    RUNPH(0, phase_prep(F));
    RUNPH(1, {
        ProbIn P; P.K = DM; P.S.init(NTOK / 256, NPROJ / 256, F.G, (int)blockIdx.x);
        P.A = (const bf16*)(F.ws + WS_XB); P.Bt = (const bf16*)(F.ws + WS_WIN); P.O = (bf16*)(F.ws + WS_PROJ); P.rs = (const float*)(F.ws + WS_RS1);
        pg8::gemm_phase(F.lds, P); });
    if (IN(2)) { phase_mix(F); __syncthreads(); }
    RUNPH(3, phase_chunk(F));
    RUNPH(4, {
        const int nscan = NB * NH;
        if ((int)blockIdx.x < nscan) phase_scan(F);
        else { ProbPool P; P.K = 512; P.S.init(NTOK / 256, 2, F.G - nscan, (int)blockIdx.x - nscan);
               P.A = (const bf16*)(F.ws + WS_MIXED); P.Bt = (const bf16*)(F.ws + WS_WPOOL); P.O = (bf16*)(F.ws + WS_CONCAT);
               pg8::gemm_phase(F.lds, P); } });
    RUNPH(5, phase_onorm(F));
    RUNPH(6, {
        ProbOut P; P.K = DM; P.S.init(NTOK / 256, DM / 256, F.G, (int)blockIdx.x);
        P.A = (const bf16*)(F.ws + WS_CONCAT); P.Bt = (const bf16*)(F.ws + WS_WOUT); P.X = F.in[0]; P.O = F.out;
        pg8::gemm_phase(F.lds, P); });
    RUNPH(7, phase_route(F));
    RUNPH(8, {
        ProbGU P; const int RT = moe_tables(F, P.T);
        P.K = DM; P.S.init(RT, 8, F.G, (int)blockIdx.x);
        P.A = (const bf16*)(F.ws + WS_X1B); P.Bt = (const bf16*)(F.ws + WS_WGU); P.O = (bf16*)(F.ws + WS_ACT); P.list = (const int*)(F.ws + WS_LIST);
        P.rs2 = (const float*)(F.ws + WS_RS2); P.bgu = (const float*)(F.ws + WS_BGU);
        pg8::gemm_phase(F.lds, P); });
    RUNPH(9, {
        ProbDown P; const int RT = moe_tables(F, P.T);
        P.K = DE; P.S.init(RT, 4, F.G, (int)blockIdx.x);
        P.A = (const bf16*)(F.ws + WS_ACT); P.Bt = (const bf16*)(F.ws + WS_WD); P.O = (bf16*)(F.ws + WS_SLAB); P.list = (const int*)(F.ws + WS_LIST);
        P.gw = (const float*)(F.ws + WS_GATEW); P.bd = F.in[16];
        pg8::gemm_phase(F.lds, P); });
    RUNPH(10, phase_final(F));
#undef RUNPH
#undef IN
#undef SEAM
}

extern "C" void kernel_launch(void* const* d_in, const int* in_sizes, int n_in, void* d_out, int out_size, void* d_ws, size_t ws_size, hipStream_t stream) {
    static int grid = 0;
    if (grid == 0) {
        if (n_in != 18 || in_sizes[0] != NTOK * DM || out_size != NTOK * DM || ws_size < WS_END) { fprintf(stderr, "kernel_launch: unexpected shapes (n_in %d, in0 %d, out %d, ws %zu)\n", n_in, n_in > 0 ? in_sizes[0] : -1, out_size, ws_size); grid = -1; return; }
        int dev = 0, cus = 0, per_cu = 0;
        if (hipGetDevice(&dev) != hipSuccess || hipDeviceGetAttribute(&cus, hipDeviceAttributeMultiprocessorCount, dev) != hipSuccess) { grid = -1; return; }
        if (hipFuncSetAttribute((const void*)mk_fwd, hipFuncAttributeMaxDynamicSharedMemorySize, LDS_BYTES) != hipSuccess) { fprintf(stderr, "kernel_launch: hipFuncSetAttribute failed\n"); grid = -1; return; }
        if (hipOccupancyMaxActiveBlocksPerMultiprocessor(&per_cu, (const void*)mk_fwd, NWAVES * 64, LDS_BYTES) != hipSuccess || per_cu < 1) { fprintf(stderr, "kernel_launch: occupancy query says %d\n", per_cu); per_cu = 1; }
        (void)hipGetLastError();
        grid = cus;
    }
    if (grid < 0) return;
    (void)hipMemsetAsync((char*)d_ws + WS_CTL, 0, CTL_ZERO_BYTES, stream);
    Args a{};
    for (int i = 0; i < 18; ++i) a.in[i] = (const float*)d_in[i];
    a.out = (float*)d_out; a.ws = (unsigned char*)d_ws;
#if MK_PER_PHASE
    for (int p = 0; p < NPHASE; ++p) { a.ph_lo = p; a.ph_hi = p + 1; const int nrep = 1 + REP_CNT * ((REP_MASK >> p) & 1);
        for (int r = 0; r < nrep; ++r) hipLaunchKernelGGL(mk_fwd, dim3(grid), dim3(NWAVES * 64), LDS_BYTES, stream, a); }
#else
    a.ph_lo = 0; a.ph_hi = NPHASE;
    hipLaunchKernelGGL(mk_fwd, dim3(grid), dim3(NWAVES * 64), LDS_BYTES, stream, a);
#endif
}
```

```cpp
#include <hip/hip_runtime.h>
#include <cstdio>
#include <cstdint>

#ifndef REP_MASK
#define REP_MASK 0
#endif
#ifndef REP_CNT
#define REP_CNT 1
#endif
#ifndef MK_PER_PHASE
#define MK_PER_PHASE 0
#endif

constexpr int NB = 8, SEQ = 4096, DM = 1024, NTOK = NB * SEQ;
constexpr int NH = 4, HD = 128, DDN = 512, DPOOL = 512, DIN = 2568, NPROJ = 2560;
constexpr int NE = 32, TOPK = 4, DE = 1024, NASSIGN = NTOK * TOPK;
constexpr int LISTCAP = NTOK;
constexpr int ACT_ROWS = NASSIGN + NE * 256;

constexpr size_t MiB = 1u << 20;
constexpr size_t WS_CTL = 0, CTL_ZERO_BYTES = 1 * MiB;
constexpr size_t WS_WIN = 1 * MiB;
constexpr size_t WS_WOUT = 6 * MiB;
constexpr size_t WS_WPOOL = 8 * MiB;
constexpr size_t WS_WR = 8 * MiB + 512 * 1024;
constexpr size_t WS_BGU = 8 * MiB + 768 * 1024;
constexpr size_t WS_RS1 = 9 * MiB;
constexpr size_t WS_BETA = 9 * MiB + 128 * 1024;
constexpr size_t WS_G = 9 * MiB + 640 * 1024;
constexpr size_t WS_RS2 = 10 * MiB + 256 * 1024;
constexpr size_t WS_GATEW = 10 * MiB + 512 * 1024;
constexpr size_t WS_LIST = 11 * MiB;
constexpr size_t WS_WGU = 16 * MiB;
constexpr size_t WS_WD = 144 * MiB;
constexpr size_t WS_XB = 208 * MiB;
constexpr size_t WS_PROJ = 272 * MiB;
constexpr size_t WS_CHUNK = 432 * MiB;
constexpr size_t WS_UC = 544 * MiB;
constexpr size_t WS_GTOT = 576 * MiB;
constexpr size_t WS_ORAW = 577 * MiB;
constexpr int CH_WF = 0, CH_QD = 16384, CH_KT = 32768, CH_QK = 49152, CH_BYTES = 57344, UC_BYTES = 16384;
constexpr size_t WS_MIXED = 688 * MiB;
constexpr size_t WS_CONCAT = 720 * MiB;
constexpr size_t WS_X1B = 208 * MiB;
constexpr size_t WS_ACT = 272 * MiB;
constexpr size_t WS_SLAB = 544 * MiB;
constexpr size_t WS_END = 800 * MiB;
static_assert(WS_ACT + (size_t)ACT_ROWS * 2048 <= WS_SLAB, "act fits");
static_assert(WS_SLAB + (size_t)NASSIGN * 2048 <= WS_END, "slab fits");

constexpr int CW_BAR = 4096;
constexpr int CW_CNT = 16384;

constexpr int LDS_BYTES = 147456;
constexpr int LDSCTL_OFF = LDS_BYTES - 1024, MISC_OFF = LDSCTL_OFF + 320, TAB_OFF = LDSCTL_OFF + 512;
constexpr int NWAVES = 8;

#define GAS __attribute__((address_space(1)))
#define LAS __attribute__((address_space(3)))
typedef unsigned short bf16;
typedef unsigned v4u __attribute__((ext_vector_type(4)));
typedef unsigned v2u __attribute__((ext_vector_type(2)));
typedef float f32x4 __attribute__((ext_vector_type(4)));
typedef float f32x2 __attribute__((ext_vector_type(2)));
typedef short bf16x8 __attribute__((ext_vector_type(8)));
typedef GAS unsigned gu32;
#define RLX_AGENT __ATOMIC_RELAXED, __HIP_MEMORY_SCOPE_AGENT
#define LDS_WAIT() asm volatile("s_waitcnt lgkmcnt(0)" ::: "memory")
#define VM_WAIT() asm volatile("s_waitcnt vmcnt(0)" ::: "memory")

__device__ __forceinline__ unsigned f2bf(float f) { unsigned u = __builtin_bit_cast(unsigned, f); return (u + 0x7fffu + ((u >> 16) & 1u)) >> 16; }
__device__ __forceinline__ unsigned pk2(float lo, float hi) { return f2bf(lo) | (f2bf(hi) << 16); }
__device__ __forceinline__ float bflo(unsigned u) { return __builtin_bit_cast(float, u << 16); }
__device__ __forceinline__ float bfhi(unsigned u) { return __builtin_bit_cast(float, u & 0xffff0000u); }
__device__ __forceinline__ float wave_sum(float v) {
#pragma unroll
    for (int o = 1; o < 64; o <<= 1) v += __shfl_xor(v, o);
    return v;
}
__device__ __forceinline__ float frcp_(float x) { return __builtin_amdgcn_rcpf(x); }
__device__ __forceinline__ float frsq_(float x) { return __builtin_amdgcn_rsqf(x); }
__device__ __forceinline__ float fexp_(float x) { return __builtin_amdgcn_exp2f(x * 1.4426950408889634f); }
__device__ __forceinline__ float sigmoidf_(float x) { return frcp_(1.f + fexp_(-x)); }
__device__ __forceinline__ float siluf_(float x) { return x * frcp_(1.f + fexp_(-x)); }

namespace pg8 {
constexpr int BM = 256, BK = 64, HALF = 128, HTB = HALF * BK * 2, STAGE_BYTES = 8 * HTB;
__device__ __forceinline__ int lds_byte(int r, int c) { const int st = (r >> 4) * 2 + (c >> 5), rr = r & 15, cc = c & 31, ob = rr * 64 + cc * 2; return st * 1024 + (ob ^ (((ob >> 9) & 1) << 5)); }
__device__ __forceinline__ void stage_rc(int b, int& R, int& C) { const int st = b / 1024, sb = b % 1024, swz = sb ^ (((sb >> 9) & 1) << 5); R = (st >> 1) * 16 + swz / 64; C = (st & 1) * 32 + (swz % 64) / 2; }
__device__ __forceinline__ int perm32(int rho) { const int n = rho >> 4, i = rho & 15; return 8 * (i >> 2) + 4 * n + (i & 3); }
typedef __bf16 bf16x2_t __attribute__((ext_vector_type(2)));
__device__ __forceinline__ unsigned cvt_pk_bf16(float lo, float hi) { const f32x2 v = {lo, hi}; const bf16x2_t b = __builtin_convertvector(v, bf16x2_t); return __builtin_bit_cast(unsigned, b); }

struct Unit { int rt, pn, e, rb, rows; };

struct Sched {
    int nM, nN, nwg, G, c;
    __device__ __forceinline__ void init(int nM_, int nN_, int G_, int c_) { nM = nM_; nN = nN_; nwg = nM * nN; G = G_; c = c_; }
    __device__ __forceinline__ bool next(int i, int& pm, int& pn) const {
        const long L = (long)i * G + c; if (L >= nwg) return false;
        int wgid = (int)L; { const int q = nwg / 8, r = nwg % 8, xcd = wgid % 8, off = wgid / 8; wgid = (xcd < r ? xcd * (q + 1) : r * (q + 1) + (xcd - r) * q) + off; }
        const int nig = 8 * nN, gid = wgid / nig, fm = gid * 8, gsz = (nM - fm) < 8 ? (nM - fm) : 8;
        pm = fm + ((wgid % nig) % gsz); pn = (wgid % nig) / gsz; return true;
    }
};

template <class P>
__device__ __forceinline__ void gemm_phase(LAS unsigned char* lds, const P& p) {
    const int tid = threadIdx.x, wid = __builtin_amdgcn_readfirstlane(tid >> 6), lane = tid & 63, wr = wid >> 2, wc = wid & 3, fr = lane & 15, fq = lane >> 4;
    const int K = p.K, nt = K / BK;
    int R[2], C[2]; unsigned voffB[2];
#pragma unroll
    for (int i = 0; i < 2; ++i) { stage_rc(tid * 16 + i * 8192, R[i], C[i]); const int Rb = (R[i] & ~31) + perm32(R[i] & 31); voffB[i] = (unsigned)(Rb * K + C[i]) * 2u; }
    const size_t kstep = (size_t)(BK * 2);
    const size_t hstep = (size_t)HALF * K * 2;
    const unsigned ldsw = (unsigned)wid * 1024u;
    const int aoff = lds_byte(wr * 64 + fr, fq * 8), boff = lds_byte(wc * 32 + fr, fq * 8);
#define PG8_SA(b, h) (((b) * 2 + (h)) * HTB)
#define PG8_SB(b, h) ((4 + (b) * 2 + (h)) * HTB)
#define PG8_STAGE(bufoff, gbase, voff) do { _Pragma("unroll") for (int _i = 0; _i < 2; ++_i) \
        __builtin_amdgcn_global_load_lds((const unsigned*)((const char*)(gbase) + (voff)[_i]), (LAS unsigned*)(lds + (bufoff) + ldsw + _i * 8192), 16, 0, 0); } while (0)
#define PG8_LDA(dst, b, h) do { _Pragma("unroll") for (int m = 0; m < 4; ++m) _Pragma("unroll") for (int k = 0; k < 2; ++k) dst[m][k] = *(const LAS bf16x8*)(lds + PG8_SA(b, h) + aoff + m * 2048 + k * 1024); } while (0)
#define PG8_LDB(dst, b, h) do { _Pragma("unroll") for (int n = 0; n < 2; ++n) _Pragma("unroll") for (int k = 0; k < 2; ++k) dst[n][k] = *(const LAS bf16x8*)(lds + PG8_SB(b, h) + boff + n * 2048 + k * 1024); } while (0)
#define PG8_MMA(ai, bj, At, Bt) do { __builtin_amdgcn_s_setprio(1); _Pragma("unroll") for (int m = 0; m < 4; ++m) _Pragma("unroll") for (int n = 0; n < 2; ++n) _Pragma("unroll") for (int k = 0; k < 2; ++k) \
        acc[ai][bj][m][n] = __builtin_amdgcn_mfma_f32_16x16x32_bf16(Bt[n][k], At[m][k], acc[ai][bj][m][n], 0, 0, 0); __builtin_amdgcn_s_setprio(0); } while (0)
#define PG8_WAIT_V(n) asm volatile("s_waitcnt vmcnt(" #n ")" ::: "memory")
#define PG8_WAIT_L(n) asm volatile("s_waitcnt lgkmcnt(" #n ")" ::: "memory")
#define PG8_BAR __builtin_amdgcn_s_barrier()
#define PG8_SCHED __builtin_amdgcn_sched_barrier(0)
    Unit cur, nxt; int ui = 0;
    if (!p.next(0, cur)) return;
    f32x4 acc[2][2][4][2];
#pragma unroll
    for (int a = 0; a < 2; ++a)
#pragma unroll
        for (int b = 0; b < 2; ++b)
#pragma unroll
            for (int m = 0; m < 4; ++m)
#pragma unroll
                for (int n = 0; n < 2; ++n) acc[a][b][m][n] = (f32x4){0.f, 0.f, 0.f, 0.f};
    bf16x8 At[4][2], B0[2][2], B1[2][2];
    unsigned oA[2][2], nO[2][2];
    p.a_off(cur, R, C, oA);
    const char* cA = p.a_base(cur); const char* cB = p.b_base(cur);
    PG8_STAGE(PG8_SB(0, 0), cB, voffB); PG8_STAGE(PG8_SB(0, 1), cB + hstep, voffB); PG8_STAGE(PG8_SA(0, 0), cA, oA[0]); PG8_STAGE(PG8_SA(0, 1), cA, oA[1]);
    if (wr == 1) PG8_BAR;
    PG8_WAIT_V(2); PG8_BAR;
    PG8_STAGE(PG8_SB(1, 0), cB + kstep, voffB); PG8_STAGE(PG8_SA(1, 0), cA + kstep, oA[0]); PG8_STAGE(PG8_SB(1, 1), cB + hstep + kstep, voffB);
    PG8_WAIT_V(6); PG8_BAR;
    for (;;) {
        const bool has_next = p.next(ui + 1, nxt);
        const char* nA = cA; const char* nB = cB;
#pragma unroll
        for (int h = 0; h < 2; ++h)
#pragma unroll
            for (int i = 0; i < 2; ++i) nO[h][i] = oA[h][i];
        if (has_next) { nA = p.a_base(nxt); nB = p.b_base(nxt); p.a_off(nxt, R, C, nO); }
        asm volatile("" : "+v"(nO[0][0]), "+v"(nO[0][1]), "+v"(nO[1][0]), "+v"(nO[1][1]));
        for (int t = 0; t < nt; t += 2) {
            const bool last = (t == nt - 2);
            const char* a1 = cA + (size_t)(t + 1) * kstep;
            const char* a2 = last ? nA : cA + (size_t)(t + 2) * kstep; const char* b2 = last ? nB : cB + (size_t)(t + 2) * kstep;
            const char* a3 = a2 + kstep; const char* b3 = b2 + kstep;
            unsigned o2[2][2];
#pragma unroll
            for (int h = 0; h < 2; ++h)
#pragma unroll
                for (int i = 0; i < 2; ++i) o2[h][i] = last ? nO[h][i] : oA[h][i];
            PG8_LDB(B0, 0, 0); PG8_LDB(B1, 0, 1); PG8_SCHED; PG8_LDA(At, 0, 0); PG8_STAGE(PG8_SA(1, 1), a1, oA[1]);
            PG8_WAIT_V(8); PG8_WAIT_L(0); PG8_BAR; PG8_MMA(0, 0, At, B0); PG8_MMA(0, 1, At, B1); PG8_BAR; PG8_SCHED;
            PG8_LDA(At, 0, 1); PG8_STAGE(PG8_SB(0, 0), b2, voffB); PG8_STAGE(PG8_SB(0, 1), b2 + hstep, voffB); PG8_STAGE(PG8_SA(0, 0), a2, o2[0]);
            PG8_WAIT_V(8); PG8_WAIT_L(0); PG8_BAR; PG8_MMA(1, 0, At, B0); PG8_MMA(1, 1, At, B1); PG8_BAR; PG8_SCHED;
            PG8_LDB(B0, 1, 0); PG8_LDB(B1, 1, 1); PG8_SCHED; PG8_LDA(At, 1, 0); PG8_STAGE(PG8_SA(0, 1), a2, o2[1]);
            PG8_WAIT_V(8); PG8_WAIT_L(0); PG8_BAR; PG8_MMA(0, 0, At, B0); PG8_MMA(0, 1, At, B1); PG8_BAR; PG8_SCHED;
            PG8_LDA(At, 1, 1); PG8_STAGE(PG8_SB(1, 0), b3, voffB); PG8_STAGE(PG8_SB(1, 1), b3 + hstep, voffB); PG8_STAGE(PG8_SA(1, 0), a3, o2[0]);
            PG8_WAIT_V(8); PG8_WAIT_L(0); PG8_BAR; PG8_MMA(1, 0, At, B0); PG8_MMA(1, 1, At, B1); PG8_BAR; PG8_SCHED;
        }
        if (wr == 0) PG8_BAR;
        p.epi(acc, cur, wr, wc, fr, fq);
        if (!has_next) break;
#pragma unroll
        for (int a = 0; a < 2; ++a)
#pragma unroll
            for (int b = 0; b < 2; ++b)
#pragma unroll
                for (int m = 0; m < 4; ++m)
#pragma unroll
                    for (int n = 0; n < 2; ++n) acc[a][b][m][n] = (f32x4){0.f, 0.f, 0.f, 0.f};
        cur = nxt; cA = nA; cB = nB; ++ui;
#pragma unroll
        for (int h = 0; h < 2; ++h)
#pragma unroll
            for (int i = 0; i < 2; ++i) oA[h][i] = nO[h][i];
        if (wr == 1) PG8_BAR;
    }
    PG8_WAIT_V(0);
    PG8_BAR;
#undef PG8_SA
#undef PG8_SB
#undef PG8_STAGE
#undef PG8_LDA
#undef PG8_LDB
#undef PG8_MMA
#undef PG8_WAIT_V
#undef PG8_WAIT_L
#undef PG8_BAR
#undef PG8_SCHED
}
}

#define XB_TMO      128
#define XB_XCNT(j)  (256  + 64 * (j))
#define XB_XSUB(j)  (1280 + 64 * (j))
#define XB_XGEN(j)  (2304 + 64 * (j))
#define XB_TOP      3328
#define XB_TOPGEN   3392
#define XCD_BAR_WORDS 3456
#define XB_SPIN_CAP (1u << 18)
__device__ __forceinline__ unsigned xb_ld(unsigned* p)              { return __hip_atomic_load(p, __ATOMIC_RELAXED, __HIP_MEMORY_SCOPE_AGENT); }
__device__ __forceinline__ unsigned xb_add(unsigned* p, unsigned v) { return __hip_atomic_fetch_add(p, v, __ATOMIC_RELAXED, __HIP_MEMORY_SCOPE_AGENT); }
__device__ __forceinline__ unsigned xb_xcc_id() { return (unsigned)__builtin_amdgcn_s_getreg((3 << 11) | 20) & 0xFu; }
#define XB_SPIN(cond, bar) do { unsigned _sp = 0; while (cond) { __builtin_amdgcn_s_sleep(1); \
    if ((++_sp & 255u) == 0u) { if (xb_ld(&(bar)[XB_TMO])) break; if (_sp > XB_SPIN_CAP) { atomicAdd(&(bar)[XB_TMO], 1u); break; } } } } while (0)
struct XcdBarrier { unsigned* bar; unsigned x; volatile LAS unsigned* st; };
__device__ __forceinline__ XcdBarrier xcd_barrier_post(unsigned* bar, volatile LAS unsigned* st) {
    XcdBarrier b; b.bar = bar; b.x = xb_xcc_id(); b.st = st;
    if (threadIdx.x == 0) (void)xb_add(&bar[XB_XCNT(b.x)], 1u);
    return b;
}
__device__ __forceinline__ void xcd_barrier_complete(unsigned* bar, unsigned x, unsigned& nloc, unsigned& nx) {
    const unsigned G = gridDim.x * gridDim.y * gridDim.z;
    unsigned sum, cnt, mine, sp = 0u;
    for (;;) {
        sum = 0u; cnt = 0u; mine = 0u;
#pragma unroll
        for (unsigned j = 0; j < 16; ++j) { const unsigned c = xb_ld(&bar[XB_XCNT(j)]); sum += c; cnt += (c > 0u) ? 1u : 0u; mine = (j == x) ? c : mine; }
        if (sum == G) break;
        __builtin_amdgcn_s_sleep(1);
        if ((++sp & 255u) == 0u) { if (xb_ld(&bar[XB_TMO])) break; if (sp > XB_SPIN_CAP) { atomicAdd(&bar[XB_TMO], 1u); break; } }
    }
    nloc = mine > 0u ? mine : 1u; nx = cnt > 0u ? cnt : 1u;
}
__device__ __forceinline__ void xcd_barrier(const XcdBarrier& b) {
    asm volatile("s_waitcnt vmcnt(0)" ::: "memory");
    __syncthreads();
    if (threadIdx.x == 0) {
        unsigned* bar = b.bar;
        __builtin_amdgcn_s_waitcnt(0);
        unsigned nloc = b.st[0], nx = b.st[1];
        if (nloc == 0u) { xcd_barrier_complete(bar, b.x, nloc, nx); b.st[0] = nloc; b.st[1] = nx; }
        const unsigned old = xb_add(&bar[XB_XSUB(b.x)], 1u);
        const unsigned gen = old / nloc;
        if (old + 1u == (gen + 1u) * nloc) {
            __builtin_amdgcn_fence(__ATOMIC_RELEASE, "agent");
            asm volatile("s_waitcnt vmcnt(0)" ::: "memory");
            const unsigned og = xb_add(&bar[XB_TOP], 1u);
            const unsigned tg = og / nx;
            if (og + 1u == (tg + 1u) * nx) xb_add(&bar[XB_TOPGEN], 1u);
            else XB_SPIN(xb_ld(&bar[XB_TOPGEN]) == tg, bar);
            __builtin_amdgcn_fence(__ATOMIC_ACQUIRE, "agent");
            xb_add(&bar[XB_XGEN(b.x)], 1u);
            asm volatile("s_waitcnt vmcnt(0)" ::: "memory");
        } else {
            XB_SPIN(xb_ld(&bar[XB_XGEN(b.x)]) == gen, bar);
            __builtin_amdgcn_fence(__ATOMIC_ACQUIRE, "agent");
            asm volatile("s_waitcnt vmcnt(0)" ::: "memory");
        }
    }
    __syncthreads();
}

struct Frame {
    LAS unsigned char* lds;
    int tid, lane, wave, vcu, G;
    const float* in[18];
    float* out;
    unsigned char* ws;
};
using pg8::Unit;
using pg8::cvt_pk_bf16;

struct ProbBase {
    int K; pg8::Sched S;
    __device__ __forceinline__ void lin_off(const int (&R)[2], const int (&C)[2], unsigned (&off)[2][2]) const {
#pragma unroll
        for (int h = 0; h < 2; ++h)
#pragma unroll
            for (int i = 0; i < 2; ++i) off[h][i] = (unsigned)((h * 128 + R[i]) * K + C[i]) * 2u;
    }
};
struct ProbIn : ProbBase {
    const bf16* A; const bf16* Bt; bf16* O; const float* rs;
    __device__ __forceinline__ bool next(int i, Unit& u) const { int pm, pn; if (!S.next(i, pm, pn)) return false; u.rt = pm; u.pn = pn; u.e = 0; u.rb = pm; u.rows = 256; return true; }
    __device__ __forceinline__ const char* a_base(const Unit& u) const { return (const char*)A + (size_t)u.rt * 256 * K * 2; }
    __device__ __forceinline__ const char* b_base(const Unit& u) const { return (const char*)Bt + (size_t)u.pn * 256 * K * 2; }
    __device__ __forceinline__ void a_off(const Unit&, const int (&R)[2], const int (&C)[2], unsigned (&off)[2][2]) const { lin_off(R, C, off); }
    __device__ __forceinline__ void epi(const f32x4 (&acc)[2][2][4][2], const Unit& u, int wr, int wc, int fr, int fq) const {
        const int row0 = u.rt * 256 + wr * 64 + fr, col0 = u.pn * 256 + wc * 32 + 8 * fq;
#pragma unroll
        for (int ai = 0; ai < 2; ++ai)
#pragma unroll
            for (int m = 0; m < 4; ++m) { const int row = row0 + ai * 128 + m * 16; const float sc = rs[row]; bf16* rowp = O + (size_t)row * NPROJ + col0;
#pragma unroll
                for (int bj = 0; bj < 2; ++bj) { const f32x4 v0 = acc[ai][bj][m][0] * sc, v1 = acc[ai][bj][m][1] * sc; v4u w;
                    w.x = cvt_pk_bf16(v0[0], v0[1]); w.y = cvt_pk_bf16(v0[2], v0[3]); w.z = cvt_pk_bf16(v1[0], v1[1]); w.w = cvt_pk_bf16(v1[2], v1[3]);
                    *(v4u*)(rowp + bj * 128) = w; } }
    }
};
struct ProbPool : ProbBase {
    const bf16* A; const bf16* Bt; bf16* O;
    __device__ __forceinline__ bool next(int i, Unit& u) const { int pm, pn; if (!S.next(i, pm, pn)) return false; u.rt = pm; u.pn = pn; u.e = 0; u.rb = pm; u.rows = 256; return true; }
    __device__ __forceinline__ const char* a_base(const Unit& u) const { return (const char*)A + (size_t)u.rt * 256 * K * 2; }
    __device__ __forceinline__ const char* b_base(const Unit& u) const { return (const char*)Bt + (size_t)u.pn * 256 * K * 2; }
    __device__ __forceinline__ void a_off(const Unit&, const int (&R)[2], const int (&C)[2], unsigned (&off)[2][2]) const { lin_off(R, C, off); }
    __device__ __forceinline__ void epi(const f32x4 (&acc)[2][2][4][2], const Unit& u, int wr, int wc, int fr, int fq) const {
        const int row0 = u.rt * 256 + wr * 64 + fr, col0 = 512 + u.pn * 256 + wc * 32 + 8 * fq;
#pragma unroll
        for (int ai = 0; ai < 2; ++ai)
#pragma unroll
            for (int m = 0; m < 4; ++m) { const int row = row0 + ai * 128 + m * 16; bf16* rowp = O + (size_t)row * DM + col0;
#pragma unroll
                for (int bj = 0; bj < 2; ++bj) { const f32x4 v0 = acc[ai][bj][m][0], v1 = acc[ai][bj][m][1]; v4u w;
                    w.x = cvt_pk_bf16(v0[0], v0[1]); w.y = cvt_pk_bf16(v0[2], v0[3]); w.z = cvt_pk_bf16(v1[0], v1[1]); w.w = cvt_pk_bf16(v1[2], v1[3]);
                    *(v4u*)(rowp + bj * 128) = w; } }
    }
};
struct ProbOut : ProbBase {
    const bf16* A; const bf16* Bt; const float* X; float* O;
    __device__ __forceinline__ bool next(int i, Unit& u) const { int pm, pn; if (!S.next(i, pm, pn)) return false; u.rt = pm; u.pn = pn; u.e = 0; u.rb = pm; u.rows = 256; return true; }
    __device__ __forceinline__ const char* a_base(const Unit& u) const { return (const char*)A + (size_t)u.rt * 256 * K * 2; }
    __device__ __forceinline__ const char* b_base(const Unit& u) const { return (const char*)Bt + (size_t)u.pn * 256 * K * 2; }
    __device__ __forceinline__ void a_off(const Unit&, const int (&R)[2], const int (&C)[2], unsigned (&off)[2][2]) const { lin_off(R, C, off); }
    __device__ __forceinline__ void epi(const f32x4 (&acc)[2][2][4][2], const Unit& u, int wr, int wc, int fr, int fq) const {
        const int row0 = u.rt * 256 + wr * 64 + fr, col0 = u.pn * 256 + wc * 32 + 8 * fq;
#pragma unroll
        for (int ai = 0; ai < 2; ++ai)
#pragma unroll
            for (int m = 0; m < 4; ++m) { const size_t off = (size_t)(row0 + ai * 128 + m * 16) * DM + col0;
#pragma unroll
                for (int bj = 0; bj < 2; ++bj)
#pragma unroll
                    for (int n = 0; n < 2; ++n) { const f32x4 xv = *(const f32x4*)(X + off + bj * 128 + 4 * n); *(f32x4*)(O + off + bj * 128 + 4 * n) = xv + acc[ai][bj][m][n]; } }
    }
};
struct MoeTab { const LAS int* pref; const LAS int* cnt; };
__device__ __forceinline__ void moe_decode(const MoeTab& T, int rt, Unit& u) {
    int e = 0;
#pragma unroll 1
    for (int j = 1; j < NE; ++j) if (T.pref[j] <= rt) e = j;
    u.e = e; u.rb = rt - T.pref[e]; const int left = T.cnt[e] - u.rb * 256; u.rows = left < 256 ? left : 256;
}
struct ProbGU : ProbBase {
    MoeTab T; const bf16* A; const bf16* Bt; bf16* O; const int* list; const float* rs2; const float* bgu;
    __device__ __forceinline__ bool next(int i, Unit& u) const { int pm, pn; if (!S.next(i, pm, pn)) return false; u.rt = pm; u.pn = pn; moe_decode(T, pm, u); return true; }
    __device__ __forceinline__ const char* a_base(const Unit&) const { return (const char*)A; }
    __device__ __forceinline__ const char* b_base(const Unit& u) const { return (const char*)Bt + ((size_t)u.e * 2048 + (size_t)u.pn * 256) * K * 2; }
    __device__ __forceinline__ void a_off(const Unit& u, const int (&R)[2], const int (&C)[2], unsigned (&off)[2][2]) const {
        const int* lp = list + (size_t)u.e * LISTCAP + u.rb * 256;
#pragma unroll
        for (int h = 0; h < 2; ++h)
#pragma unroll
            for (int i = 0; i < 2; ++i) { const int r = h * 128 + R[i]; const int ent = (r < u.rows) ? lp[r] : 0; off[h][i] = (unsigned)(ent >> 2) * (unsigned)(K * 2) + (unsigned)C[i] * 2u; }
    }
    __device__ __forceinline__ void epi(const f32x4 (&acc)[2][2][4][2], const Unit& u, int wr, int wc, int fr, int fq) const {
        const int* lp = list + (size_t)u.e * LISTCAP + u.rb * 256;
        const int j0 = wc * 32 + 8 * fq;
        const float* bg = bgu + (size_t)u.e * 2048 + u.pn * 256 + j0;
        f32x4 bgv[2], buv[2];
#pragma unroll
        for (int n = 0; n < 2; ++n) { bgv[n] = *(const f32x4*)(bg + 4 * n); buv[n] = *(const f32x4*)(bg + 128 + 4 * n); }
#pragma unroll
        for (int ai = 0; ai < 2; ++ai)
#pragma unroll
            for (int m = 0; m < 4; ++m) { const int r = ai * 128 + wr * 64 + m * 16 + fr;
                if (r < u.rows) { const int ent = lp[r]; const float sc = rs2[ent >> 2]; unsigned w[4];
#pragma unroll
                    for (int n = 0; n < 2; ++n) { float a[4];
#pragma unroll
                        for (int q = 0; q < 4; ++q) { float gt = acc[ai][0][m][n][q] * sc + bgv[n][q], up = acc[ai][1][m][n][q] * sc + buv[n][q];
                            gt = fminf(gt, 7.f); up = fminf(fmaxf(up, -7.f), 7.f); a[q] = (up + 1.f) * gt * frcp_(1.f + fexp_(-1.702f * gt)); }
                        w[2 * n] = cvt_pk_bf16(a[0], a[1]); w[2 * n + 1] = cvt_pk_bf16(a[2], a[3]); }
                    *(v4u*)(O + (size_t)(u.rt * 256 + r) * DE + u.pn * 128 + j0) = (v4u){w[0], w[1], w[2], w[3]}; } }
    }
};
struct ProbDown : ProbBase {
    MoeTab T; const bf16* A; const bf16* Bt; bf16* O; const int* list; const float* gw; const float* bd;
    __device__ __forceinline__ bool next(int i, Unit& u) const { int pm, pn; if (!S.next(i, pm, pn)) return false; u.rt = pm; u.pn = pn; moe_decode(T, pm, u); return true; }
    __device__ __forceinline__ const char* a_base(const Unit& u) const { return (const char*)A + (size_t)u.rt * 256 * K * 2; }
    __device__ __forceinline__ const char* b_base(const Unit& u) const { return (const char*)Bt + ((size_t)u.e * 1024 + (size_t)u.pn * 256) * K * 2; }
    __device__ __forceinline__ void a_off(const Unit&, const int (&R)[2], const int (&C)[2], unsigned (&off)[2][2]) const { lin_off(R, C, off); }
    __device__ __forceinline__ void epi(const f32x4 (&acc)[2][2][4][2], const Unit& u, int wr, int wc, int fr, int fq) const {
        const int* lp = list + (size_t)u.e * LISTCAP + u.rb * 256;
        const int c0 = u.pn * 256 + wc * 32 + 8 * fq;
        const float* bp = bd + (size_t)u.e * DM + c0;
        f32x4 bv[2][2];
#pragma unroll
        for (int bj = 0; bj < 2; ++bj)
#pragma unroll
            for (int n = 0; n < 2; ++n) bv[bj][n] = *(const f32x4*)(bp + bj * 128 + 4 * n);
#pragma unroll
        for (int ai = 0; ai < 2; ++ai)
#pragma unroll
            for (int m = 0; m < 4; ++m) { const int r = ai * 128 + wr * 64 + m * 16 + fr;
                if (r < u.rows) { const int ent = lp[r]; const float g = gw[ent]; bf16* rowp = O + (size_t)ent * DM + c0;
#pragma unroll
                    for (int bj = 0; bj < 2; ++bj) { const f32x4 v0 = (acc[ai][bj][m][0] + bv[bj][0]) * g, v1 = (acc[ai][bj][m][1] + bv[bj][1]) * g; v4u w;
                        w.x = cvt_pk_bf16(v0[0], v0[1]); w.y = cvt_pk_bf16(v0[2], v0[3]); w.z = cvt_pk_bf16(v1[0], v1[1]); w.w = cvt_pk_bf16(v1[2], v1[3]);
                        *(v4u*)(rowp + bj * 128) = w; } } }
    }
};

typedef short v4i16_t __attribute__((ext_vector_type(4)));
__device__ __forceinline__ void tr_item(const float* W, int ldw, int k0, int nsrc0, bf16* WT, size_t drow0, int ldk, int dk0, const float* ks, const float* ns, LAS unsigned char* scr, int lane) {
    const int kr = lane >> 4, n4 = (lane & 15) * 4;
    f32x4 nsc = (f32x4){1.f, 1.f, 1.f, 1.f}; if (ns) nsc = *(const f32x4*)(ns + nsrc0 + n4);
    f32x4 v[16];
#pragma unroll
    for (int i = 0; i < 16; ++i) v[i] = *(const f32x4*)(W + (size_t)(k0 + 4 * i + kr) * ldw + nsrc0 + n4);
#pragma unroll
    for (int i = 0; i < 16; ++i) { f32x4 x = v[i] * nsc; if (ks) x = x * ks[k0 + 4 * i + kr];
        *(LAS v2u*)(scr + (4 * i + kr) * 192 + n4 * 2) = (v2u){pg8::cvt_pk_bf16(x.x, x.y), pg8::cvt_pk_bf16(x.z, x.w)}; }
    LDS_WAIT(); asm volatile("" ::: "memory");
    const int G = lane >> 4, li = lane & 15, q = li >> 2, p = li & 3;
    const LAS unsigned char* rb = scr + q * 192 + (16 * G + 4 * p) * 2;
    bf16* dst = WT + (drow0 + 16 * G + li) * (size_t)ldk + dk0 + k0;
#pragma unroll
    for (int kc = 0; kc < 8; ++kc) {
        const v4i16_t lo = __builtin_amdgcn_ds_read_tr16_b64_v4i16((LAS v4i16_t*)(rb + (8 * kc) * 192));
        const v4i16_t hi = __builtin_amdgcn_ds_read_tr16_b64_v4i16((LAS v4i16_t*)(rb + (8 * kc + 4) * 192));
        const v2u l2 = __builtin_bit_cast(v2u, lo), h2 = __builtin_bit_cast(v2u, hi);
        *(v4u*)(dst + 8 * kc) = (v4u){l2.x, l2.y, h2.x, h2.y};
    }
    LDS_WAIT(); asm volatile("" ::: "memory");
}

__device__ __forceinline__ void moe_weight_prep(Frame& F, int b0) {
    const float* fnw = F.in[10]; const float* w_gu = F.in[13]; const float* w_d = F.in[15];
    bf16* WguT = (bf16*)(F.ws + WS_WGU); bf16* WdT = (bf16*)(F.ws + WS_WD);
    LAS unsigned char* scr = F.lds + F.wave * 12288;
    const int gw = ((int)blockIdx.x - b0) * NWAVES + F.wave, NGW = (F.G - b0) * NWAVES;
    constexpr int I_GU = 32 * 16 * 16 * 2, I_D = 32 * 16 * 16;
    for (int it = gw; it < I_GU + I_D; it += NGW) {
        int r = it;
        if (r < I_GU) { const int e = r / 512, r2 = r % 512, seg = r2 / 32, kb = (r2 % 32) / 2, nb = r2 % 2; const int t = seg >> 1, half = seg & 1;
            tr_item(w_gu + (size_t)e * DM * 2048, 2048, kb * 64, half * 1024 + t * 128 + nb * 64, WguT, (size_t)e * 2048 + t * 256 + half * 128 + nb * 64, DM, 0, fnw, nullptr, scr, F.lane); continue; } r -= I_GU;
        { const int e = r / 256, r2 = r % 256, kb = r2 / 16, nb = r2 % 16; tr_item(w_d + (size_t)e * DE * DM, DM, kb * 64, nb * 64, WdT, (size_t)e * 1024 + nb * 64, DE, 0, nullptr, nullptr, scr, F.lane); }
    }
}

__device__ __forceinline__ void phase_prep(Frame& F) {
    const float* x = F.in[0]; const float* anw = F.in[1]; const float* w_in = F.in[2]; const float* a_log = F.in[4]; const float* dt_bias = F.in[5];
    const float* pool_w = F.in[7]; const float* pool_scale = F.in[8]; const float* w_out = F.in[9]; const float* fnw = F.in[10];
    const float* w_router = F.in[11]; const float* w_gu = F.in[13]; const float* b_gu = F.in[14]; const float* w_d = F.in[15];
    bf16* WinT = (bf16*)(F.ws + WS_WIN); bf16* WoutT = (bf16*)(F.ws + WS_WOUT); bf16* WpoolT = (bf16*)(F.ws + WS_WPOOL);
    bf16* WguT = (bf16*)(F.ws + WS_WGU); bf16* WdT = (bf16*)(F.ws + WS_WD);
    bf16* WrI = (bf16*)(F.ws + WS_WR); float* bguP = (float*)(F.ws + WS_BGU);
    bf16* xb = (bf16*)(F.ws + WS_XB); float* rs1 = (float*)(F.ws + WS_RS1); float* betaA = (float*)(F.ws + WS_BETA); float* gA = (float*)(F.ws + WS_G);
    LAS unsigned char* scr = F.lds + F.wave * 12288;
    LAS float* W8T = (LAS float*)(F.lds + 98304);
    const int gw = F.vcu * NWAVES + F.wave, NGW = F.G * NWAVES;
    const int gt = F.vcu * 512 + F.tid, NGT = F.G * 512;
    for (int idx = F.tid; idx < 8192; idx += 512) { const int k = idx >> 3, c = idx & 7; W8T[c * 1024 + k] = anw[k] * w_in[(size_t)k * DIN + 2048 + c]; }
    __syncthreads();
    constexpr int I_IN1 = 16 * 32, I_IN2 = 16 * 8, I_OUT = 16 * 16, I_POOL = 4 * 2 * 2;
    constexpr int NITEMS = I_IN1 + I_IN2 + I_OUT + I_POOL;
    for (int it = gw; it < NITEMS; it += NGW) {
        int r = it;
        if (r < I_IN1) { const int kb = r / 32, nb = r % 32; tr_item(w_in, DIN, kb * 64, nb * 64, WinT, (size_t)nb * 64, DM, 0, anw, nullptr, scr, F.lane); continue; } r -= I_IN1;
        if (r < I_IN2) { const int kb = r / 8, nb = r % 8; tr_item(w_in, DIN, kb * 64, 2056 + nb * 64, WinT, (size_t)2048 + nb * 64, DM, 0, anw, nullptr, scr, F.lane); continue; } r -= I_IN2;
        if (r < I_OUT) { const int kb = r / 16, nb = r % 16; tr_item(w_out, DM, kb * 64, nb * 64, WoutT, (size_t)nb * 64, DM, 0, nullptr, nullptr, scr, F.lane); continue; } r -= I_OUT;
        { const int g = r / 4, kb = (r % 4) / 2, nb = r % 2; tr_item(pool_w + (size_t)g * 128 * 128, 128, kb * 64, nb * 64, WpoolT, (size_t)g * 128 + nb * 64, 512, g * 128, nullptr, pool_scale + g * 128, scr, F.lane); }
    }
    for (int idx = gt; idx < NE * 2048; idx += NGT) { const int e = idx >> 11, r = idx & 2047, t = r >> 8, j = r & 255, half = j >> 7, jj = j & 127; bguP[idx] = b_gu[(size_t)e * 2048 + half * 1024 + t * 128 + jj]; }
    for (int idx = gt; idx < 64 * 64 * 8; idx += NGT) { const int j = idx & 7, ln = (idx >> 3) & 63, fr2 = idx >> 9, nb = fr2 & 1, ks = fr2 >> 1;
        const int k = 32 * ks + 8 * (ln >> 4) + j, e = 16 * nb + (ln & 15); const float v = fnw[k] * w_router[(size_t)k * NE + e];
        const unsigned hb = f2bf(v); const float hf = __builtin_bit_cast(float, hb << 16); const unsigned lb = f2bf(v - hf);
        WrI[((size_t)(fr2 * 2 + 0) * 64 + ln) * 8 + j] = (bf16)hb; WrI[((size_t)(fr2 * 2 + 1) * 64 + ln) * 8 + j] = (bf16)lb; }
    for (int idx = gt; idx < 512 * 64; idx += NGT) { const int n = idx >> 6, ch = idx & 63; if ((n >> 7) != (ch >> 4)) *(v4u*)(WpoolT + (size_t)n * 512 + ch * 8) = (v4u){0u, 0u, 0u, 0u}; }
    for (int m = gw; m < NTOK; m += NGW) {
        const f32x4* xr = (const f32x4*)(x + (size_t)m * DM) + F.lane;
        f32x4 v[4]; float ss = 0.f; float d8[8];
#pragma unroll
        for (int c = 0; c < 8; ++c) d8[c] = 0.f;
#pragma unroll
        for (int j = 0; j < 4; ++j) { v[j] = xr[64 * j]; ss += (v[j].x * v[j].x + v[j].y * v[j].y) + (v[j].z * v[j].z + v[j].w * v[j].w); }
#pragma unroll
        for (int c = 0; c < 8; ++c)
#pragma unroll
            for (int j = 0; j < 4; ++j) { const f32x4 w = *(const LAS f32x4*)(W8T + c * 1024 + 256 * j + 4 * F.lane); d8[c] += (v[j].x * w.x + v[j].y * w.y) + (v[j].z * w.z + v[j].w * w.w); }
        ss = wave_sum(ss);
#pragma unroll
        for (int c = 0; c < 8; ++c) d8[c] = wave_sum(d8[c]);
        const float rs = 1.f / sqrtf(ss * (1.f / DM) + 1e-6f);
        unsigned long long* o8 = (unsigned long long*)(xb + (size_t)m * DM) + F.lane;
#pragma unroll
        for (int j = 0; j < 4; ++j) o8[64 * j] = (unsigned long long)pk2(v[j].x, v[j].y) | ((unsigned long long)pk2(v[j].z, v[j].w) << 32);
        if (F.lane == 0) rs1[m] = rs;
        if (F.lane < 4) {
            float bl = 0.f, al = 0.f;
#pragma unroll
            for (int c = 0; c < 4; ++c) { bl = (F.lane == c) ? d8[c] : bl; al = (F.lane == c) ? d8[4 + c] : al; }
            bl *= rs; al *= rs;
            betaA[(size_t)m * 4 + F.lane] = 1.f / (1.f + expf(-bl));
            const float z = al + dt_bias[F.lane]; const float sp = z > 20.f ? z : log1pf(expf(z));
            gA[(size_t)m * 4 + F.lane] = -expf(a_log[F.lane]) * sp;
        }
    }
}

__device__ __forceinline__ void phase_mix(Frame& F) {
    const bf16* proj = (const bf16*)(F.ws + WS_PROJ); bf16* mixed = (bf16*)(F.ws + WS_MIXED);
    const int gw = F.vcu * NWAVES + F.wave, NGW = F.G * NWAVES;
    const int ch = 8 * F.lane, gi = F.lane >> 4, win = 2 << gi, hal = win - 1;
    for (int rbk = gw; rbk < NTOK / 16; rbk += NGW) {
        const int m0 = rbk * 16, t0 = m0 % SEQ;
        v4u X[31];
#pragma unroll
        for (int k = 0; k < 31; ++k) { X[k] = (v4u){0u, 0u, 0u, 0u}; if (k >= 15 - hal && t0 - 15 + k >= 0) X[k] = *(const v4u*)(proj + (size_t)(m0 - 15 + k) * NPROJ + 2048 + ch); }
        float s[8];
#pragma unroll
        for (int q = 0; q < 8; ++q) s[q] = 0.f;
#pragma unroll
        for (int k = 0; k < 15; ++k) { s[0] += bflo(X[k].x); s[1] += bfhi(X[k].x); s[2] += bflo(X[k].y); s[3] += bfhi(X[k].y); s[4] += bflo(X[k].z); s[5] += bfhi(X[k].z); s[6] += bflo(X[k].w); s[7] += bfhi(X[k].w); }
#pragma unroll
        for (int r = 0; r < 16; ++r) {
            const v4u u = X[15 + r];
            const float p[8] = {bflo(u.x), bfhi(u.x), bflo(u.y), bfhi(u.y), bflo(u.z), bfhi(u.z), bflo(u.w), bfhi(u.w)};
#pragma unroll
            for (int q = 0; q < 8; ++q) s[q] += p[q];
            const int tt = t0 + r + 1; const float ic = 1.f / (float)(tt < win ? tt : win);
            v4u o; o.x = pk2(s[0] * ic - p[0], s[1] * ic - p[1]); o.y = pk2(s[2] * ic - p[2], s[3] * ic - p[3]); o.z = pk2(s[4] * ic - p[4], s[5] * ic - p[5]); o.w = pk2(s[6] * ic - p[6], s[7] * ic - p[7]);
            *(v4u*)(mixed + (size_t)(m0 + r) * 512 + ch) = o;
            const v4u od = gi == 0 ? X[14 + r] : gi == 1 ? X[12 + r] : gi == 2 ? X[8 + r] : X[r];
            s[0] -= bflo(od.x); s[1] -= bfhi(od.x); s[2] -= bflo(od.y); s[3] -= bfhi(od.y); s[4] -= bflo(od.z); s[5] -= bfhi(od.z); s[6] -= bflo(od.w); s[7] -= bfhi(od.w);
        }
    }
}

typedef float f32x16 __attribute__((ext_vector_type(16)));
__device__ __forceinline__ bf16x8 pack8(const f32x4 a, const f32x4 b) {
    v4u w; w.x = cvt_pk_bf16(a[0], a[1]); w.y = cvt_pk_bf16(a[2], a[3]); w.z = cvt_pk_bf16(b[0], b[1]); w.w = cvt_pk_bf16(b[2], b[3]);
    return __builtin_bit_cast(bf16x8, w);
}
__device__ __forceinline__ void fmac_(float& acc, float a, float b) { asm("v_fmac_f32 %0, %1, %2" : "+v"(acc) : "v"(a), "v"(b)); }
__device__ __forceinline__ float bf2f(unsigned short u) { return __builtin_bit_cast(float, (unsigned)u << 16); }

constexpr int CP_QN = 0, CP_KN = 17408, CP_VA = 34816, CP_QKL = 51200, CP_SC = 59392, CP_HALF = 61440;
__device__ __forceinline__ void phase_chunk(Frame& F) {
    const float* conv_w = F.in[3];
    const bf16* proj = (const bf16*)(F.ws + WS_PROJ);
    const float* betaA = (const float*)(F.ws + WS_BETA); const float* gA = (const float*)(F.ws + WS_G);
    float* gtotA = (float*)(F.ws + WS_GTOT);
    const int half = F.wave >> 2, hw = F.wave & 3, ht = F.tid & 255, lane = F.lane;
    LAS unsigned char* L = F.lds + half * CP_HALF;
    LAS bf16* qn = (LAS bf16*)(L + CP_QN); LAS bf16* kn = (LAS bf16*)(L + CP_KN); LAS bf16* vn = (LAS bf16*)(L + CP_VA);
    LAS float* Am = (LAS float*)(L + CP_VA); LAS bf16* qkL = (LAS bf16*)(L + CP_QKL); LAS float* sc = (LAS float*)(L + CP_SC);
    const int r16 = lane & 15, gq = lane >> 4;
#pragma unroll 1
    for (int it = 0; it < 4; ++it) {
        const int unit = (it * (int)gridDim.x + (int)blockIdx.x) * 2 + half;
        const bool live = unit < NB * NH * 64;
        const int bh = unit >> 6, n = unit & 63, b = bh >> 2, h = bh & 3;
        const size_t m0 = (size_t)b * SEQ + (size_t)n * 64;
        unsigned char* chunk = F.ws + WS_CHUNK + (size_t)unit * CH_BYTES;
        if (live && hw == 0) {
            const float gi = gA[(m0 + lane) * 4 + h], bi = betaA[(m0 + lane) * 4 + h];
            float c = gi;
#pragma unroll
            for (int o = 1; o < 64; o <<= 1) { const float tt = __shfl_up(c, o); if (lane >= o) c += tt; }
            const float gl = __shfl(c, 63);
            sc[lane] = bi; sc[64 + lane] = c; sc[128 + lane] = __expf(c); sc[192 + lane] = __expf(gl - c);
            if (lane == 63) gtotA[unit] = __expf(c);
        }
        if (live) {
            const int rq = ht >> 4, cg = ht & 15;
#pragma unroll 1
            for (int p = 0; p < 3; ++p) {
                const int col = p * 512 + h * 128 + 8 * cg;
                float xin[7][8];
#pragma unroll
                for (int jj = 0; jj < 7; ++jj) { const int trow = n * 64 + 4 * rq - 3 + jj; v4u u = (v4u){0u, 0u, 0u, 0u};
                    if (trow >= 0) u = *(const v4u*)(proj + ((size_t)b * SEQ + trow) * NPROJ + col);
                    xin[jj][0] = bflo(u.x); xin[jj][1] = bfhi(u.x); xin[jj][2] = bflo(u.y); xin[jj][3] = bfhi(u.y); xin[jj][4] = bflo(u.z); xin[jj][5] = bfhi(u.z); xin[jj][6] = bflo(u.w); xin[jj][7] = bfhi(u.w); }
                float wv[4][8];
#pragma unroll
                for (int j = 0; j < 4; ++j) { const f32x4 w0 = *(const f32x4*)(conv_w + j * 1536 + col), w1 = *(const f32x4*)(conv_w + j * 1536 + col + 4);
                    wv[j][0] = w0.x; wv[j][1] = w0.y; wv[j][2] = w0.z; wv[j][3] = w0.w; wv[j][4] = w1.x; wv[j][5] = w1.y; wv[j][6] = w1.z; wv[j][7] = w1.w; }
#pragma unroll
                for (int rr = 0; rr < 4; ++rr) {
                    float y[8]; float ss = 0.f;
#pragma unroll
                    for (int q = 0; q < 8; ++q) { float a = 0.f;
#pragma unroll
                        for (int j = 0; j < 4; ++j) a += wv[j][q] * xin[rr + j][q];
                        y[q] = siluf_(a); ss += y[q] * y[q]; }
                    float scl = 1.f;
                    if (p < 2) { ss += __shfl_xor(ss, 1); ss += __shfl_xor(ss, 2); ss += __shfl_xor(ss, 4); ss += __shfl_xor(ss, 8); scl = frsq_(ss + 1e-6f); if (p == 0) scl *= 0.08838834764831845f; }
                    v4u o; o.x = pk2(y[0] * scl, y[1] * scl); o.y = pk2(y[2] * scl, y[3] * scl); o.z = pk2(y[4] * scl, y[5] * scl); o.w = pk2(y[6] * scl, y[7] * scl);
                    const int row = 4 * rq + rr;
                    if (p == 0) *(LAS v4u*)(qn + row * 136 + 8 * cg) = o; else if (p == 1) *(LAS v4u*)(kn + row * 136 + 8 * cg) = o; else *(LAS v4u*)(vn + row * 128 + 8 * cg) = o;
                }
            }
        }
        __syncthreads();
        const int which = ht >> 7, c = ht & 127;
        float U[64];
        if (live) {
#pragma unroll
            for (int i = 0; i < 64; ++i) { const float bi = sc[i]; const float tv = which ? bf2f(kn[i * 136 + c]) * sc[128 + i] : bf2f(vn[i * 128 + c]); U[i] = tv * bi; }
        } else {
#pragma unroll
            for (int i = 0; i < 64; ++i) U[i] = 0.f;
        }
        __syncthreads();
        if (live) {
            const int ti = hw >> 1, tj = hw & 1, r = lane & 31, hh = lane >> 5;
            f32x16 KK, QK;
#pragma unroll
            for (int q = 0; q < 16; ++q) { KK[q] = 0.f; QK[q] = 0.f; }
#pragma unroll
            for (int ks = 0; ks < 8; ++ks) {
                const bf16x8 ak = *(const LAS bf16x8*)(kn + (ti * 32 + r) * 136 + 16 * ks + 8 * hh);
                const bf16x8 aq = *(const LAS bf16x8*)(qn + (ti * 32 + r) * 136 + 16 * ks + 8 * hh);
                const bf16x8 bb = *(const LAS bf16x8*)(kn + (tj * 32 + r) * 136 + 16 * ks + 8 * hh);
                KK = __builtin_amdgcn_mfma_f32_32x32x16_bf16(ak, bb, KK, 0, 0, 0);
                QK = __builtin_amdgcn_mfma_f32_32x32x16_bf16(aq, bb, QK, 0, 0, 0);
            }
            const int j = tj * 32 + r; const float gcj = sc[64 + j];
#pragma unroll
            for (int reg = 0; reg < 16; ++reg) { const int i = ti * 32 + (reg & 3) + 8 * (reg >> 2) + 4 * hh;
                const float dec = (i >= j) ? __expf(sc[64 + i] - gcj) : 0.f;
                Am[i * 64 + j] = (i > j) ? sc[i] * KK[reg] * dec : 0.f;
                qkL[i * 64 + j] = (bf16)f2bf((i >= j) ? QK[reg] * dec : 0.f); }
        }
        __syncthreads();
        if (live) {
#pragma unroll
            for (int fi = 0; fi < 4; ++fi) { const int f = hw * 4 + fi, mb = f >> 2, ks = f & 3, row = 16 * mb + r16; const float s = sc[128 + row];
                const v2u lo = *(const LAS v2u*)(qn + row * 136 + 32 * ks + 4 * gq), hi = *(const LAS v2u*)(qn + row * 136 + 32 * ks + 16 + 4 * gq);
                v4u o; o.x = pk2(bflo(lo.x) * s, bfhi(lo.x) * s); o.y = pk2(bflo(lo.y) * s, bfhi(lo.y) * s); o.z = pk2(bflo(hi.x) * s, bfhi(hi.x) * s); o.w = pk2(bflo(hi.y) * s, bfhi(hi.y) * s);
                *(v4u*)(chunk + CH_QD + (f * 64 + lane) * 16) = o; }
#pragma unroll
            for (int fi = 0; fi < 4; ++fi) { const int f = hw * 4 + fi, db = f >> 1, ksp = f & 1, dcol = 16 * db + r16; float e[8];
#pragma unroll
                for (int j = 0; j < 8; ++j) { const int i = 32 * ksp + 16 * (j >> 2) + 4 * gq + (j & 3); e[j] = bf2f(kn[i * 136 + dcol]) * sc[192 + i]; }
                v4u o; o.x = pk2(e[0], e[1]); o.y = pk2(e[2], e[3]); o.z = pk2(e[4], e[5]); o.w = pk2(e[6], e[7]);
                *(v4u*)(chunk + CH_KT + (f * 64 + lane) * 16) = o; }
#pragma unroll
            for (int fi = 0; fi < 2; ++fi) { const int f = hw * 2 + fi, mb = f >> 1, ksp = f & 1, row = 16 * mb + r16;
                const v2u lo = *(const LAS v2u*)(qkL + row * 64 + 32 * ksp + 4 * gq), hi = *(const LAS v2u*)(qkL + row * 64 + 32 * ksp + 16 + 4 * gq);
                *(v4u*)(chunk + CH_QK + (f * 64 + lane) * 16) = (v4u){lo.x, lo.y, hi.x, hi.y}; }
#pragma unroll
            for (int i = 1; i < 64; ++i) {
                float s0 = 0.f, s1 = 0.f, s2 = 0.f, s3 = 0.f;
#pragma unroll
                for (int j4 = 0; j4 < (i + 3) / 4; ++j4) { const f32x4 a = *(const LAS f32x4*)(Am + i * 64 + 4 * j4);
                    fmac_(s0, a.x, U[4 * j4]); if (4 * j4 + 1 < i) fmac_(s1, a.y, U[4 * j4 + 1]); if (4 * j4 + 2 < i) fmac_(s2, a.z, U[4 * j4 + 2]); if (4 * j4 + 3 < i) fmac_(s3, a.w, U[4 * j4 + 3]); }
                U[i] -= (s0 + s1) + (s2 + s3);
                __builtin_amdgcn_sched_barrier(0);
            }
        }
        __syncthreads();
        if (live) {
            if (which == 0) {
                const int w8 = c >> 4, cl = c & 15;
                unsigned char* ub = F.ws + WS_UC + (size_t)unit * UC_BYTES;
#pragma unroll
                for (int g = 0; g < 4; ++g) {
                    v4u lo, hi;
                    lo.x = pk2(U[4 * g], U[4 * g + 1]); lo.y = pk2(U[4 * g + 2], U[4 * g + 3]); lo.z = pk2(U[16 + 4 * g], U[16 + 4 * g + 1]); lo.w = pk2(U[16 + 4 * g + 2], U[16 + 4 * g + 3]);
                    hi.x = pk2(U[32 + 4 * g], U[32 + 4 * g + 1]); hi.y = pk2(U[32 + 4 * g + 2], U[32 + 4 * g + 3]); hi.z = pk2(U[48 + 4 * g], U[48 + 4 * g + 1]); hi.w = pk2(U[48 + 4 * g + 2], U[48 + 4 * g + 3]);
                    v4u* dst = (v4u*)(ub + ((w8 * 64 + g * 16 + cl) * 32)); dst[0] = lo; dst[1] = hi;
                }
            } else {
#pragma unroll
                for (int i = 0; i < 64; ++i) qn[i * 136 + c] = (bf16)f2bf(U[i]);
            }
        }
        __syncthreads();
        if (live) {
#pragma unroll
            for (int fi = 0; fi < 4; ++fi) { const int f = hw * 4 + fi, mb = f >> 2, ks = f & 3, row = 16 * mb + r16;
                const v2u lo = *(const LAS v2u*)(qn + row * 136 + 32 * ks + 4 * gq), hi = *(const LAS v2u*)(qn + row * 136 + 32 * ks + 16 + 4 * gq);
                *(v4u*)(chunk + CH_WF + (f * 64 + lane) * 16) = (v4u){lo.x, lo.y, hi.x, hi.y}; }
        }
        __syncthreads();
    }
}

__device__ __forceinline__ void phase_scan(Frame& F) {
    const int bh = blockIdx.x, b = bh >> 2, h = bh & 3, w = F.wave, lane = F.lane, cl = lane & 15, gq = lane >> 4;
    const float* gtotA = (const float*)(F.ws + WS_GTOT);
    const int unit0 = bh * 64;
    const unsigned char* cbase = F.ws + WS_CHUNK + (size_t)unit0 * CH_BYTES;
    const unsigned char* ubase = F.ws + WS_UC + (size_t)unit0 * UC_BYTES + (w * 64 + lane) * 32;
    bf16* op = (bf16*)(F.ws + WS_ORAW) + ((size_t)b * SEQ + cl) * 512 + h * 128 + 16 * w + 4 * gq;
    f32x4 Sacc[8]; bf16x8 Sb[4];
#pragma unroll
    for (int d = 0; d < 8; ++d) Sacc[d] = (f32x4){0.f, 0.f, 0.f, 0.f};
#pragma unroll
    for (int k = 0; k < 4; ++k) Sb[k] = (bf16x8){0, 0, 0, 0, 0, 0, 0, 0};
#define SCAN_ISSUE(nn) do { const unsigned char* s_ = cbase + (size_t)(nn) * CH_BYTES + (w * 7) * 1024 + lane * 16; LAS unsigned char* d_ = F.lds + ((nn) & 1) * CH_BYTES + (w * 7) * 1024; \
        _Pragma("unroll") for (int k_ = 0; k_ < 7; ++k_) __builtin_amdgcn_global_load_lds((const unsigned*)(s_ + k_ * 1024), (LAS unsigned*)(d_ + k_ * 1024), 16, 0, 0); } while (0)
    SCAN_ISSUE(0);
    v4u nu0 = *(const v4u*)(ubase), nu1 = *(const v4u*)(ubase + 16);
    float ngt = gtotA[unit0];
    v2u Ow[4];
#pragma unroll
    for (int mb = 0; mb < 4; ++mb) Ow[mb] = (v2u){0u, 0u};
#pragma unroll 1
    for (int n = 0; n < 64; ++n) {
        VM_WAIT(); __syncthreads();
        const v4u cu0 = nu0, cu1 = nu1; const float gt = ngt;
        if (n + 1 < 64) { SCAN_ISSUE(n + 1); nu0 = *(const v4u*)(ubase + (size_t)(n + 1) * UC_BYTES); nu1 = *(const v4u*)(ubase + (size_t)(n + 1) * UC_BYTES + 16); ngt = gtotA[unit0 + n + 1]; }
        if (n > 0) {
#pragma unroll
            for (int mb = 0; mb < 4; ++mb) *(v2u*)(op + (size_t)((n - 1) * 64 + 16 * mb) * 512) = Ow[mb];
        }
        const LAS unsigned char* B = F.lds + (n & 1) * CH_BYTES;
#define FRAG(off, f) (*(const LAS bf16x8*)(B + (off) + ((f) * 64 + lane) * 16))
        f32x4 P[4];
#pragma unroll
        for (int mb = 0; mb < 4; ++mb) { P[mb] = (f32x4){0.f, 0.f, 0.f, 0.f};
#pragma unroll
            for (int ks = 0; ks < 4; ++ks) P[mb] = __builtin_amdgcn_mfma_f32_16x16x32_bf16(FRAG(CH_WF, mb * 4 + ks), Sb[ks], P[mb], 0, 0, 0); }
        f32x4 vnw[4];
        vnw[0] = (f32x4){bflo(cu0.x), bfhi(cu0.x), bflo(cu0.y), bfhi(cu0.y)} - P[0];
        vnw[1] = (f32x4){bflo(cu0.z), bfhi(cu0.z), bflo(cu0.w), bfhi(cu0.w)} - P[1];
        vnw[2] = (f32x4){bflo(cu1.x), bfhi(cu1.x), bflo(cu1.y), bfhi(cu1.y)} - P[2];
        vnw[3] = (f32x4){bflo(cu1.z), bfhi(cu1.z), bflo(cu1.w), bfhi(cu1.w)} - P[3];
        bf16x8 Vb[2]; Vb[0] = pack8(vnw[0], vnw[1]); Vb[1] = pack8(vnw[2], vnw[3]);
#pragma unroll
        for (int db = 0; db < 8; ++db) { Sacc[db] = Sacc[db] * gt;
#pragma unroll
            for (int ksp = 0; ksp < 2; ++ksp) Sacc[db] = __builtin_amdgcn_mfma_f32_16x16x32_bf16(FRAG(CH_KT, db * 2 + ksp), Vb[ksp], Sacc[db], 0, 0, 0); }
#pragma unroll
        for (int mb = 0; mb < 4; ++mb) { f32x4 OT = (f32x4){0.f, 0.f, 0.f, 0.f};
#pragma unroll
            for (int ks = 0; ks < 4; ++ks) OT = __builtin_amdgcn_mfma_f32_16x16x32_bf16(Sb[ks], FRAG(CH_QD, mb * 4 + ks), OT, 0, 0, 0);
#pragma unroll
            for (int ksp = 0; ksp < 2; ++ksp) OT = __builtin_amdgcn_mfma_f32_16x16x32_bf16(Vb[ksp], FRAG(CH_QK, mb * 2 + ksp), OT, 0, 0, 0);
            Ow[mb] = (v2u){cvt_pk_bf16(OT[0], OT[1]), cvt_pk_bf16(OT[2], OT[3])}; }
#pragma unroll
        for (int ks = 0; ks < 4; ++ks) Sb[ks] = pack8(Sacc[2 * ks], Sacc[2 * ks + 1]);
#undef FRAG
    }
#undef SCAN_ISSUE
#pragma unroll
    for (int mb = 0; mb < 4; ++mb) *(v2u*)(op + (size_t)(63 * 64 + 16 * mb) * 512) = Ow[mb];
    VM_WAIT(); __syncthreads();
}

__device__ __forceinline__ void phase_onorm(Frame& F) {
    const float* dnw = F.in[6]; const bf16* proj = (const bf16*)(F.ws + WS_PROJ); const bf16* oraw = (const bf16*)(F.ws + WS_ORAW); bf16* concat = (bf16*)(F.ws + WS_CONCAT);
    const int gw = F.vcu * NWAVES + F.wave, NGW = F.G * NWAVES, lane = F.lane;
    const int cc = 8 * (lane & 15);
    const f32x4 d0 = *(const f32x4*)(dnw + cc), d1 = *(const f32x4*)(dnw + cc + 4);
    for (int m = gw; m < NTOK; m += NGW) {
        const v4u o = *(const v4u*)(oraw + (size_t)m * 512 + 8 * lane);
        const v4u z = *(const v4u*)(proj + (size_t)m * NPROJ + 1536 + 8 * lane);
        const float ov[8] = {bflo(o.x), bfhi(o.x), bflo(o.y), bfhi(o.y), bflo(o.z), bfhi(o.z), bflo(o.w), bfhi(o.w)};
        const float zv[8] = {bflo(z.x), bfhi(z.x), bflo(z.y), bfhi(z.y), bflo(z.z), bfhi(z.z), bflo(z.w), bfhi(z.w)};
        float ss = 0.f;
#pragma unroll
        for (int q = 0; q < 8; ++q) ss += ov[q] * ov[q];
        ss += __shfl_xor(ss, 1); ss += __shfl_xor(ss, 2); ss += __shfl_xor(ss, 4); ss += __shfl_xor(ss, 8);
        const float rs = frsq_(ss * (1.f / 128.f) + 1e-6f);
        const float dv[8] = {d0.x, d0.y, d0.z, d0.w, d1.x, d1.y, d1.z, d1.w};
        float r[8];
#pragma unroll
        for (int q = 0; q < 8; ++q) r[q] = ov[q] * rs * dv[q] * siluf_(zv[q]);
        *(v4u*)(concat + (size_t)m * DM + 8 * lane) = (v4u){cvt_pk_bf16(r[0], r[1]), cvt_pk_bf16(r[2], r[3]), cvt_pk_bf16(r[4], r[5]), cvt_pk_bf16(r[6], r[7])};
    }
}

__device__ __forceinline__ void phase_route(Frame& F) {
    const float* x1 = F.out; const float* b_router = F.in[12];
    bf16* x1b = (bf16*)(F.ws + WS_X1B); float* rs2A = (float*)(F.ws + WS_RS2); float* gatew = (float*)(F.ws + WS_GATEW); int* list = (int*)(F.ws + WS_LIST);
    unsigned* cntw = (unsigned*)(F.ws + WS_CTL) + CW_CNT;
    LAS unsigned char* WI = F.lds;
    LAS unsigned* lcnt = (LAS unsigned*)(F.lds + TAB_OFF);
    { const v4u* src = (const v4u*)(F.ws + WS_WR);
      for (int idx = F.tid; idx < 131072 / 16; idx += 512) *(LAS v4u*)(WI + 16 * idx) = src[idx]; }
    const int lane = F.lane, c = lane & 15, g = lane >> 4;
    const int gw = F.vcu * NWAVES + F.wave, NGW = F.G * NWAVES, NT = NTOK / 16;
    const float bia0 = b_router[c], bia1 = b_router[16 + c];
    for (int t0 = 0; t0 < NT; t0 += NGW) {
        const int tile = t0 + gw; const bool live = tile < NT;
        if (F.tid < 64) lcnt[F.tid] = 0u;
        __syncthreads();
        int my_e = 0; float my_g = 0.f; unsigned my_rank = 0u; int my_ent = 0;
        if (live) {
            const int m0 = tile * 16;
            const float* xrow = x1 + (size_t)(m0 + c) * DM + 8 * g;
            bf16* xbrow = x1b + (size_t)(m0 + c) * DM + 8 * g;
            f32x4 acc0 = (f32x4){0.f, 0.f, 0.f, 0.f}, acc1 = acc0; float ssq = 0.f;
#pragma unroll 1
            for (int kb = 0; kb < 4; ++kb) {
                f32x4 xa[8], xb4[8];
#pragma unroll
                for (int q = 0; q < 8; ++q) { xa[q] = *(const f32x4*)(xrow + 32 * (kb * 8 + q)); xb4[q] = *(const f32x4*)(xrow + 32 * (kb * 8 + q) + 4); }
#pragma unroll
                for (int q = 0; q < 8; ++q) { const int ks = kb * 8 + q; const f32x4 a = xa[q], b = xb4[q];
                    ssq += (a.x * a.x + a.y * a.y) + (a.z * a.z + a.w * a.w) + (b.x * b.x + b.y * b.y) + (b.z * b.z + b.w * b.w);
                    v4u h; h.x = cvt_pk_bf16(a.x, a.y); h.y = cvt_pk_bf16(a.z, a.w); h.z = cvt_pk_bf16(b.x, b.y); h.w = cvt_pk_bf16(b.z, b.w);
                    v4u l; l.x = cvt_pk_bf16(a.x - bflo(h.x), a.y - bfhi(h.x)); l.y = cvt_pk_bf16(a.z - bflo(h.y), a.w - bfhi(h.y)); l.z = cvt_pk_bf16(b.x - bflo(h.z), b.y - bfhi(h.z)); l.w = cvt_pk_bf16(b.z - bflo(h.w), b.w - bfhi(h.w));
                    *(v4u*)(xbrow + 32 * ks) = h;
                    const bf16x8 ah = __builtin_bit_cast(bf16x8, h), al = __builtin_bit_cast(bf16x8, l);
                    const LAS unsigned char* fb = WI + (size_t)(ks * 4) * 1024 + lane * 16;
                    const bf16x8 b0h = *(const LAS bf16x8*)(fb), b0l = *(const LAS bf16x8*)(fb + 1024), b1h = *(const LAS bf16x8*)(fb + 2048), b1l = *(const LAS bf16x8*)(fb + 3072);
                    acc0 = __builtin_amdgcn_mfma_f32_16x16x32_bf16(ah, b0h, acc0, 0, 0, 0); acc0 = __builtin_amdgcn_mfma_f32_16x16x32_bf16(ah, b0l, acc0, 0, 0, 0); acc0 = __builtin_amdgcn_mfma_f32_16x16x32_bf16(al, b0h, acc0, 0, 0, 0);
                    acc1 = __builtin_amdgcn_mfma_f32_16x16x32_bf16(ah, b1h, acc1, 0, 0, 0); acc1 = __builtin_amdgcn_mfma_f32_16x16x32_bf16(ah, b1l, acc1, 0, 0, 0); acc1 = __builtin_amdgcn_mfma_f32_16x16x32_bf16(al, b1h, acc1, 0, 0, 0); }
            }
            ssq += __shfl_xor(ssq, 16); ssq += __shfl_xor(ssq, 32);
            const float rsr = frsq_(ssq * (1.f / DM) + 1e-6f);
            if (g == 0) rs2A[m0 + c] = rsr;
            float ge_[4]; int ee_[4];
#pragma unroll
            for (int reg = 0; reg < 4; ++reg) {
                const float rsw = __shfl(rsr, 4 * g + reg);
                float v0 = acc0[reg] * rsw + bia0, v1 = acc1[reg] * rsw + bia1;
                float tv[4]; int te[4];
#pragma unroll
                for (int s = 0; s < 4; ++s) {
                    float bv; int bi; if (v1 > v0) { bv = v1; bi = 16 + c; } else { bv = v0; bi = c; }
#pragma unroll
                    for (int o = 1; o < 16; o <<= 1) { const float ov = __shfl_xor(bv, o); const int oi = __shfl_xor(bi, o); if (ov > bv || (ov == bv && oi < bi)) { bv = ov; bi = oi; } }
                    tv[s] = bv; te[s] = bi; if (bi == c) v0 = -3.0e38f; if (bi == 16 + c) v1 = -3.0e38f;
                }
                const float e1 = fexp_(tv[1] - tv[0]), e2 = fexp_(tv[2] - tv[0]), e3 = fexp_(tv[3] - tv[0]); const float inv = frcp_(1.f + e1 + e2 + e3);
                const int s_ = c & 3; const float gsel = (s_ == 0 ? 1.f : s_ == 1 ? e1 : s_ == 2 ? e2 : e3) * inv; const int esel = s_ == 0 ? te[0] : s_ == 1 ? te[1] : s_ == 2 ? te[2] : te[3];
                ge_[reg] = gsel; ee_[reg] = esel;
            }
            const int rsel = c >> 2;
            my_g = rsel == 0 ? ge_[0] : rsel == 1 ? ge_[1] : rsel == 2 ? ge_[2] : ge_[3];
            my_e = rsel == 0 ? ee_[0] : rsel == 1 ? ee_[1] : rsel == 2 ? ee_[2] : ee_[3];
            my_ent = (m0 + 4 * g + rsel) * 4 + (c & 3);
            my_rank = __hip_atomic_fetch_add(lcnt + my_e, 1u, __ATOMIC_RELAXED, __HIP_MEMORY_SCOPE_WORKGROUP);
        }
        __syncthreads();
        if (F.tid < NE) { const unsigned n = lcnt[F.tid]; lcnt[32 + F.tid] = n ? __hip_atomic_fetch_add(cntw + 64 * F.tid, n, RLX_AGENT) : 0u; }
        __syncthreads();
        if (live) { const unsigned pos = lcnt[32 + my_e] + my_rank; list[(size_t)my_e * LISTCAP + pos] = my_ent; gatew[my_ent] = my_g; }
        __syncthreads();
    }
}

__device__ __forceinline__ int moe_tables(Frame& F, MoeTab& T) {
    LAS int* pref = (LAS int*)(F.lds + TAB_OFF); LAS int* cnt = pref + 40;
    unsigned* cntw = (unsigned*)(F.ws + WS_CTL) + CW_CNT;
    if (F.tid == 0) { int acc = 0; for (int e = 0; e < NE; ++e) { const int c = (int)__hip_atomic_load(cntw + 64 * e, RLX_AGENT); cnt[e] = c; pref[e] = acc; acc += (c + 255) >> 8; } pref[NE] = acc; }
    __syncthreads();
    T.pref = pref; T.cnt = cnt;
    return pref[NE];
}

struct FinalRow { f32x4 v[4]; v4u sl[4][2]; };
__device__ __forceinline__ void final_load(FinalRow& R, const float* orow, const bf16* srow) {
#pragma unroll
    for (int j = 0; j < 2; ++j) { R.v[2 * j] = *(const f32x4*)(orow + 512 * j); R.v[2 * j + 1] = *(const f32x4*)(orow + 512 * j + 4); }
#pragma unroll
    for (int s = 0; s < 4; ++s)
#pragma unroll
        for (int j = 0; j < 2; ++j) R.sl[s][j] = *(const v4u*)(srow + (size_t)s * DM + 512 * j);
}
__device__ __forceinline__ void final_finish(FinalRow& R, float* orow, const f32x4 (&wv)[4], size_t dry_off) {
    orow += dry_off;
#pragma unroll
    for (int s = 0; s < 4; ++s)
#pragma unroll
        for (int j = 0; j < 2; ++j) { const v4u u = R.sl[s][j];
            R.v[2 * j].x += bflo(u.x); R.v[2 * j].y += bfhi(u.x); R.v[2 * j].z += bflo(u.y); R.v[2 * j].w += bfhi(u.y);
            R.v[2 * j + 1].x += bflo(u.z); R.v[2 * j + 1].y += bfhi(u.z); R.v[2 * j + 1].z += bflo(u.w); R.v[2 * j + 1].w += bfhi(u.w); }
    float ss = 0.f;
#pragma unroll
    for (int j = 0; j < 4; ++j) ss += (R.v[j].x * R.v[j].x + R.v[j].y * R.v[j].y) + (R.v[j].z * R.v[j].z + R.v[j].w * R.v[j].w);
    ss = wave_sum(ss);
    const float rs = frsq_(ss * (1.f / DM) + 1e-6f);
#pragma unroll
    for (int j = 0; j < 2; ++j) { *(f32x4*)(orow + 512 * j) = R.v[2 * j] * rs * wv[2 * j]; *(f32x4*)(orow + 512 * j + 4) = R.v[2 * j + 1] * rs * wv[2 * j + 1]; }
}
__device__ __forceinline__ void phase_final(Frame& F, int dryrun) {
    const float* fw = F.in[17]; const bf16* slab = (const bf16*)(F.ws + WS_SLAB); float* out = F.out;
    const int gw = F.vcu * NWAVES + F.wave, NGW = F.G * NWAVES, lane = F.lane;
    f32x4 wv[4];
#pragma unroll
    for (int j = 0; j < 2; ++j) { wv[2 * j] = *(const f32x4*)(fw + 512 * j + 8 * lane); wv[2 * j + 1] = *(const f32x4*)(fw + 512 * j + 8 * lane + 4); }
    const size_t dry_off = dryrun ? (size_t)((float*)(F.ws + WS_XB) - out) : 0;
    FinalRow A, B;
    int m = gw;
    if (m < NTOK) final_load(A, out + (size_t)m * DM + 8 * lane, slab + (size_t)m * 4 * DM + 8 * lane);
    for (; m < NTOK; m += 2 * NGW) {
        const int m1 = m + NGW, m2 = m + 2 * NGW;
        if (m1 < NTOK) final_load(B, out + (size_t)m1 * DM + 8 * lane, slab + (size_t)m1 * 4 * DM + 8 * lane);
        final_finish(A, out + (size_t)m * DM + 8 * lane, wv, dry_off);
        if (m2 < NTOK) final_load(A, out + (size_t)m2 * DM + 8 * lane, slab + (size_t)m2 * 4 * DM + 8 * lane);
        if (m1 < NTOK) final_finish(B, out + (size_t)m1 * DM + 8 * lane, wv, dry_off);
    }
}

struct Args { const float* in[18]; float* out; unsigned char* ws; int ph_lo, ph_hi, flag, pad; };
constexpr int NPHASE = 11;

__global__ void __launch_bounds__(NWAVES * 64, 2) mk_fwd(Args args) {
    extern __shared__ __attribute__((aligned(16))) unsigned char lds_raw[];
    Frame F;
    F.lds = (LAS unsigned char*)lds_raw;
    F.tid = threadIdx.x; F.lane = F.tid & 63; F.wave = __builtin_amdgcn_readfirstlane(F.tid >> 6);
    F.G = gridDim.x; { const int bx = blockIdx.x; F.vcu = (F.G % 8 == 0) ? (bx % 8) * (F.G / 8) + bx / 8 : bx; }
#pragma unroll
    for (int i = 0; i < 18; ++i) F.in[i] = args.in[i];
    F.out = args.out; F.ws = args.ws;
    volatile LAS unsigned* MISC = (volatile LAS unsigned*)(F.lds + MISC_OFF);
    for (int u = F.tid; u < (LDS_BYTES - LDSCTL_OFF) / 4; u += NWAVES * 64) ((LAS unsigned*)(F.lds + LDSCTL_OFF))[u] = 0u;
    __syncthreads();
    unsigned* ctl = (unsigned*)(F.ws + WS_CTL);
#if !MK_PER_PHASE
    XcdBarrier bar = xcd_barrier_post(ctl + CW_BAR, MISC + 8);
#define GRID_BAR() xcd_barrier(bar)
#else
#define GRID_BAR() do {} while (0)
#endif
    const int lo = args.ph_lo, hi = args.ph_hi;
#define IN(k) (lo <= (k) && (k) < hi)
#define SEAM(k) do { if (IN(k) && IN((k) + 1)) GRID_BAR(); } while (0)

#define RUNPH(k, ...) do { if (IN(k)) { __VA_ARGS__; } SEAM(k); } while (0)
    RUNPH(0, phase_prep(F));
    RUNPH(1, {
        ProbIn P; P.K = DM; P.S.init(NTOK / 256, NPROJ / 256, F.G, (int)blockIdx.x);
        P.A = (const bf16*)(F.ws + WS_XB); P.Bt = (const bf16*)(F.ws + WS_WIN); P.O = (bf16*)(F.ws + WS_PROJ); P.rs = (const float*)(F.ws + WS_RS1);
        pg8::gemm_phase(F.lds, P); });
    if (IN(2)) { phase_mix(F); __syncthreads(); }
    RUNPH(3, phase_chunk(F));
    RUNPH(4, {
        const int nscan = NB * NH;
        if ((int)blockIdx.x < nscan) phase_scan(F);
        else { ProbPool P; P.K = 512; P.S.init(NTOK / 256, 2, F.G - nscan, (int)blockIdx.x - nscan);
               P.A = (const bf16*)(F.ws + WS_MIXED); P.Bt = (const bf16*)(F.ws + WS_WPOOL); P.O = (bf16*)(F.ws + WS_CONCAT);
               pg8::gemm_phase(F.lds, P);
               __syncthreads();
               moe_weight_prep(F, nscan); } });
    RUNPH(5, phase_onorm(F));
    RUNPH(6, {
        ProbOut P; P.K = DM; P.S.init(NTOK / 256, DM / 256, F.G, (int)blockIdx.x);
        P.A = (const bf16*)(F.ws + WS_CONCAT); P.Bt = (const bf16*)(F.ws + WS_WOUT); P.X = F.in[0]; P.O = F.out;
        pg8::gemm_phase(F.lds, P); });
    RUNPH(7, phase_route(F));
    RUNPH(8, {
        ProbGU P; const int RT = moe_tables(F, P.T);
        P.K = DM; P.S.init(RT, 8, F.G, (int)blockIdx.x);
        P.A = (const bf16*)(F.ws + WS_X1B); P.Bt = (const bf16*)(F.ws + WS_WGU); P.O = (bf16*)(F.ws + WS_ACT); P.list = (const int*)(F.ws + WS_LIST);
        P.rs2 = (const float*)(F.ws + WS_RS2); P.bgu = (const float*)(F.ws + WS_BGU);
        pg8::gemm_phase(F.lds, P); });
    RUNPH(9, {
        ProbDown P; const int RT = moe_tables(F, P.T);
        P.K = DE; P.S.init(RT, 4, F.G, (int)blockIdx.x);
        P.A = (const bf16*)(F.ws + WS_ACT); P.Bt = (const bf16*)(F.ws + WS_WD); P.O = (bf16*)(F.ws + WS_SLAB); P.list = (const int*)(F.ws + WS_LIST);
        P.gw = (const float*)(F.ws + WS_GATEW); P.bd = F.in[16];
        pg8::gemm_phase(F.lds, P); });
    RUNPH(10, phase_final(F, args.flag));
#undef RUNPH
#undef IN
#undef SEAM
}

extern "C" void kernel_launch(void* const* d_in, const int* in_sizes, int n_in, void* d_out, int out_size, void* d_ws, size_t ws_size, hipStream_t stream) {
    static int grid = 0;
    if (grid == 0) {
        if (n_in != 18 || in_sizes[0] != NTOK * DM || out_size != NTOK * DM || ws_size < WS_END) { fprintf(stderr, "kernel_launch: unexpected shapes (n_in %d, in0 %d, out %d, ws %zu)\n", n_in, n_in > 0 ? in_sizes[0] : -1, out_size, ws_size); grid = -1; return; }
        int dev = 0, cus = 0, per_cu = 0;
        if (hipGetDevice(&dev) != hipSuccess || hipDeviceGetAttribute(&cus, hipDeviceAttributeMultiprocessorCount, dev) != hipSuccess) { grid = -1; return; }
        if (hipFuncSetAttribute((const void*)mk_fwd, hipFuncAttributeMaxDynamicSharedMemorySize, LDS_BYTES) != hipSuccess) { fprintf(stderr, "kernel_launch: hipFuncSetAttribute failed\n"); grid = -1; return; }
        if (hipOccupancyMaxActiveBlocksPerMultiprocessor(&per_cu, (const void*)mk_fwd, NWAVES * 64, LDS_BYTES) != hipSuccess || per_cu < 1) { fprintf(stderr, "kernel_launch: occupancy query says %d\n", per_cu); per_cu = 1; }
        (void)hipGetLastError();
        grid = cus;
    }
    if (grid < 0) return;
    (void)hipMemsetAsync((char*)d_ws + WS_CTL, 0, CTL_ZERO_BYTES, stream);
    Args a{};
    for (int i = 0; i < 18; ++i) a.in[i] = (const float*)d_in[i];
    a.out = (float*)d_out; a.ws = (unsigned char*)d_ws;
#if MK_PER_PHASE
    for (int p = 0; p < NPHASE; ++p) { a.ph_lo = p; a.ph_hi = p + 1; const int nrep = 1 + REP_CNT * ((REP_MASK >> p) & 1);
        for (int r = 0; r < nrep; ++r) { a.flag = (p == NPHASE - 1 && r + 1 < nrep) ? 1 : 0; hipLaunchKernelGGL(mk_fwd, dim3(grid), dim3(NWAVES * 64), LDS_BYTES, stream, a); } }
#else
    a.ph_lo = 0; a.ph_hi = NPHASE;
    hipLaunchKernelGGL(mk_fwd, dim3(grid), dim3(NWAVES * 64), LDS_BYTES, stream, a);
#endif
}
```

```cpp
#include <hip/hip_runtime.h>
#include <cstdio>
#include <cstdint>

#ifndef REP_MASK
#define REP_MASK 0
#endif
#ifndef REP_CNT
#define REP_CNT 1
#endif
#ifndef MK_PER_PHASE
#define MK_PER_PHASE 0
#endif

constexpr int NB = 8, SEQ = 4096, DM = 1024, NTOK = NB * SEQ;
constexpr int NH = 4, HD = 128, DDN = 512, DPOOL = 512, DIN = 2568, NPROJ = 2560;
constexpr int NE = 32, TOPK = 4, DE = 1024, NASSIGN = NTOK * TOPK;
constexpr int LISTCAP = NTOK;
constexpr int ACT_ROWS = NASSIGN + NE * 256;

constexpr size_t MiB = 1u << 20;
constexpr size_t WS_CTL = 0, CTL_ZERO_BYTES = 1 * MiB;
constexpr size_t WS_WIN = 1 * MiB;
constexpr size_t WS_WOUT = 6 * MiB;
constexpr size_t WS_WPOOL = 8 * MiB;
constexpr size_t WS_WR = 8 * MiB + 512 * 1024;
constexpr size_t WS_BGU = 8 * MiB + 768 * 1024;
constexpr size_t WS_RS1 = 9 * MiB;
constexpr size_t WS_BETA = 9 * MiB + 128 * 1024;
constexpr size_t WS_G = 9 * MiB + 640 * 1024;
constexpr size_t WS_RS2 = 10 * MiB + 256 * 1024;
constexpr size_t WS_GATEW = 10 * MiB + 512 * 1024;
constexpr size_t WS_LIST = 11 * MiB;
constexpr size_t WS_WGU = 16 * MiB;
constexpr size_t WS_WD = 144 * MiB;
constexpr size_t WS_XB = 208 * MiB;
constexpr size_t WS_PROJ = 272 * MiB;
constexpr size_t WS_CHUNK = 432 * MiB;
constexpr size_t WS_UC = 544 * MiB;
constexpr size_t WS_GTOT = 576 * MiB;
constexpr size_t WS_ORAW = 577 * MiB;
constexpr int CH_WF = 0, CH_QD = 16384, CH_KT = 32768, CH_QK = 49152, CH_BYTES = 57344, UC_BYTES = 16384;
constexpr size_t WS_MIXED = 688 * MiB;
constexpr size_t WS_CONCAT = 720 * MiB;
constexpr size_t WS_X1B = 208 * MiB;
constexpr size_t WS_ACT = 272 * MiB;
constexpr size_t WS_SLAB = 544 * MiB;
constexpr size_t WS_END = 800 * MiB;
static_assert(WS_ACT + (size_t)ACT_ROWS * 2048 <= WS_SLAB, "act fits");
static_assert(WS_SLAB + (size_t)NASSIGN * 2048 <= WS_END, "slab fits");

constexpr int CW_BAR = 4096;
constexpr int CW_CNT = 16384;

constexpr int LDS_BYTES = 147456;
constexpr int LDSCTL_OFF = LDS_BYTES - 1024, MISC_OFF = LDSCTL_OFF + 320, TAB_OFF = LDSCTL_OFF + 512;
constexpr int NWAVES = 8;

#define GAS __attribute__((address_space(1)))
#define LAS __attribute__((address_space(3)))
typedef unsigned short bf16;
typedef unsigned v4u __attribute__((ext_vector_type(4)));
typedef unsigned v2u __attribute__((ext_vector_type(2)));
typedef float f32x4 __attribute__((ext_vector_type(4)));
typedef float f32x2 __attribute__((ext_vector_type(2)));
typedef short bf16x8 __attribute__((ext_vector_type(8)));
typedef GAS unsigned gu32;
#define RLX_AGENT __ATOMIC_RELAXED, __HIP_MEMORY_SCOPE_AGENT
#define LDS_WAIT() asm volatile("s_waitcnt lgkmcnt(0)" ::: "memory")
#define VM_WAIT() asm volatile("s_waitcnt vmcnt(0)" ::: "memory")

__device__ __forceinline__ unsigned f2bf(float f) { unsigned u = __builtin_bit_cast(unsigned, f); return (u + 0x7fffu + ((u >> 16) & 1u)) >> 16; }
__device__ __forceinline__ unsigned pk2(float lo, float hi) { return f2bf(lo) | (f2bf(hi) << 16); }
__device__ __forceinline__ float bflo(unsigned u) { return __builtin_bit_cast(float, u << 16); }
__device__ __forceinline__ float bfhi(unsigned u) { return __builtin_bit_cast(float, u & 0xffff0000u); }
__device__ __forceinline__ unsigned pk4_fp8(float a, float b, float c, float d) { int p = __builtin_amdgcn_cvt_pk_fp8_f32(a, b, 0, false); p = __builtin_amdgcn_cvt_pk_fp8_f32(c, d, p, true); return (unsigned)p; }
constexpr float W8_SCALE = 32.f, W8_INV = 1.f / 32.f;
__device__ __forceinline__ float wave_sum(float v) {
#pragma unroll
    for (int o = 1; o < 64; o <<= 1) v += __shfl_xor(v, o);
    return v;
}
__device__ __forceinline__ float frcp_(float x) { return __builtin_amdgcn_rcpf(x); }
__device__ __forceinline__ float frsq_(float x) { return __builtin_amdgcn_rsqf(x); }
__device__ __forceinline__ float fexp_(float x) { return __builtin_amdgcn_exp2f(x * 1.4426950408889634f); }
__device__ __forceinline__ float sigmoidf_(float x) { return frcp_(1.f + fexp_(-x)); }
__device__ __forceinline__ float siluf_(float x) { return x * frcp_(1.f + fexp_(-x)); }

namespace pg8 {
constexpr int BM = 256, BK = 64, HALF = 128, HTB = HALF * BK * 2, STAGE_BYTES = 8 * HTB;
__device__ __forceinline__ int lds_byte(int r, int c) { const int st = (r >> 4) * 2 + (c >> 5), rr = r & 15, cc = c & 31, ob = rr * 64 + cc * 2; return st * 1024 + (ob ^ (((ob >> 9) & 1) << 5)); }
__device__ __forceinline__ void stage_rc(int b, int& R, int& C) { const int st = b / 1024, sb = b % 1024, swz = sb ^ (((sb >> 9) & 1) << 5); R = (st >> 1) * 16 + swz / 64; C = (st & 1) * 32 + (swz % 64) / 2; }
__device__ __forceinline__ int perm32(int rho) { const int n = rho >> 4, i = rho & 15; return 8 * (i >> 2) + 4 * n + (i & 3); }
typedef __bf16 bf16x2_t __attribute__((ext_vector_type(2)));
__device__ __forceinline__ unsigned cvt_pk_bf16(float lo, float hi) { const f32x2 v = {lo, hi}; const bf16x2_t b = __builtin_convertvector(v, bf16x2_t); return __builtin_bit_cast(unsigned, b); }

struct Unit { int rt, pn, e, rb, rows; };

struct Sched {
    int nM, nN, nwg, G, c;
    __device__ __forceinline__ void init(int nM_, int nN_, int G_, int c_) { nM = nM_; nN = nN_; nwg = nM * nN; G = G_; c = c_; }
    __device__ __forceinline__ bool next(int i, int& pm, int& pn) const {
        const long L = (long)i * G + c; if (L >= nwg) return false;
        int wgid = (int)L; { const int q = nwg / 8, r = nwg % 8, xcd = wgid % 8, off = wgid / 8; wgid = (xcd < r ? xcd * (q + 1) : r * (q + 1) + (xcd - r) * q) + off; }
        const int nig = 8 * nN, gid = wgid / nig, fm = gid * 8, gsz = (nM - fm) < 8 ? (nM - fm) : 8;
        pm = fm + ((wgid % nig) % gsz); pn = (wgid % nig) / gsz; return true;
    }
};

typedef int v8i_t __attribute__((ext_vector_type(8)));
template <class P, bool F8 = false>
__device__ __forceinline__ void gemm_phase(LAS unsigned char* lds, const P& p) {
    const int tid = threadIdx.x, wid = __builtin_amdgcn_readfirstlane(tid >> 6), lane = tid & 63, wr = wid >> 2, wc = wid & 3, fr = lane & 15, fq = lane >> 4;
    const int K = p.K, RB = F8 ? K : 2 * K, nt = RB / (BK * 2);
    unsigned voffB[2];
#pragma unroll
    for (int i = 0; i < 2; ++i) { int R_, C_; stage_rc(tid * 16 + i * 8192, R_, C_); const int Rb = (R_ & ~31) + perm32(R_ & 31); voffB[i] = (unsigned)(Rb * RB + C_ * 2); }
#define PG8_AOFF(unit, dst) do { int R[2], C[2]; asm volatile("" ::: "memory"); _Pragma("unroll") for (int i_ = 0; i_ < 2; ++i_) stage_rc(tid * 16 + i_ * 8192, R[i_], C[i_]); p.a_off(unit, R, C, dst); } while (0)
    const size_t kstep = (size_t)(BK * 2);
    const size_t hstep = (size_t)HALF * RB;
    const unsigned ldsw = (unsigned)wid * 1024u;
    const int aoff = lds_byte(wr * 64 + fr, fq * 8), boff = lds_byte(wc * 32 + fr, fq * 8);
#define PG8_SA(b, h) (((b) * 2 + (h)) * HTB)
#define PG8_SB(b, h) ((4 + (b) * 2 + (h)) * HTB)
#define PG8_STAGE(bufoff, gbase, voff) do { _Pragma("unroll") for (int _i = 0; _i < 2; ++_i) \
        __builtin_amdgcn_global_load_lds((const unsigned*)((const char*)(gbase) + (voff)[_i]), (LAS unsigned*)(lds + (bufoff) + ldsw + _i * 8192), 16, 0, 0); } while (0)
#define PG8_LDA(dst, b, h) do { _Pragma("unroll") for (int m = 0; m < 4; ++m) { const v4i_t l_ = *(const LAS v4i_t*)(lds + PG8_SA(b, h) + aoff + m * 2048), h_ = *(const LAS v4i_t*)(lds + PG8_SA(b, h) + aoff + m * 2048 + 1024); dst[m] = __builtin_shufflevector(l_, h_, 0, 1, 2, 3, 4, 5, 6, 7); } } while (0)
#define PG8_LDB(dst, b, h) do { _Pragma("unroll") for (int n = 0; n < 2; ++n) { const v4i_t l_ = *(const LAS v4i_t*)(lds + PG8_SB(b, h) + boff + n * 2048), h_ = *(const LAS v4i_t*)(lds + PG8_SB(b, h) + boff + n * 2048 + 1024); dst[n] = __builtin_shufflevector(l_, h_, 0, 1, 2, 3, 4, 5, 6, 7); } } while (0)
#define PG8_HALF(x, k) __builtin_bit_cast(bf16x8, __builtin_shufflevector(x, x, 4 * (k), 4 * (k) + 1, 4 * (k) + 2, 4 * (k) + 3))
#define PG8_MMA(ai, bj, At, Bt) do { __builtin_amdgcn_s_setprio(1); \
        if constexpr (F8) { _Pragma("unroll") for (int m = 0; m < 4; ++m) _Pragma("unroll") for (int n = 0; n < 2; ++n) \
            asm volatile("v_mfma_scale_f32_16x16x128_f8f6f4 %0, %1, %2, %0, %3, %3 op_sel_hi:[0,0,0]" : "+v"(acc[ai][bj][m][n]) : "v"(Bt[n]), "v"(At[m]), "v"(mxs)); } \
        else { _Pragma("unroll") for (int m = 0; m < 4; ++m) _Pragma("unroll") for (int n = 0; n < 2; ++n) { \
            acc[ai][bj][m][n] = __builtin_amdgcn_mfma_f32_16x16x32_bf16(PG8_HALF(Bt[n], 0), PG8_HALF(At[m], 0), acc[ai][bj][m][n], 0, 0, 0); \
            acc[ai][bj][m][n] = __builtin_amdgcn_mfma_f32_16x16x32_bf16(PG8_HALF(Bt[n], 1), PG8_HALF(At[m], 1), acc[ai][bj][m][n], 0, 0, 0); } } \
        __builtin_amdgcn_s_setprio(0); } while (0)
#define PG8_WAIT_V(n) asm volatile("s_waitcnt vmcnt(" #n ")" ::: "memory")
#define PG8_WAIT_L(n) asm volatile("s_waitcnt lgkmcnt(" #n ")" ::: "memory")
#define PG8_BAR __builtin_amdgcn_s_barrier()
#define PG8_SCHED __builtin_amdgcn_sched_barrier(0)
    Unit cur, nxt; int ui = 0;
    if (!p.next(0, cur)) return;
    unsigned mxs = 0x7f7f7f7fu; asm volatile("" : "+v"(mxs));
    f32x4 acc[2][2][4][2];
#pragma unroll
    for (int a = 0; a < 2; ++a)
#pragma unroll
        for (int b = 0; b < 2; ++b)
#pragma unroll
            for (int m = 0; m < 4; ++m)
#pragma unroll
                for (int n = 0; n < 2; ++n) acc[a][b][m][n] = (f32x4){0.f, 0.f, 0.f, 0.f};
    typedef int v4i_t __attribute__((ext_vector_type(4)));
    v8i_t At[4], B0[2], B1[2];
    unsigned oA[2][2];
    PG8_AOFF(cur, oA);
    const char* cA = p.a_base(cur); const char* cB = p.b_base(cur);
    PG8_STAGE(PG8_SB(0, 0), cB, voffB); PG8_STAGE(PG8_SB(0, 1), cB + hstep, voffB); PG8_STAGE(PG8_SA(0, 0), cA, oA[0]); PG8_STAGE(PG8_SA(0, 1), cA, oA[1]);
    if (wr == 1) PG8_BAR;
    PG8_WAIT_V(2); PG8_BAR;
    PG8_STAGE(PG8_SB(1, 0), cB + kstep, voffB); PG8_STAGE(PG8_SA(1, 0), cA + kstep, oA[0]); PG8_STAGE(PG8_SB(1, 1), cB + hstep + kstep, voffB);
    PG8_WAIT_V(6); PG8_BAR;
    LAS v4u* park = (LAS v4u*)(lds + STAGE_BYTES) + tid;
    for (;;) {
        const bool has_next = p.next(ui + 1, nxt);
        const char* nA = cA; const char* nB = cB;
        { unsigned nO[2][2];
#pragma unroll
          for (int h = 0; h < 2; ++h)
#pragma unroll
              for (int i = 0; i < 2; ++i) nO[h][i] = oA[h][i];
          if (has_next) { nA = p.a_base(nxt); nB = p.b_base(nxt); PG8_AOFF(nxt, nO); }
          *park = (v4u){nO[0][0], nO[0][1], nO[1][0], nO[1][1]}; }
        for (int t = 0; t < nt; t += 2) {
            const bool last = (t == nt - 2);
            const char* a1 = cA + (size_t)(t + 1) * kstep;
            const char* a2 = last ? nA : cA + (size_t)(t + 2) * kstep; const char* b2 = last ? nB : cB + (size_t)(t + 2) * kstep;
            const char* a3 = a2 + kstep; const char* b3 = b2 + kstep;
            unsigned o2[2][2];
#pragma unroll
            for (int h = 0; h < 2; ++h)
#pragma unroll
                for (int i = 0; i < 2; ++i) o2[h][i] = oA[h][i];
            if (last) { const v4u q_ = *park; o2[0][0] = q_.x; o2[0][1] = q_.y; o2[1][0] = q_.z; o2[1][1] = q_.w; }
            PG8_LDB(B0, 0, 0); PG8_LDB(B1, 0, 1); PG8_SCHED; PG8_LDA(At, 0, 0); PG8_STAGE(PG8_SA(1, 1), a1, oA[1]);
            PG8_WAIT_V(8); PG8_WAIT_L(0); PG8_BAR; PG8_MMA(0, 0, At, B0); PG8_MMA(0, 1, At, B1); PG8_BAR; PG8_SCHED;
            PG8_LDA(At, 0, 1); PG8_STAGE(PG8_SB(0, 0), b2, voffB); PG8_STAGE(PG8_SB(0, 1), b2 + hstep, voffB); PG8_STAGE(PG8_SA(0, 0), a2, o2[0]);
            PG8_WAIT_V(8); PG8_WAIT_L(0); PG8_BAR; PG8_MMA(1, 0, At, B0); PG8_MMA(1, 1, At, B1); PG8_BAR; PG8_SCHED;
            PG8_LDB(B0, 1, 0); PG8_LDB(B1, 1, 1); PG8_SCHED; PG8_LDA(At, 1, 0); PG8_STAGE(PG8_SA(0, 1), a2, o2[1]);
            PG8_WAIT_V(8); PG8_WAIT_L(0); PG8_BAR; PG8_MMA(0, 0, At, B0); PG8_MMA(0, 1, At, B1); PG8_BAR; PG8_SCHED;
            PG8_LDA(At, 1, 1); PG8_STAGE(PG8_SB(1, 0), b3, voffB); PG8_STAGE(PG8_SB(1, 1), b3 + hstep, voffB); PG8_STAGE(PG8_SA(1, 0), a3, o2[0]);
            PG8_WAIT_V(8); PG8_WAIT_L(0); PG8_BAR; PG8_MMA(1, 0, At, B0); PG8_MMA(1, 1, At, B1); PG8_BAR; PG8_SCHED;
        }
        if (wr == 0) PG8_BAR;
        if constexpr (F8) asm volatile("s_nop 15\n\ts_nop 15" ::: "memory");
        p.epi(acc, cur, wr, wc, fr, fq);
        if (!has_next) break;
#pragma unroll
        for (int a = 0; a < 2; ++a)
#pragma unroll
            for (int b = 0; b < 2; ++b)
#pragma unroll
                for (int m = 0; m < 4; ++m)
#pragma unroll
                    for (int n = 0; n < 2; ++n) acc[a][b][m][n] = (f32x4){0.f, 0.f, 0.f, 0.f};
        cur = nxt; cA = nA; cB = nB; ++ui;
        { const v4u q_ = *park; oA[0][0] = q_.x; oA[0][1] = q_.y; oA[1][0] = q_.z; oA[1][1] = q_.w; }
        if (wr == 1) PG8_BAR;
    }
    PG8_WAIT_V(0);
    PG8_BAR;
#undef PG8_SA
#undef PG8_SB
#undef PG8_STAGE
#undef PG8_LDA
#undef PG8_LDB
#undef PG8_MMA
#undef PG8_HALF
#undef PG8_AOFF
#undef PG8_WAIT_V
#undef PG8_WAIT_L
#undef PG8_BAR
#undef PG8_SCHED
}
}

#define XB_TMO      128
#define XB_XCNT(j)  (256  + 64 * (j))
#define XB_XSUB(j)  (1280 + 64 * (j))
#define XB_XGEN(j)  (2304 + 64 * (j))
#define XB_TOP      3328
#define XB_TOPGEN   3392
#define XCD_BAR_WORDS 3456
#define XB_SPIN_CAP (1u << 18)
__device__ __forceinline__ unsigned xb_ld(unsigned* p)              { return __hip_atomic_load(p, __ATOMIC_RELAXED, __HIP_MEMORY_SCOPE_AGENT); }
__device__ __forceinline__ unsigned xb_add(unsigned* p, unsigned v) { return __hip_atomic_fetch_add(p, v, __ATOMIC_RELAXED, __HIP_MEMORY_SCOPE_AGENT); }
__device__ __forceinline__ unsigned xb_xcc_id() { return (unsigned)__builtin_amdgcn_s_getreg((3 << 11) | 20) & 0xFu; }
#define XB_SPIN(cond, bar) do { unsigned _sp = 0; while (cond) { __builtin_amdgcn_s_sleep(1); \
    if ((++_sp & 255u) == 0u) { if (xb_ld(&(bar)[XB_TMO])) break; if (_sp > XB_SPIN_CAP) { atomicAdd(&(bar)[XB_TMO], 1u); break; } } } } while (0)
struct XcdBarrier { unsigned* bar; unsigned x; volatile LAS unsigned* st; };
__device__ __forceinline__ XcdBarrier xcd_barrier_post(unsigned* bar, volatile LAS unsigned* st) {
    XcdBarrier b; b.bar = bar; b.x = xb_xcc_id(); b.st = st;
    if (threadIdx.x == 0) (void)xb_add(&bar[XB_XCNT(b.x)], 1u);
    return b;
}
__device__ __forceinline__ void xcd_barrier_complete(unsigned* bar, unsigned x, unsigned& nloc, unsigned& nx) {
    const unsigned G = gridDim.x * gridDim.y * gridDim.z;
    unsigned sum, cnt, mine, sp = 0u;
    for (;;) {
        sum = 0u; cnt = 0u; mine = 0u;
#pragma unroll
        for (unsigned j = 0; j < 16; ++j) { const unsigned c = xb_ld(&bar[XB_XCNT(j)]); sum += c; cnt += (c > 0u) ? 1u : 0u; mine = (j == x) ? c : mine; }
        if (sum == G) break;
        __builtin_amdgcn_s_sleep(1);
        if ((++sp & 255u) == 0u) { if (xb_ld(&bar[XB_TMO])) break; if (sp > XB_SPIN_CAP) { atomicAdd(&bar[XB_TMO], 1u); break; } }
    }
    nloc = mine > 0u ? mine : 1u; nx = cnt > 0u ? cnt : 1u;
}
__device__ __forceinline__ void xcd_barrier(const XcdBarrier& b) {
    asm volatile("s_waitcnt vmcnt(0)" ::: "memory");
    __syncthreads();
    if (threadIdx.x == 0) {
        unsigned* bar = b.bar;
        __builtin_amdgcn_s_waitcnt(0);
        unsigned nloc = b.st[0], nx = b.st[1];
        if (nloc == 0u) { xcd_barrier_complete(bar, b.x, nloc, nx); b.st[0] = nloc; b.st[1] = nx; }
        const unsigned old = xb_add(&bar[XB_XSUB(b.x)], 1u);
        const unsigned gen = old / nloc;
        if (old + 1u == (gen + 1u) * nloc) {
            __builtin_amdgcn_fence(__ATOMIC_RELEASE, "agent");
            asm volatile("s_waitcnt vmcnt(0)" ::: "memory");
            const unsigned og = xb_add(&bar[XB_TOP], 1u);
            const unsigned tg = og / nx;
            if (og + 1u == (tg + 1u) * nx) xb_add(&bar[XB_TOPGEN], 1u);
            else XB_SPIN(xb_ld(&bar[XB_TOPGEN]) == tg, bar);
            __builtin_amdgcn_fence(__ATOMIC_ACQUIRE, "agent");
            xb_add(&bar[XB_XGEN(b.x)], 1u);
            asm volatile("s_waitcnt vmcnt(0)" ::: "memory");
        } else {
            XB_SPIN(xb_ld(&bar[XB_XGEN(b.x)]) == gen, bar);
            __builtin_amdgcn_fence(__ATOMIC_ACQUIRE, "agent");
            asm volatile("s_waitcnt vmcnt(0)" ::: "memory");
        }
    }
    __syncthreads();
}

struct Frame {
    LAS unsigned char* lds;
    int tid, lane, wave, vcu, G;
    const float* in[18];
    float* out;
    unsigned char* ws;
};
using pg8::Unit;
using pg8::cvt_pk_bf16;

struct ProbBase {
    int K; int RB; pg8::Sched S;
    __device__ __forceinline__ void lin_off(const int (&R)[2], const int (&C)[2], unsigned (&off)[2][2]) const {
#pragma unroll
        for (int h = 0; h < 2; ++h)
#pragma unroll
            for (int i = 0; i < 2; ++i) off[h][i] = (unsigned)((h * 128 + R[i]) * RB + C[i] * 2);
    }
};
struct ProbIn : ProbBase {
    const bf16* A; const bf16* Bt; bf16* O; const float* rs;
    __device__ __forceinline__ bool next(int i, Unit& u) const { int pm, pn; if (!S.next(i, pm, pn)) return false; u.rt = pm; u.pn = pn; u.e = 0; u.rb = pm; u.rows = 256; return true; }
    __device__ __forceinline__ const char* a_base(const Unit& u) const { return (const char*)A + (size_t)u.rt * 256 * RB; }
    __device__ __forceinline__ const char* b_base(const Unit& u) const { return (const char*)Bt + (size_t)u.pn * 256 * RB; }
    __device__ __forceinline__ void a_off(const Unit&, const int (&R)[2], const int (&C)[2], unsigned (&off)[2][2]) const { lin_off(R, C, off); }
    __device__ __forceinline__ void epi(const f32x4 (&acc)[2][2][4][2], const Unit& u, int wr, int wc, int fr, int fq) const {
        const int row0 = u.rt * 256 + wr * 64 + fr, col0 = u.pn * 256 + wc * 32 + 8 * fq;
#pragma unroll
        for (int ai = 0; ai < 2; ++ai)
#pragma unroll
            for (int m = 0; m < 4; ++m) { const int row = row0 + ai * 128 + m * 16; const float sc = rs[row]; bf16* rowp = O + (size_t)row * NPROJ + col0;
#pragma unroll
                for (int bj = 0; bj < 2; ++bj) { const f32x4 v0 = acc[ai][bj][m][0] * sc, v1 = acc[ai][bj][m][1] * sc; v4u w;
                    w.x = cvt_pk_bf16(v0[0], v0[1]); w.y = cvt_pk_bf16(v0[2], v0[3]); w.z = cvt_pk_bf16(v1[0], v1[1]); w.w = cvt_pk_bf16(v1[2], v1[3]);
                    *(v4u*)(rowp + bj * 128) = w; } }
    }
};
struct ProbPool : ProbBase {
    const bf16* A; const bf16* Bt; bf16* O;
    __device__ __forceinline__ bool next(int i, Unit& u) const { int pm, pn; if (!S.next(i, pm, pn)) return false; u.rt = pm; u.pn = pn; u.e = 0; u.rb = pm; u.rows = 256; return true; }
    __device__ __forceinline__ const char* a_base(const Unit& u) const { return (const char*)A + (size_t)u.rt * 256 * RB; }
    __device__ __forceinline__ const char* b_base(const Unit& u) const { return (const char*)Bt + (size_t)u.pn * 256 * RB; }
    __device__ __forceinline__ void a_off(const Unit&, const int (&R)[2], const int (&C)[2], unsigned (&off)[2][2]) const { lin_off(R, C, off); }
    __device__ __forceinline__ void epi(const f32x4 (&acc)[2][2][4][2], const Unit& u, int wr, int wc, int fr, int fq) const {
        const int row0 = u.rt * 256 + wr * 64 + fr, col0 = 512 + u.pn * 256 + wc * 32 + 8 * fq;
#pragma unroll
        for (int ai = 0; ai < 2; ++ai)
#pragma unroll
            for (int m = 0; m < 4; ++m) { const int row = row0 + ai * 128 + m * 16; bf16* rowp = O + (size_t)row * DM + col0;
#pragma unroll
                for (int bj = 0; bj < 2; ++bj) { const f32x4 v0 = acc[ai][bj][m][0], v1 = acc[ai][bj][m][1]; v4u w;
                    w.x = cvt_pk_bf16(v0[0], v0[1]); w.y = cvt_pk_bf16(v0[2], v0[3]); w.z = cvt_pk_bf16(v1[0], v1[1]); w.w = cvt_pk_bf16(v1[2], v1[3]);
                    *(v4u*)(rowp + bj * 128) = w; } }
    }
};
struct ProbOut : ProbBase {
    const bf16* A; const bf16* Bt; const float* X; float* O;
    __device__ __forceinline__ bool next(int i, Unit& u) const { int pm, pn; if (!S.next(i, pm, pn)) return false; u.rt = pm; u.pn = pn; u.e = 0; u.rb = pm; u.rows = 256; return true; }
    __device__ __forceinline__ const char* a_base(const Unit& u) const { return (const char*)A + (size_t)u.rt * 256 * RB; }
    __device__ __forceinline__ const char* b_base(const Unit& u) const { return (const char*)Bt + (size_t)u.pn * 256 * RB; }
    __device__ __forceinline__ void a_off(const Unit&, const int (&R)[2], const int (&C)[2], unsigned (&off)[2][2]) const { lin_off(R, C, off); }
    __device__ __forceinline__ void epi(const f32x4 (&acc)[2][2][4][2], const Unit& u, int wr, int wc, int fr, int fq) const {
        const int row0 = u.rt * 256 + wr * 64 + fr, col0 = u.pn * 256 + wc * 32 + 8 * fq;
#pragma unroll
        for (int ai = 0; ai < 2; ++ai)
#pragma unroll
            for (int m = 0; m < 4; ++m) { const size_t off = (size_t)(row0 + ai * 128 + m * 16) * DM + col0;
#pragma unroll
                for (int bj = 0; bj < 2; ++bj)
#pragma unroll
                    for (int n = 0; n < 2; ++n) { const f32x4 xv = *(const f32x4*)(X + off + bj * 128 + 4 * n); *(f32x4*)(O + off + bj * 128 + 4 * n) = xv + acc[ai][bj][m][n]; } }
    }
};
struct MoeTab { const LAS int* pref; const LAS int* cnt; };
__device__ __forceinline__ void moe_decode(const MoeTab& T, int rt, Unit& u) {
    int e = 0;
#pragma unroll 1
    for (int j = 1; j < NE; ++j) if (T.pref[j] <= rt) e = j;
    u.e = e; u.rb = rt - T.pref[e]; const int left = T.cnt[e] - u.rb * 256; u.rows = left < 256 ? left : 256;
}
struct ProbGU : ProbBase {
    MoeTab T; const unsigned char* A; const unsigned char* Bt; unsigned char* O; const int* list; const float* rs2; const float* bgu;
    __device__ __forceinline__ bool next(int i, Unit& u) const { int pm, pn; if (!S.next(i, pm, pn)) return false; u.rt = pm; u.pn = pn; moe_decode(T, pm, u); return true; }
    __device__ __forceinline__ const char* a_base(const Unit&) const { return (const char*)A; }
    __device__ __forceinline__ const char* b_base(const Unit& u) const { return (const char*)Bt + ((size_t)u.e * 2048 + (size_t)u.pn * 256) * RB; }
    __device__ __forceinline__ void a_off(const Unit& u, const int (&R)[2], const int (&C)[2], unsigned (&off)[2][2]) const {
        const int* lp = list + (size_t)u.e * LISTCAP + u.rb * 256;
#pragma unroll
        for (int h = 0; h < 2; ++h)
#pragma unroll
            for (int i = 0; i < 2; ++i) { const int r = h * 128 + R[i]; const int ent = (r < u.rows) ? lp[r] : 0; off[h][i] = (unsigned)(ent >> 2) * (unsigned)RB + (unsigned)C[i] * 2u; }
    }
    __device__ __forceinline__ void epi(const f32x4 (&acc)[2][2][4][2], const Unit& u, int wr, int wc, int fr, int fq) const {
        const int* lp = list + (size_t)u.e * LISTCAP + u.rb * 256;
        const int j0 = wc * 32 + 8 * fq;
        const float* bg = bgu + (size_t)u.e * 2048 + u.pn * 256 + j0;
        f32x4 bgv[2], buv[2];
#pragma unroll
        for (int n = 0; n < 2; ++n) { bgv[n] = *(const f32x4*)(bg + 4 * n); buv[n] = *(const f32x4*)(bg + 128 + 4 * n); }
#pragma unroll
        for (int ai = 0; ai < 2; ++ai)
#pragma unroll
            for (int m = 0; m < 4; ++m) { const int r = ai * 128 + wr * 64 + m * 16 + fr;
                if (r < u.rows) { const int ent = lp[r]; const float sc = rs2[ent >> 2] * W8_INV; unsigned w[2];
#pragma unroll
                    for (int n = 0; n < 2; ++n) { float a[4];
#pragma unroll
                        for (int q = 0; q < 4; ++q) { float gt = acc[ai][0][m][n][q] * sc + bgv[n][q], up = acc[ai][1][m][n][q] * sc + buv[n][q];
                            gt = fminf(gt, 7.f); up = fminf(fmaxf(up, -7.f), 7.f); a[q] = (up + 1.f) * gt * frcp_(1.f + fexp_(-1.702f * gt)); }
                        w[n] = pk4_fp8(a[0], a[1], a[2], a[3]); }
                    *(v2u*)(O + (size_t)(u.rt * 256 + r) * DE + u.pn * 128 + j0) = (v2u){w[0], w[1]}; } }
    }
};
struct ProbDown : ProbBase {
    MoeTab T; const unsigned char* A; const unsigned char* Bt; bf16* O; const int* list; const float* gw; const float* bd;
    __device__ __forceinline__ bool next(int i, Unit& u) const { int pm, pn; if (!S.next(i, pm, pn)) return false; u.rt = pm; u.pn = pn; moe_decode(T, pm, u); return true; }
    __device__ __forceinline__ const char* a_base(const Unit& u) const { return (const char*)A + (size_t)u.rt * 256 * RB; }
    __device__ __forceinline__ const char* b_base(const Unit& u) const { return (const char*)Bt + ((size_t)u.e * 1024 + (size_t)u.pn * 256) * RB; }
    __device__ __forceinline__ void a_off(const Unit&, const int (&R)[2], const int (&C)[2], unsigned (&off)[2][2]) const { lin_off(R, C, off); }
    __device__ __forceinline__ void epi(const f32x4 (&acc)[2][2][4][2], const Unit& u, int wr, int wc, int fr, int fq) const {
        const int* lp = list + (size_t)u.e * LISTCAP + u.rb * 256;
        const int c0 = u.pn * 256 + wc * 32 + 8 * fq;
        const float* bp = bd + (size_t)u.e * DM + c0;
        f32x4 bv[2][2];
#pragma unroll
        for (int bj = 0; bj < 2; ++bj)
#pragma unroll
            for (int n = 0; n < 2; ++n) bv[bj][n] = *(const f32x4*)(bp + bj * 128 + 4 * n);
#pragma unroll
        for (int ai = 0; ai < 2; ++ai)
#pragma unroll
            for (int m = 0; m < 4; ++m) { const int r = ai * 128 + wr * 64 + m * 16 + fr;
                if (r < u.rows) { const int ent = lp[r]; const float g = gw[ent]; bf16* rowp = O + (size_t)ent * DM + c0;
#pragma unroll
                    for (int bj = 0; bj < 2; ++bj) { const f32x4 v0 = (acc[ai][bj][m][0] * W8_INV + bv[bj][0]) * g, v1 = (acc[ai][bj][m][1] * W8_INV + bv[bj][1]) * g; v4u w;
                        w.x = cvt_pk_bf16(v0[0], v0[1]); w.y = cvt_pk_bf16(v0[2], v0[3]); w.z = cvt_pk_bf16(v1[0], v1[1]); w.w = cvt_pk_bf16(v1[2], v1[3]);
                        *(v4u*)(rowp + bj * 128) = w; } } }
    }
};

typedef short v4i16_t __attribute__((ext_vector_type(4)));
__device__ __forceinline__ void tr_item(const float* W, int ldw, int k0, int nsrc0, bf16* WT, size_t drow0, int ldk, int dk0, const float* ks, const float* ns, LAS unsigned char* scr, int lane) {
    const int kr = lane >> 4, n4 = (lane & 15) * 4;
    f32x4 nsc = (f32x4){1.f, 1.f, 1.f, 1.f}; if (ns) nsc = *(const f32x4*)(ns + nsrc0 + n4);
    f32x4 v[16];
#pragma unroll
    for (int i = 0; i < 16; ++i) v[i] = *(const f32x4*)(W + (size_t)(k0 + 4 * i + kr) * ldw + nsrc0 + n4);
#pragma unroll
    for (int i = 0; i < 16; ++i) { f32x4 x = v[i] * nsc; if (ks) x = x * ks[k0 + 4 * i + kr];
        *(LAS v2u*)(scr + (4 * i + kr) * 192 + n4 * 2) = (v2u){pg8::cvt_pk_bf16(x.x, x.y), pg8::cvt_pk_bf16(x.z, x.w)}; }
    LDS_WAIT(); asm volatile("" ::: "memory");
    const int G = lane >> 4, li = lane & 15, q = li >> 2, p = li & 3;
    const LAS unsigned char* rb = scr + q * 192 + (16 * G + 4 * p) * 2;
    bf16* dst = WT + (drow0 + 16 * G + li) * (size_t)ldk + dk0 + k0;
#pragma unroll
    for (int kc = 0; kc < 8; ++kc) {
        const v4i16_t lo = __builtin_amdgcn_ds_read_tr16_b64_v4i16((LAS v4i16_t*)(rb + (8 * kc) * 192));
        const v4i16_t hi = __builtin_amdgcn_ds_read_tr16_b64_v4i16((LAS v4i16_t*)(rb + (8 * kc + 4) * 192));
        const v2u l2 = __builtin_bit_cast(v2u, lo), h2 = __builtin_bit_cast(v2u, hi);
        *(v4u*)(dst + 8 * kc) = (v4u){l2.x, l2.y, h2.x, h2.y};
    }
    LDS_WAIT(); asm volatile("" ::: "memory");
}

__device__ __forceinline__ void tr_item8(const float* W, int ldw, int k0, int nsrc0, unsigned char* WT, size_t drow0, int ldk, const float* ks, float mul, LAS unsigned char* scr, int lane) {
    const int kr = lane >> 4, n4 = (lane & 15) * 4;
    f32x4 v[16];
#pragma unroll
    for (int i = 0; i < 16; ++i) v[i] = *(const f32x4*)(W + (size_t)(k0 + 4 * i + kr) * ldw + nsrc0 + n4);
#pragma unroll
    for (int i = 0; i < 16; ++i) { const float sc = ks ? ks[k0 + 4 * i + kr] * mul : mul; const f32x4 x = v[i] * sc;
        *(LAS v2u*)(scr + (4 * i + kr) * 192 + n4 * 2) = (v2u){pg8::cvt_pk_bf16(x.x, x.y), pg8::cvt_pk_bf16(x.z, x.w)}; }
    LDS_WAIT(); asm volatile("" ::: "memory");
    const int G = lane >> 4, li = lane & 15, q = li >> 2, p = li & 3;
    const LAS unsigned char* rb = scr + q * 192 + (16 * G + 4 * p) * 2;
    unsigned char* dst = WT + (drow0 + 16 * G + li) * (size_t)ldk + k0;
#pragma unroll
    for (int kq = 0; kq < 4; ++kq) {
        v2u t[4];
#pragma unroll
        for (int u = 0; u < 4; ++u) t[u] = __builtin_bit_cast(v2u, __builtin_amdgcn_ds_read_tr16_b64_v4i16((LAS v4i16_t*)(rb + (16 * kq + 4 * u) * 192)));
        v4u o;
        o.x = pk4_fp8(bflo(t[0].x), bfhi(t[0].x), bflo(t[0].y), bfhi(t[0].y)); o.y = pk4_fp8(bflo(t[1].x), bfhi(t[1].x), bflo(t[1].y), bfhi(t[1].y));
        o.z = pk4_fp8(bflo(t[2].x), bfhi(t[2].x), bflo(t[2].y), bfhi(t[2].y)); o.w = pk4_fp8(bflo(t[3].x), bfhi(t[3].x), bflo(t[3].y), bfhi(t[3].y));
        *(v4u*)(dst + 16 * kq) = o;
    }
    LDS_WAIT(); asm volatile("" ::: "memory");
}

constexpr int MOE_PREP_ITEMS = 32 * 16 * 16 * 2 + 32 * 16 * 16;
__device__ __forceinline__ void moe_weight_prep(Frame& F, int b0, int lo, int hi) {
    const float* fnw = F.in[10]; const float* w_gu = F.in[13]; const float* w_d = F.in[15];
    unsigned char* WguT = F.ws + WS_WGU; unsigned char* WdT = F.ws + WS_WD;
    LAS unsigned char* scr = F.lds + F.wave * 12288;
    const int gw = ((int)blockIdx.x - b0) * NWAVES + F.wave, NGW = (F.G - b0) * NWAVES;
    constexpr int I_GU = 32 * 16 * 16 * 2;
    for (int it = lo + gw; it < hi; it += NGW) {
        int r = it;
        if (r < I_GU) { const int e = r / 512, r2 = r % 512, kb = r2 / 32, half = (r2 % 32) / 16, t = (r2 % 16) / 2, nb = r2 % 2;
            tr_item8(w_gu + (size_t)e * DM * 2048, 2048, kb * 64, half * 1024 + t * 128 + nb * 64, WguT, (size_t)e * 2048 + t * 256 + half * 128 + nb * 64, DM, fnw, W8_SCALE, scr, F.lane); continue; } r -= I_GU;
        { const int e = r / 256, r2 = r % 256, kb = r2 / 16, nb = r2 % 16; tr_item8(w_d + (size_t)e * DE * DM, DM, kb * 64, nb * 64, WdT, (size_t)e * 1024 + nb * 64, DE, nullptr, W8_SCALE, scr, F.lane); }
    }
}
constexpr int MOE_PREP_SPLIT = 0;

__device__ __forceinline__ void phase_prep(Frame& F) {
    const float* x = F.in[0]; const float* anw = F.in[1]; const float* w_in = F.in[2]; const float* a_log = F.in[4]; const float* dt_bias = F.in[5];
    const float* pool_w = F.in[7]; const float* pool_scale = F.in[8]; const float* w_out = F.in[9]; const float* fnw = F.in[10];
    const float* w_router = F.in[11]; const float* w_gu = F.in[13]; const float* b_gu = F.in[14]; const float* w_d = F.in[15];
    bf16* WinT = (bf16*)(F.ws + WS_WIN); bf16* WoutT = (bf16*)(F.ws + WS_WOUT); bf16* WpoolT = (bf16*)(F.ws + WS_WPOOL);
    bf16* WguT = (bf16*)(F.ws + WS_WGU); bf16* WdT = (bf16*)(F.ws + WS_WD);
    bf16* WrI = (bf16*)(F.ws + WS_WR); float* bguP = (float*)(F.ws + WS_BGU);
    bf16* xb = (bf16*)(F.ws + WS_XB); float* rs1 = (float*)(F.ws + WS_RS1); float* betaA = (float*)(F.ws + WS_BETA); float* gA = (float*)(F.ws + WS_G);
    LAS unsigned char* scr = F.lds + F.wave * 12288;
    LAS float* W8T = (LAS float*)(F.lds + 98304);
    const int gw = F.vcu * NWAVES + F.wave, NGW = F.G * NWAVES;
    const int gt = F.vcu * 512 + F.tid, NGT = F.G * 512;
    for (int idx = F.tid; idx < 8192; idx += 512) { const int k = idx >> 3, c = idx & 7; W8T[c * 1024 + k] = anw[k] * w_in[(size_t)k * DIN + 2048 + c]; }
    __syncthreads();
    constexpr int I_IN1 = 16 * 32, I_IN2 = 16 * 8, I_OUT = 16 * 16, I_POOL = 4 * 2 * 2;
    constexpr int NITEMS = I_IN1 + I_IN2 + I_OUT + I_POOL;
    for (int it = gw; it < NITEMS; it += NGW) {
        int r = it;
        if (r < I_IN1) { const int kb = r / 32, nb = r % 32; tr_item(w_in, DIN, kb * 64, nb * 64, WinT, (size_t)nb * 64, DM, 0, anw, nullptr, scr, F.lane); continue; } r -= I_IN1;
        if (r < I_IN2) { const int kb = r / 8, nb = r % 8; tr_item(w_in, DIN, kb * 64, 2056 + nb * 64, WinT, (size_t)2048 + nb * 64, DM, 0, anw, nullptr, scr, F.lane); continue; } r -= I_IN2;
        if (r < I_OUT) { const int kb = r / 16, nb = r % 16; tr_item(w_out, DM, kb * 64, nb * 64, WoutT, (size_t)nb * 64, DM, 0, nullptr, nullptr, scr, F.lane); continue; } r -= I_OUT;
        { const int g = r / 4, kb = (r % 4) / 2, nb = r % 2; tr_item(pool_w + (size_t)g * 128 * 128, 128, kb * 64, nb * 64, WpoolT, (size_t)g * 128 + nb * 64, 512, g * 128, nullptr, pool_scale + g * 128, scr, F.lane); }
    }
    moe_weight_prep(F, 0, 0, MOE_PREP_SPLIT);
    for (int idx = gt; idx < NE * 2048; idx += NGT) { const int e = idx >> 11, r = idx & 2047, t = r >> 8, j = r & 255, half = j >> 7, jj = j & 127; bguP[idx] = b_gu[(size_t)e * 2048 + half * 1024 + t * 128 + jj]; }
    for (int idx = gt; idx < 64 * 64 * 8; idx += NGT) { const int j = idx & 7, ln = (idx >> 3) & 63, fr2 = idx >> 9, nb = fr2 & 1, ks = fr2 >> 1;
        const int k = 32 * ks + 8 * (ln >> 4) + j, e = 16 * nb + (ln & 15); const float v = fnw[k] * w_router[(size_t)k * NE + e];
        const unsigned hb = f2bf(v); const float hf = __builtin_bit_cast(float, hb << 16); const unsigned lb = f2bf(v - hf);
        WrI[((size_t)(fr2 * 2 + 0) * 64 + ln) * 8 + j] = (bf16)hb; WrI[((size_t)(fr2 * 2 + 1) * 64 + ln) * 8 + j] = (bf16)lb; }
    for (int idx = gt; idx < 512 * 64; idx += NGT) { const int n = idx >> 6, ch = idx & 63; if ((n >> 7) != (ch >> 4)) *(v4u*)(WpoolT + (size_t)n * 512 + ch * 8) = (v4u){0u, 0u, 0u, 0u}; }
    for (int m = gw; m < NTOK; m += NGW) {
        const f32x4* xr = (const f32x4*)(x + (size_t)m * DM) + F.lane;
        f32x4 v[4]; float ss = 0.f; float d8[8];
#pragma unroll
        for (int c = 0; c < 8; ++c) d8[c] = 0.f;
#pragma unroll
        for (int j = 0; j < 4; ++j) { v[j] = xr[64 * j]; ss += (v[j].x * v[j].x + v[j].y * v[j].y) + (v[j].z * v[j].z + v[j].w * v[j].w); }
#pragma unroll
        for (int c = 0; c < 8; ++c)
#pragma unroll
            for (int j = 0; j < 4; ++j) { const f32x4 w = *(const LAS f32x4*)(W8T + c * 1024 + 256 * j + 4 * F.lane); d8[c] += (v[j].x * w.x + v[j].y * w.y) + (v[j].z * w.z + v[j].w * w.w); }
        ss = wave_sum(ss);
#pragma unroll
        for (int c = 0; c < 8; ++c) d8[c] = wave_sum(d8[c]);
        const float rs = 1.f / sqrtf(ss * (1.f / DM) + 1e-6f);
        unsigned long long* o8 = (unsigned long long*)(xb + (size_t)m * DM) + F.lane;
#pragma unroll
        for (int j = 0; j < 4; ++j) o8[64 * j] = (unsigned long long)pk2(v[j].x, v[j].y) | ((unsigned long long)pk2(v[j].z, v[j].w) << 32);
        if (F.lane == 0) rs1[m] = rs;
        if (F.lane < 4) {
            float bl = 0.f, al = 0.f;
#pragma unroll
            for (int c = 0; c < 4; ++c) { bl = (F.lane == c) ? d8[c] : bl; al = (F.lane == c) ? d8[4 + c] : al; }
            bl *= rs; al *= rs;
            betaA[(size_t)m * 4 + F.lane] = 1.f / (1.f + expf(-bl));
            const float z = al + dt_bias[F.lane]; const float sp = z > 20.f ? z : log1pf(expf(z));
            gA[(size_t)m * 4 + F.lane] = -expf(a_log[F.lane]) * sp;
        }
    }
}

__device__ __forceinline__ void phase_mix(Frame& F) {
    const bf16* proj = (const bf16*)(F.ws + WS_PROJ); bf16* mixed = (bf16*)(F.ws + WS_MIXED);
    const int gw = F.vcu * NWAVES + F.wave, NGW = F.G * NWAVES;
    const int ch = 8 * F.lane, gi = F.lane >> 4, win = 2 << gi, hal = win - 1;
    for (int rbk = gw; rbk < NTOK / 16; rbk += NGW) {
        const int m0 = rbk * 16, t0 = m0 % SEQ;
        v4u X[31];
#pragma unroll
        for (int k = 0; k < 31; ++k) { X[k] = (v4u){0u, 0u, 0u, 0u}; if (k >= 15 - hal && t0 - 15 + k >= 0) X[k] = *(const v4u*)(proj + (size_t)(m0 - 15 + k) * NPROJ + 2048 + ch); }
        float s[8];
#pragma unroll
        for (int q = 0; q < 8; ++q) s[q] = 0.f;
#pragma unroll
        for (int k = 0; k < 15; ++k) { s[0] += bflo(X[k].x); s[1] += bfhi(X[k].x); s[2] += bflo(X[k].y); s[3] += bfhi(X[k].y); s[4] += bflo(X[k].z); s[5] += bfhi(X[k].z); s[6] += bflo(X[k].w); s[7] += bfhi(X[k].w); }
#pragma unroll
        for (int r = 0; r < 16; ++r) {
            const v4u u = X[15 + r];
            const float p[8] = {bflo(u.x), bfhi(u.x), bflo(u.y), bfhi(u.y), bflo(u.z), bfhi(u.z), bflo(u.w), bfhi(u.w)};
#pragma unroll
            for (int q = 0; q < 8; ++q) s[q] += p[q];
            const int tt = t0 + r + 1; const float ic = 1.f / (float)(tt < win ? tt : win);
            v4u o; o.x = pk2(s[0] * ic - p[0], s[1] * ic - p[1]); o.y = pk2(s[2] * ic - p[2], s[3] * ic - p[3]); o.z = pk2(s[4] * ic - p[4], s[5] * ic - p[5]); o.w = pk2(s[6] * ic - p[6], s[7] * ic - p[7]);
            *(v4u*)(mixed + (size_t)(m0 + r) * 512 + ch) = o;
            const v4u od = gi == 0 ? X[14 + r] : gi == 1 ? X[12 + r] : gi == 2 ? X[8 + r] : X[r];
            s[0] -= bflo(od.x); s[1] -= bfhi(od.x); s[2] -= bflo(od.y); s[3] -= bfhi(od.y); s[4] -= bflo(od.z); s[5] -= bfhi(od.z); s[6] -= bflo(od.w); s[7] -= bfhi(od.w);
        }
    }
}

typedef float f32x16 __attribute__((ext_vector_type(16)));
__device__ __forceinline__ bf16x8 pack8(const f32x4 a, const f32x4 b) {
    v4u w; w.x = cvt_pk_bf16(a[0], a[1]); w.y = cvt_pk_bf16(a[2], a[3]); w.z = cvt_pk_bf16(b[0], b[1]); w.w = cvt_pk_bf16(b[2], b[3]);
    return __builtin_bit_cast(bf16x8, w);
}
__device__ __forceinline__ void fmac_(float& acc, float a, float b) { asm("v_fmac_f32 %0, %1, %2" : "+v"(acc) : "v"(a), "v"(b)); }
__device__ __forceinline__ float bf2f(unsigned short u) { return __builtin_bit_cast(float, (unsigned)u << 16); }

constexpr int CP_QN = 0, CP_KN = 17408, CP_VA = 34816, CP_QKL = 51200, CP_SC = 59392, CP_HALF = 61440;
__device__ __forceinline__ void phase_chunk(Frame& F) {
    const float* conv_w = F.in[3];
    const bf16* proj = (const bf16*)(F.ws + WS_PROJ);
    const float* betaA = (const float*)(F.ws + WS_BETA); const float* gA = (const float*)(F.ws + WS_G);
    float* gtotA = (float*)(F.ws + WS_GTOT);
    const int half = F.wave >> 2, hw = F.wave & 3, ht = F.tid & 255, lane = F.lane;
    LAS unsigned char* L = F.lds + half * CP_HALF;
    LAS bf16* qn = (LAS bf16*)(L + CP_QN); LAS bf16* kn = (LAS bf16*)(L + CP_KN); LAS bf16* vn = (LAS bf16*)(L + CP_VA);
    LAS float* Am = (LAS float*)(L + CP_VA); LAS bf16* qkL = (LAS bf16*)(L + CP_QKL); LAS float* sc = (LAS float*)(L + CP_SC);
    const int r16 = lane & 15, gq = lane >> 4;
#pragma unroll 1
    for (int it = 0; it < 4; ++it) {
        const int unit = (it * (int)gridDim.x + (int)blockIdx.x) * 2 + half;
        const bool live = unit < NB * NH * 64;
        const int bh = unit >> 6, n = unit & 63, b = bh >> 2, h = bh & 3;
        const size_t m0 = (size_t)b * SEQ + (size_t)n * 64;
        unsigned char* chunk = F.ws + WS_CHUNK + (size_t)unit * CH_BYTES;
        if (live && hw == 0) {
            const float gi = gA[(m0 + lane) * 4 + h], bi = betaA[(m0 + lane) * 4 + h];
            float c = gi;
#pragma unroll
            for (int o = 1; o < 64; o <<= 1) { const float tt = __shfl_up(c, o); if (lane >= o) c += tt; }
            const float gl = __shfl(c, 63);
            sc[lane] = bi; sc[64 + lane] = c; sc[128 + lane] = __expf(c); sc[192 + lane] = __expf(gl - c);
            if (lane == 63) gtotA[unit] = __expf(c);
        }
        if (live) {
            const int rq = ht >> 4, cg = ht & 15;
#pragma unroll 1
            for (int p = 0; p < 3; ++p) {
                const int col = p * 512 + h * 128 + 8 * cg;
                float xin[7][8];
#pragma unroll
                for (int jj = 0; jj < 7; ++jj) { const int trow = n * 64 + 4 * rq - 3 + jj; v4u u = (v4u){0u, 0u, 0u, 0u};
                    if (trow >= 0) u = *(const v4u*)(proj + ((size_t)b * SEQ + trow) * NPROJ + col);
                    xin[jj][0] = bflo(u.x); xin[jj][1] = bfhi(u.x); xin[jj][2] = bflo(u.y); xin[jj][3] = bfhi(u.y); xin[jj][4] = bflo(u.z); xin[jj][5] = bfhi(u.z); xin[jj][6] = bflo(u.w); xin[jj][7] = bfhi(u.w); }
                float wv[4][8];
#pragma unroll
                for (int j = 0; j < 4; ++j) { const f32x4 w0 = *(const f32x4*)(conv_w + j * 1536 + col), w1 = *(const f32x4*)(conv_w + j * 1536 + col + 4);
                    wv[j][0] = w0.x; wv[j][1] = w0.y; wv[j][2] = w0.z; wv[j][3] = w0.w; wv[j][4] = w1.x; wv[j][5] = w1.y; wv[j][6] = w1.z; wv[j][7] = w1.w; }
#pragma unroll
                for (int rr = 0; rr < 4; ++rr) {
                    float y[8]; float ss = 0.f;
#pragma unroll
                    for (int q = 0; q < 8; ++q) { float a = 0.f;
#pragma unroll
                        for (int j = 0; j < 4; ++j) a += wv[j][q] * xin[rr + j][q];
                        y[q] = siluf_(a); ss += y[q] * y[q]; }
                    float scl = 1.f;
                    if (p < 2) { ss += __shfl_xor(ss, 1); ss += __shfl_xor(ss, 2); ss += __shfl_xor(ss, 4); ss += __shfl_xor(ss, 8); scl = frsq_(ss + 1e-6f); if (p == 0) scl *= 0.08838834764831845f; }
                    v4u o; o.x = pk2(y[0] * scl, y[1] * scl); o.y = pk2(y[2] * scl, y[3] * scl); o.z = pk2(y[4] * scl, y[5] * scl); o.w = pk2(y[6] * scl, y[7] * scl);
                    const int row = 4 * rq + rr;
                    if (p == 0) *(LAS v4u*)(qn + row * 136 + 8 * cg) = o; else if (p == 1) *(LAS v4u*)(kn + row * 136 + 8 * cg) = o; else *(LAS v4u*)(vn + row * 128 + 8 * cg) = o;
                }
            }
        }
        __syncthreads();
        const int which = ht >> 7, c = ht & 127;
        float U[64];
        if (live) {
#pragma unroll
            for (int i = 0; i < 64; ++i) { const float bi = sc[i]; const float tv = which ? bf2f(kn[i * 136 + c]) * sc[128 + i] : bf2f(vn[i * 128 + c]); U[i] = tv * bi; }
        } else {
#pragma unroll
            for (int i = 0; i < 64; ++i) U[i] = 0.f;
        }
        __syncthreads();
        if (live) {
            const int ti = hw >> 1, tj = hw & 1, r = lane & 31, hh = lane >> 5;
            f32x16 KK, QK;
#pragma unroll
            for (int q = 0; q < 16; ++q) { KK[q] = 0.f; QK[q] = 0.f; }
#pragma unroll
            for (int ks = 0; ks < 8; ++ks) {
                const bf16x8 ak = *(const LAS bf16x8*)(kn + (ti * 32 + r) * 136 + 16 * ks + 8 * hh);
                const bf16x8 aq = *(const LAS bf16x8*)(qn + (ti * 32 + r) * 136 + 16 * ks + 8 * hh);
                const bf16x8 bb = *(const LAS bf16x8*)(kn + (tj * 32 + r) * 136 + 16 * ks + 8 * hh);
                KK = __builtin_amdgcn_mfma_f32_32x32x16_bf16(ak, bb, KK, 0, 0, 0);
                QK = __builtin_amdgcn_mfma_f32_32x32x16_bf16(aq, bb, QK, 0, 0, 0);
            }
            const int j = tj * 32 + r; const float gcj = sc[64 + j];
#pragma unroll
            for (int reg = 0; reg < 16; ++reg) { const int i = ti * 32 + (reg & 3) + 8 * (reg >> 2) + 4 * hh;
                const float dec = (i >= j) ? __expf(sc[64 + i] - gcj) : 0.f;
                Am[i * 64 + j] = (i > j) ? sc[i] * KK[reg] * dec : 0.f;
                qkL[i * 64 + j] = (bf16)f2bf((i >= j) ? QK[reg] * dec : 0.f); }
        }
        __syncthreads();
        if (live) {
#pragma unroll
            for (int fi = 0; fi < 4; ++fi) { const int f = hw * 4 + fi, mb = f >> 2, ks = f & 3, row = 16 * mb + r16; const float s = sc[128 + row];
                const v2u lo = *(const LAS v2u*)(qn + row * 136 + 32 * ks + 4 * gq), hi = *(const LAS v2u*)(qn + row * 136 + 32 * ks + 16 + 4 * gq);
                v4u o; o.x = pk2(bflo(lo.x) * s, bfhi(lo.x) * s); o.y = pk2(bflo(lo.y) * s, bfhi(lo.y) * s); o.z = pk2(bflo(hi.x) * s, bfhi(hi.x) * s); o.w = pk2(bflo(hi.y) * s, bfhi(hi.y) * s);
                *(v4u*)(chunk + CH_QD + (f * 64 + lane) * 16) = o; }
#pragma unroll
            for (int fi = 0; fi < 4; ++fi) { const int f = hw * 4 + fi, db = f >> 1, ksp = f & 1, dcol = 16 * db + r16; float e[8];
#pragma unroll
                for (int j = 0; j < 8; ++j) { const int i = 32 * ksp + 16 * (j >> 2) + 4 * gq + (j & 3); e[j] = bf2f(kn[i * 136 + dcol]) * sc[192 + i]; }
                v4u o; o.x = pk2(e[0], e[1]); o.y = pk2(e[2], e[3]); o.z = pk2(e[4], e[5]); o.w = pk2(e[6], e[7]);
                *(v4u*)(chunk + CH_KT + (f * 64 + lane) * 16) = o; }
#pragma unroll
            for (int fi = 0; fi < 2; ++fi) { const int f = hw * 2 + fi, mb = f >> 1, ksp = f & 1, row = 16 * mb + r16;
                const v2u lo = *(const LAS v2u*)(qkL + row * 64 + 32 * ksp + 4 * gq), hi = *(const LAS v2u*)(qkL + row * 64 + 32 * ksp + 16 + 4 * gq);
                *(v4u*)(chunk + CH_QK + (f * 64 + lane) * 16) = (v4u){lo.x, lo.y, hi.x, hi.y}; }
#pragma unroll
            for (int i = 1; i < 64; ++i) {
                float s0 = 0.f, s1 = 0.f, s2 = 0.f, s3 = 0.f;
#pragma unroll
                for (int j4 = 0; j4 < (i + 3) / 4; ++j4) { const f32x4 a = *(const LAS f32x4*)(Am + i * 64 + 4 * j4);
                    fmac_(s0, a.x, U[4 * j4]); if (4 * j4 + 1 < i) fmac_(s1, a.y, U[4 * j4 + 1]); if (4 * j4 + 2 < i) fmac_(s2, a.z, U[4 * j4 + 2]); if (4 * j4 + 3 < i) fmac_(s3, a.w, U[4 * j4 + 3]); }
                U[i] -= (s0 + s1) + (s2 + s3);
                __builtin_amdgcn_sched_barrier(0);
            }
        }
        __syncthreads();
        if (live) {
            if (which == 0) {
                const int w8 = c >> 4, cl = c & 15;
                unsigned char* ub = F.ws + WS_UC + (size_t)unit * UC_BYTES;
#pragma unroll
                for (int g = 0; g < 4; ++g) {
                    v4u lo, hi;
                    lo.x = pk2(U[4 * g], U[4 * g + 1]); lo.y = pk2(U[4 * g + 2], U[4 * g + 3]); lo.z = pk2(U[16 + 4 * g], U[16 + 4 * g + 1]); lo.w = pk2(U[16 + 4 * g + 2], U[16 + 4 * g + 3]);
                    hi.x = pk2(U[32 + 4 * g], U[32 + 4 * g + 1]); hi.y = pk2(U[32 + 4 * g + 2], U[32 + 4 * g + 3]); hi.z = pk2(U[48 + 4 * g], U[48 + 4 * g + 1]); hi.w = pk2(U[48 + 4 * g + 2], U[48 + 4 * g + 3]);
                    v4u* dst = (v4u*)(ub + ((w8 * 64 + g * 16 + cl) * 32)); dst[0] = lo; dst[1] = hi;
                }
            } else {
#pragma unroll
                for (int i = 0; i < 64; ++i) qn[i * 136 + c] = (bf16)f2bf(U[i]);
            }
        }
        __syncthreads();
        if (live) {
#pragma unroll
            for (int fi = 0; fi < 4; ++fi) { const int f = hw * 4 + fi, mb = f >> 2, ks = f & 3, row = 16 * mb + r16;
                const v2u lo = *(const LAS v2u*)(qn + row * 136 + 32 * ks + 4 * gq), hi = *(const LAS v2u*)(qn + row * 136 + 32 * ks + 16 + 4 * gq);
                *(v4u*)(chunk + CH_WF + (f * 64 + lane) * 16) = (v4u){lo.x, lo.y, hi.x, hi.y}; }
        }
        __syncthreads();
    }
}

__device__ __forceinline__ void phase_scan(Frame& F) {
    const int bh = blockIdx.x, b = bh >> 2, h = bh & 3, w = F.wave, lane = F.lane, cl = lane & 15, gq = lane >> 4;
    const float* gtotA = (const float*)(F.ws + WS_GTOT);
    const int unit0 = bh * 64;
    const unsigned char* cbase = F.ws + WS_CHUNK + (size_t)unit0 * CH_BYTES;
    const unsigned char* ubase = F.ws + WS_UC + (size_t)unit0 * UC_BYTES + (w * 64 + lane) * 32;
    bf16* op = (bf16*)(F.ws + WS_ORAW) + ((size_t)b * SEQ + cl) * 512 + h * 128 + 16 * w + 4 * gq;
    f32x4 Sacc[8]; bf16x8 Sb[4];
#pragma unroll
    for (int d = 0; d < 8; ++d) Sacc[d] = (f32x4){0.f, 0.f, 0.f, 0.f};
#pragma unroll
    for (int k = 0; k < 4; ++k) Sb[k] = (bf16x8){0, 0, 0, 0, 0, 0, 0, 0};
#define SCAN_ISSUE(nn) do { const unsigned char* s_ = cbase + (size_t)(nn) * CH_BYTES + (w * 7) * 1024 + lane * 16; LAS unsigned char* d_ = F.lds + ((nn) & 1) * CH_BYTES + (w * 7) * 1024; \
        _Pragma("unroll") for (int k_ = 0; k_ < 7; ++k_) __builtin_amdgcn_global_load_lds((const unsigned*)(s_ + k_ * 1024), (LAS unsigned*)(d_ + k_ * 1024), 16, 0, 0); } while (0)
    SCAN_ISSUE(0);
    v4u nu0 = *(const v4u*)(ubase), nu1 = *(const v4u*)(ubase + 16);
    float ngt = gtotA[unit0];
    v2u Ow[4];
#pragma unroll
    for (int mb = 0; mb < 4; ++mb) Ow[mb] = (v2u){0u, 0u};
#pragma unroll 1
    for (int n = 0; n < 64; ++n) {
        VM_WAIT(); __syncthreads();
        const v4u cu0 = nu0, cu1 = nu1; const float gt = ngt;
        if (n + 1 < 64) { SCAN_ISSUE(n + 1); nu0 = *(const v4u*)(ubase + (size_t)(n + 1) * UC_BYTES); nu1 = *(const v4u*)(ubase + (size_t)(n + 1) * UC_BYTES + 16); ngt = gtotA[unit0 + n + 1]; }
        if (n > 0) {
#pragma unroll
            for (int mb = 0; mb < 4; ++mb) *(v2u*)(op + (size_t)((n - 1) * 64 + 16 * mb) * 512) = Ow[mb];
        }
        const LAS unsigned char* B = F.lds + (n & 1) * CH_BYTES;
#define FRAG(off, f) (*(const LAS bf16x8*)(B + (off) + ((f) * 64 + lane) * 16))
        f32x4 P[4];
#pragma unroll
        for (int mb = 0; mb < 4; ++mb) { P[mb] = (f32x4){0.f, 0.f, 0.f, 0.f};
#pragma unroll
            for (int ks = 0; ks < 4; ++ks) P[mb] = __builtin_amdgcn_mfma_f32_16x16x32_bf16(FRAG(CH_WF, mb * 4 + ks), Sb[ks], P[mb], 0, 0, 0); }
        f32x4 vnw[4];
        vnw[0] = (f32x4){bflo(cu0.x), bfhi(cu0.x), bflo(cu0.y), bfhi(cu0.y)} - P[0];
        vnw[1] = (f32x4){bflo(cu0.z), bfhi(cu0.z), bflo(cu0.w), bfhi(cu0.w)} - P[1];
        vnw[2] = (f32x4){bflo(cu1.x), bfhi(cu1.x), bflo(cu1.y), bfhi(cu1.y)} - P[2];
        vnw[3] = (f32x4){bflo(cu1.z), bfhi(cu1.z), bflo(cu1.w), bfhi(cu1.w)} - P[3];
        bf16x8 Vb[2]; Vb[0] = pack8(vnw[0], vnw[1]); Vb[1] = pack8(vnw[2], vnw[3]);
#pragma unroll
        for (int db = 0; db < 8; ++db) { Sacc[db] = Sacc[db] * gt;
#pragma unroll
            for (int ksp = 0; ksp < 2; ++ksp) Sacc[db] = __builtin_amdgcn_mfma_f32_16x16x32_bf16(FRAG(CH_KT, db * 2 + ksp), Vb[ksp], Sacc[db], 0, 0, 0); }
#pragma unroll
        for (int mb = 0; mb < 4; ++mb) { f32x4 OT = (f32x4){0.f, 0.f, 0.f, 0.f};
#pragma unroll
            for (int ks = 0; ks < 4; ++ks) OT = __builtin_amdgcn_mfma_f32_16x16x32_bf16(Sb[ks], FRAG(CH_QD, mb * 4 + ks), OT, 0, 0, 0);
#pragma unroll
            for (int ksp = 0; ksp < 2; ++ksp) OT = __builtin_amdgcn_mfma_f32_16x16x32_bf16(Vb[ksp], FRAG(CH_QK, mb * 2 + ksp), OT, 0, 0, 0);
            Ow[mb] = (v2u){cvt_pk_bf16(OT[0], OT[1]), cvt_pk_bf16(OT[2], OT[3])}; }
#pragma unroll
        for (int ks = 0; ks < 4; ++ks) Sb[ks] = pack8(Sacc[2 * ks], Sacc[2 * ks + 1]);
#undef FRAG
    }
#undef SCAN_ISSUE
#pragma unroll
    for (int mb = 0; mb < 4; ++mb) *(v2u*)(op + (size_t)(63 * 64 + 16 * mb) * 512) = Ow[mb];
    VM_WAIT(); __syncthreads();
}

__device__ __forceinline__ void phase_onorm(Frame& F) {
    const float* dnw = F.in[6]; const bf16* proj = (const bf16*)(F.ws + WS_PROJ); const bf16* oraw = (const bf16*)(F.ws + WS_ORAW); bf16* concat = (bf16*)(F.ws + WS_CONCAT);
    const int gw = F.vcu * NWAVES + F.wave, NGW = F.G * NWAVES, lane = F.lane;
    const int cc = 8 * (lane & 15);
    const f32x4 d0 = *(const f32x4*)(dnw + cc), d1 = *(const f32x4*)(dnw + cc + 4);
    for (int m = gw; m < NTOK; m += NGW) {
        const v4u o = *(const v4u*)(oraw + (size_t)m * 512 + 8 * lane);
        const v4u z = *(const v4u*)(proj + (size_t)m * NPROJ + 1536 + 8 * lane);
        const float ov[8] = {bflo(o.x), bfhi(o.x), bflo(o.y), bfhi(o.y), bflo(o.z), bfhi(o.z), bflo(o.w), bfhi(o.w)};
        const float zv[8] = {bflo(z.x), bfhi(z.x), bflo(z.y), bfhi(z.y), bflo(z.z), bfhi(z.z), bflo(z.w), bfhi(z.w)};
        float ss = 0.f;
#pragma unroll
        for (int q = 0; q < 8; ++q) ss += ov[q] * ov[q];
        ss += __shfl_xor(ss, 1); ss += __shfl_xor(ss, 2); ss += __shfl_xor(ss, 4); ss += __shfl_xor(ss, 8);
        const float rs = frsq_(ss * (1.f / 128.f) + 1e-6f);
        const float dv[8] = {d0.x, d0.y, d0.z, d0.w, d1.x, d1.y, d1.z, d1.w};
        float r[8];
#pragma unroll
        for (int q = 0; q < 8; ++q) r[q] = ov[q] * rs * dv[q] * siluf_(zv[q]);
        *(v4u*)(concat + (size_t)m * DM + 8 * lane) = (v4u){cvt_pk_bf16(r[0], r[1]), cvt_pk_bf16(r[2], r[3]), cvt_pk_bf16(r[4], r[5]), cvt_pk_bf16(r[6], r[7])};
    }
}

__device__ __forceinline__ void phase_route(Frame& F) {
    const float* x1 = F.out; const float* b_router = F.in[12];
    unsigned char* x1b = F.ws + WS_X1B; float* rs2A = (float*)(F.ws + WS_RS2); float* gatew = (float*)(F.ws + WS_GATEW); int* list = (int*)(F.ws + WS_LIST);
    unsigned* cntw = (unsigned*)(F.ws + WS_CTL) + CW_CNT;
    LAS unsigned char* WI = F.lds;
    LAS unsigned* lcnt = (LAS unsigned*)(F.lds + TAB_OFF);
    { const v4u* src = (const v4u*)(F.ws + WS_WR);
      for (int idx = F.tid; idx < 131072 / 16; idx += 512) *(LAS v4u*)(WI + 16 * idx) = src[idx]; }
    const int lane = F.lane, c = lane & 15, g = lane >> 4;
    const int gw = F.vcu * NWAVES + F.wave, NGW = F.G * NWAVES, NT = NTOK / 16;
    const float bia0 = b_router[c], bia1 = b_router[16 + c];
    for (int t0 = 0; t0 < NT; t0 += NGW) {
        const int tile = t0 + gw; const bool live = tile < NT;
        if (F.tid < 64) lcnt[F.tid] = 0u;
        __syncthreads();
        int my_e = 0; float my_g = 0.f; unsigned my_rank = 0u; int my_ent = 0;
        if (live) {
            const int m0 = tile * 16;
            const float* xrow = x1 + (size_t)(m0 + c) * DM + 8 * g;
            unsigned char* xbrow = x1b + (size_t)(m0 + c) * DM + 8 * g;
            f32x4 acc0 = (f32x4){0.f, 0.f, 0.f, 0.f}, acc1 = acc0; float ssq = 0.f;
#pragma unroll 1
            for (int kb = 0; kb < 4; ++kb) {
                f32x4 xa[8], xb4[8];
#pragma unroll
                for (int q = 0; q < 8; ++q) { xa[q] = *(const f32x4*)(xrow + 32 * (kb * 8 + q)); xb4[q] = *(const f32x4*)(xrow + 32 * (kb * 8 + q) + 4); }
#pragma unroll
                for (int q = 0; q < 8; ++q) { const int ks = kb * 8 + q; const f32x4 a = xa[q], b = xb4[q];
                    ssq += (a.x * a.x + a.y * a.y) + (a.z * a.z + a.w * a.w) + (b.x * b.x + b.y * b.y) + (b.z * b.z + b.w * b.w);
                    v4u h; h.x = cvt_pk_bf16(a.x, a.y); h.y = cvt_pk_bf16(a.z, a.w); h.z = cvt_pk_bf16(b.x, b.y); h.w = cvt_pk_bf16(b.z, b.w);
                    v4u l; l.x = cvt_pk_bf16(a.x - bflo(h.x), a.y - bfhi(h.x)); l.y = cvt_pk_bf16(a.z - bflo(h.y), a.w - bfhi(h.y)); l.z = cvt_pk_bf16(b.x - bflo(h.z), b.y - bfhi(h.z)); l.w = cvt_pk_bf16(b.z - bflo(h.w), b.w - bfhi(h.w));
                    *(v2u*)(xbrow + 32 * ks) = (v2u){pk4_fp8(a.x, a.y, a.z, a.w), pk4_fp8(b.x, b.y, b.z, b.w)};
                    const bf16x8 ah = __builtin_bit_cast(bf16x8, h), al = __builtin_bit_cast(bf16x8, l);
                    const LAS unsigned char* fb = WI + (size_t)(ks * 4) * 1024 + lane * 16;
                    const bf16x8 b0h = *(const LAS bf16x8*)(fb), b0l = *(const LAS bf16x8*)(fb + 1024), b1h = *(const LAS bf16x8*)(fb + 2048), b1l = *(const LAS bf16x8*)(fb + 3072);
                    acc0 = __builtin_amdgcn_mfma_f32_16x16x32_bf16(ah, b0h, acc0, 0, 0, 0); acc0 = __builtin_amdgcn_mfma_f32_16x16x32_bf16(ah, b0l, acc0, 0, 0, 0); acc0 = __builtin_amdgcn_mfma_f32_16x16x32_bf16(al, b0h, acc0, 0, 0, 0);
                    acc1 = __builtin_amdgcn_mfma_f32_16x16x32_bf16(ah, b1h, acc1, 0, 0, 0); acc1 = __builtin_amdgcn_mfma_f32_16x16x32_bf16(ah, b1l, acc1, 0, 0, 0); acc1 = __builtin_amdgcn_mfma_f32_16x16x32_bf16(al, b1h, acc1, 0, 0, 0); }
            }
            ssq += __shfl_xor(ssq, 16); ssq += __shfl_xor(ssq, 32);
            const float rsr = frsq_(ssq * (1.f / DM) + 1e-6f);
            if (g == 0) rs2A[m0 + c] = rsr;
            float ge_[4]; int ee_[4];
#pragma unroll
            for (int reg = 0; reg < 4; ++reg) {
                const float rsw = __shfl(rsr, 4 * g + reg);
                float v0 = acc0[reg] * rsw + bia0, v1 = acc1[reg] * rsw + bia1;
                float tv[4]; int te[4];
#pragma unroll
                for (int s = 0; s < 4; ++s) {
                    float bv; int bi; if (v1 > v0) { bv = v1; bi = 16 + c; } else { bv = v0; bi = c; }
#pragma unroll
                    for (int o = 1; o < 16; o <<= 1) { const float ov = __shfl_xor(bv, o); const int oi = __shfl_xor(bi, o); if (ov > bv || (ov == bv && oi < bi)) { bv = ov; bi = oi; } }
                    tv[s] = bv; te[s] = bi; if (bi == c) v0 = -3.0e38f; if (bi == 16 + c) v1 = -3.0e38f;
                }
                const float e1 = fexp_(tv[1] - tv[0]), e2 = fexp_(tv[2] - tv[0]), e3 = fexp_(tv[3] - tv[0]); const float inv = frcp_(1.f + e1 + e2 + e3);
                const int s_ = c & 3; const float gsel = (s_ == 0 ? 1.f : s_ == 1 ? e1 : s_ == 2 ? e2 : e3) * inv; const int esel = s_ == 0 ? te[0] : s_ == 1 ? te[1] : s_ == 2 ? te[2] : te[3];
                ge_[reg] = gsel; ee_[reg] = esel;
            }
            const int rsel = c >> 2;
            my_g = rsel == 0 ? ge_[0] : rsel == 1 ? ge_[1] : rsel == 2 ? ge_[2] : ge_[3];
            my_e = rsel == 0 ? ee_[0] : rsel == 1 ? ee_[1] : rsel == 2 ? ee_[2] : ee_[3];
            my_ent = (m0 + 4 * g + rsel) * 4 + (c & 3);
            my_rank = __hip_atomic_fetch_add(lcnt + my_e, 1u, __ATOMIC_RELAXED, __HIP_MEMORY_SCOPE_WORKGROUP);
        }
        __syncthreads();
        if (F.tid < NE) { const unsigned n = lcnt[F.tid]; lcnt[32 + F.tid] = n ? __hip_atomic_fetch_add(cntw + 64 * F.tid, n, RLX_AGENT) : 0u; }
        __syncthreads();
        if (live) { const unsigned pos = lcnt[32 + my_e] + my_rank; list[(size_t)my_e * LISTCAP + pos] = my_ent; gatew[my_ent] = my_g; }
        __syncthreads();
    }
}

__device__ __forceinline__ int moe_tables(Frame& F, MoeTab& T) {
    LAS int* pref = (LAS int*)(F.lds + TAB_OFF); LAS int* cnt = pref + 40;
    unsigned* cntw = (unsigned*)(F.ws + WS_CTL) + CW_CNT;
    if (F.tid == 0) { int acc = 0; for (int e = 0; e < NE; ++e) { const int c = (int)__hip_atomic_load(cntw + 64 * e, RLX_AGENT); cnt[e] = c; pref[e] = acc; acc += (c + 255) >> 8; } pref[NE] = acc; }
    __syncthreads();
    T.pref = pref; T.cnt = cnt;
    return pref[NE];
}

struct FinalRow { f32x4 v[4]; v4u sl[4][2]; };
__device__ __forceinline__ void final_load(FinalRow& R, const float* orow, const bf16* srow) {
#pragma unroll
    for (int j = 0; j < 2; ++j) { R.v[2 * j] = *(const f32x4*)(orow + 512 * j); R.v[2 * j + 1] = *(const f32x4*)(orow + 512 * j + 4); }
#pragma unroll
    for (int s = 0; s < 4; ++s)
#pragma unroll
        for (int j = 0; j < 2; ++j) R.sl[s][j] = *(const v4u*)(srow + (size_t)s * DM + 512 * j);
}
__device__ __forceinline__ void final_finish(FinalRow& R, float* orow, const f32x4 (&wv)[4], size_t dry_off) {
    orow += dry_off;
#pragma unroll
    for (int s = 0; s < 4; ++s)
#pragma unroll
        for (int j = 0; j < 2; ++j) { const v4u u = R.sl[s][j];
            R.v[2 * j].x += bflo(u.x); R.v[2 * j].y += bfhi(u.x); R.v[2 * j].z += bflo(u.y); R.v[2 * j].w += bfhi(u.y);
            R.v[2 * j + 1].x += bflo(u.z); R.v[2 * j + 1].y += bfhi(u.z); R.v[2 * j + 1].z += bflo(u.w); R.v[2 * j + 1].w += bfhi(u.w); }
    float ss = 0.f;
#pragma unroll
    for (int j = 0; j < 4; ++j) ss += (R.v[j].x * R.v[j].x + R.v[j].y * R.v[j].y) + (R.v[j].z * R.v[j].z + R.v[j].w * R.v[j].w);
    ss = wave_sum(ss);
    const float rs = frsq_(ss * (1.f / DM) + 1e-6f);
#pragma unroll
    for (int j = 0; j < 2; ++j) { *(f32x4*)(orow + 512 * j) = R.v[2 * j] * rs * wv[2 * j]; *(f32x4*)(orow + 512 * j + 4) = R.v[2 * j + 1] * rs * wv[2 * j + 1]; }
}
__device__ __forceinline__ void phase_final(Frame& F, int dryrun) {
    const float* fw = F.in[17]; const bf16* slab = (const bf16*)(F.ws + WS_SLAB); float* out = F.out;
    const int gw = F.vcu * NWAVES + F.wave, NGW = F.G * NWAVES, lane = F.lane;
    f32x4 wv[4];
#pragma unroll
    for (int j = 0; j < 2; ++j) { wv[2 * j] = *(const f32x4*)(fw + 512 * j + 8 * lane); wv[2 * j + 1] = *(const f32x4*)(fw + 512 * j + 8 * lane + 4); }
    const size_t dry_off = dryrun ? (size_t)((float*)(F.ws + WS_XB) - out) : 0;
    FinalRow A, B;
    int m = gw;
    if (m < NTOK) final_load(A, out + (size_t)m * DM + 8 * lane, slab + (size_t)m * 4 * DM + 8 * lane);
    for (; m < NTOK; m += 2 * NGW) {
        const int m1 = m + NGW, m2 = m + 2 * NGW;
        if (m1 < NTOK) final_load(B, out + (size_t)m1 * DM + 8 * lane, slab + (size_t)m1 * 4 * DM + 8 * lane);
        final_finish(A, out + (size_t)m * DM + 8 * lane, wv, dry_off);
        if (m2 < NTOK) final_load(A, out + (size_t)m2 * DM + 8 * lane, slab + (size_t)m2 * 4 * DM + 8 * lane);
        if (m1 < NTOK) final_finish(B, out + (size_t)m1 * DM + 8 * lane, wv, dry_off);
    }
}

struct Args { const float* in[18]; float* out; unsigned char* ws; int ph_lo, ph_hi, flag, pad; };
constexpr int NPHASE = 11;

__global__ void __launch_bounds__(NWAVES * 64, 2) mk_fwd(Args args) {
    extern __shared__ __attribute__((aligned(16))) unsigned char lds_raw[];
    Frame F;
    F.lds = (LAS unsigned char*)lds_raw;
    F.tid = threadIdx.x; F.lane = F.tid & 63; F.wave = __builtin_amdgcn_readfirstlane(F.tid >> 6);
    F.G = gridDim.x; { const int bx = blockIdx.x; F.vcu = (F.G % 8 == 0) ? (bx % 8) * (F.G / 8) + bx / 8 : bx; }
#pragma unroll
    for (int i = 0; i < 18; ++i) F.in[i] = args.in[i];
    F.out = args.out; F.ws = args.ws;
    volatile LAS unsigned* MISC = (volatile LAS unsigned*)(F.lds + MISC_OFF);
    for (int u = F.tid; u < (LDS_BYTES - LDSCTL_OFF) / 4; u += NWAVES * 64) ((LAS unsigned*)(F.lds + LDSCTL_OFF))[u] = 0u;
    __syncthreads();
    unsigned* ctl = (unsigned*)(F.ws + WS_CTL);
#if !MK_PER_PHASE
    XcdBarrier bar = xcd_barrier_post(ctl + CW_BAR, MISC + 8);
#define GRID_BAR() xcd_barrier(bar)
#else
#define GRID_BAR() do {} while (0)
#endif
    const int lo = args.ph_lo, hi = args.ph_hi;
#define IN(k) (lo <= (k) && (k) < hi)
#define SEAM(k) do { if (IN(k) && IN((k) + 1)) GRID_BAR(); } while (0)

#define RUNPH(k, ...) do { if (IN(k)) { __VA_ARGS__; } SEAM(k); } while (0)
    RUNPH(0, phase_prep(F));
    RUNPH(1, {
        ProbIn P; P.K = DM; P.RB = 2 * DM; P.S.init(NTOK / 256, NPROJ / 256, F.G, (int)blockIdx.x);
        P.A = (const bf16*)(F.ws + WS_XB); P.Bt = (const bf16*)(F.ws + WS_WIN); P.O = (bf16*)(F.ws + WS_PROJ); P.rs = (const float*)(F.ws + WS_RS1);
        pg8::gemm_phase(F.lds, P); });
    if (IN(2)) { phase_mix(F); __syncthreads(); }
    RUNPH(3, phase_chunk(F));
    RUNPH(4, {
        const int nscan = NB * NH;
        if ((int)blockIdx.x < nscan) phase_scan(F);
        else { ProbPool P; P.K = 512; P.RB = 1024; P.S.init(NTOK / 256, 2, F.G - nscan, (int)blockIdx.x - nscan);
               P.A = (const bf16*)(F.ws + WS_MIXED); P.Bt = (const bf16*)(F.ws + WS_WPOOL); P.O = (bf16*)(F.ws + WS_CONCAT);
               pg8::gemm_phase(F.lds, P);
               __syncthreads();
               moe_weight_prep(F, nscan, MOE_PREP_SPLIT, MOE_PREP_ITEMS); } });
    RUNPH(5, phase_onorm(F));
    RUNPH(6, {
        ProbOut P; P.K = DM; P.RB = 2 * DM; P.S.init(NTOK / 256, DM / 256, F.G, (int)blockIdx.x);
        P.A = (const bf16*)(F.ws + WS_CONCAT); P.Bt = (const bf16*)(F.ws + WS_WOUT); P.X = F.in[0]; P.O = F.out;
        pg8::gemm_phase(F.lds, P); });
    RUNPH(7, phase_route(F));
    RUNPH(8, {
        ProbGU P; const int RT = moe_tables(F, P.T);
        P.K = DM; P.RB = DM; P.S.init(RT, 8, F.G, (int)blockIdx.x);
        P.A = F.ws + WS_X1B; P.Bt = F.ws + WS_WGU; P.O = F.ws + WS_ACT; P.list = (const int*)(F.ws + WS_LIST);
        P.rs2 = (const float*)(F.ws + WS_RS2); P.bgu = (const float*)(F.ws + WS_BGU);
        pg8::gemm_phase<ProbGU, true>(F.lds, P); });
    RUNPH(9, {
        ProbDown P; const int RT = moe_tables(F, P.T);
        P.K = DE; P.RB = DE; P.S.init(RT, 4, F.G, (int)blockIdx.x);
        P.A = F.ws + WS_ACT; P.Bt = F.ws + WS_WD; P.O = (bf16*)(F.ws + WS_SLAB); P.list = (const int*)(F.ws + WS_LIST);
        P.gw = (const float*)(F.ws + WS_GATEW); P.bd = F.in[16];
        pg8::gemm_phase<ProbDown, true>(F.lds, P); });
    RUNPH(10, phase_final(F, args.flag));
#undef RUNPH
#undef IN
#undef SEAM
}

extern "C" void kernel_launch(void* const* d_in, const int* in_sizes, int n_in, void* d_out, int out_size, void* d_ws, size_t ws_size, hipStream_t stream) {
    static int grid = 0;
    if (grid == 0) {
        if (n_in != 18 || in_sizes[0] != NTOK * DM || out_size != NTOK * DM || ws_size < WS_END) { fprintf(stderr, "kernel_launch: unexpected shapes (n_in %d, in0 %d, out %d, ws %zu)\n", n_in, n_in > 0 ? in_sizes[0] : -1, out_size, ws_size); grid = -1; return; }
        int dev = 0, cus = 0, per_cu = 0;
        if (hipGetDevice(&dev) != hipSuccess || hipDeviceGetAttribute(&cus, hipDeviceAttributeMultiprocessorCount, dev) != hipSuccess) { grid = -1; return; }
        if (hipFuncSetAttribute((const void*)mk_fwd, hipFuncAttributeMaxDynamicSharedMemorySize, LDS_BYTES) != hipSuccess) { fprintf(stderr, "kernel_launch: hipFuncSetAttribute failed\n"); grid = -1; return; }
        if (hipOccupancyMaxActiveBlocksPerMultiprocessor(&per_cu, (const void*)mk_fwd, NWAVES * 64, LDS_BYTES) != hipSuccess || per_cu < 1) { fprintf(stderr, "kernel_launch: occupancy query says %d\n", per_cu); per_cu = 1; }
        (void)hipGetLastError();
        grid = cus;
    }
    if (grid < 0) return;
    (void)hipMemsetAsync((char*)d_ws + WS_CTL, 0, CTL_ZERO_BYTES, stream);
    Args a{};
    for (int i = 0; i < 18; ++i) a.in[i] = (const float*)d_in[i];
    a.out = (float*)d_out; a.ws = (unsigned char*)d_ws;
#if MK_PER_PHASE
    for (int p = 0; p < NPHASE; ++p) { a.ph_lo = p; a.ph_hi = p + 1; const int nrep = 1 + REP_CNT * ((REP_MASK >> p) & 1);
        for (int r = 0; r < nrep; ++r) { a.flag = (p == NPHASE - 1 && r + 1 < nrep) ? 1 : 0; hipLaunchKernelGGL(mk_fwd, dim3(grid), dim3(NWAVES * 64), LDS_BYTES, stream, a); } }
#else
    a.ph_lo = 0; a.ph_hi = NPHASE;
    hipLaunchKernelGGL(mk_fwd, dim3(grid), dim3(NWAVES * 64), LDS_BYTES, stream, a);
#endif
}
```

```cpp
#include <hip/hip_runtime.h>
#include <cstdio>
#include <cstdint>

#ifndef REP_MASK
#define REP_MASK 0
#endif
#ifndef REP_CNT
#define REP_CNT 1
#endif
#ifndef MK_PER_PHASE
#define MK_PER_PHASE 0
#endif

constexpr int NB = 8, SEQ = 4096, DM = 1024, NTOK = NB * SEQ;
constexpr int NH = 4, HD = 128, DDN = 512, DPOOL = 512, DIN = 2568, NPROJ = 2560;
constexpr int NE = 32, TOPK = 4, DE = 1024, NASSIGN = NTOK * TOPK;
constexpr int LISTCAP = NTOK;
constexpr int ACT_ROWS = NASSIGN + NE * 256;

constexpr size_t MiB = 1u << 20;
constexpr size_t WS_CTL = 0, CTL_ZERO_BYTES = 1 * MiB;
constexpr size_t WS_WIN = 1 * MiB;
constexpr size_t WS_WOUT = 6 * MiB;
constexpr size_t WS_WPOOL = 8 * MiB;
constexpr size_t WS_WR = 8 * MiB + 512 * 1024;
constexpr size_t WS_BGU = 8 * MiB + 768 * 1024;
constexpr size_t WS_RS1 = 9 * MiB;
constexpr size_t WS_BETA = 9 * MiB + 128 * 1024;
constexpr size_t WS_G = 9 * MiB + 640 * 1024;
constexpr size_t WS_RS2 = 10 * MiB + 256 * 1024;
constexpr size_t WS_GATEW = 10 * MiB + 512 * 1024;
constexpr size_t WS_LIST = 11 * MiB;
constexpr size_t WS_RSL = 800 * MiB;
constexpr size_t WS_GWL = 804 * MiB;
constexpr size_t WS_WGU = 16 * MiB;
constexpr size_t WS_WD = 144 * MiB;
constexpr size_t WS_XB = 208 * MiB;
constexpr size_t WS_PROJ = 272 * MiB;
constexpr size_t WS_CHUNK = 432 * MiB;
constexpr size_t WS_UC = 544 * MiB;
constexpr size_t WS_GTOT = 576 * MiB;
constexpr size_t WS_ORAW = 577 * MiB;
constexpr int CH_WF = 0, CH_QD = 16384, CH_KT = 32768, CH_QK = 49152, CH_BYTES = 57344, UC_BYTES = 16384;
constexpr size_t WS_MIXED = 688 * MiB;
constexpr size_t WS_CONCAT = 720 * MiB;
constexpr size_t WS_X1B = 208 * MiB;
constexpr size_t WS_ACT = 272 * MiB;
constexpr size_t WS_SLAB = 544 * MiB;
constexpr size_t WS_END = 808 * MiB;
static_assert(WS_ACT + (size_t)ACT_ROWS * 2048 <= WS_SLAB, "act fits");
static_assert(WS_SLAB + (size_t)NASSIGN * 2048 <= WS_END, "slab fits");

constexpr int CW_BAR = 4096;
constexpr int CW_CNT = 16384;

constexpr int LDS_BYTES = 147456;
constexpr int LDSCTL_OFF = LDS_BYTES - 1024, MISC_OFF = LDSCTL_OFF + 320, TAB_OFF = LDSCTL_OFF + 512;
constexpr int NWAVES = 8;

#define GAS __attribute__((address_space(1)))
#define LAS __attribute__((address_space(3)))
typedef unsigned short bf16;
typedef unsigned v4u __attribute__((ext_vector_type(4)));
typedef unsigned v2u __attribute__((ext_vector_type(2)));
typedef float f32x4 __attribute__((ext_vector_type(4)));
typedef float f32x2 __attribute__((ext_vector_type(2)));
typedef short bf16x8 __attribute__((ext_vector_type(8)));
typedef GAS unsigned gu32;
#define RLX_AGENT __ATOMIC_RELAXED, __HIP_MEMORY_SCOPE_AGENT
#define LDS_WAIT() asm volatile("s_waitcnt lgkmcnt(0)" ::: "memory")
#define VM_WAIT() asm volatile("s_waitcnt vmcnt(0)" ::: "memory")

__device__ __forceinline__ unsigned f2bf(float f) { unsigned u = __builtin_bit_cast(unsigned, f); return (u + 0x7fffu + ((u >> 16) & 1u)) >> 16; }
__device__ __forceinline__ unsigned pk2(float lo, float hi) { return f2bf(lo) | (f2bf(hi) << 16); }
__device__ __forceinline__ float bflo(unsigned u) { return __builtin_bit_cast(float, u << 16); }
__device__ __forceinline__ float bfhi(unsigned u) { return __builtin_bit_cast(float, u & 0xffff0000u); }
__device__ __forceinline__ unsigned pk4_fp8(float a, float b, float c, float d) { int p = __builtin_amdgcn_cvt_pk_fp8_f32(a, b, 0, false); p = __builtin_amdgcn_cvt_pk_fp8_f32(c, d, p, true); return (unsigned)p; }
constexpr float W8_SCALE = 32.f, W8_INV = 1.f / 32.f;
__device__ __forceinline__ float wave_sum(float v) {
#pragma unroll
    for (int o = 1; o < 64; o <<= 1) v += __shfl_xor(v, o);
    return v;
}
__device__ __forceinline__ float frcp_(float x) { return __builtin_amdgcn_rcpf(x); }
__device__ __forceinline__ float frsq_(float x) { return __builtin_amdgcn_rsqf(x); }
__device__ __forceinline__ float fexp_(float x) { return __builtin_amdgcn_exp2f(x * 1.4426950408889634f); }
__device__ __forceinline__ float sigmoidf_(float x) { return frcp_(1.f + fexp_(-x)); }
__device__ __forceinline__ float siluf_(float x) { return x * frcp_(1.f + fexp_(-x)); }

namespace pg8 {
constexpr int BM = 256, BK = 64, HALF = 128, HTB = HALF * BK * 2, STAGE_BYTES = 8 * HTB;
__device__ __forceinline__ int lds_byte(int r, int c) { const int st = (r >> 4) * 2 + (c >> 5), rr = r & 15, cc = c & 31, ob = rr * 64 + cc * 2; return st * 1024 + (ob ^ (((ob >> 9) & 1) << 5)); }
__device__ __forceinline__ void stage_rc(int b, int& R, int& C) { const int st = b / 1024, sb = b % 1024, swz = sb ^ (((sb >> 9) & 1) << 5); R = (st >> 1) * 16 + swz / 64; C = (st & 1) * 32 + (swz % 64) / 2; }
__device__ __forceinline__ int perm32(int rho) { const int n = rho >> 4, i = rho & 15; return 8 * (i >> 2) + 4 * n + (i & 3); }
typedef __bf16 bf16x2_t __attribute__((ext_vector_type(2)));
__device__ __forceinline__ unsigned cvt_pk_bf16(float lo, float hi) { const f32x2 v = {lo, hi}; const bf16x2_t b = __builtin_convertvector(v, bf16x2_t); return __builtin_bit_cast(unsigned, b); }

struct Unit { int rt, pn, e, rb, rows; };

struct Sched {
    int nM, nN, nwg, G, c;
    __device__ __forceinline__ void init(int nM_, int nN_, int G_, int c_) { nM = nM_; nN = nN_; nwg = nM * nN; G = G_; c = c_; }
    __device__ __forceinline__ bool next(int i, int& pm, int& pn) const {
        const long L = (long)i * G + c; if (L >= nwg) return false;
        int wgid = (int)L; { const int q = nwg / 8, r = nwg % 8, xcd = wgid % 8, off = wgid / 8; wgid = (xcd < r ? xcd * (q + 1) : r * (q + 1) + (xcd - r) * q) + off; }
        const int nig = 8 * nN, gid = wgid / nig, fm = gid * 8, gsz = (nM - fm) < 8 ? (nM - fm) : 8;
        pm = fm + ((wgid % nig) % gsz); pn = (wgid % nig) / gsz; return true;
    }
};

typedef int v8i_t __attribute__((ext_vector_type(8)));
template <class P, bool F8 = false>
__device__ __forceinline__ void gemm_phase(LAS unsigned char* lds, const P& p) {
    const int tid = threadIdx.x, wid = __builtin_amdgcn_readfirstlane(tid >> 6), lane = tid & 63, wr = wid >> 2, wc = wid & 3, fr = lane & 15, fq = lane >> 4;
    const int K = p.K, RB = F8 ? K : 2 * K, nt = RB / (BK * 2);
    unsigned voffB[2];
#pragma unroll
    for (int i = 0; i < 2; ++i) { int R_, C_; stage_rc(tid * 16 + i * 8192, R_, C_); const int Rb = (R_ & ~31) + perm32(R_ & 31); voffB[i] = (unsigned)(Rb * RB + C_ * 2); }
#define PG8_AOFF(unit, dst) do { int R[2], C[2]; asm volatile("" ::: "memory"); _Pragma("unroll") for (int i_ = 0; i_ < 2; ++i_) stage_rc(tid * 16 + i_ * 8192, R[i_], C[i_]); p.a_off(unit, R, C, dst); } while (0)
    const size_t kstep = (size_t)(BK * 2);
    const size_t hstep = (size_t)HALF * RB;
    const unsigned ldsw = (unsigned)wid * 1024u;
    const int aoff = lds_byte(wr * 64 + fr, fq * 8), boff = lds_byte(wc * 32 + fr, fq * 8);
#define PG8_SA(b, h) (((b) * 2 + (h)) * HTB)
#define PG8_SB(b, h) ((4 + (b) * 2 + (h)) * HTB)
#define PG8_STAGE(bufoff, gbase, voff) do { _Pragma("unroll") for (int _i = 0; _i < 2; ++_i) \
        __builtin_amdgcn_global_load_lds((const unsigned*)((const char*)(gbase) + (voff)[_i]), (LAS unsigned*)(lds + (bufoff) + ldsw + _i * 8192), 16, 0, 0); } while (0)
#define PG8_LDA(dst, b, h) do { _Pragma("unroll") for (int m = 0; m < 4; ++m) { const v4i_t l_ = *(const LAS v4i_t*)(lds + PG8_SA(b, h) + aoff + m * 2048), h_ = *(const LAS v4i_t*)(lds + PG8_SA(b, h) + aoff + m * 2048 + 1024); dst[m] = __builtin_shufflevector(l_, h_, 0, 1, 2, 3, 4, 5, 6, 7); } } while (0)
#define PG8_LDB(dst, b, h) do { _Pragma("unroll") for (int n = 0; n < 2; ++n) { const v4i_t l_ = *(const LAS v4i_t*)(lds + PG8_SB(b, h) + boff + n * 2048), h_ = *(const LAS v4i_t*)(lds + PG8_SB(b, h) + boff + n * 2048 + 1024); dst[n] = __builtin_shufflevector(l_, h_, 0, 1, 2, 3, 4, 5, 6, 7); } } while (0)
#define PG8_HALF(x, k) __builtin_bit_cast(bf16x8, __builtin_shufflevector(x, x, 4 * (k), 4 * (k) + 1, 4 * (k) + 2, 4 * (k) + 3))
#define PG8_MMA(ai, bj, At, Bt) do { __builtin_amdgcn_s_setprio(1); \
        if constexpr (F8) { _Pragma("unroll") for (int m = 0; m < 4; ++m) _Pragma("unroll") for (int n = 0; n < 2; ++n) \
            asm volatile("v_mfma_scale_f32_16x16x128_f8f6f4 %0, %1, %2, %0, %3, %3 op_sel_hi:[0,0,0]" : "+v"(acc[ai][bj][m][n]) : "v"(Bt[n]), "v"(At[m]), "v"(mxs)); } \
        else { _Pragma("unroll") for (int m = 0; m < 4; ++m) _Pragma("unroll") for (int n = 0; n < 2; ++n) { \
            acc[ai][bj][m][n] = __builtin_amdgcn_mfma_f32_16x16x32_bf16(PG8_HALF(Bt[n], 0), PG8_HALF(At[m], 0), acc[ai][bj][m][n], 0, 0, 0); \
            acc[ai][bj][m][n] = __builtin_amdgcn_mfma_f32_16x16x32_bf16(PG8_HALF(Bt[n], 1), PG8_HALF(At[m], 1), acc[ai][bj][m][n], 0, 0, 0); } } \
        __builtin_amdgcn_s_setprio(0); } while (0)
#define PG8_WAIT_V(n) asm volatile("s_waitcnt vmcnt(" #n ")" ::: "memory")
#define PG8_WAIT_L(n) asm volatile("s_waitcnt lgkmcnt(" #n ")" ::: "memory")
#define PG8_BAR __builtin_amdgcn_s_barrier()
#define PG8_SCHED __builtin_amdgcn_sched_barrier(0)
    Unit cur, nxt; int ui = 0;
    if (!p.next(0, cur)) return;
    unsigned mxs = 0x7f7f7f7fu; asm volatile("" : "+v"(mxs));
    f32x4 acc[2][2][4][2];
#pragma unroll
    for (int a = 0; a < 2; ++a)
#pragma unroll
        for (int b = 0; b < 2; ++b)
#pragma unroll
            for (int m = 0; m < 4; ++m)
#pragma unroll
                for (int n = 0; n < 2; ++n) acc[a][b][m][n] = (f32x4){0.f, 0.f, 0.f, 0.f};
    typedef int v4i_t __attribute__((ext_vector_type(4)));
    v8i_t At[4], B0[2], B1[2];
    unsigned oA[2][2];
    PG8_AOFF(cur, oA);
    const char* cA = p.a_base(cur); const char* cB = p.b_base(cur);
    PG8_STAGE(PG8_SB(0, 0), cB, voffB); PG8_STAGE(PG8_SB(0, 1), cB + hstep, voffB); PG8_STAGE(PG8_SA(0, 0), cA, oA[0]); PG8_STAGE(PG8_SA(0, 1), cA, oA[1]);
    if (wr == 1) PG8_BAR;
    PG8_WAIT_V(2); PG8_BAR;
    PG8_STAGE(PG8_SB(1, 0), cB + kstep, voffB); PG8_STAGE(PG8_SA(1, 0), cA + kstep, oA[0]); PG8_STAGE(PG8_SB(1, 1), cB + hstep + kstep, voffB);
    PG8_WAIT_V(6); PG8_BAR;
    LAS v4u* park = (LAS v4u*)(lds + STAGE_BYTES) + tid;
    for (;;) {
        const bool has_next = p.next(ui + 1, nxt);
        const char* nA = cA; const char* nB = cB;
        { unsigned nO[2][2];
#pragma unroll
          for (int h = 0; h < 2; ++h)
#pragma unroll
              for (int i = 0; i < 2; ++i) nO[h][i] = oA[h][i];
          if (has_next) { nA = p.a_base(nxt); nB = p.b_base(nxt); PG8_AOFF(nxt, nO); }
          *park = (v4u){nO[0][0], nO[0][1], nO[1][0], nO[1][1]}; }
        for (int t = 0; t < nt; t += 2) {
            const bool last = (t == nt - 2);
            const char* a1 = cA + (size_t)(t + 1) * kstep;
            const char* a2 = last ? nA : cA + (size_t)(t + 2) * kstep; const char* b2 = last ? nB : cB + (size_t)(t + 2) * kstep;
            const char* a3 = a2 + kstep; const char* b3 = b2 + kstep;
            unsigned o2[2][2];
#pragma unroll
            for (int h = 0; h < 2; ++h)
#pragma unroll
                for (int i = 0; i < 2; ++i) o2[h][i] = oA[h][i];
            if (last) { const v4u q_ = *park; o2[0][0] = q_.x; o2[0][1] = q_.y; o2[1][0] = q_.z; o2[1][1] = q_.w; }
            PG8_LDB(B0, 0, 0); PG8_LDB(B1, 0, 1); PG8_SCHED; PG8_LDA(At, 0, 0); PG8_STAGE(PG8_SA(1, 1), a1, oA[1]);
            PG8_WAIT_V(8); PG8_WAIT_L(0); PG8_BAR; PG8_MMA(0, 0, At, B0); PG8_MMA(0, 1, At, B1); PG8_BAR; PG8_SCHED;
            PG8_LDA(At, 0, 1); PG8_STAGE(PG8_SB(0, 0), b2, voffB); PG8_STAGE(PG8_SB(0, 1), b2 + hstep, voffB); PG8_STAGE(PG8_SA(0, 0), a2, o2[0]);
            PG8_WAIT_V(8); PG8_WAIT_L(0); PG8_BAR; PG8_MMA(1, 0, At, B0); PG8_MMA(1, 1, At, B1); PG8_BAR; PG8_SCHED;
            PG8_LDB(B0, 1, 0); PG8_LDB(B1, 1, 1); PG8_SCHED; PG8_LDA(At, 1, 0); PG8_STAGE(PG8_SA(0, 1), a2, o2[1]);
            PG8_WAIT_V(8); PG8_WAIT_L(0); PG8_BAR; PG8_MMA(0, 0, At, B0); PG8_MMA(0, 1, At, B1); PG8_BAR; PG8_SCHED;
            PG8_LDA(At, 1, 1); PG8_STAGE(PG8_SB(1, 0), b3, voffB); PG8_STAGE(PG8_SB(1, 1), b3 + hstep, voffB); PG8_STAGE(PG8_SA(1, 0), a3, o2[0]);
            PG8_WAIT_V(8); PG8_WAIT_L(0); PG8_BAR; PG8_MMA(1, 0, At, B0); PG8_MMA(1, 1, At, B1); PG8_BAR; PG8_SCHED;
        }
        if (wr == 0) PG8_BAR;
        if constexpr (F8) asm volatile("s_nop 15\n\ts_nop 15" ::: "memory");
        p.epi(acc, cur, wr, wc, fr, fq);
        if (!has_next) break;
#pragma unroll
        for (int a = 0; a < 2; ++a)
#pragma unroll
            for (int b = 0; b < 2; ++b)
#pragma unroll
                for (int m = 0; m < 4; ++m)
#pragma unroll
                    for (int n = 0; n < 2; ++n) acc[a][b][m][n] = (f32x4){0.f, 0.f, 0.f, 0.f};
        cur = nxt; cA = nA; cB = nB; ++ui;
        { const v4u q_ = *park; oA[0][0] = q_.x; oA[0][1] = q_.y; oA[1][0] = q_.z; oA[1][1] = q_.w; }
        if (wr == 1) PG8_BAR;
    }
    PG8_WAIT_V(0);
    PG8_BAR;
#undef PG8_SA
#undef PG8_SB
#undef PG8_STAGE
#undef PG8_LDA
#undef PG8_LDB
#undef PG8_MMA
#undef PG8_HALF
#undef PG8_AOFF
#undef PG8_WAIT_V
#undef PG8_WAIT_L
#undef PG8_BAR
#undef PG8_SCHED
}
}

#define XB_TMO      128
#define XB_XCNT(j)  (256  + 64 * (j))
#define XB_XSUB(j)  (1280 + 64 * (j))
#define XB_XGEN(j)  (2304 + 64 * (j))
#define XB_TOP      3328
#define XB_TOPGEN   3392
#define XCD_BAR_WORDS 3456
#define XB_SPIN_CAP (1u << 18)
__device__ __forceinline__ unsigned xb_ld(unsigned* p)              { return __hip_atomic_load(p, __ATOMIC_RELAXED, __HIP_MEMORY_SCOPE_AGENT); }
__device__ __forceinline__ unsigned xb_add(unsigned* p, unsigned v) { return __hip_atomic_fetch_add(p, v, __ATOMIC_RELAXED, __HIP_MEMORY_SCOPE_AGENT); }
__device__ __forceinline__ unsigned xb_xcc_id() { return (unsigned)__builtin_amdgcn_s_getreg((3 << 11) | 20) & 0xFu; }
#define XB_SPIN(cond, bar) do { unsigned _sp = 0; while (cond) { __builtin_amdgcn_s_sleep(1); \
    if ((++_sp & 255u) == 0u) { if (xb_ld(&(bar)[XB_TMO])) break; if (_sp > XB_SPIN_CAP) { atomicAdd(&(bar)[XB_TMO], 1u); break; } } } } while (0)
struct XcdBarrier { unsigned* bar; unsigned x; volatile LAS unsigned* st; };
__device__ __forceinline__ XcdBarrier xcd_barrier_post(unsigned* bar, volatile LAS unsigned* st) {
    XcdBarrier b; b.bar = bar; b.x = xb_xcc_id(); b.st = st;
    if (threadIdx.x == 0) (void)xb_add(&bar[XB_XCNT(b.x)], 1u);
    return b;
}
__device__ __forceinline__ void xcd_barrier_complete(unsigned* bar, unsigned x, unsigned& nloc, unsigned& nx) {
    const unsigned G = gridDim.x * gridDim.y * gridDim.z;
    unsigned sum, cnt, mine, sp = 0u;
    for (;;) {
        sum = 0u; cnt = 0u; mine = 0u;
#pragma unroll
        for (unsigned j = 0; j < 16; ++j) { const unsigned c = xb_ld(&bar[XB_XCNT(j)]); sum += c; cnt += (c > 0u) ? 1u : 0u; mine = (j == x) ? c : mine; }
        if (sum == G) break;
        __builtin_amdgcn_s_sleep(1);
        if ((++sp & 255u) == 0u) { if (xb_ld(&bar[XB_TMO])) break; if (sp > XB_SPIN_CAP) { atomicAdd(&bar[XB_TMO], 1u); break; } }
    }
    nloc = mine > 0u ? mine : 1u; nx = cnt > 0u ? cnt : 1u;
}
__device__ __forceinline__ void xcd_barrier(const XcdBarrier& b) {
    asm volatile("s_waitcnt vmcnt(0)" ::: "memory");
    __syncthreads();
    if (threadIdx.x == 0) {
        unsigned* bar = b.bar;
        __builtin_amdgcn_s_waitcnt(0);
        unsigned nloc = b.st[0], nx = b.st[1];
        if (nloc == 0u) { xcd_barrier_complete(bar, b.x, nloc, nx); b.st[0] = nloc; b.st[1] = nx; }
        const unsigned old = xb_add(&bar[XB_XSUB(b.x)], 1u);
        const unsigned gen = old / nloc;
        if (old + 1u == (gen + 1u) * nloc) {
            __builtin_amdgcn_fence(__ATOMIC_RELEASE, "agent");
            asm volatile("s_waitcnt vmcnt(0)" ::: "memory");
            const unsigned og = xb_add(&bar[XB_TOP], 1u);
            const unsigned tg = og / nx;
            if (og + 1u == (tg + 1u) * nx) xb_add(&bar[XB_TOPGEN], 1u);
            else XB_SPIN(xb_ld(&bar[XB_TOPGEN]) == tg, bar);
            __builtin_amdgcn_fence(__ATOMIC_ACQUIRE, "agent");
            xb_add(&bar[XB_XGEN(b.x)], 1u);
            asm volatile("s_waitcnt vmcnt(0)" ::: "memory");
        } else {
            XB_SPIN(xb_ld(&bar[XB_XGEN(b.x)]) == gen, bar);
            __builtin_amdgcn_fence(__ATOMIC_ACQUIRE, "agent");
            asm volatile("s_waitcnt vmcnt(0)" ::: "memory");
        }
    }
    __syncthreads();
}

struct Frame {
    LAS unsigned char* lds;
    int tid, lane, wave, vcu, G;
    const float* in[18];
    float* out;
    unsigned char* ws;
};
using pg8::Unit;
using pg8::cvt_pk_bf16;

struct ProbBase {
    int K; int RB; pg8::Sched S;
    __device__ __forceinline__ void lin_off(const int (&R)[2], const int (&C)[2], unsigned (&off)[2][2]) const {
#pragma unroll
        for (int h = 0; h < 2; ++h)
#pragma unroll
            for (int i = 0; i < 2; ++i) off[h][i] = (unsigned)((h * 128 + R[i]) * RB + C[i] * 2);
    }
};
struct ProbIn : ProbBase {
    const bf16* A; const bf16* Bt; bf16* O; const float* rs;
    __device__ __forceinline__ bool next(int i, Unit& u) const { int pm, pn; if (!S.next(i, pm, pn)) return false; u.rt = pm; u.pn = pn; u.e = 0; u.rb = pm; u.rows = 256; return true; }
    __device__ __forceinline__ const char* a_base(const Unit& u) const { return (const char*)A + (size_t)u.rt * 256 * RB; }
    __device__ __forceinline__ const char* b_base(const Unit& u) const { return (const char*)Bt + (size_t)u.pn * 256 * RB; }
    __device__ __forceinline__ void a_off(const Unit&, const int (&R)[2], const int (&C)[2], unsigned (&off)[2][2]) const { lin_off(R, C, off); }
    __device__ __forceinline__ void epi(const f32x4 (&acc)[2][2][4][2], const Unit& u, int wr, int wc, int fr, int fq) const {
        const int row0 = u.rt * 256 + wr * 64 + fr, col0 = u.pn * 256 + wc * 32 + 8 * fq;
#pragma unroll
        for (int ai = 0; ai < 2; ++ai)
#pragma unroll
            for (int m = 0; m < 4; ++m) { const int row = row0 + ai * 128 + m * 16; const float sc = rs[row]; bf16* rowp = O + (size_t)row * NPROJ + col0;
#pragma unroll
                for (int bj = 0; bj < 2; ++bj) { const f32x4 v0 = acc[ai][bj][m][0] * sc, v1 = acc[ai][bj][m][1] * sc; v4u w;
                    w.x = cvt_pk_bf16(v0[0], v0[1]); w.y = cvt_pk_bf16(v0[2], v0[3]); w.z = cvt_pk_bf16(v1[0], v1[1]); w.w = cvt_pk_bf16(v1[2], v1[3]);
                    *(v4u*)(rowp + bj * 128) = w; } }
    }
};
struct ProbPool : ProbBase {
    const bf16* A; const bf16* Bt; bf16* O;
    __device__ __forceinline__ bool next(int i, Unit& u) const { int pm, pn; if (!S.next(i, pm, pn)) return false; u.rt = pm; u.pn = pn; u.e = 0; u.rb = pm; u.rows = 256; return true; }
    __device__ __forceinline__ const char* a_base(const Unit& u) const { return (const char*)A + (size_t)u.rt * 256 * RB; }
    __device__ __forceinline__ const char* b_base(const Unit& u) const { return (const char*)Bt + (size_t)u.pn * 256 * RB; }
    __device__ __forceinline__ void a_off(const Unit&, const int (&R)[2], const int (&C)[2], unsigned (&off)[2][2]) const { lin_off(R, C, off); }
    __device__ __forceinline__ void epi(const f32x4 (&acc)[2][2][4][2], const Unit& u, int wr, int wc, int fr, int fq) const {
        const int row0 = u.rt * 256 + wr * 64 + fr, col0 = 512 + u.pn * 256 + wc * 32 + 8 * fq;
#pragma unroll
        for (int ai = 0; ai < 2; ++ai)
#pragma unroll
            for (int m = 0; m < 4; ++m) { const int row = row0 + ai * 128 + m * 16; bf16* rowp = O + (size_t)row * DM + col0;
#pragma unroll
                for (int bj = 0; bj < 2; ++bj) { const f32x4 v0 = acc[ai][bj][m][0], v1 = acc[ai][bj][m][1]; v4u w;
                    w.x = cvt_pk_bf16(v0[0], v0[1]); w.y = cvt_pk_bf16(v0[2], v0[3]); w.z = cvt_pk_bf16(v1[0], v1[1]); w.w = cvt_pk_bf16(v1[2], v1[3]);
                    *(v4u*)(rowp + bj * 128) = w; } }
    }
};
struct ProbOut : ProbBase {
    const bf16* A; const bf16* Bt; const float* X; float* O;
    __device__ __forceinline__ bool next(int i, Unit& u) const { int pm, pn; if (!S.next(i, pm, pn)) return false; u.rt = pm; u.pn = pn; u.e = 0; u.rb = pm; u.rows = 256; return true; }
    __device__ __forceinline__ const char* a_base(const Unit& u) const { return (const char*)A + (size_t)u.rt * 256 * RB; }
    __device__ __forceinline__ const char* b_base(const Unit& u) const { return (const char*)Bt + (size_t)u.pn * 256 * RB; }
    __device__ __forceinline__ void a_off(const Unit&, const int (&R)[2], const int (&C)[2], unsigned (&off)[2][2]) const { lin_off(R, C, off); }
    __device__ __forceinline__ void epi(const f32x4 (&acc)[2][2][4][2], const Unit& u, int wr, int wc, int fr, int fq) const {
        const int row0 = u.rt * 256 + wr * 64 + fr, col0 = u.pn * 256 + wc * 32 + 8 * fq;
#pragma unroll
        for (int ai = 0; ai < 2; ++ai)
#pragma unroll
            for (int m = 0; m < 4; ++m) { const size_t off = (size_t)(row0 + ai * 128 + m * 16) * DM + col0;
#pragma unroll
                for (int bj = 0; bj < 2; ++bj)
#pragma unroll
                    for (int n = 0; n < 2; ++n) { const f32x4 xv = *(const f32x4*)(X + off + bj * 128 + 4 * n); *(f32x4*)(O + off + bj * 128 + 4 * n) = xv + acc[ai][bj][m][n]; } }
    }
};
struct MoeTab { const LAS int* pref; const LAS int* cnt; };
__device__ __forceinline__ void moe_decode(const MoeTab& T, int rt, Unit& u) {
    int e = 0;
#pragma unroll 1
    for (int j = 1; j < NE; ++j) if (T.pref[j] <= rt) e = j;
    u.e = e; u.rb = rt - T.pref[e]; const int left = T.cnt[e] - u.rb * 256; u.rows = left < 256 ? left : 256;
}
struct ProbGU : ProbBase {
    MoeTab T; const unsigned char* A; const unsigned char* Bt; unsigned char* O; const int* list; const float* rs2; const float* bgu;
    __device__ __forceinline__ bool next(int i, Unit& u) const { int pm, pn; if (!S.next(i, pm, pn)) return false; u.rt = pm; u.pn = pn; moe_decode(T, pm, u); return true; }
    __device__ __forceinline__ const char* a_base(const Unit&) const { return (const char*)A; }
    __device__ __forceinline__ const char* b_base(const Unit& u) const { return (const char*)Bt + ((size_t)u.e * 2048 + (size_t)u.pn * 256) * RB; }
    __device__ __forceinline__ void a_off(const Unit& u, const int (&R)[2], const int (&C)[2], unsigned (&off)[2][2]) const {
        const int* lp = list + (size_t)u.e * LISTCAP + u.rb * 256;
#pragma unroll
        for (int h = 0; h < 2; ++h)
#pragma unroll
            for (int i = 0; i < 2; ++i) { const int r = h * 128 + R[i]; const int ent = (r < u.rows) ? lp[r] : 0; off[h][i] = (unsigned)(ent >> 2) * (unsigned)RB + (unsigned)C[i] * 2u; }
    }
    __device__ __forceinline__ void epi(const f32x4 (&acc)[2][2][4][2], const Unit& u, int wr, int wc, int fr, int fq) const {
        const float* rsp = rs2 + (size_t)u.e * LISTCAP + u.rb * 256;
        const int j0 = wc * 32 + 8 * fq;
        const float* bg = bgu + (size_t)u.e * 2048 + u.pn * 256 + j0;
        f32x4 bgv[2], buv[2];
#pragma unroll
        for (int n = 0; n < 2; ++n) { bgv[n] = *(const f32x4*)(bg + 4 * n); buv[n] = *(const f32x4*)(bg + 128 + 4 * n); }
#pragma unroll
        for (int ai = 0; ai < 2; ++ai)
#pragma unroll
            for (int m = 0; m < 4; ++m) { const int r = ai * 128 + wr * 64 + m * 16 + fr;
                if (r < u.rows) { const float sc = rsp[r] * W8_INV; unsigned w[2];
#pragma unroll
                    for (int n = 0; n < 2; ++n) { float a[4];
#pragma unroll
                        for (int q = 0; q < 4; ++q) { float gt = acc[ai][0][m][n][q] * sc + bgv[n][q], up = acc[ai][1][m][n][q] * sc + buv[n][q];
                            gt = fminf(gt, 7.f); up = fminf(fmaxf(up, -7.f), 7.f); a[q] = (up + 1.f) * gt * frcp_(1.f + fexp_(-1.702f * gt)); }
                        w[n] = pk4_fp8(a[0], a[1], a[2], a[3]); }
                    *(v2u*)(O + (size_t)(u.rt * 256 + r) * DE + u.pn * 128 + j0) = (v2u){w[0], w[1]}; } }
    }
};
struct ProbDown : ProbBase {
    MoeTab T; const unsigned char* A; const unsigned char* Bt; bf16* O; const int* list; const float* gw; const float* bd;
    __device__ __forceinline__ bool next(int i, Unit& u) const { int pm, pn; if (!S.next(i, pm, pn)) return false; u.rt = pm; u.pn = pn; moe_decode(T, pm, u); return true; }
    __device__ __forceinline__ const char* a_base(const Unit& u) const { return (const char*)A + (size_t)u.rt * 256 * RB; }
    __device__ __forceinline__ const char* b_base(const Unit& u) const { return (const char*)Bt + ((size_t)u.e * 1024 + (size_t)u.pn * 256) * RB; }
    __device__ __forceinline__ void a_off(const Unit&, const int (&R)[2], const int (&C)[2], unsigned (&off)[2][2]) const { lin_off(R, C, off); }
    __device__ __forceinline__ void epi(const f32x4 (&acc)[2][2][4][2], const Unit& u, int wr, int wc, int fr, int fq) const {
        const int* lp = list + (size_t)u.e * LISTCAP + u.rb * 256;
        const int c0 = u.pn * 256 + wc * 32 + 8 * fq;
        const float* gwp = gw + (size_t)u.e * LISTCAP + u.rb * 256;
        const float* bp = bd + (size_t)u.e * DM + c0;
        f32x4 bv[2][2];
#pragma unroll
        for (int bj = 0; bj < 2; ++bj)
#pragma unroll
            for (int n = 0; n < 2; ++n) bv[bj][n] = *(const f32x4*)(bp + bj * 128 + 4 * n);
#pragma unroll
        for (int ai = 0; ai < 2; ++ai)
#pragma unroll
            for (int m = 0; m < 4; ++m) { const int r = ai * 128 + wr * 64 + m * 16 + fr;
                if (r < u.rows) { const int ent = lp[r]; const float g = gwp[r]; bf16* rowp = O + (size_t)ent * DM + c0;
#pragma unroll
                    for (int bj = 0; bj < 2; ++bj) { const f32x4 v0 = (acc[ai][bj][m][0] * W8_INV + bv[bj][0]) * g, v1 = (acc[ai][bj][m][1] * W8_INV + bv[bj][1]) * g; v4u w;
                        w.x = cvt_pk_bf16(v0[0], v0[1]); w.y = cvt_pk_bf16(v0[2], v0[3]); w.z = cvt_pk_bf16(v1[0], v1[1]); w.w = cvt_pk_bf16(v1[2], v1[3]);
                        *(v4u*)(rowp + bj * 128) = w; } } }
    }
};

typedef short v4i16_t __attribute__((ext_vector_type(4)));
__device__ __forceinline__ void tr_item(const float* W, int ldw, int k0, int nsrc0, bf16* WT, size_t drow0, int ldk, int dk0, const float* ks, const float* ns, LAS unsigned char* scr, int lane) {
    const int kr = lane >> 4, n4 = (lane & 15) * 4;
    f32x4 nsc = (f32x4){1.f, 1.f, 1.f, 1.f}; if (ns) nsc = *(const f32x4*)(ns + nsrc0 + n4);
    f32x4 v[16];
#pragma unroll
    for (int i = 0; i < 16; ++i) v[i] = *(const f32x4*)(W + (size_t)(k0 + 4 * i + kr) * ldw + nsrc0 + n4);
#pragma unroll
    for (int i = 0; i < 16; ++i) { f32x4 x = v[i] * nsc; if (ks) x = x * ks[k0 + 4 * i + kr];
        *(LAS v2u*)(scr + (4 * i + kr) * 192 + n4 * 2) = (v2u){pg8::cvt_pk_bf16(x.x, x.y), pg8::cvt_pk_bf16(x.z, x.w)}; }
    LDS_WAIT(); asm volatile("" ::: "memory");
    const int G = lane >> 4, li = lane & 15, q = li >> 2, p = li & 3;
    const LAS unsigned char* rb = scr + q * 192 + (16 * G + 4 * p) * 2;
    bf16* dst = WT + (drow0 + 16 * G + li) * (size_t)ldk + dk0 + k0;
#pragma unroll
    for (int kc = 0; kc < 8; ++kc) {
        const v4i16_t lo = __builtin_amdgcn_ds_read_tr16_b64_v4i16((LAS v4i16_t*)(rb + (8 * kc) * 192));
        const v4i16_t hi = __builtin_amdgcn_ds_read_tr16_b64_v4i16((LAS v4i16_t*)(rb + (8 * kc + 4) * 192));
        const v2u l2 = __builtin_bit_cast(v2u, lo), h2 = __builtin_bit_cast(v2u, hi);
        *(v4u*)(dst + 8 * kc) = (v4u){l2.x, l2.y, h2.x, h2.y};
    }
    LDS_WAIT(); asm volatile("" ::: "memory");
}

template <int KT, int NT>
__device__ __forceinline__ void tr_item8(const float* W, int ldw, int k0, int nsrc0, unsigned char* WT, size_t drow0, int ldk, const float* ks, float mul, LAS unsigned char* scr, int lane) {
    constexpr int LPR = NT / 4, RPL = 64 / LPR, PA = NT * 2 + 64;
    static_assert(KT * NT == 4096 && (PA / 4) % 32 == 16, "tile geometry");
    const int kr = lane / LPR, n4 = (lane % LPR) * 4;
    f32x4 v[16];
#pragma unroll
    for (int i = 0; i < 16; ++i) v[i] = *(const f32x4*)(W + (size_t)(k0 + RPL * i + kr) * ldw + nsrc0 + n4);
#pragma unroll
    for (int i = 0; i < 16; ++i) { const float sc = ks ? ks[k0 + RPL * i + kr] * mul : mul; const f32x4 x = v[i] * sc;
        *(LAS v2u*)(scr + (RPL * i + kr) * PA + n4 * 2) = (v2u){pg8::cvt_pk_bf16(x.x, x.y), pg8::cvt_pk_bf16(x.z, x.w)}; }
    LDS_WAIT(); asm volatile("" ::: "memory");
    const int G = lane >> 4, li = lane & 15, q = li >> 2, p = li & 3;
#pragma unroll
    for (int ps = 0; ps < NT / 64; ++ps) {
        const LAS unsigned char* rb = scr + q * PA + (16 * (G + 4 * ps) + 4 * p) * 2;
        unsigned char* dst = WT + (drow0 + 16 * (G + 4 * ps) + li) * (size_t)ldk + k0;
#pragma unroll
        for (int kq = 0; kq < KT / 16; ++kq) {
            v2u t[4];
#pragma unroll
            for (int u = 0; u < 4; ++u) t[u] = __builtin_bit_cast(v2u, __builtin_amdgcn_ds_read_tr16_b64_v4i16((LAS v4i16_t*)(rb + (16 * kq + 4 * u) * PA)));
            v4u o;
            o.x = pk4_fp8(bflo(t[0].x), bfhi(t[0].x), bflo(t[0].y), bfhi(t[0].y)); o.y = pk4_fp8(bflo(t[1].x), bfhi(t[1].x), bflo(t[1].y), bfhi(t[1].y));
            o.z = pk4_fp8(bflo(t[2].x), bfhi(t[2].x), bflo(t[2].y), bfhi(t[2].y)); o.w = pk4_fp8(bflo(t[3].x), bfhi(t[3].x), bflo(t[3].y), bfhi(t[3].y));
            *(v4u*)(dst + 16 * kq) = o;
        }
    }
    LDS_WAIT(); asm volatile("" ::: "memory");
}

constexpr int TRK = 32, TRN = 128;
constexpr int MOE_PREP_ITEMS = 32 * (1024 / TRK) * (2048 / TRN) + 32 * (1024 / TRK) * (1024 / TRN);
__device__ __forceinline__ void moe_weight_prep(Frame& F, int b0, int lo, int hi) {
    const float* fnw = F.in[10]; const float* w_gu = F.in[13]; const float* w_d = F.in[15];
    unsigned char* WguT = F.ws + WS_WGU; unsigned char* WdT = F.ws + WS_WD;
    LAS unsigned char* scr = F.lds + F.wave * 12288;
    constexpr int TW = 2;
    if (F.wave >= TW) return;
    const int gw = ((int)blockIdx.x - b0) * TW + F.wave, NGW = (F.G - b0) * TW;
    constexpr int NKB = 1024 / TRK, NNB_GU = 2048 / TRN, NNB_D = 1024 / TRN, SEGN = 128 / TRN;
    constexpr int I_GU = 32 * NKB * NNB_GU;
    for (int it = lo + gw; it < hi; it += NGW) {
        int r = it;
        if (r < I_GU) { const int e = r / (NKB * NNB_GU), r2 = r % (NKB * NNB_GU), kb = r2 / NNB_GU, cb = r2 % NNB_GU;
            const int half = cb / (NNB_GU / 2), t = (cb % (NNB_GU / 2)) / SEGN, nb = cb % SEGN;
            tr_item8<TRK, TRN>(w_gu + (size_t)e * DM * 2048, 2048, kb * TRK, half * 1024 + t * 128 + nb * TRN, WguT, (size_t)e * 2048 + t * 256 + half * 128 + nb * TRN, DM, fnw, W8_SCALE, scr, F.lane); continue; } r -= I_GU;
        { const int e = r / (NKB * NNB_D), r2 = r % (NKB * NNB_D), kb = r2 / NNB_D, nb = r2 % NNB_D;
          tr_item8<TRK, TRN>(w_d + (size_t)e * DE * DM, DM, kb * TRK, nb * TRN, WdT, (size_t)e * 1024 + nb * TRN, DE, nullptr, W8_SCALE, scr, F.lane); }
    }
}
constexpr int MOE_PREP_SPLIT = 0;

__device__ __forceinline__ void phase_prep(Frame& F) {
    const float* x = F.in[0]; const float* anw = F.in[1]; const float* w_in = F.in[2]; const float* a_log = F.in[4]; const float* dt_bias = F.in[5];
    const float* pool_w = F.in[7]; const float* pool_scale = F.in[8]; const float* w_out = F.in[9]; const float* fnw = F.in[10];
    const float* w_router = F.in[11]; const float* w_gu = F.in[13]; const float* b_gu = F.in[14]; const float* w_d = F.in[15];
    bf16* WinT = (bf16*)(F.ws + WS_WIN); bf16* WoutT = (bf16*)(F.ws + WS_WOUT); bf16* WpoolT = (bf16*)(F.ws + WS_WPOOL);
    bf16* WguT = (bf16*)(F.ws + WS_WGU); bf16* WdT = (bf16*)(F.ws + WS_WD);
    bf16* WrI = (bf16*)(F.ws + WS_WR); float* bguP = (float*)(F.ws + WS_BGU);
    bf16* xb = (bf16*)(F.ws + WS_XB); float* rs1 = (float*)(F.ws + WS_RS1); float* betaA = (float*)(F.ws + WS_BETA); float* gA = (float*)(F.ws + WS_G);
    LAS unsigned char* scr = F.lds + F.wave * 12288;
    LAS float* W8T = (LAS float*)(F.lds + 98304);
    const int gw = F.vcu * NWAVES + F.wave, NGW = F.G * NWAVES;
    const int gt = F.vcu * 512 + F.tid, NGT = F.G * 512;
    for (int idx = F.tid; idx < 8192; idx += 512) { const int k = idx >> 3, c = idx & 7; W8T[c * 1024 + k] = anw[k] * w_in[(size_t)k * DIN + 2048 + c]; }
    __syncthreads();
    constexpr int I_IN1 = 16 * 32, I_IN2 = 16 * 8, I_OUT = 16 * 16, I_POOL = 4 * 2 * 2;
    constexpr int NITEMS = I_IN1 + I_IN2 + I_OUT + I_POOL;
    for (int it = gw; it < NITEMS; it += NGW) {
        int r = it;
        if (r < I_IN1) { const int kb = r / 32, nb = r % 32; tr_item(w_in, DIN, kb * 64, nb * 64, WinT, (size_t)nb * 64, DM, 0, anw, nullptr, scr, F.lane); continue; } r -= I_IN1;
        if (r < I_IN2) { const int kb = r / 8, nb = r % 8; tr_item(w_in, DIN, kb * 64, 2056 + nb * 64, WinT, (size_t)2048 + nb * 64, DM, 0, anw, nullptr, scr, F.lane); continue; } r -= I_IN2;
        if (r < I_OUT) { const int kb = r / 16, nb = r % 16; tr_item(w_out, DM, kb * 64, nb * 64, WoutT, (size_t)nb * 64, DM, 0, nullptr, nullptr, scr, F.lane); continue; } r -= I_OUT;
        { const int g = r / 4, kb = (r % 4) / 2, nb = r % 2; tr_item(pool_w + (size_t)g * 128 * 128, 128, kb * 64, nb * 64, WpoolT, (size_t)g * 128 + nb * 64, 512, g * 128, nullptr, pool_scale + g * 128, scr, F.lane); }
    }
    moe_weight_prep(F, 0, 0, MOE_PREP_SPLIT);
    for (int idx = gt; idx < NE * 2048; idx += NGT) { const int e = idx >> 11, r = idx & 2047, t = r >> 8, j = r & 255, half = j >> 7, jj = j & 127; bguP[idx] = b_gu[(size_t)e * 2048 + half * 1024 + t * 128 + jj]; }
    for (int idx = gt; idx < 64 * 64 * 8; idx += NGT) { const int j = idx & 7, ln = (idx >> 3) & 63, fr2 = idx >> 9, nb = fr2 & 1, ks = fr2 >> 1;
        const int k = 32 * ks + 8 * (ln >> 4) + j, e = 16 * nb + (ln & 15); const float v = fnw[k] * w_router[(size_t)k * NE + e];
        const unsigned hb = f2bf(v); const float hf = __builtin_bit_cast(float, hb << 16); const unsigned lb = f2bf(v - hf);
        WrI[((size_t)(fr2 * 2 + 0) * 64 + ln) * 8 + j] = (bf16)hb; WrI[((size_t)(fr2 * 2 + 1) * 64 + ln) * 8 + j] = (bf16)lb; }
    for (int idx = gt; idx < 512 * 64; idx += NGT) { const int n = idx >> 6, ch = idx & 63; if ((n >> 7) != (ch >> 4)) *(v4u*)(WpoolT + (size_t)n * 512 + ch * 8) = (v4u){0u, 0u, 0u, 0u}; }
    for (int m = gw; m < NTOK; m += NGW) {
        const f32x4* xr = (const f32x4*)(x + (size_t)m * DM) + F.lane;
        f32x4 v[4]; float ss = 0.f; float d8[8];
#pragma unroll
        for (int c = 0; c < 8; ++c) d8[c] = 0.f;
#pragma unroll
        for (int j = 0; j < 4; ++j) { v[j] = xr[64 * j]; ss += (v[j].x * v[j].x + v[j].y * v[j].y) + (v[j].z * v[j].z + v[j].w * v[j].w); }
#pragma unroll
        for (int c = 0; c < 8; ++c)
#pragma unroll
            for (int j = 0; j < 4; ++j) { const f32x4 w = *(const LAS f32x4*)(W8T + c * 1024 + 256 * j + 4 * F.lane); d8[c] += (v[j].x * w.x + v[j].y * w.y) + (v[j].z * w.z + v[j].w * w.w); }
        ss = wave_sum(ss);
#pragma unroll
        for (int c = 0; c < 8; ++c) d8[c] = wave_sum(d8[c]);
        const float rs = 1.f / sqrtf(ss * (1.f / DM) + 1e-6f);
        unsigned long long* o8 = (unsigned long long*)(xb + (size_t)m * DM) + F.lane;
#pragma unroll
        for (int j = 0; j < 4; ++j) o8[64 * j] = (unsigned long long)pk2(v[j].x, v[j].y) | ((unsigned long long)pk2(v[j].z, v[j].w) << 32);
        if (F.lane == 0) rs1[m] = rs;
        if (F.lane < 4) {
            float bl = 0.f, al = 0.f;
#pragma unroll
            for (int c = 0; c < 4; ++c) { bl = (F.lane == c) ? d8[c] : bl; al = (F.lane == c) ? d8[4 + c] : al; }
            bl *= rs; al *= rs;
            betaA[(size_t)m * 4 + F.lane] = 1.f / (1.f + expf(-bl));
            const float z = al + dt_bias[F.lane]; const float sp = z > 20.f ? z : log1pf(expf(z));
            gA[(size_t)m * 4 + F.lane] = -expf(a_log[F.lane]) * sp;
        }
    }
}

__device__ __forceinline__ void phase_mix(Frame& F) {
    const bf16* proj = (const bf16*)(F.ws + WS_PROJ); bf16* mixed = (bf16*)(F.ws + WS_MIXED);
    const int gw = F.vcu * NWAVES + F.wave, NGW = F.G * NWAVES;
    const int ch = 8 * F.lane, gi = F.lane >> 4, win = 2 << gi, hal = win - 1;
    for (int rbk = gw; rbk < NTOK / 16; rbk += NGW) {
        const int m0 = rbk * 16, t0 = m0 % SEQ;
        v4u X[31];
#pragma unroll
        for (int k = 0; k < 31; ++k) { X[k] = (v4u){0u, 0u, 0u, 0u}; if (k >= 15 - hal && t0 - 15 + k >= 0) X[k] = *(const v4u*)(proj + (size_t)(m0 - 15 + k) * NPROJ + 2048 + ch); }
        float s[8];
#pragma unroll
        for (int q = 0; q < 8; ++q) s[q] = 0.f;
#pragma unroll
        for (int k = 0; k < 15; ++k) { s[0] += bflo(X[k].x); s[1] += bfhi(X[k].x); s[2] += bflo(X[k].y); s[3] += bfhi(X[k].y); s[4] += bflo(X[k].z); s[5] += bfhi(X[k].z); s[6] += bflo(X[k].w); s[7] += bfhi(X[k].w); }
#pragma unroll
        for (int r = 0; r < 16; ++r) {
            const v4u u = X[15 + r];
            const float p[8] = {bflo(u.x), bfhi(u.x), bflo(u.y), bfhi(u.y), bflo(u.z), bfhi(u.z), bflo(u.w), bfhi(u.w)};
#pragma unroll
            for (int q = 0; q < 8; ++q) s[q] += p[q];
            const int tt = t0 + r + 1; const float ic = 1.f / (float)(tt < win ? tt : win);
            v4u o; o.x = pk2(s[0] * ic - p[0], s[1] * ic - p[1]); o.y = pk2(s[2] * ic - p[2], s[3] * ic - p[3]); o.z = pk2(s[4] * ic - p[4], s[5] * ic - p[5]); o.w = pk2(s[6] * ic - p[6], s[7] * ic - p[7]);
            *(v4u*)(mixed + (size_t)(m0 + r) * 512 + ch) = o;
            const v4u od = gi == 0 ? X[14 + r] : gi == 1 ? X[12 + r] : gi == 2 ? X[8 + r] : X[r];
            s[0] -= bflo(od.x); s[1] -= bfhi(od.x); s[2] -= bflo(od.y); s[3] -= bfhi(od.y); s[4] -= bflo(od.z); s[5] -= bfhi(od.z); s[6] -= bflo(od.w); s[7] -= bfhi(od.w);
        }
    }
}

typedef float f32x16 __attribute__((ext_vector_type(16)));
__device__ __forceinline__ bf16x8 pack8(const f32x4 a, const f32x4 b) {
    v4u w; w.x = cvt_pk_bf16(a[0], a[1]); w.y = cvt_pk_bf16(a[2], a[3]); w.z = cvt_pk_bf16(b[0], b[1]); w.w = cvt_pk_bf16(b[2], b[3]);
    return __builtin_bit_cast(bf16x8, w);
}
__device__ __forceinline__ void fmac_(float& acc, float a, float b) { asm("v_fmac_f32 %0, %1, %2" : "+v"(acc) : "v"(a), "v"(b)); }
__device__ __forceinline__ float bf2f(unsigned short u) { return __builtin_bit_cast(float, (unsigned)u << 16); }

template <int I> __device__ __forceinline__ void solve_rows(float (&U)[64], const LAS float* Am, const f32x4 (&cur)[4]) {
    if constexpr (I < 64) {
        constexpr int NQ = (I + 3) / 4, NQN = (I + 4) / 4, NR = NQ > 4 ? NQ - 4 : 1;
        f32x4 rest[NR];
#pragma unroll
        for (int j4 = 4; j4 < NQ; ++j4) rest[j4 - 4] = *(const LAS f32x4*)(Am + I * 64 + 4 * j4);
        f32x4 nxt[4];
        if constexpr (I + 1 < 64) {
#pragma unroll
            for (int j4 = 0; j4 < (NQN < 4 ? NQN : 4); ++j4) nxt[j4] = *(const LAS f32x4*)(Am + (I + 1) * 64 + 4 * j4);
        }
        float s0 = 0.f, s1 = 0.f, s2 = 0.f, s3 = 0.f;
#pragma unroll
        for (int j4 = 0; j4 < (NQ < 4 ? NQ : 4); ++j4) { const f32x4 a = cur[j4];
            fmac_(s0, a.x, U[4 * j4]); if (4 * j4 + 1 < I) fmac_(s1, a.y, U[4 * j4 + 1]); if (4 * j4 + 2 < I) fmac_(s2, a.z, U[4 * j4 + 2]); if (4 * j4 + 3 < I) fmac_(s3, a.w, U[4 * j4 + 3]); }
#pragma unroll
        for (int j4 = 4; j4 < NQ; ++j4) { const f32x4 a = rest[j4 - 4];
            fmac_(s0, a.x, U[4 * j4]); if (4 * j4 + 1 < I) fmac_(s1, a.y, U[4 * j4 + 1]); if (4 * j4 + 2 < I) fmac_(s2, a.z, U[4 * j4 + 2]); if (4 * j4 + 3 < I) fmac_(s3, a.w, U[4 * j4 + 3]); }
        U[I] -= (s0 + s1) + (s2 + s3);
        __builtin_amdgcn_sched_barrier(0);
        solve_rows<I + 1>(U, Am, nxt);
    }
}

constexpr int CP_QN = 0, CP_KN = 17408, CP_VA = 34816, CP_QKL = 51200, CP_SC = 59392, CP_HALF = 61440;
__device__ __forceinline__ void phase_chunk(Frame& F) {
    const float* conv_w = F.in[3];
    const bf16* proj = (const bf16*)(F.ws + WS_PROJ);
    const float* betaA = (const float*)(F.ws + WS_BETA); const float* gA = (const float*)(F.ws + WS_G);
    float* gtotA = (float*)(F.ws + WS_GTOT);
    const int half = F.wave >> 2, hw = F.wave & 3;
    LAS unsigned char* L = F.lds + half * CP_HALF;
    LAS bf16* qn = (LAS bf16*)(L + CP_QN); LAS bf16* kn = (LAS bf16*)(L + CP_KN); LAS bf16* vn = (LAS bf16*)(L + CP_VA);
    LAS float* Am = (LAS float*)(L + CP_VA); LAS bf16* qkL = (LAS bf16*)(L + CP_QKL); LAS float* sc = (LAS float*)(L + CP_SC);
#pragma unroll 1
    for (int it = 0; it < 4; ++it) {
        int tid_ = F.tid; asm volatile("" : "+v"(tid_));
        const int ht = tid_ & 255, lane = tid_ & 63, r16 = lane & 15, gq = lane >> 4;
        const int unit = (it * (int)gridDim.x + (int)blockIdx.x) * 2 + half;
        const bool live = unit < NB * NH * 64;
        const int bh = unit >> 6, n = unit & 63, b = bh >> 2, h = bh & 3;
        const size_t m0 = (size_t)b * SEQ + (size_t)n * 64;
        unsigned char* chunk = F.ws + WS_CHUNK + (size_t)unit * CH_BYTES;
        if (live && hw == 0) {
            const float gi = gA[(m0 + lane) * 4 + h], bi = betaA[(m0 + lane) * 4 + h];
            float c = gi;
#pragma unroll
            for (int o = 1; o < 64; o <<= 1) { const float tt = __shfl_up(c, o); if (lane >= o) c += tt; }
            const float gl = __shfl(c, 63);
            sc[lane] = bi; sc[64 + lane] = c; sc[128 + lane] = __expf(c); sc[192 + lane] = __expf(gl - c);
            if (lane == 63) gtotA[unit] = __expf(c);
        }
        if (live) {
            const int rq = ht >> 4, cg = ht & 15;
#pragma unroll 1
            for (int p = 0; p < 3; ++p) {
                const int col = p * 512 + h * 128 + 8 * cg;
                float xin[7][8];
#pragma unroll
                for (int jj = 0; jj < 7; ++jj) { const int trow = n * 64 + 4 * rq - 3 + jj; v4u u = (v4u){0u, 0u, 0u, 0u};
                    if (trow >= 0) u = *(const v4u*)(proj + ((size_t)b * SEQ + trow) * NPROJ + col);
                    xin[jj][0] = bflo(u.x); xin[jj][1] = bfhi(u.x); xin[jj][2] = bflo(u.y); xin[jj][3] = bfhi(u.y); xin[jj][4] = bflo(u.z); xin[jj][5] = bfhi(u.z); xin[jj][6] = bflo(u.w); xin[jj][7] = bfhi(u.w); }
                float wv[4][8];
#pragma unroll
                for (int j = 0; j < 4; ++j) { const f32x4 w0 = *(const f32x4*)(conv_w + j * 1536 + col), w1 = *(const f32x4*)(conv_w + j * 1536 + col + 4);
                    wv[j][0] = w0.x; wv[j][1] = w0.y; wv[j][2] = w0.z; wv[j][3] = w0.w; wv[j][4] = w1.x; wv[j][5] = w1.y; wv[j][6] = w1.z; wv[j][7] = w1.w; }
#pragma unroll
                for (int rr = 0; rr < 4; ++rr) {
                    float y[8]; float ss = 0.f;
#pragma unroll
                    for (int q = 0; q < 8; ++q) { float a = 0.f;
#pragma unroll
                        for (int j = 0; j < 4; ++j) a += wv[j][q] * xin[rr + j][q];
                        y[q] = siluf_(a); ss += y[q] * y[q]; }
                    float scl = 1.f;
                    if (p < 2) { ss += __shfl_xor(ss, 1); ss += __shfl_xor(ss, 2); ss += __shfl_xor(ss, 4); ss += __shfl_xor(ss, 8); scl = frsq_(ss + 1e-6f); if (p == 0) scl *= 0.08838834764831845f; }
                    v4u o; o.x = pk2(y[0] * scl, y[1] * scl); o.y = pk2(y[2] * scl, y[3] * scl); o.z = pk2(y[4] * scl, y[5] * scl); o.w = pk2(y[6] * scl, y[7] * scl);
                    const int row = 4 * rq + rr;
                    if (p == 0) *(LAS v4u*)(qn + row * 136 + 8 * cg) = o; else if (p == 1) *(LAS v4u*)(kn + row * 136 + 8 * cg) = o; else *(LAS v4u*)(vn + row * 128 + 8 * cg) = o;
                }
            }
        }
        __syncthreads();
        const int which = ht >> 7, c = ht & 127;
        float U[64];
        if (live) {
#pragma unroll
            for (int i = 0; i < 64; ++i) { const float bi = sc[i]; const float tv = which ? bf2f(kn[i * 136 + c]) * sc[128 + i] : bf2f(vn[i * 128 + c]); U[i] = tv * bi; }
        } else {
#pragma unroll
            for (int i = 0; i < 64; ++i) U[i] = 0.f;
        }
        __syncthreads();
        if (live) {
            const int ti = hw >> 1, tj = hw & 1, r = lane & 31, hh = lane >> 5;
            f32x16 KK, QK;
#pragma unroll
            for (int q = 0; q < 16; ++q) { KK[q] = 0.f; QK[q] = 0.f; }
#pragma unroll
            for (int ks = 0; ks < 8; ++ks) {
                const bf16x8 ak = *(const LAS bf16x8*)(kn + (ti * 32 + r) * 136 + 16 * ks + 8 * hh);
                const bf16x8 aq = *(const LAS bf16x8*)(qn + (ti * 32 + r) * 136 + 16 * ks + 8 * hh);
                const bf16x8 bb = *(const LAS bf16x8*)(kn + (tj * 32 + r) * 136 + 16 * ks + 8 * hh);
                KK = __builtin_amdgcn_mfma_f32_32x32x16_bf16(ak, bb, KK, 0, 0, 0);
                QK = __builtin_amdgcn_mfma_f32_32x32x16_bf16(aq, bb, QK, 0, 0, 0);
            }
            const int j = tj * 32 + r; const float gcj = sc[64 + j];
#pragma unroll
            for (int reg = 0; reg < 16; ++reg) { const int i = ti * 32 + (reg & 3) + 8 * (reg >> 2) + 4 * hh;
                const float dec = (i >= j) ? __expf(sc[64 + i] - gcj) : 0.f;
                Am[i * 64 + j] = (i > j) ? sc[i] * KK[reg] * dec : 0.f;
                qkL[i * 64 + j] = (bf16)f2bf((i >= j) ? QK[reg] * dec : 0.f); }
        }
        __syncthreads();
        if (live) {
#pragma unroll
            for (int fi = 0; fi < 4; ++fi) { const int f = hw * 4 + fi, mb = f >> 2, ks = f & 3, row = 16 * mb + r16; const float s = sc[128 + row];
                const v2u lo = *(const LAS v2u*)(qn + row * 136 + 32 * ks + 4 * gq), hi = *(const LAS v2u*)(qn + row * 136 + 32 * ks + 16 + 4 * gq);
                v4u o; o.x = pk2(bflo(lo.x) * s, bfhi(lo.x) * s); o.y = pk2(bflo(lo.y) * s, bfhi(lo.y) * s); o.z = pk2(bflo(hi.x) * s, bfhi(hi.x) * s); o.w = pk2(bflo(hi.y) * s, bfhi(hi.y) * s);
                *(v4u*)(chunk + CH_QD + (f * 64 + lane) * 16) = o; }
#pragma unroll
            for (int fi = 0; fi < 4; ++fi) { const int f = hw * 4 + fi, db = f >> 1, ksp = f & 1, dcol = 16 * db + r16; float e[8];
#pragma unroll
                for (int j = 0; j < 8; ++j) { const int i = 32 * ksp + 16 * (j >> 2) + 4 * gq + (j & 3); e[j] = bf2f(kn[i * 136 + dcol]) * sc[192 + i]; }
                v4u o; o.x = pk2(e[0], e[1]); o.y = pk2(e[2], e[3]); o.z = pk2(e[4], e[5]); o.w = pk2(e[6], e[7]);
                *(v4u*)(chunk + CH_KT + (f * 64 + lane) * 16) = o; }
#pragma unroll
            for (int fi = 0; fi < 2; ++fi) { const int f = hw * 2 + fi, mb = f >> 1, ksp = f & 1, row = 16 * mb + r16;
                const v2u lo = *(const LAS v2u*)(qkL + row * 64 + 32 * ksp + 4 * gq), hi = *(const LAS v2u*)(qkL + row * 64 + 32 * ksp + 16 + 4 * gq);
                *(v4u*)(chunk + CH_QK + (f * 64 + lane) * 16) = (v4u){lo.x, lo.y, hi.x, hi.y}; }
            { f32x4 first[4]; first[0] = *(const LAS f32x4*)(Am + 1 * 64); solve_rows<1>(U, Am, first); }
        }
        __syncthreads();
        if (live) {
            if (which == 0) {
                const int w8 = c >> 4, cl = c & 15;
                unsigned char* ub = F.ws + WS_UC + (size_t)unit * UC_BYTES;
#pragma unroll
                for (int g = 0; g < 4; ++g) {
                    v4u lo, hi;
                    lo.x = pk2(U[4 * g], U[4 * g + 1]); lo.y = pk2(U[4 * g + 2], U[4 * g + 3]); lo.z = pk2(U[16 + 4 * g], U[16 + 4 * g + 1]); lo.w = pk2(U[16 + 4 * g + 2], U[16 + 4 * g + 3]);
                    hi.x = pk2(U[32 + 4 * g], U[32 + 4 * g + 1]); hi.y = pk2(U[32 + 4 * g + 2], U[32 + 4 * g + 3]); hi.z = pk2(U[48 + 4 * g], U[48 + 4 * g + 1]); hi.w = pk2(U[48 + 4 * g + 2], U[48 + 4 * g + 3]);
                    v4u* dst = (v4u*)(ub + ((w8 * 64 + g * 16 + cl) * 32)); dst[0] = lo; dst[1] = hi;
                }
            } else {
#pragma unroll
                for (int i = 0; i < 64; ++i) qn[i * 136 + c] = (bf16)f2bf(U[i]);
            }
        }
        __syncthreads();
        if (live) {
#pragma unroll
            for (int fi = 0; fi < 4; ++fi) { const int f = hw * 4 + fi, mb = f >> 2, ks = f & 3, row = 16 * mb + r16;
                const v2u lo = *(const LAS v2u*)(qn + row * 136 + 32 * ks + 4 * gq), hi = *(const LAS v2u*)(qn + row * 136 + 32 * ks + 16 + 4 * gq);
                *(v4u*)(chunk + CH_WF + (f * 64 + lane) * 16) = (v4u){lo.x, lo.y, hi.x, hi.y}; }
        }
        __syncthreads();
    }
}

__device__ __forceinline__ void phase_scan(Frame& F) {
    const int bh = blockIdx.x, b = bh >> 2, h = bh & 3, w = F.wave, lane = F.lane, cl = lane & 15, gq = lane >> 4;
    const float* gtotA = (const float*)(F.ws + WS_GTOT);
    const int unit0 = bh * 64;
    const unsigned char* cbase = F.ws + WS_CHUNK + (size_t)unit0 * CH_BYTES;
    const unsigned char* ubase = F.ws + WS_UC + (size_t)unit0 * UC_BYTES + (w * 64 + lane) * 32;
    bf16* op = (bf16*)(F.ws + WS_ORAW) + ((size_t)b * SEQ + cl) * 512 + h * 128 + 16 * w + 4 * gq;
    f32x4 Sacc[8]; bf16x8 Sb[4];
#pragma unroll
    for (int d = 0; d < 8; ++d) Sacc[d] = (f32x4){0.f, 0.f, 0.f, 0.f};
#pragma unroll
    for (int k = 0; k < 4; ++k) Sb[k] = (bf16x8){0, 0, 0, 0, 0, 0, 0, 0};
#define SCAN_ISSUE(nn) do { const unsigned char* s_ = cbase + (size_t)(nn) * CH_BYTES + (w * 7) * 1024 + lane * 16; LAS unsigned char* d_ = F.lds + ((nn) & 1) * CH_BYTES + (w * 7) * 1024; \
        _Pragma("unroll") for (int k_ = 0; k_ < 7; ++k_) __builtin_amdgcn_global_load_lds((const unsigned*)(s_ + k_ * 1024), (LAS unsigned*)(d_ + k_ * 1024), 16, 0, 0); } while (0)
    SCAN_ISSUE(0);
    v4u nu0 = *(const v4u*)(ubase), nu1 = *(const v4u*)(ubase + 16);
    float ngt = gtotA[unit0];
    v2u Ow[4];
#pragma unroll
    for (int mb = 0; mb < 4; ++mb) Ow[mb] = (v2u){0u, 0u};
#pragma unroll 1
    for (int n = 0; n < 64; ++n) {
        VM_WAIT(); __syncthreads();
        const v4u cu0 = nu0, cu1 = nu1; const float gt = ngt;
        if (n + 1 < 64) { SCAN_ISSUE(n + 1); nu0 = *(const v4u*)(ubase + (size_t)(n + 1) * UC_BYTES); nu1 = *(const v4u*)(ubase + (size_t)(n + 1) * UC_BYTES + 16); ngt = gtotA[unit0 + n + 1]; }
        if (n > 0) {
#pragma unroll
            for (int mb = 0; mb < 4; ++mb) *(v2u*)(op + (size_t)((n - 1) * 64 + 16 * mb) * 512) = Ow[mb];
        }
        const LAS unsigned char* B = F.lds + (n & 1) * CH_BYTES;
#define FRAG(off, f) (*(const LAS bf16x8*)(B + (off) + ((f) * 64 + lane) * 16))
        f32x4 P[4];
#pragma unroll
        for (int mb = 0; mb < 4; ++mb) { P[mb] = (f32x4){0.f, 0.f, 0.f, 0.f};
#pragma unroll
            for (int ks = 0; ks < 4; ++ks) P[mb] = __builtin_amdgcn_mfma_f32_16x16x32_bf16(FRAG(CH_WF, mb * 4 + ks), Sb[ks], P[mb], 0, 0, 0); }
        f32x4 vnw[4];
        vnw[0] = (f32x4){bflo(cu0.x), bfhi(cu0.x), bflo(cu0.y), bfhi(cu0.y)} - P[0];
        vnw[1] = (f32x4){bflo(cu0.z), bfhi(cu0.z), bflo(cu0.w), bfhi(cu0.w)} - P[1];
        vnw[2] = (f32x4){bflo(cu1.x), bfhi(cu1.x), bflo(cu1.y), bfhi(cu1.y)} - P[2];
        vnw[3] = (f32x4){bflo(cu1.z), bfhi(cu1.z), bflo(cu1.w), bfhi(cu1.w)} - P[3];
        bf16x8 Vb[2]; Vb[0] = pack8(vnw[0], vnw[1]); Vb[1] = pack8(vnw[2], vnw[3]);
#pragma unroll
        for (int db = 0; db < 8; ++db) { Sacc[db] = Sacc[db] * gt;
#pragma unroll
            for (int ksp = 0; ksp < 2; ++ksp) Sacc[db] = __builtin_amdgcn_mfma_f32_16x16x32_bf16(FRAG(CH_KT, db * 2 + ksp), Vb[ksp], Sacc[db], 0, 0, 0); }
#pragma unroll
        for (int mb = 0; mb < 4; ++mb) { f32x4 OT = (f32x4){0.f, 0.f, 0.f, 0.f};
#pragma unroll
            for (int ks = 0; ks < 4; ++ks) OT = __builtin_amdgcn_mfma_f32_16x16x32_bf16(Sb[ks], FRAG(CH_QD, mb * 4 + ks), OT, 0, 0, 0);
#pragma unroll
            for (int ksp = 0; ksp < 2; ++ksp) OT = __builtin_amdgcn_mfma_f32_16x16x32_bf16(Vb[ksp], FRAG(CH_QK, mb * 2 + ksp), OT, 0, 0, 0);
            Ow[mb] = (v2u){cvt_pk_bf16(OT[0], OT[1]), cvt_pk_bf16(OT[2], OT[3])}; }
#pragma unroll
        for (int ks = 0; ks < 4; ++ks) Sb[ks] = pack8(Sacc[2 * ks], Sacc[2 * ks + 1]);
#undef FRAG
    }
#undef SCAN_ISSUE
#pragma unroll
    for (int mb = 0; mb < 4; ++mb) *(v2u*)(op + (size_t)(63 * 64 + 16 * mb) * 512) = Ow[mb];
    VM_WAIT(); __syncthreads();
}

__device__ __forceinline__ void phase_onorm(Frame& F) {
    const float* dnw = F.in[6]; const bf16* proj = (const bf16*)(F.ws + WS_PROJ); const bf16* oraw = (const bf16*)(F.ws + WS_ORAW); bf16* concat = (bf16*)(F.ws + WS_CONCAT);
    const int gw = F.vcu * NWAVES + F.wave, NGW = F.G * NWAVES, lane = F.lane;
    const int cc = 8 * (lane & 15);
    const f32x4 d0 = *(const f32x4*)(dnw + cc), d1 = *(const f32x4*)(dnw + cc + 4);
    for (int m = gw; m < NTOK; m += NGW) {
        const v4u o = *(const v4u*)(oraw + (size_t)m * 512 + 8 * lane);
        const v4u z = *(const v4u*)(proj + (size_t)m * NPROJ + 1536 + 8 * lane);
        const float ov[8] = {bflo(o.x), bfhi(o.x), bflo(o.y), bfhi(o.y), bflo(o.z), bfhi(o.z), bflo(o.w), bfhi(o.w)};
        const float zv[8] = {bflo(z.x), bfhi(z.x), bflo(z.y), bfhi(z.y), bflo(z.z), bfhi(z.z), bflo(z.w), bfhi(z.w)};
        float ss = 0.f;
#pragma unroll
        for (int q = 0; q < 8; ++q) ss += ov[q] * ov[q];
        ss += __shfl_xor(ss, 1); ss += __shfl_xor(ss, 2); ss += __shfl_xor(ss, 4); ss += __shfl_xor(ss, 8);
        const float rs = frsq_(ss * (1.f / 128.f) + 1e-6f);
        const float dv[8] = {d0.x, d0.y, d0.z, d0.w, d1.x, d1.y, d1.z, d1.w};
        float r[8];
#pragma unroll
        for (int q = 0; q < 8; ++q) r[q] = ov[q] * rs * dv[q] * siluf_(zv[q]);
        *(v4u*)(concat + (size_t)m * DM + 8 * lane) = (v4u){cvt_pk_bf16(r[0], r[1]), cvt_pk_bf16(r[2], r[3]), cvt_pk_bf16(r[4], r[5]), cvt_pk_bf16(r[6], r[7])};
    }
}

__device__ __forceinline__ void phase_route(Frame& F) {
    const float* x1 = F.out; const float* b_router = F.in[12];
    unsigned char* x1b = F.ws + WS_X1B; float* rs2A = (float*)(F.ws + WS_RS2); int* list = (int*)(F.ws + WS_LIST);
    float* rsl = (float*)(F.ws + WS_RSL); float* gwl = (float*)(F.ws + WS_GWL);
    unsigned* cntw = (unsigned*)(F.ws + WS_CTL) + CW_CNT;
    LAS unsigned char* WI = F.lds;
    LAS unsigned* lcnt = (LAS unsigned*)(F.lds + TAB_OFF);
    { const v4u* src = (const v4u*)(F.ws + WS_WR);
      for (int idx = F.tid; idx < 131072 / 16; idx += 512) *(LAS v4u*)(WI + 16 * idx) = src[idx]; }
    const int lane = F.lane, c = lane & 15, g = lane >> 4;
    const int gw = F.vcu * NWAVES + F.wave, NGW = F.G * NWAVES, NT = NTOK / 16;
    const float bia0 = b_router[c], bia1 = b_router[16 + c];
    for (int t0 = 0; t0 < NT; t0 += NGW) {
        const int tile = t0 + gw; const bool live = tile < NT;
        if (F.tid < 64) lcnt[F.tid] = 0u;
        __syncthreads();
        int my_e = 0; float my_g = 0.f, my_rs = 0.f; unsigned my_rank = 0u; int my_ent = 0;
        if (live) {
            const int m0 = tile * 16;
            const float* xrow = x1 + (size_t)(m0 + c) * DM + 8 * g;
            unsigned char* xbrow = x1b + (size_t)(m0 + c) * DM + 8 * g;
            f32x4 acc0 = (f32x4){0.f, 0.f, 0.f, 0.f}, acc1 = acc0; float ssq = 0.f;
#pragma unroll 1
            for (int kb = 0; kb < 4; ++kb) {
                f32x4 xa[8], xb4[8];
#pragma unroll
                for (int q = 0; q < 8; ++q) { xa[q] = *(const f32x4*)(xrow + 32 * (kb * 8 + q)); xb4[q] = *(const f32x4*)(xrow + 32 * (kb * 8 + q) + 4); }
#pragma unroll
                for (int q = 0; q < 8; ++q) { const int ks = kb * 8 + q; const f32x4 a = xa[q], b = xb4[q];
                    ssq += (a.x * a.x + a.y * a.y) + (a.z * a.z + a.w * a.w) + (b.x * b.x + b.y * b.y) + (b.z * b.z + b.w * b.w);
                    v4u h; h.x = cvt_pk_bf16(a.x, a.y); h.y = cvt_pk_bf16(a.z, a.w); h.z = cvt_pk_bf16(b.x, b.y); h.w = cvt_pk_bf16(b.z, b.w);
                    v4u l; l.x = cvt_pk_bf16(a.x - bflo(h.x), a.y - bfhi(h.x)); l.y = cvt_pk_bf16(a.z - bflo(h.y), a.w - bfhi(h.y)); l.z = cvt_pk_bf16(b.x - bflo(h.z), b.y - bfhi(h.z)); l.w = cvt_pk_bf16(b.z - bflo(h.w), b.w - bfhi(h.w));
                    *(v2u*)(xbrow + 32 * ks) = (v2u){pk4_fp8(a.x, a.y, a.z, a.w), pk4_fp8(b.x, b.y, b.z, b.w)};
                    const bf16x8 ah = __builtin_bit_cast(bf16x8, h), al = __builtin_bit_cast(bf16x8, l);
                    const LAS unsigned char* fb = WI + (size_t)(ks * 4) * 1024 + lane * 16;
                    const bf16x8 b0h = *(const LAS bf16x8*)(fb), b0l = *(const LAS bf16x8*)(fb + 1024), b1h = *(const LAS bf16x8*)(fb + 2048), b1l = *(const LAS bf16x8*)(fb + 3072);
                    acc0 = __builtin_amdgcn_mfma_f32_16x16x32_bf16(ah, b0h, acc0, 0, 0, 0); acc0 = __builtin_amdgcn_mfma_f32_16x16x32_bf16(ah, b0l, acc0, 0, 0, 0); acc0 = __builtin_amdgcn_mfma_f32_16x16x32_bf16(al, b0h, acc0, 0, 0, 0);
                    acc1 = __builtin_amdgcn_mfma_f32_16x16x32_bf16(ah, b1h, acc1, 0, 0, 0); acc1 = __builtin_amdgcn_mfma_f32_16x16x32_bf16(ah, b1l, acc1, 0, 0, 0); acc1 = __builtin_amdgcn_mfma_f32_16x16x32_bf16(al, b1h, acc1, 0, 0, 0); }
            }
            ssq += __shfl_xor(ssq, 16); ssq += __shfl_xor(ssq, 32);
            const float rsr = frsq_(ssq * (1.f / DM) + 1e-6f);
            if (g == 0) rs2A[m0 + c] = rsr;
            float ge_[4]; int ee_[4];
#pragma unroll
            for (int reg = 0; reg < 4; ++reg) {
                const float rsw = __shfl(rsr, 4 * g + reg);
                float v0 = acc0[reg] * rsw + bia0, v1 = acc1[reg] * rsw + bia1;
                float tv[4]; int te[4];
#pragma unroll
                for (int s = 0; s < 4; ++s) {
                    float bv; int bi; if (v1 > v0) { bv = v1; bi = 16 + c; } else { bv = v0; bi = c; }
#pragma unroll
                    for (int o = 1; o < 16; o <<= 1) { const float ov = __shfl_xor(bv, o); const int oi = __shfl_xor(bi, o); if (ov > bv || (ov == bv && oi < bi)) { bv = ov; bi = oi; } }
                    tv[s] = bv; te[s] = bi; if (bi == c) v0 = -3.0e38f; if (bi == 16 + c) v1 = -3.0e38f;
                }
                const float e1 = fexp_(tv[1] - tv[0]), e2 = fexp_(tv[2] - tv[0]), e3 = fexp_(tv[3] - tv[0]); const float inv = frcp_(1.f + e1 + e2 + e3);
                const int s_ = c & 3; const float gsel = (s_ == 0 ? 1.f : s_ == 1 ? e1 : s_ == 2 ? e2 : e3) * inv; const int esel = s_ == 0 ? te[0] : s_ == 1 ? te[1] : s_ == 2 ? te[2] : te[3];
                ge_[reg] = gsel; ee_[reg] = esel;
            }
            const int rsel = c >> 2;
            my_g = rsel == 0 ? ge_[0] : rsel == 1 ? ge_[1] : rsel == 2 ? ge_[2] : ge_[3];
            my_e = rsel == 0 ? ee_[0] : rsel == 1 ? ee_[1] : rsel == 2 ? ee_[2] : ee_[3];
            my_ent = (m0 + 4 * g + rsel) * 4 + (c & 3);
            my_rs = __shfl(rsr, 4 * g + rsel);
            my_rank = __hip_atomic_fetch_add(lcnt + my_e, 1u, __ATOMIC_RELAXED, __HIP_MEMORY_SCOPE_WORKGROUP);
        }
        __syncthreads();
        if (F.tid < NE) { const unsigned n = lcnt[F.tid]; lcnt[32 + F.tid] = n ? __hip_atomic_fetch_add(cntw + 64 * F.tid, n, RLX_AGENT) : 0u; }
        __syncthreads();
        if (live) { const size_t pos = (size_t)my_e * LISTCAP + lcnt[32 + my_e] + my_rank; list[pos] = my_ent; rsl[pos] = my_rs; gwl[pos] = my_g; }
        __syncthreads();
    }
}

__device__ __forceinline__ int moe_tables(Frame& F, MoeTab& T) {
    LAS int* pref = (LAS int*)(F.lds + TAB_OFF); LAS int* cnt = pref + 40;
    unsigned* cntw = (unsigned*)(F.ws + WS_CTL) + CW_CNT;
    if (F.tid == 0) { int acc = 0; for (int e = 0; e < NE; ++e) { const int c = (int)__hip_atomic_load(cntw + 64 * e, RLX_AGENT); cnt[e] = c; pref[e] = acc; acc += (c + 255) >> 8; } pref[NE] = acc; }
    __syncthreads();
    T.pref = pref; T.cnt = cnt;
    return pref[NE];
}

struct FinalRow { f32x4 v[4]; v4u sl[4][2]; };
__device__ __forceinline__ void final_load(FinalRow& R, const float* orow, const bf16* srow) {
#pragma unroll
    for (int j = 0; j < 2; ++j) { R.v[2 * j] = *(const f32x4*)(orow + 512 * j); R.v[2 * j + 1] = *(const f32x4*)(orow + 512 * j + 4); }
#pragma unroll
    for (int s = 0; s < 4; ++s)
#pragma unroll
        for (int j = 0; j < 2; ++j) R.sl[s][j] = *(const v4u*)(srow + (size_t)s * DM + 512 * j);
}
__device__ __forceinline__ void final_finish(FinalRow& R, float* orow, const f32x4 (&wv)[4], size_t dry_off) {
    orow += dry_off;
#pragma unroll
    for (int s = 0; s < 4; ++s)
#pragma unroll
        for (int j = 0; j < 2; ++j) { const v4u u = R.sl[s][j];
            R.v[2 * j].x += bflo(u.x); R.v[2 * j].y += bfhi(u.x); R.v[2 * j].z += bflo(u.y); R.v[2 * j].w += bfhi(u.y);
            R.v[2 * j + 1].x += bflo(u.z); R.v[2 * j + 1].y += bfhi(u.z); R.v[2 * j + 1].z += bflo(u.w); R.v[2 * j + 1].w += bfhi(u.w); }
    float ss = 0.f;
#pragma unroll
    for (int j = 0; j < 4; ++j) ss += (R.v[j].x * R.v[j].x + R.v[j].y * R.v[j].y) + (R.v[j].z * R.v[j].z + R.v[j].w * R.v[j].w);
    ss = wave_sum(ss);
    const float rs = frsq_(ss * (1.f / DM) + 1e-6f);
#pragma unroll
    for (int j = 0; j < 2; ++j) { *(f32x4*)(orow + 512 * j) = R.v[2 * j] * rs * wv[2 * j]; *(f32x4*)(orow + 512 * j + 4) = R.v[2 * j + 1] * rs * wv[2 * j + 1]; }
}
__device__ __forceinline__ void phase_final(Frame& F, int dryrun) {
    const float* fw = F.in[17]; const bf16* slab = (const bf16*)(F.ws + WS_SLAB); float* out = F.out;
    const int gw = F.vcu * NWAVES + F.wave, NGW = F.G * NWAVES, lane = F.lane;
    f32x4 wv[4];
#pragma unroll
    for (int j = 0; j < 2; ++j) { wv[2 * j] = *(const f32x4*)(fw + 512 * j + 8 * lane); wv[2 * j + 1] = *(const f32x4*)(fw + 512 * j + 8 * lane + 4); }
    const size_t dry_off = dryrun ? (size_t)((float*)(F.ws + WS_XB) - out) : 0;
    FinalRow A, B;
    int m = gw;
    if (m < NTOK) final_load(A, out + (size_t)m * DM + 8 * lane, slab + (size_t)m * 4 * DM + 8 * lane);
    for (; m < NTOK; m += 2 * NGW) {
        const int m1 = m + NGW, m2 = m + 2 * NGW;
        if (m1 < NTOK) final_load(B, out + (size_t)m1 * DM + 8 * lane, slab + (size_t)m1 * 4 * DM + 8 * lane);
        final_finish(A, out + (size_t)m * DM + 8 * lane, wv, dry_off);
        if (m2 < NTOK) final_load(A, out + (size_t)m2 * DM + 8 * lane, slab + (size_t)m2 * 4 * DM + 8 * lane);
        if (m1 < NTOK) final_finish(B, out + (size_t)m1 * DM + 8 * lane, wv, dry_off);
    }
}

struct Args { const float* in[18]; float* out; unsigned char* ws; int ph_lo, ph_hi, flag, pad; };
constexpr int NPHASE = 11;

__global__ void __launch_bounds__(NWAVES * 64, 2) mk_fwd(Args args) {
    extern __shared__ __attribute__((aligned(16))) unsigned char lds_raw[];
    Frame F;
    F.lds = (LAS unsigned char*)lds_raw;
    F.tid = threadIdx.x; F.lane = F.tid & 63; F.wave = __builtin_amdgcn_readfirstlane(F.tid >> 6);
    F.G = gridDim.x; { const int bx = blockIdx.x; F.vcu = (F.G % 8 == 0) ? (bx % 8) * (F.G / 8) + bx / 8 : bx; }
#pragma unroll
    for (int i = 0; i < 18; ++i) F.in[i] = args.in[i];
    F.out = args.out; F.ws = args.ws;
    volatile LAS unsigned* MISC = (volatile LAS unsigned*)(F.lds + MISC_OFF);
    for (int u = F.tid; u < (LDS_BYTES - LDSCTL_OFF) / 4; u += NWAVES * 64) ((LAS unsigned*)(F.lds + LDSCTL_OFF))[u] = 0u;
    __syncthreads();
    unsigned* ctl = (unsigned*)(F.ws + WS_CTL);
#if !MK_PER_PHASE
    XcdBarrier bar = xcd_barrier_post(ctl + CW_BAR, MISC + 8);
#define GRID_BAR() xcd_barrier(bar)
#else
#define GRID_BAR() do {} while (0)
#endif
    const int lo = args.ph_lo, hi = args.ph_hi;
#define IN(k) (lo <= (k) && (k) < hi)
#define SEAM(k) do { if (IN(k) && IN((k) + 1)) GRID_BAR(); } while (0)

#define RUNPH(k, ...) do { if (IN(k)) { __VA_ARGS__; } SEAM(k); } while (0)
    RUNPH(0, phase_prep(F));
    RUNPH(1, {
        ProbIn P; P.K = DM; P.RB = 2 * DM; P.S.init(NTOK / 256, NPROJ / 256, F.G, (int)blockIdx.x);
        P.A = (const bf16*)(F.ws + WS_XB); P.Bt = (const bf16*)(F.ws + WS_WIN); P.O = (bf16*)(F.ws + WS_PROJ); P.rs = (const float*)(F.ws + WS_RS1);
        pg8::gemm_phase(F.lds, P); });
    if (IN(2)) { phase_mix(F); __syncthreads(); }
    RUNPH(3, phase_chunk(F));
    RUNPH(4, {
        const int nscan = NB * NH;
        if ((int)blockIdx.x < nscan) phase_scan(F);
        else { ProbPool P; P.K = 512; P.RB = 1024; P.S.init(NTOK / 256, 2, F.G - nscan, (int)blockIdx.x - nscan);
               P.A = (const bf16*)(F.ws + WS_MIXED); P.Bt = (const bf16*)(F.ws + WS_WPOOL); P.O = (bf16*)(F.ws + WS_CONCAT);
               pg8::gemm_phase(F.lds, P);
               __syncthreads();
               moe_weight_prep(F, nscan, MOE_PREP_SPLIT, MOE_PREP_ITEMS); } });
    RUNPH(5, phase_onorm(F));
    RUNPH(6, {
        ProbOut P; P.K = DM; P.RB = 2 * DM; P.S.init(NTOK / 256, DM / 256, F.G, (int)blockIdx.x);
        P.A = (const bf16*)(F.ws + WS_CONCAT); P.Bt = (const bf16*)(F.ws + WS_WOUT); P.X = F.in[0]; P.O = F.out;
        pg8::gemm_phase(F.lds, P); });
    RUNPH(7, phase_route(F));
    RUNPH(8, {
        ProbGU P; const int RT = moe_tables(F, P.T);
        P.K = DM; P.RB = DM; P.S.init(RT, 8, F.G, (int)blockIdx.x);
        P.A = F.ws + WS_X1B; P.Bt = F.ws + WS_WGU; P.O = F.ws + WS_ACT; P.list = (const int*)(F.ws + WS_LIST);
        P.rs2 = (const float*)(F.ws + WS_RSL); P.bgu = (const float*)(F.ws + WS_BGU);
        pg8::gemm_phase<ProbGU, true>(F.lds, P); });
    RUNPH(9, {
        ProbDown P; const int RT = moe_tables(F, P.T);
        P.K = DE; P.RB = DE; P.S.init(RT, 4, F.G, (int)blockIdx.x);
        P.A = F.ws + WS_ACT; P.Bt = F.ws + WS_WD; P.O = (bf16*)(F.ws + WS_SLAB); P.list = (const int*)(F.ws + WS_LIST);
        P.gw = (const float*)(F.ws + WS_GWL); P.bd = F.in[16];
        pg8::gemm_phase<ProbDown, true>(F.lds, P); });
    RUNPH(10, phase_final(F, args.flag));
#undef RUNPH
#undef IN
#undef SEAM
}

extern "C" void kernel_launch(void* const* d_in, const int* in_sizes, int n_in, void* d_out, int out_size, void* d_ws, size_t ws_size, hipStream_t stream) {
    static int grid = 0;
    if (grid == 0) {
        if (n_in != 18 || in_sizes[0] != NTOK * DM || out_size != NTOK * DM || ws_size < WS_END) { fprintf(stderr, "kernel_launch: unexpected shapes (n_in %d, in0 %d, out %d, ws %zu)\n", n_in, n_in > 0 ? in_sizes[0] : -1, out_size, ws_size); grid = -1; return; }
        int dev = 0, cus = 0, per_cu = 0;
        if (hipGetDevice(&dev) != hipSuccess || hipDeviceGetAttribute(&cus, hipDeviceAttributeMultiprocessorCount, dev) != hipSuccess) { grid = -1; return; }
        if (hipFuncSetAttribute((const void*)mk_fwd, hipFuncAttributeMaxDynamicSharedMemorySize, LDS_BYTES) != hipSuccess) { fprintf(stderr, "kernel_launch: hipFuncSetAttribute failed\n"); grid = -1; return; }
        if (hipOccupancyMaxActiveBlocksPerMultiprocessor(&per_cu, (const void*)mk_fwd, NWAVES * 64, LDS_BYTES) != hipSuccess || per_cu < 1) { fprintf(stderr, "kernel_launch: occupancy query says %d\n", per_cu); per_cu = 1; }
        (void)hipGetLastError();
        grid = cus;
    }
    if (grid < 0) return;
    (void)hipMemsetAsync((char*)d_ws + WS_CTL, 0, CTL_ZERO_BYTES, stream);
    Args a{};
    for (int i = 0; i < 18; ++i) a.in[i] = (const float*)d_in[i];
    a.out = (float*)d_out; a.ws = (unsigned char*)d_ws;
#if MK_PER_PHASE
    for (int p = 0; p < NPHASE; ++p) { a.ph_lo = p; a.ph_hi = p + 1; const int nrep = 1 + REP_CNT * ((REP_MASK >> p) & 1);
        for (int r = 0; r < nrep; ++r) { a.flag = (p == NPHASE - 1 && r + 1 < nrep) ? 1 : 0; hipLaunchKernelGGL(mk_fwd, dim3(grid), dim3(NWAVES * 64), LDS_BYTES, stream, a); } }
#else
    a.ph_lo = 0; a.ph_hi = NPHASE;
    hipLaunchKernelGGL(mk_fwd, dim3(grid), dim3(NWAVES * 64), LDS_BYTES, stream, a);
#endif
}
```

```cpp
#include <hip/hip_runtime.h>
#include <cstdio>
#include <cstdint>

#ifndef REP_MASK
#define REP_MASK 0
#endif
#ifndef REP_CNT
#define REP_CNT 1
#endif
#ifndef MK_PER_PHASE
#define MK_PER_PHASE 0
#endif

constexpr int NB = 8, SEQ = 4096, DM = 1024, NTOK = NB * SEQ;
constexpr int NH = 4, HD = 128, DDN = 512, DPOOL = 512, DIN = 2568, NPROJ = 2560;
constexpr int NE = 32, TOPK = 4, DE = 1024, NASSIGN = NTOK * TOPK;
constexpr int LISTCAP = NTOK;
constexpr int ACT_ROWS = NASSIGN + NE * 256;

constexpr size_t MiB = 1u << 20;
constexpr size_t WS_CTL = 0, CTL_ZERO_BYTES = 1 * MiB;
constexpr size_t WS_WIN = 1 * MiB;
constexpr size_t WS_WOUT = 6 * MiB;
constexpr size_t WS_WPOOL = 8 * MiB;
constexpr size_t WS_WR = 8 * MiB + 512 * 1024;
constexpr size_t WS_BGU = 8 * MiB + 768 * 1024;
constexpr size_t WS_RS1 = 9 * MiB;
constexpr size_t WS_BETA = 9 * MiB + 128 * 1024;
constexpr size_t WS_G = 9 * MiB + 640 * 1024;
constexpr size_t WS_RS2 = 10 * MiB + 256 * 1024;
constexpr size_t WS_GATEW = 10 * MiB + 512 * 1024;
constexpr size_t WS_LIST = 11 * MiB;
constexpr size_t WS_RSL = 800 * MiB;
constexpr size_t WS_GWL = 804 * MiB;
constexpr size_t WS_WGU = 16 * MiB;
constexpr size_t WS_WD = 144 * MiB;
constexpr size_t WS_XB = 208 * MiB;
constexpr size_t WS_PROJ = 272 * MiB;
constexpr size_t WS_CHUNK = 432 * MiB;
constexpr size_t WS_UC = 544 * MiB;
constexpr size_t WS_GTOT = 576 * MiB;
constexpr size_t WS_ORAW = 577 * MiB;
constexpr int CH_WF = 0, CH_QD = 16384, CH_KT = 32768, CH_QK = 49152, CH_BYTES = 57344, UC_BYTES = 16384;
constexpr size_t WS_MIXED = 688 * MiB;
constexpr size_t WS_CONCAT = 720 * MiB;
constexpr size_t WS_X1B = 208 * MiB;
constexpr size_t WS_ACT = 272 * MiB;
constexpr size_t WS_SLAB = 544 * MiB;
constexpr size_t WS_END = 808 * MiB;
static_assert(WS_ACT + (size_t)ACT_ROWS * 2048 <= WS_SLAB, "act fits");
static_assert(WS_SLAB + (size_t)NASSIGN * 2048 <= WS_END, "slab fits");

constexpr int CW_BAR = 4096;
constexpr int CW_CNT = 16384;

constexpr int LDS_BYTES = 147456;
constexpr int LDSCTL_OFF = LDS_BYTES - 1024, MISC_OFF = LDSCTL_OFF + 320, TAB_OFF = LDSCTL_OFF + 512;
constexpr int NWAVES = 8;

#define GAS __attribute__((address_space(1)))
#define LAS __attribute__((address_space(3)))
typedef unsigned short bf16;
typedef unsigned v4u __attribute__((ext_vector_type(4)));
typedef unsigned v2u __attribute__((ext_vector_type(2)));
typedef float f32x4 __attribute__((ext_vector_type(4)));
typedef float f32x2 __attribute__((ext_vector_type(2)));
typedef short bf16x8 __attribute__((ext_vector_type(8)));
typedef GAS unsigned gu32;
#define RLX_AGENT __ATOMIC_RELAXED, __HIP_MEMORY_SCOPE_AGENT
#define LDS_WAIT() asm volatile("s_waitcnt lgkmcnt(0)" ::: "memory")
#define VM_WAIT() asm volatile("s_waitcnt vmcnt(0)" ::: "memory")

__device__ __forceinline__ unsigned f2bf(float f) { unsigned u = __builtin_bit_cast(unsigned, f); return (u + 0x7fffu + ((u >> 16) & 1u)) >> 16; }
__device__ __forceinline__ unsigned pk2(float lo, float hi) { return f2bf(lo) | (f2bf(hi) << 16); }
__device__ __forceinline__ float bflo(unsigned u) { return __builtin_bit_cast(float, u << 16); }
__device__ __forceinline__ float bfhi(unsigned u) { return __builtin_bit_cast(float, u & 0xffff0000u); }
__device__ __forceinline__ unsigned pk4_fp8(float a, float b, float c, float d) { int p = __builtin_amdgcn_cvt_pk_fp8_f32(a, b, 0, false); p = __builtin_amdgcn_cvt_pk_fp8_f32(c, d, p, true); return (unsigned)p; }
constexpr float SLAB_SCALE = 16.f, SLAB_INV = 1.f / 16.f;
constexpr float W8_SCALE = 32.f, W8_INV = 1.f / 32.f;
__device__ __forceinline__ float wave_sum(float v) {
#pragma unroll
    for (int o = 1; o < 64; o <<= 1) v += __shfl_xor(v, o);
    return v;
}
__device__ __forceinline__ float frcp_(float x) { return __builtin_amdgcn_rcpf(x); }
__device__ __forceinline__ float frsq_(float x) { return __builtin_amdgcn_rsqf(x); }
__device__ __forceinline__ float fexp_(float x) { return __builtin_amdgcn_exp2f(x * 1.4426950408889634f); }
__device__ __forceinline__ float sigmoidf_(float x) { return frcp_(1.f + fexp_(-x)); }
__device__ __forceinline__ float siluf_(float x) { return x * frcp_(1.f + fexp_(-x)); }

namespace pg8 {
constexpr int BM = 256, BK = 64, HALF = 128, HTB = HALF * BK * 2, STAGE_BYTES = 8 * HTB;
__device__ __forceinline__ int lds_byte(int r, int c) { const int st = (r >> 4) * 2 + (c >> 5), rr = r & 15, cc = c & 31, ob = rr * 64 + cc * 2; return st * 1024 + (ob ^ (((ob >> 9) & 1) << 5)); }
__device__ __forceinline__ void stage_rc(int b, int& R, int& C) { const int st = b / 1024, sb = b % 1024, swz = sb ^ (((sb >> 9) & 1) << 5); R = (st >> 1) * 16 + swz / 64; C = (st & 1) * 32 + (swz % 64) / 2; }
__device__ __forceinline__ int perm32(int rho) { const int n = rho >> 4, i = rho & 15; return 8 * (i >> 2) + 4 * n + (i & 3); }
typedef __bf16 bf16x2_t __attribute__((ext_vector_type(2)));
__device__ __forceinline__ unsigned cvt_pk_bf16(float lo, float hi) { const f32x2 v = {lo, hi}; const bf16x2_t b = __builtin_convertvector(v, bf16x2_t); return __builtin_bit_cast(unsigned, b); }

struct Unit { int rt, pn, e, rb, rows; };

struct Sched {
    int nM, nN, nwg, G, c;
    __device__ __forceinline__ void init(int nM_, int nN_, int G_, int c_) { nM = nM_; nN = nN_; nwg = nM * nN; G = G_; c = c_; }
    __device__ __forceinline__ bool next(int i, int& pm, int& pn) const {
        const long L = (long)i * G + c; if (L >= nwg) return false;
        int wgid = (int)L; { const int q = nwg / 8, r = nwg % 8, xcd = wgid % 8, off = wgid / 8; wgid = (xcd < r ? xcd * (q + 1) : r * (q + 1) + (xcd - r) * q) + off; }
        const int nig = 8 * nN, gid = wgid / nig, fm = gid * 8, gsz = (nM - fm) < 8 ? (nM - fm) : 8;
        pm = fm + ((wgid % nig) % gsz); pn = (wgid % nig) / gsz; return true;
    }
};

typedef int v8i_t __attribute__((ext_vector_type(8)));
template <class P, bool F8 = false>
__device__ __forceinline__ void gemm_phase(LAS unsigned char* lds, const P& p) {
    const int tid = threadIdx.x, wid = __builtin_amdgcn_readfirstlane(tid >> 6), lane = tid & 63, wr = wid >> 2, wc = wid & 3, fr = lane & 15, fq = lane >> 4;
    const int K = p.K, RB = F8 ? K : 2 * K, nt = RB / (BK * 2);
    unsigned voffB[2];
#pragma unroll
    for (int i = 0; i < 2; ++i) { int R_, C_; stage_rc(tid * 16 + i * 8192, R_, C_); const int Rb = (R_ & ~31) + perm32(R_ & 31); voffB[i] = (unsigned)(Rb * RB + C_ * 2); }
#define PG8_AOFF(unit, dst) do { int R[2], C[2]; asm volatile("" ::: "memory"); _Pragma("unroll") for (int i_ = 0; i_ < 2; ++i_) stage_rc(tid * 16 + i_ * 8192, R[i_], C[i_]); p.a_off(unit, R, C, dst); } while (0)
    const size_t kstep = (size_t)(BK * 2);
    const size_t hstep = (size_t)HALF * RB;
    const unsigned ldsw = (unsigned)wid * 1024u;
    const int aoff = lds_byte(wr * 64 + fr, fq * 8), boff = lds_byte(wc * 32 + fr, fq * 8);
#define PG8_SA(b, h) (((b) * 2 + (h)) * HTB)
#define PG8_SB(b, h) ((4 + (b) * 2 + (h)) * HTB)
#define PG8_STAGE(bufoff, gbase, voff) do { _Pragma("unroll") for (int _i = 0; _i < 2; ++_i) \
        __builtin_amdgcn_global_load_lds((const unsigned*)((const char*)(gbase) + (voff)[_i]), (LAS unsigned*)(lds + (bufoff) + ldsw + _i * 8192), 16, 0, 0); } while (0)
#define PG8_LDA(dst, b, h) do { _Pragma("unroll") for (int m = 0; m < 4; ++m) { const v4i_t l_ = *(const LAS v4i_t*)(lds + PG8_SA(b, h) + aoff + m * 2048), h_ = *(const LAS v4i_t*)(lds + PG8_SA(b, h) + aoff + m * 2048 + 1024); dst[m] = __builtin_shufflevector(l_, h_, 0, 1, 2, 3, 4, 5, 6, 7); } } while (0)
#define PG8_LDB(dst, b, h) do { _Pragma("unroll") for (int n = 0; n < 2; ++n) { const v4i_t l_ = *(const LAS v4i_t*)(lds + PG8_SB(b, h) + boff + n * 2048), h_ = *(const LAS v4i_t*)(lds + PG8_SB(b, h) + boff + n * 2048 + 1024); dst[n] = __builtin_shufflevector(l_, h_, 0, 1, 2, 3, 4, 5, 6, 7); } } while (0)
#define PG8_HALF(x, k) __builtin_bit_cast(bf16x8, __builtin_shufflevector(x, x, 4 * (k), 4 * (k) + 1, 4 * (k) + 2, 4 * (k) + 3))
#define PG8_MMA(ai, bj, At, Bt) do { __builtin_amdgcn_s_setprio(1); \
        if constexpr (F8) { _Pragma("unroll") for (int m = 0; m < 4; ++m) _Pragma("unroll") for (int n = 0; n < 2; ++n) \
            asm volatile("v_mfma_scale_f32_16x16x128_f8f6f4 %0, %1, %2, %0, %3, %3 op_sel_hi:[0,0,0]" : "+v"(acc[ai][bj][m][n]) : "v"(Bt[n]), "v"(At[m]), "v"(mxs)); } \
        else { _Pragma("unroll") for (int m = 0; m < 4; ++m) _Pragma("unroll") for (int n = 0; n < 2; ++n) { \
            acc[ai][bj][m][n] = __builtin_amdgcn_mfma_f32_16x16x32_bf16(PG8_HALF(Bt[n], 0), PG8_HALF(At[m], 0), acc[ai][bj][m][n], 0, 0, 0); \
            acc[ai][bj][m][n] = __builtin_amdgcn_mfma_f32_16x16x32_bf16(PG8_HALF(Bt[n], 1), PG8_HALF(At[m], 1), acc[ai][bj][m][n], 0, 0, 0); } } \
        __builtin_amdgcn_s_setprio(0); } while (0)
#define PG8_WAIT_V(n) asm volatile("s_waitcnt vmcnt(" #n ")" ::: "memory")
#define PG8_WAIT_L(n) asm volatile("s_waitcnt lgkmcnt(" #n ")" ::: "memory")
#define PG8_BAR __builtin_amdgcn_s_barrier()
#define PG8_SCHED __builtin_amdgcn_sched_barrier(0)
    Unit cur, nxt; int ui = 0;
    if (!p.next(0, cur)) return;
    unsigned mxs = 0x7f7f7f7fu; asm volatile("" : "+v"(mxs));
    f32x4 acc[2][2][4][2];
#pragma unroll
    for (int a = 0; a < 2; ++a)
#pragma unroll
        for (int b = 0; b < 2; ++b)
#pragma unroll
            for (int m = 0; m < 4; ++m)
#pragma unroll
                for (int n = 0; n < 2; ++n) acc[a][b][m][n] = (f32x4){0.f, 0.f, 0.f, 0.f};
    typedef int v4i_t __attribute__((ext_vector_type(4)));
    v8i_t At[4], B0[2], B1[2];
    unsigned oA[2][2];
    PG8_AOFF(cur, oA);
    const char* cA = p.a_base(cur); const char* cB = p.b_base(cur);
    PG8_STAGE(PG8_SB(0, 0), cB, voffB); PG8_STAGE(PG8_SB(0, 1), cB + hstep, voffB); PG8_STAGE(PG8_SA(0, 0), cA, oA[0]); PG8_STAGE(PG8_SA(0, 1), cA, oA[1]);
    if (wr == 1) PG8_BAR;
    PG8_WAIT_V(2); PG8_BAR;
    PG8_STAGE(PG8_SB(1, 0), cB + kstep, voffB); PG8_STAGE(PG8_SA(1, 0), cA + kstep, oA[0]); PG8_STAGE(PG8_SB(1, 1), cB + hstep + kstep, voffB);
    PG8_WAIT_V(6); PG8_BAR;
    LAS v4u* park = (LAS v4u*)(lds + STAGE_BYTES) + tid;
    for (;;) {
        const bool has_next = p.next(ui + 1, nxt);
        const char* nA = cA; const char* nB = cB;
        { unsigned nO[2][2];
#pragma unroll
          for (int h = 0; h < 2; ++h)
#pragma unroll
              for (int i = 0; i < 2; ++i) nO[h][i] = oA[h][i];
          if (has_next) { nA = p.a_base(nxt); nB = p.b_base(nxt); PG8_AOFF(nxt, nO); }
          *park = (v4u){nO[0][0], nO[0][1], nO[1][0], nO[1][1]}; }
        for (int t = 0; t < nt; t += 2) {
            const bool last = (t == nt - 2);
            const char* a1 = cA + (size_t)(t + 1) * kstep;
            const char* a2 = last ? nA : cA + (size_t)(t + 2) * kstep; const char* b2 = last ? nB : cB + (size_t)(t + 2) * kstep;
            const char* a3 = a2 + kstep; const char* b3 = b2 + kstep;
            unsigned o2[2][2];
#pragma unroll
            for (int h = 0; h < 2; ++h)
#pragma unroll
                for (int i = 0; i < 2; ++i) o2[h][i] = oA[h][i];
            if (last) { const v4u q_ = *park; o2[0][0] = q_.x; o2[0][1] = q_.y; o2[1][0] = q_.z; o2[1][1] = q_.w; }
            PG8_LDB(B0, 0, 0); PG8_LDB(B1, 0, 1); PG8_SCHED; PG8_LDA(At, 0, 0); PG8_STAGE(PG8_SA(1, 1), a1, oA[1]);
            PG8_WAIT_V(8); PG8_WAIT_L(0); PG8_BAR; PG8_MMA(0, 0, At, B0); PG8_MMA(0, 1, At, B1); PG8_BAR; PG8_SCHED;
            PG8_LDA(At, 0, 1); PG8_STAGE(PG8_SB(0, 0), b2, voffB); PG8_STAGE(PG8_SB(0, 1), b2 + hstep, voffB); PG8_STAGE(PG8_SA(0, 0), a2, o2[0]);
            PG8_WAIT_V(8); PG8_WAIT_L(0); PG8_BAR; PG8_MMA(1, 0, At, B0); PG8_MMA(1, 1, At, B1); PG8_BAR; PG8_SCHED;
            PG8_LDB(B0, 1, 0); PG8_LDB(B1, 1, 1); PG8_SCHED; PG8_LDA(At, 1, 0); PG8_STAGE(PG8_SA(0, 1), a2, o2[1]);
            PG8_WAIT_V(8); PG8_WAIT_L(0); PG8_BAR; PG8_MMA(0, 0, At, B0); PG8_MMA(0, 1, At, B1); PG8_BAR; PG8_SCHED;
            PG8_LDA(At, 1, 1); PG8_STAGE(PG8_SB(1, 0), b3, voffB); PG8_STAGE(PG8_SB(1, 1), b3 + hstep, voffB); PG8_STAGE(PG8_SA(1, 0), a3, o2[0]);
            PG8_WAIT_V(8); PG8_WAIT_L(0); PG8_BAR; PG8_MMA(1, 0, At, B0); PG8_MMA(1, 1, At, B1); PG8_BAR; PG8_SCHED;
        }
        if (wr == 0) PG8_BAR;
        if constexpr (F8) asm volatile("s_nop 15\n\ts_nop 15" ::: "memory");
        p.epi(acc, cur, wr, wc, fr, fq);
        if (!has_next) break;
#pragma unroll
        for (int a = 0; a < 2; ++a)
#pragma unroll
            for (int b = 0; b < 2; ++b)
#pragma unroll
                for (int m = 0; m < 4; ++m)
#pragma unroll
                    for (int n = 0; n < 2; ++n) acc[a][b][m][n] = (f32x4){0.f, 0.f, 0.f, 0.f};
        cur = nxt; cA = nA; cB = nB; ++ui;
        { const v4u q_ = *park; oA[0][0] = q_.x; oA[0][1] = q_.y; oA[1][0] = q_.z; oA[1][1] = q_.w; }
        if (wr == 1) PG8_BAR;
    }
    PG8_WAIT_V(0);
    PG8_BAR;
#undef PG8_SA
#undef PG8_SB
#undef PG8_STAGE
#undef PG8_LDA
#undef PG8_LDB
#undef PG8_MMA
#undef PG8_HALF
#undef PG8_AOFF
#undef PG8_WAIT_V
#undef PG8_WAIT_L
#undef PG8_BAR
#undef PG8_SCHED
}
}

#define XB_TMO      128
#define XB_XCNT(j)  (256  + 64 * (j))
#define XB_XSUB(j)  (1280 + 64 * (j))
#define XB_XGEN(j)  (2304 + 64 * (j))
#define XB_TOP      3328
#define XB_TOPGEN   3392
#define XCD_BAR_WORDS 3456
#define XB_SPIN_CAP (1u << 18)
__device__ __forceinline__ unsigned xb_ld(unsigned* p)              { return __hip_atomic_load(p, __ATOMIC_RELAXED, __HIP_MEMORY_SCOPE_AGENT); }
__device__ __forceinline__ unsigned xb_add(unsigned* p, unsigned v) { return __hip_atomic_fetch_add(p, v, __ATOMIC_RELAXED, __HIP_MEMORY_SCOPE_AGENT); }
__device__ __forceinline__ unsigned xb_xcc_id() { return (unsigned)__builtin_amdgcn_s_getreg((3 << 11) | 20) & 0xFu; }
#define XB_SPIN(cond, bar) do { unsigned _sp = 0; while (cond) { __builtin_amdgcn_s_sleep(1); \
    if ((++_sp & 255u) == 0u) { if (xb_ld(&(bar)[XB_TMO])) break; if (_sp > XB_SPIN_CAP) { atomicAdd(&(bar)[XB_TMO], 1u); break; } } } } while (0)
struct XcdBarrier { unsigned* bar; unsigned x; volatile LAS unsigned* st; };
__device__ __forceinline__ XcdBarrier xcd_barrier_post(unsigned* bar, volatile LAS unsigned* st) {
    XcdBarrier b; b.bar = bar; b.x = xb_xcc_id(); b.st = st;
    if (threadIdx.x == 0) (void)xb_add(&bar[XB_XCNT(b.x)], 1u);
    return b;
}
__device__ __forceinline__ void xcd_barrier_complete(unsigned* bar, unsigned x, unsigned& nloc, unsigned& nx) {
    const unsigned G = gridDim.x * gridDim.y * gridDim.z;
    unsigned sum, cnt, mine, sp = 0u;
    for (;;) {
        sum = 0u; cnt = 0u; mine = 0u;
#pragma unroll
        for (unsigned j = 0; j < 16; ++j) { const unsigned c = xb_ld(&bar[XB_XCNT(j)]); sum += c; cnt += (c > 0u) ? 1u : 0u; mine = (j == x) ? c : mine; }
        if (sum == G) break;
        __builtin_amdgcn_s_sleep(1);
        if ((++sp & 255u) == 0u) { if (xb_ld(&bar[XB_TMO])) break; if (sp > XB_SPIN_CAP) { atomicAdd(&bar[XB_TMO], 1u); break; } }
    }
    nloc = mine > 0u ? mine : 1u; nx = cnt > 0u ? cnt : 1u;
}
__device__ __forceinline__ void xcd_barrier(const XcdBarrier& b) {
    asm volatile("s_waitcnt vmcnt(0)" ::: "memory");
    __syncthreads();
    if (threadIdx.x == 0) {
        unsigned* bar = b.bar;
        __builtin_amdgcn_s_waitcnt(0);
        unsigned nloc = b.st[0], nx = b.st[1];
        if (nloc == 0u) { xcd_barrier_complete(bar, b.x, nloc, nx); b.st[0] = nloc; b.st[1] = nx; }
        const unsigned old = xb_add(&bar[XB_XSUB(b.x)], 1u);
        const unsigned gen = old / nloc;
        if (old + 1u == (gen + 1u) * nloc) {
            __builtin_amdgcn_fence(__ATOMIC_RELEASE, "agent");
            asm volatile("s_waitcnt vmcnt(0)" ::: "memory");
            const unsigned og = xb_add(&bar[XB_TOP], 1u);
            const unsigned tg = og / nx;
            if (og + 1u == (tg + 1u) * nx) xb_add(&bar[XB_TOPGEN], 1u);
            else XB_SPIN(xb_ld(&bar[XB_TOPGEN]) == tg, bar);
            __builtin_amdgcn_fence(__ATOMIC_ACQUIRE, "agent");
            xb_add(&bar[XB_XGEN(b.x)], 1u);
            asm volatile("s_waitcnt vmcnt(0)" ::: "memory");
        } else {
            XB_SPIN(xb_ld(&bar[XB_XGEN(b.x)]) == gen, bar);
            __builtin_amdgcn_fence(__ATOMIC_ACQUIRE, "agent");
            asm volatile("s_waitcnt vmcnt(0)" ::: "memory");
        }
    }
    __syncthreads();
}

struct Frame {
    LAS unsigned char* lds;
    int tid, lane, wave, vcu, G;
    const float* in[18];
    float* out;
    unsigned char* ws;
};
using pg8::Unit;
using pg8::cvt_pk_bf16;

struct ProbBase {
    int K; int RB; pg8::Sched S;
    __device__ __forceinline__ void lin_off(const int (&R)[2], const int (&C)[2], unsigned (&off)[2][2]) const {
#pragma unroll
        for (int h = 0; h < 2; ++h)
#pragma unroll
            for (int i = 0; i < 2; ++i) off[h][i] = (unsigned)((h * 128 + R[i]) * RB + C[i] * 2);
    }
};
struct ProbIn : ProbBase {
    const bf16* A; const bf16* Bt; bf16* O; const float* rs;
    __device__ __forceinline__ bool next(int i, Unit& u) const { int pm, pn; if (!S.next(i, pm, pn)) return false; u.rt = pm; u.pn = pn; u.e = 0; u.rb = pm; u.rows = 256; return true; }
    __device__ __forceinline__ const char* a_base(const Unit& u) const { return (const char*)A + (size_t)u.rt * 256 * RB; }
    __device__ __forceinline__ const char* b_base(const Unit& u) const { return (const char*)Bt + (size_t)u.pn * 256 * RB; }
    __device__ __forceinline__ void a_off(const Unit&, const int (&R)[2], const int (&C)[2], unsigned (&off)[2][2]) const { lin_off(R, C, off); }
    __device__ __forceinline__ void epi(const f32x4 (&acc)[2][2][4][2], const Unit& u, int wr, int wc, int fr, int fq) const {
        const int row0 = u.rt * 256 + wr * 64 + fr, col0 = u.pn * 256 + wc * 32 + 8 * fq;
#pragma unroll
        for (int ai = 0; ai < 2; ++ai)
#pragma unroll
            for (int m = 0; m < 4; ++m) { const int row = row0 + ai * 128 + m * 16; const float sc = rs[row]; bf16* rowp = O + (size_t)row * NPROJ + col0;
#pragma unroll
                for (int bj = 0; bj < 2; ++bj) { const f32x4 v0 = acc[ai][bj][m][0] * sc, v1 = acc[ai][bj][m][1] * sc; v4u w;
                    w.x = cvt_pk_bf16(v0[0], v0[1]); w.y = cvt_pk_bf16(v0[2], v0[3]); w.z = cvt_pk_bf16(v1[0], v1[1]); w.w = cvt_pk_bf16(v1[2], v1[3]);
                    *(v4u*)(rowp + bj * 128) = w; } }
    }
};
struct ProbPool : ProbBase {
    const bf16* A; const bf16* Bt; bf16* O;
    __device__ __forceinline__ bool next(int i, Unit& u) const { int pm, pn; if (!S.next(i, pm, pn)) return false; u.rt = pm; u.pn = pn; u.e = 0; u.rb = pm; u.rows = 256; return true; }
    __device__ __forceinline__ const char* a_base(const Unit& u) const { return (const char*)A + (size_t)u.rt * 256 * RB; }
    __device__ __forceinline__ const char* b_base(const Unit& u) const { return (const char*)Bt + (size_t)u.pn * 256 * RB; }
    __device__ __forceinline__ void a_off(const Unit&, const int (&R)[2], const int (&C)[2], unsigned (&off)[2][2]) const { lin_off(R, C, off); }
    __device__ __forceinline__ void epi(const f32x4 (&acc)[2][2][4][2], const Unit& u, int wr, int wc, int fr, int fq) const {
        const int row0 = u.rt * 256 + wr * 64 + fr, col0 = 512 + u.pn * 256 + wc * 32 + 8 * fq;
#pragma unroll
        for (int ai = 0; ai < 2; ++ai)
#pragma unroll
            for (int m = 0; m < 4; ++m) { const int row = row0 + ai * 128 + m * 16; bf16* rowp = O + (size_t)row * DM + col0;
#pragma unroll
                for (int bj = 0; bj < 2; ++bj) { const f32x4 v0 = acc[ai][bj][m][0], v1 = acc[ai][bj][m][1]; v4u w;
                    w.x = cvt_pk_bf16(v0[0], v0[1]); w.y = cvt_pk_bf16(v0[2], v0[3]); w.z = cvt_pk_bf16(v1[0], v1[1]); w.w = cvt_pk_bf16(v1[2], v1[3]);
                    *(v4u*)(rowp + bj * 128) = w; } }
    }
};
struct ProbOut : ProbBase {
    const bf16* A; const bf16* Bt; const float* X; float* O;
    __device__ __forceinline__ bool next(int i, Unit& u) const { int pm, pn; if (!S.next(i, pm, pn)) return false; u.rt = pm; u.pn = pn; u.e = 0; u.rb = pm; u.rows = 256; return true; }
    __device__ __forceinline__ const char* a_base(const Unit& u) const { return (const char*)A + (size_t)u.rt * 256 * RB; }
    __device__ __forceinline__ const char* b_base(const Unit& u) const { return (const char*)Bt + (size_t)u.pn * 256 * RB; }
    __device__ __forceinline__ void a_off(const Unit&, const int (&R)[2], const int (&C)[2], unsigned (&off)[2][2]) const { lin_off(R, C, off); }
    __device__ __forceinline__ void epi(const f32x4 (&acc)[2][2][4][2], const Unit& u, int wr, int wc, int fr, int fq) const {
        const int row0 = u.rt * 256 + wr * 64 + fr, col0 = u.pn * 256 + wc * 32 + 8 * fq;
#pragma unroll
        for (int ai = 0; ai < 2; ++ai)
#pragma unroll
            for (int m = 0; m < 4; ++m) { const size_t off = (size_t)(row0 + ai * 128 + m * 16) * DM + col0;
#pragma unroll
                for (int bj = 0; bj < 2; ++bj)
#pragma unroll
                    for (int n = 0; n < 2; ++n) { const f32x4 xv = *(const f32x4*)(X + off + bj * 128 + 4 * n); *(f32x4*)(O + off + bj * 128 + 4 * n) = xv + acc[ai][bj][m][n]; } }
    }
};
struct MoeTab { const LAS int* pref; const LAS int* cnt; };
__device__ __forceinline__ void moe_decode(const MoeTab& T, int rt, Unit& u) {
    int e = 0;
#pragma unroll 1
    for (int j = 1; j < NE; ++j) if (T.pref[j] <= rt) e = j;
    u.e = e; u.rb = rt - T.pref[e]; const int left = T.cnt[e] - u.rb * 256; u.rows = left < 256 ? left : 256;
}
struct ProbGU : ProbBase {
    MoeTab T; const unsigned char* A; const unsigned char* Bt; unsigned char* O; const int* list; const float* rs2; const float* bgu;
    __device__ __forceinline__ bool next(int i, Unit& u) const { int pm, pn; if (!S.next(i, pm, pn)) return false; u.rt = pm; u.pn = pn; moe_decode(T, pm, u); return true; }
    __device__ __forceinline__ const char* a_base(const Unit&) const { return (const char*)A; }
    __device__ __forceinline__ const char* b_base(const Unit& u) const { return (const char*)Bt + ((size_t)u.e * 2048 + (size_t)u.pn * 256) * RB; }
    __device__ __forceinline__ void a_off(const Unit& u, const int (&R)[2], const int (&C)[2], unsigned (&off)[2][2]) const {
        const int* lp = list + (size_t)u.e * LISTCAP + u.rb * 256;
#pragma unroll
        for (int h = 0; h < 2; ++h)
#pragma unroll
            for (int i = 0; i < 2; ++i) { const int r = h * 128 + R[i]; const int ent = (r < u.rows) ? lp[r] : 0; off[h][i] = (unsigned)(ent >> 2) * (unsigned)RB + (unsigned)C[i] * 2u; }
    }
    __device__ __forceinline__ void epi(const f32x4 (&acc)[2][2][4][2], const Unit& u, int wr, int wc, int fr, int fq) const {
        const float* rsp = rs2 + (size_t)u.e * LISTCAP + u.rb * 256;
        const int j0 = wc * 32 + 8 * fq;
        const float* bg = bgu + (size_t)u.e * 2048 + u.pn * 256 + j0;
        f32x4 bgv[2], buv[2];
#pragma unroll
        for (int n = 0; n < 2; ++n) { bgv[n] = *(const f32x4*)(bg + 4 * n); buv[n] = *(const f32x4*)(bg + 128 + 4 * n); }
#pragma unroll
        for (int ai = 0; ai < 2; ++ai)
#pragma unroll
            for (int m = 0; m < 4; ++m) { const int r = ai * 128 + wr * 64 + m * 16 + fr;
                if (r < u.rows) { const float sc = rsp[r] * W8_INV; unsigned w[2];
#pragma unroll
                    for (int n = 0; n < 2; ++n) { float a[4];
#pragma unroll
                        for (int q = 0; q < 4; ++q) { float gt = acc[ai][0][m][n][q] * sc + bgv[n][q], up = acc[ai][1][m][n][q] * sc + buv[n][q];
                            gt = fminf(gt, 7.f); up = fminf(fmaxf(up, -7.f), 7.f); a[q] = (up + 1.f) * gt * frcp_(1.f + fexp_(-1.702f * gt)); }
                        w[n] = pk4_fp8(a[0], a[1], a[2], a[3]); }
                    *(v2u*)(O + (size_t)(u.rt * 256 + r) * DE + u.pn * 128 + j0) = (v2u){w[0], w[1]}; } }
    }
};
struct ProbDown : ProbBase {
    MoeTab T; const unsigned char* A; const unsigned char* Bt; unsigned char* O; const int* list; const float* gw; const float* bd;
    __device__ __forceinline__ bool next(int i, Unit& u) const { int pm, pn; if (!S.next(i, pm, pn)) return false; u.rt = pm; u.pn = pn; moe_decode(T, pm, u); return true; }
    __device__ __forceinline__ const char* a_base(const Unit& u) const { return (const char*)A + (size_t)u.rt * 256 * RB; }
    __device__ __forceinline__ const char* b_base(const Unit& u) const { return (const char*)Bt + ((size_t)u.e * 1024 + (size_t)u.pn * 256) * RB; }
    __device__ __forceinline__ void a_off(const Unit&, const int (&R)[2], const int (&C)[2], unsigned (&off)[2][2]) const { lin_off(R, C, off); }
    __device__ __forceinline__ void epi(const f32x4 (&acc)[2][2][4][2], const Unit& u, int wr, int wc, int fr, int fq) const {
        const int* lp = list + (size_t)u.e * LISTCAP + u.rb * 256;
        const int c0 = u.pn * 256 + wc * 32 + 8 * fq;
        const float* gwp = gw + (size_t)u.e * LISTCAP + u.rb * 256;
        const float* bp = bd + (size_t)u.e * DM + c0;
        f32x4 bv[2][2];
#pragma unroll
        for (int bj = 0; bj < 2; ++bj)
#pragma unroll
            for (int n = 0; n < 2; ++n) bv[bj][n] = *(const f32x4*)(bp + bj * 128 + 4 * n);
#pragma unroll
        for (int ai = 0; ai < 2; ++ai)
#pragma unroll
            for (int m = 0; m < 4; ++m) { const int r = ai * 128 + wr * 64 + m * 16 + fr;
                if (r < u.rows) { const int ent = lp[r]; const float g = gwp[r]; unsigned char* rowp = O + (size_t)ent * DM + c0;
#pragma unroll
                    for (int bj = 0; bj < 2; ++bj) { const f32x4 v0 = (acc[ai][bj][m][0] * W8_INV + bv[bj][0]) * g, v1 = (acc[ai][bj][m][1] * W8_INV + bv[bj][1]) * g;
                        *(v2u*)(rowp + bj * 128) = (v2u){pk4_fp8(v0[0] * SLAB_SCALE, v0[1] * SLAB_SCALE, v0[2] * SLAB_SCALE, v0[3] * SLAB_SCALE), pk4_fp8(v1[0] * SLAB_SCALE, v1[1] * SLAB_SCALE, v1[2] * SLAB_SCALE, v1[3] * SLAB_SCALE)}; } } }
    }
};

typedef short v4i16_t __attribute__((ext_vector_type(4)));
__device__ __forceinline__ void tr_item(const float* W, int ldw, int k0, int nsrc0, bf16* WT, size_t drow0, int ldk, int dk0, const float* ks, const float* ns, LAS unsigned char* scr, int lane) {
    const int kr = lane >> 4, n4 = (lane & 15) * 4;
    f32x4 nsc = (f32x4){1.f, 1.f, 1.f, 1.f}; if (ns) nsc = *(const f32x4*)(ns + nsrc0 + n4);
    f32x4 v[16];
#pragma unroll
    for (int i = 0; i < 16; ++i) v[i] = *(const f32x4*)(W + (size_t)(k0 + 4 * i + kr) * ldw + nsrc0 + n4);
#pragma unroll
    for (int i = 0; i < 16; ++i) { f32x4 x = v[i] * nsc; if (ks) x = x * ks[k0 + 4 * i + kr];
        *(LAS v2u*)(scr + (4 * i + kr) * 192 + n4 * 2) = (v2u){pg8::cvt_pk_bf16(x.x, x.y), pg8::cvt_pk_bf16(x.z, x.w)}; }
    LDS_WAIT(); asm volatile("" ::: "memory");
    const int G = lane >> 4, li = lane & 15, q = li >> 2, p = li & 3;
    const LAS unsigned char* rb = scr + q * 192 + (16 * G + 4 * p) * 2;
    bf16* dst = WT + (drow0 + 16 * G + li) * (size_t)ldk + dk0 + k0;
#pragma unroll
    for (int kc = 0; kc < 8; ++kc) {
        const v4i16_t lo = __builtin_amdgcn_ds_read_tr16_b64_v4i16((LAS v4i16_t*)(rb + (8 * kc) * 192));
        const v4i16_t hi = __builtin_amdgcn_ds_read_tr16_b64_v4i16((LAS v4i16_t*)(rb + (8 * kc + 4) * 192));
        const v2u l2 = __builtin_bit_cast(v2u, lo), h2 = __builtin_bit_cast(v2u, hi);
        *(v4u*)(dst + 8 * kc) = (v4u){l2.x, l2.y, h2.x, h2.y};
    }
    LDS_WAIT(); asm volatile("" ::: "memory");
}

template <int KT, int NT>
__device__ __forceinline__ void tr_item8(const float* W, int ldw, int k0, int nsrc0, unsigned char* WT, size_t drow0, int ldk, const float* ks, float mul, LAS unsigned char* scr, int lane) {
    constexpr int LPR = NT / 4, RPL = 64 / LPR, PA = NT * 2 + 64;
    static_assert(KT * NT == 4096 && (PA / 4) % 32 == 16, "tile geometry");
    const int kr = lane / LPR, n4 = (lane % LPR) * 4;
    f32x4 v[16];
#pragma unroll
    for (int i = 0; i < 16; ++i) v[i] = *(const f32x4*)(W + (size_t)(k0 + RPL * i + kr) * ldw + nsrc0 + n4);
#pragma unroll
    for (int i = 0; i < 16; ++i) { const float sc = ks ? ks[k0 + RPL * i + kr] * mul : mul; const f32x4 x = v[i] * sc;
        *(LAS v2u*)(scr + (RPL * i + kr) * PA + n4 * 2) = (v2u){pg8::cvt_pk_bf16(x.x, x.y), pg8::cvt_pk_bf16(x.z, x.w)}; }
    LDS_WAIT(); asm volatile("" ::: "memory");
    const int G = lane >> 4, li = lane & 15, q = li >> 2, p = li & 3;
#pragma unroll
    for (int ps = 0; ps < NT / 64; ++ps) {
        const LAS unsigned char* rb = scr + q * PA + (16 * (G + 4 * ps) + 4 * p) * 2;
        unsigned char* dst = WT + (drow0 + 16 * (G + 4 * ps) + li) * (size_t)ldk + k0;
#pragma unroll
        for (int kq = 0; kq < KT / 16; ++kq) {
            v2u t[4];
#pragma unroll
            for (int u = 0; u < 4; ++u) t[u] = __builtin_bit_cast(v2u, __builtin_amdgcn_ds_read_tr16_b64_v4i16((LAS v4i16_t*)(rb + (16 * kq + 4 * u) * PA)));
            v4u o;
            o.x = pk4_fp8(bflo(t[0].x), bfhi(t[0].x), bflo(t[0].y), bfhi(t[0].y)); o.y = pk4_fp8(bflo(t[1].x), bfhi(t[1].x), bflo(t[1].y), bfhi(t[1].y));
            o.z = pk4_fp8(bflo(t[2].x), bfhi(t[2].x), bflo(t[2].y), bfhi(t[2].y)); o.w = pk4_fp8(bflo(t[3].x), bfhi(t[3].x), bflo(t[3].y), bfhi(t[3].y));
            *(v4u*)(dst + 16 * kq) = o;
        }
    }
    LDS_WAIT(); asm volatile("" ::: "memory");
}

constexpr int TRF_T1 = 128 * 192, TRF_T2 = 64 * 144, TRF_BYTES = TRF_T1 + TRF_T2;
__device__ __forceinline__ void tr_item8f(const float* W, int ldw, int k0, int nsrc0, unsigned char* WT, size_t drow0, int ldk, const float* ks, float mul, LAS unsigned char* scr, int lane) {
    const int kr = lane >> 4, n4 = (lane & 15) * 4;
#pragma unroll
    for (int hb = 0; hb < 2; ++hb) {
        f32x4 v[16];
#pragma unroll
        for (int i = 0; i < 16; ++i) v[i] = *(const f32x4*)(W + (size_t)(k0 + 64 * hb + 4 * i + kr) * ldw + nsrc0 + n4);
#pragma unroll
        for (int i = 0; i < 16; ++i) { const float sc = ks ? ks[k0 + 64 * hb + 4 * i + kr] * mul : mul; const f32x4 x = v[i] * sc;
            *(LAS v2u*)(scr + (64 * hb + 4 * i + kr) * 192 + n4 * 2) = (v2u){pg8::cvt_pk_bf16(x.x, x.y), pg8::cvt_pk_bf16(x.z, x.w)}; }
    }
    LDS_WAIT(); asm volatile("" ::: "memory");
    const int G = lane >> 4, li = lane & 15, q = li >> 2, p = li & 3;
    const LAS unsigned char* rb = scr + q * 192 + (16 * G + 4 * p) * 2;
    LAS unsigned char* t2 = scr + TRF_T1;
#pragma unroll
    for (int kq = 0; kq < 8; ++kq) {
        v2u t[4];
#pragma unroll
        for (int u = 0; u < 4; ++u) t[u] = __builtin_bit_cast(v2u, __builtin_amdgcn_ds_read_tr16_b64_v4i16((LAS v4i16_t*)(rb + (16 * kq + 4 * u) * 192)));
        v4u o;
        o.x = pk4_fp8(bflo(t[0].x), bfhi(t[0].x), bflo(t[0].y), bfhi(t[0].y)); o.y = pk4_fp8(bflo(t[1].x), bfhi(t[1].x), bflo(t[1].y), bfhi(t[1].y));
        o.z = pk4_fp8(bflo(t[2].x), bfhi(t[2].x), bflo(t[2].y), bfhi(t[2].y)); o.w = pk4_fp8(bflo(t[3].x), bfhi(t[3].x), bflo(t[3].y), bfhi(t[3].y));
        *(LAS v4u*)(t2 + (16 * G + li) * 144 + 16 * kq) = o;
    }
    LDS_WAIT(); asm volatile("" ::: "memory");
    const int r8 = lane >> 3, c8 = lane & 7;
#pragma unroll
    for (int j = 0; j < 8; ++j) { const v4u o = *(const LAS v4u*)(t2 + (8 * j + r8) * 144 + 16 * c8);
        *(v4u*)(WT + (drow0 + 8 * j + r8) * (size_t)ldk + k0 + 16 * c8) = o; }
    LDS_WAIT(); asm volatile("" ::: "memory");
}

constexpr int TRK = 128, TRN = 64;
constexpr int MOE_PREP_ITEMS = 32 * (1024 / TRK) * (2048 / TRN) + 32 * (1024 / TRK) * (1024 / TRN);
__device__ __forceinline__ void moe_weight_prep(Frame& F, int b0, int lo, int hi) {
    const float* fnw = F.in[10]; const float* w_gu = F.in[13]; const float* w_d = F.in[15];
    unsigned char* WguT = F.ws + WS_WGU; unsigned char* WdT = F.ws + WS_WD;
    constexpr int TW = 2;
    if (F.wave >= TW) return;
    LAS unsigned char* scr = F.lds + F.wave * TRF_BYTES;
    const int gw = ((int)blockIdx.x - b0) * TW + F.wave, NGW = (F.G - b0) * TW;
    constexpr int NKB = 1024 / TRK, NNB_GU = 2048 / TRN, NNB_D = 1024 / TRN, SEGN = 128 / TRN;
    constexpr int I_GU = 32 * NKB * NNB_GU;
    for (int it = lo + gw; it < hi; it += NGW) {
        int r = it;
        if (r < I_GU) { const int e = r / (NKB * NNB_GU), r2 = r % (NKB * NNB_GU), kb = r2 / NNB_GU, cb = r2 % NNB_GU;
            const int half = cb / (NNB_GU / 2), t = (cb % (NNB_GU / 2)) / SEGN, nb = cb % SEGN;
            tr_item8f(w_gu + (size_t)e * DM * 2048, 2048, kb * TRK, half * 1024 + t * 128 + nb * TRN, WguT, (size_t)e * 2048 + t * 256 + half * 128 + nb * TRN, DM, fnw, W8_SCALE, scr, F.lane); continue; } r -= I_GU;
        { const int e = r / (NKB * NNB_D), r2 = r % (NKB * NNB_D), kb = r2 / NNB_D, nb = r2 % NNB_D;
          tr_item8f(w_d + (size_t)e * DE * DM, DM, kb * TRK, nb * TRN, WdT, (size_t)e * 1024 + nb * TRN, DE, nullptr, W8_SCALE, scr, F.lane); }
    }
}
static_assert(4 * TRF_BYTES <= LDSCTL_OFF, "transposer LDS");
constexpr int MOE_PREP_SPLIT = 0;

__device__ __forceinline__ void phase_prep(Frame& F) {
    const float* x = F.in[0]; const float* anw = F.in[1]; const float* w_in = F.in[2]; const float* a_log = F.in[4]; const float* dt_bias = F.in[5];
    const float* pool_w = F.in[7]; const float* pool_scale = F.in[8]; const float* w_out = F.in[9]; const float* fnw = F.in[10];
    const float* w_router = F.in[11]; const float* w_gu = F.in[13]; const float* b_gu = F.in[14]; const float* w_d = F.in[15];
    bf16* WinT = (bf16*)(F.ws + WS_WIN); bf16* WoutT = (bf16*)(F.ws + WS_WOUT); bf16* WpoolT = (bf16*)(F.ws + WS_WPOOL);
    bf16* WguT = (bf16*)(F.ws + WS_WGU); bf16* WdT = (bf16*)(F.ws + WS_WD);
    bf16* WrI = (bf16*)(F.ws + WS_WR); float* bguP = (float*)(F.ws + WS_BGU);
    bf16* xb = (bf16*)(F.ws + WS_XB); float* rs1 = (float*)(F.ws + WS_RS1); float* betaA = (float*)(F.ws + WS_BETA); float* gA = (float*)(F.ws + WS_G);
    LAS unsigned char* scr = F.lds + F.wave * 12288;
    LAS float* W8T = (LAS float*)(F.lds + 98304);
    const int gw = F.vcu * NWAVES + F.wave, NGW = F.G * NWAVES;
    const int gt = F.vcu * 512 + F.tid, NGT = F.G * 512;
    for (int idx = F.tid; idx < 8192; idx += 512) { const int k = idx >> 3, c = idx & 7; W8T[c * 1024 + k] = anw[k] * w_in[(size_t)k * DIN + 2048 + c]; }
    __syncthreads();
    constexpr int I_IN1 = 16 * 32, I_OUT = 16 * 16;
    constexpr int NITEMS = I_IN1 + I_OUT;
    for (int it = gw; it < NITEMS; it += NGW) {
        int r = it;
        if (r < I_IN1) { const int kb = r / 32, nb = r % 32; tr_item(w_in, DIN, kb * 64, nb * 64, WinT, (size_t)nb * 64, DM, 0, anw, nullptr, scr, F.lane); continue; } r -= I_IN1;
        { const int kb = r / 16, nb = r % 16; tr_item(w_out, DM, kb * 64, nb * 64, WoutT, (size_t)nb * 64, DM, 0, nullptr, nullptr, scr, F.lane); }
    }
    __syncthreads();
    for (int task = blockIdx.x; task < 256; task += F.G) {
        const int g = task >> 6, kb = (task >> 2) & 15, dq = task & 3;
        LAS float* Wt = (LAS float*)F.lds;
        LAS float* Pw = (LAS float*)(F.lds + 33024);
        for (int idx = F.tid; idx < 64 * 32; idx += 512) { const int k = idx >> 5, c4 = (idx & 31) * 4; const f32x4 v = *(const f32x4*)(w_in + (size_t)(kb * 64 + k) * DIN + 2056 + g * 128 + c4);
            Wt[k * 129 + c4] = v.x; Wt[k * 129 + c4 + 1] = v.y; Wt[k * 129 + c4 + 2] = v.z; Wt[k * 129 + c4 + 3] = v.w; }
        for (int idx = F.tid; idx < 128 * 8; idx += 512) { const int c = idx >> 3, d4 = (idx & 7) * 4; *(LAS f32x4*)(Pw + c * 32 + d4) = *(const f32x4*)(pool_w + (size_t)g * 16384 + c * 128 + dq * 32 + d4); }
        __syncthreads();
        const int k = F.tid & 63, d4 = (F.tid >> 6) * 4;
        f32x4 acc = (f32x4){0.f, 0.f, 0.f, 0.f};
#pragma unroll 8
        for (int c = 0; c < 128; ++c) acc += *(const LAS f32x4*)(Pw + c * 32 + d4) * Wt[k * 129 + c];
        const int n0 = g * 128 + dq * 32 + d4; const f32x4 ps = *(const f32x4*)(pool_scale + n0); const float an = anw[kb * 64 + k];
        bf16* dst = WinT + (size_t)(2048 + n0) * DM + kb * 64 + k;
        dst[0] = (bf16)f2bf(acc.x * ps.x * an); dst[DM] = (bf16)f2bf(acc.y * ps.y * an); dst[2 * DM] = (bf16)f2bf(acc.z * ps.z * an); dst[3 * DM] = (bf16)f2bf(acc.w * ps.w * an);
        __syncthreads();
    }
    moe_weight_prep(F, 0, 0, MOE_PREP_SPLIT);
    for (int idx = gt; idx < NE * 2048; idx += NGT) { const int e = idx >> 11, r = idx & 2047, t = r >> 8, j = r & 255, half = j >> 7, jj = j & 127; bguP[idx] = b_gu[(size_t)e * 2048 + half * 1024 + t * 128 + jj]; }
    for (int idx = gt; idx < 64 * 64 * 8; idx += NGT) { const int j = idx & 7, ln = (idx >> 3) & 63, fr2 = idx >> 9, nb = fr2 & 1, ks = fr2 >> 1;
        const int k = 32 * ks + 8 * (ln >> 4) + j, e = 16 * nb + (ln & 15); const float v = fnw[k] * w_router[(size_t)k * NE + e];
        const unsigned hb = f2bf(v); const float hf = __builtin_bit_cast(float, hb << 16); const unsigned lb = f2bf(v - hf);
        WrI[((size_t)(fr2 * 2 + 0) * 64 + ln) * 8 + j] = (bf16)hb; WrI[((size_t)(fr2 * 2 + 1) * 64 + ln) * 8 + j] = (bf16)lb; }
    for (int m = gw; m < NTOK; m += NGW) {
        const f32x4* xr = (const f32x4*)(x + (size_t)m * DM) + F.lane;
        f32x4 v[4]; float ss = 0.f; float d8[8];
#pragma unroll
        for (int c = 0; c < 8; ++c) d8[c] = 0.f;
#pragma unroll
        for (int j = 0; j < 4; ++j) { v[j] = xr[64 * j]; ss += (v[j].x * v[j].x + v[j].y * v[j].y) + (v[j].z * v[j].z + v[j].w * v[j].w); }
#pragma unroll
        for (int c = 0; c < 8; ++c)
#pragma unroll
            for (int j = 0; j < 4; ++j) { const f32x4 w = *(const LAS f32x4*)(W8T + c * 1024 + 256 * j + 4 * F.lane); d8[c] += (v[j].x * w.x + v[j].y * w.y) + (v[j].z * w.z + v[j].w * w.w); }
        ss = wave_sum(ss);
#pragma unroll
        for (int c = 0; c < 8; ++c) d8[c] = wave_sum(d8[c]);
        const float rs = 1.f / sqrtf(ss * (1.f / DM) + 1e-6f);
        unsigned long long* o8 = (unsigned long long*)(xb + (size_t)m * DM) + F.lane;
#pragma unroll
        for (int j = 0; j < 4; ++j) o8[64 * j] = (unsigned long long)pk2(v[j].x, v[j].y) | ((unsigned long long)pk2(v[j].z, v[j].w) << 32);
        if (F.lane == 0) rs1[m] = rs;
        if (F.lane < 4) {
            float bl = 0.f, al = 0.f;
#pragma unroll
            for (int c = 0; c < 4; ++c) { bl = (F.lane == c) ? d8[c] : bl; al = (F.lane == c) ? d8[4 + c] : al; }
            bl *= rs; al *= rs;
            betaA[(size_t)m * 4 + F.lane] = 1.f / (1.f + expf(-bl));
            const float z = al + dt_bias[F.lane]; const float sp = z > 20.f ? z : log1pf(expf(z));
            gA[(size_t)m * 4 + F.lane] = -expf(a_log[F.lane]) * sp;
        }
    }
}

__device__ __forceinline__ void phase_mix(Frame& F) {
    const bf16* proj = (const bf16*)(F.ws + WS_PROJ); bf16* mixed = (bf16*)(F.ws + WS_CONCAT) + 512;
    const int gw = F.vcu * NWAVES + F.wave, NGW = F.G * NWAVES;
    const int ch = 8 * F.lane, gi = F.lane >> 4, win = 2 << gi, hal = win - 1;
    for (int rbk = gw; rbk < NTOK / 16; rbk += NGW) {
        const int m0 = rbk * 16, t0 = m0 % SEQ;
        v4u X[31];
#pragma unroll
        for (int k = 0; k < 31; ++k) { X[k] = (v4u){0u, 0u, 0u, 0u}; if (k >= 15 - hal && t0 - 15 + k >= 0) X[k] = *(const v4u*)(proj + (size_t)(m0 - 15 + k) * NPROJ + 2048 + ch); }
        float s[8];
#pragma unroll
        for (int q = 0; q < 8; ++q) s[q] = 0.f;
#pragma unroll
        for (int k = 0; k < 15; ++k) { s[0] += bflo(X[k].x); s[1] += bfhi(X[k].x); s[2] += bflo(X[k].y); s[3] += bfhi(X[k].y); s[4] += bflo(X[k].z); s[5] += bfhi(X[k].z); s[6] += bflo(X[k].w); s[7] += bfhi(X[k].w); }
#pragma unroll
        for (int r = 0; r < 16; ++r) {
            const v4u u = X[15 + r];
            const float p[8] = {bflo(u.x), bfhi(u.x), bflo(u.y), bfhi(u.y), bflo(u.z), bfhi(u.z), bflo(u.w), bfhi(u.w)};
#pragma unroll
            for (int q = 0; q < 8; ++q) s[q] += p[q];
            const int tt = t0 + r + 1; const float ic = 1.f / (float)(tt < win ? tt : win);
            v4u o; o.x = pk2(s[0] * ic - p[0], s[1] * ic - p[1]); o.y = pk2(s[2] * ic - p[2], s[3] * ic - p[3]); o.z = pk2(s[4] * ic - p[4], s[5] * ic - p[5]); o.w = pk2(s[6] * ic - p[6], s[7] * ic - p[7]);
            *(v4u*)(mixed + (size_t)(m0 + r) * DM + ch) = o;
            const v4u od = gi == 0 ? X[14 + r] : gi == 1 ? X[12 + r] : gi == 2 ? X[8 + r] : X[r];
            s[0] -= bflo(od.x); s[1] -= bfhi(od.x); s[2] -= bflo(od.y); s[3] -= bfhi(od.y); s[4] -= bflo(od.z); s[5] -= bfhi(od.z); s[6] -= bflo(od.w); s[7] -= bfhi(od.w);
        }
    }
}

typedef float f32x16 __attribute__((ext_vector_type(16)));
__device__ __forceinline__ bf16x8 pack8(const f32x4 a, const f32x4 b) {
    v4u w; w.x = cvt_pk_bf16(a[0], a[1]); w.y = cvt_pk_bf16(a[2], a[3]); w.z = cvt_pk_bf16(b[0], b[1]); w.w = cvt_pk_bf16(b[2], b[3]);
    return __builtin_bit_cast(bf16x8, w);
}
__device__ __forceinline__ void fmac_(float& acc, float a, float b) { asm("v_fmac_f32 %0, %1, %2" : "+v"(acc) : "v"(a), "v"(b)); }
__device__ __forceinline__ float bf2f(unsigned short u) { return __builtin_bit_cast(float, (unsigned)u << 16); }

constexpr int SOLVE_D = 5;
struct RQ { int i, j; };
__host__ __device__ constexpr int solve_nq(int i) { return (i + 3) / 4; }
__host__ __device__ constexpr RQ solve_adv(int i, int j, int d) { while (d-- > 0 && i < 64) { if (j + 1 < solve_nq(i)) ++j; else { ++i; j = 0; } } return RQ{i, j}; }
template <int I, int J> __device__ __forceinline__ void solve_step(float (&U)[64], const LAS float* Am, const f32x4 (&win)[SOLVE_D], float s0, float s1, float s2, float s3) {
    if constexpr (I < 64) {
        constexpr RQ P = solve_adv(I, J, SOLVE_D);
        f32x4 nw = (f32x4){0.f, 0.f, 0.f, 0.f};
        if constexpr (P.i < 64) nw = *(const LAS f32x4*)(Am + P.i * 64 + 4 * P.j);
        const f32x4 a = win[0];
        fmac_(s0, a.x, U[4 * J]); if constexpr (4 * J + 1 < I) fmac_(s1, a.y, U[4 * J + 1]); if constexpr (4 * J + 2 < I) fmac_(s2, a.z, U[4 * J + 2]); if constexpr (4 * J + 3 < I) fmac_(s3, a.w, U[4 * J + 3]);
        f32x4 nx[SOLVE_D];
#pragma unroll
        for (int q = 0; q + 1 < SOLVE_D; ++q) nx[q] = win[q + 1];
        nx[SOLVE_D - 1] = nw;
        __builtin_amdgcn_sched_barrier(0);
        if constexpr (J + 1 < solve_nq(I)) solve_step<I, J + 1>(U, Am, nx, s0, s1, s2, s3);
        else { U[I] -= (s0 + s1) + (s2 + s3); solve_step<I + 1, 0>(U, Am, nx, 0.f, 0.f, 0.f, 0.f); }
    }
}
__device__ __forceinline__ void solve_all(float (&U)[64], const LAS float* Am) {
    f32x4 win[SOLVE_D];
#pragma unroll
    for (int q = 0; q < SOLVE_D; ++q) { constexpr RQ dummy{0, 0}; (void)dummy; }
    { constexpr RQ p0 = solve_adv(1, 0, 0), p1 = solve_adv(1, 0, 1), p2 = solve_adv(1, 0, 2), p3 = solve_adv(1, 0, 3), p4 = solve_adv(1, 0, 4);
      win[0] = *(const LAS f32x4*)(Am + p0.i * 64 + 4 * p0.j); win[1] = *(const LAS f32x4*)(Am + p1.i * 64 + 4 * p1.j); win[2] = *(const LAS f32x4*)(Am + p2.i * 64 + 4 * p2.j);
      win[3] = *(const LAS f32x4*)(Am + p3.i * 64 + 4 * p3.j); win[4] = *(const LAS f32x4*)(Am + p4.i * 64 + 4 * p4.j); }
    static_assert(SOLVE_D == 5, "window priming is written for SOLVE_D = 5");
    solve_step<1, 0>(U, Am, win, 0.f, 0.f, 0.f, 0.f);
}

constexpr int CP_QN = 0, CP_KN = 17408, CP_VA = 34816, CP_QKL = 51200, CP_SC = 59392, CP_HALF = 60416, CP_CW = 2 * CP_HALF;
__device__ __forceinline__ void phase_chunk(Frame& F) {
    const float* conv_w = F.in[3];
    const bf16* proj = (const bf16*)(F.ws + WS_PROJ);
    const float* betaA = (const float*)(F.ws + WS_BETA); const float* gA = (const float*)(F.ws + WS_G);
    float* gtotA = (float*)(F.ws + WS_GTOT);
    const int half = F.wave >> 2, hw = F.wave & 3;
    LAS unsigned char* L = F.lds + half * CP_HALF;
    LAS bf16* qn = (LAS bf16*)(L + CP_QN); LAS bf16* kn = (LAS bf16*)(L + CP_KN); LAS bf16* vn = (LAS bf16*)(L + CP_VA);
    LAS float* Am = (LAS float*)(L + CP_VA); LAS bf16* qkL = (LAS bf16*)(L + CP_QKL); LAS float* sc = (LAS float*)(L + CP_SC);
    LAS float* cwL = (LAS float*)(F.lds + CP_CW);
    for (int idx = F.tid; idx < 4 * 1536 / 4; idx += 512) *(LAS f32x4*)(cwL + 4 * idx) = *(const f32x4*)(conv_w + 4 * idx);
    __syncthreads();
#pragma unroll 1
    for (int it = 0; it < 4; ++it) {
        int tid_ = F.tid; asm volatile("" : "+v"(tid_));
        const int ht = tid_ & 255, lane = tid_ & 63, r16 = lane & 15, gq = lane >> 4;
        int unit = (it * (int)gridDim.x + (int)blockIdx.x) * 2 + half; asm volatile("" : "+s"(unit));
        const bool live = unit < NB * NH * 64;
        const int bh = unit >> 6, n = unit & 63, b = bh >> 2, h = bh & 3;
        const size_t m0 = (size_t)b * SEQ + (size_t)n * 64;
        unsigned char* chunk = F.ws + WS_CHUNK + (size_t)unit * CH_BYTES;
        const int rq = ht >> 4, cg = ht & 15;
        v4u Xa[7], Xb[7]; float gi = 0.f, bi = 0.f;
#define CHUNK_LOADX(X, p_) do { _Pragma("unroll") for (int jj = 0; jj < 7; ++jj) { const int trow = n * 64 + 4 * rq - 3 + jj; const int trc = trow < 0 ? 0 : trow; \
            const v4u u_ = *(const v4u*)(proj + ((size_t)b * SEQ + trc) * NPROJ + (p_) * 512 + h * 128 + 8 * cg); const unsigned mk_ = trow < 0 ? 0u : 0xffffffffu; \
            X[jj] = (v4u){u_.x & mk_, u_.y & mk_, u_.z & mk_, u_.w & mk_}; } } while (0)
#define CHUNK_CONV(X, p_) do { const int col = (p_) * 512 + h * 128 + 8 * cg; float wv[4][8]; \
            _Pragma("unroll") for (int j = 0; j < 4; ++j) { const f32x4 w0 = *(const LAS f32x4*)(cwL + j * 1536 + col), w1 = *(const LAS f32x4*)(cwL + j * 1536 + col + 4); \
                wv[j][0] = w0.x; wv[j][1] = w0.y; wv[j][2] = w0.z; wv[j][3] = w0.w; wv[j][4] = w1.x; wv[j][5] = w1.y; wv[j][6] = w1.z; wv[j][7] = w1.w; } \
            _Pragma("unroll") for (int rr = 0; rr < 4; ++rr) { float y[8]; \
                _Pragma("unroll") for (int q = 0; q < 8; ++q) y[q] = 0.f; \
                _Pragma("unroll") for (int j = 0; j < 4; ++j) { const v4u u = X[rr + j]; \
                    fmac_(y[0], wv[j][0], bflo(u.x)); fmac_(y[1], wv[j][1], bfhi(u.x)); fmac_(y[2], wv[j][2], bflo(u.y)); fmac_(y[3], wv[j][3], bfhi(u.y)); \
                    fmac_(y[4], wv[j][4], bflo(u.z)); fmac_(y[5], wv[j][5], bfhi(u.z)); fmac_(y[6], wv[j][6], bflo(u.w)); fmac_(y[7], wv[j][7], bfhi(u.w)); } \
                float ss = 0.f; \
                _Pragma("unroll") for (int q = 0; q < 8; ++q) { y[q] = siluf_(y[q]); ss += y[q] * y[q]; } \
                float scl = 1.f; \
                if ((p_) < 2) { ss += __shfl_xor(ss, 1); ss += __shfl_xor(ss, 2); ss += __shfl_xor(ss, 4); ss += __shfl_xor(ss, 8); scl = frsq_(ss + 1e-6f); if ((p_) == 0) scl *= 0.08838834764831845f; } \
                v4u o; o.x = cvt_pk_bf16(y[0] * scl, y[1] * scl); o.y = cvt_pk_bf16(y[2] * scl, y[3] * scl); o.z = cvt_pk_bf16(y[4] * scl, y[5] * scl); o.w = cvt_pk_bf16(y[6] * scl, y[7] * scl); \
                const int row = 4 * rq + rr; \
                if ((p_) == 0) *(LAS v4u*)(qn + row * 136 + 8 * cg) = o; else if ((p_) == 1) *(LAS v4u*)(kn + row * 136 + 8 * cg) = o; else *(LAS v4u*)(vn + row * 128 + 8 * cg) = o; \
                __builtin_amdgcn_sched_barrier(0); } } while (0)
        if (live) { CHUNK_LOADX(Xa, 0); CHUNK_LOADX(Xb, 1); if (hw == 0) { gi = gA[(m0 + lane) * 4 + h]; bi = betaA[(m0 + lane) * 4 + h]; } }
        if (live && hw == 0) {
            float c = gi;
#pragma unroll
            for (int o = 1; o < 64; o <<= 1) { const float tt = __shfl_up(c, o); if (lane >= o) c += tt; }
            const float gl = __shfl(c, 63);
            sc[lane] = bi; sc[64 + lane] = c; sc[128 + lane] = fexp_(c); sc[192 + lane] = fexp_(gl - c);
            if (lane == 63) gtotA[unit] = fexp_(c);
        }
        if (live) { CHUNK_CONV(Xa, 0); CHUNK_LOADX(Xa, 2); CHUNK_CONV(Xb, 1); CHUNK_CONV(Xa, 2); }
#undef CHUNK_LOADX
#undef CHUNK_CONV
        __syncthreads();
        const int which = ht >> 7, c = ht & 127;
        float U[64];
        if (live) {
#pragma unroll
            for (int i = 0; i < 64; ++i) { const float bi = sc[i]; const float tv = which ? bf2f(kn[i * 136 + c]) * sc[128 + i] : bf2f(vn[i * 128 + c]); U[i] = tv * bi; }
        } else {
#pragma unroll
            for (int i = 0; i < 64; ++i) U[i] = 0.f;
        }
        __syncthreads();
        if (live) {
            const int ti = hw >> 1, tj = hw & 1, r = lane & 31, hh = lane >> 5;
            f32x16 KK, QK;
#pragma unroll
            for (int q = 0; q < 16; ++q) { KK[q] = 0.f; QK[q] = 0.f; }
#pragma unroll
            for (int ks = 0; ks < 8; ++ks) {
                const bf16x8 ak = *(const LAS bf16x8*)(kn + (ti * 32 + r) * 136 + 16 * ks + 8 * hh);
                const bf16x8 aq = *(const LAS bf16x8*)(qn + (ti * 32 + r) * 136 + 16 * ks + 8 * hh);
                const bf16x8 bb = *(const LAS bf16x8*)(kn + (tj * 32 + r) * 136 + 16 * ks + 8 * hh);
                KK = __builtin_amdgcn_mfma_f32_32x32x16_bf16(ak, bb, KK, 0, 0, 0);
                QK = __builtin_amdgcn_mfma_f32_32x32x16_bf16(aq, bb, QK, 0, 0, 0);
            }
            const int j = tj * 32 + r; const float gcj = sc[64 + j];
#pragma unroll
            for (int reg = 0; reg < 16; ++reg) { const int i = ti * 32 + (reg & 3) + 8 * (reg >> 2) + 4 * hh;
                const float dec = (i >= j) ? __expf(sc[64 + i] - gcj) : 0.f;
                Am[i * 64 + j] = (i > j) ? sc[i] * KK[reg] * dec : 0.f;
                qkL[i * 64 + j] = (bf16)f2bf((i >= j) ? QK[reg] * dec : 0.f); }
        }
        __syncthreads();
        if (live) {
#pragma unroll
            for (int fi = 0; fi < 4; ++fi) { const int f = hw * 4 + fi, mb = f >> 2, ks = f & 3, row = 16 * mb + r16; const float s = sc[128 + row];
                const v2u lo = *(const LAS v2u*)(qn + row * 136 + 32 * ks + 4 * gq), hi = *(const LAS v2u*)(qn + row * 136 + 32 * ks + 16 + 4 * gq);
                v4u o; o.x = pk2(bflo(lo.x) * s, bfhi(lo.x) * s); o.y = pk2(bflo(lo.y) * s, bfhi(lo.y) * s); o.z = pk2(bflo(hi.x) * s, bfhi(hi.x) * s); o.w = pk2(bflo(hi.y) * s, bfhi(hi.y) * s);
                *(v4u*)(chunk + CH_QD + (f * 64 + lane) * 16) = o; }
#pragma unroll
            for (int fi = 0; fi < 4; ++fi) { const int f = hw * 4 + fi, db = f >> 1, ksp = f & 1, dcol = 16 * db + r16; float e[8];
#pragma unroll
                for (int j = 0; j < 8; ++j) { const int i = 32 * ksp + 16 * (j >> 2) + 4 * gq + (j & 3); e[j] = bf2f(kn[i * 136 + dcol]) * sc[192 + i]; }
                v4u o; o.x = pk2(e[0], e[1]); o.y = pk2(e[2], e[3]); o.z = pk2(e[4], e[5]); o.w = pk2(e[6], e[7]);
                *(v4u*)(chunk + CH_KT + (f * 64 + lane) * 16) = o; }
#pragma unroll
            for (int fi = 0; fi < 2; ++fi) { const int f = hw * 2 + fi, mb = f >> 1, ksp = f & 1, row = 16 * mb + r16;
                const v2u lo = *(const LAS v2u*)(qkL + row * 64 + 32 * ksp + 4 * gq), hi = *(const LAS v2u*)(qkL + row * 64 + 32 * ksp + 16 + 4 * gq);
                *(v4u*)(chunk + CH_QK + (f * 64 + lane) * 16) = (v4u){lo.x, lo.y, hi.x, hi.y}; }
            solve_all(U, Am);
        }
        __syncthreads();
        if (live) {
            if (which == 0) {
                const int w8 = c >> 4, cl = c & 15;
                unsigned char* ub = F.ws + WS_UC + (size_t)unit * UC_BYTES;
#pragma unroll
                for (int g = 0; g < 4; ++g) {
                    v4u lo, hi;
                    lo.x = pk2(U[4 * g], U[4 * g + 1]); lo.y = pk2(U[4 * g + 2], U[4 * g + 3]); lo.z = pk2(U[16 + 4 * g], U[16 + 4 * g + 1]); lo.w = pk2(U[16 + 4 * g + 2], U[16 + 4 * g + 3]);
                    hi.x = pk2(U[32 + 4 * g], U[32 + 4 * g + 1]); hi.y = pk2(U[32 + 4 * g + 2], U[32 + 4 * g + 3]); hi.z = pk2(U[48 + 4 * g], U[48 + 4 * g + 1]); hi.w = pk2(U[48 + 4 * g + 2], U[48 + 4 * g + 3]);
                    v4u* dst = (v4u*)(ub + ((w8 * 64 + g * 16 + cl) * 32)); dst[0] = lo; dst[1] = hi;
                }
            } else {
#pragma unroll
                for (int i = 0; i < 64; ++i) qn[i * 136 + c] = (bf16)f2bf(U[i]);
            }
        }
        __syncthreads();
        if (live) {
#pragma unroll
            for (int fi = 0; fi < 4; ++fi) { const int f = hw * 4 + fi, mb = f >> 2, ks = f & 3, row = 16 * mb + r16;
                const v2u lo = *(const LAS v2u*)(qn + row * 136 + 32 * ks + 4 * gq), hi = *(const LAS v2u*)(qn + row * 136 + 32 * ks + 16 + 4 * gq);
                *(v4u*)(chunk + CH_WF + (f * 64 + lane) * 16) = (v4u){lo.x, lo.y, hi.x, hi.y}; }
        }
        __syncthreads();
    }
}

__device__ __forceinline__ void phase_scan(Frame& F) {
    const int bh = blockIdx.x, b = bh >> 2, h = bh & 3, w = F.wave, lane = F.lane, cl = lane & 15, gq = lane >> 4;
    const float* gtotA = (const float*)(F.ws + WS_GTOT);
    const int unit0 = bh * 64;
    const unsigned char* cbase = F.ws + WS_CHUNK + (size_t)unit0 * CH_BYTES;
    const unsigned char* ubase = F.ws + WS_UC + (size_t)unit0 * UC_BYTES + (w * 64 + lane) * 32;
    bf16* op = (bf16*)(F.ws + WS_ORAW) + ((size_t)b * SEQ + cl) * 512 + h * 128 + 16 * w + 4 * gq;
    f32x4 Sacc[8]; bf16x8 Sb[4];
#pragma unroll
    for (int d = 0; d < 8; ++d) Sacc[d] = (f32x4){0.f, 0.f, 0.f, 0.f};
#pragma unroll
    for (int k = 0; k < 4; ++k) Sb[k] = (bf16x8){0, 0, 0, 0, 0, 0, 0, 0};
#define SCAN_ISSUE(nn) do { const unsigned char* s_ = cbase + (size_t)(nn) * CH_BYTES + (w * 7) * 1024 + lane * 16; LAS unsigned char* d_ = F.lds + ((nn) & 1) * CH_BYTES + (w * 7) * 1024; \
        _Pragma("unroll") for (int k_ = 0; k_ < 7; ++k_) __builtin_amdgcn_global_load_lds((const unsigned*)(s_ + k_ * 1024), (LAS unsigned*)(d_ + k_ * 1024), 16, 0, 0); } while (0)
    SCAN_ISSUE(0);
    v4u nu0 = *(const v4u*)(ubase), nu1 = *(const v4u*)(ubase + 16);
    float ngt = gtotA[unit0];
    v2u Ow[4];
#pragma unroll
    for (int mb = 0; mb < 4; ++mb) Ow[mb] = (v2u){0u, 0u};
#pragma unroll 1
    for (int n = 0; n < 64; ++n) {
        VM_WAIT(); __syncthreads();
        const v4u cu0 = nu0, cu1 = nu1; const float gt = ngt;
        if (n + 1 < 64) { SCAN_ISSUE(n + 1); nu0 = *(const v4u*)(ubase + (size_t)(n + 1) * UC_BYTES); nu1 = *(const v4u*)(ubase + (size_t)(n + 1) * UC_BYTES + 16); ngt = gtotA[unit0 + n + 1]; }
        if (n > 0) {
#pragma unroll
            for (int mb = 0; mb < 4; ++mb) *(v2u*)(op + (size_t)((n - 1) * 64 + 16 * mb) * 512) = Ow[mb];
        }
        const LAS unsigned char* B = F.lds + (n & 1) * CH_BYTES;
#define FRAG(off, f) (*(const LAS bf16x8*)(B + (off) + ((f) * 64 + lane) * 16))
        f32x4 P[4];
#pragma unroll
        for (int mb = 0; mb < 4; ++mb) { P[mb] = (f32x4){0.f, 0.f, 0.f, 0.f};
#pragma unroll
            for (int ks = 0; ks < 4; ++ks) P[mb] = __builtin_amdgcn_mfma_f32_16x16x32_bf16(FRAG(CH_WF, mb * 4 + ks), Sb[ks], P[mb], 0, 0, 0); }
        f32x4 vnw[4];
        vnw[0] = (f32x4){bflo(cu0.x), bfhi(cu0.x), bflo(cu0.y), bfhi(cu0.y)} - P[0];
        vnw[1] = (f32x4){bflo(cu0.z), bfhi(cu0.z), bflo(cu0.w), bfhi(cu0.w)} - P[1];
        vnw[2] = (f32x4){bflo(cu1.x), bfhi(cu1.x), bflo(cu1.y), bfhi(cu1.y)} - P[2];
        vnw[3] = (f32x4){bflo(cu1.z), bfhi(cu1.z), bflo(cu1.w), bfhi(cu1.w)} - P[3];
        bf16x8 Vb[2]; Vb[0] = pack8(vnw[0], vnw[1]); Vb[1] = pack8(vnw[2], vnw[3]);
#pragma unroll
        for (int db = 0; db < 8; ++db) { Sacc[db] = Sacc[db] * gt;
#pragma unroll
            for (int ksp = 0; ksp < 2; ++ksp) Sacc[db] = __builtin_amdgcn_mfma_f32_16x16x32_bf16(FRAG(CH_KT, db * 2 + ksp), Vb[ksp], Sacc[db], 0, 0, 0); }
#pragma unroll
        for (int mb = 0; mb < 4; ++mb) { f32x4 OT = (f32x4){0.f, 0.f, 0.f, 0.f};
#pragma unroll
            for (int ks = 0; ks < 4; ++ks) OT = __builtin_amdgcn_mfma_f32_16x16x32_bf16(Sb[ks], FRAG(CH_QD, mb * 4 + ks), OT, 0, 0, 0);
#pragma unroll
            for (int ksp = 0; ksp < 2; ++ksp) OT = __builtin_amdgcn_mfma_f32_16x16x32_bf16(Vb[ksp], FRAG(CH_QK, mb * 2 + ksp), OT, 0, 0, 0);
            Ow[mb] = (v2u){cvt_pk_bf16(OT[0], OT[1]), cvt_pk_bf16(OT[2], OT[3])}; }
#pragma unroll
        for (int ks = 0; ks < 4; ++ks) Sb[ks] = pack8(Sacc[2 * ks], Sacc[2 * ks + 1]);
#undef FRAG
    }
#undef SCAN_ISSUE
#pragma unroll
    for (int mb = 0; mb < 4; ++mb) *(v2u*)(op + (size_t)(63 * 64 + 16 * mb) * 512) = Ow[mb];
    VM_WAIT(); __syncthreads();
}

__device__ __forceinline__ void phase_onorm(Frame& F) {
    const float* dnw = F.in[6]; const bf16* proj = (const bf16*)(F.ws + WS_PROJ); const bf16* oraw = (const bf16*)(F.ws + WS_ORAW); bf16* concat = (bf16*)(F.ws + WS_CONCAT);
    const int gw = F.vcu * NWAVES + F.wave, NGW = F.G * NWAVES, lane = F.lane;
    const int cc = 8 * (lane & 15);
    const f32x4 d0 = *(const f32x4*)(dnw + cc), d1 = *(const f32x4*)(dnw + cc + 4);
    for (int m = gw; m < NTOK; m += NGW) {
        const v4u o = *(const v4u*)(oraw + (size_t)m * 512 + 8 * lane);
        const v4u z = *(const v4u*)(proj + (size_t)m * NPROJ + 1536 + 8 * lane);
        const float ov[8] = {bflo(o.x), bfhi(o.x), bflo(o.y), bfhi(o.y), bflo(o.z), bfhi(o.z), bflo(o.w), bfhi(o.w)};
        const float zv[8] = {bflo(z.x), bfhi(z.x), bflo(z.y), bfhi(z.y), bflo(z.z), bfhi(z.z), bflo(z.w), bfhi(z.w)};
        float ss = 0.f;
#pragma unroll
        for (int q = 0; q < 8; ++q) ss += ov[q] * ov[q];
        ss += __shfl_xor(ss, 1); ss += __shfl_xor(ss, 2); ss += __shfl_xor(ss, 4); ss += __shfl_xor(ss, 8);
        const float rs = frsq_(ss * (1.f / 128.f) + 1e-6f);
        const float dv[8] = {d0.x, d0.y, d0.z, d0.w, d1.x, d1.y, d1.z, d1.w};
        float r[8];
#pragma unroll
        for (int q = 0; q < 8; ++q) r[q] = ov[q] * rs * dv[q] * siluf_(zv[q]);
        *(v4u*)(concat + (size_t)m * DM + 8 * lane) = (v4u){cvt_pk_bf16(r[0], r[1]), cvt_pk_bf16(r[2], r[3]), cvt_pk_bf16(r[4], r[5]), cvt_pk_bf16(r[6], r[7])};
    }
}

__device__ __forceinline__ void phase_route(Frame& F) {
    const float* x1 = F.out; const float* b_router = F.in[12];
    unsigned char* x1b = F.ws + WS_X1B; float* rs2A = (float*)(F.ws + WS_RS2); int* list = (int*)(F.ws + WS_LIST);
    float* rsl = (float*)(F.ws + WS_RSL); float* gwl = (float*)(F.ws + WS_GWL);
    unsigned* cntw = (unsigned*)(F.ws + WS_CTL) + CW_CNT;
    LAS unsigned char* WI = F.lds;
    LAS unsigned* lcnt = (LAS unsigned*)(F.lds + TAB_OFF);
    { const v4u* src = (const v4u*)(F.ws + WS_WR);
      for (int idx = F.tid; idx < 131072 / 16; idx += 512) *(LAS v4u*)(WI + 16 * idx) = src[idx]; }
    const int lane = F.lane, c = lane & 15, g = lane >> 4;
    const int gw = F.vcu * NWAVES + F.wave, NGW = F.G * NWAVES, NT = NTOK / 16;
    const float bia0 = b_router[c], bia1 = b_router[16 + c];
    for (int t0 = 0; t0 < NT; t0 += NGW) {
        const int tile = t0 + gw; const bool live = tile < NT;
        if (F.tid < 64) lcnt[F.tid] = 0u;
        __syncthreads();
        int my_e = 0; float my_g = 0.f, my_rs = 0.f; unsigned my_rank = 0u; int my_ent = 0;
        if (live) {
            const int m0 = tile * 16;
            const float* xrow = x1 + (size_t)(m0 + c) * DM + 8 * g;
            unsigned char* xbrow = x1b + (size_t)(m0 + c) * DM + 8 * g;
            f32x4 acc0 = (f32x4){0.f, 0.f, 0.f, 0.f}, acc1 = acc0; float ssq = 0.f;
#pragma unroll 1
            for (int kb = 0; kb < 4; ++kb) {
                f32x4 xa[8], xb4[8];
#pragma unroll
                for (int q = 0; q < 8; ++q) { xa[q] = *(const f32x4*)(xrow + 32 * (kb * 8 + q)); xb4[q] = *(const f32x4*)(xrow + 32 * (kb * 8 + q) + 4); }
#pragma unroll
                for (int q = 0; q < 8; ++q) { const int ks = kb * 8 + q; const f32x4 a = xa[q], b = xb4[q];
                    ssq += (a.x * a.x + a.y * a.y) + (a.z * a.z + a.w * a.w) + (b.x * b.x + b.y * b.y) + (b.z * b.z + b.w * b.w);
                    v4u h; h.x = cvt_pk_bf16(a.x, a.y); h.y = cvt_pk_bf16(a.z, a.w); h.z = cvt_pk_bf16(b.x, b.y); h.w = cvt_pk_bf16(b.z, b.w);
                    v4u l; l.x = cvt_pk_bf16(a.x - bflo(h.x), a.y - bfhi(h.x)); l.y = cvt_pk_bf16(a.z - bflo(h.y), a.w - bfhi(h.y)); l.z = cvt_pk_bf16(b.x - bflo(h.z), b.y - bfhi(h.z)); l.w = cvt_pk_bf16(b.z - bflo(h.w), b.w - bfhi(h.w));
                    *(v2u*)(xbrow + 32 * ks) = (v2u){pk4_fp8(a.x, a.y, a.z, a.w), pk4_fp8(b.x, b.y, b.z, b.w)};
                    const bf16x8 ah = __builtin_bit_cast(bf16x8, h), al = __builtin_bit_cast(bf16x8, l);
                    const LAS unsigned char* fb = WI + (size_t)(ks * 4) * 1024 + lane * 16;
                    const bf16x8 b0h = *(const LAS bf16x8*)(fb), b0l = *(const LAS bf16x8*)(fb + 1024), b1h = *(const LAS bf16x8*)(fb + 2048), b1l = *(const LAS bf16x8*)(fb + 3072);
                    acc0 = __builtin_amdgcn_mfma_f32_16x16x32_bf16(ah, b0h, acc0, 0, 0, 0); acc0 = __builtin_amdgcn_mfma_f32_16x16x32_bf16(ah, b0l, acc0, 0, 0, 0); acc0 = __builtin_amdgcn_mfma_f32_16x16x32_bf16(al, b0h, acc0, 0, 0, 0);
                    acc1 = __builtin_amdgcn_mfma_f32_16x16x32_bf16(ah, b1h, acc1, 0, 0, 0); acc1 = __builtin_amdgcn_mfma_f32_16x16x32_bf16(ah, b1l, acc1, 0, 0, 0); acc1 = __builtin_amdgcn_mfma_f32_16x16x32_bf16(al, b1h, acc1, 0, 0, 0); }
            }
            ssq += __shfl_xor(ssq, 16); ssq += __shfl_xor(ssq, 32);
            const float rsr = frsq_(ssq * (1.f / DM) + 1e-6f);
            if (g == 0) rs2A[m0 + c] = rsr;
            float ge_[4]; int ee_[4];
#pragma unroll
            for (int reg = 0; reg < 4; ++reg) {
                const float rsw = __shfl(rsr, 4 * g + reg);
                float v0 = acc0[reg] * rsw + bia0, v1 = acc1[reg] * rsw + bia1;
                float tv[4]; int te[4];
#pragma unroll
                for (int s = 0; s < 4; ++s) {
                    float bv; int bi; if (v1 > v0) { bv = v1; bi = 16 + c; } else { bv = v0; bi = c; }
#pragma unroll
                    for (int o = 1; o < 16; o <<= 1) { const float ov = __shfl_xor(bv, o); const int oi = __shfl_xor(bi, o); if (ov > bv || (ov == bv && oi < bi)) { bv = ov; bi = oi; } }
                    tv[s] = bv; te[s] = bi; if (bi == c) v0 = -3.0e38f; if (bi == 16 + c) v1 = -3.0e38f;
                }
                const float e1 = fexp_(tv[1] - tv[0]), e2 = fexp_(tv[2] - tv[0]), e3 = fexp_(tv[3] - tv[0]); const float inv = frcp_(1.f + e1 + e2 + e3);
                const int s_ = c & 3; const float gsel = (s_ == 0 ? 1.f : s_ == 1 ? e1 : s_ == 2 ? e2 : e3) * inv; const int esel = s_ == 0 ? te[0] : s_ == 1 ? te[1] : s_ == 2 ? te[2] : te[3];
                ge_[reg] = gsel; ee_[reg] = esel;
            }
            const int rsel = c >> 2;
            my_g = rsel == 0 ? ge_[0] : rsel == 1 ? ge_[1] : rsel == 2 ? ge_[2] : ge_[3];
            my_e = rsel == 0 ? ee_[0] : rsel == 1 ? ee_[1] : rsel == 2 ? ee_[2] : ee_[3];
            my_ent = (m0 + 4 * g + rsel) * 4 + (c & 3);
            my_rs = __shfl(rsr, 4 * g + rsel);
            my_rank = __hip_atomic_fetch_add(lcnt + my_e, 1u, __ATOMIC_RELAXED, __HIP_MEMORY_SCOPE_WORKGROUP);
        }
        __syncthreads();
        if (F.tid < NE) { const unsigned n = lcnt[F.tid]; lcnt[32 + F.tid] = n ? __hip_atomic_fetch_add(cntw + 64 * F.tid, n, RLX_AGENT) : 0u; }
        __syncthreads();
        if (live) { const size_t pos = (size_t)my_e * LISTCAP + lcnt[32 + my_e] + my_rank; list[pos] = my_ent; rsl[pos] = my_rs; gwl[pos] = my_g; }
        __syncthreads();
    }
}

__device__ __forceinline__ int moe_tables(Frame& F, MoeTab& T) {
    LAS int* pref = (LAS int*)(F.lds + TAB_OFF); LAS int* cnt = pref + 40;
    unsigned* cntw = (unsigned*)(F.ws + WS_CTL) + CW_CNT;
    if (F.tid == 0) { int acc = 0; for (int e = 0; e < NE; ++e) { const int c = (int)__hip_atomic_load(cntw + 64 * e, RLX_AGENT); cnt[e] = c; pref[e] = acc; acc += (c + 255) >> 8; } pref[NE] = acc; }
    __syncthreads();
    T.pref = pref; T.cnt = cnt;
    return pref[NE];
}

struct FinalRow { f32x4 v[4]; v2u sl[4][2]; };
typedef float f32x2_t __attribute__((ext_vector_type(2)));
__device__ __forceinline__ void final_load(FinalRow& R, const float* orow, const unsigned char* srow) {
#pragma unroll
    for (int j = 0; j < 2; ++j) { R.v[2 * j] = *(const f32x4*)(orow + 512 * j); R.v[2 * j + 1] = *(const f32x4*)(orow + 512 * j + 4); }
#pragma unroll
    for (int s = 0; s < 4; ++s)
#pragma unroll
        for (int j = 0; j < 2; ++j) R.sl[s][j] = *(const v2u*)(srow + (size_t)s * DM + 512 * j);
}
__device__ __forceinline__ void final_finish(FinalRow& R, float* orow, const f32x4 (&wv)[4], size_t dry_off) {
    orow += dry_off;
#pragma unroll
    for (int s = 0; s < 4; ++s)
#pragma unroll
        for (int j = 0; j < 2; ++j) { const v2u u = R.sl[s][j];
            const f32x2_t a0 = __builtin_amdgcn_cvt_pk_f32_fp8((int)u.x, false), a1 = __builtin_amdgcn_cvt_pk_f32_fp8((int)u.x, true), b0 = __builtin_amdgcn_cvt_pk_f32_fp8((int)u.y, false), b1 = __builtin_amdgcn_cvt_pk_f32_fp8((int)u.y, true);
            R.v[2 * j].x += a0.x * SLAB_INV; R.v[2 * j].y += a0.y * SLAB_INV; R.v[2 * j].z += a1.x * SLAB_INV; R.v[2 * j].w += a1.y * SLAB_INV;
            R.v[2 * j + 1].x += b0.x * SLAB_INV; R.v[2 * j + 1].y += b0.y * SLAB_INV; R.v[2 * j + 1].z += b1.x * SLAB_INV; R.v[2 * j + 1].w += b1.y * SLAB_INV; }
    float ss = 0.f;
#pragma unroll
    for (int j = 0; j < 4; ++j) ss += (R.v[j].x * R.v[j].x + R.v[j].y * R.v[j].y) + (R.v[j].z * R.v[j].z + R.v[j].w * R.v[j].w);
    ss = wave_sum(ss);
    const float rs = frsq_(ss * (1.f / DM) + 1e-6f);
#pragma unroll
    for (int j = 0; j < 2; ++j) { *(f32x4*)(orow + 512 * j) = R.v[2 * j] * rs * wv[2 * j]; *(f32x4*)(orow + 512 * j + 4) = R.v[2 * j + 1] * rs * wv[2 * j + 1]; }
}
__device__ __forceinline__ void phase_final(Frame& F, int dryrun) {
    const float* fw = F.in[17]; const unsigned char* slab = F.ws + WS_SLAB; float* out = F.out;
    const int gw = F.vcu * NWAVES + F.wave, NGW = F.G * NWAVES, lane = F.lane;
    f32x4 wv[4];
#pragma unroll
    for (int j = 0; j < 2; ++j) { wv[2 * j] = *(const f32x4*)(fw + 512 * j + 8 * lane); wv[2 * j + 1] = *(const f32x4*)(fw + 512 * j + 8 * lane + 4); }
    const size_t dry_off = dryrun ? (size_t)((float*)(F.ws + WS_XB) - out) : 0;
    FinalRow A, B;
    int m = gw;
    if (m < NTOK) final_load(A, out + (size_t)m * DM + 8 * lane, slab + (size_t)m * 4 * DM + 8 * lane);
    for (; m < NTOK; m += 2 * NGW) {
        const int m1 = m + NGW, m2 = m + 2 * NGW;
        if (m1 < NTOK) final_load(B, out + (size_t)m1 * DM + 8 * lane, slab + (size_t)m1 * 4 * DM + 8 * lane);
        final_finish(A, out + (size_t)m * DM + 8 * lane, wv, dry_off);
        if (m2 < NTOK) final_load(A, out + (size_t)m2 * DM + 8 * lane, slab + (size_t)m2 * 4 * DM + 8 * lane);
        if (m1 < NTOK) final_finish(B, out + (size_t)m1 * DM + 8 * lane, wv, dry_off);
    }
}

struct Args { const float* in[18]; float* out; unsigned char* ws; int ph_lo, ph_hi, flag, pad; };
constexpr int NPHASE = 11;

__global__ void __launch_bounds__(NWAVES * 64, 2) mk_fwd(Args args) {
    extern __shared__ __attribute__((aligned(16))) unsigned char lds_raw[];
    Frame F;
    F.lds = (LAS unsigned char*)lds_raw;
    F.tid = threadIdx.x; F.lane = F.tid & 63; F.wave = __builtin_amdgcn_readfirstlane(F.tid >> 6);
    F.G = gridDim.x; { const int bx = blockIdx.x; F.vcu = (F.G % 8 == 0) ? (bx % 8) * (F.G / 8) + bx / 8 : bx; }
#pragma unroll
    for (int i = 0; i < 18; ++i) F.in[i] = args.in[i];
    F.out = args.out; F.ws = args.ws;
    volatile LAS unsigned* MISC = (volatile LAS unsigned*)(F.lds + MISC_OFF);
    for (int u = F.tid; u < (LDS_BYTES - LDSCTL_OFF) / 4; u += NWAVES * 64) ((LAS unsigned*)(F.lds + LDSCTL_OFF))[u] = 0u;
    __syncthreads();
    unsigned* ctl = (unsigned*)(F.ws + WS_CTL);
#if !MK_PER_PHASE
    XcdBarrier bar = xcd_barrier_post(ctl + CW_BAR, MISC + 8);
#define GRID_BAR() xcd_barrier(bar)
#else
#define GRID_BAR() do {} while (0)
#endif
    const int lo = args.ph_lo, hi = args.ph_hi;
#define IN(k) (lo <= (k) && (k) < hi)
#define SEAM(k) do { if (IN(k) && IN((k) + 1)) GRID_BAR(); } while (0)

#define RUNPH(k, ...) do { if (IN(k)) { __VA_ARGS__; } SEAM(k); } while (0)
    RUNPH(0, phase_prep(F));
    RUNPH(1, {
        ProbIn P; P.K = DM; P.RB = 2 * DM; P.S.init(NTOK / 256, NPROJ / 256, F.G, (int)blockIdx.x);
        P.A = (const bf16*)(F.ws + WS_XB); P.Bt = (const bf16*)(F.ws + WS_WIN); P.O = (bf16*)(F.ws + WS_PROJ); P.rs = (const float*)(F.ws + WS_RS1);
        pg8::gemm_phase(F.lds, P); });
    if (IN(2)) { phase_mix(F); __syncthreads(); }
    RUNPH(3, phase_chunk(F));
    RUNPH(4, {
        const int nscan = NB * NH;
        if ((int)blockIdx.x < nscan) phase_scan(F);
        else {
               moe_weight_prep(F, nscan, MOE_PREP_SPLIT, MOE_PREP_ITEMS); } });
    RUNPH(5, phase_onorm(F));
    RUNPH(6, {
        ProbOut P; P.K = DM; P.RB = 2 * DM; P.S.init(NTOK / 256, DM / 256, F.G, (int)blockIdx.x);
        P.A = (const bf16*)(F.ws + WS_CONCAT); P.Bt = (const bf16*)(F.ws + WS_WOUT); P.X = F.in[0]; P.O = F.out;
        pg8::gemm_phase(F.lds, P); });
    RUNPH(7, phase_route(F));
    RUNPH(8, {
        ProbGU P; const int RT = moe_tables(F, P.T);
        P.K = DM; P.RB = DM; P.S.init(RT, 8, F.G, (int)blockIdx.x);
        P.A = F.ws + WS_X1B; P.Bt = F.ws + WS_WGU; P.O = F.ws + WS_ACT; P.list = (const int*)(F.ws + WS_LIST);
        P.rs2 = (const float*)(F.ws + WS_RSL); P.bgu = (const float*)(F.ws + WS_BGU);
        pg8::gemm_phase<ProbGU, true>(F.lds, P); });
    RUNPH(9, {
        ProbDown P; const int RT = moe_tables(F, P.T);
        P.K = DE; P.RB = DE; P.S.init(RT, 4, F.G, (int)blockIdx.x);
        P.A = F.ws + WS_ACT; P.Bt = F.ws + WS_WD; P.O = F.ws + WS_SLAB; P.list = (const int*)(F.ws + WS_LIST);
        P.gw = (const float*)(F.ws + WS_GWL); P.bd = F.in[16];
        pg8::gemm_phase<ProbDown, true>(F.lds, P); });
    RUNPH(10, phase_final(F, args.flag));
#undef RUNPH
#undef IN
#undef SEAM
}

extern "C" void kernel_launch(void* const* d_in, const int* in_sizes, int n_in, void* d_out, int out_size, void* d_ws, size_t ws_size, hipStream_t stream) {
    static int grid = 0;
    if (grid == 0) {
        if (n_in != 18 || in_sizes[0] != NTOK * DM || out_size != NTOK * DM || ws_size < WS_END) { fprintf(stderr, "kernel_launch: unexpected shapes (n_in %d, in0 %d, out %d, ws %zu)\n", n_in, n_in > 0 ? in_sizes[0] : -1, out_size, ws_size); grid = -1; return; }
        int dev = 0, cus = 0, per_cu = 0;
        if (hipGetDevice(&dev) != hipSuccess || hipDeviceGetAttribute(&cus, hipDeviceAttributeMultiprocessorCount, dev) != hipSuccess) { grid = -1; return; }
        if (hipFuncSetAttribute((const void*)mk_fwd, hipFuncAttributeMaxDynamicSharedMemorySize, LDS_BYTES) != hipSuccess) { fprintf(stderr, "kernel_launch: hipFuncSetAttribute failed\n"); grid = -1; return; }
        if (hipOccupancyMaxActiveBlocksPerMultiprocessor(&per_cu, (const void*)mk_fwd, NWAVES * 64, LDS_BYTES) != hipSuccess || per_cu < 1) { fprintf(stderr, "kernel_launch: occupancy query says %d\n", per_cu); per_cu = 1; }
        (void)hipGetLastError();
        grid = cus;
    }
    if (grid < 0) return;
    (void)hipMemsetAsync((char*)d_ws + WS_CTL, 0, CTL_ZERO_BYTES, stream);
    Args a{};
    for (int i = 0; i < 18; ++i) a.in[i] = (const float*)d_in[i];
    a.out = (float*)d_out; a.ws = (unsigned char*)d_ws;
#if MK_PER_PHASE
    for (int p = 0; p < NPHASE; ++p) { a.ph_lo = p; a.ph_hi = p + 1; const int nrep = 1 + REP_CNT * ((REP_MASK >> p) & 1);
        for (int r = 0; r < nrep; ++r) { a.flag = (p == NPHASE - 1 && r + 1 < nrep) ? 1 : 0; hipLaunchKernelGGL(mk_fwd, dim3(grid), dim3(NWAVES * 64), LDS_BYTES, stream, a); } }
#else
    a.ph_lo = 0; a.ph_hi = NPHASE;
    hipLaunchKernelGGL(mk_fwd, dim3(grid), dim3(NWAVES * 64), LDS_BYTES, stream, a);
#endif
}
```

```cpp
#include <hip/hip_runtime.h>
#include <cstdio>
#include <cstdint>

#ifndef REP_MASK
#define REP_MASK 0
#endif
#ifndef REP_CNT
#define REP_CNT 1
#endif
#ifndef MK_PER_PHASE
#define MK_PER_PHASE 0
#endif

constexpr int NB = 8, SEQ = 4096, DM = 1024, NTOK = NB * SEQ;
constexpr int NH = 4, HD = 128, DDN = 512, DPOOL = 512, DIN = 2568, NPROJ = 2560;
constexpr int NE = 32, TOPK = 4, DE = 1024, NASSIGN = NTOK * TOPK;
constexpr int LISTCAP = NTOK;
constexpr int ACT_ROWS = NASSIGN + NE * 256;

constexpr size_t MiB = 1u << 20;
constexpr size_t WS_CTL = 0, CTL_ZERO_BYTES = 1 * MiB;
constexpr size_t WS_WIN = 1 * MiB;
constexpr size_t WS_WOUT = 6 * MiB;
constexpr size_t WS_WPOOL = 8 * MiB;
constexpr size_t WS_WR = 8 * MiB + 512 * 1024;
constexpr size_t WS_BGU = 8 * MiB + 768 * 1024;
constexpr size_t WS_RS1 = 9 * MiB;
constexpr size_t WS_BETA = 9 * MiB + 128 * 1024;
constexpr size_t WS_G = 9 * MiB + 640 * 1024;
constexpr size_t WS_RS2 = 10 * MiB + 256 * 1024;
constexpr size_t WS_GATEW = 10 * MiB + 512 * 1024;
constexpr size_t WS_LIST = 11 * MiB;
constexpr size_t WS_RSL = 800 * MiB;
constexpr size_t WS_GWL = 804 * MiB;
constexpr size_t WS_WGU = 16 * MiB;
constexpr size_t WS_WD = 144 * MiB;
constexpr size_t WS_XB = 208 * MiB;
constexpr size_t WS_PROJ = 272 * MiB;
constexpr size_t WS_CHUNK = 432 * MiB;
constexpr size_t WS_UC = 544 * MiB;
constexpr size_t WS_GTOT = 576 * MiB;
constexpr size_t WS_ORAW = 577 * MiB;
constexpr int CH_WF = 0, CH_QD = 16384, CH_KT = 32768, CH_QK = 49152, CH_BYTES = 57344, UC_BYTES = 16384;
constexpr size_t WS_MIXED = 688 * MiB;
constexpr size_t WS_CONCAT = 720 * MiB;
constexpr size_t WS_X1B = 208 * MiB;
constexpr size_t WS_ACT = 272 * MiB;
constexpr size_t WS_SLAB = 544 * MiB;
constexpr size_t WS_END = 808 * MiB;
static_assert(WS_ACT + (size_t)ACT_ROWS * 2048 <= WS_SLAB, "act fits");
static_assert(WS_SLAB + (size_t)NASSIGN * 2048 <= WS_END, "slab fits");

constexpr int CW_BAR = 4096;
constexpr int CW_CNT = 16384;
constexpr int CW_SEAM4 = 20480;

constexpr int LDS_BYTES = 163840;
constexpr int LDSCTL_OFF = LDS_BYTES - 1024, MISC_OFF = LDSCTL_OFF + 320, TAB_OFF = LDSCTL_OFF + 512;
constexpr int NWAVES = 8;

#define GAS __attribute__((address_space(1)))
#define LAS __attribute__((address_space(3)))
typedef unsigned short bf16;
typedef unsigned v4u __attribute__((ext_vector_type(4)));
typedef unsigned v2u __attribute__((ext_vector_type(2)));
typedef float f32x4 __attribute__((ext_vector_type(4)));
typedef float f32x2 __attribute__((ext_vector_type(2)));
typedef short bf16x8 __attribute__((ext_vector_type(8)));
typedef GAS unsigned gu32;
#define RLX_AGENT __ATOMIC_RELAXED, __HIP_MEMORY_SCOPE_AGENT
#define LDS_WAIT() asm volatile("s_waitcnt lgkmcnt(0)" ::: "memory")
#define VM_WAIT() asm volatile("s_waitcnt vmcnt(0)" ::: "memory")

__device__ __forceinline__ unsigned f2bf(float f) { unsigned u = __builtin_bit_cast(unsigned, f); return (u + 0x7fffu + ((u >> 16) & 1u)) >> 16; }
__device__ __forceinline__ unsigned pk2(float lo, float hi) { return f2bf(lo) | (f2bf(hi) << 16); }
__device__ __forceinline__ float bflo(unsigned u) { return __builtin_bit_cast(float, u << 16); }
__device__ __forceinline__ float bfhi(unsigned u) { return __builtin_bit_cast(float, u & 0xffff0000u); }
__device__ __forceinline__ unsigned pk4_fp8(float a, float b, float c, float d) { int p = __builtin_amdgcn_cvt_pk_fp8_f32(a, b, 0, false); p = __builtin_amdgcn_cvt_pk_fp8_f32(c, d, p, true); return (unsigned)p; }
constexpr float SLAB_SCALE = 16.f, SLAB_INV = 1.f / 16.f;
constexpr float W8_SCALE = 32.f, W8_INV = 1.f / 32.f;
__device__ __forceinline__ float wave_sum(float v) {
#pragma unroll
    for (int o = 1; o < 64; o <<= 1) v += __shfl_xor(v, o);
    return v;
}
__device__ __forceinline__ float frcp_(float x) { return __builtin_amdgcn_rcpf(x); }
__device__ __forceinline__ float frsq_(float x) { return __builtin_amdgcn_rsqf(x); }
__device__ __forceinline__ float fexp_(float x) { return __builtin_amdgcn_exp2f(x * 1.4426950408889634f); }
__device__ __forceinline__ float sigmoidf_(float x) { return frcp_(1.f + fexp_(-x)); }
__device__ __forceinline__ float siluf_(float x) { return x * frcp_(1.f + fexp_(-x)); }

namespace pg8 {
constexpr int BM = 256, BK = 64, HALF = 128, HTB = HALF * BK * 2, STAGE_BYTES = 8 * HTB;
__device__ __forceinline__ int lds_byte(int r, int c) { const int st = (r >> 4) * 2 + (c >> 5), rr = r & 15, cc = c & 31, ob = rr * 64 + cc * 2; return st * 1024 + (ob ^ (((ob >> 9) & 1) << 5)); }
__device__ __forceinline__ void stage_rc(int b, int& R, int& C) { const int st = b / 1024, sb = b % 1024, swz = sb ^ (((sb >> 9) & 1) << 5); R = (st >> 1) * 16 + swz / 64; C = (st & 1) * 32 + (swz % 64) / 2; }
__device__ __forceinline__ int perm32(int rho) { const int n = rho >> 4, i = rho & 15; return 8 * (i >> 2) + 4 * n + (i & 3); }
typedef __bf16 bf16x2_t __attribute__((ext_vector_type(2)));
__device__ __forceinline__ unsigned cvt_pk_bf16(float lo, float hi) { const f32x2 v = {lo, hi}; const bf16x2_t b = __builtin_convertvector(v, bf16x2_t); return __builtin_bit_cast(unsigned, b); }

struct Unit { int rt, pn, e, rb, rows; };

struct Sched {
    int nM, nN, nwg, G, c;
    __device__ __forceinline__ void init(int nM_, int nN_, int G_, int c_) { nM = nM_; nN = nN_; nwg = nM * nN; G = G_; c = c_; }
    __device__ __forceinline__ bool next(int i, int& pm, int& pn) const {
        const long L = (long)i * G + c; if (L >= nwg) return false;
        int wgid = (int)L; { const int q = nwg / 8, r = nwg % 8, xcd = wgid % 8, off = wgid / 8; wgid = (xcd < r ? xcd * (q + 1) : r * (q + 1) + (xcd - r) * q) + off; }
        const int nig = 8 * nN, gid = wgid / nig, fm = gid * 8, gsz = (nM - fm) < 8 ? (nM - fm) : 8;
        pm = fm + ((wgid % nig) % gsz); pn = (wgid % nig) / gsz; return true;
    }
};

typedef int v8i_t __attribute__((ext_vector_type(8)));
template <class P, bool F8 = false>
__device__ __forceinline__ void gemm_phase(LAS unsigned char* lds, const P& p) {
    const int tid = threadIdx.x, wid = __builtin_amdgcn_readfirstlane(tid >> 6), lane = tid & 63, wr = wid >> 2, wc = wid & 3, fr = lane & 15, fq = lane >> 4;
    const int K = p.K, RB = F8 ? K : 2 * K, nt = RB / (BK * 2);
    unsigned voffB[2];
#pragma unroll
    for (int i = 0; i < 2; ++i) { int R_, C_; stage_rc(tid * 16 + i * 8192, R_, C_); const int Rb = (R_ & ~31) + perm32(R_ & 31); voffB[i] = (unsigned)(Rb * RB + C_ * 2); }
#define PG8_AOFF(unit, dst) do { int R[2], C[2]; asm volatile("" ::: "memory"); _Pragma("unroll") for (int i_ = 0; i_ < 2; ++i_) stage_rc(tid * 16 + i_ * 8192, R[i_], C[i_]); p.a_off(unit, R, C, dst); } while (0)
    const size_t kstep = (size_t)(BK * 2);
    const size_t hstep = (size_t)HALF * RB;
    const unsigned ldsw = (unsigned)wid * 1024u;
    const int aoff = lds_byte(wr * 64 + fr, fq * 8), boff = lds_byte(wc * 32 + fr, fq * 8);
#define PG8_SA(b, h) (((b) * 2 + (h)) * HTB)
#define PG8_SB(b, h) ((4 + (b) * 2 + (h)) * HTB)
#define PG8_STAGE(bufoff, gbase, voff) do { _Pragma("unroll") for (int _i = 0; _i < 2; ++_i) \
        __builtin_amdgcn_global_load_lds((const unsigned*)((const char*)(gbase) + (voff)[_i]), (LAS unsigned*)(lds + (bufoff) + ldsw + _i * 8192), 16, 0, 0); } while (0)
#define PG8_LDA(dst, b, h) do { _Pragma("unroll") for (int m = 0; m < 4; ++m) { const v4i_t l_ = *(const LAS v4i_t*)(lds + PG8_SA(b, h) + aoff + m * 2048), h_ = *(const LAS v4i_t*)(lds + PG8_SA(b, h) + aoff + m * 2048 + 1024); dst[m] = __builtin_shufflevector(l_, h_, 0, 1, 2, 3, 4, 5, 6, 7); } } while (0)
#define PG8_LDB(dst, b, h) do { _Pragma("unroll") for (int n = 0; n < 2; ++n) { const v4i_t l_ = *(const LAS v4i_t*)(lds + PG8_SB(b, h) + boff + n * 2048), h_ = *(const LAS v4i_t*)(lds + PG8_SB(b, h) + boff + n * 2048 + 1024); dst[n] = __builtin_shufflevector(l_, h_, 0, 1, 2, 3, 4, 5, 6, 7); } } while (0)
#define PG8_HALF(x, k) __builtin_bit_cast(bf16x8, __builtin_shufflevector(x, x, 4 * (k), 4 * (k) + 1, 4 * (k) + 2, 4 * (k) + 3))
#define PG8_MMA(ai, bj, At, Bt) do { __builtin_amdgcn_s_setprio(1); \
        if constexpr (F8) { _Pragma("unroll") for (int m = 0; m < 4; ++m) _Pragma("unroll") for (int n = 0; n < 2; ++n) \
            asm volatile("v_mfma_scale_f32_16x16x128_f8f6f4 %0, %1, %2, %0, %3, %3 op_sel_hi:[0,0,0]" : "+v"(acc[ai][bj][m][n]) : "v"(Bt[n]), "v"(At[m]), "v"(mxs)); } \
        else { _Pragma("unroll") for (int m = 0; m < 4; ++m) _Pragma("unroll") for (int n = 0; n < 2; ++n) { \
            acc[ai][bj][m][n] = __builtin_amdgcn_mfma_f32_16x16x32_bf16(PG8_HALF(Bt[n], 0), PG8_HALF(At[m], 0), acc[ai][bj][m][n], 0, 0, 0); \
            acc[ai][bj][m][n] = __builtin_amdgcn_mfma_f32_16x16x32_bf16(PG8_HALF(Bt[n], 1), PG8_HALF(At[m], 1), acc[ai][bj][m][n], 0, 0, 0); } } \
        __builtin_amdgcn_s_setprio(0); } while (0)
#define PG8_WAIT_V(n) asm volatile("s_waitcnt vmcnt(" #n ")" ::: "memory")
#define PG8_WAIT_L(n) asm volatile("s_waitcnt lgkmcnt(" #n ")" ::: "memory")
#define PG8_BAR __builtin_amdgcn_s_barrier()
#define PG8_SCHED __builtin_amdgcn_sched_barrier(0)
    Unit cur, nxt; int ui = 0;
    if (!p.next(0, cur)) return;
    unsigned mxs = 0x7f7f7f7fu; asm volatile("" : "+v"(mxs));
    f32x4 acc[2][2][4][2];
#pragma unroll
    for (int a = 0; a < 2; ++a)
#pragma unroll
        for (int b = 0; b < 2; ++b)
#pragma unroll
            for (int m = 0; m < 4; ++m)
#pragma unroll
                for (int n = 0; n < 2; ++n) acc[a][b][m][n] = (f32x4){0.f, 0.f, 0.f, 0.f};
    typedef int v4i_t __attribute__((ext_vector_type(4)));
    v8i_t At[4], B0[2], B1[2];
    unsigned oA[2][2];
    PG8_AOFF(cur, oA);
    const char* cA = p.a_base(cur); const char* cB = p.b_base(cur);
    PG8_STAGE(PG8_SB(0, 0), cB, voffB); PG8_STAGE(PG8_SB(0, 1), cB + hstep, voffB); PG8_STAGE(PG8_SA(0, 0), cA, oA[0]); PG8_STAGE(PG8_SA(0, 1), cA, oA[1]);
    if (wr == 1) PG8_BAR;
    PG8_WAIT_V(2); PG8_BAR;
    PG8_STAGE(PG8_SB(1, 0), cB + kstep, voffB); PG8_STAGE(PG8_SA(1, 0), cA + kstep, oA[0]); PG8_STAGE(PG8_SB(1, 1), cB + hstep + kstep, voffB);
    PG8_WAIT_V(6); PG8_BAR;
    LAS v4u* park = (LAS v4u*)(lds + STAGE_BYTES) + tid;
    for (;;) {
        const bool has_next = p.next(ui + 1, nxt);
        const char* nA = cA; const char* nB = cB;
        { unsigned nO[2][2];
#pragma unroll
          for (int h = 0; h < 2; ++h)
#pragma unroll
              for (int i = 0; i < 2; ++i) nO[h][i] = oA[h][i];
          if (has_next) { nA = p.a_base(nxt); nB = p.b_base(nxt); PG8_AOFF(nxt, nO); }
          *park = (v4u){nO[0][0], nO[0][1], nO[1][0], nO[1][1]}; }
        for (int t = 0; t < nt; t += 2) {
            const bool last = (t == nt - 2);
            const char* a1 = cA + (size_t)(t + 1) * kstep;
            const char* a2 = last ? nA : cA + (size_t)(t + 2) * kstep; const char* b2 = last ? nB : cB + (size_t)(t + 2) * kstep;
            const char* a3 = a2 + kstep; const char* b3 = b2 + kstep;
            unsigned o2[2][2];
#pragma unroll
            for (int h = 0; h < 2; ++h)
#pragma unroll
                for (int i = 0; i < 2; ++i) o2[h][i] = oA[h][i];
            if (last) { const v4u q_ = *park; o2[0][0] = q_.x; o2[0][1] = q_.y; o2[1][0] = q_.z; o2[1][1] = q_.w; }
            PG8_LDB(B0, 0, 0); PG8_LDB(B1, 0, 1); PG8_SCHED; PG8_LDA(At, 0, 0); PG8_STAGE(PG8_SA(1, 1), a1, oA[1]);
            PG8_WAIT_V(8); PG8_WAIT_L(0); PG8_BAR; PG8_MMA(0, 0, At, B0); PG8_MMA(0, 1, At, B1); PG8_BAR; PG8_SCHED;
            PG8_LDA(At, 0, 1); PG8_STAGE(PG8_SB(0, 0), b2, voffB); PG8_STAGE(PG8_SB(0, 1), b2 + hstep, voffB); PG8_STAGE(PG8_SA(0, 0), a2, o2[0]);
            PG8_WAIT_V(8); PG8_WAIT_L(0); PG8_BAR; PG8_MMA(1, 0, At, B0); PG8_MMA(1, 1, At, B1); PG8_BAR; PG8_SCHED;
            PG8_LDB(B0, 1, 0); PG8_LDB(B1, 1, 1); PG8_SCHED; PG8_LDA(At, 1, 0); PG8_STAGE(PG8_SA(0, 1), a2, o2[1]);
            PG8_WAIT_V(8); PG8_WAIT_L(0); PG8_BAR; PG8_MMA(0, 0, At, B0); PG8_MMA(0, 1, At, B1); PG8_BAR; PG8_SCHED;
            PG8_LDA(At, 1, 1); PG8_STAGE(PG8_SB(1, 0), b3, voffB); PG8_STAGE(PG8_SB(1, 1), b3 + hstep, voffB); PG8_STAGE(PG8_SA(1, 0), a3, o2[0]);
            PG8_WAIT_V(8); PG8_WAIT_L(0); PG8_BAR; PG8_MMA(1, 0, At, B0); PG8_MMA(1, 1, At, B1); PG8_BAR; PG8_SCHED;
        }
        if (wr == 0) PG8_BAR;
        if constexpr (F8) asm volatile("s_nop 15\n\ts_nop 15" ::: "memory");
        p.epi(acc, cur, wr, wc, fr, fq);
        if (!has_next) break;
#pragma unroll
        for (int a = 0; a < 2; ++a)
#pragma unroll
            for (int b = 0; b < 2; ++b)
#pragma unroll
                for (int m = 0; m < 4; ++m)
#pragma unroll
                    for (int n = 0; n < 2; ++n) acc[a][b][m][n] = (f32x4){0.f, 0.f, 0.f, 0.f};
        cur = nxt; cA = nA; cB = nB; ++ui;
        { const v4u q_ = *park; oA[0][0] = q_.x; oA[0][1] = q_.y; oA[1][0] = q_.z; oA[1][1] = q_.w; }
        if (wr == 1) PG8_BAR;
    }
    PG8_WAIT_V(0);
    PG8_BAR;
#undef PG8_SA
#undef PG8_SB
#undef PG8_STAGE
#undef PG8_LDA
#undef PG8_LDB
#undef PG8_MMA
#undef PG8_HALF
#undef PG8_AOFF
#undef PG8_WAIT_V
#undef PG8_WAIT_L
#undef PG8_BAR
#undef PG8_SCHED
}
}

#define XB_TMO      128
#define XB_XCNT(j)  (256  + 64 * (j))
#define XB_XSUB(j)  (1280 + 64 * (j))
#define XB_XGEN(j)  (2304 + 64 * (j))
#define XB_TOP      3328
#define XB_TOPGEN   3392
#define XCD_BAR_WORDS 3456
#define XB_SPIN_CAP (1u << 18)
__device__ __forceinline__ unsigned xb_ld(unsigned* p)              { return __hip_atomic_load(p, __ATOMIC_RELAXED, __HIP_MEMORY_SCOPE_AGENT); }
__device__ __forceinline__ unsigned xb_add(unsigned* p, unsigned v) { return __hip_atomic_fetch_add(p, v, __ATOMIC_RELAXED, __HIP_MEMORY_SCOPE_AGENT); }
__device__ __forceinline__ unsigned xb_xcc_id() { return (unsigned)__builtin_amdgcn_s_getreg((3 << 11) | 20) & 0xFu; }
#define XB_SPIN(cond, bar) do { unsigned _sp = 0; while (cond) { __builtin_amdgcn_s_sleep(1); \
    if ((++_sp & 255u) == 0u) { if (xb_ld(&(bar)[XB_TMO])) break; if (_sp > XB_SPIN_CAP) { atomicAdd(&(bar)[XB_TMO], 1u); break; } } } } while (0)
struct XcdBarrier { unsigned* bar; unsigned x; volatile LAS unsigned* st; };
__device__ __forceinline__ XcdBarrier xcd_barrier_post(unsigned* bar, volatile LAS unsigned* st) {
    XcdBarrier b; b.bar = bar; b.x = xb_xcc_id(); b.st = st;
    if (threadIdx.x == 0) (void)xb_add(&bar[XB_XCNT(b.x)], 1u);
    return b;
}
__device__ __forceinline__ void xcd_barrier_complete(unsigned* bar, unsigned x, unsigned& nloc, unsigned& nx) {
    const unsigned G = gridDim.x * gridDim.y * gridDim.z;
    unsigned sum, cnt, mine, sp = 0u;
    for (;;) {
        sum = 0u; cnt = 0u; mine = 0u;
#pragma unroll
        for (unsigned j = 0; j < 16; ++j) { const unsigned c = xb_ld(&bar[XB_XCNT(j)]); sum += c; cnt += (c > 0u) ? 1u : 0u; mine = (j == x) ? c : mine; }
        if (sum == G) break;
        __builtin_amdgcn_s_sleep(1);
        if ((++sp & 255u) == 0u) { if (xb_ld(&bar[XB_TMO])) break; if (sp > XB_SPIN_CAP) { atomicAdd(&bar[XB_TMO], 1u); break; } }
    }
    nloc = mine > 0u ? mine : 1u; nx = cnt > 0u ? cnt : 1u;
}
__device__ __forceinline__ void xcd_barrier(const XcdBarrier& b) {
    asm volatile("s_waitcnt vmcnt(0)" ::: "memory");
    __syncthreads();
    if (threadIdx.x == 0) {
        unsigned* bar = b.bar;
        __builtin_amdgcn_s_waitcnt(0);
        unsigned nloc = b.st[0], nx = b.st[1];
        if (nloc == 0u) { xcd_barrier_complete(bar, b.x, nloc, nx); b.st[0] = nloc; b.st[1] = nx; }
        const unsigned old = xb_add(&bar[XB_XSUB(b.x)], 1u);
        const unsigned gen = old / nloc;
        if (old + 1u == (gen + 1u) * nloc) {
            __builtin_amdgcn_fence(__ATOMIC_RELEASE, "agent");
            asm volatile("s_waitcnt vmcnt(0)" ::: "memory");
            const unsigned og = xb_add(&bar[XB_TOP], 1u);
            const unsigned tg = og / nx;
            if (og + 1u == (tg + 1u) * nx) xb_add(&bar[XB_TOPGEN], 1u);
            else XB_SPIN(xb_ld(&bar[XB_TOPGEN]) == tg, bar);
            __builtin_amdgcn_fence(__ATOMIC_ACQUIRE, "agent");
            xb_add(&bar[XB_XGEN(b.x)], 1u);
            asm volatile("s_waitcnt vmcnt(0)" ::: "memory");
        } else {
            XB_SPIN(xb_ld(&bar[XB_XGEN(b.x)]) == gen, bar);
            __builtin_amdgcn_fence(__ATOMIC_ACQUIRE, "agent");
            asm volatile("s_waitcnt vmcnt(0)" ::: "memory");
        }
    }
    __syncthreads();
}

struct Frame {
    LAS unsigned char* lds;
    int tid, lane, wave, vcu, G;
    const float* in[18];
    float* out;
    unsigned char* ws;
};
using pg8::Unit;
using pg8::cvt_pk_bf16;

struct ProbBase {
    int K; int RB; pg8::Sched S;
    __device__ __forceinline__ void lin_off(const int (&R)[2], const int (&C)[2], unsigned (&off)[2][2]) const {
#pragma unroll
        for (int h = 0; h < 2; ++h)
#pragma unroll
            for (int i = 0; i < 2; ++i) off[h][i] = (unsigned)((h * 128 + R[i]) * RB + C[i] * 2);
    }
};
struct ProbIn : ProbBase {
    const bf16* A; const bf16* Bt; bf16* O; const float* rs;
    __device__ __forceinline__ bool next(int i, Unit& u) const { int pm, pn; if (!S.next(i, pm, pn)) return false; u.rt = pm; u.pn = pn; u.e = 0; u.rb = pm; u.rows = 256; return true; }
    __device__ __forceinline__ const char* a_base(const Unit& u) const { return (const char*)A + (size_t)u.rt * 256 * RB; }
    __device__ __forceinline__ const char* b_base(const Unit& u) const { return (const char*)Bt + (size_t)u.pn * 256 * RB; }
    __device__ __forceinline__ void a_off(const Unit&, const int (&R)[2], const int (&C)[2], unsigned (&off)[2][2]) const { lin_off(R, C, off); }
    __device__ __forceinline__ void epi(const f32x4 (&acc)[2][2][4][2], const Unit& u, int wr, int wc, int fr, int fq) const {
        const int row0 = u.rt * 256 + wr * 64 + fr, col0 = u.pn * 256 + wc * 32 + 8 * fq;
#pragma unroll
        for (int ai = 0; ai < 2; ++ai)
#pragma unroll
            for (int m = 0; m < 4; ++m) { const int row = row0 + ai * 128 + m * 16; const float sc = rs[row]; bf16* rowp = O + (size_t)row * NPROJ + col0;
#pragma unroll
                for (int bj = 0; bj < 2; ++bj) { const f32x4 v0 = acc[ai][bj][m][0] * sc, v1 = acc[ai][bj][m][1] * sc; v4u w;
                    w.x = cvt_pk_bf16(v0[0], v0[1]); w.y = cvt_pk_bf16(v0[2], v0[3]); w.z = cvt_pk_bf16(v1[0], v1[1]); w.w = cvt_pk_bf16(v1[2], v1[3]);
                    *(v4u*)(rowp + bj * 128) = w; } }
    }
};
struct ProbPool : ProbBase {
    const bf16* A; const bf16* Bt; bf16* O;
    __device__ __forceinline__ bool next(int i, Unit& u) const { int pm, pn; if (!S.next(i, pm, pn)) return false; u.rt = pm; u.pn = pn; u.e = 0; u.rb = pm; u.rows = 256; return true; }
    __device__ __forceinline__ const char* a_base(const Unit& u) const { return (const char*)A + (size_t)u.rt * 256 * RB; }
    __device__ __forceinline__ const char* b_base(const Unit& u) const { return (const char*)Bt + (size_t)u.pn * 256 * RB; }
    __device__ __forceinline__ void a_off(const Unit&, const int (&R)[2], const int (&C)[2], unsigned (&off)[2][2]) const { lin_off(R, C, off); }
    __device__ __forceinline__ void epi(const f32x4 (&acc)[2][2][4][2], const Unit& u, int wr, int wc, int fr, int fq) const {
        const int row0 = u.rt * 256 + wr * 64 + fr, col0 = 512 + u.pn * 256 + wc * 32 + 8 * fq;
#pragma unroll
        for (int ai = 0; ai < 2; ++ai)
#pragma unroll
            for (int m = 0; m < 4; ++m) { const int row = row0 + ai * 128 + m * 16; bf16* rowp = O + (size_t)row * DM + col0;
#pragma unroll
                for (int bj = 0; bj < 2; ++bj) { const f32x4 v0 = acc[ai][bj][m][0], v1 = acc[ai][bj][m][1]; v4u w;
                    w.x = cvt_pk_bf16(v0[0], v0[1]); w.y = cvt_pk_bf16(v0[2], v0[3]); w.z = cvt_pk_bf16(v1[0], v1[1]); w.w = cvt_pk_bf16(v1[2], v1[3]);
                    *(v4u*)(rowp + bj * 128) = w; } }
    }
};
struct ProbOut : ProbBase {
    const bf16* A; const bf16* Bt; const float* X; float* O;
    __device__ __forceinline__ bool next(int i, Unit& u) const { int pm, pn; if (!S.next(i, pm, pn)) return false; u.rt = pm; u.pn = pn; u.e = 0; u.rb = pm; u.rows = 256; return true; }
    __device__ __forceinline__ const char* a_base(const Unit& u) const { return (const char*)A + (size_t)u.rt * 256 * RB; }
    __device__ __forceinline__ const char* b_base(const Unit& u) const { return (const char*)Bt + (size_t)u.pn * 256 * RB; }
    __device__ __forceinline__ void a_off(const Unit&, const int (&R)[2], const int (&C)[2], unsigned (&off)[2][2]) const { lin_off(R, C, off); }
    __device__ __forceinline__ void epi(const f32x4 (&acc)[2][2][4][2], const Unit& u, int wr, int wc, int fr, int fq) const {
        const int row0 = u.rt * 256 + wr * 64 + fr, col0 = u.pn * 256 + wc * 32 + 8 * fq;
#pragma unroll
        for (int ai = 0; ai < 2; ++ai)
#pragma unroll
            for (int m = 0; m < 4; ++m) { const size_t off = (size_t)(row0 + ai * 128 + m * 16) * DM + col0;
#pragma unroll
                for (int bj = 0; bj < 2; ++bj)
#pragma unroll
                    for (int n = 0; n < 2; ++n) { const f32x4 xv = *(const f32x4*)(X + off + bj * 128 + 4 * n); *(f32x4*)(O + off + bj * 128 + 4 * n) = xv + acc[ai][bj][m][n]; } }
    }
};
struct MoeTab { const LAS int* pref; const LAS int* cnt; };
__device__ __forceinline__ void moe_decode(const MoeTab& T, int rt, Unit& u) {
    int e = 0;
#pragma unroll 1
    for (int j = 1; j < NE; ++j) if (T.pref[j] <= rt) e = j;
    u.e = e; u.rb = rt - T.pref[e]; const int left = T.cnt[e] - u.rb * 256; u.rows = left < 256 ? left : 256;
}
struct ProbGU : ProbBase {
    MoeTab T; const unsigned char* A; const unsigned char* Bt; unsigned char* O; const int* list; const float* rs2; const float* bgu;
    __device__ __forceinline__ bool next(int i, Unit& u) const { int pm, pn; if (!S.next(i, pm, pn)) return false; u.rt = pm; u.pn = pn; moe_decode(T, pm, u); return true; }
    __device__ __forceinline__ const char* a_base(const Unit&) const { return (const char*)A; }
    __device__ __forceinline__ const char* b_base(const Unit& u) const { return (const char*)Bt + ((size_t)u.e * 2048 + (size_t)u.pn * 256) * RB; }
    __device__ __forceinline__ void a_off(const Unit& u, const int (&R)[2], const int (&C)[2], unsigned (&off)[2][2]) const {
        const int* lp = list + (size_t)u.e * LISTCAP + u.rb * 256;
#pragma unroll
        for (int h = 0; h < 2; ++h)
#pragma unroll
            for (int i = 0; i < 2; ++i) { const int r = h * 128 + R[i]; const int ent = (r < u.rows) ? lp[r] : 0; off[h][i] = (unsigned)(ent >> 2) * (unsigned)RB + (unsigned)C[i] * 2u; }
    }
    __device__ __forceinline__ void epi(const f32x4 (&acc)[2][2][4][2], const Unit& u, int wr, int wc, int fr, int fq) const {
        const float* rsp = rs2 + (size_t)u.e * LISTCAP + u.rb * 256;
        const int j0 = wc * 32 + 8 * fq;
        const float* bg = bgu + (size_t)u.e * 2048 + u.pn * 256 + j0;
        f32x4 bgv[2], buv[2];
#pragma unroll
        for (int n = 0; n < 2; ++n) { bgv[n] = *(const f32x4*)(bg + 4 * n); buv[n] = *(const f32x4*)(bg + 128 + 4 * n); }
#pragma unroll
        for (int ai = 0; ai < 2; ++ai)
#pragma unroll
            for (int m = 0; m < 4; ++m) { const int r = ai * 128 + wr * 64 + m * 16 + fr;
                if (r < u.rows) { const float sc = rsp[r] * W8_INV; unsigned w[2];
#pragma unroll
                    for (int n = 0; n < 2; ++n) { float a[4];
#pragma unroll
                        for (int q = 0; q < 4; ++q) { float gt = acc[ai][0][m][n][q] * sc + bgv[n][q], up = acc[ai][1][m][n][q] * sc + buv[n][q];
                            gt = fminf(gt, 7.f); up = fminf(fmaxf(up, -7.f), 7.f); a[q] = (up + 1.f) * gt * frcp_(1.f + fexp_(-1.702f * gt)); }
                        w[n] = pk4_fp8(a[0], a[1], a[2], a[3]); }
                    *(v2u*)(O + (size_t)(u.rt * 256 + r) * DE + u.pn * 128 + j0) = (v2u){w[0], w[1]}; } }
    }
};
struct ProbDown : ProbBase {
    MoeTab T; const unsigned char* A; const unsigned char* Bt; unsigned char* O; const int* list; const float* gw; const float* bd;
    __device__ __forceinline__ bool next(int i, Unit& u) const { int pm, pn; if (!S.next(i, pm, pn)) return false; u.rt = pm; u.pn = pn; moe_decode(T, pm, u); return true; }
    __device__ __forceinline__ const char* a_base(const Unit& u) const { return (const char*)A + (size_t)u.rt * 256 * RB; }
    __device__ __forceinline__ const char* b_base(const Unit& u) const { return (const char*)Bt + ((size_t)u.e * 1024 + (size_t)u.pn * 256) * RB; }
    __device__ __forceinline__ void a_off(const Unit&, const int (&R)[2], const int (&C)[2], unsigned (&off)[2][2]) const { lin_off(R, C, off); }
    __device__ __forceinline__ void epi(const f32x4 (&acc)[2][2][4][2], const Unit& u, int wr, int wc, int fr, int fq) const {
        const int* lp = list + (size_t)u.e * LISTCAP + u.rb * 256;
        const int c0 = u.pn * 256 + wc * 32 + 8 * fq;
        const float* gwp = gw + (size_t)u.e * LISTCAP + u.rb * 256;
        const float* bp = bd + (size_t)u.e * DM + c0;
        f32x4 bv[2][2];
#pragma unroll
        for (int bj = 0; bj < 2; ++bj)
#pragma unroll
            for (int n = 0; n < 2; ++n) bv[bj][n] = *(const f32x4*)(bp + bj * 128 + 4 * n);
#pragma unroll
        for (int ai = 0; ai < 2; ++ai)
#pragma unroll
            for (int m = 0; m < 4; ++m) { const int r = ai * 128 + wr * 64 + m * 16 + fr;
                if (r < u.rows) { const int ent = lp[r]; const float g = gwp[r]; unsigned char* rowp = O + (size_t)ent * DM + c0;
#pragma unroll
                    for (int bj = 0; bj < 2; ++bj) { const f32x4 v0 = (acc[ai][bj][m][0] * W8_INV + bv[bj][0]) * g, v1 = (acc[ai][bj][m][1] * W8_INV + bv[bj][1]) * g;
                        *(v2u*)(rowp + bj * 128) = (v2u){pk4_fp8(v0[0] * SLAB_SCALE, v0[1] * SLAB_SCALE, v0[2] * SLAB_SCALE, v0[3] * SLAB_SCALE), pk4_fp8(v1[0] * SLAB_SCALE, v1[1] * SLAB_SCALE, v1[2] * SLAB_SCALE, v1[3] * SLAB_SCALE)}; } } }
    }
};

typedef short v4i16_t __attribute__((ext_vector_type(4)));
__device__ __forceinline__ void tr_item(const float* W, int ldw, int k0, int nsrc0, bf16* WT, size_t drow0, int ldk, int dk0, const float* ks, const float* ns, LAS unsigned char* scr, int lane) {
    const int kr = lane >> 4, n4 = (lane & 15) * 4;
    f32x4 nsc = (f32x4){1.f, 1.f, 1.f, 1.f}; if (ns) nsc = *(const f32x4*)(ns + nsrc0 + n4);
    f32x4 v[16];
#pragma unroll
    for (int i = 0; i < 16; ++i) v[i] = *(const f32x4*)(W + (size_t)(k0 + 4 * i + kr) * ldw + nsrc0 + n4);
#pragma unroll
    for (int i = 0; i < 16; ++i) { f32x4 x = v[i] * nsc; if (ks) x = x * ks[k0 + 4 * i + kr];
        *(LAS v2u*)(scr + (4 * i + kr) * 192 + n4 * 2) = (v2u){pg8::cvt_pk_bf16(x.x, x.y), pg8::cvt_pk_bf16(x.z, x.w)}; }
    LDS_WAIT(); asm volatile("" ::: "memory");
    const int G = lane >> 4, li = lane & 15, q = li >> 2, p = li & 3;
    const LAS unsigned char* rb = scr + q * 192 + (16 * G + 4 * p) * 2;
    bf16* dst = WT + (drow0 + 16 * G + li) * (size_t)ldk + dk0 + k0;
#pragma unroll
    for (int kc = 0; kc < 8; ++kc) {
        const v4i16_t lo = __builtin_amdgcn_ds_read_tr16_b64_v4i16((LAS v4i16_t*)(rb + (8 * kc) * 192));
        const v4i16_t hi = __builtin_amdgcn_ds_read_tr16_b64_v4i16((LAS v4i16_t*)(rb + (8 * kc + 4) * 192));
        const v2u l2 = __builtin_bit_cast(v2u, lo), h2 = __builtin_bit_cast(v2u, hi);
        *(v4u*)(dst + 8 * kc) = (v4u){l2.x, l2.y, h2.x, h2.y};
    }
    LDS_WAIT(); asm volatile("" ::: "memory");
}

template <int KT, int NT>
__device__ __forceinline__ void tr_item8(const float* W, int ldw, int k0, int nsrc0, unsigned char* WT, size_t drow0, int ldk, const float* ks, float mul, LAS unsigned char* scr, int lane) {
    constexpr int LPR = NT / 4, RPL = 64 / LPR, PA = NT * 2 + 64;
    static_assert(KT * NT == 4096 && (PA / 4) % 32 == 16, "tile geometry");
    const int kr = lane / LPR, n4 = (lane % LPR) * 4;
    f32x4 v[16];
#pragma unroll
    for (int i = 0; i < 16; ++i) v[i] = *(const f32x4*)(W + (size_t)(k0 + RPL * i + kr) * ldw + nsrc0 + n4);
#pragma unroll
    for (int i = 0; i < 16; ++i) { const float sc = ks ? ks[k0 + RPL * i + kr] * mul : mul; const f32x4 x = v[i] * sc;
        *(LAS v2u*)(scr + (RPL * i + kr) * PA + n4 * 2) = (v2u){pg8::cvt_pk_bf16(x.x, x.y), pg8::cvt_pk_bf16(x.z, x.w)}; }
    LDS_WAIT(); asm volatile("" ::: "memory");
    const int G = lane >> 4, li = lane & 15, q = li >> 2, p = li & 3;
#pragma unroll
    for (int ps = 0; ps < NT / 64; ++ps) {
        const LAS unsigned char* rb = scr + q * PA + (16 * (G + 4 * ps) + 4 * p) * 2;
        unsigned char* dst = WT + (drow0 + 16 * (G + 4 * ps) + li) * (size_t)ldk + k0;
#pragma unroll
        for (int kq = 0; kq < KT / 16; ++kq) {
            v2u t[4];
#pragma unroll
            for (int u = 0; u < 4; ++u) t[u] = __builtin_bit_cast(v2u, __builtin_amdgcn_ds_read_tr16_b64_v4i16((LAS v4i16_t*)(rb + (16 * kq + 4 * u) * PA)));
            v4u o;
            o.x = pk4_fp8(bflo(t[0].x), bfhi(t[0].x), bflo(t[0].y), bfhi(t[0].y)); o.y = pk4_fp8(bflo(t[1].x), bfhi(t[1].x), bflo(t[1].y), bfhi(t[1].y));
            o.z = pk4_fp8(bflo(t[2].x), bfhi(t[2].x), bflo(t[2].y), bfhi(t[2].y)); o.w = pk4_fp8(bflo(t[3].x), bfhi(t[3].x), bflo(t[3].y), bfhi(t[3].y));
            *(v4u*)(dst + 16 * kq) = o;
        }
    }
    LDS_WAIT(); asm volatile("" ::: "memory");
}

constexpr int TRF_T1 = 128 * 192, TRF_T2 = 64 * 144, TRF_BYTES = TRF_T1 + TRF_T2;
__device__ __forceinline__ void tr_item8f(const float* W, int ldw, int k0, int nsrc0, unsigned char* WT, size_t drow0, int ldk, const float* ks, float mul, LAS unsigned char* scr, int lane) {
    const int kr = lane >> 4, n4 = (lane & 15) * 4;
#pragma unroll
    for (int hb = 0; hb < 2; ++hb) {
        f32x4 v[16];
#pragma unroll
        for (int i = 0; i < 16; ++i) v[i] = *(const f32x4*)(W + (size_t)(k0 + 64 * hb + 4 * i + kr) * ldw + nsrc0 + n4);
#pragma unroll
        for (int i = 0; i < 16; ++i) { const float sc = ks ? ks[k0 + 64 * hb + 4 * i + kr] * mul : mul; const f32x4 x = v[i] * sc;
            *(LAS v2u*)(scr + (64 * hb + 4 * i + kr) * 192 + n4 * 2) = (v2u){pg8::cvt_pk_bf16(x.x, x.y), pg8::cvt_pk_bf16(x.z, x.w)}; }
    }
    LDS_WAIT(); asm volatile("" ::: "memory");
    const int G = lane >> 4, li = lane & 15, q = li >> 2, p = li & 3;
    const LAS unsigned char* rb = scr + q * 192 + (16 * G + 4 * p) * 2;
    LAS unsigned char* t2 = scr + TRF_T1;
#pragma unroll
    for (int kq = 0; kq < 8; ++kq) {
        v2u t[4];
#pragma unroll
        for (int u = 0; u < 4; ++u) t[u] = __builtin_bit_cast(v2u, __builtin_amdgcn_ds_read_tr16_b64_v4i16((LAS v4i16_t*)(rb + (16 * kq + 4 * u) * 192)));
        v4u o;
        o.x = pk4_fp8(bflo(t[0].x), bfhi(t[0].x), bflo(t[0].y), bfhi(t[0].y)); o.y = pk4_fp8(bflo(t[1].x), bfhi(t[1].x), bflo(t[1].y), bfhi(t[1].y));
        o.z = pk4_fp8(bflo(t[2].x), bfhi(t[2].x), bflo(t[2].y), bfhi(t[2].y)); o.w = pk4_fp8(bflo(t[3].x), bfhi(t[3].x), bflo(t[3].y), bfhi(t[3].y));
        *(LAS v4u*)(t2 + (16 * G + li) * 144 + 16 * kq) = o;
    }
    LDS_WAIT(); asm volatile("" ::: "memory");
    const int r8 = lane >> 3, c8 = lane & 7;
#pragma unroll
    for (int j = 0; j < 8; ++j) { const v4u o = *(const LAS v4u*)(t2 + (8 * j + r8) * 144 + 16 * c8);
        *(v4u*)(WT + (drow0 + 8 * j + r8) * (size_t)ldk + k0 + 16 * c8) = o; }
    LDS_WAIT(); asm volatile("" ::: "memory");
}

constexpr int TRK = 128, TRN = 64;
constexpr int MOE_PREP_ITEMS = 32 * (1024 / TRK) * (2048 / TRN) + 32 * (1024 / TRK) * (1024 / TRN);
__device__ __forceinline__ void moe_weight_prep(Frame& F, int b0, int lo, int hi) {
    const float* fnw = F.in[10]; const float* w_gu = F.in[13]; const float* w_d = F.in[15];
    unsigned char* WguT = F.ws + WS_WGU; unsigned char* WdT = F.ws + WS_WD;
    constexpr int TW = 4;
    if (F.wave >= TW) return;
    LAS unsigned char* scr = F.lds + F.wave * TRF_BYTES;
    const int gw = ((int)blockIdx.x - b0) * TW + F.wave, NGW = (F.G - b0) * TW;
    constexpr int NKB = 1024 / TRK, NNB_GU = 2048 / TRN, NNB_D = 1024 / TRN, SEGN = 128 / TRN;
    constexpr int I_GU = 32 * NKB * NNB_GU;
    for (int it = lo + gw; it < hi; it += NGW) {
        int r = it;
        if (r < I_GU) { const int e = r / (NKB * NNB_GU), r2 = r % (NKB * NNB_GU), kb = r2 / NNB_GU, cb = r2 % NNB_GU;
            const int half = cb / (NNB_GU / 2), t = (cb % (NNB_GU / 2)) / SEGN, nb = cb % SEGN;
            tr_item8f(w_gu + (size_t)e * DM * 2048, 2048, kb * TRK, half * 1024 + t * 128 + nb * TRN, WguT, (size_t)e * 2048 + t * 256 + half * 128 + nb * TRN, DM, fnw, W8_SCALE, scr, F.lane); continue; } r -= I_GU;
        { const int e = r / (NKB * NNB_D), r2 = r % (NKB * NNB_D), kb = r2 / NNB_D, nb = r2 % NNB_D;
          tr_item8f(w_d + (size_t)e * DE * DM, DM, kb * TRK, nb * TRN, WdT, (size_t)e * 1024 + nb * TRN, DE, nullptr, W8_SCALE, scr, F.lane); }
    }
}
static_assert(4 * TRF_BYTES <= LDSCTL_OFF, "transposer LDS");
constexpr int MOE_PREP_SPLIT = 0;

__device__ __forceinline__ void phase_prep(Frame& F) {
    const float* x = F.in[0]; const float* anw = F.in[1]; const float* w_in = F.in[2]; const float* a_log = F.in[4]; const float* dt_bias = F.in[5];
    const float* pool_w = F.in[7]; const float* pool_scale = F.in[8]; const float* w_out = F.in[9]; const float* fnw = F.in[10];
    const float* w_router = F.in[11]; const float* w_gu = F.in[13]; const float* b_gu = F.in[14]; const float* w_d = F.in[15];
    bf16* WinT = (bf16*)(F.ws + WS_WIN); bf16* WoutT = (bf16*)(F.ws + WS_WOUT); bf16* WpoolT = (bf16*)(F.ws + WS_WPOOL);
    bf16* WguT = (bf16*)(F.ws + WS_WGU); bf16* WdT = (bf16*)(F.ws + WS_WD);
    bf16* WrI = (bf16*)(F.ws + WS_WR); float* bguP = (float*)(F.ws + WS_BGU);
    bf16* xb = (bf16*)(F.ws + WS_XB); float* rs1 = (float*)(F.ws + WS_RS1); float* betaA = (float*)(F.ws + WS_BETA); float* gA = (float*)(F.ws + WS_G);
    LAS unsigned char* scr = F.lds + F.wave * 12288;
    LAS float* W8T = (LAS float*)(F.lds + 98304);
    const int gw = F.vcu * NWAVES + F.wave, NGW = F.G * NWAVES;
    const int gt = F.vcu * 512 + F.tid, NGT = F.G * 512;
    for (int idx = F.tid; idx < 8192; idx += 512) { const int k = idx >> 3, c = idx & 7; W8T[c * 1024 + k] = anw[k] * w_in[(size_t)k * DIN + 2048 + c]; }
    __syncthreads();
    constexpr int I_IN1 = 16 * 32, I_OUT = 16 * 16;
    constexpr int NITEMS = I_IN1 + I_OUT;
    for (int it = gw; it < NITEMS; it += NGW) {
        int r = it;
        if (r < I_IN1) { const int kb = r / 32, nb = r % 32; tr_item(w_in, DIN, kb * 64, nb * 64, WinT, (size_t)nb * 64, DM, 0, anw, nullptr, scr, F.lane); continue; } r -= I_IN1;
        { const int kb = r / 16, nb = r % 16; tr_item(w_out, DM, kb * 64, nb * 64, WoutT, (size_t)nb * 64, DM, 0, nullptr, nullptr, scr, F.lane); }
    }
    __syncthreads();
    for (int task = blockIdx.x; task < 256; task += F.G) {
        const int g = task >> 6, kb = (task >> 2) & 15, dq = task & 3;
        LAS float* Wt = (LAS float*)F.lds;
        LAS float* Pw = (LAS float*)(F.lds + 33024);
        for (int idx = F.tid; idx < 64 * 32; idx += 512) { const int k = idx >> 5, c4 = (idx & 31) * 4; const f32x4 v = *(const f32x4*)(w_in + (size_t)(kb * 64 + k) * DIN + 2056 + g * 128 + c4);
            Wt[k * 129 + c4] = v.x; Wt[k * 129 + c4 + 1] = v.y; Wt[k * 129 + c4 + 2] = v.z; Wt[k * 129 + c4 + 3] = v.w; }
        for (int idx = F.tid; idx < 128 * 8; idx += 512) { const int c = idx >> 3, d4 = (idx & 7) * 4; *(LAS f32x4*)(Pw + c * 32 + d4) = *(const f32x4*)(pool_w + (size_t)g * 16384 + c * 128 + dq * 32 + d4); }
        __syncthreads();
        const int k = F.tid & 63, d4 = (F.tid >> 6) * 4;
        f32x4 acc = (f32x4){0.f, 0.f, 0.f, 0.f};
#pragma unroll 8
        for (int c = 0; c < 128; ++c) acc += *(const LAS f32x4*)(Pw + c * 32 + d4) * Wt[k * 129 + c];
        const int n0 = g * 128 + dq * 32 + d4; const f32x4 ps = *(const f32x4*)(pool_scale + n0); const float an = anw[kb * 64 + k];
        bf16* dst = WinT + (size_t)(2048 + n0) * DM + kb * 64 + k;
        dst[0] = (bf16)f2bf(acc.x * ps.x * an); dst[DM] = (bf16)f2bf(acc.y * ps.y * an); dst[2 * DM] = (bf16)f2bf(acc.z * ps.z * an); dst[3 * DM] = (bf16)f2bf(acc.w * ps.w * an);
        __syncthreads();
    }
    moe_weight_prep(F, 0, 0, MOE_PREP_SPLIT);
    for (int idx = gt; idx < NE * 2048; idx += NGT) { const int e = idx >> 11, r = idx & 2047, t = r >> 8, j = r & 255, half = j >> 7, jj = j & 127; bguP[idx] = b_gu[(size_t)e * 2048 + half * 1024 + t * 128 + jj]; }
    for (int idx = gt; idx < 64 * 64 * 8; idx += NGT) { const int j = idx & 7, ln = (idx >> 3) & 63, fr2 = idx >> 9, nb = fr2 & 1, ks = fr2 >> 1;
        const int k = 32 * ks + 8 * (ln >> 4) + j, e = 16 * nb + (ln & 15); const float v = fnw[k] * w_router[(size_t)k * NE + e];
        const unsigned hb = f2bf(v); const float hf = __builtin_bit_cast(float, hb << 16); const unsigned lb = f2bf(v - hf);
        WrI[((size_t)(fr2 * 2 + 0) * 64 + ln) * 8 + j] = (bf16)hb; WrI[((size_t)(fr2 * 2 + 1) * 64 + ln) * 8 + j] = (bf16)lb; }
    for (int m = gw; m < NTOK; m += NGW) {
        const f32x4* xr = (const f32x4*)(x + (size_t)m * DM) + F.lane;
        f32x4 v[4]; float ss = 0.f; float d8[8];
#pragma unroll
        for (int c = 0; c < 8; ++c) d8[c] = 0.f;
#pragma unroll
        for (int j = 0; j < 4; ++j) { v[j] = xr[64 * j]; ss += (v[j].x * v[j].x + v[j].y * v[j].y) + (v[j].z * v[j].z + v[j].w * v[j].w); }
#pragma unroll
        for (int c = 0; c < 8; ++c)
#pragma unroll
            for (int j = 0; j < 4; ++j) { const f32x4 w = *(const LAS f32x4*)(W8T + c * 1024 + 256 * j + 4 * F.lane); d8[c] += (v[j].x * w.x + v[j].y * w.y) + (v[j].z * w.z + v[j].w * w.w); }
        ss = wave_sum(ss);
#pragma unroll
        for (int c = 0; c < 8; ++c) d8[c] = wave_sum(d8[c]);
        const float rs = 1.f / sqrtf(ss * (1.f / DM) + 1e-6f);
        unsigned long long* o8 = (unsigned long long*)(xb + (size_t)m * DM) + F.lane;
#pragma unroll
        for (int j = 0; j < 4; ++j) o8[64 * j] = (unsigned long long)pk2(v[j].x, v[j].y) | ((unsigned long long)pk2(v[j].z, v[j].w) << 32);
        if (F.lane == 0) rs1[m] = rs;
        if (F.lane < 4) {
            float bl = 0.f, al = 0.f;
#pragma unroll
            for (int c = 0; c < 4; ++c) { bl = (F.lane == c) ? d8[c] : bl; al = (F.lane == c) ? d8[4 + c] : al; }
            bl *= rs; al *= rs;
            betaA[(size_t)m * 4 + F.lane] = 1.f / (1.f + expf(-bl));
            const float z = al + dt_bias[F.lane]; const float sp = z > 20.f ? z : log1pf(expf(z));
            gA[(size_t)m * 4 + F.lane] = -expf(a_log[F.lane]) * sp;
        }
    }
}

__device__ __forceinline__ void phase_mix(Frame& F) {
    const bf16* proj = (const bf16*)(F.ws + WS_PROJ); bf16* mixed = (bf16*)(F.ws + WS_CONCAT) + 512;
    const int gw = F.vcu * NWAVES + F.wave, NGW = F.G * NWAVES;
    const int ch = 8 * F.lane, gi = F.lane >> 4, win = 2 << gi, hal = win - 1;
    for (int rbk = gw; rbk < NTOK / 16; rbk += NGW) {
        const int m0 = rbk * 16, t0 = m0 % SEQ;
        v4u X[31];
#pragma unroll
        for (int k = 0; k < 31; ++k) { X[k] = (v4u){0u, 0u, 0u, 0u}; if (k >= 15 - hal && t0 - 15 + k >= 0) X[k] = *(const v4u*)(proj + (size_t)(m0 - 15 + k) * NPROJ + 2048 + ch); }
        float s[8];
#pragma unroll
        for (int q = 0; q < 8; ++q) s[q] = 0.f;
#pragma unroll
        for (int k = 0; k < 15; ++k) { s[0] += bflo(X[k].x); s[1] += bfhi(X[k].x); s[2] += bflo(X[k].y); s[3] += bfhi(X[k].y); s[4] += bflo(X[k].z); s[5] += bfhi(X[k].z); s[6] += bflo(X[k].w); s[7] += bfhi(X[k].w); }
#pragma unroll
        for (int r = 0; r < 16; ++r) {
            const v4u u = X[15 + r];
            const float p[8] = {bflo(u.x), bfhi(u.x), bflo(u.y), bfhi(u.y), bflo(u.z), bfhi(u.z), bflo(u.w), bfhi(u.w)};
#pragma unroll
            for (int q = 0; q < 8; ++q) s[q] += p[q];
            const int tt = t0 + r + 1; const float ic = 1.f / (float)(tt < win ? tt : win);
            v4u o; o.x = pk2(s[0] * ic - p[0], s[1] * ic - p[1]); o.y = pk2(s[2] * ic - p[2], s[3] * ic - p[3]); o.z = pk2(s[4] * ic - p[4], s[5] * ic - p[5]); o.w = pk2(s[6] * ic - p[6], s[7] * ic - p[7]);
            *(v4u*)(mixed + (size_t)(m0 + r) * DM + ch) = o;
            const v4u od = gi == 0 ? X[14 + r] : gi == 1 ? X[12 + r] : gi == 2 ? X[8 + r] : X[r];
            s[0] -= bflo(od.x); s[1] -= bfhi(od.x); s[2] -= bflo(od.y); s[3] -= bfhi(od.y); s[4] -= bflo(od.z); s[5] -= bfhi(od.z); s[6] -= bflo(od.w); s[7] -= bfhi(od.w);
        }
    }
}

typedef float f32x16 __attribute__((ext_vector_type(16)));
__device__ __forceinline__ bf16x8 pack8(const f32x4 a, const f32x4 b) {
    v4u w; w.x = cvt_pk_bf16(a[0], a[1]); w.y = cvt_pk_bf16(a[2], a[3]); w.z = cvt_pk_bf16(b[0], b[1]); w.w = cvt_pk_bf16(b[2], b[3]);
    return __builtin_bit_cast(bf16x8, w);
}
__device__ __forceinline__ void fmac_(float& acc, float a, float b) { asm("v_fmac_f32 %0, %1, %2" : "+v"(acc) : "v"(a), "v"(b)); }
__device__ __forceinline__ float bf2f(unsigned short u) { return __builtin_bit_cast(float, (unsigned)u << 16); }

constexpr int SOLVE_D = 5;
struct RQ { int i, j; };
__host__ __device__ constexpr int solve_nq(int i) { return (i + 3) / 4; }
__host__ __device__ constexpr RQ solve_adv(int i, int j, int d) { while (d-- > 0 && i < 64) { if (j + 1 < solve_nq(i)) ++j; else { ++i; j = 0; } } return RQ{i, j}; }
template <int I, int J> __device__ __forceinline__ void solve_step(float (&U)[64], const LAS float* Am, const f32x4 (&win)[SOLVE_D], float s0, float s1, float s2, float s3) {
    if constexpr (I < 64) {
        constexpr RQ P = solve_adv(I, J, SOLVE_D);
        f32x4 nw = (f32x4){0.f, 0.f, 0.f, 0.f};
        if constexpr (P.i < 64) nw = *(const LAS f32x4*)(Am + P.i * 64 + 4 * P.j);
        const f32x4 a = win[0];
        fmac_(s0, a.x, U[4 * J]); if constexpr (4 * J + 1 < I) fmac_(s1, a.y, U[4 * J + 1]); if constexpr (4 * J + 2 < I) fmac_(s2, a.z, U[4 * J + 2]); if constexpr (4 * J + 3 < I) fmac_(s3, a.w, U[4 * J + 3]);
        f32x4 nx[SOLVE_D];
#pragma unroll
        for (int q = 0; q + 1 < SOLVE_D; ++q) nx[q] = win[q + 1];
        nx[SOLVE_D - 1] = nw;
        __builtin_amdgcn_sched_barrier(0);
        if constexpr (J + 1 < solve_nq(I)) solve_step<I, J + 1>(U, Am, nx, s0, s1, s2, s3);
        else { U[I] -= (s0 + s1) + (s2 + s3); solve_step<I + 1, 0>(U, Am, nx, 0.f, 0.f, 0.f, 0.f); }
    }
}
__device__ __forceinline__ void solve_all(float (&U)[64], const LAS float* Am) {
    f32x4 win[SOLVE_D];
#pragma unroll
    for (int q = 0; q < SOLVE_D; ++q) { constexpr RQ dummy{0, 0}; (void)dummy; }
    { constexpr RQ p0 = solve_adv(1, 0, 0), p1 = solve_adv(1, 0, 1), p2 = solve_adv(1, 0, 2), p3 = solve_adv(1, 0, 3), p4 = solve_adv(1, 0, 4);
      win[0] = *(const LAS f32x4*)(Am + p0.i * 64 + 4 * p0.j); win[1] = *(const LAS f32x4*)(Am + p1.i * 64 + 4 * p1.j); win[2] = *(const LAS f32x4*)(Am + p2.i * 64 + 4 * p2.j);
      win[3] = *(const LAS f32x4*)(Am + p3.i * 64 + 4 * p3.j); win[4] = *(const LAS f32x4*)(Am + p4.i * 64 + 4 * p4.j); }
    static_assert(SOLVE_D == 5, "window priming is written for SOLVE_D = 5");
    solve_step<1, 0>(U, Am, win, 0.f, 0.f, 0.f, 0.f);
}

constexpr int CP_QN = 0, CP_KN = 17408, CP_VA = 34816, CP_QKL = 51200, CP_SC = 59392, CP_HALF = 60416, CP_CW = 2 * CP_HALF;
__device__ __forceinline__ void phase_chunk(Frame& F, int blk0, int nblk, int n_lo, int n_cnt) {
    const float* conv_w = F.in[3];
    const bf16* proj = (const bf16*)(F.ws + WS_PROJ);
    const float* betaA = (const float*)(F.ws + WS_BETA); const float* gA = (const float*)(F.ws + WS_G);
    float* gtotA = (float*)(F.ws + WS_GTOT);
    const int half = F.wave >> 2, hw = F.wave & 3;
    LAS unsigned char* L = F.lds + half * CP_HALF;
    LAS bf16* qn = (LAS bf16*)(L + CP_QN); LAS bf16* kn = (LAS bf16*)(L + CP_KN); LAS bf16* vn = (LAS bf16*)(L + CP_VA);
    LAS float* Am = (LAS float*)(L + CP_VA); LAS bf16* qkL = (LAS bf16*)(L + CP_QKL); LAS float* sc = (LAS float*)(L + CP_SC);
    LAS float* cwL = (LAS float*)(F.lds + CP_CW);
    for (int idx = F.tid; idx < 4 * 1536 / 4; idx += 512) *(LAS f32x4*)(cwL + 4 * idx) = *(const f32x4*)(conv_w + 4 * idx);
    __syncthreads();
    const int nunits = NB * NH * n_cnt, nrounds = (nunits + 2 * nblk - 1) / (2 * nblk);
#pragma unroll 1
    for (int it = 0; it < nrounds; ++it) {
        int tid_ = F.tid; asm volatile("" : "+v"(tid_));
        const int ht = tid_ & 255, lane = tid_ & 63, r16 = lane & 15, gq = lane >> 4;
        int v_ = (it * nblk + ((int)blockIdx.x - blk0)) * 2 + half; asm volatile("" : "+s"(v_));
        const bool live = v_ < nunits;
        const int bh = live ? v_ / n_cnt : 0, n = live ? n_lo + v_ % n_cnt : 0, b = bh >> 2, h = bh & 3; const int unit = bh * 64 + n;
        const size_t m0 = (size_t)b * SEQ + (size_t)n * 64;
        unsigned char* chunk = F.ws + WS_CHUNK + (size_t)unit * CH_BYTES;
        const int rq = ht >> 4, cg = ht & 15;
        v4u Xa[7], Xb[7]; float gi = 0.f, bi = 0.f;
#define CHUNK_LOADX(X, p_) do { _Pragma("unroll") for (int jj = 0; jj < 7; ++jj) { const int trow = n * 64 + 4 * rq - 3 + jj; const int trc = trow < 0 ? 0 : trow; \
            const v4u u_ = *(const v4u*)(proj + ((size_t)b * SEQ + trc) * NPROJ + (p_) * 512 + h * 128 + 8 * cg); const unsigned mk_ = trow < 0 ? 0u : 0xffffffffu; \
            X[jj] = (v4u){u_.x & mk_, u_.y & mk_, u_.z & mk_, u_.w & mk_}; } } while (0)
#define CHUNK_CONV(X, p_) do { const int col = (p_) * 512 + h * 128 + 8 * cg; float wv[4][8]; \
            _Pragma("unroll") for (int j = 0; j < 4; ++j) { const f32x4 w0 = *(const LAS f32x4*)(cwL + j * 1536 + col), w1 = *(const LAS f32x4*)(cwL + j * 1536 + col + 4); \
                wv[j][0] = w0.x; wv[j][1] = w0.y; wv[j][2] = w0.z; wv[j][3] = w0.w; wv[j][4] = w1.x; wv[j][5] = w1.y; wv[j][6] = w1.z; wv[j][7] = w1.w; } \
            _Pragma("unroll") for (int rr = 0; rr < 4; ++rr) { float y[8]; \
                _Pragma("unroll") for (int q = 0; q < 8; ++q) y[q] = 0.f; \
                _Pragma("unroll") for (int j = 0; j < 4; ++j) { const v4u u = X[rr + j]; \
                    fmac_(y[0], wv[j][0], bflo(u.x)); fmac_(y[1], wv[j][1], bfhi(u.x)); fmac_(y[2], wv[j][2], bflo(u.y)); fmac_(y[3], wv[j][3], bfhi(u.y)); \
                    fmac_(y[4], wv[j][4], bflo(u.z)); fmac_(y[5], wv[j][5], bfhi(u.z)); fmac_(y[6], wv[j][6], bflo(u.w)); fmac_(y[7], wv[j][7], bfhi(u.w)); } \
                float ss = 0.f; \
                _Pragma("unroll") for (int q = 0; q < 8; ++q) { y[q] = siluf_(y[q]); ss += y[q] * y[q]; } \
                float scl = 1.f; \
                if ((p_) < 2) { ss += __shfl_xor(ss, 1); ss += __shfl_xor(ss, 2); ss += __shfl_xor(ss, 4); ss += __shfl_xor(ss, 8); scl = frsq_(ss + 1e-6f); if ((p_) == 0) scl *= 0.08838834764831845f; } \
                v4u o; o.x = cvt_pk_bf16(y[0] * scl, y[1] * scl); o.y = cvt_pk_bf16(y[2] * scl, y[3] * scl); o.z = cvt_pk_bf16(y[4] * scl, y[5] * scl); o.w = cvt_pk_bf16(y[6] * scl, y[7] * scl); \
                const int row = 4 * rq + rr; \
                if ((p_) == 0) *(LAS v4u*)(qn + row * 136 + 8 * cg) = o; else if ((p_) == 1) *(LAS v4u*)(kn + row * 136 + 8 * cg) = o; else *(LAS v4u*)(vn + row * 128 + 8 * cg) = o; \
                __builtin_amdgcn_sched_barrier(0); } } while (0)
        if (live) { CHUNK_LOADX(Xa, 0); CHUNK_LOADX(Xb, 1); if (hw == 0) { gi = gA[(m0 + lane) * 4 + h]; bi = betaA[(m0 + lane) * 4 + h]; } }
        if (live && hw == 0) {
            float c = gi;
#pragma unroll
            for (int o = 1; o < 64; o <<= 1) { const float tt = __shfl_up(c, o); if (lane >= o) c += tt; }
            const float gl = __shfl(c, 63);
            sc[lane] = bi; sc[64 + lane] = c; sc[128 + lane] = fexp_(c); sc[192 + lane] = fexp_(gl - c);
            if (lane == 63) gtotA[unit] = fexp_(c);
        }
        if (live) { CHUNK_CONV(Xa, 0); CHUNK_LOADX(Xa, 2); CHUNK_CONV(Xb, 1); CHUNK_CONV(Xa, 2); }
#undef CHUNK_LOADX
#undef CHUNK_CONV
        __syncthreads();
        const int which = ht >> 7, c = ht & 127;
        float U[64];
        if (live) {
#pragma unroll
            for (int i = 0; i < 64; ++i) { const float bi = sc[i]; const float tv = which ? bf2f(kn[i * 136 + c]) * sc[128 + i] : bf2f(vn[i * 128 + c]); U[i] = tv * bi; }
        } else {
#pragma unroll
            for (int i = 0; i < 64; ++i) U[i] = 0.f;
        }
        __syncthreads();
        if (live) {
            const int ti = hw >> 1, tj = hw & 1, r = lane & 31, hh = lane >> 5;
            f32x16 KK, QK;
#pragma unroll
            for (int q = 0; q < 16; ++q) { KK[q] = 0.f; QK[q] = 0.f; }
#pragma unroll
            for (int ks = 0; ks < 8; ++ks) {
                const bf16x8 ak = *(const LAS bf16x8*)(kn + (ti * 32 + r) * 136 + 16 * ks + 8 * hh);
                const bf16x8 aq = *(const LAS bf16x8*)(qn + (ti * 32 + r) * 136 + 16 * ks + 8 * hh);
                const bf16x8 bb = *(const LAS bf16x8*)(kn + (tj * 32 + r) * 136 + 16 * ks + 8 * hh);
                KK = __builtin_amdgcn_mfma_f32_32x32x16_bf16(ak, bb, KK, 0, 0, 0);
                QK = __builtin_amdgcn_mfma_f32_32x32x16_bf16(aq, bb, QK, 0, 0, 0);
            }
            const int j = tj * 32 + r; const float gcj = sc[64 + j];
#pragma unroll
            for (int reg = 0; reg < 16; ++reg) { const int i = ti * 32 + (reg & 3) + 8 * (reg >> 2) + 4 * hh;
                const float dec = (i >= j) ? __expf(sc[64 + i] - gcj) : 0.f;
                Am[i * 64 + j] = (i > j) ? sc[i] * KK[reg] * dec : 0.f;
                qkL[i * 64 + j] = (bf16)f2bf((i >= j) ? QK[reg] * dec : 0.f); }
        }
        __syncthreads();
        if (live) {
#pragma unroll
            for (int fi = 0; fi < 4; ++fi) { const int f = hw * 4 + fi, mb = f >> 2, ks = f & 3, row = 16 * mb + r16; const float s = sc[128 + row];
                const v2u lo = *(const LAS v2u*)(qn + row * 136 + 32 * ks + 4 * gq), hi = *(const LAS v2u*)(qn + row * 136 + 32 * ks + 16 + 4 * gq);
                v4u o; o.x = pk2(bflo(lo.x) * s, bfhi(lo.x) * s); o.y = pk2(bflo(lo.y) * s, bfhi(lo.y) * s); o.z = pk2(bflo(hi.x) * s, bfhi(hi.x) * s); o.w = pk2(bflo(hi.y) * s, bfhi(hi.y) * s);
                *(v4u*)(chunk + CH_QD + (f * 64 + lane) * 16) = o; }
#pragma unroll
            for (int fi = 0; fi < 4; ++fi) { const int f = hw * 4 + fi, db = f >> 1, ksp = f & 1, dcol = 16 * db + r16; float e[8];
#pragma unroll
                for (int j = 0; j < 8; ++j) { const int i = 32 * ksp + 16 * (j >> 2) + 4 * gq + (j & 3); e[j] = bf2f(kn[i * 136 + dcol]) * sc[192 + i]; }
                v4u o; o.x = pk2(e[0], e[1]); o.y = pk2(e[2], e[3]); o.z = pk2(e[4], e[5]); o.w = pk2(e[6], e[7]);
                *(v4u*)(chunk + CH_KT + (f * 64 + lane) * 16) = o; }
#pragma unroll
            for (int fi = 0; fi < 2; ++fi) { const int f = hw * 2 + fi, mb = f >> 1, ksp = f & 1, row = 16 * mb + r16;
                const v2u lo = *(const LAS v2u*)(qkL + row * 64 + 32 * ksp + 4 * gq), hi = *(const LAS v2u*)(qkL + row * 64 + 32 * ksp + 16 + 4 * gq);
                *(v4u*)(chunk + CH_QK + (f * 64 + lane) * 16) = (v4u){lo.x, lo.y, hi.x, hi.y}; }
            solve_all(U, Am);
        }
        __syncthreads();
        if (live) {
            if (which == 0) {
                const int w8 = c >> 4, cl = c & 15;
                unsigned char* ub = F.ws + WS_UC + (size_t)unit * UC_BYTES;
#pragma unroll
                for (int g = 0; g < 4; ++g) {
                    v4u lo, hi;
                    lo.x = pk2(U[4 * g], U[4 * g + 1]); lo.y = pk2(U[4 * g + 2], U[4 * g + 3]); lo.z = pk2(U[16 + 4 * g], U[16 + 4 * g + 1]); lo.w = pk2(U[16 + 4 * g + 2], U[16 + 4 * g + 3]);
                    hi.x = pk2(U[32 + 4 * g], U[32 + 4 * g + 1]); hi.y = pk2(U[32 + 4 * g + 2], U[32 + 4 * g + 3]); hi.z = pk2(U[48 + 4 * g], U[48 + 4 * g + 1]); hi.w = pk2(U[48 + 4 * g + 2], U[48 + 4 * g + 3]);
                    v4u* dst = (v4u*)(ub + ((w8 * 64 + g * 16 + cl) * 32)); dst[0] = lo; dst[1] = hi;
                }
            } else {
#pragma unroll
                for (int i = 0; i < 64; ++i) qn[i * 136 + c] = (bf16)f2bf(U[i]);
            }
        }
        __syncthreads();
        if (live) {
#pragma unroll
            for (int fi = 0; fi < 4; ++fi) { const int f = hw * 4 + fi, mb = f >> 2, ks = f & 3, row = 16 * mb + r16;
                const v2u lo = *(const LAS v2u*)(qn + row * 136 + 32 * ks + 4 * gq), hi = *(const LAS v2u*)(qn + row * 136 + 32 * ks + 16 + 4 * gq);
                *(v4u*)(chunk + CH_WF + (f * 64 + lane) * 16) = (v4u){lo.x, lo.y, hi.x, hi.y}; }
        }
        __syncthreads();
    }
}

constexpr int SCAN_SPLIT = 32;
constexpr int SC_STAGED = 49152, SC_NLOAD = 16;
struct ScanU { v4u u0, u1; };
struct ScanQ { v4u q[8]; };
__device__ __forceinline__ void scan_issue_u(ScanU& R, const unsigned char* up) {
    asm volatile("global_load_dwordx4 %0, %1, off" : "=v"(R.u0) : "v"(up) : "memory");
    asm volatile("global_load_dwordx4 %0, %1, off offset:16" : "=v"(R.u1) : "v"(up) : "memory");
}
__device__ __forceinline__ void scan_issue_q(ScanQ& R, const unsigned char* qp) {
    asm volatile("global_load_dwordx4 %0, %1, off" : "=v"(R.q[0]) : "v"(qp) : "memory");
    asm volatile("global_load_dwordx4 %0, %1, off offset:1024" : "=v"(R.q[1]) : "v"(qp) : "memory");
    asm volatile("global_load_dwordx4 %0, %1, off offset:2048" : "=v"(R.q[2]) : "v"(qp) : "memory");
    asm volatile("global_load_dwordx4 %0, %1, off offset:3072" : "=v"(R.q[3]) : "v"(qp) : "memory");
    const unsigned char* qp2 = qp + 4096;
    asm volatile("global_load_dwordx4 %0, %1, off" : "=v"(R.q[4]) : "v"(qp2) : "memory");
    asm volatile("global_load_dwordx4 %0, %1, off offset:1024" : "=v"(R.q[5]) : "v"(qp2) : "memory");
    asm volatile("global_load_dwordx4 %0, %1, off offset:2048" : "=v"(R.q[6]) : "v"(qp2) : "memory");
    asm volatile("global_load_dwordx4 %0, %1, off offset:3072" : "=v"(R.q[7]) : "v"(qp2) : "memory");
}
#define SCAN_WAIT_REGS(U, Q, cnt) asm volatile("s_waitcnt vmcnt(" #cnt ")" : "+v"(U.u0), "+v"(U.u1), "+v"(Q.q[0]), "+v"(Q.q[1]), "+v"(Q.q[2]), "+v"(Q.q[3]), "+v"(Q.q[4]), "+v"(Q.q[5]), "+v"(Q.q[6]), "+v"(Q.q[7]) :: "memory")
template <class Bar> __device__ __forceinline__ void phase_scan(Frame& F, const Bar& mid_barrier) {
    const int bh = blockIdx.x, b = bh >> 2, h = bh & 3, w = F.wave, lane = F.lane, cl = lane & 15, gq = lane >> 4;
    const float* gtotA = (const float*)(F.ws + WS_GTOT);
    const int unit0 = bh * 64;
    const unsigned char* cbase = F.ws + WS_CHUNK + (size_t)unit0 * CH_BYTES;
    const unsigned char* ubase = F.ws + WS_UC + (size_t)unit0 * UC_BYTES + (w * 64 + lane) * 32;
    const unsigned char* qbase = cbase + CH_QK + lane * 16;
    bf16* op = (bf16*)(F.ws + WS_ORAW) + ((size_t)b * SEQ + cl) * 512 + h * 128 + 16 * w + 4 * gq;
    f32x4 Sacc[8]; bf16x8 Sb[4];
#pragma unroll
    for (int d = 0; d < 8; ++d) Sacc[d] = (f32x4){0.f, 0.f, 0.f, 0.f};
#pragma unroll
    for (int k = 0; k < 4; ++k) Sb[k] = (bf16x8){0, 0, 0, 0, 0, 0, 0, 0};
    v2u Ow[4];
#pragma unroll
    for (int mb = 0; mb < 4; ++mb) Ow[mb] = (v2u){0u, 0u};
    ScanU U0, U1, U2; ScanQ QA, QB;
#define SCAN_ISSUE(nn) do { const unsigned char* s_ = cbase + (size_t)(nn) * CH_BYTES + (w * 6) * 1024 + lane * 16; LAS unsigned char* d_ = F.lds + ((nn) % 3) * SC_STAGED + (w * 6) * 1024; \
        _Pragma("unroll") for (int k_ = 0; k_ < 6; ++k_) __builtin_amdgcn_global_load_lds((const unsigned*)(s_ + k_ * 1024), (LAS unsigned*)(d_ + k_ * 1024), 16, 0, 0); } while (0)
#define SCAN_STEP(n, UC, UN, Q, ISSUE2, WAITCNT) do { \
        SCAN_WAIT_REGS(UC, Q, WAITCNT); asm volatile("s_waitcnt lgkmcnt(0)" ::: "memory"); __builtin_amdgcn_s_barrier(); asm volatile("" ::: "memory"); \
        const float gt = __shfl(gtv, (n) & 31); \
        if (ISSUE2) { scan_issue_u(UN, ubase + (size_t)((n) + 2) * UC_BYTES); SCAN_ISSUE((n) + 2); } \
        if ((n) > 0) { _Pragma("unroll") for (int mb = 0; mb < 4; ++mb) *(v2u*)(op + (size_t)(((n) - 1) * 64 + 16 * mb) * 512) = Ow[mb]; } \
        const LAS unsigned char* B = F.lds + ((n) % 3) * SC_STAGED; \
        f32x4 P[4]; \
        _Pragma("unroll") for (int mb = 0; mb < 4; ++mb) { P[mb] = (f32x4){0.f, 0.f, 0.f, 0.f}; \
            _Pragma("unroll") for (int ks = 0; ks < 4; ++ks) P[mb] = __builtin_amdgcn_mfma_f32_16x16x32_bf16(SFRAG(CH_WF, mb * 4 + ks), Sb[ks], P[mb], 0, 0, 0); } \
        f32x4 vnw[4]; \
        vnw[0] = (f32x4){bflo(UC.u0.x), bfhi(UC.u0.x), bflo(UC.u0.y), bfhi(UC.u0.y)} - P[0]; \
        vnw[1] = (f32x4){bflo(UC.u0.z), bfhi(UC.u0.z), bflo(UC.u0.w), bfhi(UC.u0.w)} - P[1]; \
        vnw[2] = (f32x4){bflo(UC.u1.x), bfhi(UC.u1.x), bflo(UC.u1.y), bfhi(UC.u1.y)} - P[2]; \
        vnw[3] = (f32x4){bflo(UC.u1.z), bfhi(UC.u1.z), bflo(UC.u1.w), bfhi(UC.u1.w)} - P[3]; \
        bf16x8 Vb[2]; Vb[0] = pack8(vnw[0], vnw[1]); Vb[1] = pack8(vnw[2], vnw[3]); \
        _Pragma("unroll") for (int mb = 0; mb < 4; ++mb) { f32x4 OT = (f32x4){0.f, 0.f, 0.f, 0.f}; \
            _Pragma("unroll") for (int ks = 0; ks < 4; ++ks) OT = __builtin_amdgcn_mfma_f32_16x16x32_bf16(Sb[ks], SFRAG(CH_QD, mb * 4 + ks), OT, 0, 0, 0); \
            _Pragma("unroll") for (int ksp = 0; ksp < 2; ++ksp) OT = __builtin_amdgcn_mfma_f32_16x16x32_bf16(Vb[ksp], __builtin_bit_cast(bf16x8, Q.q[mb * 2 + ksp]), OT, 0, 0, 0); \
            Ow[mb] = (v2u){cvt_pk_bf16(OT[0], OT[1]), cvt_pk_bf16(OT[2], OT[3])}; } \
        asm volatile("s_nop 7" : "+v"(Q.q[0]), "+v"(Q.q[1]), "+v"(Q.q[2]), "+v"(Q.q[3]), "+v"(Q.q[4]), "+v"(Q.q[5]), "+v"(Q.q[6]), "+v"(Q.q[7]));     \
        if (ISSUE2) scan_issue_q(Q, qbase + (size_t)((n) + 2) * CH_BYTES); \
        _Pragma("unroll") for (int db = 0; db < 8; ++db) { Sacc[db] = Sacc[db] * gt; \
            _Pragma("unroll") for (int ksp = 0; ksp < 2; ++ksp) Sacc[db] = __builtin_amdgcn_mfma_f32_16x16x32_bf16(SFRAG(CH_KT, db * 2 + ksp), Vb[ksp], Sacc[db], 0, 0, 0); } \
        _Pragma("unroll") for (int ks = 0; ks < 4; ++ks) Sb[ks] = pack8(Sacc[2 * ks], Sacc[2 * ks + 1]); \
    } while (0)
#define SFRAG(off, f) (*(const LAS bf16x8*)(B + (off) + ((f) * 64 + lane) * 16))
    static_assert(CH_WF == 0 && CH_QD == 16384 && CH_KT == 32768 && CH_QK == SC_STAGED && SCAN_SPLIT % 6 == 2 && 2 * SCAN_SPLIT == 64, "staged part = the first 48 KiB of a chunk; a half = 5 x 6 + 2 steps");
#pragma unroll 1
    for (int part = 0; part < 2; ++part) {
        const int n0 = part * SCAN_SPLIT;
        float gtv = gtotA[unit0 + n0 + (lane & 31)];
        asm volatile("s_waitcnt vmcnt(0)" : "+v"(gtv) :: "memory");
        scan_issue_u(U0, ubase + (size_t)n0 * UC_BYTES); SCAN_ISSUE(n0); scan_issue_q(QA, qbase + (size_t)n0 * CH_BYTES);
        scan_issue_u(U1, ubase + (size_t)(n0 + 1) * UC_BYTES); SCAN_ISSUE(n0 + 1); scan_issue_q(QB, qbase + (size_t)(n0 + 1) * CH_BYTES);
#pragma unroll 1
        for (int n = n0; n < n0 + SCAN_SPLIT - 2; n += 6) {
            SCAN_STEP(n, U0, U2, QA, true, 16);
            SCAN_STEP(n + 1, U1, U0, QB, true, 16);
            SCAN_STEP(n + 2, U2, U1, QA, true, 16);
            SCAN_STEP(n + 3, U0, U2, QB, true, 16);
            SCAN_STEP(n + 4, U1, U0, QA, true, 16);
            SCAN_STEP(n + 5, U2, U1, QB, true, 16);
        }
        SCAN_STEP(n0 + SCAN_SPLIT - 2, U0, U2, QA, false, 16);
        SCAN_STEP(n0 + SCAN_SPLIT - 1, U1, U0, QB, false, 0);
        if (part == 0) mid_barrier();
    }
#undef SFRAG
#undef SCAN_STEP
#undef SCAN_ISSUE
#pragma unroll
    for (int mb = 0; mb < 4; ++mb) *(v2u*)(op + (size_t)(63 * 64 + 16 * mb) * 512) = Ow[mb];
    VM_WAIT(); __syncthreads();
}

__device__ __forceinline__ void phase_onorm(Frame& F) {
    const float* dnw = F.in[6]; const bf16* proj = (const bf16*)(F.ws + WS_PROJ); const bf16* oraw = (const bf16*)(F.ws + WS_ORAW); bf16* concat = (bf16*)(F.ws + WS_CONCAT);
    const int gw = F.vcu * NWAVES + F.wave, NGW = F.G * NWAVES, lane = F.lane;
    const int cc = 8 * (lane & 15);
    const f32x4 d0 = *(const f32x4*)(dnw + cc), d1 = *(const f32x4*)(dnw + cc + 4);
    for (int m = gw; m < NTOK; m += NGW) {
        const v4u o = *(const v4u*)(oraw + (size_t)m * 512 + 8 * lane);
        const v4u z = *(const v4u*)(proj + (size_t)m * NPROJ + 1536 + 8 * lane);
        const float ov[8] = {bflo(o.x), bfhi(o.x), bflo(o.y), bfhi(o.y), bflo(o.z), bfhi(o.z), bflo(o.w), bfhi(o.w)};
        const float zv[8] = {bflo(z.x), bfhi(z.x), bflo(z.y), bfhi(z.y), bflo(z.z), bfhi(z.z), bflo(z.w), bfhi(z.w)};
        float ss = 0.f;
#pragma unroll
        for (int q = 0; q < 8; ++q) ss += ov[q] * ov[q];
        ss += __shfl_xor(ss, 1); ss += __shfl_xor(ss, 2); ss += __shfl_xor(ss, 4); ss += __shfl_xor(ss, 8);
        const float rs = frsq_(ss * (1.f / 128.f) + 1e-6f);
        const float dv[8] = {d0.x, d0.y, d0.z, d0.w, d1.x, d1.y, d1.z, d1.w};
        float r[8];
#pragma unroll
        for (int q = 0; q < 8; ++q) r[q] = ov[q] * rs * dv[q] * siluf_(zv[q]);
        *(v4u*)(concat + (size_t)m * DM + 8 * lane) = (v4u){cvt_pk_bf16(r[0], r[1]), cvt_pk_bf16(r[2], r[3]), cvt_pk_bf16(r[4], r[5]), cvt_pk_bf16(r[6], r[7])};
    }
}

__device__ __forceinline__ void phase_route(Frame& F) {
    const float* x1 = F.out; const float* b_router = F.in[12];
    unsigned char* x1b = F.ws + WS_X1B; float* rs2A = (float*)(F.ws + WS_RS2); int* list = (int*)(F.ws + WS_LIST);
    float* rsl = (float*)(F.ws + WS_RSL); float* gwl = (float*)(F.ws + WS_GWL);
    unsigned* cntw = (unsigned*)(F.ws + WS_CTL) + CW_CNT;
    LAS unsigned char* WI = F.lds;
    LAS unsigned* lcnt = (LAS unsigned*)(F.lds + TAB_OFF);
    { const v4u* src = (const v4u*)(F.ws + WS_WR);
      for (int idx = F.tid; idx < 131072 / 16; idx += 512) *(LAS v4u*)(WI + 16 * idx) = src[idx]; }
    const int lane = F.lane, c = lane & 15, g = lane >> 4;
    const int gw = F.vcu * NWAVES + F.wave, NGW = F.G * NWAVES, NT = NTOK / 16;
    const float bia0 = b_router[c], bia1 = b_router[16 + c];
    for (int t0 = 0; t0 < NT; t0 += NGW) {
        const int tile = t0 + gw; const bool live = tile < NT;
        if (F.tid < 64) lcnt[F.tid] = 0u;
        __syncthreads();
        int my_e = 0; float my_g = 0.f, my_rs = 0.f; unsigned my_rank = 0u; int my_ent = 0;
        if (live) {
            const int m0 = tile * 16;
            const float* xrow = x1 + (size_t)(m0 + c) * DM + 8 * g;
            unsigned char* xbrow = x1b + (size_t)(m0 + c) * DM + 8 * g;
            f32x4 acc0 = (f32x4){0.f, 0.f, 0.f, 0.f}, acc1 = acc0; float ssq = 0.f;
#pragma unroll 1
            for (int kb = 0; kb < 4; ++kb) {
                f32x4 xa[8], xb4[8];
#pragma unroll
                for (int q = 0; q < 8; ++q) { xa[q] = *(const f32x4*)(xrow + 32 * (kb * 8 + q)); xb4[q] = *(const f32x4*)(xrow + 32 * (kb * 8 + q) + 4); }
#pragma unroll
                for (int q = 0; q < 8; ++q) { const int ks = kb * 8 + q; const f32x4 a = xa[q], b = xb4[q];
                    ssq += (a.x * a.x + a.y * a.y) + (a.z * a.z + a.w * a.w) + (b.x * b.x + b.y * b.y) + (b.z * b.z + b.w * b.w);
                    v4u h; h.x = cvt_pk_bf16(a.x, a.y); h.y = cvt_pk_bf16(a.z, a.w); h.z = cvt_pk_bf16(b.x, b.y); h.w = cvt_pk_bf16(b.z, b.w);
                    v4u l; l.x = cvt_pk_bf16(a.x - bflo(h.x), a.y - bfhi(h.x)); l.y = cvt_pk_bf16(a.z - bflo(h.y), a.w - bfhi(h.y)); l.z = cvt_pk_bf16(b.x - bflo(h.z), b.y - bfhi(h.z)); l.w = cvt_pk_bf16(b.z - bflo(h.w), b.w - bfhi(h.w));
                    *(v2u*)(xbrow + 32 * ks) = (v2u){pk4_fp8(a.x, a.y, a.z, a.w), pk4_fp8(b.x, b.y, b.z, b.w)};
                    const bf16x8 ah = __builtin_bit_cast(bf16x8, h), al = __builtin_bit_cast(bf16x8, l);
                    const LAS unsigned char* fb = WI + (size_t)(ks * 4) * 1024 + lane * 16;
                    const bf16x8 b0h = *(const LAS bf16x8*)(fb), b0l = *(const LAS bf16x8*)(fb + 1024), b1h = *(const LAS bf16x8*)(fb + 2048), b1l = *(const LAS bf16x8*)(fb + 3072);
                    acc0 = __builtin_amdgcn_mfma_f32_16x16x32_bf16(ah, b0h, acc0, 0, 0, 0); acc0 = __builtin_amdgcn_mfma_f32_16x16x32_bf16(ah, b0l, acc0, 0, 0, 0); acc0 = __builtin_amdgcn_mfma_f32_16x16x32_bf16(al, b0h, acc0, 0, 0, 0);
                    acc1 = __builtin_amdgcn_mfma_f32_16x16x32_bf16(ah, b1h, acc1, 0, 0, 0); acc1 = __builtin_amdgcn_mfma_f32_16x16x32_bf16(ah, b1l, acc1, 0, 0, 0); acc1 = __builtin_amdgcn_mfma_f32_16x16x32_bf16(al, b1h, acc1, 0, 0, 0); }
            }
            ssq += __shfl_xor(ssq, 16); ssq += __shfl_xor(ssq, 32);
            const float rsr = frsq_(ssq * (1.f / DM) + 1e-6f);
            if (g == 0) rs2A[m0 + c] = rsr;
            float ge_[4]; int ee_[4];
#pragma unroll
            for (int reg = 0; reg < 4; ++reg) {
                const float rsw = __shfl(rsr, 4 * g + reg);
                float v0 = acc0[reg] * rsw + bia0, v1 = acc1[reg] * rsw + bia1;
                float tv[4]; int te[4];
#pragma unroll
                for (int s = 0; s < 4; ++s) {
                    float bv; int bi; if (v1 > v0) { bv = v1; bi = 16 + c; } else { bv = v0; bi = c; }
#pragma unroll
                    for (int o = 1; o < 16; o <<= 1) { const float ov = __shfl_xor(bv, o); const int oi = __shfl_xor(bi, o); if (ov > bv || (ov == bv && oi < bi)) { bv = ov; bi = oi; } }
                    tv[s] = bv; te[s] = bi; if (bi == c) v0 = -3.0e38f; if (bi == 16 + c) v1 = -3.0e38f;
                }
                const float e1 = fexp_(tv[1] - tv[0]), e2 = fexp_(tv[2] - tv[0]), e3 = fexp_(tv[3] - tv[0]); const float inv = frcp_(1.f + e1 + e2 + e3);
                const int s_ = c & 3; const float gsel = (s_ == 0 ? 1.f : s_ == 1 ? e1 : s_ == 2 ? e2 : e3) * inv; const int esel = s_ == 0 ? te[0] : s_ == 1 ? te[1] : s_ == 2 ? te[2] : te[3];
                ge_[reg] = gsel; ee_[reg] = esel;
            }
            const int rsel = c >> 2;
            my_g = rsel == 0 ? ge_[0] : rsel == 1 ? ge_[1] : rsel == 2 ? ge_[2] : ge_[3];
            my_e = rsel == 0 ? ee_[0] : rsel == 1 ? ee_[1] : rsel == 2 ? ee_[2] : ee_[3];
            my_ent = (m0 + 4 * g + rsel) * 4 + (c & 3);
            my_rs = __shfl(rsr, 4 * g + rsel);
            my_rank = __hip_atomic_fetch_add(lcnt + my_e, 1u, __ATOMIC_RELAXED, __HIP_MEMORY_SCOPE_WORKGROUP);
        }
        __syncthreads();
        if (F.tid < NE) { const unsigned n = lcnt[F.tid]; lcnt[32 + F.tid] = n ? __hip_atomic_fetch_add(cntw + 64 * F.tid, n, RLX_AGENT) : 0u; }
        __syncthreads();
        if (live) { const size_t pos = (size_t)my_e * LISTCAP + lcnt[32 + my_e] + my_rank; list[pos] = my_ent; rsl[pos] = my_rs; gwl[pos] = my_g; }
        __syncthreads();
    }
}

__device__ __forceinline__ int moe_tables(Frame& F, MoeTab& T) {
    LAS int* pref = (LAS int*)(F.lds + TAB_OFF); LAS int* cnt = pref + 40;
    unsigned* cntw = (unsigned*)(F.ws + WS_CTL) + CW_CNT;
    if (F.tid == 0) { int acc = 0; for (int e = 0; e < NE; ++e) { const int c = (int)__hip_atomic_load(cntw + 64 * e, RLX_AGENT); cnt[e] = c; pref[e] = acc; acc += (c + 255) >> 8; } pref[NE] = acc; }
    __syncthreads();
    T.pref = pref; T.cnt = cnt;
    return pref[NE];
}

struct FinalRow { f32x4 v[4]; v2u sl[4][2]; };
typedef float f32x2_t __attribute__((ext_vector_type(2)));
__device__ __forceinline__ void final_load(FinalRow& R, const float* orow, const unsigned char* srow) {
#pragma unroll
    for (int j = 0; j < 2; ++j) { R.v[2 * j] = *(const f32x4*)(orow + 512 * j); R.v[2 * j + 1] = *(const f32x4*)(orow + 512 * j + 4); }
#pragma unroll
    for (int s = 0; s < 4; ++s)
#pragma unroll
        for (int j = 0; j < 2; ++j) R.sl[s][j] = *(const v2u*)(srow + (size_t)s * DM + 512 * j);
}
__device__ __forceinline__ void final_finish(FinalRow& R, float* orow, const f32x4 (&wv)[4], size_t dry_off) {
    orow += dry_off;
#pragma unroll
    for (int s = 0; s < 4; ++s)
#pragma unroll
        for (int j = 0; j < 2; ++j) { const v2u u = R.sl[s][j];
            const f32x2_t a0 = __builtin_amdgcn_cvt_pk_f32_fp8((int)u.x, false), a1 = __builtin_amdgcn_cvt_pk_f32_fp8((int)u.x, true), b0 = __builtin_amdgcn_cvt_pk_f32_fp8((int)u.y, false), b1 = __builtin_amdgcn_cvt_pk_f32_fp8((int)u.y, true);
            R.v[2 * j].x += a0.x * SLAB_INV; R.v[2 * j].y += a0.y * SLAB_INV; R.v[2 * j].z += a1.x * SLAB_INV; R.v[2 * j].w += a1.y * SLAB_INV;
            R.v[2 * j + 1].x += b0.x * SLAB_INV; R.v[2 * j + 1].y += b0.y * SLAB_INV; R.v[2 * j + 1].z += b1.x * SLAB_INV; R.v[2 * j + 1].w += b1.y * SLAB_INV; }
    float ss = 0.f;
#pragma unroll
    for (int j = 0; j < 4; ++j) ss += (R.v[j].x * R.v[j].x + R.v[j].y * R.v[j].y) + (R.v[j].z * R.v[j].z + R.v[j].w * R.v[j].w);
    ss = wave_sum(ss);
    const float rs = frsq_(ss * (1.f / DM) + 1e-6f);
#pragma unroll
    for (int j = 0; j < 2; ++j) { *(f32x4*)(orow + 512 * j) = R.v[2 * j] * rs * wv[2 * j]; *(f32x4*)(orow + 512 * j + 4) = R.v[2 * j + 1] * rs * wv[2 * j + 1]; }
}
__device__ __forceinline__ void phase_final(Frame& F, int dryrun) {
    const float* fw = F.in[17]; const unsigned char* slab = F.ws + WS_SLAB; float* out = F.out;
    const int gw = F.vcu * NWAVES + F.wave, NGW = F.G * NWAVES, lane = F.lane;
    f32x4 wv[4];
#pragma unroll
    for (int j = 0; j < 2; ++j) { wv[2 * j] = *(const f32x4*)(fw + 512 * j + 8 * lane); wv[2 * j + 1] = *(const f32x4*)(fw + 512 * j + 8 * lane + 4); }
    const size_t dry_off = dryrun ? (size_t)((float*)(F.ws + WS_XB) - out) : 0;
    FinalRow A, B;
    int m = gw;
    if (m < NTOK) final_load(A, out + (size_t)m * DM + 8 * lane, slab + (size_t)m * 4 * DM + 8 * lane);
    for (; m < NTOK; m += 2 * NGW) {
        const int m1 = m + NGW, m2 = m + 2 * NGW;
        if (m1 < NTOK) final_load(B, out + (size_t)m1 * DM + 8 * lane, slab + (size_t)m1 * 4 * DM + 8 * lane);
        final_finish(A, out + (size_t)m * DM + 8 * lane, wv, dry_off);
        if (m2 < NTOK) final_load(A, out + (size_t)m2 * DM + 8 * lane, slab + (size_t)m2 * 4 * DM + 8 * lane);
        if (m1 < NTOK) final_finish(B, out + (size_t)m1 * DM + 8 * lane, wv, dry_off);
    }
}

struct Args { const float* in[18]; float* out; unsigned char* ws; int ph_lo, ph_hi, flag, breg; };
constexpr int NPHASE = 11;

__global__ void __launch_bounds__(NWAVES * 64, 2) mk_fwd(Args args) {
    extern __shared__ __attribute__((aligned(16))) unsigned char lds_raw[];
    Frame F;
    F.lds = (LAS unsigned char*)lds_raw;
    F.tid = threadIdx.x; F.lane = F.tid & 63; F.wave = __builtin_amdgcn_readfirstlane(F.tid >> 6);
    F.G = gridDim.x; { const int bx = blockIdx.x; F.vcu = (F.G % 8 == 0) ? (bx % 8) * (F.G / 8) + bx / 8 : bx; }
#pragma unroll
    for (int i = 0; i < 18; ++i) F.in[i] = args.in[i];
    F.out = args.out; F.ws = args.ws;
    volatile LAS unsigned* MISC = (volatile LAS unsigned*)(F.lds + MISC_OFF);
    for (int u = F.tid; u < (LDS_BYTES - LDSCTL_OFF) / 4; u += NWAVES * 64) ((LAS unsigned*)(F.lds + LDSCTL_OFF))[u] = 0u;
    __syncthreads();
    unsigned* ctl = (unsigned*)(F.ws + WS_CTL);
#if !MK_PER_PHASE
    XcdBarrier bar = xcd_barrier_post(ctl + CW_BAR, MISC + 8);
#define GRID_BAR() xcd_barrier(bar)
#else
#define GRID_BAR() do {} while (0)
#endif
    const int lo = args.ph_lo, hi = args.ph_hi;
#define IN(k) (lo <= (k) && (k) < hi)
#define SEAM(k) do { if (IN(k) && IN((k) + 1)) GRID_BAR(); } while (0)

#define RUNPH(k, ...) do { if (IN(k)) { __VA_ARGS__; } SEAM(k); } while (0)
    RUNPH(0, phase_prep(F));
    RUNPH(1, {
        ProbIn P; P.K = DM; P.RB = 2 * DM; P.S.init(NTOK / 256, NPROJ / 256, F.G, (int)blockIdx.x);
        P.A = (const bf16*)(F.ws + WS_XB); P.Bt = (const bf16*)(F.ws + WS_WIN); P.O = (bf16*)(F.ws + WS_PROJ); P.rs = (const float*)(F.ws + WS_RS1);
        pg8::gemm_phase(F.lds, P); });
    if (IN(2)) { phase_mix(F); __syncthreads(); }
    RUNPH(3, phase_chunk(F, 0, F.G, 0, SCAN_SPLIT));
    RUNPH(4, {
        const int nscan = NB * NH;
        unsigned* seam = ctl + CW_SEAM4 + 64 * args.breg;
        auto scan_wait = [&]() {
            asm volatile("s_waitcnt vmcnt(0)" ::: "memory"); __syncthreads();
            if (F.tid == 0) { const unsigned want = (unsigned)(F.G - nscan); unsigned sp = 0u;
                while (__hip_atomic_load(seam, RLX_AGENT) < want) { __builtin_amdgcn_s_sleep(2); if (++sp > (1u << 22)) break; }
                __builtin_amdgcn_fence(__ATOMIC_ACQUIRE, "agent"); asm volatile("s_waitcnt vmcnt(0)" ::: "memory"); }
            __syncthreads();
        };
        if ((int)blockIdx.x < nscan) phase_scan(F, scan_wait);
        else {
               phase_chunk(F, nscan, F.G - nscan, SCAN_SPLIT, 64 - SCAN_SPLIT);
               asm volatile("s_waitcnt vmcnt(0)" ::: "memory"); __syncthreads();
               if (F.tid == 0) { __builtin_amdgcn_fence(__ATOMIC_RELEASE, "agent"); asm volatile("s_waitcnt vmcnt(0)" ::: "memory"); __hip_atomic_fetch_add(seam, 1u, RLX_AGENT); }
               moe_weight_prep(F, nscan, MOE_PREP_SPLIT, MOE_PREP_ITEMS); } });
    RUNPH(5, phase_onorm(F));
    RUNPH(6, {
        ProbOut P; P.K = DM; P.RB = 2 * DM; P.S.init(NTOK / 256, DM / 256, F.G, (int)blockIdx.x);
        P.A = (const bf16*)(F.ws + WS_CONCAT); P.Bt = (const bf16*)(F.ws + WS_WOUT); P.X = F.in[0]; P.O = F.out;
        pg8::gemm_phase(F.lds, P); });
    RUNPH(7, phase_route(F));
    RUNPH(8, {
        ProbGU P; const int RT = moe_tables(F, P.T);
        P.K = DM; P.RB = DM; P.S.init(RT, 8, F.G, (int)blockIdx.x);
        P.A = F.ws + WS_X1B; P.Bt = F.ws + WS_WGU; P.O = F.ws + WS_ACT; P.list = (const int*)(F.ws + WS_LIST);
        P.rs2 = (const float*)(F.ws + WS_RSL); P.bgu = (const float*)(F.ws + WS_BGU);
        pg8::gemm_phase<ProbGU, true>(F.lds, P); });
    RUNPH(9, {
        ProbDown P; const int RT = moe_tables(F, P.T);
        P.K = DE; P.RB = DE; P.S.init(RT, 4, F.G, (int)blockIdx.x);
        P.A = F.ws + WS_ACT; P.Bt = F.ws + WS_WD; P.O = F.ws + WS_SLAB; P.list = (const int*)(F.ws + WS_LIST);
        P.gw = (const float*)(F.ws + WS_GWL); P.bd = F.in[16];
        pg8::gemm_phase<ProbDown, true>(F.lds, P); });
    RUNPH(10, phase_final(F, args.flag));
#undef RUNPH
#undef IN
#undef SEAM
}

extern "C" void kernel_launch(void* const* d_in, const int* in_sizes, int n_in, void* d_out, int out_size, void* d_ws, size_t ws_size, hipStream_t stream) {
    static int grid = 0;
    if (grid == 0) {
        if (n_in != 18 || in_sizes[0] != NTOK * DM || out_size != NTOK * DM || ws_size < WS_END) { fprintf(stderr, "kernel_launch: unexpected shapes (n_in %d, in0 %d, out %d, ws %zu)\n", n_in, n_in > 0 ? in_sizes[0] : -1, out_size, ws_size); grid = -1; return; }
        int dev = 0, cus = 0, per_cu = 0;
        if (hipGetDevice(&dev) != hipSuccess || hipDeviceGetAttribute(&cus, hipDeviceAttributeMultiprocessorCount, dev) != hipSuccess) { grid = -1; return; }
        if (hipFuncSetAttribute((const void*)mk_fwd, hipFuncAttributeMaxDynamicSharedMemorySize, LDS_BYTES) != hipSuccess) { fprintf(stderr, "kernel_launch: hipFuncSetAttribute failed\n"); grid = -1; return; }
        if (hipOccupancyMaxActiveBlocksPerMultiprocessor(&per_cu, (const void*)mk_fwd, NWAVES * 64, LDS_BYTES) != hipSuccess || per_cu < 1) { fprintf(stderr, "kernel_launch: occupancy query says %d\n", per_cu); per_cu = 1; }
        (void)hipGetLastError();
        grid = cus;
    }
    if (grid < 0) return;
    (void)hipMemsetAsync((char*)d_ws + WS_CTL, 0, CTL_ZERO_BYTES, stream);
    Args a{};
    for (int i = 0; i < 18; ++i) a.in[i] = (const float*)d_in[i];
    a.out = (float*)d_out; a.ws = (unsigned char*)d_ws;
#if MK_PER_PHASE
    for (int p = 0; p < NPHASE; ++p) { a.ph_lo = p; a.ph_hi = p + 1; const int nrep = 1 + REP_CNT * ((REP_MASK >> p) & 1);
        for (int r = 0; r < nrep; ++r) { a.flag = (p == NPHASE - 1 && r + 1 < nrep) ? 1 : 0; a.breg = r; hipLaunchKernelGGL(mk_fwd, dim3(grid), dim3(NWAVES * 64), LDS_BYTES, stream, a); } }
#else
    a.ph_lo = 0; a.ph_hi = NPHASE;
    hipLaunchKernelGGL(mk_fwd, dim3(grid), dim3(NWAVES * 64), LDS_BYTES, stream, a);
#endif
}
```

```cpp
#include <hip/hip_runtime.h>
#include <cstdio>
#include <cstdint>

#ifndef REP_MASK
#define REP_MASK 0
#endif
#ifndef REP_CNT
#define REP_CNT 1
#endif
#ifndef MK_PER_PHASE
#define MK_PER_PHASE 0
#endif

constexpr int NB = 8, SEQ = 4096, DM = 1024, NTOK = NB * SEQ;
constexpr int NH = 4, HD = 128, DDN = 512, DPOOL = 512, DIN = 2568, NPROJ = 2560;
constexpr int NE = 32, TOPK = 4, DE = 1024, NASSIGN = NTOK * TOPK;
constexpr int LISTCAP = NTOK;
constexpr int ACT_ROWS = NASSIGN + NE * 256;

constexpr size_t MiB = 1u << 20;
constexpr size_t WS_CTL = 0, CTL_ZERO_BYTES = 1 * MiB;
constexpr size_t WS_WIN = 1 * MiB;
constexpr size_t WS_WOUT = 6 * MiB;
constexpr size_t WS_WPOOL = 8 * MiB;
constexpr size_t WS_WR = 8 * MiB + 512 * 1024;
constexpr size_t WS_BGU = 8 * MiB + 768 * 1024;
constexpr size_t WS_RS1 = 9 * MiB;
constexpr size_t WS_BETA = 9 * MiB + 128 * 1024;
constexpr size_t WS_G = 9 * MiB + 640 * 1024;
constexpr size_t WS_RS2 = 10 * MiB + 256 * 1024;
constexpr size_t WS_GATEW = 10 * MiB + 512 * 1024;
constexpr size_t WS_LIST = 11 * MiB;
constexpr size_t WS_RSL = 800 * MiB;
constexpr size_t WS_GWL = 804 * MiB;
constexpr size_t WS_WGU = 16 * MiB;
constexpr size_t WS_WD = 144 * MiB;
constexpr size_t WS_XB = 208 * MiB;
constexpr size_t WS_PROJ = 272 * MiB;
constexpr size_t WS_CHUNK = 432 * MiB;
constexpr size_t WS_UC = 544 * MiB;
constexpr size_t WS_GTOT = 576 * MiB;
constexpr size_t WS_ORAW = 577 * MiB;
constexpr int CH_WF = 0, CH_QD = 16384, CH_KT = 32768, CH_QK = 49152, CH_BYTES = 57344, UC_BYTES = 16384;
constexpr size_t WS_MIXED = 688 * MiB;
constexpr size_t WS_CONCAT = 720 * MiB;
constexpr size_t WS_X1B = 208 * MiB;
constexpr size_t WS_ACT = 272 * MiB;
constexpr size_t WS_SLAB = 544 * MiB;
constexpr size_t WS_X1 = 808 * MiB;
constexpr size_t WS_END = 872 * MiB;
static_assert(WS_ACT + (size_t)ACT_ROWS * 2048 <= WS_SLAB, "act fits");
static_assert(WS_SLAB + (size_t)NASSIGN * 2048 <= WS_END, "slab fits");

constexpr int CW_BAR = 4096;
constexpr int CW_CNT = 16384;
constexpr int CW_SEAM4 = 20480;

constexpr int LDS_BYTES = 163840;
constexpr int LDSCTL_OFF = LDS_BYTES - 1024, MISC_OFF = LDSCTL_OFF + 320, TAB_OFF = LDSCTL_OFF + 512;
constexpr int NWAVES = 8;

#define GAS __attribute__((address_space(1)))
#define LAS __attribute__((address_space(3)))
typedef unsigned short bf16;
typedef unsigned v4u __attribute__((ext_vector_type(4)));
typedef unsigned v2u __attribute__((ext_vector_type(2)));
typedef float f32x4 __attribute__((ext_vector_type(4)));
typedef float f32x2 __attribute__((ext_vector_type(2)));
typedef short bf16x8 __attribute__((ext_vector_type(8)));
typedef GAS unsigned gu32;
#define RLX_AGENT __ATOMIC_RELAXED, __HIP_MEMORY_SCOPE_AGENT
#define LDS_WAIT() asm volatile("s_waitcnt lgkmcnt(0)" ::: "memory")
#define VM_WAIT() asm volatile("s_waitcnt vmcnt(0)" ::: "memory")

__device__ __forceinline__ unsigned f2bf(float f) { unsigned u = __builtin_bit_cast(unsigned, f); return (u + 0x7fffu + ((u >> 16) & 1u)) >> 16; }
__device__ __forceinline__ unsigned pk2(float lo, float hi) { return f2bf(lo) | (f2bf(hi) << 16); }
__device__ __forceinline__ float bflo(unsigned u) { return __builtin_bit_cast(float, u << 16); }
__device__ __forceinline__ float bfhi(unsigned u) { return __builtin_bit_cast(float, u & 0xffff0000u); }
__device__ __forceinline__ unsigned pk4_fp8(float a, float b, float c, float d) { int p = __builtin_amdgcn_cvt_pk_fp8_f32(a, b, 0, false); p = __builtin_amdgcn_cvt_pk_fp8_f32(c, d, p, true); return (unsigned)p; }
constexpr float SLAB_SCALE = 16.f, SLAB_INV = 1.f / 16.f;
constexpr float W8_SCALE = 32.f, W8_INV = 1.f / 32.f;
__device__ __forceinline__ float wave_sum(float v) {
#pragma unroll
    for (int o = 1; o < 64; o <<= 1) v += __shfl_xor(v, o);
    return v;
}
__device__ __forceinline__ float frcp_(float x) { return __builtin_amdgcn_rcpf(x); }
__device__ __forceinline__ float frsq_(float x) { return __builtin_amdgcn_rsqf(x); }
__device__ __forceinline__ float fexp_(float x) { return __builtin_amdgcn_exp2f(x * 1.4426950408889634f); }
__device__ __forceinline__ float sigmoidf_(float x) { return frcp_(1.f + fexp_(-x)); }
__device__ __forceinline__ float siluf_(float x) { return x * frcp_(1.f + fexp_(-x)); }

namespace pg8 {
constexpr int BM = 256, BK = 64, HALF = 128, HTB = HALF * BK * 2, STAGE_BYTES = 8 * HTB;
__device__ __forceinline__ int lds_byte(int r, int c) { const int st = (r >> 4) * 2 + (c >> 5), rr = r & 15, cc = c & 31, ob = rr * 64 + cc * 2; return st * 1024 + (ob ^ (((ob >> 9) & 1) << 5)); }
__device__ __forceinline__ void stage_rc(int b, int& R, int& C) { const int st = b / 1024, sb = b % 1024, swz = sb ^ (((sb >> 9) & 1) << 5); R = (st >> 1) * 16 + swz / 64; C = (st & 1) * 32 + (swz % 64) / 2; }
__device__ __forceinline__ int perm32(int rho) { const int n = rho >> 4, i = rho & 15; return 8 * (i >> 2) + 4 * n + (i & 3); }
typedef __bf16 bf16x2_t __attribute__((ext_vector_type(2)));
__device__ __forceinline__ unsigned cvt_pk_bf16(float lo, float hi) { const f32x2 v = {lo, hi}; const bf16x2_t b = __builtin_convertvector(v, bf16x2_t); return __builtin_bit_cast(unsigned, b); }

struct Unit { int rt, pn, e, rb, rows; };

struct Sched {
    int nM, nN, nwg, G, c;
    __device__ __forceinline__ void init(int nM_, int nN_, int G_, int c_) { nM = nM_; nN = nN_; nwg = nM * nN; G = G_; c = c_; }
    __device__ __forceinline__ bool next(int i, int& pm, int& pn) const {
        const long L = (long)i * G + c; if (L >= nwg) return false;
        int wgid = (int)L; { const int q = nwg / 8, r = nwg % 8, xcd = wgid % 8, off = wgid / 8; wgid = (xcd < r ? xcd * (q + 1) : r * (q + 1) + (xcd - r) * q) + off; }
        const int nig = 8 * nN, gid = wgid / nig, fm = gid * 8, gsz = (nM - fm) < 8 ? (nM - fm) : 8;
        pm = fm + ((wgid % nig) % gsz); pn = (wgid % nig) / gsz; return true;
    }
};

typedef int v8i_t __attribute__((ext_vector_type(8)));
template <class P, bool F8 = false>
__device__ __forceinline__ void gemm_phase(LAS unsigned char* lds, const P& p) {
    const int tid = threadIdx.x, wid = __builtin_amdgcn_readfirstlane(tid >> 6), lane = tid & 63, wr = wid >> 2, wc = wid & 3, fr = lane & 15, fq = lane >> 4;
    const int K = p.K, RB = F8 ? K : 2 * K, nt = RB / (BK * 2);
    unsigned voffB[2];
#pragma unroll
    for (int i = 0; i < 2; ++i) { int R_, C_; stage_rc(tid * 16 + i * 8192, R_, C_); const int Rb = (R_ & ~31) + perm32(R_ & 31); voffB[i] = (unsigned)(Rb * RB + C_ * 2); }
#define PG8_AOFF(unit, dst) do { int R[2], C[2]; asm volatile("" ::: "memory"); _Pragma("unroll") for (int i_ = 0; i_ < 2; ++i_) stage_rc(tid * 16 + i_ * 8192, R[i_], C[i_]); p.a_off(unit, R, C, dst); } while (0)
    const size_t kstep = (size_t)(BK * 2);
    const size_t hstep = (size_t)HALF * RB;
    const unsigned ldsw = (unsigned)wid * 1024u;
    const int aoff = lds_byte(wr * 64 + fr, fq * 8), boff = lds_byte(wc * 32 + fr, fq * 8);
#define PG8_SA(b, h) (((b) * 2 + (h)) * HTB)
#define PG8_SB(b, h) ((4 + (b) * 2 + (h)) * HTB)
#define PG8_STAGE(bufoff, gbase, voff) do { _Pragma("unroll") for (int _i = 0; _i < 2; ++_i) \
        __builtin_amdgcn_global_load_lds((const unsigned*)((const char*)(gbase) + (voff)[_i]), (LAS unsigned*)(lds + (bufoff) + ldsw + _i * 8192), 16, 0, 0); } while (0)
#define PG8_LDA(dst, b, h) do { _Pragma("unroll") for (int m = 0; m < 4; ++m) { const v4i_t l_ = *(const LAS v4i_t*)(lds + PG8_SA(b, h) + aoff + m * 2048), h_ = *(const LAS v4i_t*)(lds + PG8_SA(b, h) + aoff + m * 2048 + 1024); dst[m] = __builtin_shufflevector(l_, h_, 0, 1, 2, 3, 4, 5, 6, 7); } } while (0)
#define PG8_LDB(dst, b, h) do { _Pragma("unroll") for (int n = 0; n < 2; ++n) { const v4i_t l_ = *(const LAS v4i_t*)(lds + PG8_SB(b, h) + boff + n * 2048), h_ = *(const LAS v4i_t*)(lds + PG8_SB(b, h) + boff + n * 2048 + 1024); dst[n] = __builtin_shufflevector(l_, h_, 0, 1, 2, 3, 4, 5, 6, 7); } } while (0)
#define PG8_HALF(x, k) __builtin_bit_cast(bf16x8, __builtin_shufflevector(x, x, 4 * (k), 4 * (k) + 1, 4 * (k) + 2, 4 * (k) + 3))
#define PG8_MMA(ai, bj, At, Bt) do { __builtin_amdgcn_s_setprio(1); \
        if constexpr (F8) { _Pragma("unroll") for (int m = 0; m < 4; ++m) _Pragma("unroll") for (int n = 0; n < 2; ++n) \
            asm volatile("v_mfma_scale_f32_16x16x128_f8f6f4 %0, %1, %2, %0, %3, %3 op_sel_hi:[0,0,0]" : "+v"(acc[ai][bj][m][n]) : "v"(Bt[n]), "v"(At[m]), "v"(mxs)); } \
        else { _Pragma("unroll") for (int m = 0; m < 4; ++m) _Pragma("unroll") for (int n = 0; n < 2; ++n) { \
            acc[ai][bj][m][n] = __builtin_amdgcn_mfma_f32_16x16x32_bf16(PG8_HALF(Bt[n], 0), PG8_HALF(At[m], 0), acc[ai][bj][m][n], 0, 0, 0); \
            acc[ai][bj][m][n] = __builtin_amdgcn_mfma_f32_16x16x32_bf16(PG8_HALF(Bt[n], 1), PG8_HALF(At[m], 1), acc[ai][bj][m][n], 0, 0, 0); } } \
        __builtin_amdgcn_s_setprio(0); } while (0)
#define PG8_WAIT_V(n) asm volatile("s_waitcnt vmcnt(" #n ")" ::: "memory")
#define PG8_WAIT_L(n) asm volatile("s_waitcnt lgkmcnt(" #n ")" ::: "memory")
#define PG8_BAR __builtin_amdgcn_s_barrier()
#define PG8_SCHED __builtin_amdgcn_sched_barrier(0)
    Unit cur, nxt; int ui = 0;
    if (!p.next(0, cur)) return;
    unsigned mxs = 0x7f7f7f7fu; asm volatile("" : "+v"(mxs));
    f32x4 acc[2][2][4][2];
#pragma unroll
    for (int a = 0; a < 2; ++a)
#pragma unroll
        for (int b = 0; b < 2; ++b)
#pragma unroll
            for (int m = 0; m < 4; ++m)
#pragma unroll
                for (int n = 0; n < 2; ++n) acc[a][b][m][n] = (f32x4){0.f, 0.f, 0.f, 0.f};
    typedef int v4i_t __attribute__((ext_vector_type(4)));
    v8i_t At[4], B0[2], B1[2];
    unsigned oA[2][2];
    PG8_AOFF(cur, oA);
    const char* cA = p.a_base(cur); const char* cB = p.b_base(cur);
    PG8_STAGE(PG8_SB(0, 0), cB, voffB); PG8_STAGE(PG8_SB(0, 1), cB + hstep, voffB); PG8_STAGE(PG8_SA(0, 0), cA, oA[0]); PG8_STAGE(PG8_SA(0, 1), cA, oA[1]);
    if (wr == 1) PG8_BAR;
    PG8_WAIT_V(2); PG8_BAR;
    PG8_STAGE(PG8_SB(1, 0), cB + kstep, voffB); PG8_STAGE(PG8_SA(1, 0), cA + kstep, oA[0]); PG8_STAGE(PG8_SB(1, 1), cB + hstep + kstep, voffB);
    PG8_WAIT_V(6); PG8_BAR;
    LAS v4u* park = (LAS v4u*)(lds + STAGE_BYTES) + tid;
    for (;;) {
        const bool has_next = p.next(ui + 1, nxt);
        const char* nA = cA; const char* nB = cB;
        { unsigned nO[2][2];
#pragma unroll
          for (int h = 0; h < 2; ++h)
#pragma unroll
              for (int i = 0; i < 2; ++i) nO[h][i] = oA[h][i];
          if (has_next) { nA = p.a_base(nxt); nB = p.b_base(nxt); PG8_AOFF(nxt, nO); }
          *park = (v4u){nO[0][0], nO[0][1], nO[1][0], nO[1][1]}; }
        for (int t = 0; t < nt; t += 2) {
            const bool last = (t == nt - 2);
            const char* a1 = cA + (size_t)(t + 1) * kstep;
            const char* a2 = last ? nA : cA + (size_t)(t + 2) * kstep; const char* b2 = last ? nB : cB + (size_t)(t + 2) * kstep;
            const char* a3 = a2 + kstep; const char* b3 = b2 + kstep;
            unsigned o2[2][2];
#pragma unroll
            for (int h = 0; h < 2; ++h)
#pragma unroll
                for (int i = 0; i < 2; ++i) o2[h][i] = oA[h][i];
            if (last) { const v4u q_ = *park; o2[0][0] = q_.x; o2[0][1] = q_.y; o2[1][0] = q_.z; o2[1][1] = q_.w; }
            PG8_LDB(B0, 0, 0); PG8_LDB(B1, 0, 1); PG8_SCHED; PG8_LDA(At, 0, 0); PG8_STAGE(PG8_SA(1, 1), a1, oA[1]);
            PG8_WAIT_V(8); PG8_WAIT_L(0); PG8_BAR; PG8_MMA(0, 0, At, B0); PG8_MMA(0, 1, At, B1); PG8_BAR; PG8_SCHED;
            PG8_LDA(At, 0, 1); PG8_STAGE(PG8_SB(0, 0), b2, voffB); PG8_STAGE(PG8_SB(0, 1), b2 + hstep, voffB); PG8_STAGE(PG8_SA(0, 0), a2, o2[0]);
            PG8_WAIT_V(8); PG8_WAIT_L(0); PG8_BAR; PG8_MMA(1, 0, At, B0); PG8_MMA(1, 1, At, B1); PG8_BAR; PG8_SCHED;
            PG8_LDB(B0, 1, 0); PG8_LDB(B1, 1, 1); PG8_SCHED; PG8_LDA(At, 1, 0); PG8_STAGE(PG8_SA(0, 1), a2, o2[1]);
            PG8_WAIT_V(8); PG8_WAIT_L(0); PG8_BAR; PG8_MMA(0, 0, At, B0); PG8_MMA(0, 1, At, B1); PG8_BAR; PG8_SCHED;
            PG8_LDA(At, 1, 1); PG8_STAGE(PG8_SB(1, 0), b3, voffB); PG8_STAGE(PG8_SB(1, 1), b3 + hstep, voffB); PG8_STAGE(PG8_SA(1, 0), a3, o2[0]);
            PG8_WAIT_V(8); PG8_WAIT_L(0); PG8_BAR; PG8_MMA(1, 0, At, B0); PG8_MMA(1, 1, At, B1); PG8_BAR; PG8_SCHED;
        }
        if (wr == 0) PG8_BAR;
        if constexpr (F8) asm volatile("s_nop 15\n\ts_nop 15" ::: "memory");
        p.epi(acc, cur, wr, wc, fr, fq);
        if (!has_next) break;
#pragma unroll
        for (int a = 0; a < 2; ++a)
#pragma unroll
            for (int b = 0; b < 2; ++b)
#pragma unroll
                for (int m = 0; m < 4; ++m)
#pragma unroll
                    for (int n = 0; n < 2; ++n) acc[a][b][m][n] = (f32x4){0.f, 0.f, 0.f, 0.f};
        cur = nxt; cA = nA; cB = nB; ++ui;
        { const v4u q_ = *park; oA[0][0] = q_.x; oA[0][1] = q_.y; oA[1][0] = q_.z; oA[1][1] = q_.w; }
        if (wr == 1) PG8_BAR;
    }
    PG8_WAIT_V(0);
    PG8_BAR;
#undef PG8_SA
#undef PG8_SB
#undef PG8_STAGE
#undef PG8_LDA
#undef PG8_LDB
#undef PG8_MMA
#undef PG8_HALF
#undef PG8_AOFF
#undef PG8_WAIT_V
#undef PG8_WAIT_L
#undef PG8_BAR
#undef PG8_SCHED
}
}

#define XB_TMO      128
#define XB_XCNT(j)  (256  + 64 * (j))
#define XB_XSUB(j)  (1280 + 64 * (j))
#define XB_XGEN(j)  (2304 + 64 * (j))
#define XB_TOP      3328
#define XB_TOPGEN   3392
#define XCD_BAR_WORDS 3456
#define XB_SPIN_CAP (1u << 18)
__device__ __forceinline__ unsigned xb_ld(unsigned* p)              { return __hip_atomic_load(p, __ATOMIC_RELAXED, __HIP_MEMORY_SCOPE_AGENT); }
__device__ __forceinline__ unsigned xb_add(unsigned* p, unsigned v) { return __hip_atomic_fetch_add(p, v, __ATOMIC_RELAXED, __HIP_MEMORY_SCOPE_AGENT); }
__device__ __forceinline__ unsigned xb_xcc_id() { return (unsigned)__builtin_amdgcn_s_getreg((3 << 11) | 20) & 0xFu; }
#define XB_SPIN(cond, bar) do { unsigned _sp = 0; while (cond) { __builtin_amdgcn_s_sleep(1); \
    if ((++_sp & 255u) == 0u) { if (xb_ld(&(bar)[XB_TMO])) break; if (_sp > XB_SPIN_CAP) { atomicAdd(&(bar)[XB_TMO], 1u); break; } } } } while (0)
struct XcdBarrier { unsigned* bar; unsigned x; volatile LAS unsigned* st; };
__device__ __forceinline__ XcdBarrier xcd_barrier_post(unsigned* bar, volatile LAS unsigned* st) {
    XcdBarrier b; b.bar = bar; b.x = xb_xcc_id(); b.st = st;
    if (threadIdx.x == 0) (void)xb_add(&bar[XB_XCNT(b.x)], 1u);
    return b;
}
__device__ __forceinline__ void xcd_barrier_complete(unsigned* bar, unsigned x, unsigned& nloc, unsigned& nx) {
    const unsigned G = gridDim.x * gridDim.y * gridDim.z;
    unsigned sum, cnt, mine, sp = 0u;
    for (;;) {
        sum = 0u; cnt = 0u; mine = 0u;
#pragma unroll
        for (unsigned j = 0; j < 16; ++j) { const unsigned c = xb_ld(&bar[XB_XCNT(j)]); sum += c; cnt += (c > 0u) ? 1u : 0u; mine = (j == x) ? c : mine; }
        if (sum == G) break;
        __builtin_amdgcn_s_sleep(1);
        if ((++sp & 255u) == 0u) { if (xb_ld(&bar[XB_TMO])) break; if (sp > XB_SPIN_CAP) { atomicAdd(&bar[XB_TMO], 1u); break; } }
    }
    nloc = mine > 0u ? mine : 1u; nx = cnt > 0u ? cnt : 1u;
}
__device__ __forceinline__ void xcd_barrier(const XcdBarrier& b) {
    asm volatile("s_waitcnt vmcnt(0)" ::: "memory");
    __syncthreads();
    if (threadIdx.x == 0) {
        unsigned* bar = b.bar;
        __builtin_amdgcn_s_waitcnt(0);
        unsigned nloc = b.st[0], nx = b.st[1];
        if (nloc == 0u) { xcd_barrier_complete(bar, b.x, nloc, nx); b.st[0] = nloc; b.st[1] = nx; }
        const unsigned old = xb_add(&bar[XB_XSUB(b.x)], 1u);
        const unsigned gen = old / nloc;
        if (old + 1u == (gen + 1u) * nloc) {
            __builtin_amdgcn_fence(__ATOMIC_RELEASE, "agent");
            asm volatile("s_waitcnt vmcnt(0)" ::: "memory");
            const unsigned og = xb_add(&bar[XB_TOP], 1u);
            const unsigned tg = og / nx;
            if (og + 1u == (tg + 1u) * nx) xb_add(&bar[XB_TOPGEN], 1u);
            else XB_SPIN(xb_ld(&bar[XB_TOPGEN]) == tg, bar);
            __builtin_amdgcn_fence(__ATOMIC_ACQUIRE, "agent");
            xb_add(&bar[XB_XGEN(b.x)], 1u);
            asm volatile("s_waitcnt vmcnt(0)" ::: "memory");
        } else {
            XB_SPIN(xb_ld(&bar[XB_XGEN(b.x)]) == gen, bar);
            __builtin_amdgcn_fence(__ATOMIC_ACQUIRE, "agent");
            asm volatile("s_waitcnt vmcnt(0)" ::: "memory");
        }
    }
    __syncthreads();
}

struct Frame {
    LAS unsigned char* lds;
    int tid, lane, wave, vcu, G;
    const float* in[18];
    float* out;
    unsigned char* ws;
};
using pg8::Unit;
using pg8::cvt_pk_bf16;

struct ProbBase {
    int K; int RB; pg8::Sched S;
    __device__ __forceinline__ void lin_off(const int (&R)[2], const int (&C)[2], unsigned (&off)[2][2]) const {
#pragma unroll
        for (int h = 0; h < 2; ++h)
#pragma unroll
            for (int i = 0; i < 2; ++i) off[h][i] = (unsigned)((h * 128 + R[i]) * RB + C[i] * 2);
    }
};
struct ProbIn : ProbBase {
    const bf16* A; const bf16* Bt; bf16* O; const float* rs;
    __device__ __forceinline__ bool next(int i, Unit& u) const { int pm, pn; if (!S.next(i, pm, pn)) return false; u.rt = pm; u.pn = pn; u.e = 0; u.rb = pm; u.rows = 256; return true; }
    __device__ __forceinline__ const char* a_base(const Unit& u) const { return (const char*)A + (size_t)u.rt * 256 * RB; }
    __device__ __forceinline__ const char* b_base(const Unit& u) const { return (const char*)Bt + (size_t)u.pn * 256 * RB; }
    __device__ __forceinline__ void a_off(const Unit&, const int (&R)[2], const int (&C)[2], unsigned (&off)[2][2]) const { lin_off(R, C, off); }
    __device__ __forceinline__ void epi(const f32x4 (&acc)[2][2][4][2], const Unit& u, int wr, int wc, int fr, int fq) const {
        const int row0 = u.rt * 256 + wr * 64 + fr, col0 = u.pn * 256 + wc * 32 + 8 * fq;
#pragma unroll
        for (int ai = 0; ai < 2; ++ai)
#pragma unroll
            for (int m = 0; m < 4; ++m) { const int row = row0 + ai * 128 + m * 16; const float sc = rs[row]; bf16* rowp = O + (size_t)row * NPROJ + col0;
#pragma unroll
                for (int bj = 0; bj < 2; ++bj) { const f32x4 v0 = acc[ai][bj][m][0] * sc, v1 = acc[ai][bj][m][1] * sc; v4u w;
                    w.x = cvt_pk_bf16(v0[0], v0[1]); w.y = cvt_pk_bf16(v0[2], v0[3]); w.z = cvt_pk_bf16(v1[0], v1[1]); w.w = cvt_pk_bf16(v1[2], v1[3]);
                    *(v4u*)(rowp + bj * 128) = w; } }
    }
};
struct ProbPool : ProbBase {
    const bf16* A; const bf16* Bt; bf16* O;
    __device__ __forceinline__ bool next(int i, Unit& u) const { int pm, pn; if (!S.next(i, pm, pn)) return false; u.rt = pm; u.pn = pn; u.e = 0; u.rb = pm; u.rows = 256; return true; }
    __device__ __forceinline__ const char* a_base(const Unit& u) const { return (const char*)A + (size_t)u.rt * 256 * RB; }
    __device__ __forceinline__ const char* b_base(const Unit& u) const { return (const char*)Bt + (size_t)u.pn * 256 * RB; }
    __device__ __forceinline__ void a_off(const Unit&, const int (&R)[2], const int (&C)[2], unsigned (&off)[2][2]) const { lin_off(R, C, off); }
    __device__ __forceinline__ void epi(const f32x4 (&acc)[2][2][4][2], const Unit& u, int wr, int wc, int fr, int fq) const {
        const int row0 = u.rt * 256 + wr * 64 + fr, col0 = 512 + u.pn * 256 + wc * 32 + 8 * fq;
#pragma unroll
        for (int ai = 0; ai < 2; ++ai)
#pragma unroll
            for (int m = 0; m < 4; ++m) { const int row = row0 + ai * 128 + m * 16; bf16* rowp = O + (size_t)row * DM + col0;
#pragma unroll
                for (int bj = 0; bj < 2; ++bj) { const f32x4 v0 = acc[ai][bj][m][0], v1 = acc[ai][bj][m][1]; v4u w;
                    w.x = cvt_pk_bf16(v0[0], v0[1]); w.y = cvt_pk_bf16(v0[2], v0[3]); w.z = cvt_pk_bf16(v1[0], v1[1]); w.w = cvt_pk_bf16(v1[2], v1[3]);
                    *(v4u*)(rowp + bj * 128) = w; } }
    }
};
struct ProbOut : ProbBase {
    const bf16* A; const bf16* Bt; const bf16* X; bf16* O;
    __device__ __forceinline__ bool next(int i, Unit& u) const { int pm, pn; if (!S.next(i, pm, pn)) return false; u.rt = pm; u.pn = pn; u.e = 0; u.rb = pm; u.rows = 256; return true; }
    __device__ __forceinline__ const char* a_base(const Unit& u) const { return (const char*)A + (size_t)u.rt * 256 * RB; }
    __device__ __forceinline__ const char* b_base(const Unit& u) const { return (const char*)Bt + (size_t)u.pn * 256 * RB; }
    __device__ __forceinline__ void a_off(const Unit&, const int (&R)[2], const int (&C)[2], unsigned (&off)[2][2]) const { lin_off(R, C, off); }
    __device__ __forceinline__ void epi(const f32x4 (&acc)[2][2][4][2], const Unit& u, int wr, int wc, int fr, int fq) const {
        const int row0 = u.rt * 256 + wr * 64 + fr, col0 = u.pn * 256 + wc * 32 + 8 * fq;
#pragma unroll
        for (int ai = 0; ai < 2; ++ai)
#pragma unroll
            for (int m = 0; m < 4; ++m) { const size_t off = (size_t)(row0 + ai * 128 + m * 16) * DM + col0;
#pragma unroll
                for (int bj = 0; bj < 2; ++bj) { const v4u xv = *(const v4u*)(X + off + bj * 128); const f32x4 a = acc[ai][bj][m][0], b = acc[ai][bj][m][1];
                    *(v4u*)(O + off + bj * 128) = (v4u){cvt_pk_bf16(bflo(xv.x) + a.x, bfhi(xv.x) + a.y), cvt_pk_bf16(bflo(xv.y) + a.z, bfhi(xv.y) + a.w),
                                                        cvt_pk_bf16(bflo(xv.z) + b.x, bfhi(xv.z) + b.y), cvt_pk_bf16(bflo(xv.w) + b.z, bfhi(xv.w) + b.w)}; } }
    }
};
struct MoeTab { const LAS int* pref; const LAS int* cnt; };
__device__ __forceinline__ void moe_decode(const MoeTab& T, int rt, Unit& u) {
    int e = 0;
#pragma unroll 1
    for (int j = 1; j < NE; ++j) if (T.pref[j] <= rt) e = j;
    u.e = e; u.rb = rt - T.pref[e]; const int left = T.cnt[e] - u.rb * 256; u.rows = left < 256 ? left : 256;
}
struct ProbGU : ProbBase {
    MoeTab T; const unsigned char* A; const unsigned char* Bt; unsigned char* O; const int* list; const float* rs2; const float* bgu;
    __device__ __forceinline__ bool next(int i, Unit& u) const { int pm, pn; if (!S.next(i, pm, pn)) return false; u.rt = pm; u.pn = pn; moe_decode(T, pm, u); return true; }
    __device__ __forceinline__ const char* a_base(const Unit&) const { return (const char*)A; }
    __device__ __forceinline__ const char* b_base(const Unit& u) const { return (const char*)Bt + ((size_t)u.e * 2048 + (size_t)u.pn * 256) * RB; }
    __device__ __forceinline__ void a_off(const Unit& u, const int (&R)[2], const int (&C)[2], unsigned (&off)[2][2]) const {
        const int* lp = list + (size_t)u.e * LISTCAP + u.rb * 256;
#pragma unroll
        for (int h = 0; h < 2; ++h)
#pragma unroll
            for (int i = 0; i < 2; ++i) { const int r = h * 128 + R[i]; const int ent = (r < u.rows) ? lp[r] : 0; off[h][i] = (unsigned)(ent >> 2) * (unsigned)RB + (unsigned)C[i] * 2u; }
    }
    __device__ __forceinline__ void epi(const f32x4 (&acc)[2][2][4][2], const Unit& u, int wr, int wc, int fr, int fq) const {
        const float* rsp = rs2 + (size_t)u.e * LISTCAP + u.rb * 256;
        const int j0 = wc * 32 + 8 * fq;
        const float* bg = bgu + (size_t)u.e * 2048 + u.pn * 256 + j0;
        f32x4 bgv[2], buv[2];
#pragma unroll
        for (int n = 0; n < 2; ++n) { bgv[n] = *(const f32x4*)(bg + 4 * n); buv[n] = *(const f32x4*)(bg + 128 + 4 * n); }
#pragma unroll
        for (int ai = 0; ai < 2; ++ai)
#pragma unroll
            for (int m = 0; m < 4; ++m) { const int r = ai * 128 + wr * 64 + m * 16 + fr;
                if (r < u.rows) { const float sc = rsp[r] * W8_INV; unsigned w[2];
#pragma unroll
                    for (int n = 0; n < 2; ++n) { float a[4];
#pragma unroll
                        for (int q = 0; q < 4; ++q) { float gt = acc[ai][0][m][n][q] * sc + bgv[n][q], up = acc[ai][1][m][n][q] * sc + buv[n][q];
                            gt = fminf(gt, 7.f); up = fminf(fmaxf(up, -7.f), 7.f); a[q] = (up + 1.f) * gt * frcp_(1.f + fexp_(-1.702f * gt)); }
                        w[n] = pk4_fp8(a[0], a[1], a[2], a[3]); }
                    *(v2u*)(O + (size_t)(u.rt * 256 + r) * DE + u.pn * 128 + j0) = (v2u){w[0], w[1]}; } }
    }
};
struct ProbDown : ProbBase {
    MoeTab T; const unsigned char* A; const unsigned char* Bt; unsigned char* O; const int* list; const float* gw; const float* bd;
    __device__ __forceinline__ bool next(int i, Unit& u) const { int pm, pn; if (!S.next(i, pm, pn)) return false; u.rt = pm; u.pn = pn; moe_decode(T, pm, u); return true; }
    __device__ __forceinline__ const char* a_base(const Unit& u) const { return (const char*)A + (size_t)u.rt * 256 * RB; }
    __device__ __forceinline__ const char* b_base(const Unit& u) const { return (const char*)Bt + ((size_t)u.e * 1024 + (size_t)u.pn * 256) * RB; }
    __device__ __forceinline__ void a_off(const Unit&, const int (&R)[2], const int (&C)[2], unsigned (&off)[2][2]) const { lin_off(R, C, off); }
    __device__ __forceinline__ void epi(const f32x4 (&acc)[2][2][4][2], const Unit& u, int wr, int wc, int fr, int fq) const {
        const int* lp = list + (size_t)u.e * LISTCAP + u.rb * 256;
        const int c0 = u.pn * 256 + wc * 32 + 8 * fq;
        const float* gwp = gw + (size_t)u.e * LISTCAP + u.rb * 256;
        const float* bp = bd + (size_t)u.e * DM + c0;
        f32x4 bv[2][2];
#pragma unroll
        for (int bj = 0; bj < 2; ++bj)
#pragma unroll
            for (int n = 0; n < 2; ++n) bv[bj][n] = *(const f32x4*)(bp + bj * 128 + 4 * n);
#pragma unroll
        for (int ai = 0; ai < 2; ++ai)
#pragma unroll
            for (int m = 0; m < 4; ++m) { const int r = ai * 128 + wr * 64 + m * 16 + fr;
                if (r < u.rows) { const int ent = lp[r]; const float g = gwp[r]; unsigned char* rowp = O + (size_t)ent * DM + c0;
#pragma unroll
                    for (int bj = 0; bj < 2; ++bj) { const f32x4 v0 = (acc[ai][bj][m][0] * W8_INV + bv[bj][0]) * g, v1 = (acc[ai][bj][m][1] * W8_INV + bv[bj][1]) * g;
                        *(v2u*)(rowp + bj * 128) = (v2u){pk4_fp8(v0[0] * SLAB_SCALE, v0[1] * SLAB_SCALE, v0[2] * SLAB_SCALE, v0[3] * SLAB_SCALE), pk4_fp8(v1[0] * SLAB_SCALE, v1[1] * SLAB_SCALE, v1[2] * SLAB_SCALE, v1[3] * SLAB_SCALE)}; } } }
    }
};

typedef short v4i16_t __attribute__((ext_vector_type(4)));
__device__ __forceinline__ void tr_item(const float* W, int ldw, int k0, int nsrc0, bf16* WT, size_t drow0, int ldk, int dk0, const float* ks, const float* ns, LAS unsigned char* scr, int lane) {
    const int kr = lane >> 4, n4 = (lane & 15) * 4;
    f32x4 nsc = (f32x4){1.f, 1.f, 1.f, 1.f}; if (ns) nsc = *(const f32x4*)(ns + nsrc0 + n4);
    f32x4 v[16];
#pragma unroll
    for (int i = 0; i < 16; ++i) v[i] = *(const f32x4*)(W + (size_t)(k0 + 4 * i + kr) * ldw + nsrc0 + n4);
#pragma unroll
    for (int i = 0; i < 16; ++i) { f32x4 x = v[i] * nsc; if (ks) x = x * ks[k0 + 4 * i + kr];
        *(LAS v2u*)(scr + (4 * i + kr) * 192 + n4 * 2) = (v2u){pg8::cvt_pk_bf16(x.x, x.y), pg8::cvt_pk_bf16(x.z, x.w)}; }
    LDS_WAIT(); asm volatile("" ::: "memory");
    const int G = lane >> 4, li = lane & 15, q = li >> 2, p = li & 3;
    const LAS unsigned char* rb = scr + q * 192 + (16 * G + 4 * p) * 2;
    bf16* dst = WT + (drow0 + 16 * G + li) * (size_t)ldk + dk0 + k0;
#pragma unroll
    for (int kc = 0; kc < 8; ++kc) {
        const v4i16_t lo = __builtin_amdgcn_ds_read_tr16_b64_v4i16((LAS v4i16_t*)(rb + (8 * kc) * 192));
        const v4i16_t hi = __builtin_amdgcn_ds_read_tr16_b64_v4i16((LAS v4i16_t*)(rb + (8 * kc + 4) * 192));
        const v2u l2 = __builtin_bit_cast(v2u, lo), h2 = __builtin_bit_cast(v2u, hi);
        *(v4u*)(dst + 8 * kc) = (v4u){l2.x, l2.y, h2.x, h2.y};
    }
    LDS_WAIT(); asm volatile("" ::: "memory");
}

template <int KT, int NT>
__device__ __forceinline__ void tr_item8(const float* W, int ldw, int k0, int nsrc0, unsigned char* WT, size_t drow0, int ldk, const float* ks, float mul, LAS unsigned char* scr, int lane) {
    constexpr int LPR = NT / 4, RPL = 64 / LPR, PA = NT * 2 + 64;
    static_assert(KT * NT == 4096 && (PA / 4) % 32 == 16, "tile geometry");
    const int kr = lane / LPR, n4 = (lane % LPR) * 4;
    f32x4 v[16];
#pragma unroll
    for (int i = 0; i < 16; ++i) v[i] = *(const f32x4*)(W + (size_t)(k0 + RPL * i + kr) * ldw + nsrc0 + n4);
#pragma unroll
    for (int i = 0; i < 16; ++i) { const float sc = ks ? ks[k0 + RPL * i + kr] * mul : mul; const f32x4 x = v[i] * sc;
        *(LAS v2u*)(scr + (RPL * i + kr) * PA + n4 * 2) = (v2u){pg8::cvt_pk_bf16(x.x, x.y), pg8::cvt_pk_bf16(x.z, x.w)}; }
    LDS_WAIT(); asm volatile("" ::: "memory");
    const int G = lane >> 4, li = lane & 15, q = li >> 2, p = li & 3;
#pragma unroll
    for (int ps = 0; ps < NT / 64; ++ps) {
        const LAS unsigned char* rb = scr + q * PA + (16 * (G + 4 * ps) + 4 * p) * 2;
        unsigned char* dst = WT + (drow0 + 16 * (G + 4 * ps) + li) * (size_t)ldk + k0;
#pragma unroll
        for (int kq = 0; kq < KT / 16; ++kq) {
            v2u t[4];
#pragma unroll
            for (int u = 0; u < 4; ++u) t[u] = __builtin_bit_cast(v2u, __builtin_amdgcn_ds_read_tr16_b64_v4i16((LAS v4i16_t*)(rb + (16 * kq + 4 * u) * PA)));
            v4u o;
            o.x = pk4_fp8(bflo(t[0].x), bfhi(t[0].x), bflo(t[0].y), bfhi(t[0].y)); o.y = pk4_fp8(bflo(t[1].x), bfhi(t[1].x), bflo(t[1].y), bfhi(t[1].y));
            o.z = pk4_fp8(bflo(t[2].x), bfhi(t[2].x), bflo(t[2].y), bfhi(t[2].y)); o.w = pk4_fp8(bflo(t[3].x), bfhi(t[3].x), bflo(t[3].y), bfhi(t[3].y));
            *(v4u*)(dst + 16 * kq) = o;
        }
    }
    LDS_WAIT(); asm volatile("" ::: "memory");
}

constexpr int TRF_T1 = 128 * 192, TRF_T2 = 64 * 144, TRF_BYTES = TRF_T1 + TRF_T2;
__device__ __forceinline__ void tr_item8f(const float* W, int ldw, int k0, int nsrc0, unsigned char* WT, size_t drow0, int ldk, const float* ks, float mul, LAS unsigned char* scr, int lane) {
    const int kr = lane >> 4, n4 = (lane & 15) * 4;
#pragma unroll
    for (int hb = 0; hb < 2; ++hb) {
        f32x4 v[16];
#pragma unroll
        for (int i = 0; i < 16; ++i) v[i] = *(const f32x4*)(W + (size_t)(k0 + 64 * hb + 4 * i + kr) * ldw + nsrc0 + n4);
#pragma unroll
        for (int i = 0; i < 16; ++i) { const float sc = ks ? ks[k0 + 64 * hb + 4 * i + kr] * mul : mul; const f32x4 x = v[i] * sc;
            *(LAS v2u*)(scr + (64 * hb + 4 * i + kr) * 192 + n4 * 2) = (v2u){pg8::cvt_pk_bf16(x.x, x.y), pg8::cvt_pk_bf16(x.z, x.w)}; }
    }
    LDS_WAIT(); asm volatile("" ::: "memory");
    const int G = lane >> 4, li = lane & 15, q = li >> 2, p = li & 3;
    const LAS unsigned char* rb = scr + q * 192 + (16 * G + 4 * p) * 2;
    LAS unsigned char* t2 = scr + TRF_T1;
#pragma unroll
    for (int kq = 0; kq < 8; ++kq) {
        v2u t[4];
#pragma unroll
        for (int u = 0; u < 4; ++u) t[u] = __builtin_bit_cast(v2u, __builtin_amdgcn_ds_read_tr16_b64_v4i16((LAS v4i16_t*)(rb + (16 * kq + 4 * u) * 192)));
        v4u o;
        o.x = pk4_fp8(bflo(t[0].x), bfhi(t[0].x), bflo(t[0].y), bfhi(t[0].y)); o.y = pk4_fp8(bflo(t[1].x), bfhi(t[1].x), bflo(t[1].y), bfhi(t[1].y));
        o.z = pk4_fp8(bflo(t[2].x), bfhi(t[2].x), bflo(t[2].y), bfhi(t[2].y)); o.w = pk4_fp8(bflo(t[3].x), bfhi(t[3].x), bflo(t[3].y), bfhi(t[3].y));
        *(LAS v4u*)(t2 + (16 * G + li) * 144 + 16 * kq) = o;
    }
    LDS_WAIT(); asm volatile("" ::: "memory");
    const int r8 = lane >> 3, c8 = lane & 7;
#pragma unroll
    for (int j = 0; j < 8; ++j) { const v4u o = *(const LAS v4u*)(t2 + (8 * j + r8) * 144 + 16 * c8);
        *(v4u*)(WT + (drow0 + 8 * j + r8) * (size_t)ldk + k0 + 16 * c8) = o; }
    LDS_WAIT(); asm volatile("" ::: "memory");
}

constexpr int TRK = 128, TRN = 64;
constexpr int MOE_PREP_ITEMS = 32 * (1024 / TRK) * (2048 / TRN) + 32 * (1024 / TRK) * (1024 / TRN);
__device__ __forceinline__ void moe_weight_prep(Frame& F, int b0, int lo, int hi) {
    const float* fnw = F.in[10]; const float* w_gu = F.in[13]; const float* w_d = F.in[15];
    unsigned char* WguT = F.ws + WS_WGU; unsigned char* WdT = F.ws + WS_WD;
    constexpr int TW = 4;
    if (F.wave >= TW) return;
    LAS unsigned char* scr = F.lds + F.wave * TRF_BYTES;
    const int gw = ((int)blockIdx.x - b0) * TW + F.wave, NGW = (F.G - b0) * TW;
    constexpr int NKB = 1024 / TRK, NNB_GU = 2048 / TRN, NNB_D = 1024 / TRN, SEGN = 128 / TRN;
    constexpr int I_GU = 32 * NKB * NNB_GU;
    for (int it = lo + gw; it < hi; it += NGW) {
        int r = it;
        if (r < I_GU) { const int e = r / (NKB * NNB_GU), r2 = r % (NKB * NNB_GU), kb = r2 / NNB_GU, cb = r2 % NNB_GU;
            const int half = cb / (NNB_GU / 2), t = (cb % (NNB_GU / 2)) / SEGN, nb = cb % SEGN;
            tr_item8f(w_gu + (size_t)e * DM * 2048, 2048, kb * TRK, half * 1024 + t * 128 + nb * TRN, WguT, (size_t)e * 2048 + t * 256 + half * 128 + nb * TRN, DM, fnw, W8_SCALE, scr, F.lane); continue; } r -= I_GU;
        { const int e = r / (NKB * NNB_D), r2 = r % (NKB * NNB_D), kb = r2 / NNB_D, nb = r2 % NNB_D;
          tr_item8f(w_d + (size_t)e * DE * DM, DM, kb * TRK, nb * TRN, WdT, (size_t)e * 1024 + nb * TRN, DE, nullptr, W8_SCALE, scr, F.lane); }
    }
}
static_assert(4 * TRF_BYTES <= LDSCTL_OFF, "transposer LDS");
constexpr int MOE_PREP_SPLIT = 0;

__device__ __forceinline__ void phase_prep(Frame& F) {
    const float* x = F.in[0]; const float* anw = F.in[1]; const float* w_in = F.in[2]; const float* a_log = F.in[4]; const float* dt_bias = F.in[5];
    const float* pool_w = F.in[7]; const float* pool_scale = F.in[8]; const float* w_out = F.in[9]; const float* fnw = F.in[10];
    const float* w_router = F.in[11]; const float* w_gu = F.in[13]; const float* b_gu = F.in[14]; const float* w_d = F.in[15];
    bf16* WinT = (bf16*)(F.ws + WS_WIN); bf16* WoutT = (bf16*)(F.ws + WS_WOUT); bf16* WpoolT = (bf16*)(F.ws + WS_WPOOL);
    bf16* WguT = (bf16*)(F.ws + WS_WGU); bf16* WdT = (bf16*)(F.ws + WS_WD);
    bf16* WrI = (bf16*)(F.ws + WS_WR); float* bguP = (float*)(F.ws + WS_BGU);
    bf16* xb = (bf16*)(F.ws + WS_XB); float* rs1 = (float*)(F.ws + WS_RS1); float* betaA = (float*)(F.ws + WS_BETA); float* gA = (float*)(F.ws + WS_G);
    LAS unsigned char* scr = F.lds + F.wave * 12288;
    LAS float* W8T = (LAS float*)(F.lds + 98304);
    const int gw = F.vcu * NWAVES + F.wave, NGW = F.G * NWAVES;
    const int gt = F.vcu * 512 + F.tid, NGT = F.G * 512;
    for (int idx = F.tid; idx < 8192; idx += 512) { const int k = idx >> 3, c = idx & 7; W8T[c * 1024 + k] = anw[k] * w_in[(size_t)k * DIN + 2048 + c]; }
    __syncthreads();
    constexpr int I_IN1 = 16 * 32, I_OUT = 16 * 16;
    constexpr int NITEMS = I_IN1 + I_OUT;
    for (int it = gw; it < NITEMS; it += NGW) {
        int r = it;
        if (r < I_IN1) { const int kb = r / 32, nb = r % 32; tr_item(w_in, DIN, kb * 64, nb * 64, WinT, (size_t)nb * 64, DM, 0, anw, nullptr, scr, F.lane); continue; } r -= I_IN1;
        { const int kb = r / 16, nb = r % 16; tr_item(w_out, DM, kb * 64, nb * 64, WoutT, (size_t)nb * 64, DM, 0, nullptr, nullptr, scr, F.lane); }
    }
    __syncthreads();
    for (int task = blockIdx.x; task < 256; task += F.G) {
        const int g = task >> 6, kb = (task >> 2) & 15, dq = task & 3;
        LAS float* Wt = (LAS float*)F.lds;
        LAS float* Pw = (LAS float*)(F.lds + 33024);
        for (int idx = F.tid; idx < 64 * 32; idx += 512) { const int k = idx >> 5, c4 = (idx & 31) * 4; const f32x4 v = *(const f32x4*)(w_in + (size_t)(kb * 64 + k) * DIN + 2056 + g * 128 + c4);
            Wt[k * 129 + c4] = v.x; Wt[k * 129 + c4 + 1] = v.y; Wt[k * 129 + c4 + 2] = v.z; Wt[k * 129 + c4 + 3] = v.w; }
        for (int idx = F.tid; idx < 128 * 8; idx += 512) { const int c = idx >> 3, d4 = (idx & 7) * 4; *(LAS f32x4*)(Pw + c * 32 + d4) = *(const f32x4*)(pool_w + (size_t)g * 16384 + c * 128 + dq * 32 + d4); }
        __syncthreads();
        const int k = F.tid & 63, d4 = (F.tid >> 6) * 4;
        f32x4 acc = (f32x4){0.f, 0.f, 0.f, 0.f};
#pragma unroll 8
        for (int c = 0; c < 128; ++c) acc += *(const LAS f32x4*)(Pw + c * 32 + d4) * Wt[k * 129 + c];
        const int n0 = g * 128 + dq * 32 + d4; const f32x4 ps = *(const f32x4*)(pool_scale + n0); const float an = anw[kb * 64 + k];
        bf16* dst = WinT + (size_t)(2048 + n0) * DM + kb * 64 + k;
        dst[0] = (bf16)f2bf(acc.x * ps.x * an); dst[DM] = (bf16)f2bf(acc.y * ps.y * an); dst[2 * DM] = (bf16)f2bf(acc.z * ps.z * an); dst[3 * DM] = (bf16)f2bf(acc.w * ps.w * an);
        __syncthreads();
    }
    moe_weight_prep(F, 0, 0, MOE_PREP_SPLIT);
    for (int idx = gt; idx < NE * 2048; idx += NGT) { const int e = idx >> 11, r = idx & 2047, t = r >> 8, j = r & 255, half = j >> 7, jj = j & 127; bguP[idx] = b_gu[(size_t)e * 2048 + half * 1024 + t * 128 + jj]; }
    for (int idx = gt; idx < 64 * 64 * 8; idx += NGT) { const int j = idx & 7, ln = (idx >> 3) & 63, fr2 = idx >> 9, nb = fr2 & 1, ks = fr2 >> 1;
        const int k = 32 * ks + 8 * (ln >> 4) + j, e = 16 * nb + (ln & 15); const float v = fnw[k] * w_router[(size_t)k * NE + e];
        const unsigned hb = f2bf(v); const float hf = __builtin_bit_cast(float, hb << 16); const unsigned lb = f2bf(v - hf);
        WrI[((size_t)(fr2 * 2 + 0) * 64 + ln) * 8 + j] = (bf16)hb; WrI[((size_t)(fr2 * 2 + 1) * 64 + ln) * 8 + j] = (bf16)lb; }
    for (int m = gw; m < NTOK; m += NGW) {
        const f32x4* xr = (const f32x4*)(x + (size_t)m * DM) + F.lane;
        f32x4 v[4]; float ss = 0.f; float d8[8];
#pragma unroll
        for (int c = 0; c < 8; ++c) d8[c] = 0.f;
#pragma unroll
        for (int j = 0; j < 4; ++j) { v[j] = xr[64 * j]; ss += (v[j].x * v[j].x + v[j].y * v[j].y) + (v[j].z * v[j].z + v[j].w * v[j].w); }
#pragma unroll
        for (int c = 0; c < 8; ++c)
#pragma unroll
            for (int j = 0; j < 4; ++j) { const f32x4 w = *(const LAS f32x4*)(W8T + c * 1024 + 256 * j + 4 * F.lane); d8[c] += (v[j].x * w.x + v[j].y * w.y) + (v[j].z * w.z + v[j].w * w.w); }
        ss = wave_sum(ss);
#pragma unroll
        for (int c = 0; c < 8; ++c) d8[c] = wave_sum(d8[c]);
        const float rs = 1.f / sqrtf(ss * (1.f / DM) + 1e-6f);
        unsigned long long* o8 = (unsigned long long*)(xb + (size_t)m * DM) + F.lane;
#pragma unroll
        for (int j = 0; j < 4; ++j) o8[64 * j] = (unsigned long long)pk2(v[j].x, v[j].y) | ((unsigned long long)pk2(v[j].z, v[j].w) << 32);
        if (F.lane == 0) rs1[m] = rs;
        if (F.lane < 4) {
            float bl = 0.f, al = 0.f;
#pragma unroll
            for (int c = 0; c < 4; ++c) { bl = (F.lane == c) ? d8[c] : bl; al = (F.lane == c) ? d8[4 + c] : al; }
            bl *= rs; al *= rs;
            betaA[(size_t)m * 4 + F.lane] = 1.f / (1.f + expf(-bl));
            const float z = al + dt_bias[F.lane]; const float sp = z > 20.f ? z : log1pf(expf(z));
            gA[(size_t)m * 4 + F.lane] = -expf(a_log[F.lane]) * sp;
        }
    }
}

__device__ __forceinline__ void phase_mix(Frame& F) {
    const bf16* proj = (const bf16*)(F.ws + WS_PROJ); bf16* mixed = (bf16*)(F.ws + WS_CONCAT) + 512;
    const int gw = F.vcu * NWAVES + F.wave, NGW = F.G * NWAVES;
    const int ch = 8 * F.lane, gi = F.lane >> 4, win = 2 << gi, hal = win - 1;
    for (int rbk = gw; rbk < NTOK / 16; rbk += NGW) {
        const int m0 = rbk * 16, t0 = m0 % SEQ;
        v4u X[31];
#pragma unroll
        for (int k = 0; k < 31; ++k) { X[k] = (v4u){0u, 0u, 0u, 0u}; if (k >= 15 - hal && t0 - 15 + k >= 0) X[k] = *(const v4u*)(proj + (size_t)(m0 - 15 + k) * NPROJ + 2048 + ch); }
        float s[8];
#pragma unroll
        for (int q = 0; q < 8; ++q) s[q] = 0.f;
#pragma unroll
        for (int k = 0; k < 15; ++k) { s[0] += bflo(X[k].x); s[1] += bfhi(X[k].x); s[2] += bflo(X[k].y); s[3] += bfhi(X[k].y); s[4] += bflo(X[k].z); s[5] += bfhi(X[k].z); s[6] += bflo(X[k].w); s[7] += bfhi(X[k].w); }
#pragma unroll
        for (int r = 0; r < 16; ++r) {
            const v4u u = X[15 + r];
            const float p[8] = {bflo(u.x), bfhi(u.x), bflo(u.y), bfhi(u.y), bflo(u.z), bfhi(u.z), bflo(u.w), bfhi(u.w)};
#pragma unroll
            for (int q = 0; q < 8; ++q) s[q] += p[q];
            const int tt = t0 + r + 1; const float ic = 1.f / (float)(tt < win ? tt : win);
            v4u o; o.x = pk2(s[0] * ic - p[0], s[1] * ic - p[1]); o.y = pk2(s[2] * ic - p[2], s[3] * ic - p[3]); o.z = pk2(s[4] * ic - p[4], s[5] * ic - p[5]); o.w = pk2(s[6] * ic - p[6], s[7] * ic - p[7]);
            *(v4u*)(mixed + (size_t)(m0 + r) * DM + ch) = o;
            const v4u od = gi == 0 ? X[14 + r] : gi == 1 ? X[12 + r] : gi == 2 ? X[8 + r] : X[r];
            s[0] -= bflo(od.x); s[1] -= bfhi(od.x); s[2] -= bflo(od.y); s[3] -= bfhi(od.y); s[4] -= bflo(od.z); s[5] -= bfhi(od.z); s[6] -= bflo(od.w); s[7] -= bfhi(od.w);
        }
    }
}

typedef float f32x16 __attribute__((ext_vector_type(16)));
__device__ __forceinline__ bf16x8 pack8(const f32x4 a, const f32x4 b) {
    v4u w; w.x = cvt_pk_bf16(a[0], a[1]); w.y = cvt_pk_bf16(a[2], a[3]); w.z = cvt_pk_bf16(b[0], b[1]); w.w = cvt_pk_bf16(b[2], b[3]);
    return __builtin_bit_cast(bf16x8, w);
}
__device__ __forceinline__ void fmac_(float& acc, float a, float b) { asm("v_fmac_f32 %0, %1, %2" : "+v"(acc) : "v"(a), "v"(b)); }
__device__ __forceinline__ float bf2f(unsigned short u) { return __builtin_bit_cast(float, (unsigned)u << 16); }

constexpr int SOLVE_D = 5;
struct RQ { int i, j; };
__host__ __device__ constexpr int solve_nq(int i) { return (i + 3) / 4; }
__host__ __device__ constexpr RQ solve_adv(int i, int j, int d) { while (d-- > 0 && i < 64) { if (j + 1 < solve_nq(i)) ++j; else { ++i; j = 0; } } return RQ{i, j}; }
template <int I, int J> __device__ __forceinline__ void solve_step(float (&U)[64], const LAS float* Am, const f32x4 (&win)[SOLVE_D], float s0, float s1, float s2, float s3) {
    if constexpr (I < 64) {
        constexpr RQ P = solve_adv(I, J, SOLVE_D);
        f32x4 nw = (f32x4){0.f, 0.f, 0.f, 0.f};
        if constexpr (P.i < 64) nw = *(const LAS f32x4*)(Am + P.i * 64 + 4 * P.j);
        const f32x4 a = win[0];
        fmac_(s0, a.x, U[4 * J]); if constexpr (4 * J + 1 < I) fmac_(s1, a.y, U[4 * J + 1]); if constexpr (4 * J + 2 < I) fmac_(s2, a.z, U[4 * J + 2]); if constexpr (4 * J + 3 < I) fmac_(s3, a.w, U[4 * J + 3]);
        f32x4 nx[SOLVE_D];
#pragma unroll
        for (int q = 0; q + 1 < SOLVE_D; ++q) nx[q] = win[q + 1];
        nx[SOLVE_D - 1] = nw;
        __builtin_amdgcn_sched_barrier(0);
        if constexpr (J + 1 < solve_nq(I)) solve_step<I, J + 1>(U, Am, nx, s0, s1, s2, s3);
        else { U[I] -= (s0 + s1) + (s2 + s3); solve_step<I + 1, 0>(U, Am, nx, 0.f, 0.f, 0.f, 0.f); }
    }
}
__device__ __forceinline__ void solve_all(float (&U)[64], const LAS float* Am) {
    f32x4 win[SOLVE_D];
#pragma unroll
    for (int q = 0; q < SOLVE_D; ++q) { constexpr RQ dummy{0, 0}; (void)dummy; }
    { constexpr RQ p0 = solve_adv(1, 0, 0), p1 = solve_adv(1, 0, 1), p2 = solve_adv(1, 0, 2), p3 = solve_adv(1, 0, 3), p4 = solve_adv(1, 0, 4);
      win[0] = *(const LAS f32x4*)(Am + p0.i * 64 + 4 * p0.j); win[1] = *(const LAS f32x4*)(Am + p1.i * 64 + 4 * p1.j); win[2] = *(const LAS f32x4*)(Am + p2.i * 64 + 4 * p2.j);
      win[3] = *(const LAS f32x4*)(Am + p3.i * 64 + 4 * p3.j); win[4] = *(const LAS f32x4*)(Am + p4.i * 64 + 4 * p4.j); }
    static_assert(SOLVE_D == 5, "window priming is written for SOLVE_D = 5");
    solve_step<1, 0>(U, Am, win, 0.f, 0.f, 0.f, 0.f);
}

constexpr int CP_QN = 0, CP_KN = 17408, CP_VA = 34816, CP_QKL = 51200, CP_SC = 59392, CP_HALF = 60416, CP_CW = 2 * CP_HALF;
__device__ __forceinline__ void phase_chunk(Frame& F, int blk0, int nblk, int n_lo, int n_cnt) {
    const float* conv_w = F.in[3];
    const bf16* proj = (const bf16*)(F.ws + WS_PROJ);
    const float* betaA = (const float*)(F.ws + WS_BETA); const float* gA = (const float*)(F.ws + WS_G);
    float* gtotA = (float*)(F.ws + WS_GTOT);
    const int half = F.wave >> 2, hw = F.wave & 3;
    LAS unsigned char* L = F.lds + half * CP_HALF;
    LAS bf16* qn = (LAS bf16*)(L + CP_QN); LAS bf16* kn = (LAS bf16*)(L + CP_KN); LAS bf16* vn = (LAS bf16*)(L + CP_VA);
    LAS float* Am = (LAS float*)(L + CP_VA); LAS bf16* qkL = (LAS bf16*)(L + CP_QKL); LAS float* sc = (LAS float*)(L + CP_SC);
    LAS float* cwL = (LAS float*)(F.lds + CP_CW);
    for (int idx = F.tid; idx < 4 * 1536 / 4; idx += 512) *(LAS f32x4*)(cwL + 4 * idx) = *(const f32x4*)(conv_w + 4 * idx);
    __syncthreads();
    const int nunits = NB * NH * n_cnt, nrounds = (nunits + 2 * nblk - 1) / (2 * nblk);
#pragma unroll 1
    for (int it = 0; it < nrounds; ++it) {
        int tid_ = F.tid; asm volatile("" : "+v"(tid_));
        const int ht = tid_ & 255, lane = tid_ & 63, r16 = lane & 15, gq = lane >> 4;
        int v_ = (it * nblk + ((int)blockIdx.x - blk0)) * 2 + half; asm volatile("" : "+s"(v_));
        const bool live = v_ < nunits;
        const int bh = live ? v_ / n_cnt : 0, n = live ? n_lo + v_ % n_cnt : 0, b = bh >> 2, h = bh & 3; const int unit = bh * 64 + n;
        const size_t m0 = (size_t)b * SEQ + (size_t)n * 64;
        unsigned char* chunk = F.ws + WS_CHUNK + (size_t)unit * CH_BYTES;
        const int rq = ht >> 4, cg = ht & 15;
        v4u Xa[7], Xb[7]; float gi = 0.f, bi = 0.f;
#define CHUNK_LOADX(X, p_) do { _Pragma("unroll") for (int jj = 0; jj < 7; ++jj) { const int trow = n * 64 + 4 * rq - 3 + jj; const int trc = trow < 0 ? 0 : trow; \
            const v4u u_ = *(const v4u*)(proj + ((size_t)b * SEQ + trc) * NPROJ + (p_) * 512 + h * 128 + 8 * cg); const unsigned mk_ = trow < 0 ? 0u : 0xffffffffu; \
            X[jj] = (v4u){u_.x & mk_, u_.y & mk_, u_.z & mk_, u_.w & mk_}; } } while (0)
#define CHUNK_CONV(X, p_) do { const int col = (p_) * 512 + h * 128 + 8 * cg; float wv[4][8]; \
            _Pragma("unroll") for (int j = 0; j < 4; ++j) { const f32x4 w0 = *(const LAS f32x4*)(cwL + j * 1536 + col), w1 = *(const LAS f32x4*)(cwL + j * 1536 + col + 4); \
                wv[j][0] = w0.x; wv[j][1] = w0.y; wv[j][2] = w0.z; wv[j][3] = w0.w; wv[j][4] = w1.x; wv[j][5] = w1.y; wv[j][6] = w1.z; wv[j][7] = w1.w; } \
            _Pragma("unroll") for (int rr = 0; rr < 4; ++rr) { float y[8]; \
                _Pragma("unroll") for (int q = 0; q < 8; ++q) y[q] = 0.f; \
                _Pragma("unroll") for (int j = 0; j < 4; ++j) { const v4u u = X[rr + j]; \
                    fmac_(y[0], wv[j][0], bflo(u.x)); fmac_(y[1], wv[j][1], bfhi(u.x)); fmac_(y[2], wv[j][2], bflo(u.y)); fmac_(y[3], wv[j][3], bfhi(u.y)); \
                    fmac_(y[4], wv[j][4], bflo(u.z)); fmac_(y[5], wv[j][5], bfhi(u.z)); fmac_(y[6], wv[j][6], bflo(u.w)); fmac_(y[7], wv[j][7], bfhi(u.w)); } \
                float ss = 0.f; \
                _Pragma("unroll") for (int q = 0; q < 8; ++q) { y[q] = siluf_(y[q]); ss += y[q] * y[q]; } \
                float scl = 1.f; \
                if ((p_) < 2) { ss += __shfl_xor(ss, 1); ss += __shfl_xor(ss, 2); ss += __shfl_xor(ss, 4); ss += __shfl_xor(ss, 8); scl = frsq_(ss + 1e-6f); if ((p_) == 0) scl *= 0.08838834764831845f; } \
                v4u o; o.x = cvt_pk_bf16(y[0] * scl, y[1] * scl); o.y = cvt_pk_bf16(y[2] * scl, y[3] * scl); o.z = cvt_pk_bf16(y[4] * scl, y[5] * scl); o.w = cvt_pk_bf16(y[6] * scl, y[7] * scl); \
                const int row = 4 * rq + rr; \
                if ((p_) == 0) *(LAS v4u*)(qn + row * 136 + 8 * cg) = o; else if ((p_) == 1) *(LAS v4u*)(kn + row * 136 + 8 * cg) = o; else *(LAS v4u*)(vn + row * 128 + 8 * cg) = o; \
                __builtin_amdgcn_sched_barrier(0); } } while (0)
        if (live) { CHUNK_LOADX(Xa, 0); CHUNK_LOADX(Xb, 1); if (hw == 0) { gi = gA[(m0 + lane) * 4 + h]; bi = betaA[(m0 + lane) * 4 + h]; } }
        if (live && hw == 0) {
            float c = gi;
#pragma unroll
            for (int o = 1; o < 64; o <<= 1) { const float tt = __shfl_up(c, o); if (lane >= o) c += tt; }
            const float gl = __shfl(c, 63);
            sc[lane] = bi; sc[64 + lane] = c; sc[128 + lane] = fexp_(c); sc[192 + lane] = fexp_(gl - c);
            if (lane == 63) gtotA[unit] = fexp_(c);
        }
        if (live) { CHUNK_CONV(Xa, 0); CHUNK_LOADX(Xa, 2); CHUNK_CONV(Xb, 1); CHUNK_CONV(Xa, 2); }
#undef CHUNK_LOADX
#undef CHUNK_CONV
        __syncthreads();
        const int which = ht >> 7, c = ht & 127;
        float U[64];
        if (live) {
#pragma unroll
            for (int i = 0; i < 64; ++i) { const float bi = sc[i]; const float tv = which ? bf2f(kn[i * 136 + c]) * sc[128 + i] : bf2f(vn[i * 128 + c]); U[i] = tv * bi; }
        } else {
#pragma unroll
            for (int i = 0; i < 64; ++i) U[i] = 0.f;
        }
        __syncthreads();
        if (live) {
            const int ti = hw >> 1, tj = hw & 1, r = lane & 31, hh = lane >> 5;
            f32x16 KK, QK;
#pragma unroll
            for (int q = 0; q < 16; ++q) { KK[q] = 0.f; QK[q] = 0.f; }
#pragma unroll
            for (int ks = 0; ks < 8; ++ks) {
                const bf16x8 ak = *(const LAS bf16x8*)(kn + (ti * 32 + r) * 136 + 16 * ks + 8 * hh);
                const bf16x8 aq = *(const LAS bf16x8*)(qn + (ti * 32 + r) * 136 + 16 * ks + 8 * hh);
                const bf16x8 bb = *(const LAS bf16x8*)(kn + (tj * 32 + r) * 136 + 16 * ks + 8 * hh);
                KK = __builtin_amdgcn_mfma_f32_32x32x16_bf16(ak, bb, KK, 0, 0, 0);
                QK = __builtin_amdgcn_mfma_f32_32x32x16_bf16(aq, bb, QK, 0, 0, 0);
            }
            const int j = tj * 32 + r; const float gcj = sc[64 + j];
#pragma unroll
            for (int reg = 0; reg < 16; ++reg) { const int i = ti * 32 + (reg & 3) + 8 * (reg >> 2) + 4 * hh;
                const float dec = (i >= j) ? __expf(sc[64 + i] - gcj) : 0.f;
                Am[i * 64 + j] = (i > j) ? sc[i] * KK[reg] * dec : 0.f;
                qkL[i * 64 + j] = (bf16)f2bf((i >= j) ? QK[reg] * dec : 0.f); }
        }
        __syncthreads();
        if (live) {
#pragma unroll
            for (int fi = 0; fi < 4; ++fi) { const int f = hw * 4 + fi, mb = f >> 2, ks = f & 3, row = 16 * mb + r16; const float s = sc[128 + row];
                const v2u lo = *(const LAS v2u*)(qn + row * 136 + 32 * ks + 4 * gq), hi = *(const LAS v2u*)(qn + row * 136 + 32 * ks + 16 + 4 * gq);
                v4u o; o.x = pk2(bflo(lo.x) * s, bfhi(lo.x) * s); o.y = pk2(bflo(lo.y) * s, bfhi(lo.y) * s); o.z = pk2(bflo(hi.x) * s, bfhi(hi.x) * s); o.w = pk2(bflo(hi.y) * s, bfhi(hi.y) * s);
                *(v4u*)(chunk + CH_QD + (f * 64 + lane) * 16) = o; }
#pragma unroll
            for (int fi = 0; fi < 4; ++fi) { const int f = hw * 4 + fi, db = f >> 1, ksp = f & 1, dcol = 16 * db + r16; float e[8];
#pragma unroll
                for (int j = 0; j < 8; ++j) { const int i = 32 * ksp + 16 * (j >> 2) + 4 * gq + (j & 3); e[j] = bf2f(kn[i * 136 + dcol]) * sc[192 + i]; }
                v4u o; o.x = pk2(e[0], e[1]); o.y = pk2(e[2], e[3]); o.z = pk2(e[4], e[5]); o.w = pk2(e[6], e[7]);
                *(v4u*)(chunk + CH_KT + (f * 64 + lane) * 16) = o; }
#pragma unroll
            for (int fi = 0; fi < 2; ++fi) { const int f = hw * 2 + fi, mb = f >> 1, ksp = f & 1, row = 16 * mb + r16;
                const v2u lo = *(const LAS v2u*)(qkL + row * 64 + 32 * ksp + 4 * gq), hi = *(const LAS v2u*)(qkL + row * 64 + 32 * ksp + 16 + 4 * gq);
                *(v4u*)(chunk + CH_QK + (f * 64 + lane) * 16) = (v4u){lo.x, lo.y, hi.x, hi.y}; }
            solve_all(U, Am);
        }
        __syncthreads();
        if (live) {
            if (which == 0) {
                const int w8 = c >> 4, cl = c & 15;
                unsigned char* ub = F.ws + WS_UC + (size_t)unit * UC_BYTES;
#pragma unroll
                for (int g = 0; g < 4; ++g) {
                    v4u lo, hi;
                    lo.x = pk2(U[4 * g], U[4 * g + 1]); lo.y = pk2(U[4 * g + 2], U[4 * g + 3]); lo.z = pk2(U[16 + 4 * g], U[16 + 4 * g + 1]); lo.w = pk2(U[16 + 4 * g + 2], U[16 + 4 * g + 3]);
                    hi.x = pk2(U[32 + 4 * g], U[32 + 4 * g + 1]); hi.y = pk2(U[32 + 4 * g + 2], U[32 + 4 * g + 3]); hi.z = pk2(U[48 + 4 * g], U[48 + 4 * g + 1]); hi.w = pk2(U[48 + 4 * g + 2], U[48 + 4 * g + 3]);
                    v4u* dst = (v4u*)(ub + ((w8 * 64 + g * 16 + cl) * 32)); dst[0] = lo; dst[1] = hi;
                }
            } else {
#pragma unroll
                for (int i = 0; i < 64; ++i) qn[i * 136 + c] = (bf16)f2bf(U[i]);
            }
        }
        __syncthreads();
        if (live) {
#pragma unroll
            for (int fi = 0; fi < 4; ++fi) { const int f = hw * 4 + fi, mb = f >> 2, ks = f & 3, row = 16 * mb + r16;
                const v2u lo = *(const LAS v2u*)(qn + row * 136 + 32 * ks + 4 * gq), hi = *(const LAS v2u*)(qn + row * 136 + 32 * ks + 16 + 4 * gq);
                *(v4u*)(chunk + CH_WF + (f * 64 + lane) * 16) = (v4u){lo.x, lo.y, hi.x, hi.y}; }
        }
        __syncthreads();
    }
}

constexpr int SCAN_SPLIT = 32;
constexpr int SC_STAGED = 49152, SC_NLOAD = 16;
struct ScanU { v4u u0, u1; };
struct ScanQ { v4u q[8]; };
__device__ __forceinline__ void scan_issue_u(ScanU& R, const unsigned char* up) {
    asm volatile("global_load_dwordx4 %0, %1, off" : "=v"(R.u0) : "v"(up) : "memory");
    asm volatile("global_load_dwordx4 %0, %1, off offset:16" : "=v"(R.u1) : "v"(up) : "memory");
}
__device__ __forceinline__ void scan_issue_q(ScanQ& R, const unsigned char* qp) {
    asm volatile("global_load_dwordx4 %0, %1, off" : "=v"(R.q[0]) : "v"(qp) : "memory");
    asm volatile("global_load_dwordx4 %0, %1, off offset:1024" : "=v"(R.q[1]) : "v"(qp) : "memory");
    asm volatile("global_load_dwordx4 %0, %1, off offset:2048" : "=v"(R.q[2]) : "v"(qp) : "memory");
    asm volatile("global_load_dwordx4 %0, %1, off offset:3072" : "=v"(R.q[3]) : "v"(qp) : "memory");
    const unsigned char* qp2 = qp + 4096;
    asm volatile("global_load_dwordx4 %0, %1, off" : "=v"(R.q[4]) : "v"(qp2) : "memory");
    asm volatile("global_load_dwordx4 %0, %1, off offset:1024" : "=v"(R.q[5]) : "v"(qp2) : "memory");
    asm volatile("global_load_dwordx4 %0, %1, off offset:2048" : "=v"(R.q[6]) : "v"(qp2) : "memory");
    asm volatile("global_load_dwordx4 %0, %1, off offset:3072" : "=v"(R.q[7]) : "v"(qp2) : "memory");
}
#define SCAN_WAIT_REGS(U, Q, cnt) asm volatile("s_waitcnt vmcnt(" #cnt ")" : "+v"(U.u0), "+v"(U.u1), "+v"(Q.q[0]), "+v"(Q.q[1]), "+v"(Q.q[2]), "+v"(Q.q[3]), "+v"(Q.q[4]), "+v"(Q.q[5]), "+v"(Q.q[6]), "+v"(Q.q[7]) :: "memory")
template <class Bar> __device__ __forceinline__ void phase_scan(Frame& F, const Bar& mid_barrier) {
    const int bh = blockIdx.x, b = bh >> 2, h = bh & 3, w = F.wave, lane = F.lane, cl = lane & 15, gq = lane >> 4;
    const float* gtotA = (const float*)(F.ws + WS_GTOT);
    const int unit0 = bh * 64;
    const unsigned char* cbase = F.ws + WS_CHUNK + (size_t)unit0 * CH_BYTES;
    const unsigned char* ubase = F.ws + WS_UC + (size_t)unit0 * UC_BYTES + (w * 64 + lane) * 32;
    const unsigned char* qbase = cbase + CH_QK + lane * 16;
    bf16* op = (bf16*)(F.ws + WS_ORAW) + ((size_t)b * SEQ + cl) * 512 + h * 128 + 16 * w + 4 * gq;
    f32x4 Sacc[8]; bf16x8 Sb[4];
#pragma unroll
    for (int d = 0; d < 8; ++d) Sacc[d] = (f32x4){0.f, 0.f, 0.f, 0.f};
#pragma unroll
    for (int k = 0; k < 4; ++k) Sb[k] = (bf16x8){0, 0, 0, 0, 0, 0, 0, 0};
    v2u Ow[4];
#pragma unroll
    for (int mb = 0; mb < 4; ++mb) Ow[mb] = (v2u){0u, 0u};
    ScanU U0, U1, U2; ScanQ QA, QB;
#define SCAN_ISSUE(nn) do { const unsigned char* s_ = cbase + (size_t)(nn) * CH_BYTES + (w * 6) * 1024 + lane * 16; LAS unsigned char* d_ = F.lds + ((nn) % 3) * SC_STAGED + (w * 6) * 1024; \
        _Pragma("unroll") for (int k_ = 0; k_ < 6; ++k_) __builtin_amdgcn_global_load_lds((const unsigned*)(s_ + k_ * 1024), (LAS unsigned*)(d_ + k_ * 1024), 16, 0, 0); } while (0)
#define SCAN_STEP(n, UC, UN, Q, ISSUE2, WAITCNT) do { \
        SCAN_WAIT_REGS(UC, Q, WAITCNT); asm volatile("s_waitcnt lgkmcnt(0)" ::: "memory"); __builtin_amdgcn_s_barrier(); asm volatile("" ::: "memory"); \
        const float gt = __shfl(gtv, (n) & 31); \
        if (ISSUE2) { scan_issue_u(UN, ubase + (size_t)((n) + 2) * UC_BYTES); SCAN_ISSUE((n) + 2); } \
        if ((n) > 0) { _Pragma("unroll") for (int mb = 0; mb < 4; ++mb) *(v2u*)(op + (size_t)(((n) - 1) * 64 + 16 * mb) * 512) = Ow[mb]; } \
        const LAS unsigned char* B = F.lds + ((n) % 3) * SC_STAGED; \
        f32x4 P[4]; \
        _Pragma("unroll") for (int mb = 0; mb < 4; ++mb) { P[mb] = (f32x4){0.f, 0.f, 0.f, 0.f}; \
            _Pragma("unroll") for (int ks = 0; ks < 4; ++ks) P[mb] = __builtin_amdgcn_mfma_f32_16x16x32_bf16(SFRAG(CH_WF, mb * 4 + ks), Sb[ks], P[mb], 0, 0, 0); } \
        f32x4 vnw[4]; \
        vnw[0] = (f32x4){bflo(UC.u0.x), bfhi(UC.u0.x), bflo(UC.u0.y), bfhi(UC.u0.y)} - P[0]; \
        vnw[1] = (f32x4){bflo(UC.u0.z), bfhi(UC.u0.z), bflo(UC.u0.w), bfhi(UC.u0.w)} - P[1]; \
        vnw[2] = (f32x4){bflo(UC.u1.x), bfhi(UC.u1.x), bflo(UC.u1.y), bfhi(UC.u1.y)} - P[2]; \
        vnw[3] = (f32x4){bflo(UC.u1.z), bfhi(UC.u1.z), bflo(UC.u1.w), bfhi(UC.u1.w)} - P[3]; \
        bf16x8 Vb[2]; Vb[0] = pack8(vnw[0], vnw[1]); Vb[1] = pack8(vnw[2], vnw[3]); \
        _Pragma("unroll") for (int mb = 0; mb < 4; ++mb) { f32x4 OT = (f32x4){0.f, 0.f, 0.f, 0.f}; \
            _Pragma("unroll") for (int ks = 0; ks < 4; ++ks) OT = __builtin_amdgcn_mfma_f32_16x16x32_bf16(Sb[ks], SFRAG(CH_QD, mb * 4 + ks), OT, 0, 0, 0); \
            _Pragma("unroll") for (int ksp = 0; ksp < 2; ++ksp) OT = __builtin_amdgcn_mfma_f32_16x16x32_bf16(Vb[ksp], __builtin_bit_cast(bf16x8, Q.q[mb * 2 + ksp]), OT, 0, 0, 0); \
            Ow[mb] = (v2u){cvt_pk_bf16(OT[0], OT[1]), cvt_pk_bf16(OT[2], OT[3])}; } \
        asm volatile("s_nop 7" : "+v"(Q.q[0]), "+v"(Q.q[1]), "+v"(Q.q[2]), "+v"(Q.q[3]), "+v"(Q.q[4]), "+v"(Q.q[5]), "+v"(Q.q[6]), "+v"(Q.q[7]));     \
        if (ISSUE2) scan_issue_q(Q, qbase + (size_t)((n) + 2) * CH_BYTES); \
        _Pragma("unroll") for (int db = 0; db < 8; ++db) { Sacc[db] = Sacc[db] * gt; \
            _Pragma("unroll") for (int ksp = 0; ksp < 2; ++ksp) Sacc[db] = __builtin_amdgcn_mfma_f32_16x16x32_bf16(SFRAG(CH_KT, db * 2 + ksp), Vb[ksp], Sacc[db], 0, 0, 0); } \
        _Pragma("unroll") for (int ks = 0; ks < 4; ++ks) Sb[ks] = pack8(Sacc[2 * ks], Sacc[2 * ks + 1]); \
    } while (0)
#define SFRAG(off, f) (*(const LAS bf16x8*)(B + (off) + ((f) * 64 + lane) * 16))
    static_assert(CH_WF == 0 && CH_QD == 16384 && CH_KT == 32768 && CH_QK == SC_STAGED && SCAN_SPLIT % 6 == 2 && 2 * SCAN_SPLIT == 64, "staged part = the first 48 KiB of a chunk; a half = 5 x 6 + 2 steps");
#pragma unroll 1
    for (int part = 0; part < 2; ++part) {
        const int n0 = part * SCAN_SPLIT;
        float gtv = gtotA[unit0 + n0 + (lane & 31)];
        asm volatile("s_waitcnt vmcnt(0)" : "+v"(gtv) :: "memory");
        scan_issue_u(U0, ubase + (size_t)n0 * UC_BYTES); SCAN_ISSUE(n0); scan_issue_q(QA, qbase + (size_t)n0 * CH_BYTES);
        scan_issue_u(U1, ubase + (size_t)(n0 + 1) * UC_BYTES); SCAN_ISSUE(n0 + 1); scan_issue_q(QB, qbase + (size_t)(n0 + 1) * CH_BYTES);
#pragma unroll 1
        for (int n = n0; n < n0 + SCAN_SPLIT - 2; n += 6) {
            SCAN_STEP(n, U0, U2, QA, true, 16);
            SCAN_STEP(n + 1, U1, U0, QB, true, 16);
            SCAN_STEP(n + 2, U2, U1, QA, true, 16);
            SCAN_STEP(n + 3, U0, U2, QB, true, 16);
            SCAN_STEP(n + 4, U1, U0, QA, true, 16);
            SCAN_STEP(n + 5, U2, U1, QB, true, 16);
        }
        SCAN_STEP(n0 + SCAN_SPLIT - 2, U0, U2, QA, false, 16);
        SCAN_STEP(n0 + SCAN_SPLIT - 1, U1, U0, QB, false, 0);
        if (part == 0) mid_barrier();
    }
#undef SFRAG
#undef SCAN_STEP
#undef SCAN_ISSUE
#pragma unroll
    for (int mb = 0; mb < 4; ++mb) *(v2u*)(op + (size_t)(63 * 64 + 16 * mb) * 512) = Ow[mb];
    VM_WAIT(); __syncthreads();
}

__device__ __forceinline__ void phase_onorm(Frame& F) {
    const float* dnw = F.in[6]; const bf16* proj = (const bf16*)(F.ws + WS_PROJ); const bf16* oraw = (const bf16*)(F.ws + WS_ORAW); bf16* concat = (bf16*)(F.ws + WS_CONCAT);
    const int gw = F.vcu * NWAVES + F.wave, NGW = F.G * NWAVES, lane = F.lane;
    const int cc = 8 * (lane & 15);
    const f32x4 d0 = *(const f32x4*)(dnw + cc), d1 = *(const f32x4*)(dnw + cc + 4);
    for (int m = gw; m < NTOK; m += NGW) {
        const v4u o = *(const v4u*)(oraw + (size_t)m * 512 + 8 * lane);
        const v4u z = *(const v4u*)(proj + (size_t)m * NPROJ + 1536 + 8 * lane);
        const float ov[8] = {bflo(o.x), bfhi(o.x), bflo(o.y), bfhi(o.y), bflo(o.z), bfhi(o.z), bflo(o.w), bfhi(o.w)};
        const float zv[8] = {bflo(z.x), bfhi(z.x), bflo(z.y), bfhi(z.y), bflo(z.z), bfhi(z.z), bflo(z.w), bfhi(z.w)};
        float ss = 0.f;
#pragma unroll
        for (int q = 0; q < 8; ++q) ss += ov[q] * ov[q];
        ss += __shfl_xor(ss, 1); ss += __shfl_xor(ss, 2); ss += __shfl_xor(ss, 4); ss += __shfl_xor(ss, 8);
        const float rs = frsq_(ss * (1.f / 128.f) + 1e-6f);
        const float dv[8] = {d0.x, d0.y, d0.z, d0.w, d1.x, d1.y, d1.z, d1.w};
        float r[8];
#pragma unroll
        for (int q = 0; q < 8; ++q) r[q] = ov[q] * rs * dv[q] * siluf_(zv[q]);
        *(v4u*)(concat + (size_t)m * DM + 8 * lane) = (v4u){cvt_pk_bf16(r[0], r[1]), cvt_pk_bf16(r[2], r[3]), cvt_pk_bf16(r[4], r[5]), cvt_pk_bf16(r[6], r[7])};
    }
}

__device__ __forceinline__ void phase_route(Frame& F) {
    const bf16* x1 = (const bf16*)(F.ws + WS_X1); const float* b_router = F.in[12];
    unsigned char* x1b = F.ws + WS_X1B; float* rs2A = (float*)(F.ws + WS_RS2); int* list = (int*)(F.ws + WS_LIST);
    float* rsl = (float*)(F.ws + WS_RSL); float* gwl = (float*)(F.ws + WS_GWL);
    unsigned* cntw = (unsigned*)(F.ws + WS_CTL) + CW_CNT;
    LAS unsigned char* WI = F.lds;
    LAS unsigned* lcnt = (LAS unsigned*)(F.lds + TAB_OFF);
    { const v4u* src = (const v4u*)(F.ws + WS_WR);
      for (int idx = F.tid; idx < 131072 / 16; idx += 512) *(LAS v4u*)(WI + 16 * idx) = src[idx]; }
    const int lane = F.lane, c = lane & 15, g = lane >> 4;
    const int gw = F.vcu * NWAVES + F.wave, NGW = F.G * NWAVES, NT = NTOK / 16;
    const float bia0 = b_router[c], bia1 = b_router[16 + c];
    for (int t0 = 0; t0 < NT; t0 += NGW) {
        const int tile = t0 + gw; const bool live = tile < NT;
        if (F.tid < 64) lcnt[F.tid] = 0u;
        __syncthreads();
        int my_e = 0; float my_g = 0.f, my_rs = 0.f; unsigned my_rank = 0u; int my_ent = 0;
        if (live) {
            const int m0 = tile * 16;
            const bf16* xrow = x1 + (size_t)(m0 + c) * DM + 8 * g;
            unsigned char* xbrow = x1b + (size_t)(m0 + c) * DM + 8 * g;
            f32x4 acc0 = (f32x4){0.f, 0.f, 0.f, 0.f}, acc1 = acc0; float ssq = 0.f;
#pragma unroll 1
            for (int kb = 0; kb < 2; ++kb) {
                v4u xa[16];
#pragma unroll
                for (int q = 0; q < 16; ++q) xa[q] = *(const v4u*)(xrow + 32 * (kb * 16 + q));
#pragma unroll
                for (int q = 0; q < 16; ++q) { const int ks = kb * 16 + q; const v4u h = xa[q];
                    const float a0 = bflo(h.x), a1 = bfhi(h.x), a2 = bflo(h.y), a3 = bfhi(h.y), b0 = bflo(h.z), b1 = bfhi(h.z), b2 = bflo(h.w), b3 = bfhi(h.w);
                    ssq += (a0 * a0 + a1 * a1) + (a2 * a2 + a3 * a3) + (b0 * b0 + b1 * b1) + (b2 * b2 + b3 * b3);
                    *(v2u*)(xbrow + 32 * ks) = (v2u){pk4_fp8(a0, a1, a2, a3), pk4_fp8(b0, b1, b2, b3)};
                    const bf16x8 ah = __builtin_bit_cast(bf16x8, h);
                    const LAS unsigned char* fb = WI + (size_t)(ks * 4) * 1024 + lane * 16;
                    const bf16x8 b0h = *(const LAS bf16x8*)(fb), b0l = *(const LAS bf16x8*)(fb + 1024), b1h = *(const LAS bf16x8*)(fb + 2048), b1l = *(const LAS bf16x8*)(fb + 3072);
                    acc0 = __builtin_amdgcn_mfma_f32_16x16x32_bf16(ah, b0h, acc0, 0, 0, 0); acc0 = __builtin_amdgcn_mfma_f32_16x16x32_bf16(ah, b0l, acc0, 0, 0, 0);
                    acc1 = __builtin_amdgcn_mfma_f32_16x16x32_bf16(ah, b1h, acc1, 0, 0, 0); acc1 = __builtin_amdgcn_mfma_f32_16x16x32_bf16(ah, b1l, acc1, 0, 0, 0); }
            }
            ssq += __shfl_xor(ssq, 16); ssq += __shfl_xor(ssq, 32);
            const float rsr = frsq_(ssq * (1.f / DM) + 1e-6f);
            if (g == 0) rs2A[m0 + c] = rsr;
            float ge_[4]; int ee_[4];
#pragma unroll
            for (int reg = 0; reg < 4; ++reg) {
                const float rsw = __shfl(rsr, 4 * g + reg);
                float v0 = acc0[reg] * rsw + bia0, v1 = acc1[reg] * rsw + bia1;
                float tv[4]; int te[4];
#pragma unroll
                for (int s = 0; s < 4; ++s) {
                    float bv; int bi; if (v1 > v0) { bv = v1; bi = 16 + c; } else { bv = v0; bi = c; }
#pragma unroll
                    for (int o = 1; o < 16; o <<= 1) { const float ov = __shfl_xor(bv, o); const int oi = __shfl_xor(bi, o); if (ov > bv || (ov == bv && oi < bi)) { bv = ov; bi = oi; } }
                    tv[s] = bv; te[s] = bi; if (bi == c) v0 = -3.0e38f; if (bi == 16 + c) v1 = -3.0e38f;
                }
                const float e1 = fexp_(tv[1] - tv[0]), e2 = fexp_(tv[2] - tv[0]), e3 = fexp_(tv[3] - tv[0]); const float inv = frcp_(1.f + e1 + e2 + e3);
                const int s_ = c & 3; const float gsel = (s_ == 0 ? 1.f : s_ == 1 ? e1 : s_ == 2 ? e2 : e3) * inv; const int esel = s_ == 0 ? te[0] : s_ == 1 ? te[1] : s_ == 2 ? te[2] : te[3];
                ge_[reg] = gsel; ee_[reg] = esel;
            }
            const int rsel = c >> 2;
            my_g = rsel == 0 ? ge_[0] : rsel == 1 ? ge_[1] : rsel == 2 ? ge_[2] : ge_[3];
            my_e = rsel == 0 ? ee_[0] : rsel == 1 ? ee_[1] : rsel == 2 ? ee_[2] : ee_[3];
            my_ent = (m0 + 4 * g + rsel) * 4 + (c & 3);
            my_rs = __shfl(rsr, 4 * g + rsel);
            my_rank = __hip_atomic_fetch_add(lcnt + my_e, 1u, __ATOMIC_RELAXED, __HIP_MEMORY_SCOPE_WORKGROUP);
        }
        __syncthreads();
        if (F.tid < NE) { const unsigned n = lcnt[F.tid]; lcnt[32 + F.tid] = n ? __hip_atomic_fetch_add(cntw + 64 * F.tid, n, RLX_AGENT) : 0u; }
        __syncthreads();
        if (live) { const size_t pos = (size_t)my_e * LISTCAP + lcnt[32 + my_e] + my_rank; list[pos] = my_ent; rsl[pos] = my_rs; gwl[pos] = my_g; }
        __syncthreads();
    }
}

__device__ __forceinline__ int moe_tables(Frame& F, MoeTab& T) {
    LAS int* pref = (LAS int*)(F.lds + TAB_OFF); LAS int* cnt = pref + 40;
    unsigned* cntw = (unsigned*)(F.ws + WS_CTL) + CW_CNT;
    if (F.tid == 0) { int acc = 0; for (int e = 0; e < NE; ++e) { const int c = (int)__hip_atomic_load(cntw + 64 * e, RLX_AGENT); cnt[e] = c; pref[e] = acc; acc += (c + 255) >> 8; } pref[NE] = acc; }
    __syncthreads();
    T.pref = pref; T.cnt = cnt;
    return pref[NE];
}

struct FinalRow { f32x4 v[4]; v2u sl[4][2]; };
typedef float f32x2_t __attribute__((ext_vector_type(2)));
__device__ __forceinline__ void final_load(FinalRow& R, const bf16* xrow, const unsigned char* srow) {
#pragma unroll
    for (int j = 0; j < 2; ++j) { const v4u h = *(const v4u*)(xrow + 512 * j);
        R.v[2 * j] = (f32x4){bflo(h.x), bfhi(h.x), bflo(h.y), bfhi(h.y)}; R.v[2 * j + 1] = (f32x4){bflo(h.z), bfhi(h.z), bflo(h.w), bfhi(h.w)}; }
#pragma unroll
    for (int s = 0; s < 4; ++s)
#pragma unroll
        for (int j = 0; j < 2; ++j) R.sl[s][j] = *(const v2u*)(srow + (size_t)s * DM + 512 * j);
}
__device__ __forceinline__ void final_finish(FinalRow& R, float* orow, const f32x4 (&wv)[4]) {
#pragma unroll
    for (int s = 0; s < 4; ++s)
#pragma unroll
        for (int j = 0; j < 2; ++j) { const v2u u = R.sl[s][j];
            const f32x2_t a0 = __builtin_amdgcn_cvt_pk_f32_fp8((int)u.x, false), a1 = __builtin_amdgcn_cvt_pk_f32_fp8((int)u.x, true), b0 = __builtin_amdgcn_cvt_pk_f32_fp8((int)u.y, false), b1 = __builtin_amdgcn_cvt_pk_f32_fp8((int)u.y, true);
            R.v[2 * j].x += a0.x * SLAB_INV; R.v[2 * j].y += a0.y * SLAB_INV; R.v[2 * j].z += a1.x * SLAB_INV; R.v[2 * j].w += a1.y * SLAB_INV;
            R.v[2 * j + 1].x += b0.x * SLAB_INV; R.v[2 * j + 1].y += b0.y * SLAB_INV; R.v[2 * j + 1].z += b1.x * SLAB_INV; R.v[2 * j + 1].w += b1.y * SLAB_INV; }
    float ss = 0.f;
#pragma unroll
    for (int j = 0; j < 4; ++j) ss += (R.v[j].x * R.v[j].x + R.v[j].y * R.v[j].y) + (R.v[j].z * R.v[j].z + R.v[j].w * R.v[j].w);
    ss = wave_sum(ss);
    const float rs = frsq_(ss * (1.f / DM) + 1e-6f);
#pragma unroll
    for (int j = 0; j < 2; ++j) { *(f32x4*)(orow + 512 * j) = R.v[2 * j] * rs * wv[2 * j]; *(f32x4*)(orow + 512 * j + 4) = R.v[2 * j + 1] * rs * wv[2 * j + 1]; }
}
__device__ __forceinline__ void phase_final(Frame& F, int dryrun) {
    const float* fw = F.in[17]; const unsigned char* slab = F.ws + WS_SLAB; float* out = F.out;
    const bf16* x1 = (const bf16*)(F.ws + WS_X1); (void)dryrun;
    const int gw = F.vcu * NWAVES + F.wave, NGW = F.G * NWAVES, lane = F.lane;
    f32x4 wv[4];
#pragma unroll
    for (int j = 0; j < 2; ++j) { wv[2 * j] = *(const f32x4*)(fw + 512 * j + 8 * lane); wv[2 * j + 1] = *(const f32x4*)(fw + 512 * j + 8 * lane + 4); }
    FinalRow A, B;
    int m = gw;
    if (m < NTOK) final_load(A, x1 + (size_t)m * DM + 8 * lane, slab + (size_t)m * 4 * DM + 8 * lane);
    for (; m < NTOK; m += 2 * NGW) {
        const int m1 = m + NGW, m2 = m + 2 * NGW;
        if (m1 < NTOK) final_load(B, x1 + (size_t)m1 * DM + 8 * lane, slab + (size_t)m1 * 4 * DM + 8 * lane);
        final_finish(A, out + (size_t)m * DM + 8 * lane, wv);
        if (m2 < NTOK) final_load(A, x1 + (size_t)m2 * DM + 8 * lane, slab + (size_t)m2 * 4 * DM + 8 * lane);
        if (m1 < NTOK) final_finish(B, out + (size_t)m1 * DM + 8 * lane, wv);
    }
}

struct Args { const float* in[18]; float* out; unsigned char* ws; int ph_lo, ph_hi, flag, breg; };
constexpr int NPHASE = 11;

__global__ void __launch_bounds__(NWAVES * 64, 2) mk_fwd(Args args) {
    extern __shared__ __attribute__((aligned(16))) unsigned char lds_raw[];
    Frame F;
    F.lds = (LAS unsigned char*)lds_raw;
    F.tid = threadIdx.x; F.lane = F.tid & 63; F.wave = __builtin_amdgcn_readfirstlane(F.tid >> 6);
    F.G = gridDim.x; { const int bx = blockIdx.x; F.vcu = (F.G % 8 == 0) ? (bx % 8) * (F.G / 8) + bx / 8 : bx; }
#pragma unroll
    for (int i = 0; i < 18; ++i) F.in[i] = args.in[i];
    F.out = args.out; F.ws = args.ws;
    volatile LAS unsigned* MISC = (volatile LAS unsigned*)(F.lds + MISC_OFF);
    for (int u = F.tid; u < (LDS_BYTES - LDSCTL_OFF) / 4; u += NWAVES * 64) ((LAS unsigned*)(F.lds + LDSCTL_OFF))[u] = 0u;
    __syncthreads();
    unsigned* ctl = (unsigned*)(F.ws + WS_CTL);
#if !MK_PER_PHASE
    XcdBarrier bar = xcd_barrier_post(ctl + CW_BAR, MISC + 8);
#define GRID_BAR() xcd_barrier(bar)
#else
#define GRID_BAR() do {} while (0)
#endif
    const int lo = args.ph_lo, hi = args.ph_hi;
#define IN(k) (lo <= (k) && (k) < hi)
#define SEAM(k) do { if (IN(k) && IN((k) + 1)) GRID_BAR(); } while (0)

#define RUNPH(k, ...) do { if (IN(k)) { __VA_ARGS__; } SEAM(k); } while (0)
    RUNPH(0, phase_prep(F));
    RUNPH(1, {
        ProbIn P; P.K = DM; P.RB = 2 * DM; P.S.init(NTOK / 256, NPROJ / 256, F.G, (int)blockIdx.x);
        P.A = (const bf16*)(F.ws + WS_XB); P.Bt = (const bf16*)(F.ws + WS_WIN); P.O = (bf16*)(F.ws + WS_PROJ); P.rs = (const float*)(F.ws + WS_RS1);
        pg8::gemm_phase(F.lds, P); });
    if (IN(2)) { phase_mix(F); __syncthreads(); }
    RUNPH(3, phase_chunk(F, 0, F.G, 0, SCAN_SPLIT));
    RUNPH(4, {
        const int nscan = NB * NH;
        unsigned* seam = ctl + CW_SEAM4 + 64 * args.breg;
        auto scan_wait = [&]() {
            asm volatile("s_waitcnt vmcnt(0)" ::: "memory"); __syncthreads();
            if (F.tid == 0) { const unsigned want = (unsigned)(F.G - nscan); unsigned sp = 0u;
                while (__hip_atomic_load(seam, RLX_AGENT) < want) { __builtin_amdgcn_s_sleep(2); if (++sp > (1u << 22)) break; }
                __builtin_amdgcn_fence(__ATOMIC_ACQUIRE, "agent"); asm volatile("s_waitcnt vmcnt(0)" ::: "memory"); }
            __syncthreads();
        };
        if ((int)blockIdx.x < nscan) phase_scan(F, scan_wait);
        else {
               phase_chunk(F, nscan, F.G - nscan, SCAN_SPLIT, 64 - SCAN_SPLIT);
               asm volatile("s_waitcnt vmcnt(0)" ::: "memory"); __syncthreads();
               if (F.tid == 0) { __builtin_amdgcn_fence(__ATOMIC_RELEASE, "agent"); asm volatile("s_waitcnt vmcnt(0)" ::: "memory"); __hip_atomic_fetch_add(seam, 1u, RLX_AGENT); }
               moe_weight_prep(F, nscan, MOE_PREP_SPLIT, MOE_PREP_ITEMS); } });
    RUNPH(5, phase_onorm(F));
    RUNPH(6, {
        ProbOut P; P.K = DM; P.RB = 2 * DM; P.S.init(NTOK / 256, DM / 256, F.G, (int)blockIdx.x);
        P.A = (const bf16*)(F.ws + WS_CONCAT); P.Bt = (const bf16*)(F.ws + WS_WOUT); P.X = (const bf16*)(F.ws + WS_XB); P.O = (bf16*)(F.ws + WS_X1);
        pg8::gemm_phase(F.lds, P); });
    RUNPH(7, phase_route(F));
    RUNPH(8, {
        ProbGU P; const int RT = moe_tables(F, P.T);
        P.K = DM; P.RB = DM; P.S.init(RT, 8, F.G, (int)blockIdx.x);
        P.A = F.ws + WS_X1B; P.Bt = F.ws + WS_WGU; P.O = F.ws + WS_ACT; P.list = (const int*)(F.ws + WS_LIST);
        P.rs2 = (const float*)(F.ws + WS_RSL); P.bgu = (const float*)(F.ws + WS_BGU);
        pg8::gemm_phase<ProbGU, true>(F.lds, P); });
    RUNPH(9, {
        ProbDown P; const int RT = moe_tables(F, P.T);
        P.K = DE; P.RB = DE; P.S.init(RT, 4, F.G, (int)blockIdx.x);
        P.A = F.ws + WS_ACT; P.Bt = F.ws + WS_WD; P.O = F.ws + WS_SLAB; P.list = (const int*)(F.ws + WS_LIST);
        P.gw = (const float*)(F.ws + WS_GWL); P.bd = F.in[16];
        pg8::gemm_phase<ProbDown, true>(F.lds, P); });
    RUNPH(10, phase_final(F, args.flag));
#undef RUNPH
#undef IN
#undef SEAM
}

extern "C" void kernel_launch(void* const* d_in, const int* in_sizes, int n_in, void* d_out, int out_size, void* d_ws, size_t ws_size, hipStream_t stream) {
    static int grid = 0;
    if (grid == 0) {
        if (n_in != 18 || in_sizes[0] != NTOK * DM || out_size != NTOK * DM || ws_size < WS_END) { fprintf(stderr, "kernel_launch: unexpected shapes (n_in %d, in0 %d, out %d, ws %zu)\n", n_in, n_in > 0 ? in_sizes[0] : -1, out_size, ws_size); grid = -1; return; }
        int dev = 0, cus = 0, per_cu = 0;
        if (hipGetDevice(&dev) != hipSuccess || hipDeviceGetAttribute(&cus, hipDeviceAttributeMultiprocessorCount, dev) != hipSuccess) { grid = -1; return; }
        if (hipFuncSetAttribute((const void*)mk_fwd, hipFuncAttributeMaxDynamicSharedMemorySize, LDS_BYTES) != hipSuccess) { fprintf(stderr, "kernel_launch: hipFuncSetAttribute failed\n"); grid = -1; return; }
        if (hipOccupancyMaxActiveBlocksPerMultiprocessor(&per_cu, (const void*)mk_fwd, NWAVES * 64, LDS_BYTES) != hipSuccess || per_cu < 1) { fprintf(stderr, "kernel_launch: occupancy query says %d\n", per_cu); per_cu = 1; }
        (void)hipGetLastError();
        grid = cus;
    }
    if (grid < 0) return;
    (void)hipMemsetAsync((char*)d_ws + WS_CTL, 0, CTL_ZERO_BYTES, stream);
    Args a{};
    for (int i = 0; i < 18; ++i) a.in[i] = (const float*)d_in[i];
    a.out = (float*)d_out; a.ws = (unsigned char*)d_ws;
#if MK_PER_PHASE
    for (int p = 0; p < NPHASE; ++p) { a.ph_lo = p; a.ph_hi = p + 1; const int nrep = 1 + REP_CNT * ((REP_MASK >> p) & 1);
        for (int r = 0; r < nrep; ++r) { a.flag = (p == NPHASE - 1 && r + 1 < nrep) ? 1 : 0; a.breg = r; hipLaunchKernelGGL(mk_fwd, dim3(grid), dim3(NWAVES * 64), LDS_BYTES, stream, a); } }
#else
    a.ph_lo = 0; a.ph_hi = NPHASE;
    hipLaunchKernelGGL(mk_fwd, dim3(grid), dim3(NWAVES * 64), LDS_BYTES, stream, a);
#endif
}
```

```cpp
#include <hip/hip_runtime.h>
#include <cstdio>
#include <cstdint>

#ifndef REP_MASK
#define REP_MASK 0
#endif
#ifndef REP_CNT
#define REP_CNT 1
#endif
#ifndef MK_PER_PHASE
#define MK_PER_PHASE 0
#endif

constexpr int NB = 8, SEQ = 4096, DM = 1024, NTOK = NB * SEQ;
constexpr int NH = 4, HD = 128, DDN = 512, DPOOL = 512, DIN = 2568, NPROJ = 2560;
constexpr int NE = 32, TOPK = 4, DE = 1024, NASSIGN = NTOK * TOPK;
constexpr int LISTCAP = NTOK;
constexpr int ACT_ROWS = NASSIGN + NE * 256;

constexpr size_t MiB = 1u << 20;
constexpr size_t WS_CTL = 0, CTL_ZERO_BYTES = 1 * MiB;
constexpr size_t WS_WIN = 1 * MiB;
constexpr size_t WS_WOUT = 6 * MiB;
constexpr size_t WS_WPOOL = 8 * MiB;
constexpr size_t WS_WR = 8 * MiB + 512 * 1024;
constexpr size_t WS_BGU = 8 * MiB + 768 * 1024;
constexpr size_t WS_RS1 = 9 * MiB;
constexpr size_t WS_BETA = 9 * MiB + 128 * 1024;
constexpr size_t WS_G = 9 * MiB + 640 * 1024;
constexpr size_t WS_RS2 = 10 * MiB + 256 * 1024;
constexpr size_t WS_GATEW = 10 * MiB + 512 * 1024;
constexpr size_t WS_LIST = 11 * MiB;
constexpr size_t WS_RSL = 800 * MiB;
constexpr size_t WS_GWL = 804 * MiB;
constexpr size_t WS_WGU = 16 * MiB;
constexpr size_t WS_WD = 144 * MiB;
constexpr size_t WS_XB = 208 * MiB;
constexpr size_t WS_PROJ = 272 * MiB;
constexpr size_t WS_CHUNK = 432 * MiB;
constexpr size_t WS_UC = 544 * MiB;
constexpr size_t WS_GTOT = 576 * MiB;
constexpr size_t WS_ORAW = 577 * MiB;
constexpr int CH_WF = 0, CH_QD = 16384, CH_KT = 32768, CH_QK = 49152, CH_BYTES = 57344, UC_BYTES = 16384;
constexpr size_t WS_MIXED = 688 * MiB;
constexpr size_t WS_CONCAT = 720 * MiB;
constexpr size_t WS_X1B = 208 * MiB;
constexpr size_t WS_ACT = 272 * MiB;
constexpr size_t WS_SLAB = 544 * MiB;
constexpr size_t WS_X1 = 808 * MiB;
constexpr size_t WS_END = 872 * MiB;
static_assert(WS_ACT + (size_t)ACT_ROWS * 2048 <= WS_SLAB, "act fits");
static_assert(WS_SLAB + (size_t)NASSIGN * 2048 <= WS_END, "slab fits");

constexpr int CW_BAR = 4096;
constexpr int CW_CNT = 16384;
constexpr int CW_SEAM4 = 20480;

constexpr int LDS_BYTES = 163840;
constexpr int LDSCTL_OFF = LDS_BYTES - 1024, MISC_OFF = LDSCTL_OFF + 320, TAB_OFF = LDSCTL_OFF + 512;
constexpr int NWAVES = 8;

#define GAS __attribute__((address_space(1)))
#define LAS __attribute__((address_space(3)))
typedef unsigned short bf16;
typedef unsigned v4u __attribute__((ext_vector_type(4)));
typedef unsigned v2u __attribute__((ext_vector_type(2)));
typedef float f32x4 __attribute__((ext_vector_type(4)));
typedef float f32x2 __attribute__((ext_vector_type(2)));
typedef short bf16x8 __attribute__((ext_vector_type(8)));
typedef GAS unsigned gu32;
#define RLX_AGENT __ATOMIC_RELAXED, __HIP_MEMORY_SCOPE_AGENT
#define LDS_WAIT() asm volatile("s_waitcnt lgkmcnt(0)" ::: "memory")
#define VM_WAIT() asm volatile("s_waitcnt vmcnt(0)" ::: "memory")

__device__ __forceinline__ unsigned f2bf(float f) { unsigned u = __builtin_bit_cast(unsigned, f); return (u + 0x7fffu + ((u >> 16) & 1u)) >> 16; }
__device__ __forceinline__ unsigned pk2(float lo, float hi) { return f2bf(lo) | (f2bf(hi) << 16); }
__device__ __forceinline__ float bflo(unsigned u) { return __builtin_bit_cast(float, u << 16); }
__device__ __forceinline__ float bfhi(unsigned u) { return __builtin_bit_cast(float, u & 0xffff0000u); }
__device__ __forceinline__ unsigned pk4_fp8(float a, float b, float c, float d) { int p = __builtin_amdgcn_cvt_pk_fp8_f32(a, b, 0, false); p = __builtin_amdgcn_cvt_pk_fp8_f32(c, d, p, true); return (unsigned)p; }
typedef float f32x2_t __attribute__((ext_vector_type(2)));
constexpr float SLAB_SCALE = 16.f, SLAB_INV = 1.f / 16.f;
constexpr float W8_SCALE = 32.f, W8_INV = 1.f / 32.f;
__device__ __forceinline__ float wave_sum(float v) {
#pragma unroll
    for (int o = 1; o < 64; o <<= 1) v += __shfl_xor(v, o);
    return v;
}
__device__ __forceinline__ float frcp_(float x) { return __builtin_amdgcn_rcpf(x); }
__device__ __forceinline__ float frsq_(float x) { return __builtin_amdgcn_rsqf(x); }
__device__ __forceinline__ float fexp_(float x) { return __builtin_amdgcn_exp2f(x * 1.4426950408889634f); }
__device__ __forceinline__ float sigmoidf_(float x) { return frcp_(1.f + fexp_(-x)); }
__device__ __forceinline__ float siluf_(float x) { return x * frcp_(1.f + fexp_(-x)); }

namespace pg8 {
constexpr int BM = 256, BK = 64, HALF = 128, HTB = HALF * BK * 2, STAGE_BYTES = 8 * HTB;
__device__ __forceinline__ int lds_byte(int r, int c) { const int st = (r >> 4) * 2 + (c >> 5), rr = r & 15, cc = c & 31, ob = rr * 64 + cc * 2; return st * 1024 + (ob ^ (((ob >> 9) & 1) << 5)); }
__device__ __forceinline__ void stage_rc(int b, int& R, int& C) { const int st = b / 1024, sb = b % 1024, swz = sb ^ (((sb >> 9) & 1) << 5); R = (st >> 1) * 16 + swz / 64; C = (st & 1) * 32 + (swz % 64) / 2; }
__device__ __forceinline__ int perm32(int rho) { const int n = rho >> 4, i = rho & 15; return 8 * (i >> 2) + 4 * n + (i & 3); }
typedef __bf16 bf16x2_t __attribute__((ext_vector_type(2)));
__device__ __forceinline__ unsigned cvt_pk_bf16(float lo, float hi) { const f32x2 v = {lo, hi}; const bf16x2_t b = __builtin_convertvector(v, bf16x2_t); return __builtin_bit_cast(unsigned, b); }

struct Unit { int rt, pn, e, rb, rows; };

struct Sched {
    int nM, nN, nwg, G, c;
    __device__ __forceinline__ void init(int nM_, int nN_, int G_, int c_) { nM = nM_; nN = nN_; nwg = nM * nN; G = G_; c = c_; }
    __device__ __forceinline__ bool next(int i, int& pm, int& pn) const {
        const long L = (long)i * G + c; if (L >= nwg) return false;
        int wgid = (int)L; { const int q = nwg / 8, r = nwg % 8, xcd = wgid % 8, off = wgid / 8; wgid = (xcd < r ? xcd * (q + 1) : r * (q + 1) + (xcd - r) * q) + off; }
        const int nig = 8 * nN, gid = wgid / nig, fm = gid * 8, gsz = (nM - fm) < 8 ? (nM - fm) : 8;
        pm = fm + ((wgid % nig) % gsz); pn = (wgid % nig) / gsz; return true;
    }
};

typedef int v8i_t __attribute__((ext_vector_type(8)));
template <class P, bool F8 = false>
__device__ __forceinline__ void gemm_phase(LAS unsigned char* lds, const P& p) {
    const int tid = threadIdx.x, wid = __builtin_amdgcn_readfirstlane(tid >> 6), lane = tid & 63, wr = wid >> 2, wc = wid & 3, fr = lane & 15, fq = lane >> 4;
    const int K = p.K, RB = F8 ? K : 2 * K, nt = RB / (BK * 2);
    unsigned voffB[2];
#pragma unroll
    for (int i = 0; i < 2; ++i) { int R_, C_; stage_rc(tid * 16 + i * 8192, R_, C_); const int Rb = (R_ & ~31) + perm32(R_ & 31); voffB[i] = (unsigned)(Rb * RB + C_ * 2); }
#define PG8_AOFF(unit, dst) do { int R[2], C[2]; asm volatile("" ::: "memory"); _Pragma("unroll") for (int i_ = 0; i_ < 2; ++i_) stage_rc(tid * 16 + i_ * 8192, R[i_], C[i_]); p.a_off(unit, R, C, dst); } while (0)
    const size_t kstep = (size_t)(BK * 2);
    const size_t hstep = (size_t)HALF * RB;
    const unsigned ldsw = (unsigned)wid * 1024u;
    const int aoff = lds_byte(wr * 64 + fr, fq * 8), boff = lds_byte(wc * 32 + fr, fq * 8);
#define PG8_SA(b, h) (((b) * 2 + (h)) * HTB)
#define PG8_SB(b, h) ((4 + (b) * 2 + (h)) * HTB)
#define PG8_STAGE(bufoff, gbase, voff) do { _Pragma("unroll") for (int _i = 0; _i < 2; ++_i) \
        __builtin_amdgcn_global_load_lds((const unsigned*)((const char*)(gbase) + (voff)[_i]), (LAS unsigned*)(lds + (bufoff) + ldsw + _i * 8192), 16, 0, 0); } while (0)
#define PG8_LDA(dst, b, h) do { _Pragma("unroll") for (int m = 0; m < 4; ++m) { const v4i_t l_ = *(const LAS v4i_t*)(lds + PG8_SA(b, h) + aoff + m * 2048), h_ = *(const LAS v4i_t*)(lds + PG8_SA(b, h) + aoff + m * 2048 + 1024); dst[m] = __builtin_shufflevector(l_, h_, 0, 1, 2, 3, 4, 5, 6, 7); } } while (0)
#define PG8_LDB(dst, b, h) do { _Pragma("unroll") for (int n = 0; n < 2; ++n) { const v4i_t l_ = *(const LAS v4i_t*)(lds + PG8_SB(b, h) + boff + n * 2048), h_ = *(const LAS v4i_t*)(lds + PG8_SB(b, h) + boff + n * 2048 + 1024); dst[n] = __builtin_shufflevector(l_, h_, 0, 1, 2, 3, 4, 5, 6, 7); } } while (0)
#define PG8_HALF(x, k) __builtin_bit_cast(bf16x8, __builtin_shufflevector(x, x, 4 * (k), 4 * (k) + 1, 4 * (k) + 2, 4 * (k) + 3))
#define PG8_MMA(ai, bj, At, Bt) do { __builtin_amdgcn_s_setprio(1); \
        if constexpr (F8) { _Pragma("unroll") for (int m = 0; m < 4; ++m) _Pragma("unroll") for (int n = 0; n < 2; ++n) \
            asm volatile("v_mfma_scale_f32_16x16x128_f8f6f4 %0, %1, %2, %0, %3, %3 op_sel_hi:[0,0,0]" : "+v"(acc[ai][bj][m][n]) : "v"(Bt[n]), "v"(At[m]), "v"(mxs)); } \
        else { _Pragma("unroll") for (int m = 0; m < 4; ++m) _Pragma("unroll") for (int n = 0; n < 2; ++n) { \
            acc[ai][bj][m][n] = __builtin_amdgcn_mfma_f32_16x16x32_bf16(PG8_HALF(Bt[n], 0), PG8_HALF(At[m], 0), acc[ai][bj][m][n], 0, 0, 0); \
            acc[ai][bj][m][n] = __builtin_amdgcn_mfma_f32_16x16x32_bf16(PG8_HALF(Bt[n], 1), PG8_HALF(At[m], 1), acc[ai][bj][m][n], 0, 0, 0); } } \
        __builtin_amdgcn_s_setprio(0); } while (0)
#define PG8_WAIT_V(n) asm volatile("s_waitcnt vmcnt(" #n ")" ::: "memory")
#define PG8_WAIT_L(n) asm volatile("s_waitcnt lgkmcnt(" #n ")" ::: "memory")
#define PG8_BAR __builtin_amdgcn_s_barrier()
#define PG8_SCHED __builtin_amdgcn_sched_barrier(0)
    Unit cur, nxt; int ui = 0;
    if (!p.next(0, cur)) return;
    unsigned mxs = 0x7f7f7f7fu; asm volatile("" : "+v"(mxs));
    f32x4 acc[2][2][4][2];
#pragma unroll
    for (int a = 0; a < 2; ++a)
#pragma unroll
        for (int b = 0; b < 2; ++b)
#pragma unroll
            for (int m = 0; m < 4; ++m)
#pragma unroll
                for (int n = 0; n < 2; ++n) acc[a][b][m][n] = (f32x4){0.f, 0.f, 0.f, 0.f};
    typedef int v4i_t __attribute__((ext_vector_type(4)));
    v8i_t At[4], B0[2], B1[2];
    unsigned oA[2][2];
    PG8_AOFF(cur, oA);
    const char* cA = p.a_base(cur); const char* cB = p.b_base(cur);
    PG8_STAGE(PG8_SB(0, 0), cB, voffB); PG8_STAGE(PG8_SB(0, 1), cB + hstep, voffB); PG8_STAGE(PG8_SA(0, 0), cA, oA[0]); PG8_STAGE(PG8_SA(0, 1), cA, oA[1]);
    if (wr == 1) PG8_BAR;
    PG8_WAIT_V(2); PG8_BAR;
    PG8_STAGE(PG8_SB(1, 0), cB + kstep, voffB); PG8_STAGE(PG8_SA(1, 0), cA + kstep, oA[0]); PG8_STAGE(PG8_SB(1, 1), cB + hstep + kstep, voffB);
    PG8_WAIT_V(6); PG8_BAR;
    LAS v4u* park = (LAS v4u*)(lds + STAGE_BYTES) + tid;
    for (;;) {
        const bool has_next = p.next(ui + 1, nxt);
        const char* nA = cA; const char* nB = cB;
        { unsigned nO[2][2];
#pragma unroll
          for (int h = 0; h < 2; ++h)
#pragma unroll
              for (int i = 0; i < 2; ++i) nO[h][i] = oA[h][i];
          if (has_next) { nA = p.a_base(nxt); nB = p.b_base(nxt); PG8_AOFF(nxt, nO); }
          *park = (v4u){nO[0][0], nO[0][1], nO[1][0], nO[1][1]}; }
        for (int t = 0; t < nt; t += 2) {
            const bool last = (t == nt - 2);
            const char* a1 = cA + (size_t)(t + 1) * kstep;
            const char* a2 = last ? nA : cA + (size_t)(t + 2) * kstep; const char* b2 = last ? nB : cB + (size_t)(t + 2) * kstep;
            const char* a3 = a2 + kstep; const char* b3 = b2 + kstep;
            unsigned o2[2][2];
#pragma unroll
            for (int h = 0; h < 2; ++h)
#pragma unroll
                for (int i = 0; i < 2; ++i) o2[h][i] = oA[h][i];
            if (last) { const v4u q_ = *park; o2[0][0] = q_.x; o2[0][1] = q_.y; o2[1][0] = q_.z; o2[1][1] = q_.w; }
            PG8_LDB(B0, 0, 0); PG8_LDB(B1, 0, 1); PG8_SCHED; PG8_LDA(At, 0, 0); PG8_STAGE(PG8_SA(1, 1), a1, oA[1]);
            PG8_WAIT_V(8); PG8_WAIT_L(0); PG8_BAR; PG8_MMA(0, 0, At, B0); PG8_MMA(0, 1, At, B1); PG8_BAR; PG8_SCHED;
            PG8_LDA(At, 0, 1); PG8_STAGE(PG8_SB(0, 0), b2, voffB); PG8_STAGE(PG8_SB(0, 1), b2 + hstep, voffB); PG8_STAGE(PG8_SA(0, 0), a2, o2[0]);
            PG8_WAIT_V(8); PG8_WAIT_L(0); PG8_BAR; PG8_MMA(1, 0, At, B0); PG8_MMA(1, 1, At, B1); PG8_BAR; PG8_SCHED;
            PG8_LDB(B0, 1, 0); PG8_LDB(B1, 1, 1); PG8_SCHED; PG8_LDA(At, 1, 0); PG8_STAGE(PG8_SA(0, 1), a2, o2[1]);
            PG8_WAIT_V(8); PG8_WAIT_L(0); PG8_BAR; PG8_MMA(0, 0, At, B0); PG8_MMA(0, 1, At, B1); PG8_BAR; PG8_SCHED;
            PG8_LDA(At, 1, 1); PG8_STAGE(PG8_SB(1, 0), b3, voffB); PG8_STAGE(PG8_SB(1, 1), b3 + hstep, voffB); PG8_STAGE(PG8_SA(1, 0), a3, o2[0]);
            PG8_WAIT_V(8); PG8_WAIT_L(0); PG8_BAR; PG8_MMA(1, 0, At, B0); PG8_MMA(1, 1, At, B1); PG8_BAR; PG8_SCHED;
        }
        if (wr == 0) PG8_BAR;
        if constexpr (F8) asm volatile("s_nop 15\n\ts_nop 15" ::: "memory");
        p.epi(acc, cur, wr, wc, fr, fq);
        if (!has_next) break;
#pragma unroll
        for (int a = 0; a < 2; ++a)
#pragma unroll
            for (int b = 0; b < 2; ++b)
#pragma unroll
                for (int m = 0; m < 4; ++m)
#pragma unroll
                    for (int n = 0; n < 2; ++n) acc[a][b][m][n] = (f32x4){0.f, 0.f, 0.f, 0.f};
        cur = nxt; cA = nA; cB = nB; ++ui;
        { const v4u q_ = *park; oA[0][0] = q_.x; oA[0][1] = q_.y; oA[1][0] = q_.z; oA[1][1] = q_.w; }
        if (wr == 1) PG8_BAR;
    }
    PG8_WAIT_V(0);
    PG8_BAR;
#undef PG8_SA
#undef PG8_SB
#undef PG8_STAGE
#undef PG8_LDA
#undef PG8_LDB
#undef PG8_MMA
#undef PG8_HALF
#undef PG8_AOFF
#undef PG8_WAIT_V
#undef PG8_WAIT_L
#undef PG8_BAR
#undef PG8_SCHED
}
}

#define XB_TMO      128
#define XB_XCNT(j)  (256  + 64 * (j))
#define XB_XSUB(j)  (1280 + 64 * (j))
#define XB_XGEN(j)  (2304 + 64 * (j))
#define XB_TOP      3328
#define XB_TOPGEN   3392
#define XCD_BAR_WORDS 3456
#define XB_SPIN_CAP (1u << 18)
__device__ __forceinline__ unsigned xb_ld(unsigned* p)              { return __hip_atomic_load(p, __ATOMIC_RELAXED, __HIP_MEMORY_SCOPE_AGENT); }
__device__ __forceinline__ unsigned xb_add(unsigned* p, unsigned v) { return __hip_atomic_fetch_add(p, v, __ATOMIC_RELAXED, __HIP_MEMORY_SCOPE_AGENT); }
__device__ __forceinline__ unsigned xb_xcc_id() { return (unsigned)__builtin_amdgcn_s_getreg((3 << 11) | 20) & 0xFu; }
#define XB_SPIN(cond, bar) do { unsigned _sp = 0; while (cond) { __builtin_amdgcn_s_sleep(1); \
    if ((++_sp & 255u) == 0u) { if (xb_ld(&(bar)[XB_TMO])) break; if (_sp > XB_SPIN_CAP) { atomicAdd(&(bar)[XB_TMO], 1u); break; } } } } while (0)
struct XcdBarrier { unsigned* bar; unsigned x; volatile LAS unsigned* st; };
__device__ __forceinline__ XcdBarrier xcd_barrier_post(unsigned* bar, volatile LAS unsigned* st) {
    XcdBarrier b; b.bar = bar; b.x = xb_xcc_id(); b.st = st;
    if (threadIdx.x == 0) (void)xb_add(&bar[XB_XCNT(b.x)], 1u);
    return b;
}
__device__ __forceinline__ void xcd_barrier_complete(unsigned* bar, unsigned x, unsigned& nloc, unsigned& nx) {
    const unsigned G = gridDim.x * gridDim.y * gridDim.z;
    unsigned sum, cnt, mine, sp = 0u;
    for (;;) {
        sum = 0u; cnt = 0u; mine = 0u;
#pragma unroll
        for (unsigned j = 0; j < 16; ++j) { const unsigned c = xb_ld(&bar[XB_XCNT(j)]); sum += c; cnt += (c > 0u) ? 1u : 0u; mine = (j == x) ? c : mine; }
        if (sum == G) break;
        __builtin_amdgcn_s_sleep(1);
        if ((++sp & 255u) == 0u) { if (xb_ld(&bar[XB_TMO])) break; if (sp > XB_SPIN_CAP) { atomicAdd(&bar[XB_TMO], 1u); break; } }
    }
    nloc = mine > 0u ? mine : 1u; nx = cnt > 0u ? cnt : 1u;
}
__device__ __forceinline__ void xcd_barrier(const XcdBarrier& b) {
    asm volatile("s_waitcnt vmcnt(0)" ::: "memory");
    __syncthreads();
    if (threadIdx.x == 0) {
        unsigned* bar = b.bar;
        __builtin_amdgcn_s_waitcnt(0);
        unsigned nloc = b.st[0], nx = b.st[1];
        if (nloc == 0u) { xcd_barrier_complete(bar, b.x, nloc, nx); b.st[0] = nloc; b.st[1] = nx; }
        const unsigned old = xb_add(&bar[XB_XSUB(b.x)], 1u);
        const unsigned gen = old / nloc;
        if (old + 1u == (gen + 1u) * nloc) {
            __builtin_amdgcn_fence(__ATOMIC_RELEASE, "agent");
            asm volatile("s_waitcnt vmcnt(0)" ::: "memory");
            const unsigned og = xb_add(&bar[XB_TOP], 1u);
            const unsigned tg = og / nx;
            if (og + 1u == (tg + 1u) * nx) xb_add(&bar[XB_TOPGEN], 1u);
            else XB_SPIN(xb_ld(&bar[XB_TOPGEN]) == tg, bar);
            __builtin_amdgcn_fence(__ATOMIC_ACQUIRE, "agent");
            xb_add(&bar[XB_XGEN(b.x)], 1u);
            asm volatile("s_waitcnt vmcnt(0)" ::: "memory");
        } else {
            XB_SPIN(xb_ld(&bar[XB_XGEN(b.x)]) == gen, bar);
            __builtin_amdgcn_fence(__ATOMIC_ACQUIRE, "agent");
            asm volatile("s_waitcnt vmcnt(0)" ::: "memory");
        }
    }
    __syncthreads();
}

struct Frame {
    LAS unsigned char* lds;
    int tid, lane, wave, vcu, G;
    const float* in[18];
    float* out;
    unsigned char* ws;
};
using pg8::Unit;
using pg8::cvt_pk_bf16;

struct ProbBase {
    int K; int RB; pg8::Sched S;
    __device__ __forceinline__ void lin_off(const int (&R)[2], const int (&C)[2], unsigned (&off)[2][2]) const {
#pragma unroll
        for (int h = 0; h < 2; ++h)
#pragma unroll
            for (int i = 0; i < 2; ++i) off[h][i] = (unsigned)((h * 128 + R[i]) * RB + C[i] * 2);
    }
};
struct ProbIn : ProbBase {
    const bf16* A; const bf16* Bt; bf16* O; const float* rs;
    __device__ __forceinline__ bool next(int i, Unit& u) const { int pm, pn; if (!S.next(i, pm, pn)) return false; u.rt = pm; u.pn = pn; u.e = 0; u.rb = pm; u.rows = 256; return true; }
    __device__ __forceinline__ const char* a_base(const Unit& u) const { return (const char*)A + (size_t)u.rt * 256 * RB; }
    __device__ __forceinline__ const char* b_base(const Unit& u) const { return (const char*)Bt + (size_t)u.pn * 256 * RB; }
    __device__ __forceinline__ void a_off(const Unit&, const int (&R)[2], const int (&C)[2], unsigned (&off)[2][2]) const { lin_off(R, C, off); }
    __device__ __forceinline__ void epi(const f32x4 (&acc)[2][2][4][2], const Unit& u, int wr, int wc, int fr, int fq) const {
        const int row0 = u.rt * 256 + wr * 64 + fr, col0 = u.pn * 256 + wc * 32 + 8 * fq;
#pragma unroll
        for (int ai = 0; ai < 2; ++ai)
#pragma unroll
            for (int m = 0; m < 4; ++m) { const int row = row0 + ai * 128 + m * 16; const float sc = rs[row]; bf16* rowp = O + (size_t)row * NPROJ + col0;
#pragma unroll
                for (int bj = 0; bj < 2; ++bj) { const f32x4 v0 = acc[ai][bj][m][0] * sc, v1 = acc[ai][bj][m][1] * sc; v4u w;
                    w.x = cvt_pk_bf16(v0[0], v0[1]); w.y = cvt_pk_bf16(v0[2], v0[3]); w.z = cvt_pk_bf16(v1[0], v1[1]); w.w = cvt_pk_bf16(v1[2], v1[3]);
                    *(v4u*)(rowp + bj * 128) = w; } }
    }
};
struct ProbPool : ProbBase {
    const bf16* A; const bf16* Bt; bf16* O;
    __device__ __forceinline__ bool next(int i, Unit& u) const { int pm, pn; if (!S.next(i, pm, pn)) return false; u.rt = pm; u.pn = pn; u.e = 0; u.rb = pm; u.rows = 256; return true; }
    __device__ __forceinline__ const char* a_base(const Unit& u) const { return (const char*)A + (size_t)u.rt * 256 * RB; }
    __device__ __forceinline__ const char* b_base(const Unit& u) const { return (const char*)Bt + (size_t)u.pn * 256 * RB; }
    __device__ __forceinline__ void a_off(const Unit&, const int (&R)[2], const int (&C)[2], unsigned (&off)[2][2]) const { lin_off(R, C, off); }
    __device__ __forceinline__ void epi(const f32x4 (&acc)[2][2][4][2], const Unit& u, int wr, int wc, int fr, int fq) const {
        const int row0 = u.rt * 256 + wr * 64 + fr, col0 = 512 + u.pn * 256 + wc * 32 + 8 * fq;
#pragma unroll
        for (int ai = 0; ai < 2; ++ai)
#pragma unroll
            for (int m = 0; m < 4; ++m) { const int row = row0 + ai * 128 + m * 16; bf16* rowp = O + (size_t)row * DM + col0;
#pragma unroll
                for (int bj = 0; bj < 2; ++bj) { const f32x4 v0 = acc[ai][bj][m][0], v1 = acc[ai][bj][m][1]; v4u w;
                    w.x = cvt_pk_bf16(v0[0], v0[1]); w.y = cvt_pk_bf16(v0[2], v0[3]); w.z = cvt_pk_bf16(v1[0], v1[1]); w.w = cvt_pk_bf16(v1[2], v1[3]);
                    *(v4u*)(rowp + bj * 128) = w; } }
    }
};
struct ProbOut : ProbBase {
    const bf16* A; const bf16* Bt; const bf16* X; bf16* O;
    __device__ __forceinline__ bool next(int i, Unit& u) const { int pm, pn; if (!S.next(i, pm, pn)) return false; u.rt = pm; u.pn = pn; u.e = 0; u.rb = pm; u.rows = 256; return true; }
    __device__ __forceinline__ const char* a_base(const Unit& u) const { return (const char*)A + (size_t)u.rt * 256 * RB; }
    __device__ __forceinline__ const char* b_base(const Unit& u) const { return (const char*)Bt + (size_t)u.pn * 256 * RB; }
    __device__ __forceinline__ void a_off(const Unit&, const int (&R)[2], const int (&C)[2], unsigned (&off)[2][2]) const { lin_off(R, C, off); }
    __device__ __forceinline__ void epi(const f32x4 (&acc)[2][2][4][2], const Unit& u, int wr, int wc, int fr, int fq) const {
        const int row0 = u.rt * 256 + wr * 64 + fr, col0 = u.pn * 256 + wc * 32 + 8 * fq;
#pragma unroll
        for (int ai = 0; ai < 2; ++ai)
#pragma unroll
            for (int m = 0; m < 4; ++m) { const size_t off = (size_t)(row0 + ai * 128 + m * 16) * DM + col0;
#pragma unroll
                for (int bj = 0; bj < 2; ++bj) { const v4u xv = *(const v4u*)(X + off + bj * 128); const f32x4 a = acc[ai][bj][m][0], b = acc[ai][bj][m][1];
                    *(v4u*)(O + off + bj * 128) = (v4u){cvt_pk_bf16(bflo(xv.x) + a.x, bfhi(xv.x) + a.y), cvt_pk_bf16(bflo(xv.y) + a.z, bfhi(xv.y) + a.w),
                                                        cvt_pk_bf16(bflo(xv.z) + b.x, bfhi(xv.z) + b.y), cvt_pk_bf16(bflo(xv.w) + b.z, bfhi(xv.w) + b.w)}; } }
    }
};
struct MoeTab { const LAS int* pref; const LAS int* cnt; };
__device__ __forceinline__ void moe_decode(const MoeTab& T, int rt, Unit& u) {
    int e = 0;
#pragma unroll 1
    for (int j = 1; j < NE; ++j) if (T.pref[j] <= rt) e = j;
    u.e = e; u.rb = rt - T.pref[e]; const int left = T.cnt[e] - u.rb * 256; u.rows = left < 256 ? left : 256;
}
struct ProbGU : ProbBase {
    MoeTab T; const unsigned char* A; const unsigned char* Bt; unsigned char* O; const int* list; const float* rs2; const float* bgu;
    __device__ __forceinline__ bool next(int i, Unit& u) const { int pm, pn; if (!S.next(i, pm, pn)) return false; u.rt = pm; u.pn = pn; moe_decode(T, pm, u); return true; }
    __device__ __forceinline__ const char* a_base(const Unit&) const { return (const char*)A; }
    __device__ __forceinline__ const char* b_base(const Unit& u) const { return (const char*)Bt + ((size_t)u.e * 2048 + (size_t)u.pn * 256) * RB; }
    __device__ __forceinline__ void a_off(const Unit& u, const int (&R)[2], const int (&C)[2], unsigned (&off)[2][2]) const {
        const int* lp = list + (size_t)u.e * LISTCAP + u.rb * 256;
#pragma unroll
        for (int h = 0; h < 2; ++h)
#pragma unroll
            for (int i = 0; i < 2; ++i) { const int r = h * 128 + R[i]; const int ent = (r < u.rows) ? lp[r] : 0; off[h][i] = (unsigned)(ent >> 2) * (unsigned)RB + (unsigned)C[i] * 2u; }
    }
    __device__ __forceinline__ void epi(const f32x4 (&acc)[2][2][4][2], const Unit& u, int wr, int wc, int fr, int fq) const {
        const float* rsp = rs2 + (size_t)u.e * LISTCAP + u.rb * 256;
        const int j0 = wc * 32 + 8 * fq;
        const float* bg = bgu + (size_t)u.e * 2048 + u.pn * 256 + j0;
        f32x4 bgv[2], buv[2];
#pragma unroll
        for (int n = 0; n < 2; ++n) { bgv[n] = *(const f32x4*)(bg + 4 * n); buv[n] = *(const f32x4*)(bg + 128 + 4 * n); }
#pragma unroll
        for (int ai = 0; ai < 2; ++ai)
#pragma unroll
            for (int m = 0; m < 4; ++m) { const int r = ai * 128 + wr * 64 + m * 16 + fr;
                if (r < u.rows) { const float sc = rsp[r] * W8_INV; const f32x2_t sc2 = (f32x2_t){sc, sc}; unsigned w[2];
#pragma unroll
                    for (int n = 0; n < 2; ++n) { f32x2_t a2[2];
#pragma unroll
                        for (int qp = 0; qp < 2; ++qp) {
                            f32x2_t gt = (f32x2_t){acc[ai][0][m][n][2 * qp], acc[ai][0][m][n][2 * qp + 1]} * sc2 + (f32x2_t){bgv[n][2 * qp], bgv[n][2 * qp + 1]};
                            f32x2_t up = (f32x2_t){acc[ai][1][m][n][2 * qp], acc[ai][1][m][n][2 * qp + 1]} * sc2 + (f32x2_t){buv[n][2 * qp], buv[n][2 * qp + 1]};
                            gt.x = fminf(gt.x, 7.f); gt.y = fminf(gt.y, 7.f); up.x = fminf(fmaxf(up.x, -7.f), 7.f); up.y = fminf(fmaxf(up.y, -7.f), 7.f);
                            const f32x2_t ex = gt * (f32x2_t){-1.702f * 1.4426950408889634f, -1.702f * 1.4426950408889634f};
                            const f32x2_t dn = (f32x2_t){__builtin_amdgcn_exp2f(ex.x), __builtin_amdgcn_exp2f(ex.y)} + (f32x2_t){1.f, 1.f};
                            a2[qp] = (up + (f32x2_t){1.f, 1.f}) * gt * (f32x2_t){frcp_(dn.x), frcp_(dn.y)}; }
                        w[n] = pk4_fp8(a2[0].x, a2[0].y, a2[1].x, a2[1].y); }
                    *(v2u*)(O + (size_t)(u.rt * 256 + r) * DE + u.pn * 128 + j0) = (v2u){w[0], w[1]}; } }
    }
};
struct ProbDown : ProbBase {
    MoeTab T; const unsigned char* A; const unsigned char* Bt; unsigned char* O; const int* list; const float* gw; const float* bd;
    __device__ __forceinline__ bool next(int i, Unit& u) const { int pm, pn; if (!S.next(i, pm, pn)) return false; u.rt = pm; u.pn = pn; moe_decode(T, pm, u); return true; }
    __device__ __forceinline__ const char* a_base(const Unit& u) const { return (const char*)A + (size_t)u.rt * 256 * RB; }
    __device__ __forceinline__ const char* b_base(const Unit& u) const { return (const char*)Bt + ((size_t)u.e * 1024 + (size_t)u.pn * 256) * RB; }
    __device__ __forceinline__ void a_off(const Unit&, const int (&R)[2], const int (&C)[2], unsigned (&off)[2][2]) const { lin_off(R, C, off); }
    __device__ __forceinline__ void epi(const f32x4 (&acc)[2][2][4][2], const Unit& u, int wr, int wc, int fr, int fq) const {
        const int* lp = list + (size_t)u.e * LISTCAP + u.rb * 256;
        const int c0 = u.pn * 256 + wc * 32 + 8 * fq;
        const float* gwp = gw + (size_t)u.e * LISTCAP + u.rb * 256;
        const float* bp = bd + (size_t)u.e * DM + c0;
        f32x4 bv[2][2];
#pragma unroll
        for (int bj = 0; bj < 2; ++bj)
#pragma unroll
            for (int n = 0; n < 2; ++n) bv[bj][n] = *(const f32x4*)(bp + bj * 128 + 4 * n);
#pragma unroll
        for (int ai = 0; ai < 2; ++ai)
#pragma unroll
            for (int m = 0; m < 4; ++m) { const int r = ai * 128 + wr * 64 + m * 16 + fr;
                if (r < u.rows) { const int ent = lp[r]; const float g = gwp[r]; unsigned char* rowp = O + (size_t)ent * DM + c0;
#pragma unroll
                    for (int bj = 0; bj < 2; ++bj) { const f32x4 v0 = (acc[ai][bj][m][0] * W8_INV + bv[bj][0]) * g, v1 = (acc[ai][bj][m][1] * W8_INV + bv[bj][1]) * g;
                        *(v2u*)(rowp + bj * 128) = (v2u){pk4_fp8(v0[0] * SLAB_SCALE, v0[1] * SLAB_SCALE, v0[2] * SLAB_SCALE, v0[3] * SLAB_SCALE), pk4_fp8(v1[0] * SLAB_SCALE, v1[1] * SLAB_SCALE, v1[2] * SLAB_SCALE, v1[3] * SLAB_SCALE)}; } } }
    }
};

typedef short v4i16_t __attribute__((ext_vector_type(4)));
__device__ __forceinline__ void tr_item(const float* W, int ldw, int k0, int nsrc0, bf16* WT, size_t drow0, int ldk, int dk0, const float* ks, const float* ns, LAS unsigned char* scr, int lane) {
    const int kr = lane >> 4, n4 = (lane & 15) * 4;
    f32x4 nsc = (f32x4){1.f, 1.f, 1.f, 1.f}; if (ns) nsc = *(const f32x4*)(ns + nsrc0 + n4);
    f32x4 v[16];
#pragma unroll
    for (int i = 0; i < 16; ++i) v[i] = *(const f32x4*)(W + (size_t)(k0 + 4 * i + kr) * ldw + nsrc0 + n4);
#pragma unroll
    for (int i = 0; i < 16; ++i) { f32x4 x = v[i] * nsc; if (ks) x = x * ks[k0 + 4 * i + kr];
        *(LAS v2u*)(scr + (4 * i + kr) * 192 + n4 * 2) = (v2u){pg8::cvt_pk_bf16(x.x, x.y), pg8::cvt_pk_bf16(x.z, x.w)}; }
    LDS_WAIT(); asm volatile("" ::: "memory");
    const int G = lane >> 4, li = lane & 15, q = li >> 2, p = li & 3;
    const LAS unsigned char* rb = scr + q * 192 + (16 * G + 4 * p) * 2;
    bf16* dst = WT + (drow0 + 16 * G + li) * (size_t)ldk + dk0 + k0;
#pragma unroll
    for (int kc = 0; kc < 8; ++kc) {
        const v4i16_t lo = __builtin_amdgcn_ds_read_tr16_b64_v4i16((LAS v4i16_t*)(rb + (8 * kc) * 192));
        const v4i16_t hi = __builtin_amdgcn_ds_read_tr16_b64_v4i16((LAS v4i16_t*)(rb + (8 * kc + 4) * 192));
        const v2u l2 = __builtin_bit_cast(v2u, lo), h2 = __builtin_bit_cast(v2u, hi);
        *(v4u*)(dst + 8 * kc) = (v4u){l2.x, l2.y, h2.x, h2.y};
    }
    LDS_WAIT(); asm volatile("" ::: "memory");
}

template <int KT, int NT>
__device__ __forceinline__ void tr_item8(const float* W, int ldw, int k0, int nsrc0, unsigned char* WT, size_t drow0, int ldk, const float* ks, float mul, LAS unsigned char* scr, int lane) {
    constexpr int LPR = NT / 4, RPL = 64 / LPR, PA = NT * 2 + 64;
    static_assert(KT * NT == 4096 && (PA / 4) % 32 == 16, "tile geometry");
    const int kr = lane / LPR, n4 = (lane % LPR) * 4;
    f32x4 v[16];
#pragma unroll
    for (int i = 0; i < 16; ++i) v[i] = *(const f32x4*)(W + (size_t)(k0 + RPL * i + kr) * ldw + nsrc0 + n4);
#pragma unroll
    for (int i = 0; i < 16; ++i) { const float sc = ks ? ks[k0 + RPL * i + kr] * mul : mul; const f32x4 x = v[i] * sc;
        *(LAS v2u*)(scr + (RPL * i + kr) * PA + n4 * 2) = (v2u){pg8::cvt_pk_bf16(x.x, x.y), pg8::cvt_pk_bf16(x.z, x.w)}; }
    LDS_WAIT(); asm volatile("" ::: "memory");
    const int G = lane >> 4, li = lane & 15, q = li >> 2, p = li & 3;
#pragma unroll
    for (int ps = 0; ps < NT / 64; ++ps) {
        const LAS unsigned char* rb = scr + q * PA + (16 * (G + 4 * ps) + 4 * p) * 2;
        unsigned char* dst = WT + (drow0 + 16 * (G + 4 * ps) + li) * (size_t)ldk + k0;
#pragma unroll
        for (int kq = 0; kq < KT / 16; ++kq) {
            v2u t[4];
#pragma unroll
            for (int u = 0; u < 4; ++u) t[u] = __builtin_bit_cast(v2u, __builtin_amdgcn_ds_read_tr16_b64_v4i16((LAS v4i16_t*)(rb + (16 * kq + 4 * u) * PA)));
            v4u o;
            o.x = pk4_fp8(bflo(t[0].x), bfhi(t[0].x), bflo(t[0].y), bfhi(t[0].y)); o.y = pk4_fp8(bflo(t[1].x), bfhi(t[1].x), bflo(t[1].y), bfhi(t[1].y));
            o.z = pk4_fp8(bflo(t[2].x), bfhi(t[2].x), bflo(t[2].y), bfhi(t[2].y)); o.w = pk4_fp8(bflo(t[3].x), bfhi(t[3].x), bflo(t[3].y), bfhi(t[3].y));
            *(v4u*)(dst + 16 * kq) = o;
        }
    }
    LDS_WAIT(); asm volatile("" ::: "memory");
}

constexpr int TRF_T1 = 128 * 192, TRF_T2 = 64 * 144, TRF_BYTES = TRF_T1 + TRF_T2;
__device__ __forceinline__ void tr_item8f(const float* W, int ldw, int k0, int nsrc0, unsigned char* WT, size_t drow0, int ldk, const float* ks, float mul, LAS unsigned char* scr, int lane) {
    const int kr = lane >> 4, n4 = (lane & 15) * 4;
#pragma unroll
    for (int hb = 0; hb < 2; ++hb) {
        f32x4 v[16];
#pragma unroll
        for (int i = 0; i < 16; ++i) v[i] = *(const f32x4*)(W + (size_t)(k0 + 64 * hb + 4 * i + kr) * ldw + nsrc0 + n4);
#pragma unroll
        for (int i = 0; i < 16; ++i) { const float sc = ks ? ks[k0 + 64 * hb + 4 * i + kr] * mul : mul; const f32x4 x = v[i] * sc;
            *(LAS v2u*)(scr + (64 * hb + 4 * i + kr) * 192 + n4 * 2) = (v2u){pg8::cvt_pk_bf16(x.x, x.y), pg8::cvt_pk_bf16(x.z, x.w)}; }
    }
    LDS_WAIT(); asm volatile("" ::: "memory");
    const int G = lane >> 4, li = lane & 15, q = li >> 2, p = li & 3;
    const LAS unsigned char* rb = scr + q * 192 + (16 * G + 4 * p) * 2;
    LAS unsigned char* t2 = scr + TRF_T1;
#pragma unroll
    for (int kq = 0; kq < 8; ++kq) {
        v2u t[4];
#pragma unroll
        for (int u = 0; u < 4; ++u) t[u] = __builtin_bit_cast(v2u, __builtin_amdgcn_ds_read_tr16_b64_v4i16((LAS v4i16_t*)(rb + (16 * kq + 4 * u) * 192)));
        v4u o;
        o.x = pk4_fp8(bflo(t[0].x), bfhi(t[0].x), bflo(t[0].y), bfhi(t[0].y)); o.y = pk4_fp8(bflo(t[1].x), bfhi(t[1].x), bflo(t[1].y), bfhi(t[1].y));
        o.z = pk4_fp8(bflo(t[2].x), bfhi(t[2].x), bflo(t[2].y), bfhi(t[2].y)); o.w = pk4_fp8(bflo(t[3].x), bfhi(t[3].x), bflo(t[3].y), bfhi(t[3].y));
        *(LAS v4u*)(t2 + (16 * G + li) * 144 + 16 * kq) = o;
    }
    LDS_WAIT(); asm volatile("" ::: "memory");
    const int r8 = lane >> 3, c8 = lane & 7;
#pragma unroll
    for (int j = 0; j < 8; ++j) { const v4u o = *(const LAS v4u*)(t2 + (8 * j + r8) * 144 + 16 * c8);
        *(v4u*)(WT + (drow0 + 8 * j + r8) * (size_t)ldk + k0 + 16 * c8) = o; }
    LDS_WAIT(); asm volatile("" ::: "memory");
}

constexpr int TRK = 128, TRN = 64;
constexpr int MOE_PREP_ITEMS = 32 * (1024 / TRK) * (2048 / TRN) + 32 * (1024 / TRK) * (1024 / TRN);
__device__ __forceinline__ void moe_weight_prep(Frame& F, int b0, int lo, int hi) {
    const float* fnw = F.in[10]; const float* w_gu = F.in[13]; const float* w_d = F.in[15];
    unsigned char* WguT = F.ws + WS_WGU; unsigned char* WdT = F.ws + WS_WD;
    constexpr int TW = 4;
    if (F.wave >= TW) return;
    LAS unsigned char* scr = F.lds + F.wave * TRF_BYTES;
    const int gw = ((int)blockIdx.x - b0) * TW + F.wave, NGW = (F.G - b0) * TW;
    constexpr int NKB = 1024 / TRK, NNB_GU = 2048 / TRN, NNB_D = 1024 / TRN, SEGN = 128 / TRN;
    constexpr int I_GU = 32 * NKB * NNB_GU;
    for (int it = lo + gw; it < hi; it += NGW) {
        int r = it;
        if (r < I_GU) { const int e = r / (NKB * NNB_GU), r2 = r % (NKB * NNB_GU), kb = r2 / NNB_GU, cb = r2 % NNB_GU;
            const int half = cb / (NNB_GU / 2), t = (cb % (NNB_GU / 2)) / SEGN, nb = cb % SEGN;
            tr_item8f(w_gu + (size_t)e * DM * 2048, 2048, kb * TRK, half * 1024 + t * 128 + nb * TRN, WguT, (size_t)e * 2048 + t * 256 + half * 128 + nb * TRN, DM, fnw, W8_SCALE, scr, F.lane); continue; } r -= I_GU;
        { const int e = r / (NKB * NNB_D), r2 = r % (NKB * NNB_D), kb = r2 / NNB_D, nb = r2 % NNB_D;
          tr_item8f(w_d + (size_t)e * DE * DM, DM, kb * TRK, nb * TRN, WdT, (size_t)e * 1024 + nb * TRN, DE, nullptr, W8_SCALE, scr, F.lane); }
    }
}
static_assert(4 * TRF_BYTES <= LDSCTL_OFF, "transposer LDS");
constexpr int MOE_PREP_SPLIT = 0;

__device__ __forceinline__ void phase_prep(Frame& F) {
    const float* x = F.in[0]; const float* anw = F.in[1]; const float* w_in = F.in[2]; const float* a_log = F.in[4]; const float* dt_bias = F.in[5];
    const float* pool_w = F.in[7]; const float* pool_scale = F.in[8]; const float* w_out = F.in[9]; const float* fnw = F.in[10];
    const float* w_router = F.in[11]; const float* w_gu = F.in[13]; const float* b_gu = F.in[14]; const float* w_d = F.in[15];
    bf16* WinT = (bf16*)(F.ws + WS_WIN); bf16* WoutT = (bf16*)(F.ws + WS_WOUT); bf16* WpoolT = (bf16*)(F.ws + WS_WPOOL);
    bf16* WguT = (bf16*)(F.ws + WS_WGU); bf16* WdT = (bf16*)(F.ws + WS_WD);
    bf16* WrI = (bf16*)(F.ws + WS_WR); float* bguP = (float*)(F.ws + WS_BGU);
    bf16* xb = (bf16*)(F.ws + WS_XB); float* rs1 = (float*)(F.ws + WS_RS1); float* betaA = (float*)(F.ws + WS_BETA); float* gA = (float*)(F.ws + WS_G);
    LAS unsigned char* scr = F.lds + F.wave * 12288;
    LAS float* W8T = (LAS float*)(F.lds + 98304);
    const int gw = F.vcu * NWAVES + F.wave, NGW = F.G * NWAVES;
    const int gt = F.vcu * 512 + F.tid, NGT = F.G * 512;
    for (int idx = F.tid; idx < 8192; idx += 512) { const int k = idx >> 3, c = idx & 7; W8T[c * 1024 + k] = anw[k] * w_in[(size_t)k * DIN + 2048 + c]; }
    __syncthreads();
    constexpr int I_IN1 = 16 * 32, I_OUT = 16 * 16;
    constexpr int NITEMS = I_IN1 + I_OUT;
    for (int it = gw; it < NITEMS; it += NGW) {
        int r = it;
        if (r < I_IN1) { const int kb = r / 32, nb = r % 32; tr_item(w_in, DIN, kb * 64, nb * 64, WinT, (size_t)nb * 64, DM, 0, anw, nullptr, scr, F.lane); continue; } r -= I_IN1;
        { const int kb = r / 16, nb = r % 16; tr_item(w_out, DM, kb * 64, nb * 64, WoutT, (size_t)nb * 64, DM, 0, nullptr, nullptr, scr, F.lane); }
    }
    __syncthreads();
    for (int task = blockIdx.x; task < 256; task += F.G) {
        const int g = task >> 6, kb = (task >> 2) & 15, dq = task & 3;
        LAS float* Wt = (LAS float*)F.lds;
        LAS float* Pw = (LAS float*)(F.lds + 33024);
        for (int idx = F.tid; idx < 64 * 32; idx += 512) { const int k = idx >> 5, c4 = (idx & 31) * 4; const f32x4 v = *(const f32x4*)(w_in + (size_t)(kb * 64 + k) * DIN + 2056 + g * 128 + c4);
            Wt[k * 129 + c4] = v.x; Wt[k * 129 + c4 + 1] = v.y; Wt[k * 129 + c4 + 2] = v.z; Wt[k * 129 + c4 + 3] = v.w; }
        for (int idx = F.tid; idx < 128 * 8; idx += 512) { const int c = idx >> 3, d4 = (idx & 7) * 4; *(LAS f32x4*)(Pw + c * 32 + d4) = *(const f32x4*)(pool_w + (size_t)g * 16384 + c * 128 + dq * 32 + d4); }
        __syncthreads();
        const int k = F.tid & 63, d4 = (F.tid >> 6) * 4;
        f32x4 acc = (f32x4){0.f, 0.f, 0.f, 0.f};
#pragma unroll 8
        for (int c = 0; c < 128; ++c) acc += *(const LAS f32x4*)(Pw + c * 32 + d4) * Wt[k * 129 + c];
        const int n0 = g * 128 + dq * 32 + d4; const f32x4 ps = *(const f32x4*)(pool_scale + n0); const float an = anw[kb * 64 + k];
        bf16* dst = WinT + (size_t)(2048 + n0) * DM + kb * 64 + k;
        dst[0] = (bf16)f2bf(acc.x * ps.x * an); dst[DM] = (bf16)f2bf(acc.y * ps.y * an); dst[2 * DM] = (bf16)f2bf(acc.z * ps.z * an); dst[3 * DM] = (bf16)f2bf(acc.w * ps.w * an);
        __syncthreads();
    }
    moe_weight_prep(F, 0, 0, MOE_PREP_SPLIT);
    for (int idx = gt; idx < NE * 2048; idx += NGT) { const int e = idx >> 11, r = idx & 2047, t = r >> 8, j = r & 255, half = j >> 7, jj = j & 127; bguP[idx] = b_gu[(size_t)e * 2048 + half * 1024 + t * 128 + jj]; }
    for (int idx = gt; idx < 64 * 64 * 8; idx += NGT) { const int j = idx & 7, ln = (idx >> 3) & 63, fr2 = idx >> 9, nb = fr2 & 1, ks = fr2 >> 1;
        const int k = 32 * ks + 8 * (ln >> 4) + j, e = 16 * nb + (ln & 15); const float v = fnw[k] * w_router[(size_t)k * NE + e];
        const unsigned hb = f2bf(v); const float hf = __builtin_bit_cast(float, hb << 16); const unsigned lb = f2bf(v - hf);
        WrI[((size_t)(fr2 * 2 + 0) * 64 + ln) * 8 + j] = (bf16)hb; WrI[((size_t)(fr2 * 2 + 1) * 64 + ln) * 8 + j] = (bf16)lb; }
    for (int m = gw; m < NTOK; m += NGW) {
        const f32x4* xr = (const f32x4*)(x + (size_t)m * DM) + F.lane;
        f32x4 v[4]; float ss = 0.f; float d8[8];
#pragma unroll
        for (int c = 0; c < 8; ++c) d8[c] = 0.f;
#pragma unroll
        for (int j = 0; j < 4; ++j) { v[j] = xr[64 * j]; ss += (v[j].x * v[j].x + v[j].y * v[j].y) + (v[j].z * v[j].z + v[j].w * v[j].w); }
#pragma unroll
        for (int c = 0; c < 8; ++c)
#pragma unroll
            for (int j = 0; j < 4; ++j) { const f32x4 w = *(const LAS f32x4*)(W8T + c * 1024 + 256 * j + 4 * F.lane); d8[c] += (v[j].x * w.x + v[j].y * w.y) + (v[j].z * w.z + v[j].w * w.w); }
        ss = wave_sum(ss);
#pragma unroll
        for (int c = 0; c < 8; ++c) d8[c] = wave_sum(d8[c]);
        const float rs = 1.f / sqrtf(ss * (1.f / DM) + 1e-6f);
        unsigned long long* o8 = (unsigned long long*)(xb + (size_t)m * DM) + F.lane;
#pragma unroll
        for (int j = 0; j < 4; ++j) o8[64 * j] = (unsigned long long)pk2(v[j].x, v[j].y) | ((unsigned long long)pk2(v[j].z, v[j].w) << 32);
        if (F.lane == 0) rs1[m] = rs;
        if (F.lane < 4) {
            float bl = 0.f, al = 0.f;
#pragma unroll
            for (int c = 0; c < 4; ++c) { bl = (F.lane == c) ? d8[c] : bl; al = (F.lane == c) ? d8[4 + c] : al; }
            bl *= rs; al *= rs;
            betaA[(size_t)m * 4 + F.lane] = 1.f / (1.f + expf(-bl));
            const float z = al + dt_bias[F.lane]; const float sp = z > 20.f ? z : log1pf(expf(z));
            gA[(size_t)m * 4 + F.lane] = -expf(a_log[F.lane]) * sp;
        }
    }
}

__device__ __forceinline__ void phase_mix(Frame& F) {
    const bf16* proj = (const bf16*)(F.ws + WS_PROJ); bf16* mixed = (bf16*)(F.ws + WS_CONCAT) + 512;
    const int gw = F.vcu * NWAVES + F.wave, NGW = F.G * NWAVES;
    const int ch = 8 * F.lane, gi = F.lane >> 4, win = 2 << gi, hal = win - 1;
    for (int rbk = gw; rbk < NTOK / 16; rbk += NGW) {
        const int m0 = rbk * 16, t0 = m0 % SEQ;
        v4u X[31];
#pragma unroll
        for (int k = 0; k < 31; ++k) { X[k] = (v4u){0u, 0u, 0u, 0u}; if (k >= 15 - hal && t0 - 15 + k >= 0) X[k] = *(const v4u*)(proj + (size_t)(m0 - 15 + k) * NPROJ + 2048 + ch); }
        float s[8];
#pragma unroll
        for (int q = 0; q < 8; ++q) s[q] = 0.f;
#pragma unroll
        for (int k = 0; k < 15; ++k) { s[0] += bflo(X[k].x); s[1] += bfhi(X[k].x); s[2] += bflo(X[k].y); s[3] += bfhi(X[k].y); s[4] += bflo(X[k].z); s[5] += bfhi(X[k].z); s[6] += bflo(X[k].w); s[7] += bfhi(X[k].w); }
#pragma unroll
        for (int r = 0; r < 16; ++r) {
            const v4u u = X[15 + r];
            const float p[8] = {bflo(u.x), bfhi(u.x), bflo(u.y), bfhi(u.y), bflo(u.z), bfhi(u.z), bflo(u.w), bfhi(u.w)};
#pragma unroll
            for (int q = 0; q < 8; ++q) s[q] += p[q];
            const int tt = t0 + r + 1; const float ic = 1.f / (float)(tt < win ? tt : win);
            v4u o; o.x = pk2(s[0] * ic - p[0], s[1] * ic - p[1]); o.y = pk2(s[2] * ic - p[2], s[3] * ic - p[3]); o.z = pk2(s[4] * ic - p[4], s[5] * ic - p[5]); o.w = pk2(s[6] * ic - p[6], s[7] * ic - p[7]);
            *(v4u*)(mixed + (size_t)(m0 + r) * DM + ch) = o;
            const v4u od = gi == 0 ? X[14 + r] : gi == 1 ? X[12 + r] : gi == 2 ? X[8 + r] : X[r];
            s[0] -= bflo(od.x); s[1] -= bfhi(od.x); s[2] -= bflo(od.y); s[3] -= bfhi(od.y); s[4] -= bflo(od.z); s[5] -= bfhi(od.z); s[6] -= bflo(od.w); s[7] -= bfhi(od.w);
        }
    }
}

typedef float f32x16 __attribute__((ext_vector_type(16)));
__device__ __forceinline__ bf16x8 pack8(const f32x4 a, const f32x4 b) {
    v4u w; w.x = cvt_pk_bf16(a[0], a[1]); w.y = cvt_pk_bf16(a[2], a[3]); w.z = cvt_pk_bf16(b[0], b[1]); w.w = cvt_pk_bf16(b[2], b[3]);
    return __builtin_bit_cast(bf16x8, w);
}
__device__ __forceinline__ void fmac_(float& acc, float a, float b) { asm("v_fmac_f32 %0, %1, %2" : "+v"(acc) : "v"(a), "v"(b)); }
__device__ __forceinline__ float bf2f(unsigned short u) { return __builtin_bit_cast(float, (unsigned)u << 16); }

constexpr int SOLVE_D = 5;
struct RQ { int i, j; };
__host__ __device__ constexpr int solve_nq(int i) { return (i + 3) / 4; }
__host__ __device__ constexpr RQ solve_adv(int i, int j, int d) { while (d-- > 0 && i < 64) { if (j + 1 < solve_nq(i)) ++j; else { ++i; j = 0; } } return RQ{i, j}; }
template <int I, int J> __device__ __forceinline__ void solve_step(float (&U)[64], const LAS float* Am, const f32x4 (&win)[SOLVE_D], float s0, float s1, float s2, float s3) {
    if constexpr (I < 64) {
        constexpr RQ P = solve_adv(I, J, SOLVE_D);
        f32x4 nw = (f32x4){0.f, 0.f, 0.f, 0.f};
        if constexpr (P.i < 64) nw = *(const LAS f32x4*)(Am + P.i * 64 + 4 * P.j);
        const f32x4 a = win[0];
        fmac_(s0, a.x, U[4 * J]); if constexpr (4 * J + 1 < I) fmac_(s1, a.y, U[4 * J + 1]); if constexpr (4 * J + 2 < I) fmac_(s2, a.z, U[4 * J + 2]); if constexpr (4 * J + 3 < I) fmac_(s3, a.w, U[4 * J + 3]);
        f32x4 nx[SOLVE_D];
#pragma unroll
        for (int q = 0; q + 1 < SOLVE_D; ++q) nx[q] = win[q + 1];
        nx[SOLVE_D - 1] = nw;
        __builtin_amdgcn_sched_barrier(0);
        if constexpr (J + 1 < solve_nq(I)) solve_step<I, J + 1>(U, Am, nx, s0, s1, s2, s3);
        else { U[I] -= (s0 + s1) + (s2 + s3); solve_step<I + 1, 0>(U, Am, nx, 0.f, 0.f, 0.f, 0.f); }
    }
}
__device__ __forceinline__ void solve_all(float (&U)[64], const LAS float* Am) {
    f32x4 win[SOLVE_D];
#pragma unroll
    for (int q = 0; q < SOLVE_D; ++q) { constexpr RQ dummy{0, 0}; (void)dummy; }
    { constexpr RQ p0 = solve_adv(1, 0, 0), p1 = solve_adv(1, 0, 1), p2 = solve_adv(1, 0, 2), p3 = solve_adv(1, 0, 3), p4 = solve_adv(1, 0, 4);
      win[0] = *(const LAS f32x4*)(Am + p0.i * 64 + 4 * p0.j); win[1] = *(const LAS f32x4*)(Am + p1.i * 64 + 4 * p1.j); win[2] = *(const LAS f32x4*)(Am + p2.i * 64 + 4 * p2.j);
      win[3] = *(const LAS f32x4*)(Am + p3.i * 64 + 4 * p3.j); win[4] = *(const LAS f32x4*)(Am + p4.i * 64 + 4 * p4.j); }
    static_assert(SOLVE_D == 5, "window priming is written for SOLVE_D = 5");
    solve_step<1, 0>(U, Am, win, 0.f, 0.f, 0.f, 0.f);
}

constexpr int CP_QN = 0, CP_KN = 17408, CP_VA = 34816, CP_QKL = 51200, CP_SC = 59392, CP_HALF = 60416, CP_CW = 2 * CP_HALF;
__device__ __forceinline__ void phase_chunk(Frame& F, int blk0, int nblk, int n_lo, int n_cnt) {
    const float* conv_w = F.in[3];
    const bf16* proj = (const bf16*)(F.ws + WS_PROJ);
    const float* betaA = (const float*)(F.ws + WS_BETA); const float* gA = (const float*)(F.ws + WS_G);
    float* gtotA = (float*)(F.ws + WS_GTOT);
    const int half = F.wave >> 2, hw = F.wave & 3;
    LAS unsigned char* L = F.lds + half * CP_HALF;
    LAS bf16* qn = (LAS bf16*)(L + CP_QN); LAS bf16* kn = (LAS bf16*)(L + CP_KN); LAS bf16* vn = (LAS bf16*)(L + CP_VA);
    LAS float* Am = (LAS float*)(L + CP_VA); LAS bf16* qkL = (LAS bf16*)(L + CP_QKL); LAS float* sc = (LAS float*)(L + CP_SC);
    LAS float* cwL = (LAS float*)(F.lds + CP_CW);
    for (int idx = F.tid; idx < 4 * 1536 / 4; idx += 512) *(LAS f32x4*)(cwL + 4 * idx) = *(const f32x4*)(conv_w + 4 * idx);
    __syncthreads();
    const int nunits = NB * NH * n_cnt, nrounds = (nunits + 2 * nblk - 1) / (2 * nblk);
#pragma unroll 1
    for (int it = 0; it < nrounds; ++it) {
        int tid_ = F.tid; asm volatile("" : "+v"(tid_));
        const int ht = tid_ & 255, lane = tid_ & 63, r16 = lane & 15, gq = lane >> 4;
        int v_ = (it * nblk + ((int)blockIdx.x - blk0)) * 2 + half; asm volatile("" : "+s"(v_));
        const bool live = v_ < nunits;
        const int bh = live ? v_ / n_cnt : 0, n = live ? n_lo + v_ % n_cnt : 0, b = bh >> 2, h = bh & 3; const int unit = bh * 64 + n;
        const size_t m0 = (size_t)b * SEQ + (size_t)n * 64;
        unsigned char* chunk = F.ws + WS_CHUNK + (size_t)unit * CH_BYTES;
        const int rq = ht >> 4, cg = ht & 15;
        v4u Xa[7], Xb[7]; float gi = 0.f, bi = 0.f;
#define CHUNK_LOADX(X, p_) do { _Pragma("unroll") for (int jj = 0; jj < 7; ++jj) { const int trow = n * 64 + 4 * rq - 3 + jj; const int trc = trow < 0 ? 0 : trow; \
            const v4u u_ = *(const v4u*)(proj + ((size_t)b * SEQ + trc) * NPROJ + (p_) * 512 + h * 128 + 8 * cg); const unsigned mk_ = trow < 0 ? 0u : 0xffffffffu; \
            X[jj] = (v4u){u_.x & mk_, u_.y & mk_, u_.z & mk_, u_.w & mk_}; } } while (0)
#define CHUNK_CONV(X, p_) do { const int col = (p_) * 512 + h * 128 + 8 * cg; float wv[4][8]; \
            _Pragma("unroll") for (int j = 0; j < 4; ++j) { const f32x4 w0 = *(const LAS f32x4*)(cwL + j * 1536 + col), w1 = *(const LAS f32x4*)(cwL + j * 1536 + col + 4); \
                wv[j][0] = w0.x; wv[j][1] = w0.y; wv[j][2] = w0.z; wv[j][3] = w0.w; wv[j][4] = w1.x; wv[j][5] = w1.y; wv[j][6] = w1.z; wv[j][7] = w1.w; } \
            _Pragma("unroll") for (int rr = 0; rr < 4; ++rr) { float y[8]; \
                _Pragma("unroll") for (int q = 0; q < 8; ++q) y[q] = 0.f; \
                _Pragma("unroll") for (int j = 0; j < 4; ++j) { const v4u u = X[rr + j]; \
                    fmac_(y[0], wv[j][0], bflo(u.x)); fmac_(y[1], wv[j][1], bfhi(u.x)); fmac_(y[2], wv[j][2], bflo(u.y)); fmac_(y[3], wv[j][3], bfhi(u.y)); \
                    fmac_(y[4], wv[j][4], bflo(u.z)); fmac_(y[5], wv[j][5], bfhi(u.z)); fmac_(y[6], wv[j][6], bflo(u.w)); fmac_(y[7], wv[j][7], bfhi(u.w)); } \
                float ss = 0.f; \
                _Pragma("unroll") for (int q = 0; q < 8; ++q) { y[q] = siluf_(y[q]); ss += y[q] * y[q]; } \
                float scl = 1.f; \
                if ((p_) < 2) { ss += __shfl_xor(ss, 1); ss += __shfl_xor(ss, 2); ss += __shfl_xor(ss, 4); ss += __shfl_xor(ss, 8); scl = frsq_(ss + 1e-6f); if ((p_) == 0) scl *= 0.08838834764831845f; } \
                v4u o; o.x = cvt_pk_bf16(y[0] * scl, y[1] * scl); o.y = cvt_pk_bf16(y[2] * scl, y[3] * scl); o.z = cvt_pk_bf16(y[4] * scl, y[5] * scl); o.w = cvt_pk_bf16(y[6] * scl, y[7] * scl); \
                const int row = 4 * rq + rr; \
                if ((p_) == 0) *(LAS v4u*)(qn + row * 136 + 8 * cg) = o; else if ((p_) == 1) *(LAS v4u*)(kn + row * 136 + 8 * cg) = o; else *(LAS v4u*)(vn + row * 128 + 8 * cg) = o; \
                __builtin_amdgcn_sched_barrier(0); } } while (0)
        if (live) { CHUNK_LOADX(Xa, 0); CHUNK_LOADX(Xb, 1); if (hw == 0) { gi = gA[(m0 + lane) * 4 + h]; bi = betaA[(m0 + lane) * 4 + h]; } }
        if (live && hw == 0) {
            float c = gi;
#pragma unroll
            for (int o = 1; o < 64; o <<= 1) { const float tt = __shfl_up(c, o); if (lane >= o) c += tt; }
            const float gl = __shfl(c, 63);
            sc[lane] = bi; sc[64 + lane] = c; sc[128 + lane] = fexp_(c); sc[192 + lane] = fexp_(gl - c);
            if (lane == 63) gtotA[unit] = fexp_(c);
        }
        if (live) { CHUNK_CONV(Xa, 0); CHUNK_LOADX(Xa, 2); CHUNK_CONV(Xb, 1); CHUNK_CONV(Xa, 2); }
#undef CHUNK_LOADX
#undef CHUNK_CONV
        __syncthreads();
        const int which = ht >> 7, c = ht & 127;
        float U[64];
        if (live) {
#pragma unroll
            for (int i = 0; i < 64; ++i) { const float bi = sc[i]; const float tv = which ? bf2f(kn[i * 136 + c]) * sc[128 + i] : bf2f(vn[i * 128 + c]); U[i] = tv * bi; }
        } else {
#pragma unroll
            for (int i = 0; i < 64; ++i) U[i] = 0.f;
        }
        __syncthreads();
        if (live) {
            const int ti = hw >> 1, tj = hw & 1, r = lane & 31, hh = lane >> 5;
            f32x16 KK, QK;
#pragma unroll
            for (int q = 0; q < 16; ++q) { KK[q] = 0.f; QK[q] = 0.f; }
#pragma unroll
            for (int ks = 0; ks < 8; ++ks) {
                const bf16x8 ak = *(const LAS bf16x8*)(kn + (ti * 32 + r) * 136 + 16 * ks + 8 * hh);
                const bf16x8 aq = *(const LAS bf16x8*)(qn + (ti * 32 + r) * 136 + 16 * ks + 8 * hh);
                const bf16x8 bb = *(const LAS bf16x8*)(kn + (tj * 32 + r) * 136 + 16 * ks + 8 * hh);
                KK = __builtin_amdgcn_mfma_f32_32x32x16_bf16(ak, bb, KK, 0, 0, 0);
                QK = __builtin_amdgcn_mfma_f32_32x32x16_bf16(aq, bb, QK, 0, 0, 0);
            }
            const int j = tj * 32 + r; const float gcj = sc[64 + j];
#pragma unroll
            for (int reg = 0; reg < 16; ++reg) { const int i = ti * 32 + (reg & 3) + 8 * (reg >> 2) + 4 * hh;
                const float dec = (i >= j) ? __expf(sc[64 + i] - gcj) : 0.f;
                Am[i * 64 + j] = (i > j) ? sc[i] * KK[reg] * dec : 0.f;
                qkL[i * 64 + j] = (bf16)f2bf((i >= j) ? QK[reg] * dec : 0.f); }
        }
        __syncthreads();
        if (live) {
#pragma unroll
            for (int fi = 0; fi < 4; ++fi) { const int f = hw * 4 + fi, mb = f >> 2, ks = f & 3, row = 16 * mb + r16; const float s = sc[128 + row];
                const v2u lo = *(const LAS v2u*)(qn + row * 136 + 32 * ks + 4 * gq), hi = *(const LAS v2u*)(qn + row * 136 + 32 * ks + 16 + 4 * gq);
                v4u o; o.x = pk2(bflo(lo.x) * s, bfhi(lo.x) * s); o.y = pk2(bflo(lo.y) * s, bfhi(lo.y) * s); o.z = pk2(bflo(hi.x) * s, bfhi(hi.x) * s); o.w = pk2(bflo(hi.y) * s, bfhi(hi.y) * s);
                *(v4u*)(chunk + CH_QD + (f * 64 + lane) * 16) = o; }
#pragma unroll
            for (int fi = 0; fi < 4; ++fi) { const int f = hw * 4 + fi, db = f >> 1, ksp = f & 1, dcol = 16 * db + r16; float e[8];
#pragma unroll
                for (int j = 0; j < 8; ++j) { const int i = 32 * ksp + 16 * (j >> 2) + 4 * gq + (j & 3); e[j] = bf2f(kn[i * 136 + dcol]) * sc[192 + i]; }
                v4u o; o.x = pk2(e[0], e[1]); o.y = pk2(e[2], e[3]); o.z = pk2(e[4], e[5]); o.w = pk2(e[6], e[7]);
                *(v4u*)(chunk + CH_KT + (f * 64 + lane) * 16) = o; }
#pragma unroll
            for (int fi = 0; fi < 2; ++fi) { const int f = hw * 2 + fi, mb = f >> 1, ksp = f & 1, row = 16 * mb + r16;
                const v2u lo = *(const LAS v2u*)(qkL + row * 64 + 32 * ksp + 4 * gq), hi = *(const LAS v2u*)(qkL + row * 64 + 32 * ksp + 16 + 4 * gq);
                *(v4u*)(chunk + CH_QK + (f * 64 + lane) * 16) = (v4u){lo.x, lo.y, hi.x, hi.y}; }
            solve_all(U, Am);
        }
        __syncthreads();
        if (live) {
            if (which == 0) {
                const int w8 = c >> 4, cl = c & 15;
                unsigned char* ub = F.ws + WS_UC + (size_t)unit * UC_BYTES;
#pragma unroll
                for (int g = 0; g < 4; ++g) {
                    v4u lo, hi;
                    lo.x = pk2(U[4 * g], U[4 * g + 1]); lo.y = pk2(U[4 * g + 2], U[4 * g + 3]); lo.z = pk2(U[16 + 4 * g], U[16 + 4 * g + 1]); lo.w = pk2(U[16 + 4 * g + 2], U[16 + 4 * g + 3]);
                    hi.x = pk2(U[32 + 4 * g], U[32 + 4 * g + 1]); hi.y = pk2(U[32 + 4 * g + 2], U[32 + 4 * g + 3]); hi.z = pk2(U[48 + 4 * g], U[48 + 4 * g + 1]); hi.w = pk2(U[48 + 4 * g + 2], U[48 + 4 * g + 3]);
                    v4u* dst = (v4u*)(ub + ((w8 * 64 + g * 16 + cl) * 32)); dst[0] = lo; dst[1] = hi;
                }
            } else {
#pragma unroll
                for (int i = 0; i < 64; ++i) qn[i * 136 + c] = (bf16)f2bf(U[i]);
            }
        }
        __syncthreads();
        if (live) {
#pragma unroll
            for (int fi = 0; fi < 4; ++fi) { const int f = hw * 4 + fi, mb = f >> 2, ks = f & 3, row = 16 * mb + r16;
                const v2u lo = *(const LAS v2u*)(qn + row * 136 + 32 * ks + 4 * gq), hi = *(const LAS v2u*)(qn + row * 136 + 32 * ks + 16 + 4 * gq);
                *(v4u*)(chunk + CH_WF + (f * 64 + lane) * 16) = (v4u){lo.x, lo.y, hi.x, hi.y}; }
        }
        __syncthreads();
    }
}

constexpr int SCAN_SPLIT = 32;
constexpr int SC_STAGED = 49152, SC_NLOAD = 16;
struct ScanU { v4u u0, u1; };
struct ScanQ { v4u q[8]; };
__device__ __forceinline__ void scan_issue_u(ScanU& R, const unsigned char* up) {
    asm volatile("global_load_dwordx4 %0, %1, off" : "=v"(R.u0) : "v"(up) : "memory");
    asm volatile("global_load_dwordx4 %0, %1, off offset:16" : "=v"(R.u1) : "v"(up) : "memory");
}
__device__ __forceinline__ void scan_issue_q(ScanQ& R, const unsigned char* qp) {
    asm volatile("global_load_dwordx4 %0, %1, off" : "=v"(R.q[0]) : "v"(qp) : "memory");
    asm volatile("global_load_dwordx4 %0, %1, off offset:1024" : "=v"(R.q[1]) : "v"(qp) : "memory");
    asm volatile("global_load_dwordx4 %0, %1, off offset:2048" : "=v"(R.q[2]) : "v"(qp) : "memory");
    asm volatile("global_load_dwordx4 %0, %1, off offset:3072" : "=v"(R.q[3]) : "v"(qp) : "memory");
    const unsigned char* qp2 = qp + 4096;
    asm volatile("global_load_dwordx4 %0, %1, off" : "=v"(R.q[4]) : "v"(qp2) : "memory");
    asm volatile("global_load_dwordx4 %0, %1, off offset:1024" : "=v"(R.q[5]) : "v"(qp2) : "memory");
    asm volatile("global_load_dwordx4 %0, %1, off offset:2048" : "=v"(R.q[6]) : "v"(qp2) : "memory");
    asm volatile("global_load_dwordx4 %0, %1, off offset:3072" : "=v"(R.q[7]) : "v"(qp2) : "memory");
}
#define SCAN_WAIT_REGS(U, Q, cnt) asm volatile("s_waitcnt vmcnt(" #cnt ")" : "+v"(U.u0), "+v"(U.u1), "+v"(Q.q[0]), "+v"(Q.q[1]), "+v"(Q.q[2]), "+v"(Q.q[3]), "+v"(Q.q[4]), "+v"(Q.q[5]), "+v"(Q.q[6]), "+v"(Q.q[7]) :: "memory")
template <class Bar> __device__ __forceinline__ void phase_scan(Frame& F, const Bar& mid_barrier) {
    const int bh = blockIdx.x, b = bh >> 2, h = bh & 3, w = F.wave, lane = F.lane, cl = lane & 15, gq = lane >> 4;
    const float* gtotA = (const float*)(F.ws + WS_GTOT);
    const int unit0 = bh * 64;
    const unsigned char* cbase = F.ws + WS_CHUNK + (size_t)unit0 * CH_BYTES;
    const unsigned char* ubase = F.ws + WS_UC + (size_t)unit0 * UC_BYTES + (w * 64 + lane) * 32;
    const unsigned char* qbase = cbase + CH_QK + lane * 16;
    bf16* op = (bf16*)(F.ws + WS_ORAW) + ((size_t)b * SEQ + cl) * 512 + h * 128 + 16 * w + 4 * gq;
    f32x4 Sacc[8]; bf16x8 Sb[4];
#pragma unroll
    for (int d = 0; d < 8; ++d) Sacc[d] = (f32x4){0.f, 0.f, 0.f, 0.f};
#pragma unroll
    for (int k = 0; k < 4; ++k) Sb[k] = (bf16x8){0, 0, 0, 0, 0, 0, 0, 0};
    v2u Ow[4];
#pragma unroll
    for (int mb = 0; mb < 4; ++mb) Ow[mb] = (v2u){0u, 0u};
    ScanU U0, U1, U2; ScanQ QA, QB;
#define SCAN_ISSUE(nn) do { const unsigned char* s_ = cbase + (size_t)(nn) * CH_BYTES + (w * 6) * 1024 + lane * 16; LAS unsigned char* d_ = F.lds + ((nn) % 3) * SC_STAGED + (w * 6) * 1024; \
        _Pragma("unroll") for (int k_ = 0; k_ < 6; ++k_) __builtin_amdgcn_global_load_lds((const unsigned*)(s_ + k_ * 1024), (LAS unsigned*)(d_ + k_ * 1024), 16, 0, 0); } while (0)
#define SCAN_STEP(n, UC, UN, Q, ISSUE2, WAITCNT) do { \
        SCAN_WAIT_REGS(UC, Q, WAITCNT); asm volatile("s_waitcnt lgkmcnt(0)" ::: "memory"); __builtin_amdgcn_s_barrier(); asm volatile("" ::: "memory"); \
        const float gt = __shfl(gtv, (n) & 31); \
        if (ISSUE2) { scan_issue_u(UN, ubase + (size_t)((n) + 2) * UC_BYTES); SCAN_ISSUE((n) + 2); } \
        if ((n) > 0) { _Pragma("unroll") for (int mb = 0; mb < 4; ++mb) *(v2u*)(op + (size_t)(((n) - 1) * 64 + 16 * mb) * 512) = Ow[mb]; } \
        const LAS unsigned char* B = F.lds + ((n) % 3) * SC_STAGED; \
        f32x4 P[4]; \
        _Pragma("unroll") for (int mb = 0; mb < 4; ++mb) { P[mb] = (f32x4){0.f, 0.f, 0.f, 0.f}; \
            _Pragma("unroll") for (int ks = 0; ks < 4; ++ks) P[mb] = __builtin_amdgcn_mfma_f32_16x16x32_bf16(SFRAG(CH_WF, mb * 4 + ks), Sb[ks], P[mb], 0, 0, 0); } \
        f32x4 vnw[4]; \
        vnw[0] = (f32x4){bflo(UC.u0.x), bfhi(UC.u0.x), bflo(UC.u0.y), bfhi(UC.u0.y)} - P[0]; \
        vnw[1] = (f32x4){bflo(UC.u0.z), bfhi(UC.u0.z), bflo(UC.u0.w), bfhi(UC.u0.w)} - P[1]; \
        vnw[2] = (f32x4){bflo(UC.u1.x), bfhi(UC.u1.x), bflo(UC.u1.y), bfhi(UC.u1.y)} - P[2]; \
        vnw[3] = (f32x4){bflo(UC.u1.z), bfhi(UC.u1.z), bflo(UC.u1.w), bfhi(UC.u1.w)} - P[3]; \
        bf16x8 Vb[2]; Vb[0] = pack8(vnw[0], vnw[1]); Vb[1] = pack8(vnw[2], vnw[3]); \
        _Pragma("unroll") for (int mb = 0; mb < 4; ++mb) { f32x4 OT = (f32x4){0.f, 0.f, 0.f, 0.f}; \
            _Pragma("unroll") for (int ks = 0; ks < 4; ++ks) OT = __builtin_amdgcn_mfma_f32_16x16x32_bf16(Sb[ks], SFRAG(CH_QD, mb * 4 + ks), OT, 0, 0, 0); \
            _Pragma("unroll") for (int ksp = 0; ksp < 2; ++ksp) OT = __builtin_amdgcn_mfma_f32_16x16x32_bf16(Vb[ksp], __builtin_bit_cast(bf16x8, Q.q[mb * 2 + ksp]), OT, 0, 0, 0); \
            Ow[mb] = (v2u){cvt_pk_bf16(OT[0], OT[1]), cvt_pk_bf16(OT[2], OT[3])}; } \
        asm volatile("s_nop 7" : "+v"(Q.q[0]), "+v"(Q.q[1]), "+v"(Q.q[2]), "+v"(Q.q[3]), "+v"(Q.q[4]), "+v"(Q.q[5]), "+v"(Q.q[6]), "+v"(Q.q[7]));     \
        if (ISSUE2) scan_issue_q(Q, qbase + (size_t)((n) + 2) * CH_BYTES); \
        _Pragma("unroll") for (int db = 0; db < 8; ++db) { Sacc[db] = Sacc[db] * gt; \
            _Pragma("unroll") for (int ksp = 0; ksp < 2; ++ksp) Sacc[db] = __builtin_amdgcn_mfma_f32_16x16x32_bf16(SFRAG(CH_KT, db * 2 + ksp), Vb[ksp], Sacc[db], 0, 0, 0); } \
        _Pragma("unroll") for (int ks = 0; ks < 4; ++ks) Sb[ks] = pack8(Sacc[2 * ks], Sacc[2 * ks + 1]); \
    } while (0)
#define SFRAG(off, f) (*(const LAS bf16x8*)(B + (off) + ((f) * 64 + lane) * 16))
    static_assert(CH_WF == 0 && CH_QD == 16384 && CH_KT == 32768 && CH_QK == SC_STAGED && SCAN_SPLIT % 6 == 2 && 2 * SCAN_SPLIT == 64, "staged part = the first 48 KiB of a chunk; a half = 5 x 6 + 2 steps");
#pragma unroll 1
    for (int part = 0; part < 2; ++part) {
        const int n0 = part * SCAN_SPLIT;
        float gtv = gtotA[unit0 + n0 + (lane & 31)];
        asm volatile("s_waitcnt vmcnt(0)" : "+v"(gtv) :: "memory");
        scan_issue_u(U0, ubase + (size_t)n0 * UC_BYTES); SCAN_ISSUE(n0); scan_issue_q(QA, qbase + (size_t)n0 * CH_BYTES);
        scan_issue_u(U1, ubase + (size_t)(n0 + 1) * UC_BYTES); SCAN_ISSUE(n0 + 1); scan_issue_q(QB, qbase + (size_t)(n0 + 1) * CH_BYTES);
#pragma unroll 1
        for (int n = n0; n < n0 + SCAN_SPLIT - 2; n += 6) {
            SCAN_STEP(n, U0, U2, QA, true, 16);
            SCAN_STEP(n + 1, U1, U0, QB, true, 16);
            SCAN_STEP(n + 2, U2, U1, QA, true, 16);
            SCAN_STEP(n + 3, U0, U2, QB, true, 16);
            SCAN_STEP(n + 4, U1, U0, QA, true, 16);
            SCAN_STEP(n + 5, U2, U1, QB, true, 16);
        }
        SCAN_STEP(n0 + SCAN_SPLIT - 2, U0, U2, QA, false, 16);
        SCAN_STEP(n0 + SCAN_SPLIT - 1, U1, U0, QB, false, 0);
        if (part == 0) mid_barrier();
    }
#undef SFRAG
#undef SCAN_STEP
#undef SCAN_ISSUE
#pragma unroll
    for (int mb = 0; mb < 4; ++mb) *(v2u*)(op + (size_t)(63 * 64 + 16 * mb) * 512) = Ow[mb];
    VM_WAIT(); __syncthreads();
}

__device__ __forceinline__ void phase_onorm(Frame& F) {
    const float* dnw = F.in[6]; const bf16* proj = (const bf16*)(F.ws + WS_PROJ); const bf16* oraw = (const bf16*)(F.ws + WS_ORAW); bf16* concat = (bf16*)(F.ws + WS_CONCAT);
    const int gw = F.vcu * NWAVES + F.wave, NGW = F.G * NWAVES, lane = F.lane;
    const int cc = 8 * (lane & 15);
    const f32x4 d0 = *(const f32x4*)(dnw + cc), d1 = *(const f32x4*)(dnw + cc + 4);
    for (int m = gw; m < NTOK; m += NGW) {
        const v4u o = *(const v4u*)(oraw + (size_t)m * 512 + 8 * lane);
        const v4u z = *(const v4u*)(proj + (size_t)m * NPROJ + 1536 + 8 * lane);
        const float ov[8] = {bflo(o.x), bfhi(o.x), bflo(o.y), bfhi(o.y), bflo(o.z), bfhi(o.z), bflo(o.w), bfhi(o.w)};
        const float zv[8] = {bflo(z.x), bfhi(z.x), bflo(z.y), bfhi(z.y), bflo(z.z), bfhi(z.z), bflo(z.w), bfhi(z.w)};
        float ss = 0.f;
#pragma unroll
        for (int q = 0; q < 8; ++q) ss += ov[q] * ov[q];
        ss += __shfl_xor(ss, 1); ss += __shfl_xor(ss, 2); ss += __shfl_xor(ss, 4); ss += __shfl_xor(ss, 8);
        const float rs = frsq_(ss * (1.f / 128.f) + 1e-6f);
        const float dv[8] = {d0.x, d0.y, d0.z, d0.w, d1.x, d1.y, d1.z, d1.w};
        float r[8];
#pragma unroll
        for (int q = 0; q < 8; ++q) r[q] = ov[q] * rs * dv[q] * siluf_(zv[q]);
        *(v4u*)(concat + (size_t)m * DM + 8 * lane) = (v4u){cvt_pk_bf16(r[0], r[1]), cvt_pk_bf16(r[2], r[3]), cvt_pk_bf16(r[4], r[5]), cvt_pk_bf16(r[6], r[7])};
    }
}

__device__ __forceinline__ void phase_route(Frame& F) {
    const bf16* x1 = (const bf16*)(F.ws + WS_X1); const float* b_router = F.in[12];
    unsigned char* x1b = F.ws + WS_X1B; float* rs2A = (float*)(F.ws + WS_RS2); int* list = (int*)(F.ws + WS_LIST);
    float* rsl = (float*)(F.ws + WS_RSL); float* gwl = (float*)(F.ws + WS_GWL);
    unsigned* cntw = (unsigned*)(F.ws + WS_CTL) + CW_CNT;
    LAS unsigned char* WI = F.lds;
    LAS unsigned* lcnt = (LAS unsigned*)(F.lds + TAB_OFF);
    { const v4u* src = (const v4u*)(F.ws + WS_WR);
      for (int idx = F.tid; idx < 131072 / 16; idx += 512) *(LAS v4u*)(WI + 16 * idx) = src[idx]; }
    const int lane = F.lane, c = lane & 15, g = lane >> 4;
    const int gw = F.vcu * NWAVES + F.wave, NGW = F.G * NWAVES, NT = NTOK / 16;
    const float bia0 = b_router[c], bia1 = b_router[16 + c];
    for (int t0 = 0; t0 < NT; t0 += NGW) {
        const int tile = t0 + gw; const bool live = tile < NT;
        if (F.tid < 64) lcnt[F.tid] = 0u;
        __syncthreads();
        int my_e = 0; float my_g = 0.f, my_rs = 0.f; unsigned my_rank = 0u; int my_ent = 0;
        if (live) {
            const int m0 = tile * 16;
            const bf16* xrow = x1 + (size_t)(m0 + c) * DM + 8 * g;
            unsigned char* xbrow = x1b + (size_t)(m0 + c) * DM + 8 * g;
            f32x4 acc0 = (f32x4){0.f, 0.f, 0.f, 0.f}, acc1 = acc0; float ssq = 0.f;
#pragma unroll 1
            for (int kb = 0; kb < 2; ++kb) {
                v4u xa[16];
#pragma unroll
                for (int q = 0; q < 16; ++q) xa[q] = *(const v4u*)(xrow + 32 * (kb * 16 + q));
#pragma unroll
                for (int q = 0; q < 16; ++q) { const int ks = kb * 16 + q; const v4u h = xa[q];
                    const float a0 = bflo(h.x), a1 = bfhi(h.x), a2 = bflo(h.y), a3 = bfhi(h.y), b0 = bflo(h.z), b1 = bfhi(h.z), b2 = bflo(h.w), b3 = bfhi(h.w);
                    ssq += (a0 * a0 + a1 * a1) + (a2 * a2 + a3 * a3) + (b0 * b0 + b1 * b1) + (b2 * b2 + b3 * b3);
                    *(v2u*)(xbrow + 32 * ks) = (v2u){pk4_fp8(a0, a1, a2, a3), pk4_fp8(b0, b1, b2, b3)};
                    const bf16x8 ah = __builtin_bit_cast(bf16x8, h);
                    const LAS unsigned char* fb = WI + (size_t)(ks * 4) * 1024 + lane * 16;
                    const bf16x8 b0h = *(const LAS bf16x8*)(fb), b0l = *(const LAS bf16x8*)(fb + 1024), b1h = *(const LAS bf16x8*)(fb + 2048), b1l = *(const LAS bf16x8*)(fb + 3072);
                    acc0 = __builtin_amdgcn_mfma_f32_16x16x32_bf16(ah, b0h, acc0, 0, 0, 0); acc0 = __builtin_amdgcn_mfma_f32_16x16x32_bf16(ah, b0l, acc0, 0, 0, 0);
                    acc1 = __builtin_amdgcn_mfma_f32_16x16x32_bf16(ah, b1h, acc1, 0, 0, 0); acc1 = __builtin_amdgcn_mfma_f32_16x16x32_bf16(ah, b1l, acc1, 0, 0, 0); }
            }
            ssq += __shfl_xor(ssq, 16); ssq += __shfl_xor(ssq, 32);
            const float rsr = frsq_(ssq * (1.f / DM) + 1e-6f);
            if (g == 0) rs2A[m0 + c] = rsr;
            float ge_[4]; int ee_[4];
#pragma unroll
            for (int reg = 0; reg < 4; ++reg) {
                const float rsw = __shfl(rsr, 4 * g + reg);
                float v0 = acc0[reg] * rsw + bia0, v1 = acc1[reg] * rsw + bia1;
                float tv[4]; int te[4];
#pragma unroll
                for (int s = 0; s < 4; ++s) {
                    float bv; int bi; if (v1 > v0) { bv = v1; bi = 16 + c; } else { bv = v0; bi = c; }
#pragma unroll
                    for (int o = 1; o < 16; o <<= 1) { const float ov = __shfl_xor(bv, o); const int oi = __shfl_xor(bi, o); if (ov > bv || (ov == bv && oi < bi)) { bv = ov; bi = oi; } }
                    tv[s] = bv; te[s] = bi; if (bi == c) v0 = -3.0e38f; if (bi == 16 + c) v1 = -3.0e38f;
                }
                const float e1 = fexp_(tv[1] - tv[0]), e2 = fexp_(tv[2] - tv[0]), e3 = fexp_(tv[3] - tv[0]); const float inv = frcp_(1.f + e1 + e2 + e3);
                const int s_ = c & 3; const float gsel = (s_ == 0 ? 1.f : s_ == 1 ? e1 : s_ == 2 ? e2 : e3) * inv; const int esel = s_ == 0 ? te[0] : s_ == 1 ? te[1] : s_ == 2 ? te[2] : te[3];
                ge_[reg] = gsel; ee_[reg] = esel;
            }
            const int rsel = c >> 2;
            my_g = rsel == 0 ? ge_[0] : rsel == 1 ? ge_[1] : rsel == 2 ? ge_[2] : ge_[3];
            my_e = rsel == 0 ? ee_[0] : rsel == 1 ? ee_[1] : rsel == 2 ? ee_[2] : ee_[3];
            my_ent = (m0 + 4 * g + rsel) * 4 + (c & 3);
            my_rs = __shfl(rsr, 4 * g + rsel);
            my_rank = __hip_atomic_fetch_add(lcnt + my_e, 1u, __ATOMIC_RELAXED, __HIP_MEMORY_SCOPE_WORKGROUP);
        }
        __syncthreads();
        if (F.tid < NE) { const unsigned n = lcnt[F.tid]; lcnt[32 + F.tid] = n ? __hip_atomic_fetch_add(cntw + 64 * F.tid, n, RLX_AGENT) : 0u; }
        __syncthreads();
        if (live) { const size_t pos = (size_t)my_e * LISTCAP + lcnt[32 + my_e] + my_rank; list[pos] = my_ent; rsl[pos] = my_rs; gwl[pos] = my_g; }
        __syncthreads();
    }
}

__device__ __forceinline__ int moe_tables(Frame& F, MoeTab& T) {
    LAS int* pref = (LAS int*)(F.lds + TAB_OFF); LAS int* cnt = pref + 40;
    unsigned* cntw = (unsigned*)(F.ws + WS_CTL) + CW_CNT;
    if (F.tid == 0) { int acc = 0; for (int e = 0; e < NE; ++e) { const int c = (int)__hip_atomic_load(cntw + 64 * e, RLX_AGENT); cnt[e] = c; pref[e] = acc; acc += (c + 255) >> 8; } pref[NE] = acc; }
    __syncthreads();
    T.pref = pref; T.cnt = cnt;
    return pref[NE];
}

struct FinalRow { f32x4 v[4]; v2u sl[4][2]; };
__device__ __forceinline__ void final_load(FinalRow& R, const bf16* xrow, const unsigned char* srow) {
#pragma unroll
    for (int j = 0; j < 2; ++j) { const v4u h = *(const v4u*)(xrow + 512 * j);
        R.v[2 * j] = (f32x4){bflo(h.x), bfhi(h.x), bflo(h.y), bfhi(h.y)}; R.v[2 * j + 1] = (f32x4){bflo(h.z), bfhi(h.z), bflo(h.w), bfhi(h.w)}; }
#pragma unroll
    for (int s = 0; s < 4; ++s)
#pragma unroll
        for (int j = 0; j < 2; ++j) R.sl[s][j] = *(const v2u*)(srow + (size_t)s * DM + 512 * j);
}
__device__ __forceinline__ void final_finish(FinalRow& R, float* orow, const f32x4 (&wv)[4]) {
#pragma unroll
    for (int s = 0; s < 4; ++s)
#pragma unroll
        for (int j = 0; j < 2; ++j) { const v2u u = R.sl[s][j];
            const f32x2_t a0 = __builtin_amdgcn_cvt_pk_f32_fp8((int)u.x, false), a1 = __builtin_amdgcn_cvt_pk_f32_fp8((int)u.x, true), b0 = __builtin_amdgcn_cvt_pk_f32_fp8((int)u.y, false), b1 = __builtin_amdgcn_cvt_pk_f32_fp8((int)u.y, true);
            R.v[2 * j].x += a0.x * SLAB_INV; R.v[2 * j].y += a0.y * SLAB_INV; R.v[2 * j].z += a1.x * SLAB_INV; R.v[2 * j].w += a1.y * SLAB_INV;
            R.v[2 * j + 1].x += b0.x * SLAB_INV; R.v[2 * j + 1].y += b0.y * SLAB_INV; R.v[2 * j + 1].z += b1.x * SLAB_INV; R.v[2 * j + 1].w += b1.y * SLAB_INV; }
    float ss = 0.f;
#pragma unroll
    for (int j = 0; j < 4; ++j) ss += (R.v[j].x * R.v[j].x + R.v[j].y * R.v[j].y) + (R.v[j].z * R.v[j].z + R.v[j].w * R.v[j].w);
    ss = wave_sum(ss);
    const float rs = frsq_(ss * (1.f / DM) + 1e-6f);
#pragma unroll
    for (int j = 0; j < 2; ++j) { *(f32x4*)(orow + 512 * j) = R.v[2 * j] * rs * wv[2 * j]; *(f32x4*)(orow + 512 * j + 4) = R.v[2 * j + 1] * rs * wv[2 * j + 1]; }
}
__device__ __forceinline__ void phase_final(Frame& F, int dryrun) {
    const float* fw = F.in[17]; const unsigned char* slab = F.ws + WS_SLAB; float* out = F.out;
    const bf16* x1 = (const bf16*)(F.ws + WS_X1); (void)dryrun;
    const int gw = F.vcu * NWAVES + F.wave, NGW = F.G * NWAVES, lane = F.lane;
    f32x4 wv[4];
#pragma unroll
    for (int j = 0; j < 2; ++j) { wv[2 * j] = *(const f32x4*)(fw + 512 * j + 8 * lane); wv[2 * j + 1] = *(const f32x4*)(fw + 512 * j + 8 * lane + 4); }
    FinalRow A, B;
    int m = gw;
    if (m < NTOK) final_load(A, x1 + (size_t)m * DM + 8 * lane, slab + (size_t)m * 4 * DM + 8 * lane);
    for (; m < NTOK; m += 2 * NGW) {
        const int m1 = m + NGW, m2 = m + 2 * NGW;
        if (m1 < NTOK) final_load(B, x1 + (size_t)m1 * DM + 8 * lane, slab + (size_t)m1 * 4 * DM + 8 * lane);
        final_finish(A, out + (size_t)m * DM + 8 * lane, wv);
        if (m2 < NTOK) final_load(A, x1 + (size_t)m2 * DM + 8 * lane, slab + (size_t)m2 * 4 * DM + 8 * lane);
        if (m1 < NTOK) final_finish(B, out + (size_t)m1 * DM + 8 * lane, wv);
    }
}

struct Args { const float* in[18]; float* out; unsigned char* ws; int ph_lo, ph_hi, flag, breg; };
constexpr int NPHASE = 11;

__global__ void __launch_bounds__(NWAVES * 64, 2) mk_fwd(Args args) {
    extern __shared__ __attribute__((aligned(16))) unsigned char lds_raw[];
    Frame F;
    F.lds = (LAS unsigned char*)lds_raw;
    F.tid = threadIdx.x; F.lane = F.tid & 63; F.wave = __builtin_amdgcn_readfirstlane(F.tid >> 6);
    F.G = gridDim.x; { const int bx = blockIdx.x; F.vcu = (F.G % 8 == 0) ? (bx % 8) * (F.G / 8) + bx / 8 : bx; }
#pragma unroll
    for (int i = 0; i < 18; ++i) F.in[i] = args.in[i];
    F.out = args.out; F.ws = args.ws;
    volatile LAS unsigned* MISC = (volatile LAS unsigned*)(F.lds + MISC_OFF);
    for (int u = F.tid; u < (LDS_BYTES - LDSCTL_OFF) / 4; u += NWAVES * 64) ((LAS unsigned*)(F.lds + LDSCTL_OFF))[u] = 0u;
    __syncthreads();
    unsigned* ctl = (unsigned*)(F.ws + WS_CTL);
#if !MK_PER_PHASE
    XcdBarrier bar = xcd_barrier_post(ctl + CW_BAR, MISC + 8);
#define GRID_BAR() xcd_barrier(bar)
#else
#define GRID_BAR() do {} while (0)
#endif
    const int lo = args.ph_lo, hi = args.ph_hi;
#define IN(k) (lo <= (k) && (k) < hi)
#define SEAM(k) do { if (IN(k) && IN((k) + 1)) GRID_BAR(); } while (0)

#define RUNPH(k, ...) do { if (IN(k)) { __VA_ARGS__; } SEAM(k); } while (0)
    RUNPH(0, phase_prep(F));
    RUNPH(1, {
        ProbIn P; P.K = DM; P.RB = 2 * DM; P.S.init(NTOK / 256, NPROJ / 256, F.G, (int)blockIdx.x);
        P.A = (const bf16*)(F.ws + WS_XB); P.Bt = (const bf16*)(F.ws + WS_WIN); P.O = (bf16*)(F.ws + WS_PROJ); P.rs = (const float*)(F.ws + WS_RS1);
        pg8::gemm_phase(F.lds, P); });
    if (IN(2)) { phase_mix(F); __syncthreads(); }
    RUNPH(3, phase_chunk(F, 0, F.G, 0, SCAN_SPLIT));
    RUNPH(4, {
        const int nscan = NB * NH;
        unsigned* seam = ctl + CW_SEAM4 + 64 * args.breg;
        auto scan_wait = [&]() {
            asm volatile("s_waitcnt vmcnt(0)" ::: "memory"); __syncthreads();
            if (F.tid == 0) { const unsigned want = (unsigned)(F.G - nscan); unsigned sp = 0u;
                while (__hip_atomic_load(seam, RLX_AGENT) < want) { __builtin_amdgcn_s_sleep(2); if (++sp > (1u << 22)) break; }
                __builtin_amdgcn_fence(__ATOMIC_ACQUIRE, "agent"); asm volatile("s_waitcnt vmcnt(0)" ::: "memory"); }
            __syncthreads();
        };
        if ((int)blockIdx.x < nscan) phase_scan(F, scan_wait);
        else {
               phase_chunk(F, nscan, F.G - nscan, SCAN_SPLIT, 64 - SCAN_SPLIT);
               asm volatile("s_waitcnt vmcnt(0)" ::: "memory"); __syncthreads();
               if (F.tid == 0) { __builtin_amdgcn_fence(__ATOMIC_RELEASE, "agent"); asm volatile("s_waitcnt vmcnt(0)" ::: "memory"); __hip_atomic_fetch_add(seam, 1u, RLX_AGENT); }
               moe_weight_prep(F, nscan, MOE_PREP_SPLIT, MOE_PREP_ITEMS); } });
    RUNPH(5, phase_onorm(F));
    RUNPH(6, {
        ProbOut P; P.K = DM; P.RB = 2 * DM; P.S.init(NTOK / 256, DM / 256, F.G, (int)blockIdx.x);
        P.A = (const bf16*)(F.ws + WS_CONCAT); P.Bt = (const bf16*)(F.ws + WS_WOUT); P.X = (const bf16*)(F.ws + WS_XB); P.O = (bf16*)(F.ws + WS_X1);
        pg8::gemm_phase(F.lds, P); });
    RUNPH(7, phase_route(F));
    RUNPH(8, {
        ProbGU P; const int RT = moe_tables(F, P.T);
        P.K = DM; P.RB = DM; P.S.init(RT, 8, F.G, (int)blockIdx.x);
        P.A = F.ws + WS_X1B; P.Bt = F.ws + WS_WGU; P.O = F.ws + WS_ACT; P.list = (const int*)(F.ws + WS_LIST);
        P.rs2 = (const float*)(F.ws + WS_RSL); P.bgu = (const float*)(F.ws + WS_BGU);
        pg8::gemm_phase<ProbGU, true>(F.lds, P); });
    RUNPH(9, {
        ProbDown P; const int RT = moe_tables(F, P.T);
        P.K = DE; P.RB = DE; P.S.init(RT, 4, F.G, (int)blockIdx.x);
        P.A = F.ws + WS_ACT; P.Bt = F.ws + WS_WD; P.O = F.ws + WS_SLAB; P.list = (const int*)(F.ws + WS_LIST);
        P.gw = (const float*)(F.ws + WS_GWL); P.bd = F.in[16];
        pg8::gemm_phase<ProbDown, true>(F.lds, P); });
    RUNPH(10, phase_final(F, args.flag));
#undef RUNPH
#undef IN
#undef SEAM
}

extern "C" void kernel_launch(void* const* d_in, const int* in_sizes, int n_in, void* d_out, int out_size, void* d_ws, size_t ws_size, hipStream_t stream) {
    static int grid = 0;
    if (grid == 0) {
        if (n_in != 18 || in_sizes[0] != NTOK * DM || out_size != NTOK * DM || ws_size < WS_END) { fprintf(stderr, "kernel_launch: unexpected shapes (n_in %d, in0 %d, out %d, ws %zu)\n", n_in, n_in > 0 ? in_sizes[0] : -1, out_size, ws_size); grid = -1; return; }
        int dev = 0, cus = 0, per_cu = 0;
        if (hipGetDevice(&dev) != hipSuccess || hipDeviceGetAttribute(&cus, hipDeviceAttributeMultiprocessorCount, dev) != hipSuccess) { grid = -1; return; }
        if (hipFuncSetAttribute((const void*)mk_fwd, hipFuncAttributeMaxDynamicSharedMemorySize, LDS_BYTES) != hipSuccess) { fprintf(stderr, "kernel_launch: hipFuncSetAttribute failed\n"); grid = -1; return; }
        if (hipOccupancyMaxActiveBlocksPerMultiprocessor(&per_cu, (const void*)mk_fwd, NWAVES * 64, LDS_BYTES) != hipSuccess || per_cu < 1) { fprintf(stderr, "kernel_launch: occupancy query says %d\n", per_cu); per_cu = 1; }
        (void)hipGetLastError();
        grid = cus;
    }
    if (grid < 0) return;
    (void)hipMemsetAsync((char*)d_ws + WS_CTL, 0, CTL_ZERO_BYTES, stream);
    Args a{};
    for (int i = 0; i < 18; ++i) a.in[i] = (const float*)d_in[i];
    a.out = (float*)d_out; a.ws = (unsigned char*)d_ws;
#if MK_PER_PHASE
    for (int p = 0; p < NPHASE; ++p) { a.ph_lo = p; a.ph_hi = p + 1; const int nrep = 1 + REP_CNT * ((REP_MASK >> p) & 1);
        for (int r = 0; r < nrep; ++r) { a.flag = (p == NPHASE - 1 && r + 1 < nrep) ? 1 : 0; a.breg = r; hipLaunchKernelGGL(mk_fwd, dim3(grid), dim3(NWAVES * 64), LDS_BYTES, stream, a); } }
#else
    a.ph_lo = 0; a.ph_hi = NPHASE;
    hipLaunchKernelGGL(mk_fwd, dim3(grid), dim3(NWAVES * 64), LDS_BYTES, stream, a);
#endif
}
```

```cpp
#include <hip/hip_runtime.h>
#include <cstdio>
#include <cstdint>

#ifndef REP_MASK
#define REP_MASK 0
#endif
#ifndef REP_CNT
#define REP_CNT 1
#endif
#ifndef MK_PER_PHASE
#define MK_PER_PHASE 0
#endif

constexpr int NB = 8, SEQ = 4096, DM = 1024, NTOK = NB * SEQ;
constexpr int NH = 4, HD = 128, DDN = 512, DPOOL = 512, DIN = 2568, NPROJ = 2560;
constexpr int NE = 32, TOPK = 4, DE = 1024, NASSIGN = NTOK * TOPK;
constexpr int LISTCAP = NTOK;
constexpr int ACT_ROWS = NASSIGN + NE * 256;

constexpr size_t MiB = 1u << 20;
constexpr size_t WS_CTL = 0, CTL_ZERO_BYTES = 1 * MiB;
constexpr size_t WS_WIN = 1 * MiB;
constexpr size_t WS_WOUT = 6 * MiB;
constexpr size_t WS_WPOOL = 8 * MiB;
constexpr size_t WS_WR = 8 * MiB + 512 * 1024;
constexpr size_t WS_BGU = 8 * MiB + 768 * 1024;
constexpr size_t WS_RS1 = 9 * MiB;
constexpr size_t WS_BETA = 9 * MiB + 128 * 1024;
constexpr size_t WS_G = 9 * MiB + 640 * 1024;
constexpr size_t WS_RS2 = 10 * MiB + 256 * 1024;
constexpr size_t WS_GATEW = 10 * MiB + 512 * 1024;
constexpr size_t WS_LIST = 11 * MiB;
constexpr size_t WS_RSL = 800 * MiB;
constexpr size_t WS_GWL = 804 * MiB;
constexpr size_t WS_WGU = 16 * MiB;
constexpr size_t WS_WD = 144 * MiB;
constexpr size_t WS_XB = 208 * MiB;
constexpr size_t WS_PROJ = 272 * MiB;
constexpr size_t WS_CHUNK = 432 * MiB;
constexpr size_t WS_UC = 544 * MiB;
constexpr size_t WS_GTOT = 576 * MiB;
constexpr size_t WS_ORAW = 577 * MiB;
constexpr int CH_WF = 0, CH_QD = 16384, CH_KT = 32768, CH_QK = 49152, CH_BYTES = 57344, UC_BYTES = 16384;
constexpr size_t WS_MIXED = 688 * MiB;
constexpr size_t WS_CONCAT = 720 * MiB;
constexpr size_t WS_X1B = 208 * MiB;
constexpr size_t WS_ACT = 272 * MiB;
constexpr size_t WS_SLAB = 544 * MiB;
constexpr size_t WS_X1 = 808 * MiB;
constexpr size_t WS_END = 872 * MiB;
static_assert(WS_ACT + (size_t)ACT_ROWS * 2048 <= WS_SLAB, "act fits");
static_assert(WS_SLAB + (size_t)NASSIGN * 2048 <= WS_END, "slab fits");

constexpr int CW_BAR = 4096;
constexpr int CW_CNT = 16384;
constexpr int CW_SEAM4 = 20480;

constexpr int LDS_BYTES = 163840;
constexpr int LDSCTL_OFF = LDS_BYTES - 1024, MISC_OFF = LDSCTL_OFF + 320, TAB_OFF = LDSCTL_OFF + 512;
constexpr int NWAVES = 8;

#define GAS __attribute__((address_space(1)))
#define LAS __attribute__((address_space(3)))
typedef unsigned short bf16;
typedef unsigned v4u __attribute__((ext_vector_type(4)));
typedef unsigned v2u __attribute__((ext_vector_type(2)));
typedef float f32x4 __attribute__((ext_vector_type(4)));
typedef float f32x2 __attribute__((ext_vector_type(2)));
typedef short bf16x8 __attribute__((ext_vector_type(8)));
typedef GAS unsigned gu32;
#define RLX_AGENT __ATOMIC_RELAXED, __HIP_MEMORY_SCOPE_AGENT
#define LDS_WAIT() asm volatile("s_waitcnt lgkmcnt(0)" ::: "memory")
#define VM_WAIT() asm volatile("s_waitcnt vmcnt(0)" ::: "memory")

__device__ __forceinline__ unsigned f2bf(float f) { unsigned u = __builtin_bit_cast(unsigned, f); return (u + 0x7fffu + ((u >> 16) & 1u)) >> 16; }
__device__ __forceinline__ unsigned pk2(float lo, float hi) { return f2bf(lo) | (f2bf(hi) << 16); }
__device__ __forceinline__ float bflo(unsigned u) { return __builtin_bit_cast(float, u << 16); }
__device__ __forceinline__ float bfhi(unsigned u) { return __builtin_bit_cast(float, u & 0xffff0000u); }
__device__ __forceinline__ unsigned pk4_fp8(float a, float b, float c, float d) { int p = __builtin_amdgcn_cvt_pk_fp8_f32(a, b, 0, false); p = __builtin_amdgcn_cvt_pk_fp8_f32(c, d, p, true); return (unsigned)p; }
typedef float f32x2_t __attribute__((ext_vector_type(2)));
constexpr float SLAB_SCALE = 16.f, SLAB_INV = 1.f / 16.f;
constexpr float W8_SCALE = 32.f, W8_INV = 1.f / 32.f;
__device__ __forceinline__ float wave_sum(float v) {
#pragma unroll
    for (int o = 1; o < 64; o <<= 1) v += __shfl_xor(v, o);
    return v;
}
__device__ __forceinline__ float frcp_(float x) { return __builtin_amdgcn_rcpf(x); }
__device__ __forceinline__ float frsq_(float x) { return __builtin_amdgcn_rsqf(x); }
__device__ __forceinline__ float fexp_(float x) { return __builtin_amdgcn_exp2f(x * 1.4426950408889634f); }
__device__ __forceinline__ float sigmoidf_(float x) { return frcp_(1.f + fexp_(-x)); }
__device__ __forceinline__ float siluf_(float x) { return x * frcp_(1.f + fexp_(-x)); }

namespace pg8 {
constexpr int BM = 256, BK = 64, HALF = 128, HTB = HALF * BK * 2, STAGE_BYTES = 8 * HTB;
__device__ __forceinline__ int lds_byte(int r, int c) { const int st = (r >> 4) * 2 + (c >> 5), rr = r & 15, cc = c & 31, ob = rr * 64 + cc * 2; return st * 1024 + (ob ^ (((ob >> 9) & 1) << 5)); }
__device__ __forceinline__ void stage_rc(int b, int& R, int& C) { const int st = b / 1024, sb = b % 1024, swz = sb ^ (((sb >> 9) & 1) << 5); R = (st >> 1) * 16 + swz / 64; C = (st & 1) * 32 + (swz % 64) / 2; }
__device__ __forceinline__ int perm32(int rho) { const int n = rho >> 4, i = rho & 15; return 8 * (i >> 2) + 4 * n + (i & 3); }
typedef __bf16 bf16x2_t __attribute__((ext_vector_type(2)));
__device__ __forceinline__ unsigned cvt_pk_bf16(float lo, float hi) { const f32x2 v = {lo, hi}; const bf16x2_t b = __builtin_convertvector(v, bf16x2_t); return __builtin_bit_cast(unsigned, b); }

struct Unit { int rt, pn, e, rb, rows; };

struct Sched {
    int nM, nN, nwg, G, c;
    __device__ __forceinline__ void init(int nM_, int nN_, int G_, int c_) { nM = nM_; nN = nN_; nwg = nM * nN; G = G_; c = c_; }
    __device__ __forceinline__ bool next(int i, int& pm, int& pn) const {
        const long L = (long)i * G + c; if (L >= nwg) return false;
        int wgid = (int)L; { const int q = nwg / 8, r = nwg % 8, xcd = wgid % 8, off = wgid / 8; wgid = (xcd < r ? xcd * (q + 1) : r * (q + 1) + (xcd - r) * q) + off; }
        const int nig = 8 * nN, gid = wgid / nig, fm = gid * 8, gsz = (nM - fm) < 8 ? (nM - fm) : 8;
        pm = fm + ((wgid % nig) % gsz); pn = (wgid % nig) / gsz; return true;
    }
};

typedef int v8i_t __attribute__((ext_vector_type(8)));
template <class P, bool F8 = false>
__device__ __forceinline__ void gemm_phase(LAS unsigned char* lds, const P& p) {
    const int tid = threadIdx.x, wid = __builtin_amdgcn_readfirstlane(tid >> 6), lane = tid & 63, wr = wid >> 2, wc = wid & 3, fr = lane & 15, fq = lane >> 4;
    const int K = p.K, RB = F8 ? K : 2 * K, nt = RB / (BK * 2);
    unsigned voffB[2];
#pragma unroll
    for (int i = 0; i < 2; ++i) { int R_, C_; stage_rc(tid * 16 + i * 8192, R_, C_); const int Rb = (R_ & ~31) + perm32(R_ & 31); voffB[i] = (unsigned)(Rb * RB + C_ * 2); }
#define PG8_AOFF(unit, dst) do { int R[2], C[2]; asm volatile("" ::: "memory"); _Pragma("unroll") for (int i_ = 0; i_ < 2; ++i_) stage_rc(tid * 16 + i_ * 8192, R[i_], C[i_]); p.a_off(unit, R, C, dst); } while (0)
    const size_t kstep = (size_t)(BK * 2);
    const size_t hstep = (size_t)HALF * RB;
    const unsigned ldsw = (unsigned)wid * 1024u;
    const int aoff = lds_byte(wr * 64 + fr, fq * 8), boff = lds_byte(wc * 32 + fr, fq * 8);
#define PG8_SA(b, h) (((b) * 2 + (h)) * HTB)
#define PG8_SB(b, h) ((4 + (b) * 2 + (h)) * HTB)
#define PG8_STAGE(bufoff, gbase, voff) do { _Pragma("unroll") for (int _i = 0; _i < 2; ++_i) \
        __builtin_amdgcn_global_load_lds((const unsigned*)((const char*)(gbase) + (voff)[_i]), (LAS unsigned*)(lds + (bufoff) + ldsw + _i * 8192), 16, 0, 0); } while (0)
#define PG8_LDA(dst, b, h) do { _Pragma("unroll") for (int m = 0; m < 4; ++m) { const v4i_t l_ = *(const LAS v4i_t*)(lds + PG8_SA(b, h) + aoff + m * 2048), h_ = *(const LAS v4i_t*)(lds + PG8_SA(b, h) + aoff + m * 2048 + 1024); dst[m] = __builtin_shufflevector(l_, h_, 0, 1, 2, 3, 4, 5, 6, 7); } } while (0)
#define PG8_LDB(dst, b, h) do { _Pragma("unroll") for (int n = 0; n < 2; ++n) { const v4i_t l_ = *(const LAS v4i_t*)(lds + PG8_SB(b, h) + boff + n * 2048), h_ = *(const LAS v4i_t*)(lds + PG8_SB(b, h) + boff + n * 2048 + 1024); dst[n] = __builtin_shufflevector(l_, h_, 0, 1, 2, 3, 4, 5, 6, 7); } } while (0)
#define PG8_HALF(x, k) __builtin_bit_cast(bf16x8, __builtin_shufflevector(x, x, 4 * (k), 4 * (k) + 1, 4 * (k) + 2, 4 * (k) + 3))
#define PG8_MMA(ai, bj, At, Bt) do { __builtin_amdgcn_s_setprio(1); \
        if constexpr (F8) { _Pragma("unroll") for (int m = 0; m < 4; ++m) _Pragma("unroll") for (int n = 0; n < 2; ++n) \
            asm volatile("v_mfma_scale_f32_16x16x128_f8f6f4 %0, %1, %2, %0, %3, %3 op_sel_hi:[0,0,0]" : "+v"(acc[ai][bj][m][n]) : "v"(Bt[n]), "v"(At[m]), "v"(mxs)); } \
        else { _Pragma("unroll") for (int m = 0; m < 4; ++m) _Pragma("unroll") for (int n = 0; n < 2; ++n) { \
            acc[ai][bj][m][n] = __builtin_amdgcn_mfma_f32_16x16x32_bf16(PG8_HALF(Bt[n], 0), PG8_HALF(At[m], 0), acc[ai][bj][m][n], 0, 0, 0); \
            acc[ai][bj][m][n] = __builtin_amdgcn_mfma_f32_16x16x32_bf16(PG8_HALF(Bt[n], 1), PG8_HALF(At[m], 1), acc[ai][bj][m][n], 0, 0, 0); } } \
        __builtin_amdgcn_s_setprio(0); } while (0)
#define PG8_WAIT_V(n) asm volatile("s_waitcnt vmcnt(" #n ")" ::: "memory")
#define PG8_WAIT_L(n) asm volatile("s_waitcnt lgkmcnt(" #n ")" ::: "memory")
#define PG8_BAR __builtin_amdgcn_s_barrier()
#define PG8_SCHED __builtin_amdgcn_sched_barrier(0)
    Unit cur, nxt; int ui = 0;
    if (!p.next(0, cur)) return;
    unsigned mxs = 0x7f7f7f7fu; asm volatile("" : "+v"(mxs));
    f32x4 acc[2][2][4][2];
#pragma unroll
    for (int a = 0; a < 2; ++a)
#pragma unroll
        for (int b = 0; b < 2; ++b)
#pragma unroll
            for (int m = 0; m < 4; ++m)
#pragma unroll
                for (int n = 0; n < 2; ++n) acc[a][b][m][n] = (f32x4){0.f, 0.f, 0.f, 0.f};
    typedef int v4i_t __attribute__((ext_vector_type(4)));
    v8i_t At[4], B0[2], B1[2];
    unsigned oA[2][2];
    PG8_AOFF(cur, oA);
    const char* cA = p.a_base(cur); const char* cB = p.b_base(cur);
    PG8_STAGE(PG8_SB(0, 0), cB, voffB); PG8_STAGE(PG8_SB(0, 1), cB + hstep, voffB); PG8_STAGE(PG8_SA(0, 0), cA, oA[0]); PG8_STAGE(PG8_SA(0, 1), cA, oA[1]);
    if (wr == 1) PG8_BAR;
    PG8_WAIT_V(2); PG8_BAR;
    PG8_STAGE(PG8_SB(1, 0), cB + kstep, voffB); PG8_STAGE(PG8_SA(1, 0), cA + kstep, oA[0]); PG8_STAGE(PG8_SB(1, 1), cB + hstep + kstep, voffB);
    PG8_WAIT_V(6); PG8_BAR;
    LAS v4u* park = (LAS v4u*)(lds + STAGE_BYTES) + tid;
    for (;;) {
        const bool has_next = p.next(ui + 1, nxt);
        const char* nA = cA; const char* nB = cB;
        { unsigned nO[2][2];
#pragma unroll
          for (int h = 0; h < 2; ++h)
#pragma unroll
              for (int i = 0; i < 2; ++i) nO[h][i] = oA[h][i];
          if (has_next) { nA = p.a_base(nxt); nB = p.b_base(nxt); PG8_AOFF(nxt, nO); }
          *park = (v4u){nO[0][0], nO[0][1], nO[1][0], nO[1][1]}; }
        for (int t = 0; t < nt; t += 2) {
            const bool last = (t == nt - 2);
            const char* a1 = cA + (size_t)(t + 1) * kstep;
            const char* a2 = last ? nA : cA + (size_t)(t + 2) * kstep; const char* b2 = last ? nB : cB + (size_t)(t + 2) * kstep;
            const char* a3 = a2 + kstep; const char* b3 = b2 + kstep;
            unsigned o2[2][2];
#pragma unroll
            for (int h = 0; h < 2; ++h)
#pragma unroll
                for (int i = 0; i < 2; ++i) o2[h][i] = oA[h][i];
            if (last) { const v4u q_ = *park; o2[0][0] = q_.x; o2[0][1] = q_.y; o2[1][0] = q_.z; o2[1][1] = q_.w; }
            PG8_LDB(B0, 0, 0); PG8_LDB(B1, 0, 1); PG8_SCHED; PG8_LDA(At, 0, 0); PG8_STAGE(PG8_SA(1, 1), a1, oA[1]);
            PG8_WAIT_V(8); PG8_WAIT_L(0); PG8_BAR; PG8_MMA(0, 0, At, B0); PG8_MMA(0, 1, At, B1); PG8_BAR; PG8_SCHED;
            PG8_LDA(At, 0, 1); PG8_STAGE(PG8_SB(0, 0), b2, voffB); PG8_STAGE(PG8_SB(0, 1), b2 + hstep, voffB); PG8_STAGE(PG8_SA(0, 0), a2, o2[0]);
            PG8_WAIT_V(8); PG8_WAIT_L(0); PG8_BAR; PG8_MMA(1, 0, At, B0); PG8_MMA(1, 1, At, B1); PG8_BAR; PG8_SCHED;
            PG8_LDB(B0, 1, 0); PG8_LDB(B1, 1, 1); PG8_SCHED; PG8_LDA(At, 1, 0); PG8_STAGE(PG8_SA(0, 1), a2, o2[1]);
            PG8_WAIT_V(8); PG8_WAIT_L(0); PG8_BAR; PG8_MMA(0, 0, At, B0); PG8_MMA(0, 1, At, B1); PG8_BAR; PG8_SCHED;
            PG8_LDA(At, 1, 1); PG8_STAGE(PG8_SB(1, 0), b3, voffB); PG8_STAGE(PG8_SB(1, 1), b3 + hstep, voffB); PG8_STAGE(PG8_SA(1, 0), a3, o2[0]);
            PG8_WAIT_V(8); PG8_WAIT_L(0); PG8_BAR; PG8_MMA(1, 0, At, B0); PG8_MMA(1, 1, At, B1); PG8_BAR; PG8_SCHED;
        }
        if (wr == 0) PG8_BAR;
        if constexpr (F8) asm volatile("s_nop 15\n\ts_nop 15" ::: "memory");
        p.epi(acc, cur, wr, wc, fr, fq);
        if (!has_next) break;
#pragma unroll
        for (int a = 0; a < 2; ++a)
#pragma unroll
            for (int b = 0; b < 2; ++b)
#pragma unroll
                for (int m = 0; m < 4; ++m)
#pragma unroll
                    for (int n = 0; n < 2; ++n) acc[a][b][m][n] = (f32x4){0.f, 0.f, 0.f, 0.f};
        cur = nxt; cA = nA; cB = nB; ++ui;
        { const v4u q_ = *park; oA[0][0] = q_.x; oA[0][1] = q_.y; oA[1][0] = q_.z; oA[1][1] = q_.w; }
        if (wr == 1) PG8_BAR;
    }
    PG8_WAIT_V(0);
    PG8_BAR;
#undef PG8_SA
#undef PG8_SB
#undef PG8_STAGE
#undef PG8_LDA
#undef PG8_LDB
#undef PG8_MMA
#undef PG8_HALF
#undef PG8_AOFF
#undef PG8_WAIT_V
#undef PG8_WAIT_L
#undef PG8_BAR
#undef PG8_SCHED
}
}

#define XB_TMO      128
#define XB_XCNT(j)  (256  + 64 * (j))
#define XB_XSUB(j)  (1280 + 64 * (j))
#define XB_XGEN(j)  (2304 + 64 * (j))
#define XB_TOP      3328
#define XB_TOPGEN   3392
#define XCD_BAR_WORDS 3456
#define XB_SPIN_CAP (1u << 18)
__device__ __forceinline__ unsigned xb_ld(unsigned* p)              { return __hip_atomic_load(p, __ATOMIC_RELAXED, __HIP_MEMORY_SCOPE_AGENT); }
__device__ __forceinline__ unsigned xb_add(unsigned* p, unsigned v) { return __hip_atomic_fetch_add(p, v, __ATOMIC_RELAXED, __HIP_MEMORY_SCOPE_AGENT); }
__device__ __forceinline__ unsigned xb_xcc_id() { return (unsigned)__builtin_amdgcn_s_getreg((3 << 11) | 20) & 0xFu; }
#define XB_SPIN(cond, bar) do { unsigned _sp = 0; while (cond) { __builtin_amdgcn_s_sleep(1); \
    if ((++_sp & 255u) == 0u) { if (xb_ld(&(bar)[XB_TMO])) break; if (_sp > XB_SPIN_CAP) { atomicAdd(&(bar)[XB_TMO], 1u); break; } } } } while (0)
struct XcdBarrier { unsigned* bar; unsigned x; volatile LAS unsigned* st; };
__device__ __forceinline__ XcdBarrier xcd_barrier_post(unsigned* bar, volatile LAS unsigned* st) {
    XcdBarrier b; b.bar = bar; b.x = xb_xcc_id(); b.st = st;
    if (threadIdx.x == 0) (void)xb_add(&bar[XB_XCNT(b.x)], 1u);
    return b;
}
__device__ __forceinline__ void xcd_barrier_complete(unsigned* bar, unsigned x, unsigned& nloc, unsigned& nx) {
    const unsigned G = gridDim.x * gridDim.y * gridDim.z;
    unsigned sum, cnt, mine, sp = 0u;
    for (;;) {
        sum = 0u; cnt = 0u; mine = 0u;
#pragma unroll
        for (unsigned j = 0; j < 16; ++j) { const unsigned c = xb_ld(&bar[XB_XCNT(j)]); sum += c; cnt += (c > 0u) ? 1u : 0u; mine = (j == x) ? c : mine; }
        if (sum == G) break;
        __builtin_amdgcn_s_sleep(1);
        if ((++sp & 255u) == 0u) { if (xb_ld(&bar[XB_TMO])) break; if (sp > XB_SPIN_CAP) { atomicAdd(&bar[XB_TMO], 1u); break; } }
    }
    nloc = mine > 0u ? mine : 1u; nx = cnt > 0u ? cnt : 1u;
}
__device__ __forceinline__ void xcd_barrier(const XcdBarrier& b) {
    asm volatile("s_waitcnt vmcnt(0)" ::: "memory");
    __syncthreads();
    if (threadIdx.x == 0) {
        unsigned* bar = b.bar;
        __builtin_amdgcn_s_waitcnt(0);
        unsigned nloc = b.st[0], nx = b.st[1];
        if (nloc == 0u) { xcd_barrier_complete(bar, b.x, nloc, nx); b.st[0] = nloc; b.st[1] = nx; }
        const unsigned old = xb_add(&bar[XB_XSUB(b.x)], 1u);
        const unsigned gen = old / nloc;
        if (old + 1u == (gen + 1u) * nloc) {
            __builtin_amdgcn_fence(__ATOMIC_RELEASE, "agent");
            asm volatile("s_waitcnt vmcnt(0)" ::: "memory");
            const unsigned og = xb_add(&bar[XB_TOP], 1u);
            const unsigned tg = og / nx;
            if (og + 1u == (tg + 1u) * nx) xb_add(&bar[XB_TOPGEN], 1u);
            else XB_SPIN(xb_ld(&bar[XB_TOPGEN]) == tg, bar);
            __builtin_amdgcn_fence(__ATOMIC_ACQUIRE, "agent");
            xb_add(&bar[XB_XGEN(b.x)], 1u);
            asm volatile("s_waitcnt vmcnt(0)" ::: "memory");
        } else {
            XB_SPIN(xb_ld(&bar[XB_XGEN(b.x)]) == gen, bar);
            __builtin_amdgcn_fence(__ATOMIC_ACQUIRE, "agent");
            asm volatile("s_waitcnt vmcnt(0)" ::: "memory");
        }
    }
    __syncthreads();
}

struct Frame {
    LAS unsigned char* lds;
    int tid, lane, wave, vcu, G;
    const float* in[18];
    float* out;
    unsigned char* ws;
};
using pg8::Unit;
using pg8::cvt_pk_bf16;

struct ProbBase {
    int K; int RB; pg8::Sched S;
    __device__ __forceinline__ void lin_off(const int (&R)[2], const int (&C)[2], unsigned (&off)[2][2]) const {
#pragma unroll
        for (int h = 0; h < 2; ++h)
#pragma unroll
            for (int i = 0; i < 2; ++i) off[h][i] = (unsigned)((h * 128 + R[i]) * RB + C[i] * 2);
    }
};
struct ProbIn : ProbBase {
    const bf16* A; const bf16* Bt; bf16* O; const float* rs;
    __device__ __forceinline__ bool next(int i, Unit& u) const { int pm, pn; if (!S.next(i, pm, pn)) return false; u.rt = pm; u.pn = pn; u.e = 0; u.rb = pm; u.rows = 256; return true; }
    __device__ __forceinline__ const char* a_base(const Unit& u) const { return (const char*)A + (size_t)u.rt * 256 * RB; }
    __device__ __forceinline__ const char* b_base(const Unit& u) const { return (const char*)Bt + (size_t)u.pn * 256 * RB; }
    __device__ __forceinline__ void a_off(const Unit&, const int (&R)[2], const int (&C)[2], unsigned (&off)[2][2]) const { lin_off(R, C, off); }
    __device__ __forceinline__ void epi(const f32x4 (&acc)[2][2][4][2], const Unit& u, int wr, int wc, int fr, int fq) const {
        const int row0 = u.rt * 256 + wr * 64 + fr, col0 = u.pn * 256 + wc * 32 + 8 * fq;
#pragma unroll
        for (int ai = 0; ai < 2; ++ai)
#pragma unroll
            for (int m = 0; m < 4; ++m) { const int row = row0 + ai * 128 + m * 16; const float sc = rs[row]; bf16* rowp = O + (size_t)row * NPROJ + col0;
#pragma unroll
                for (int bj = 0; bj < 2; ++bj) { const f32x4 v0 = acc[ai][bj][m][0] * sc, v1 = acc[ai][bj][m][1] * sc; v4u w;
                    w.x = cvt_pk_bf16(v0[0], v0[1]); w.y = cvt_pk_bf16(v0[2], v0[3]); w.z = cvt_pk_bf16(v1[0], v1[1]); w.w = cvt_pk_bf16(v1[2], v1[3]);
                    *(v4u*)(rowp + bj * 128) = w; } }
    }
};
struct ProbPool : ProbBase {
    const bf16* A; const bf16* Bt; bf16* O;
    __device__ __forceinline__ bool next(int i, Unit& u) const { int pm, pn; if (!S.next(i, pm, pn)) return false; u.rt = pm; u.pn = pn; u.e = 0; u.rb = pm; u.rows = 256; return true; }
    __device__ __forceinline__ const char* a_base(const Unit& u) const { return (const char*)A + (size_t)u.rt * 256 * RB; }
    __device__ __forceinline__ const char* b_base(const Unit& u) const { return (const char*)Bt + (size_t)u.pn * 256 * RB; }
    __device__ __forceinline__ void a_off(const Unit&, const int (&R)[2], const int (&C)[2], unsigned (&off)[2][2]) const { lin_off(R, C, off); }
    __device__ __forceinline__ void epi(const f32x4 (&acc)[2][2][4][2], const Unit& u, int wr, int wc, int fr, int fq) const {
        const int row0 = u.rt * 256 + wr * 64 + fr, col0 = 512 + u.pn * 256 + wc * 32 + 8 * fq;
#pragma unroll
        for (int ai = 0; ai < 2; ++ai)
#pragma unroll
            for (int m = 0; m < 4; ++m) { const int row = row0 + ai * 128 + m * 16; bf16* rowp = O + (size_t)row * DM + col0;
#pragma unroll
                for (int bj = 0; bj < 2; ++bj) { const f32x4 v0 = acc[ai][bj][m][0], v1 = acc[ai][bj][m][1]; v4u w;
                    w.x = cvt_pk_bf16(v0[0], v0[1]); w.y = cvt_pk_bf16(v0[2], v0[3]); w.z = cvt_pk_bf16(v1[0], v1[1]); w.w = cvt_pk_bf16(v1[2], v1[3]);
                    *(v4u*)(rowp + bj * 128) = w; } }
    }
};
struct ProbOut : ProbBase {
    const bf16* A; const bf16* Bt; const bf16* X; bf16* O;
    __device__ __forceinline__ bool next(int i, Unit& u) const { int pm, pn; if (!S.next(i, pm, pn)) return false; u.rt = pm; u.pn = pn; u.e = 0; u.rb = pm; u.rows = 256; return true; }
    __device__ __forceinline__ const char* a_base(const Unit& u) const { return (const char*)A + (size_t)u.rt * 256 * RB; }
    __device__ __forceinline__ const char* b_base(const Unit& u) const { return (const char*)Bt + (size_t)u.pn * 256 * RB; }
    __device__ __forceinline__ void a_off(const Unit&, const int (&R)[2], const int (&C)[2], unsigned (&off)[2][2]) const { lin_off(R, C, off); }
    __device__ __forceinline__ void epi(const f32x4 (&acc)[2][2][4][2], const Unit& u, int wr, int wc, int fr, int fq) const {
        const int row0 = u.rt * 256 + wr * 64 + fr, col0 = u.pn * 256 + wc * 32 + 8 * fq;
#pragma unroll
        for (int ai = 0; ai < 2; ++ai)
#pragma unroll
            for (int m = 0; m < 4; ++m) { const size_t off = (size_t)(row0 + ai * 128 + m * 16) * DM + col0;
#pragma unroll
                for (int bj = 0; bj < 2; ++bj) { const v4u xv = *(const v4u*)(X + off + bj * 128); const f32x4 a = acc[ai][bj][m][0], b = acc[ai][bj][m][1];
                    *(v4u*)(O + off + bj * 128) = (v4u){cvt_pk_bf16(bflo(xv.x) + a.x, bfhi(xv.x) + a.y), cvt_pk_bf16(bflo(xv.y) + a.z, bfhi(xv.y) + a.w),
                                                        cvt_pk_bf16(bflo(xv.z) + b.x, bfhi(xv.z) + b.y), cvt_pk_bf16(bflo(xv.w) + b.z, bfhi(xv.w) + b.w)}; } }
    }
};
struct MoeTab { const LAS int* pref; const LAS int* cnt; const LAS int* tile; };
__device__ __forceinline__ void moe_decode(const MoeTab& T, int rt, Unit& u) {
    const int w = T.tile[rt];
    u.e = w >> 24; u.rb = (w >> 12) & 0xfff; u.rows = w & 0xfff;
}
struct ProbGU : ProbBase {
    MoeTab T; const unsigned char* A; const unsigned char* Bt; unsigned char* O; const int* list; const float* rs2; const float* bgu;
    __device__ __forceinline__ bool next(int i, Unit& u) const { int pm, pn; if (!S.next(i, pm, pn)) return false; u.rt = pm; u.pn = pn; moe_decode(T, pm, u); return true; }
    __device__ __forceinline__ const char* a_base(const Unit&) const { return (const char*)A; }
    __device__ __forceinline__ const char* b_base(const Unit& u) const { return (const char*)Bt + ((size_t)u.e * 2048 + (size_t)u.pn * 256) * RB; }
    __device__ __forceinline__ void a_off(const Unit& u, const int (&R)[2], const int (&C)[2], unsigned (&off)[2][2]) const {
        const int* lp = list + (size_t)u.e * LISTCAP + u.rb * 256;
#pragma unroll
        for (int h = 0; h < 2; ++h)
#pragma unroll
            for (int i = 0; i < 2; ++i) { const int r = h * 128 + R[i]; const int ent = (r < u.rows) ? lp[r] : 0; off[h][i] = (unsigned)(ent >> 2) * (unsigned)RB + (unsigned)C[i] * 2u; }
    }
    __device__ __forceinline__ void epi(const f32x4 (&acc)[2][2][4][2], const Unit& u, int wr, int wc, int fr, int fq) const {
        const float* rsp = rs2 + (size_t)u.e * LISTCAP + u.rb * 256;
        const int j0 = wc * 32 + 8 * fq;
        const float* bg = bgu + (size_t)u.e * 2048 + u.pn * 256 + j0;
        f32x4 bgv[2], buv[2];
#pragma unroll
        for (int n = 0; n < 2; ++n) { bgv[n] = *(const f32x4*)(bg + 4 * n); buv[n] = *(const f32x4*)(bg + 128 + 4 * n); }
#pragma unroll
        for (int ai = 0; ai < 2; ++ai)
#pragma unroll
            for (int m = 0; m < 4; ++m) { const int r = ai * 128 + wr * 64 + m * 16 + fr;
                if (r < u.rows) { const float sc = rsp[r] * W8_INV; const f32x2_t sc2 = (f32x2_t){sc, sc}; unsigned w[2];
#pragma unroll
                    for (int n = 0; n < 2; ++n) { f32x2_t a2[2];
#pragma unroll
                        for (int qp = 0; qp < 2; ++qp) {
                            f32x2_t gt = (f32x2_t){acc[ai][0][m][n][2 * qp], acc[ai][0][m][n][2 * qp + 1]} * sc2 + (f32x2_t){bgv[n][2 * qp], bgv[n][2 * qp + 1]};
                            f32x2_t up = (f32x2_t){acc[ai][1][m][n][2 * qp], acc[ai][1][m][n][2 * qp + 1]} * sc2 + (f32x2_t){buv[n][2 * qp], buv[n][2 * qp + 1]};
                            gt.x = fminf(gt.x, 7.f); gt.y = fminf(gt.y, 7.f); up.x = fminf(fmaxf(up.x, -7.f), 7.f); up.y = fminf(fmaxf(up.y, -7.f), 7.f);
                            const f32x2_t ex = gt * (f32x2_t){-1.702f * 1.4426950408889634f, -1.702f * 1.4426950408889634f};
                            const f32x2_t dn = (f32x2_t){__builtin_amdgcn_exp2f(ex.x), __builtin_amdgcn_exp2f(ex.y)} + (f32x2_t){1.f, 1.f};
                            a2[qp] = (up + (f32x2_t){1.f, 1.f}) * gt * (f32x2_t){frcp_(dn.x), frcp_(dn.y)}; }
                        w[n] = pk4_fp8(a2[0].x, a2[0].y, a2[1].x, a2[1].y); }
                    *(v2u*)(O + (size_t)(u.rt * 256 + r) * DE + u.pn * 128 + j0) = (v2u){w[0], w[1]}; } }
    }
};
struct ProbDown : ProbBase {
    MoeTab T; const unsigned char* A; const unsigned char* Bt; unsigned char* O; const int* list; const float* gw; const float* bd;
    __device__ __forceinline__ bool next(int i, Unit& u) const { int pm, pn; if (!S.next(i, pm, pn)) return false; u.rt = pm; u.pn = pn; moe_decode(T, pm, u); return true; }
    __device__ __forceinline__ const char* a_base(const Unit& u) const { return (const char*)A + (size_t)u.rt * 256 * RB; }
    __device__ __forceinline__ const char* b_base(const Unit& u) const { return (const char*)Bt + ((size_t)u.e * 1024 + (size_t)u.pn * 256) * RB; }
    __device__ __forceinline__ void a_off(const Unit&, const int (&R)[2], const int (&C)[2], unsigned (&off)[2][2]) const { lin_off(R, C, off); }
    __device__ __forceinline__ void epi(const f32x4 (&acc)[2][2][4][2], const Unit& u, int wr, int wc, int fr, int fq) const {
        const int* lp = list + (size_t)u.e * LISTCAP + u.rb * 256;
        const int c0 = u.pn * 256 + wc * 32 + 8 * fq;
        const float* gwp = gw + (size_t)u.e * LISTCAP + u.rb * 256;
        const float* bp = bd + (size_t)u.e * DM + c0;
        f32x4 bv[2][2];
#pragma unroll
        for (int bj = 0; bj < 2; ++bj)
#pragma unroll
            for (int n = 0; n < 2; ++n) bv[bj][n] = *(const f32x4*)(bp + bj * 128 + 4 * n);
#pragma unroll
        for (int ai = 0; ai < 2; ++ai)
#pragma unroll
            for (int m = 0; m < 4; ++m) { const int r = ai * 128 + wr * 64 + m * 16 + fr;
                if (r < u.rows) { const int ent = lp[r]; const float g = gwp[r]; unsigned char* rowp = O + (size_t)ent * DM + c0;
#pragma unroll
                    for (int bj = 0; bj < 2; ++bj) { const f32x4 v0 = (acc[ai][bj][m][0] * W8_INV + bv[bj][0]) * g, v1 = (acc[ai][bj][m][1] * W8_INV + bv[bj][1]) * g;
                        *(v2u*)(rowp + bj * 128) = (v2u){pk4_fp8(v0[0] * SLAB_SCALE, v0[1] * SLAB_SCALE, v0[2] * SLAB_SCALE, v0[3] * SLAB_SCALE), pk4_fp8(v1[0] * SLAB_SCALE, v1[1] * SLAB_SCALE, v1[2] * SLAB_SCALE, v1[3] * SLAB_SCALE)}; } } }
    }
};

typedef short v4i16_t __attribute__((ext_vector_type(4)));
__device__ __forceinline__ void tr_item(const float* W, int ldw, int k0, int nsrc0, bf16* WT, size_t drow0, int ldk, int dk0, const float* ks, const float* ns, LAS unsigned char* scr, int lane) {
    const int kr = lane >> 4, n4 = (lane & 15) * 4;
    f32x4 nsc = (f32x4){1.f, 1.f, 1.f, 1.f}; if (ns) nsc = *(const f32x4*)(ns + nsrc0 + n4);
    f32x4 v[16];
#pragma unroll
    for (int i = 0; i < 16; ++i) v[i] = *(const f32x4*)(W + (size_t)(k0 + 4 * i + kr) * ldw + nsrc0 + n4);
#pragma unroll
    for (int i = 0; i < 16; ++i) { f32x4 x = v[i] * nsc; if (ks) x = x * ks[k0 + 4 * i + kr];
        *(LAS v2u*)(scr + (4 * i + kr) * 192 + n4 * 2) = (v2u){pg8::cvt_pk_bf16(x.x, x.y), pg8::cvt_pk_bf16(x.z, x.w)}; }
    LDS_WAIT(); asm volatile("" ::: "memory");
    const int G = lane >> 4, li = lane & 15, q = li >> 2, p = li & 3;
    const LAS unsigned char* rb = scr + q * 192 + (16 * G + 4 * p) * 2;
    bf16* dst = WT + (drow0 + 16 * G + li) * (size_t)ldk + dk0 + k0;
#pragma unroll
    for (int kc = 0; kc < 8; ++kc) {
        const v4i16_t lo = __builtin_amdgcn_ds_read_tr16_b64_v4i16((LAS v4i16_t*)(rb + (8 * kc) * 192));
        const v4i16_t hi = __builtin_amdgcn_ds_read_tr16_b64_v4i16((LAS v4i16_t*)(rb + (8 * kc + 4) * 192));
        const v2u l2 = __builtin_bit_cast(v2u, lo), h2 = __builtin_bit_cast(v2u, hi);
        *(v4u*)(dst + 8 * kc) = (v4u){l2.x, l2.y, h2.x, h2.y};
    }
    LDS_WAIT(); asm volatile("" ::: "memory");
}

template <int KT, int NT>
__device__ __forceinline__ void tr_item8(const float* W, int ldw, int k0, int nsrc0, unsigned char* WT, size_t drow0, int ldk, const float* ks, float mul, LAS unsigned char* scr, int lane) {
    constexpr int LPR = NT / 4, RPL = 64 / LPR, PA = NT * 2 + 64;
    static_assert(KT * NT == 4096 && (PA / 4) % 32 == 16, "tile geometry");
    const int kr = lane / LPR, n4 = (lane % LPR) * 4;
    f32x4 v[16];
#pragma unroll
    for (int i = 0; i < 16; ++i) v[i] = *(const f32x4*)(W + (size_t)(k0 + RPL * i + kr) * ldw + nsrc0 + n4);
#pragma unroll
    for (int i = 0; i < 16; ++i) { const float sc = ks ? ks[k0 + RPL * i + kr] * mul : mul; const f32x4 x = v[i] * sc;
        *(LAS v2u*)(scr + (RPL * i + kr) * PA + n4 * 2) = (v2u){pg8::cvt_pk_bf16(x.x, x.y), pg8::cvt_pk_bf16(x.z, x.w)}; }
    LDS_WAIT(); asm volatile("" ::: "memory");
    const int G = lane >> 4, li = lane & 15, q = li >> 2, p = li & 3;
#pragma unroll
    for (int ps = 0; ps < NT / 64; ++ps) {
        const LAS unsigned char* rb = scr + q * PA + (16 * (G + 4 * ps) + 4 * p) * 2;
        unsigned char* dst = WT + (drow0 + 16 * (G + 4 * ps) + li) * (size_t)ldk + k0;
#pragma unroll
        for (int kq = 0; kq < KT / 16; ++kq) {
            v2u t[4];
#pragma unroll
            for (int u = 0; u < 4; ++u) t[u] = __builtin_bit_cast(v2u, __builtin_amdgcn_ds_read_tr16_b64_v4i16((LAS v4i16_t*)(rb + (16 * kq + 4 * u) * PA)));
            v4u o;
            o.x = pk4_fp8(bflo(t[0].x), bfhi(t[0].x), bflo(t[0].y), bfhi(t[0].y)); o.y = pk4_fp8(bflo(t[1].x), bfhi(t[1].x), bflo(t[1].y), bfhi(t[1].y));
            o.z = pk4_fp8(bflo(t[2].x), bfhi(t[2].x), bflo(t[2].y), bfhi(t[2].y)); o.w = pk4_fp8(bflo(t[3].x), bfhi(t[3].x), bflo(t[3].y), bfhi(t[3].y));
            *(v4u*)(dst + 16 * kq) = o;
        }
    }
    LDS_WAIT(); asm volatile("" ::: "memory");
}

constexpr int TRF_T1 = 128 * 192, TRF_T2 = 64 * 144, TRF_BYTES = TRF_T1 + TRF_T2;
__device__ __forceinline__ void tr_item8f(const float* W, int ldw, int k0, int nsrc0, unsigned char* WT, size_t drow0, int ldk, const float* ks, float mul, LAS unsigned char* scr, int lane) {
    const int kr = lane >> 4, n4 = (lane & 15) * 4;
#pragma unroll
    for (int hb = 0; hb < 2; ++hb) {
        f32x4 v[16];
#pragma unroll
        for (int i = 0; i < 16; ++i) v[i] = *(const f32x4*)(W + (size_t)(k0 + 64 * hb + 4 * i + kr) * ldw + nsrc0 + n4);
#pragma unroll
        for (int i = 0; i < 16; ++i) { const float sc = ks ? ks[k0 + 64 * hb + 4 * i + kr] * mul : mul; const f32x4 x = v[i] * sc;
            *(LAS v2u*)(scr + (64 * hb + 4 * i + kr) * 192 + n4 * 2) = (v2u){pg8::cvt_pk_bf16(x.x, x.y), pg8::cvt_pk_bf16(x.z, x.w)}; }
    }
    LDS_WAIT(); asm volatile("" ::: "memory");
    const int G = lane >> 4, li = lane & 15, q = li >> 2, p = li & 3;
    const LAS unsigned char* rb = scr + q * 192 + (16 * G + 4 * p) * 2;
    LAS unsigned char* t2 = scr + TRF_T1;
#pragma unroll
    for (int kq = 0; kq < 8; ++kq) {
        v2u t[4];
#pragma unroll
        for (int u = 0; u < 4; ++u) t[u] = __builtin_bit_cast(v2u, __builtin_amdgcn_ds_read_tr16_b64_v4i16((LAS v4i16_t*)(rb + (16 * kq + 4 * u) * 192)));
        v4u o;
        o.x = pk4_fp8(bflo(t[0].x), bfhi(t[0].x), bflo(t[0].y), bfhi(t[0].y)); o.y = pk4_fp8(bflo(t[1].x), bfhi(t[1].x), bflo(t[1].y), bfhi(t[1].y));
        o.z = pk4_fp8(bflo(t[2].x), bfhi(t[2].x), bflo(t[2].y), bfhi(t[2].y)); o.w = pk4_fp8(bflo(t[3].x), bfhi(t[3].x), bflo(t[3].y), bfhi(t[3].y));
        *(LAS v4u*)(t2 + (16 * G + li) * 144 + 16 * kq) = o;
    }
    LDS_WAIT(); asm volatile("" ::: "memory");
    const int r8 = lane >> 3, c8 = lane & 7;
#pragma unroll
    for (int j = 0; j < 8; ++j) { const v4u o = *(const LAS v4u*)(t2 + (8 * j + r8) * 144 + 16 * c8);
        *(v4u*)(WT + (drow0 + 8 * j + r8) * (size_t)ldk + k0 + 16 * c8) = o; }
    LDS_WAIT(); asm volatile("" ::: "memory");
}

constexpr int TRK = 128, TRN = 64;
constexpr int MOE_PREP_ITEMS = 32 * (1024 / TRK) * (2048 / TRN) + 32 * (1024 / TRK) * (1024 / TRN);
__device__ __forceinline__ void moe_weight_prep(Frame& F, int b0, int lo, int hi) {
    const float* fnw = F.in[10]; const float* w_gu = F.in[13]; const float* w_d = F.in[15];
    unsigned char* WguT = F.ws + WS_WGU; unsigned char* WdT = F.ws + WS_WD;
    constexpr int TW = 4;
    if (F.wave >= TW) return;
    LAS unsigned char* scr = F.lds + F.wave * TRF_BYTES;
    const int gw = ((int)blockIdx.x - b0) * TW + F.wave, NGW = (F.G - b0) * TW;
    constexpr int NKB = 1024 / TRK, NNB_GU = 2048 / TRN, NNB_D = 1024 / TRN, SEGN = 128 / TRN;
    constexpr int I_GU = 32 * NKB * NNB_GU;
    for (int it = lo + gw; it < hi; it += NGW) {
        int r = it;
        if (r < I_GU) { const int e = r / (NKB * NNB_GU), r2 = r % (NKB * NNB_GU), kb = r2 / NNB_GU, cb = r2 % NNB_GU;
            const int half = cb / (NNB_GU / 2), t = (cb % (NNB_GU / 2)) / SEGN, nb = cb % SEGN;
            tr_item8f(w_gu + (size_t)e * DM * 2048, 2048, kb * TRK, half * 1024 + t * 128 + nb * TRN, WguT, (size_t)e * 2048 + t * 256 + half * 128 + nb * TRN, DM, fnw, W8_SCALE, scr, F.lane); continue; } r -= I_GU;
        { const int e = r / (NKB * NNB_D), r2 = r % (NKB * NNB_D), kb = r2 / NNB_D, nb = r2 % NNB_D;
          tr_item8f(w_d + (size_t)e * DE * DM, DM, kb * TRK, nb * TRN, WdT, (size_t)e * 1024 + nb * TRN, DE, nullptr, W8_SCALE, scr, F.lane); }
    }
}
static_assert(4 * TRF_BYTES <= LDSCTL_OFF, "transposer LDS");
constexpr int MOE_PREP_SPLIT = 0;

__device__ __forceinline__ void phase_prep(Frame& F) {
    const float* x = F.in[0]; const float* anw = F.in[1]; const float* w_in = F.in[2]; const float* a_log = F.in[4]; const float* dt_bias = F.in[5];
    const float* pool_w = F.in[7]; const float* pool_scale = F.in[8]; const float* w_out = F.in[9]; const float* fnw = F.in[10];
    const float* w_router = F.in[11]; const float* w_gu = F.in[13]; const float* b_gu = F.in[14]; const float* w_d = F.in[15];
    bf16* WinT = (bf16*)(F.ws + WS_WIN); bf16* WoutT = (bf16*)(F.ws + WS_WOUT); bf16* WpoolT = (bf16*)(F.ws + WS_WPOOL);
    bf16* WguT = (bf16*)(F.ws + WS_WGU); bf16* WdT = (bf16*)(F.ws + WS_WD);
    bf16* WrI = (bf16*)(F.ws + WS_WR); float* bguP = (float*)(F.ws + WS_BGU);
    bf16* xb = (bf16*)(F.ws + WS_XB); float* rs1 = (float*)(F.ws + WS_RS1); float* betaA = (float*)(F.ws + WS_BETA); float* gA = (float*)(F.ws + WS_G);
    LAS unsigned char* scr = F.lds + F.wave * 12288;
    LAS float* W8T = (LAS float*)(F.lds + 98304);
    const int gw = F.vcu * NWAVES + F.wave, NGW = F.G * NWAVES;
    const int gt = F.vcu * 512 + F.tid, NGT = F.G * 512;
    for (int idx = F.tid; idx < 8192; idx += 512) { const int k = idx >> 3, c = idx & 7; W8T[c * 1024 + k] = anw[k] * w_in[(size_t)k * DIN + 2048 + c]; }
    __syncthreads();
    constexpr int I_IN1 = 16 * 32, I_OUT = 16 * 16;
    constexpr int NITEMS = I_IN1 + I_OUT;
    for (int it = gw; it < NITEMS; it += NGW) {
        int r = it;
        if (r < I_IN1) { const int kb = r / 32, nb = r % 32; tr_item(w_in, DIN, kb * 64, nb * 64, WinT, (size_t)nb * 64, DM, 0, anw, nullptr, scr, F.lane); continue; } r -= I_IN1;
        { const int kb = r / 16, nb = r % 16; tr_item(w_out, DM, kb * 64, nb * 64, WoutT, (size_t)nb * 64, DM, 0, nullptr, nullptr, scr, F.lane); }
    }
    __syncthreads();
    for (int task = blockIdx.x; task < 256; task += F.G) {
        const int g = task >> 6, kb = (task >> 2) & 15, dq = task & 3;
        LAS float* Wt = (LAS float*)F.lds;
        LAS float* Pw = (LAS float*)(F.lds + 33024);
        for (int idx = F.tid; idx < 64 * 32; idx += 512) { const int k = idx >> 5, c4 = (idx & 31) * 4; const f32x4 v = *(const f32x4*)(w_in + (size_t)(kb * 64 + k) * DIN + 2056 + g * 128 + c4);
            Wt[k * 129 + c4] = v.x; Wt[k * 129 + c4 + 1] = v.y; Wt[k * 129 + c4 + 2] = v.z; Wt[k * 129 + c4 + 3] = v.w; }
        for (int idx = F.tid; idx < 128 * 8; idx += 512) { const int c = idx >> 3, d4 = (idx & 7) * 4; *(LAS f32x4*)(Pw + c * 32 + d4) = *(const f32x4*)(pool_w + (size_t)g * 16384 + c * 128 + dq * 32 + d4); }
        __syncthreads();
        const int k = F.tid & 63, d4 = (F.tid >> 6) * 4;
        f32x4 acc = (f32x4){0.f, 0.f, 0.f, 0.f};
#pragma unroll 8
        for (int c = 0; c < 128; ++c) acc += *(const LAS f32x4*)(Pw + c * 32 + d4) * Wt[k * 129 + c];
        const int n0 = g * 128 + dq * 32 + d4; const f32x4 ps = *(const f32x4*)(pool_scale + n0); const float an = anw[kb * 64 + k];
        bf16* dst = WinT + (size_t)(2048 + n0) * DM + kb * 64 + k;
        dst[0] = (bf16)f2bf(acc.x * ps.x * an); dst[DM] = (bf16)f2bf(acc.y * ps.y * an); dst[2 * DM] = (bf16)f2bf(acc.z * ps.z * an); dst[3 * DM] = (bf16)f2bf(acc.w * ps.w * an);
        __syncthreads();
    }
    moe_weight_prep(F, 0, 0, MOE_PREP_SPLIT);
    for (int idx = gt; idx < NE * 2048; idx += NGT) { const int e = idx >> 11, r = idx & 2047, t = r >> 8, j = r & 255, half = j >> 7, jj = j & 127; bguP[idx] = b_gu[(size_t)e * 2048 + half * 1024 + t * 128 + jj]; }
    for (int idx = gt; idx < 64 * 64 * 8; idx += NGT) { const int j = idx & 7, ln = (idx >> 3) & 63, fr2 = idx >> 9, nb = fr2 & 1, ks = fr2 >> 1;
        const int k = 32 * ks + 8 * (ln >> 4) + j, e = 16 * nb + (ln & 15); const float v = fnw[k] * w_router[(size_t)k * NE + e];
        const unsigned hb = f2bf(v); const float hf = __builtin_bit_cast(float, hb << 16); const unsigned lb = f2bf(v - hf);
        WrI[((size_t)(fr2 * 2 + 0) * 64 + ln) * 8 + j] = (bf16)hb; WrI[((size_t)(fr2 * 2 + 1) * 64 + ln) * 8 + j] = (bf16)lb; }
    for (int m = gw; m < NTOK; m += NGW) {
        const f32x4* xr = (const f32x4*)(x + (size_t)m * DM) + F.lane;
        f32x4 v[4]; float ss = 0.f; float d8[8];
#pragma unroll
        for (int c = 0; c < 8; ++c) d8[c] = 0.f;
#pragma unroll
        for (int j = 0; j < 4; ++j) { v[j] = xr[64 * j]; ss += (v[j].x * v[j].x + v[j].y * v[j].y) + (v[j].z * v[j].z + v[j].w * v[j].w); }
#pragma unroll
        for (int c = 0; c < 8; ++c)
#pragma unroll
            for (int j = 0; j < 4; ++j) { const f32x4 w = *(const LAS f32x4*)(W8T + c * 1024 + 256 * j + 4 * F.lane); d8[c] += (v[j].x * w.x + v[j].y * w.y) + (v[j].z * w.z + v[j].w * w.w); }
        ss = wave_sum(ss);
#pragma unroll
        for (int c = 0; c < 8; ++c) d8[c] = wave_sum(d8[c]);
        const float rs = 1.f / sqrtf(ss * (1.f / DM) + 1e-6f);
        unsigned long long* o8 = (unsigned long long*)(xb + (size_t)m * DM) + F.lane;
#pragma unroll
        for (int j = 0; j < 4; ++j) o8[64 * j] = (unsigned long long)pk2(v[j].x, v[j].y) | ((unsigned long long)pk2(v[j].z, v[j].w) << 32);
        if (F.lane == 0) rs1[m] = rs;
        if (F.lane < 4) {
            float bl = 0.f, al = 0.f;
#pragma unroll
            for (int c = 0; c < 4; ++c) { bl = (F.lane == c) ? d8[c] : bl; al = (F.lane == c) ? d8[4 + c] : al; }
            bl *= rs; al *= rs;
            betaA[(size_t)m * 4 + F.lane] = 1.f / (1.f + expf(-bl));
            const float z = al + dt_bias[F.lane]; const float sp = z > 20.f ? z : log1pf(expf(z));
            gA[(size_t)m * 4 + F.lane] = -expf(a_log[F.lane]) * sp;
        }
    }
}

__device__ __forceinline__ void phase_mix(Frame& F) {
    const bf16* proj = (const bf16*)(F.ws + WS_PROJ); bf16* mixed = (bf16*)(F.ws + WS_CONCAT) + 512;
    const int gw = F.vcu * NWAVES + F.wave, NGW = F.G * NWAVES;
    const int ch = 8 * F.lane, gi = F.lane >> 4, win = 2 << gi, hal = win - 1;
    for (int rbk = gw; rbk < NTOK / 16; rbk += NGW) {
        const int m0 = rbk * 16, t0 = m0 % SEQ;
        v4u X[31];
#pragma unroll
        for (int k = 0; k < 31; ++k) { X[k] = (v4u){0u, 0u, 0u, 0u}; if (k >= 15 - hal && t0 - 15 + k >= 0) X[k] = *(const v4u*)(proj + (size_t)(m0 - 15 + k) * NPROJ + 2048 + ch); }
        float s[8];
#pragma unroll
        for (int q = 0; q < 8; ++q) s[q] = 0.f;
#pragma unroll
        for (int k = 0; k < 15; ++k) { s[0] += bflo(X[k].x); s[1] += bfhi(X[k].x); s[2] += bflo(X[k].y); s[3] += bfhi(X[k].y); s[4] += bflo(X[k].z); s[5] += bfhi(X[k].z); s[6] += bflo(X[k].w); s[7] += bfhi(X[k].w); }
#pragma unroll
        for (int r = 0; r < 16; ++r) {
            const v4u u = X[15 + r];
            const float p[8] = {bflo(u.x), bfhi(u.x), bflo(u.y), bfhi(u.y), bflo(u.z), bfhi(u.z), bflo(u.w), bfhi(u.w)};
#pragma unroll
            for (int q = 0; q < 8; ++q) s[q] += p[q];
            const int tt = t0 + r + 1; const float ic = 1.f / (float)(tt < win ? tt : win);
            v4u o; o.x = pk2(s[0] * ic - p[0], s[1] * ic - p[1]); o.y = pk2(s[2] * ic - p[2], s[3] * ic - p[3]); o.z = pk2(s[4] * ic - p[4], s[5] * ic - p[5]); o.w = pk2(s[6] * ic - p[6], s[7] * ic - p[7]);
            *(v4u*)(mixed + (size_t)(m0 + r) * DM + ch) = o;
            const v4u od = gi == 0 ? X[14 + r] : gi == 1 ? X[12 + r] : gi == 2 ? X[8 + r] : X[r];
            s[0] -= bflo(od.x); s[1] -= bfhi(od.x); s[2] -= bflo(od.y); s[3] -= bfhi(od.y); s[4] -= bflo(od.z); s[5] -= bfhi(od.z); s[6] -= bflo(od.w); s[7] -= bfhi(od.w);
        }
    }
}

typedef float f32x16 __attribute__((ext_vector_type(16)));
__device__ __forceinline__ bf16x8 pack8(const f32x4 a, const f32x4 b) {
    v4u w; w.x = cvt_pk_bf16(a[0], a[1]); w.y = cvt_pk_bf16(a[2], a[3]); w.z = cvt_pk_bf16(b[0], b[1]); w.w = cvt_pk_bf16(b[2], b[3]);
    return __builtin_bit_cast(bf16x8, w);
}
__device__ __forceinline__ void fmac_(float& acc, float a, float b) { asm("v_fmac_f32 %0, %1, %2" : "+v"(acc) : "v"(a), "v"(b)); }
__device__ __forceinline__ float bf2f(unsigned short u) { return __builtin_bit_cast(float, (unsigned)u << 16); }

constexpr int SOLVE_D = 5;
struct RQ { int i, j; };
__host__ __device__ constexpr int solve_nq(int i) { return (i + 3) / 4; }
__host__ __device__ constexpr RQ solve_adv(int i, int j, int d) { while (d-- > 0 && i < 64) { if (j + 1 < solve_nq(i)) ++j; else { ++i; j = 0; } } return RQ{i, j}; }
template <int I, int J> __device__ __forceinline__ void solve_step(float (&U)[64], const LAS float* Am, const f32x4 (&win)[SOLVE_D], float s0, float s1, float s2, float s3) {
    if constexpr (I < 64) {
        constexpr RQ P = solve_adv(I, J, SOLVE_D);
        f32x4 nw = (f32x4){0.f, 0.f, 0.f, 0.f};
        if constexpr (P.i < 64) nw = *(const LAS f32x4*)(Am + P.i * 64 + 4 * P.j);
        const f32x4 a = win[0];
        fmac_(s0, a.x, U[4 * J]); if constexpr (4 * J + 1 < I) fmac_(s1, a.y, U[4 * J + 1]); if constexpr (4 * J + 2 < I) fmac_(s2, a.z, U[4 * J + 2]); if constexpr (4 * J + 3 < I) fmac_(s3, a.w, U[4 * J + 3]);
        f32x4 nx[SOLVE_D];
#pragma unroll
        for (int q = 0; q + 1 < SOLVE_D; ++q) nx[q] = win[q + 1];
        nx[SOLVE_D - 1] = nw;
        __builtin_amdgcn_sched_barrier(0);
        if constexpr (J + 1 < solve_nq(I)) solve_step<I, J + 1>(U, Am, nx, s0, s1, s2, s3);
        else { U[I] -= (s0 + s1) + (s2 + s3); solve_step<I + 1, 0>(U, Am, nx, 0.f, 0.f, 0.f, 0.f); }
    }
}
__device__ __forceinline__ void solve_all(float (&U)[64], const LAS float* Am) {
    f32x4 win[SOLVE_D];
#pragma unroll
    for (int q = 0; q < SOLVE_D; ++q) { constexpr RQ dummy{0, 0}; (void)dummy; }
    { constexpr RQ p0 = solve_adv(1, 0, 0), p1 = solve_adv(1, 0, 1), p2 = solve_adv(1, 0, 2), p3 = solve_adv(1, 0, 3), p4 = solve_adv(1, 0, 4);
      win[0] = *(const LAS f32x4*)(Am + p0.i * 64 + 4 * p0.j); win[1] = *(const LAS f32x4*)(Am + p1.i * 64 + 4 * p1.j); win[2] = *(const LAS f32x4*)(Am + p2.i * 64 + 4 * p2.j);
      win[3] = *(const LAS f32x4*)(Am + p3.i * 64 + 4 * p3.j); win[4] = *(const LAS f32x4*)(Am + p4.i * 64 + 4 * p4.j); }
    static_assert(SOLVE_D == 5, "window priming is written for SOLVE_D = 5");
    solve_step<1, 0>(U, Am, win, 0.f, 0.f, 0.f, 0.f);
}

constexpr int CP_QN = 0, CP_KN = 17408, CP_VA = 34816, CP_QKL = 51200, CP_SC = 59392, CP_HALF = 60416, CP_CW = 2 * CP_HALF;
__device__ __forceinline__ void phase_chunk(Frame& F, int blk0, int nblk, int n_lo, int n_cnt) {
    const float* conv_w = F.in[3];
    const bf16* proj = (const bf16*)(F.ws + WS_PROJ);
    const float* betaA = (const float*)(F.ws + WS_BETA); const float* gA = (const float*)(F.ws + WS_G);
    float* gtotA = (float*)(F.ws + WS_GTOT);
    const int half = F.wave >> 2, hw = F.wave & 3;
    LAS unsigned char* L = F.lds + half * CP_HALF;
    LAS bf16* qn = (LAS bf16*)(L + CP_QN); LAS bf16* kn = (LAS bf16*)(L + CP_KN); LAS bf16* vn = (LAS bf16*)(L + CP_VA);
    LAS float* Am = (LAS float*)(L + CP_VA); LAS bf16* qkL = (LAS bf16*)(L + CP_QKL); LAS float* sc = (LAS float*)(L + CP_SC);
    LAS float* cwL = (LAS float*)(F.lds + CP_CW);
    for (int idx = F.tid; idx < 4 * 1536 / 4; idx += 512) *(LAS f32x4*)(cwL + 4 * idx) = *(const f32x4*)(conv_w + 4 * idx);
    __syncthreads();
    const int nunits = NB * NH * n_cnt, nrounds = (nunits + 2 * nblk - 1) / (2 * nblk);
#pragma unroll 1
    for (int it = 0; it < nrounds; ++it) {
        int tid_ = F.tid; asm volatile("" : "+v"(tid_));
        const int ht = tid_ & 255, lane = tid_ & 63, r16 = lane & 15, gq = lane >> 4;
        int v_ = (it * nblk + ((int)blockIdx.x - blk0)) * 2 + half; asm volatile("" : "+s"(v_));
        const bool live = v_ < nunits;
        const int bh = live ? v_ / n_cnt : 0, n = live ? n_lo + v_ % n_cnt : 0, b = bh >> 2, h = bh & 3; const int unit = bh * 64 + n;
        const size_t m0 = (size_t)b * SEQ + (size_t)n * 64;
        unsigned char* chunk = F.ws + WS_CHUNK + (size_t)unit * CH_BYTES;
        const int rq = ht >> 4, cg = ht & 15;
        v4u Xa[7], Xb[7]; float gi = 0.f, bi = 0.f;
#define CHUNK_LOADX(X, p_) do { _Pragma("unroll") for (int jj = 0; jj < 7; ++jj) { const int trow = n * 64 + 4 * rq - 3 + jj; const int trc = trow < 0 ? 0 : trow; \
            const v4u u_ = *(const v4u*)(proj + ((size_t)b * SEQ + trc) * NPROJ + (p_) * 512 + h * 128 + 8 * cg); const unsigned mk_ = trow < 0 ? 0u : 0xffffffffu; \
            X[jj] = (v4u){u_.x & mk_, u_.y & mk_, u_.z & mk_, u_.w & mk_}; } } while (0)
#define CHUNK_CONV(X, p_) do { const int col = (p_) * 512 + h * 128 + 8 * cg; float wv[4][8]; \
            _Pragma("unroll") for (int j = 0; j < 4; ++j) { const f32x4 w0 = *(const LAS f32x4*)(cwL + j * 1536 + col), w1 = *(const LAS f32x4*)(cwL + j * 1536 + col + 4); \
                wv[j][0] = w0.x; wv[j][1] = w0.y; wv[j][2] = w0.z; wv[j][3] = w0.w; wv[j][4] = w1.x; wv[j][5] = w1.y; wv[j][6] = w1.z; wv[j][7] = w1.w; } \
            _Pragma("unroll") for (int rr = 0; rr < 4; ++rr) { float y[8]; \
                _Pragma("unroll") for (int q = 0; q < 8; ++q) y[q] = 0.f; \
                _Pragma("unroll") for (int j = 0; j < 4; ++j) { const v4u u = X[rr + j]; \
                    fmac_(y[0], wv[j][0], bflo(u.x)); fmac_(y[1], wv[j][1], bfhi(u.x)); fmac_(y[2], wv[j][2], bflo(u.y)); fmac_(y[3], wv[j][3], bfhi(u.y)); \
                    fmac_(y[4], wv[j][4], bflo(u.z)); fmac_(y[5], wv[j][5], bfhi(u.z)); fmac_(y[6], wv[j][6], bflo(u.w)); fmac_(y[7], wv[j][7], bfhi(u.w)); } \
                float ss = 0.f; \
                _Pragma("unroll") for (int q = 0; q < 8; ++q) { y[q] = siluf_(y[q]); ss += y[q] * y[q]; } \
                float scl = 1.f; \
                if ((p_) < 2) { ss += __shfl_xor(ss, 1); ss += __shfl_xor(ss, 2); ss += __shfl_xor(ss, 4); ss += __shfl_xor(ss, 8); scl = frsq_(ss + 1e-6f); if ((p_) == 0) scl *= 0.08838834764831845f; } \
                v4u o; o.x = cvt_pk_bf16(y[0] * scl, y[1] * scl); o.y = cvt_pk_bf16(y[2] * scl, y[3] * scl); o.z = cvt_pk_bf16(y[4] * scl, y[5] * scl); o.w = cvt_pk_bf16(y[6] * scl, y[7] * scl); \
                const int row = 4 * rq + rr; \
                if ((p_) == 0) *(LAS v4u*)(qn + row * 136 + 8 * cg) = o; else if ((p_) == 1) *(LAS v4u*)(kn + row * 136 + 8 * cg) = o; else *(LAS v4u*)(vn + row * 128 + 8 * cg) = o; \
                __builtin_amdgcn_sched_barrier(0); } } while (0)
        if (live) { CHUNK_LOADX(Xa, 0); CHUNK_LOADX(Xb, 1); if (hw == 0) { gi = gA[(m0 + lane) * 4 + h]; bi = betaA[(m0 + lane) * 4 + h]; } }
        if (live && hw == 0) {
            float c = gi;
#pragma unroll
            for (int o = 1; o < 64; o <<= 1) { const float tt = __shfl_up(c, o); if (lane >= o) c += tt; }
            const float gl = __shfl(c, 63);
            sc[lane] = bi; sc[64 + lane] = c; sc[128 + lane] = fexp_(c); sc[192 + lane] = fexp_(gl - c);
            if (lane == 63) gtotA[unit] = fexp_(c);
        }
        if (live) { CHUNK_CONV(Xa, 0); CHUNK_LOADX(Xa, 2); CHUNK_CONV(Xb, 1); CHUNK_CONV(Xa, 2); }
#undef CHUNK_LOADX
#undef CHUNK_CONV
        __syncthreads();
        const int which = ht >> 7, c = ht & 127;
        float U[64];
        if (live) {
#pragma unroll
            for (int i = 0; i < 64; ++i) { const float bi = sc[i]; const float tv = which ? bf2f(kn[i * 136 + c]) * sc[128 + i] : bf2f(vn[i * 128 + c]); U[i] = tv * bi; }
        } else {
#pragma unroll
            for (int i = 0; i < 64; ++i) U[i] = 0.f;
        }
        __syncthreads();
        if (live) {
            const int ti = hw >> 1, tj = hw & 1, r = lane & 31, hh = lane >> 5;
            f32x16 KK, QK;
#pragma unroll
            for (int q = 0; q < 16; ++q) { KK[q] = 0.f; QK[q] = 0.f; }
#pragma unroll
            for (int ks = 0; ks < 8; ++ks) {
                const bf16x8 ak = *(const LAS bf16x8*)(kn + (ti * 32 + r) * 136 + 16 * ks + 8 * hh);
                const bf16x8 aq = *(const LAS bf16x8*)(qn + (ti * 32 + r) * 136 + 16 * ks + 8 * hh);
                const bf16x8 bb = *(const LAS bf16x8*)(kn + (tj * 32 + r) * 136 + 16 * ks + 8 * hh);
                KK = __builtin_amdgcn_mfma_f32_32x32x16_bf16(ak, bb, KK, 0, 0, 0);
                QK = __builtin_amdgcn_mfma_f32_32x32x16_bf16(aq, bb, QK, 0, 0, 0);
            }
            const int j = tj * 32 + r; const float gcj = sc[64 + j];
#pragma unroll
            for (int reg = 0; reg < 16; ++reg) { const int i = ti * 32 + (reg & 3) + 8 * (reg >> 2) + 4 * hh;
                const float dec = (i >= j) ? __expf(sc[64 + i] - gcj) : 0.f;
                Am[i * 64 + j] = (i > j) ? sc[i] * KK[reg] * dec : 0.f;
                qkL[i * 64 + j] = (bf16)f2bf((i >= j) ? QK[reg] * dec : 0.f); }
        }
        __syncthreads();
        if (live) {
#pragma unroll
            for (int fi = 0; fi < 4; ++fi) { const int f = hw * 4 + fi, mb = f >> 2, ks = f & 3, row = 16 * mb + r16; const float s = sc[128 + row];
                const v2u lo = *(const LAS v2u*)(qn + row * 136 + 32 * ks + 4 * gq), hi = *(const LAS v2u*)(qn + row * 136 + 32 * ks + 16 + 4 * gq);
                v4u o; o.x = pk2(bflo(lo.x) * s, bfhi(lo.x) * s); o.y = pk2(bflo(lo.y) * s, bfhi(lo.y) * s); o.z = pk2(bflo(hi.x) * s, bfhi(hi.x) * s); o.w = pk2(bflo(hi.y) * s, bfhi(hi.y) * s);
                *(v4u*)(chunk + CH_QD + (f * 64 + lane) * 16) = o; }
#pragma unroll
            for (int fi = 0; fi < 4; ++fi) { const int f = hw * 4 + fi, db = f >> 1, ksp = f & 1, dcol = 16 * db + r16; float e[8];
#pragma unroll
                for (int j = 0; j < 8; ++j) { const int i = 32 * ksp + 16 * (j >> 2) + 4 * gq + (j & 3); e[j] = bf2f(kn[i * 136 + dcol]) * sc[192 + i]; }
                v4u o; o.x = pk2(e[0], e[1]); o.y = pk2(e[2], e[3]); o.z = pk2(e[4], e[5]); o.w = pk2(e[6], e[7]);
                *(v4u*)(chunk + CH_KT + (f * 64 + lane) * 16) = o; }
#pragma unroll
            for (int fi = 0; fi < 2; ++fi) { const int f = hw * 2 + fi, mb = f >> 1, ksp = f & 1, row = 16 * mb + r16;
                const v2u lo = *(const LAS v2u*)(qkL + row * 64 + 32 * ksp + 4 * gq), hi = *(const LAS v2u*)(qkL + row * 64 + 32 * ksp + 16 + 4 * gq);
                *(v4u*)(chunk + CH_QK + (f * 64 + lane) * 16) = (v4u){lo.x, lo.y, hi.x, hi.y}; }
            solve_all(U, Am);
        }
        __syncthreads();
        if (live) {
            if (which == 0) {
                const int w8 = c >> 4, cl = c & 15;
                unsigned char* ub = F.ws + WS_UC + (size_t)unit * UC_BYTES;
#pragma unroll
                for (int g = 0; g < 4; ++g) {
                    v4u lo, hi;
                    lo.x = pk2(U[4 * g], U[4 * g + 1]); lo.y = pk2(U[4 * g + 2], U[4 * g + 3]); lo.z = pk2(U[16 + 4 * g], U[16 + 4 * g + 1]); lo.w = pk2(U[16 + 4 * g + 2], U[16 + 4 * g + 3]);
                    hi.x = pk2(U[32 + 4 * g], U[32 + 4 * g + 1]); hi.y = pk2(U[32 + 4 * g + 2], U[32 + 4 * g + 3]); hi.z = pk2(U[48 + 4 * g], U[48 + 4 * g + 1]); hi.w = pk2(U[48 + 4 * g + 2], U[48 + 4 * g + 3]);
                    v4u* dst = (v4u*)(ub + ((w8 * 64 + g * 16 + cl) * 32)); dst[0] = lo; dst[1] = hi;
                }
            } else {
#pragma unroll
                for (int i = 0; i < 64; ++i) qn[i * 136 + c] = (bf16)f2bf(U[i]);
            }
        }
        __syncthreads();
        if (live) {
#pragma unroll
            for (int fi = 0; fi < 4; ++fi) { const int f = hw * 4 + fi, mb = f >> 2, ks = f & 3, row = 16 * mb + r16;
                const v2u lo = *(const LAS v2u*)(qn + row * 136 + 32 * ks + 4 * gq), hi = *(const LAS v2u*)(qn + row * 136 + 32 * ks + 16 + 4 * gq);
                *(v4u*)(chunk + CH_WF + (f * 64 + lane) * 16) = (v4u){lo.x, lo.y, hi.x, hi.y}; }
        }
        __syncthreads();
    }
}

constexpr int SCAN_SPLIT = 32;
constexpr int SC_STAGED = 49152, SC_NLOAD = 16;
struct ScanU { v4u u0, u1; };
struct ScanQ { v4u q[8]; };
__device__ __forceinline__ void scan_issue_u(ScanU& R, const unsigned char* up) {
    asm volatile("global_load_dwordx4 %0, %1, off" : "=v"(R.u0) : "v"(up) : "memory");
    asm volatile("global_load_dwordx4 %0, %1, off offset:16" : "=v"(R.u1) : "v"(up) : "memory");
}
__device__ __forceinline__ void scan_issue_q(ScanQ& R, const unsigned char* qp) {
    asm volatile("global_load_dwordx4 %0, %1, off" : "=v"(R.q[0]) : "v"(qp) : "memory");
    asm volatile("global_load_dwordx4 %0, %1, off offset:1024" : "=v"(R.q[1]) : "v"(qp) : "memory");
    asm volatile("global_load_dwordx4 %0, %1, off offset:2048" : "=v"(R.q[2]) : "v"(qp) : "memory");
    asm volatile("global_load_dwordx4 %0, %1, off offset:3072" : "=v"(R.q[3]) : "v"(qp) : "memory");
    const unsigned char* qp2 = qp + 4096;
    asm volatile("global_load_dwordx4 %0, %1, off" : "=v"(R.q[4]) : "v"(qp2) : "memory");
    asm volatile("global_load_dwordx4 %0, %1, off offset:1024" : "=v"(R.q[5]) : "v"(qp2) : "memory");
    asm volatile("global_load_dwordx4 %0, %1, off offset:2048" : "=v"(R.q[6]) : "v"(qp2) : "memory");
    asm volatile("global_load_dwordx4 %0, %1, off offset:3072" : "=v"(R.q[7]) : "v"(qp2) : "memory");
}
#define SCAN_WAIT_REGS(U, Q, cnt) asm volatile("s_waitcnt vmcnt(" #cnt ")" : "+v"(U.u0), "+v"(U.u1), "+v"(Q.q[0]), "+v"(Q.q[1]), "+v"(Q.q[2]), "+v"(Q.q[3]), "+v"(Q.q[4]), "+v"(Q.q[5]), "+v"(Q.q[6]), "+v"(Q.q[7]) :: "memory")
template <class Bar> __device__ __forceinline__ void phase_scan(Frame& F, const Bar& mid_barrier) {
    const int bh = blockIdx.x, b = bh >> 2, h = bh & 3, w = F.wave, lane = F.lane, cl = lane & 15, gq = lane >> 4;
    const float* gtotA = (const float*)(F.ws + WS_GTOT);
    const int unit0 = bh * 64;
    const unsigned char* cbase = F.ws + WS_CHUNK + (size_t)unit0 * CH_BYTES;
    const unsigned char* ubase = F.ws + WS_UC + (size_t)unit0 * UC_BYTES + (w * 64 + lane) * 32;
    const unsigned char* qbase = cbase + CH_QK + lane * 16;
    bf16* op = (bf16*)(F.ws + WS_ORAW) + ((size_t)b * SEQ + cl) * 512 + h * 128 + 16 * w + 4 * gq;
    f32x4 Sacc[8]; bf16x8 Sb[4];
#pragma unroll
    for (int d = 0; d < 8; ++d) Sacc[d] = (f32x4){0.f, 0.f, 0.f, 0.f};
#pragma unroll
    for (int k = 0; k < 4; ++k) Sb[k] = (bf16x8){0, 0, 0, 0, 0, 0, 0, 0};
    v2u Ow[4];
#pragma unroll
    for (int mb = 0; mb < 4; ++mb) Ow[mb] = (v2u){0u, 0u};
    ScanU U0, U1, U2; ScanQ QA, QB;
#define SCAN_ISSUE(nn) do { const unsigned char* s_ = cbase + (size_t)(nn) * CH_BYTES + (w * 6) * 1024 + lane * 16; LAS unsigned char* d_ = F.lds + ((nn) % 3) * SC_STAGED + (w * 6) * 1024; \
        _Pragma("unroll") for (int k_ = 0; k_ < 6; ++k_) __builtin_amdgcn_global_load_lds((const unsigned*)(s_ + k_ * 1024), (LAS unsigned*)(d_ + k_ * 1024), 16, 0, 0); } while (0)
#define SCAN_STEP(n, UC, UN, Q, ISSUE2, WAITCNT) do { \
        SCAN_WAIT_REGS(UC, Q, WAITCNT); asm volatile("s_waitcnt lgkmcnt(0)" ::: "memory"); __builtin_amdgcn_s_barrier(); asm volatile("" ::: "memory"); \
        const float gt = __shfl(gtv, (n) & 31); \
        if (ISSUE2) { scan_issue_u(UN, ubase + (size_t)((n) + 2) * UC_BYTES); SCAN_ISSUE((n) + 2); } \
        if ((n) > 0) { _Pragma("unroll") for (int mb = 0; mb < 4; ++mb) *(v2u*)(op + (size_t)(((n) - 1) * 64 + 16 * mb) * 512) = Ow[mb]; } \
        const LAS unsigned char* B = F.lds + ((n) % 3) * SC_STAGED; \
        f32x4 P[4]; \
        _Pragma("unroll") for (int mb = 0; mb < 4; ++mb) { P[mb] = (f32x4){0.f, 0.f, 0.f, 0.f}; \
            _Pragma("unroll") for (int ks = 0; ks < 4; ++ks) P[mb] = __builtin_amdgcn_mfma_f32_16x16x32_bf16(SFRAG(CH_WF, mb * 4 + ks), Sb[ks], P[mb], 0, 0, 0); } \
        f32x4 vnw[4]; \
        vnw[0] = (f32x4){bflo(UC.u0.x), bfhi(UC.u0.x), bflo(UC.u0.y), bfhi(UC.u0.y)} - P[0]; \
        vnw[1] = (f32x4){bflo(UC.u0.z), bfhi(UC.u0.z), bflo(UC.u0.w), bfhi(UC.u0.w)} - P[1]; \
        vnw[2] = (f32x4){bflo(UC.u1.x), bfhi(UC.u1.x), bflo(UC.u1.y), bfhi(UC.u1.y)} - P[2]; \
        vnw[3] = (f32x4){bflo(UC.u1.z), bfhi(UC.u1.z), bflo(UC.u1.w), bfhi(UC.u1.w)} - P[3]; \
        bf16x8 Vb[2]; Vb[0] = pack8(vnw[0], vnw[1]); Vb[1] = pack8(vnw[2], vnw[3]); \
        _Pragma("unroll") for (int mb = 0; mb < 4; ++mb) { f32x4 OT = (f32x4){0.f, 0.f, 0.f, 0.f}; \
            _Pragma("unroll") for (int ks = 0; ks < 4; ++ks) OT = __builtin_amdgcn_mfma_f32_16x16x32_bf16(Sb[ks], SFRAG(CH_QD, mb * 4 + ks), OT, 0, 0, 0); \
            _Pragma("unroll") for (int ksp = 0; ksp < 2; ++ksp) OT = __builtin_amdgcn_mfma_f32_16x16x32_bf16(Vb[ksp], __builtin_bit_cast(bf16x8, Q.q[mb * 2 + ksp]), OT, 0, 0, 0); \
            Ow[mb] = (v2u){cvt_pk_bf16(OT[0], OT[1]), cvt_pk_bf16(OT[2], OT[3])}; } \
        asm volatile("s_nop 7" : "+v"(Q.q[0]), "+v"(Q.q[1]), "+v"(Q.q[2]), "+v"(Q.q[3]), "+v"(Q.q[4]), "+v"(Q.q[5]), "+v"(Q.q[6]), "+v"(Q.q[7]));     \
        if (ISSUE2) scan_issue_q(Q, qbase + (size_t)((n) + 2) * CH_BYTES); \
        _Pragma("unroll") for (int db = 0; db < 8; ++db) { Sacc[db] = Sacc[db] * gt; \
            _Pragma("unroll") for (int ksp = 0; ksp < 2; ++ksp) Sacc[db] = __builtin_amdgcn_mfma_f32_16x16x32_bf16(SFRAG(CH_KT, db * 2 + ksp), Vb[ksp], Sacc[db], 0, 0, 0); } \
        _Pragma("unroll") for (int ks = 0; ks < 4; ++ks) Sb[ks] = pack8(Sacc[2 * ks], Sacc[2 * ks + 1]); \
    } while (0)
#define SFRAG(off, f) (*(const LAS bf16x8*)(B + (off) + ((f) * 64 + lane) * 16))
    static_assert(CH_WF == 0 && CH_QD == 16384 && CH_KT == 32768 && CH_QK == SC_STAGED && SCAN_SPLIT % 6 == 2 && 2 * SCAN_SPLIT == 64, "staged part = the first 48 KiB of a chunk; a half = 5 x 6 + 2 steps");
#pragma unroll 1
    for (int part = 0; part < 2; ++part) {
        const int n0 = part * SCAN_SPLIT;
        float gtv = gtotA[unit0 + n0 + (lane & 31)];
        asm volatile("s_waitcnt vmcnt(0)" : "+v"(gtv) :: "memory");
        scan_issue_u(U0, ubase + (size_t)n0 * UC_BYTES); SCAN_ISSUE(n0); scan_issue_q(QA, qbase + (size_t)n0 * CH_BYTES);
        scan_issue_u(U1, ubase + (size_t)(n0 + 1) * UC_BYTES); SCAN_ISSUE(n0 + 1); scan_issue_q(QB, qbase + (size_t)(n0 + 1) * CH_BYTES);
#pragma unroll 1
        for (int n = n0; n < n0 + SCAN_SPLIT - 2; n += 6) {
            SCAN_STEP(n, U0, U2, QA, true, 16);
            SCAN_STEP(n + 1, U1, U0, QB, true, 16);
            SCAN_STEP(n + 2, U2, U1, QA, true, 16);
            SCAN_STEP(n + 3, U0, U2, QB, true, 16);
            SCAN_STEP(n + 4, U1, U0, QA, true, 16);
            SCAN_STEP(n + 5, U2, U1, QB, true, 16);
        }
        SCAN_STEP(n0 + SCAN_SPLIT - 2, U0, U2, QA, false, 16);
        SCAN_STEP(n0 + SCAN_SPLIT - 1, U1, U0, QB, false, 0);
        if (part == 0) mid_barrier();
    }
#undef SFRAG
#undef SCAN_STEP
#undef SCAN_ISSUE
#pragma unroll
    for (int mb = 0; mb < 4; ++mb) *(v2u*)(op + (size_t)(63 * 64 + 16 * mb) * 512) = Ow[mb];
    VM_WAIT(); __syncthreads();
}

__device__ __forceinline__ void phase_onorm(Frame& F) {
    const float* dnw = F.in[6]; const bf16* proj = (const bf16*)(F.ws + WS_PROJ); const bf16* oraw = (const bf16*)(F.ws + WS_ORAW); bf16* concat = (bf16*)(F.ws + WS_CONCAT);
    const int gw = F.vcu * NWAVES + F.wave, NGW = F.G * NWAVES, lane = F.lane;
    const int cc = 8 * (lane & 15);
    const f32x4 d0 = *(const f32x4*)(dnw + cc), d1 = *(const f32x4*)(dnw + cc + 4);
    for (int m = gw; m < NTOK; m += NGW) {
        const v4u o = *(const v4u*)(oraw + (size_t)m * 512 + 8 * lane);
        const v4u z = *(const v4u*)(proj + (size_t)m * NPROJ + 1536 + 8 * lane);
        const float ov[8] = {bflo(o.x), bfhi(o.x), bflo(o.y), bfhi(o.y), bflo(o.z), bfhi(o.z), bflo(o.w), bfhi(o.w)};
        const float zv[8] = {bflo(z.x), bfhi(z.x), bflo(z.y), bfhi(z.y), bflo(z.z), bfhi(z.z), bflo(z.w), bfhi(z.w)};
        float ss = 0.f;
#pragma unroll
        for (int q = 0; q < 8; ++q) ss += ov[q] * ov[q];
        ss += __shfl_xor(ss, 1); ss += __shfl_xor(ss, 2); ss += __shfl_xor(ss, 4); ss += __shfl_xor(ss, 8);
        const float rs = frsq_(ss * (1.f / 128.f) + 1e-6f);
        const float dv[8] = {d0.x, d0.y, d0.z, d0.w, d1.x, d1.y, d1.z, d1.w};
        float r[8];
#pragma unroll
        for (int q = 0; q < 8; ++q) r[q] = ov[q] * rs * dv[q] * siluf_(zv[q]);
        *(v4u*)(concat + (size_t)m * DM + 8 * lane) = (v4u){cvt_pk_bf16(r[0], r[1]), cvt_pk_bf16(r[2], r[3]), cvt_pk_bf16(r[4], r[5]), cvt_pk_bf16(r[6], r[7])};
    }
}

__device__ __forceinline__ void phase_route(Frame& F) {
    const bf16* x1 = (const bf16*)(F.ws + WS_X1); const float* b_router = F.in[12];
    unsigned char* x1b = F.ws + WS_X1B; float* rs2A = (float*)(F.ws + WS_RS2); int* list = (int*)(F.ws + WS_LIST);
    float* rsl = (float*)(F.ws + WS_RSL); float* gwl = (float*)(F.ws + WS_GWL);
    unsigned* cntw = (unsigned*)(F.ws + WS_CTL) + CW_CNT;
    LAS unsigned char* WI = F.lds;
    LAS unsigned* lcnt = (LAS unsigned*)(F.lds + TAB_OFF);
    { const v4u* src = (const v4u*)(F.ws + WS_WR);
      for (int idx = F.tid; idx < 131072 / 16; idx += 512) *(LAS v4u*)(WI + 16 * idx) = src[idx]; }
    const int lane = F.lane, c = lane & 15, g = lane >> 4;
    const int gw = F.vcu * NWAVES + F.wave, NGW = F.G * NWAVES, NT = NTOK / 16;
    const float bia0 = b_router[c], bia1 = b_router[16 + c];
    for (int t0 = 0; t0 < NT; t0 += NGW) {
        const int tile = t0 + gw; const bool live = tile < NT;
        if (F.tid < 64) lcnt[F.tid] = 0u;
        __syncthreads();
        int my_e = 0; float my_g = 0.f, my_rs = 0.f; unsigned my_rank = 0u; int my_ent = 0;
        if (live) {
            const int m0 = tile * 16;
            const bf16* xrow = x1 + (size_t)(m0 + c) * DM + 8 * g;
            unsigned char* xbrow = x1b + (size_t)(m0 + c) * DM + 8 * g;
            f32x4 acc0 = (f32x4){0.f, 0.f, 0.f, 0.f}, acc1 = acc0; float ssq = 0.f;
#pragma unroll 1
            for (int kb = 0; kb < 2; ++kb) {
                v4u xa[16];
#pragma unroll
                for (int q = 0; q < 16; ++q) xa[q] = *(const v4u*)(xrow + 32 * (kb * 16 + q));
#pragma unroll
                for (int q = 0; q < 16; ++q) { const int ks = kb * 16 + q; const v4u h = xa[q];
                    const float a0 = bflo(h.x), a1 = bfhi(h.x), a2 = bflo(h.y), a3 = bfhi(h.y), b0 = bflo(h.z), b1 = bfhi(h.z), b2 = bflo(h.w), b3 = bfhi(h.w);
                    ssq += (a0 * a0 + a1 * a1) + (a2 * a2 + a3 * a3) + (b0 * b0 + b1 * b1) + (b2 * b2 + b3 * b3);
                    *(v2u*)(xbrow + 32 * ks) = (v2u){pk4_fp8(a0, a1, a2, a3), pk4_fp8(b0, b1, b2, b3)};
                    const bf16x8 ah = __builtin_bit_cast(bf16x8, h);
                    const LAS unsigned char* fb = WI + (size_t)(ks * 4) * 1024 + lane * 16;
                    const bf16x8 b0h = *(const LAS bf16x8*)(fb), b0l = *(const LAS bf16x8*)(fb + 1024), b1h = *(const LAS bf16x8*)(fb + 2048), b1l = *(const LAS bf16x8*)(fb + 3072);
                    acc0 = __builtin_amdgcn_mfma_f32_16x16x32_bf16(ah, b0h, acc0, 0, 0, 0); acc0 = __builtin_amdgcn_mfma_f32_16x16x32_bf16(ah, b0l, acc0, 0, 0, 0);
                    acc1 = __builtin_amdgcn_mfma_f32_16x16x32_bf16(ah, b1h, acc1, 0, 0, 0); acc1 = __builtin_amdgcn_mfma_f32_16x16x32_bf16(ah, b1l, acc1, 0, 0, 0); }
            }
            ssq += __shfl_xor(ssq, 16); ssq += __shfl_xor(ssq, 32);
            const float rsr = frsq_(ssq * (1.f / DM) + 1e-6f);
            if (g == 0) rs2A[m0 + c] = rsr;
            float ge_[4]; int ee_[4];
#pragma unroll
            for (int reg = 0; reg < 4; ++reg) {
                const float rsw = __shfl(rsr, 4 * g + reg);
                float v0 = acc0[reg] * rsw + bia0, v1 = acc1[reg] * rsw + bia1;
                float tv[4]; int te[4];
#pragma unroll
                for (int s = 0; s < 4; ++s) {
                    float bv; int bi; if (v1 > v0) { bv = v1; bi = 16 + c; } else { bv = v0; bi = c; }
#pragma unroll
                    for (int o = 1; o < 16; o <<= 1) { const float ov = __shfl_xor(bv, o); const int oi = __shfl_xor(bi, o); if (ov > bv || (ov == bv && oi < bi)) { bv = ov; bi = oi; } }
                    tv[s] = bv; te[s] = bi; if (bi == c) v0 = -3.0e38f; if (bi == 16 + c) v1 = -3.0e38f;
                }
                const float e1 = fexp_(tv[1] - tv[0]), e2 = fexp_(tv[2] - tv[0]), e3 = fexp_(tv[3] - tv[0]); const float inv = frcp_(1.f + e1 + e2 + e3);
                const int s_ = c & 3; const float gsel = (s_ == 0 ? 1.f : s_ == 1 ? e1 : s_ == 2 ? e2 : e3) * inv; const int esel = s_ == 0 ? te[0] : s_ == 1 ? te[1] : s_ == 2 ? te[2] : te[3];
                ge_[reg] = gsel; ee_[reg] = esel;
            }
            const int rsel = c >> 2;
            my_g = rsel == 0 ? ge_[0] : rsel == 1 ? ge_[1] : rsel == 2 ? ge_[2] : ge_[3];
            my_e = rsel == 0 ? ee_[0] : rsel == 1 ? ee_[1] : rsel == 2 ? ee_[2] : ee_[3];
            my_ent = (m0 + 4 * g + rsel) * 4 + (c & 3);
            my_rs = __shfl(rsr, 4 * g + rsel);
            my_rank = __hip_atomic_fetch_add(lcnt + my_e, 1u, __ATOMIC_RELAXED, __HIP_MEMORY_SCOPE_WORKGROUP);
        }
        __syncthreads();
        if (F.tid < NE) { const unsigned n = lcnt[F.tid]; lcnt[32 + F.tid] = n ? __hip_atomic_fetch_add(cntw + 64 * F.tid, n, RLX_AGENT) : 0u; }
        __syncthreads();
        if (live) { const size_t pos = (size_t)my_e * LISTCAP + lcnt[32 + my_e] + my_rank; list[pos] = my_ent; rsl[pos] = my_rs; gwl[pos] = my_g; }
        __syncthreads();
    }
}

constexpr int TILE_TAB_OFF = pg8::STAGE_BYTES + 8192;
__device__ __forceinline__ int moe_tables(Frame& F, MoeTab& T) {
    LAS int* pref = (LAS int*)(F.lds + TAB_OFF); LAS int* cnt = pref + 40; LAS int* tile = (LAS int*)(F.lds + TILE_TAB_OFF);
    unsigned* cntw = (unsigned*)(F.ws + WS_CTL) + CW_CNT;
    if (F.tid == 0) { int acc = 0; for (int e = 0; e < NE; ++e) { const int c = (int)__hip_atomic_load(cntw + 64 * e, RLX_AGENT); cnt[e] = c; pref[e] = acc; acc += (c + 255) >> 8; } pref[NE] = acc; }
    __syncthreads();
    const int RT = pref[NE];
    for (int rt = F.tid; rt < RT; rt += NWAVES * 64) { int e = 0;
        for (int j = 1; j < NE; ++j) if (pref[j] <= rt) e = j;
        const int rb = rt - pref[e], left = cnt[e] - rb * 256;
        tile[rt] = (e << 24) | (rb << 12) | (left < 256 ? left : 256); }
    __syncthreads();
    T.pref = pref; T.cnt = cnt; T.tile = tile;
    return RT;
}

struct FinalRow { f32x4 v[4]; v2u sl[4][2]; };
__device__ __forceinline__ void final_load(FinalRow& R, const bf16* xrow, const unsigned char* srow) {
#pragma unroll
    for (int j = 0; j < 2; ++j) { const v4u h = *(const v4u*)(xrow + 512 * j);
        R.v[2 * j] = (f32x4){bflo(h.x), bfhi(h.x), bflo(h.y), bfhi(h.y)}; R.v[2 * j + 1] = (f32x4){bflo(h.z), bfhi(h.z), bflo(h.w), bfhi(h.w)}; }
#pragma unroll
    for (int s = 0; s < 4; ++s)
#pragma unroll
        for (int j = 0; j < 2; ++j) R.sl[s][j] = *(const v2u*)(srow + (size_t)s * DM + 512 * j);
}
__device__ __forceinline__ void final_finish(FinalRow& R, float* orow, const f32x4 (&wv)[4]) {
#pragma unroll
    for (int s = 0; s < 4; ++s)
#pragma unroll
        for (int j = 0; j < 2; ++j) { const v2u u = R.sl[s][j];
            const f32x2_t a0 = __builtin_amdgcn_cvt_pk_f32_fp8((int)u.x, false), a1 = __builtin_amdgcn_cvt_pk_f32_fp8((int)u.x, true), b0 = __builtin_amdgcn_cvt_pk_f32_fp8((int)u.y, false), b1 = __builtin_amdgcn_cvt_pk_f32_fp8((int)u.y, true);
            R.v[2 * j].x += a0.x * SLAB_INV; R.v[2 * j].y += a0.y * SLAB_INV; R.v[2 * j].z += a1.x * SLAB_INV; R.v[2 * j].w += a1.y * SLAB_INV;
            R.v[2 * j + 1].x += b0.x * SLAB_INV; R.v[2 * j + 1].y += b0.y * SLAB_INV; R.v[2 * j + 1].z += b1.x * SLAB_INV; R.v[2 * j + 1].w += b1.y * SLAB_INV; }
    float ss = 0.f;
#pragma unroll
    for (int j = 0; j < 4; ++j) ss += (R.v[j].x * R.v[j].x + R.v[j].y * R.v[j].y) + (R.v[j].z * R.v[j].z + R.v[j].w * R.v[j].w);
    ss = wave_sum(ss);
    const float rs = frsq_(ss * (1.f / DM) + 1e-6f);
#pragma unroll
    for (int j = 0; j < 2; ++j) { *(f32x4*)(orow + 512 * j) = R.v[2 * j] * rs * wv[2 * j]; *(f32x4*)(orow + 512 * j + 4) = R.v[2 * j + 1] * rs * wv[2 * j + 1]; }
}
__device__ __forceinline__ void phase_final(Frame& F, int dryrun) {
    const float* fw = F.in[17]; const unsigned char* slab = F.ws + WS_SLAB; float* out = F.out;
    const bf16* x1 = (const bf16*)(F.ws + WS_X1); (void)dryrun;
    const int gw = F.vcu * NWAVES + F.wave, NGW = F.G * NWAVES, lane = F.lane;
    f32x4 wv[4];
#pragma unroll
    for (int j = 0; j < 2; ++j) { wv[2 * j] = *(const f32x4*)(fw + 512 * j + 8 * lane); wv[2 * j + 1] = *(const f32x4*)(fw + 512 * j + 8 * lane + 4); }
    FinalRow A, B;
    int m = gw;
    if (m < NTOK) final_load(A, x1 + (size_t)m * DM + 8 * lane, slab + (size_t)m * 4 * DM + 8 * lane);
    for (; m < NTOK; m += 2 * NGW) {
        const int m1 = m + NGW, m2 = m + 2 * NGW;
        if (m1 < NTOK) final_load(B, x1 + (size_t)m1 * DM + 8 * lane, slab + (size_t)m1 * 4 * DM + 8 * lane);
        final_finish(A, out + (size_t)m * DM + 8 * lane, wv);
        if (m2 < NTOK) final_load(A, x1 + (size_t)m2 * DM + 8 * lane, slab + (size_t)m2 * 4 * DM + 8 * lane);
        if (m1 < NTOK) final_finish(B, out + (size_t)m1 * DM + 8 * lane, wv);
    }
}

struct Args { const float* in[18]; float* out; unsigned char* ws; int ph_lo, ph_hi, flag, breg; };
constexpr int NPHASE = 11;

__global__ void __launch_bounds__(NWAVES * 64, 2) mk_fwd(Args args) {
    extern __shared__ __attribute__((aligned(16))) unsigned char lds_raw[];
    Frame F;
    F.lds = (LAS unsigned char*)lds_raw;
    F.tid = threadIdx.x; F.lane = F.tid & 63; F.wave = __builtin_amdgcn_readfirstlane(F.tid >> 6);
    F.G = gridDim.x; { const int bx = blockIdx.x; F.vcu = (F.G % 8 == 0) ? (bx % 8) * (F.G / 8) + bx / 8 : bx; }
#pragma unroll
    for (int i = 0; i < 18; ++i) F.in[i] = args.in[i];
    F.out = args.out; F.ws = args.ws;
    volatile LAS unsigned* MISC = (volatile LAS unsigned*)(F.lds + MISC_OFF);
    for (int u = F.tid; u < (LDS_BYTES - LDSCTL_OFF) / 4; u += NWAVES * 64) ((LAS unsigned*)(F.lds + LDSCTL_OFF))[u] = 0u;
    __syncthreads();
    unsigned* ctl = (unsigned*)(F.ws + WS_CTL);
#if !MK_PER_PHASE
    XcdBarrier bar = xcd_barrier_post(ctl + CW_BAR, MISC + 8);
#define GRID_BAR() xcd_barrier(bar)
#else
#define GRID_BAR() do {} while (0)
#endif
    const int lo = args.ph_lo, hi = args.ph_hi;
#define IN(k) (lo <= (k) && (k) < hi)
#define SEAM(k) do { if (IN(k) && IN((k) + 1)) GRID_BAR(); } while (0)

#define RUNPH(k, ...) do { if (IN(k)) { __VA_ARGS__; } SEAM(k); } while (0)
    RUNPH(0, phase_prep(F));
    RUNPH(1, {
        ProbIn P; P.K = DM; P.RB = 2 * DM; P.S.init(NTOK / 256, NPROJ / 256, F.G, (int)blockIdx.x);
        P.A = (const bf16*)(F.ws + WS_XB); P.Bt = (const bf16*)(F.ws + WS_WIN); P.O = (bf16*)(F.ws + WS_PROJ); P.rs = (const float*)(F.ws + WS_RS1);
        pg8::gemm_phase(F.lds, P); });
    if (IN(2)) { phase_mix(F); __syncthreads(); }
    RUNPH(3, phase_chunk(F, 0, F.G, 0, SCAN_SPLIT));
    RUNPH(4, {
        const int nscan = NB * NH;
        unsigned* seam = ctl + CW_SEAM4 + 64 * args.breg;
        auto scan_wait = [&]() {
            asm volatile("s_waitcnt vmcnt(0)" ::: "memory"); __syncthreads();
            if (F.tid == 0) { const unsigned want = (unsigned)(F.G - nscan); unsigned sp = 0u;
                while (__hip_atomic_load(seam, RLX_AGENT) < want) { __builtin_amdgcn_s_sleep(2); if (++sp > (1u << 22)) break; }
                __builtin_amdgcn_fence(__ATOMIC_ACQUIRE, "agent"); asm volatile("s_waitcnt vmcnt(0)" ::: "memory"); }
            __syncthreads();
        };
        if ((int)blockIdx.x < nscan) phase_scan(F, scan_wait);
        else {
               phase_chunk(F, nscan, F.G - nscan, SCAN_SPLIT, 64 - SCAN_SPLIT);
               asm volatile("s_waitcnt vmcnt(0)" ::: "memory"); __syncthreads();
               if (F.tid == 0) { __builtin_amdgcn_fence(__ATOMIC_RELEASE, "agent"); asm volatile("s_waitcnt vmcnt(0)" ::: "memory"); __hip_atomic_fetch_add(seam, 1u, RLX_AGENT); }
               moe_weight_prep(F, nscan, MOE_PREP_SPLIT, MOE_PREP_ITEMS); } });
    RUNPH(5, phase_onorm(F));
    RUNPH(6, {
        ProbOut P; P.K = DM; P.RB = 2 * DM; P.S.init(NTOK / 256, DM / 256, F.G, (int)blockIdx.x);
        P.A = (const bf16*)(F.ws + WS_CONCAT); P.Bt = (const bf16*)(F.ws + WS_WOUT); P.X = (const bf16*)(F.ws + WS_XB); P.O = (bf16*)(F.ws + WS_X1);
        pg8::gemm_phase(F.lds, P); });
    RUNPH(7, phase_route(F));
    RUNPH(8, {
        ProbGU P; const int RT = moe_tables(F, P.T);
        P.K = DM; P.RB = DM; P.S.init(RT, 8, F.G, (int)blockIdx.x);
        P.A = F.ws + WS_X1B; P.Bt = F.ws + WS_WGU; P.O = F.ws + WS_ACT; P.list = (const int*)(F.ws + WS_LIST);
        P.rs2 = (const float*)(F.ws + WS_RSL); P.bgu = (const float*)(F.ws + WS_BGU);
        pg8::gemm_phase<ProbGU, true>(F.lds, P); });
    RUNPH(9, {
        ProbDown P; const int RT = moe_tables(F, P.T);
        P.K = DE; P.RB = DE; P.S.init(RT, 4, F.G, (int)blockIdx.x);
        P.A = F.ws + WS_ACT; P.Bt = F.ws + WS_WD; P.O = F.ws + WS_SLAB; P.list = (const int*)(F.ws + WS_LIST);
        P.gw = (const float*)(F.ws + WS_GWL); P.bd = F.in[16];
        pg8::gemm_phase<ProbDown, true>(F.lds, P); });
    RUNPH(10, phase_final(F, args.flag));
#undef RUNPH
#undef IN
#undef SEAM
}

extern "C" void kernel_launch(void* const* d_in, const int* in_sizes, int n_in, void* d_out, int out_size, void* d_ws, size_t ws_size, hipStream_t stream) {
    static int grid = 0;
    if (grid == 0) {
        if (n_in != 18 || in_sizes[0] != NTOK * DM || out_size != NTOK * DM || ws_size < WS_END) { fprintf(stderr, "kernel_launch: unexpected shapes (n_in %d, in0 %d, out %d, ws %zu)\n", n_in, n_in > 0 ? in_sizes[0] : -1, out_size, ws_size); grid = -1; return; }
        int dev = 0, cus = 0, per_cu = 0;
        if (hipGetDevice(&dev) != hipSuccess || hipDeviceGetAttribute(&cus, hipDeviceAttributeMultiprocessorCount, dev) != hipSuccess) { grid = -1; return; }
        if (hipFuncSetAttribute((const void*)mk_fwd, hipFuncAttributeMaxDynamicSharedMemorySize, LDS_BYTES) != hipSuccess) { fprintf(stderr, "kernel_launch: hipFuncSetAttribute failed\n"); grid = -1; return; }
        if (hipOccupancyMaxActiveBlocksPerMultiprocessor(&per_cu, (const void*)mk_fwd, NWAVES * 64, LDS_BYTES) != hipSuccess || per_cu < 1) { fprintf(stderr, "kernel_launch: occupancy query says %d\n", per_cu); per_cu = 1; }
        (void)hipGetLastError();
        grid = cus;
    }
    if (grid < 0) return;
    (void)hipMemsetAsync((char*)d_ws + WS_CTL, 0, CTL_ZERO_BYTES, stream);
    Args a{};
    for (int i = 0; i < 18; ++i) a.in[i] = (const float*)d_in[i];
    a.out = (float*)d_out; a.ws = (unsigned char*)d_ws;
#if MK_PER_PHASE
    for (int p = 0; p < NPHASE; ++p) { a.ph_lo = p; a.ph_hi = p + 1; const int nrep = 1 + REP_CNT * ((REP_MASK >> p) & 1);
        for (int r = 0; r < nrep; ++r) { a.flag = (p == NPHASE - 1 && r + 1 < nrep) ? 1 : 0; a.breg = r; hipLaunchKernelGGL(mk_fwd, dim3(grid), dim3(NWAVES * 64), LDS_BYTES, stream, a); } }
#else
    a.ph_lo = 0; a.ph_hi = NPHASE;
    hipLaunchKernelGGL(mk_fwd, dim3(grid), dim3(NWAVES * 64), LDS_BYTES, stream, a);
#endif
}
```

```cpp
#include <hip/hip_runtime.h>
#include <cstdio>
#include <cstdint>

#ifndef REP_MASK
#define REP_MASK 0
#endif
#ifndef REP_CNT
#define REP_CNT 1
#endif
#ifndef MK_PER_PHASE
#define MK_PER_PHASE 0
#endif

constexpr int NB = 8, SEQ = 4096, DM = 1024, NTOK = NB * SEQ;
constexpr int NH = 4, HD = 128, DDN = 512, DPOOL = 512, DIN = 2568, NPROJ = 2560;
constexpr int NE = 32, TOPK = 4, DE = 1024, NASSIGN = NTOK * TOPK;
constexpr int LISTCAP = NTOK;
constexpr int ACT_ROWS = NASSIGN + NE * 256;

constexpr size_t MiB = 1u << 20;
constexpr size_t WS_CTL = 0, CTL_ZERO_BYTES = 1 * MiB;
constexpr size_t WS_WIN = 1 * MiB;
constexpr size_t WS_WOUT = 6 * MiB;
constexpr size_t WS_WPOOL = 8 * MiB;
constexpr size_t WS_WR = 8 * MiB + 512 * 1024;
constexpr size_t WS_BGU = 8 * MiB + 768 * 1024;
constexpr size_t WS_RS1 = 9 * MiB;
constexpr size_t WS_BETA = 9 * MiB + 128 * 1024;
constexpr size_t WS_G = 9 * MiB + 640 * 1024;
constexpr size_t WS_RS2 = 10 * MiB + 256 * 1024;
constexpr size_t WS_GATEW = 10 * MiB + 512 * 1024;
constexpr size_t WS_LIST = 11 * MiB;
constexpr size_t WS_RSL = 800 * MiB;
constexpr size_t WS_GWL = 804 * MiB;
constexpr size_t WS_WGU = 16 * MiB;
constexpr size_t WS_WD = 144 * MiB;
constexpr size_t WS_XB = 208 * MiB;
constexpr size_t WS_PROJ = 272 * MiB;
constexpr size_t WS_CHUNK = 432 * MiB;
constexpr size_t WS_UC = 544 * MiB;
constexpr size_t WS_GTOT = 576 * MiB;
constexpr size_t WS_ORAW = 577 * MiB;
constexpr int CH_WF = 0, CH_QD = 16384, CH_KT = 32768, CH_QK = 49152, CH_BYTES = 57344, UC_BYTES = 16384;
constexpr size_t WS_MIXED = 688 * MiB;
constexpr size_t WS_CONCAT = 720 * MiB;
constexpr size_t WS_X1B = 208 * MiB;
constexpr size_t WS_ACT = 272 * MiB;
constexpr size_t WS_SLAB = 544 * MiB;
constexpr size_t WS_X1 = 808 * MiB;
constexpr size_t WS_END = 872 * MiB;
static_assert(WS_ACT + (size_t)ACT_ROWS * 2048 <= WS_SLAB, "act fits");
static_assert(WS_SLAB + (size_t)NASSIGN * 2048 <= WS_END, "slab fits");

constexpr int CW_BAR = 4096;
constexpr int CW_CNT = 16384;
constexpr int CW_SEAM4 = 20480;

constexpr int LDS_BYTES = 163840;
constexpr int LDSCTL_OFF = LDS_BYTES - 1024, MISC_OFF = LDSCTL_OFF + 320, TAB_OFF = LDSCTL_OFF + 512;
constexpr int NWAVES = 8;

#define GAS __attribute__((address_space(1)))
#define LAS __attribute__((address_space(3)))
typedef unsigned short bf16;
typedef unsigned v4u __attribute__((ext_vector_type(4)));
typedef unsigned v2u __attribute__((ext_vector_type(2)));
typedef float f32x4 __attribute__((ext_vector_type(4)));
typedef float f32x2 __attribute__((ext_vector_type(2)));
typedef short bf16x8 __attribute__((ext_vector_type(8)));
typedef GAS unsigned gu32;
#define RLX_AGENT __ATOMIC_RELAXED, __HIP_MEMORY_SCOPE_AGENT
#define LDS_WAIT() asm volatile("s_waitcnt lgkmcnt(0)" ::: "memory")
#define VM_WAIT() asm volatile("s_waitcnt vmcnt(0)" ::: "memory")

__device__ __forceinline__ unsigned f2bf(float f) { unsigned u = __builtin_bit_cast(unsigned, f); return (u + 0x7fffu + ((u >> 16) & 1u)) >> 16; }
__device__ __forceinline__ unsigned pk2(float lo, float hi) { return f2bf(lo) | (f2bf(hi) << 16); }
__device__ __forceinline__ float bflo(unsigned u) { return __builtin_bit_cast(float, u << 16); }
__device__ __forceinline__ float bfhi(unsigned u) { return __builtin_bit_cast(float, u & 0xffff0000u); }
__device__ __forceinline__ unsigned pk4_fp8(float a, float b, float c, float d) { int p = __builtin_amdgcn_cvt_pk_fp8_f32(a, b, 0, false); p = __builtin_amdgcn_cvt_pk_fp8_f32(c, d, p, true); return (unsigned)p; }
typedef float f32x2_t __attribute__((ext_vector_type(2)));
constexpr float SLAB_SCALE = 16.f, SLAB_INV = 1.f / 16.f;
constexpr float W8_SCALE = 32.f, W8_INV = 1.f / 32.f;
__device__ __forceinline__ float wave_sum(float v) {
#pragma unroll
    for (int o = 1; o < 64; o <<= 1) v += __shfl_xor(v, o);
    return v;
}
__device__ __forceinline__ float frcp_(float x) { return __builtin_amdgcn_rcpf(x); }
__device__ __forceinline__ float frsq_(float x) { return __builtin_amdgcn_rsqf(x); }
__device__ __forceinline__ float fexp_(float x) { return __builtin_amdgcn_exp2f(x * 1.4426950408889634f); }
__device__ __forceinline__ float sigmoidf_(float x) { return frcp_(1.f + fexp_(-x)); }
__device__ __forceinline__ float siluf_(float x) { return x * frcp_(1.f + fexp_(-x)); }

namespace pg8 {
constexpr int BM = 256, BK = 64, HALF = 128, HTB = HALF * BK * 2, STAGE_BYTES = 8 * HTB;
__device__ __forceinline__ int lds_byte(int r, int c) { const int st = (r >> 4) * 2 + (c >> 5), rr = r & 15, cc = c & 31, ob = rr * 64 + cc * 2; return st * 1024 + (ob ^ (((ob >> 9) & 1) << 5)); }
__device__ __forceinline__ void stage_rc(int b, int& R, int& C) { const int st = b / 1024, sb = b % 1024, swz = sb ^ (((sb >> 9) & 1) << 5); R = (st >> 1) * 16 + swz / 64; C = (st & 1) * 32 + (swz % 64) / 2; }
__device__ __forceinline__ int perm32(int rho) { const int n = rho >> 4, i = rho & 15; return 8 * (i >> 2) + 4 * n + (i & 3); }
typedef __bf16 bf16x2_t __attribute__((ext_vector_type(2)));
__device__ __forceinline__ unsigned cvt_pk_bf16(float lo, float hi) { const f32x2 v = {lo, hi}; const bf16x2_t b = __builtin_convertvector(v, bf16x2_t); return __builtin_bit_cast(unsigned, b); }

struct Unit { int rt, pn, e, rb, rows; };

struct Sched {
    int nM, nN, nwg, G, c;
    __device__ __forceinline__ void init(int nM_, int nN_, int G_, int c_) { nM = nM_; nN = nN_; nwg = nM * nN; G = G_; c = c_; }
    __device__ __forceinline__ bool next(int i, int& pm, int& pn) const {
        const long L = (long)i * G + c; if (L >= nwg) return false;
        int wgid = (int)L; { const int q = nwg / 8, r = nwg % 8, xcd = wgid % 8, off = wgid / 8; wgid = (xcd < r ? xcd * (q + 1) : r * (q + 1) + (xcd - r) * q) + off; }
        const int nig = 8 * nN, gid = wgid / nig, fm = gid * 8, gsz = (nM - fm) < 8 ? (nM - fm) : 8;
        pm = fm + ((wgid % nig) % gsz); pn = (wgid % nig) / gsz; return true;
    }
};

typedef int v8i_t __attribute__((ext_vector_type(8)));
template <class P, bool F8 = false>
__device__ __forceinline__ void gemm_phase(LAS unsigned char* lds, const P& p) {
    const int tid = threadIdx.x, wid = __builtin_amdgcn_readfirstlane(tid >> 6), lane = tid & 63, wr = wid >> 2, wc = wid & 3, fr = lane & 15, fq = lane >> 4;
    const int K = p.K, RB = F8 ? K : 2 * K, nt = RB / (BK * 2);
    unsigned voffB[2];
#pragma unroll
    for (int i = 0; i < 2; ++i) { int R_, C_; stage_rc(tid * 16 + i * 8192, R_, C_); const int Rb = (R_ & ~31) + perm32(R_ & 31); voffB[i] = (unsigned)(Rb * RB + C_ * 2); }
#define PG8_AOFF(unit, dst) do { int R[2], C[2]; asm volatile("" ::: "memory"); _Pragma("unroll") for (int i_ = 0; i_ < 2; ++i_) stage_rc(tid * 16 + i_ * 8192, R[i_], C[i_]); p.a_off(unit, R, C, dst); } while (0)
    const size_t kstep = (size_t)(BK * 2);
    const size_t hstep = (size_t)HALF * RB;
    const unsigned ldsw = (unsigned)wid * 1024u;
    const int aoff = lds_byte(wr * 64 + fr, fq * 8), boff = lds_byte(wc * 32 + fr, fq * 8);
#define PG8_SA(b, h) (((b) * 2 + (h)) * HTB)
#define PG8_SB(b, h) ((4 + (b) * 2 + (h)) * HTB)
#define PG8_STAGE(bufoff, gbase, voff) do { _Pragma("unroll") for (int _i = 0; _i < 2; ++_i) \
        __builtin_amdgcn_global_load_lds((const unsigned*)((const char*)(gbase) + (voff)[_i]), (LAS unsigned*)(lds + (bufoff) + ldsw + _i * 8192), 16, 0, 0); } while (0)
#define PG8_LDA(dst, b, h) do { _Pragma("unroll") for (int m = 0; m < 4; ++m) { const v4i_t l_ = *(const LAS v4i_t*)(lds + PG8_SA(b, h) + aoff + m * 2048), h_ = *(const LAS v4i_t*)(lds + PG8_SA(b, h) + aoff + m * 2048 + 1024); dst[m] = __builtin_shufflevector(l_, h_, 0, 1, 2, 3, 4, 5, 6, 7); } } while (0)
#define PG8_LDB(dst, b, h) do { _Pragma("unroll") for (int n = 0; n < 2; ++n) { const v4i_t l_ = *(const LAS v4i_t*)(lds + PG8_SB(b, h) + boff + n * 2048), h_ = *(const LAS v4i_t*)(lds + PG8_SB(b, h) + boff + n * 2048 + 1024); dst[n] = __builtin_shufflevector(l_, h_, 0, 1, 2, 3, 4, 5, 6, 7); } } while (0)
#define PG8_HALF(x, k) __builtin_bit_cast(bf16x8, __builtin_shufflevector(x, x, 4 * (k), 4 * (k) + 1, 4 * (k) + 2, 4 * (k) + 3))
#define PG8_MMA(ai, bj, At, Bt) do { __builtin_amdgcn_s_setprio(1); \
        if constexpr (F8) { _Pragma("unroll") for (int m = 0; m < 4; ++m) _Pragma("unroll") for (int n = 0; n < 2; ++n) \
            asm volatile("v_mfma_scale_f32_16x16x128_f8f6f4 %0, %1, %2, %0, %3, %3 op_sel_hi:[0,0,0]" : "+v"(acc[ai][bj][m][n]) : "v"(Bt[n]), "v"(At[m]), "v"(mxs)); } \
        else { _Pragma("unroll") for (int m = 0; m < 4; ++m) _Pragma("unroll") for (int n = 0; n < 2; ++n) { \
            acc[ai][bj][m][n] = __builtin_amdgcn_mfma_f32_16x16x32_bf16(PG8_HALF(Bt[n], 0), PG8_HALF(At[m], 0), acc[ai][bj][m][n], 0, 0, 0); \
            acc[ai][bj][m][n] = __builtin_amdgcn_mfma_f32_16x16x32_bf16(PG8_HALF(Bt[n], 1), PG8_HALF(At[m], 1), acc[ai][bj][m][n], 0, 0, 0); } } \
        __builtin_amdgcn_s_setprio(0); } while (0)
#define PG8_WAIT_V(n) asm volatile("s_waitcnt vmcnt(" #n ")" ::: "memory")
#define PG8_WAIT_L(n) asm volatile("s_waitcnt lgkmcnt(" #n ")" ::: "memory")
#define PG8_BAR __builtin_amdgcn_s_barrier()
#define PG8_SCHED __builtin_amdgcn_sched_barrier(0)
    Unit cur, nxt; int ui = 0;
    if (!p.next(0, cur)) return;
    unsigned mxs = 0x7f7f7f7fu; asm volatile("" : "+v"(mxs));
    f32x4 acc[2][2][4][2];
#pragma unroll
    for (int a = 0; a < 2; ++a)
#pragma unroll
        for (int b = 0; b < 2; ++b)
#pragma unroll
            for (int m = 0; m < 4; ++m)
#pragma unroll
                for (int n = 0; n < 2; ++n) acc[a][b][m][n] = (f32x4){0.f, 0.f, 0.f, 0.f};
    typedef int v4i_t __attribute__((ext_vector_type(4)));
    v8i_t At[4], B0[2], B1[2];
    unsigned oA[2][2];
    PG8_AOFF(cur, oA);
    const char* cA = p.a_base(cur); const char* cB = p.b_base(cur);
    PG8_STAGE(PG8_SB(0, 0), cB, voffB); PG8_STAGE(PG8_SB(0, 1), cB + hstep, voffB); PG8_STAGE(PG8_SA(0, 0), cA, oA[0]); PG8_STAGE(PG8_SA(0, 1), cA, oA[1]);
    if (wr == 1) PG8_BAR;
    PG8_WAIT_V(2); PG8_BAR;
    PG8_STAGE(PG8_SB(1, 0), cB + kstep, voffB); PG8_STAGE(PG8_SA(1, 0), cA + kstep, oA[0]); PG8_STAGE(PG8_SB(1, 1), cB + hstep + kstep, voffB);
    PG8_WAIT_V(6); PG8_BAR;
    LAS v4u* park = (LAS v4u*)(lds + STAGE_BYTES) + tid;
#define PG8_AIDX(unit, ent) do { int R[2], C[2]; asm volatile("" ::: "memory"); _Pragma("unroll") for (int i_ = 0; i_ < 2; ++i_) stage_rc(tid * 16 + i_ * 8192, R[i_], C[i_]); p.a_idx(unit, R, ent); } while (0)
#define PG8_AFIN(unit, ent, dst) do { int R[2], C[2]; asm volatile("" ::: "memory"); _Pragma("unroll") for (int i_ = 0; i_ < 2; ++i_) stage_rc(tid * 16 + i_ * 8192, R[i_], C[i_]); p.a_fin(unit, R, C, ent, dst); } while (0)
    Unit nn; int ent[2][2];
    bool has_next = p.next(1, nxt);
    if (has_next) PG8_AIDX(nxt, ent); else ent[0][0] = ent[0][1] = ent[1][0] = ent[1][1] = 0;
    for (;;) {
        const char* nA = cA; const char* nB = cB;
        { unsigned nO[2][2];
#pragma unroll
          for (int h = 0; h < 2; ++h)
#pragma unroll
              for (int i = 0; i < 2; ++i) nO[h][i] = oA[h][i];
          if (has_next) { nA = p.a_base(nxt); nB = p.b_base(nxt); PG8_AFIN(nxt, ent, nO); }
          *park = (v4u){nO[0][0], nO[0][1], nO[1][0], nO[1][1]}; }
        for (int t = 0; t < nt; t += 2) {
            const bool last = (t == nt - 2);
            const char* a1 = cA + (size_t)(t + 1) * kstep;
            const char* a2 = last ? nA : cA + (size_t)(t + 2) * kstep; const char* b2 = last ? nB : cB + (size_t)(t + 2) * kstep;
            const char* a3 = a2 + kstep; const char* b3 = b2 + kstep;
            unsigned o2[2][2];
#pragma unroll
            for (int h = 0; h < 2; ++h)
#pragma unroll
                for (int i = 0; i < 2; ++i) o2[h][i] = oA[h][i];
            if (last) { const v4u q_ = *park; o2[0][0] = q_.x; o2[0][1] = q_.y; o2[1][0] = q_.z; o2[1][1] = q_.w; }
            PG8_LDB(B0, 0, 0); PG8_LDB(B1, 0, 1); PG8_SCHED; PG8_LDA(At, 0, 0); PG8_STAGE(PG8_SA(1, 1), a1, oA[1]);
            PG8_WAIT_V(8); PG8_WAIT_L(0); PG8_BAR; PG8_MMA(0, 0, At, B0); PG8_MMA(0, 1, At, B1); PG8_BAR; PG8_SCHED;
            PG8_LDA(At, 0, 1); PG8_STAGE(PG8_SB(0, 0), b2, voffB); PG8_STAGE(PG8_SB(0, 1), b2 + hstep, voffB); PG8_STAGE(PG8_SA(0, 0), a2, o2[0]);
            PG8_WAIT_V(8); PG8_WAIT_L(0); PG8_BAR; PG8_MMA(1, 0, At, B0); PG8_MMA(1, 1, At, B1); PG8_BAR; PG8_SCHED;
            PG8_LDB(B0, 1, 0); PG8_LDB(B1, 1, 1); PG8_SCHED; PG8_LDA(At, 1, 0); PG8_STAGE(PG8_SA(0, 1), a2, o2[1]);
            PG8_WAIT_V(8); PG8_WAIT_L(0); PG8_BAR; PG8_MMA(0, 0, At, B0); PG8_MMA(0, 1, At, B1); PG8_BAR; PG8_SCHED;
            PG8_LDA(At, 1, 1); PG8_STAGE(PG8_SB(1, 0), b3, voffB); PG8_STAGE(PG8_SB(1, 1), b3 + hstep, voffB); PG8_STAGE(PG8_SA(1, 0), a3, o2[0]);
            PG8_WAIT_V(8); PG8_WAIT_L(0); PG8_BAR; PG8_MMA(1, 0, At, B0); PG8_MMA(1, 1, At, B1); PG8_BAR; PG8_SCHED;
        }
        const bool has_nn = has_next && p.next(ui + 2, nn);
        if (has_nn) PG8_AIDX(nn, ent);
        if (wr == 0) PG8_BAR;
        if constexpr (F8) asm volatile("s_nop 15\n\ts_nop 15" ::: "memory");
        p.epi(acc, cur, wr, wc, fr, fq);
        if (!has_next) break;
#pragma unroll
        for (int a = 0; a < 2; ++a)
#pragma unroll
            for (int b = 0; b < 2; ++b)
#pragma unroll
                for (int m = 0; m < 4; ++m)
#pragma unroll
                    for (int n = 0; n < 2; ++n) acc[a][b][m][n] = (f32x4){0.f, 0.f, 0.f, 0.f};
        cur = nxt; nxt = nn; has_next = has_nn; cA = nA; cB = nB; ++ui;
        { const v4u q_ = *park; oA[0][0] = q_.x; oA[0][1] = q_.y; oA[1][0] = q_.z; oA[1][1] = q_.w; }
        if (wr == 1) PG8_BAR;
    }
    PG8_WAIT_V(0);
    PG8_BAR;
#undef PG8_SA
#undef PG8_SB
#undef PG8_STAGE
#undef PG8_LDA
#undef PG8_LDB
#undef PG8_MMA
#undef PG8_HALF
#undef PG8_AOFF
#undef PG8_AIDX
#undef PG8_AFIN
#undef PG8_WAIT_V
#undef PG8_WAIT_L
#undef PG8_BAR
#undef PG8_SCHED
}
}

#define XB_TMO      128
#define XB_XCNT(j)  (256  + 64 * (j))
#define XB_XSUB(j)  (1280 + 64 * (j))
#define XB_XGEN(j)  (2304 + 64 * (j))
#define XB_TOP      3328
#define XB_TOPGEN   3392
#define XCD_BAR_WORDS 3456
#define XB_SPIN_CAP (1u << 18)
__device__ __forceinline__ unsigned xb_ld(unsigned* p)              { return __hip_atomic_load(p, __ATOMIC_RELAXED, __HIP_MEMORY_SCOPE_AGENT); }
__device__ __forceinline__ unsigned xb_add(unsigned* p, unsigned v) { return __hip_atomic_fetch_add(p, v, __ATOMIC_RELAXED, __HIP_MEMORY_SCOPE_AGENT); }
__device__ __forceinline__ unsigned xb_xcc_id() { return (unsigned)__builtin_amdgcn_s_getreg((3 << 11) | 20) & 0xFu; }
#define XB_SPIN(cond, bar) do { unsigned _sp = 0; while (cond) { __builtin_amdgcn_s_sleep(1); \
    if ((++_sp & 255u) == 0u) { if (xb_ld(&(bar)[XB_TMO])) break; if (_sp > XB_SPIN_CAP) { atomicAdd(&(bar)[XB_TMO], 1u); break; } } } } while (0)
struct XcdBarrier { unsigned* bar; unsigned x; volatile LAS unsigned* st; };
__device__ __forceinline__ XcdBarrier xcd_barrier_post(unsigned* bar, volatile LAS unsigned* st) {
    XcdBarrier b; b.bar = bar; b.x = xb_xcc_id(); b.st = st;
    if (threadIdx.x == 0) (void)xb_add(&bar[XB_XCNT(b.x)], 1u);
    return b;
}
__device__ __forceinline__ void xcd_barrier_complete(unsigned* bar, unsigned x, unsigned& nloc, unsigned& nx) {
    const unsigned G = gridDim.x * gridDim.y * gridDim.z;
    unsigned sum, cnt, mine, sp = 0u;
    for (;;) {
        sum = 0u; cnt = 0u; mine = 0u;
#pragma unroll
        for (unsigned j = 0; j < 16; ++j) { const unsigned c = xb_ld(&bar[XB_XCNT(j)]); sum += c; cnt += (c > 0u) ? 1u : 0u; mine = (j == x) ? c : mine; }
        if (sum == G) break;
        __builtin_amdgcn_s_sleep(1);
        if ((++sp & 255u) == 0u) { if (xb_ld(&bar[XB_TMO])) break; if (sp > XB_SPIN_CAP) { atomicAdd(&bar[XB_TMO], 1u); break; } }
    }
    nloc = mine > 0u ? mine : 1u; nx = cnt > 0u ? cnt : 1u;
}
__device__ __forceinline__ void xcd_barrier(const XcdBarrier& b) {
    asm volatile("s_waitcnt vmcnt(0)" ::: "memory");
    __syncthreads();
    if (threadIdx.x == 0) {
        unsigned* bar = b.bar;
        __builtin_amdgcn_s_waitcnt(0);
        unsigned nloc = b.st[0], nx = b.st[1];
        if (nloc == 0u) { xcd_barrier_complete(bar, b.x, nloc, nx); b.st[0] = nloc; b.st[1] = nx; }
        const unsigned old = xb_add(&bar[XB_XSUB(b.x)], 1u);
        const unsigned gen = old / nloc;
        if (old + 1u == (gen + 1u) * nloc) {
            __builtin_amdgcn_fence(__ATOMIC_RELEASE, "agent");
            asm volatile("s_waitcnt vmcnt(0)" ::: "memory");
            const unsigned og = xb_add(&bar[XB_TOP], 1u);
            const unsigned tg = og / nx;
            if (og + 1u == (tg + 1u) * nx) xb_add(&bar[XB_TOPGEN], 1u);
            else XB_SPIN(xb_ld(&bar[XB_TOPGEN]) == tg, bar);
            __builtin_amdgcn_fence(__ATOMIC_ACQUIRE, "agent");
            xb_add(&bar[XB_XGEN(b.x)], 1u);
            asm volatile("s_waitcnt vmcnt(0)" ::: "memory");
        } else {
            XB_SPIN(xb_ld(&bar[XB_XGEN(b.x)]) == gen, bar);
            __builtin_amdgcn_fence(__ATOMIC_ACQUIRE, "agent");
            asm volatile("s_waitcnt vmcnt(0)" ::: "memory");
        }
    }
    __syncthreads();
}

struct Frame {
    LAS unsigned char* lds;
    int tid, lane, wave, vcu, G;
    const float* in[18];
    float* out;
    unsigned char* ws;
};
using pg8::Unit;
using pg8::cvt_pk_bf16;

struct ProbBase {
    int K; int RB; pg8::Sched S;
    __device__ __forceinline__ void a_idx(const Unit&, const int (&)[2], int (&ent)[2][2]) const { ent[0][0] = ent[0][1] = ent[1][0] = ent[1][1] = 0; }
    __device__ __forceinline__ void a_fin(const Unit&, const int (&R)[2], const int (&C)[2], const int (&)[2][2], unsigned (&off)[2][2]) const { lin_off(R, C, off); }
    __device__ __forceinline__ void lin_off(const int (&R)[2], const int (&C)[2], unsigned (&off)[2][2]) const {
#pragma unroll
        for (int h = 0; h < 2; ++h)
#pragma unroll
            for (int i = 0; i < 2; ++i) off[h][i] = (unsigned)((h * 128 + R[i]) * RB + C[i] * 2);
    }
};
struct ProbIn : ProbBase {
    const bf16* A; const bf16* Bt; bf16* O; const float* rs;
    __device__ __forceinline__ bool next(int i, Unit& u) const { int pm, pn; if (!S.next(i, pm, pn)) return false; u.rt = pm; u.pn = pn; u.e = 0; u.rb = pm; u.rows = 256; return true; }
    __device__ __forceinline__ const char* a_base(const Unit& u) const { return (const char*)A + (size_t)u.rt * 256 * RB; }
    __device__ __forceinline__ const char* b_base(const Unit& u) const { return (const char*)Bt + (size_t)u.pn * 256 * RB; }
    __device__ __forceinline__ void a_off(const Unit&, const int (&R)[2], const int (&C)[2], unsigned (&off)[2][2]) const { lin_off(R, C, off); }
    __device__ __forceinline__ void epi(const f32x4 (&acc)[2][2][4][2], const Unit& u, int wr, int wc, int fr, int fq) const {
        const int row0 = u.rt * 256 + wr * 64 + fr, col0 = u.pn * 256 + wc * 32 + 8 * fq;
#pragma unroll
        for (int ai = 0; ai < 2; ++ai)
#pragma unroll
            for (int m = 0; m < 4; ++m) { const int row = row0 + ai * 128 + m * 16; const float sc = rs[row]; bf16* rowp = O + (size_t)row * NPROJ + col0;
#pragma unroll
                for (int bj = 0; bj < 2; ++bj) { const f32x4 v0 = acc[ai][bj][m][0] * sc, v1 = acc[ai][bj][m][1] * sc; v4u w;
                    w.x = cvt_pk_bf16(v0[0], v0[1]); w.y = cvt_pk_bf16(v0[2], v0[3]); w.z = cvt_pk_bf16(v1[0], v1[1]); w.w = cvt_pk_bf16(v1[2], v1[3]);
                    *(v4u*)(rowp + bj * 128) = w; } }
    }
};
struct ProbPool : ProbBase {
    const bf16* A; const bf16* Bt; bf16* O;
    __device__ __forceinline__ bool next(int i, Unit& u) const { int pm, pn; if (!S.next(i, pm, pn)) return false; u.rt = pm; u.pn = pn; u.e = 0; u.rb = pm; u.rows = 256; return true; }
    __device__ __forceinline__ const char* a_base(const Unit& u) const { return (const char*)A + (size_t)u.rt * 256 * RB; }
    __device__ __forceinline__ const char* b_base(const Unit& u) const { return (const char*)Bt + (size_t)u.pn * 256 * RB; }
    __device__ __forceinline__ void a_off(const Unit&, const int (&R)[2], const int (&C)[2], unsigned (&off)[2][2]) const { lin_off(R, C, off); }
    __device__ __forceinline__ void epi(const f32x4 (&acc)[2][2][4][2], const Unit& u, int wr, int wc, int fr, int fq) const {
        const int row0 = u.rt * 256 + wr * 64 + fr, col0 = 512 + u.pn * 256 + wc * 32 + 8 * fq;
#pragma unroll
        for (int ai = 0; ai < 2; ++ai)
#pragma unroll
            for (int m = 0; m < 4; ++m) { const int row = row0 + ai * 128 + m * 16; bf16* rowp = O + (size_t)row * DM + col0;
#pragma unroll
                for (int bj = 0; bj < 2; ++bj) { const f32x4 v0 = acc[ai][bj][m][0], v1 = acc[ai][bj][m][1]; v4u w;
                    w.x = cvt_pk_bf16(v0[0], v0[1]); w.y = cvt_pk_bf16(v0[2], v0[3]); w.z = cvt_pk_bf16(v1[0], v1[1]); w.w = cvt_pk_bf16(v1[2], v1[3]);
                    *(v4u*)(rowp + bj * 128) = w; } }
    }
};
struct ProbOut : ProbBase {
    const bf16* A; const bf16* Bt; const bf16* X; bf16* O;
    __device__ __forceinline__ bool next(int i, Unit& u) const { int pm, pn; if (!S.next(i, pm, pn)) return false; u.rt = pm; u.pn = pn; u.e = 0; u.rb = pm; u.rows = 256; return true; }
    __device__ __forceinline__ const char* a_base(const Unit& u) const { return (const char*)A + (size_t)u.rt * 256 * RB; }
    __device__ __forceinline__ const char* b_base(const Unit& u) const { return (const char*)Bt + (size_t)u.pn * 256 * RB; }
    __device__ __forceinline__ void a_off(const Unit&, const int (&R)[2], const int (&C)[2], unsigned (&off)[2][2]) const { lin_off(R, C, off); }
    __device__ __forceinline__ void epi(const f32x4 (&acc)[2][2][4][2], const Unit& u, int wr, int wc, int fr, int fq) const {
        const int row0 = u.rt * 256 + wr * 64 + fr, col0 = u.pn * 256 + wc * 32 + 8 * fq;
#pragma unroll
        for (int ai = 0; ai < 2; ++ai)
#pragma unroll
            for (int m = 0; m < 4; ++m) { const size_t off = (size_t)(row0 + ai * 128 + m * 16) * DM + col0;
#pragma unroll
                for (int bj = 0; bj < 2; ++bj) { const v4u xv = *(const v4u*)(X + off + bj * 128); const f32x4 a = acc[ai][bj][m][0], b = acc[ai][bj][m][1];
                    *(v4u*)(O + off + bj * 128) = (v4u){cvt_pk_bf16(bflo(xv.x) + a.x, bfhi(xv.x) + a.y), cvt_pk_bf16(bflo(xv.y) + a.z, bfhi(xv.y) + a.w),
                                                        cvt_pk_bf16(bflo(xv.z) + b.x, bfhi(xv.z) + b.y), cvt_pk_bf16(bflo(xv.w) + b.z, bfhi(xv.w) + b.w)}; } }
    }
};
struct MoeTab { const LAS int* pref; const LAS int* cnt; const LAS int* tile; };
__device__ __forceinline__ void moe_decode(const MoeTab& T, int rt, Unit& u) {
    const int w = T.tile[rt];
    u.e = w >> 24; u.rb = (w >> 12) & 0xfff; u.rows = w & 0xfff;
}
struct ProbGU : ProbBase {
    MoeTab T; const unsigned char* A; const unsigned char* Bt; unsigned char* O; const int* list; const float* rs2; const float* bgu;
    __device__ __forceinline__ bool next(int i, Unit& u) const { int pm, pn; if (!S.next(i, pm, pn)) return false; u.rt = pm; u.pn = pn; moe_decode(T, pm, u); return true; }
    __device__ __forceinline__ const char* a_base(const Unit&) const { return (const char*)A; }
    __device__ __forceinline__ const char* b_base(const Unit& u) const { return (const char*)Bt + ((size_t)u.e * 2048 + (size_t)u.pn * 256) * RB; }
    __device__ __forceinline__ void a_off(const Unit& u, const int (&R)[2], const int (&C)[2], unsigned (&off)[2][2]) const { int ent[2][2]; a_idx(u, R, ent); a_fin(u, R, C, ent, off); }
    __device__ __forceinline__ void a_idx(const Unit& u, const int (&R)[2], int (&ent)[2][2]) const {
        const int* lp = list + (size_t)u.e * LISTCAP + u.rb * 256;
#pragma unroll
        for (int h = 0; h < 2; ++h)
#pragma unroll
            for (int i = 0; i < 2; ++i) { const int r = h * 128 + R[i]; ent[h][i] = (r < u.rows) ? lp[r] : 0; }
    }
    __device__ __forceinline__ void a_fin(const Unit&, const int (&)[2], const int (&C)[2], const int (&ent)[2][2], unsigned (&off)[2][2]) const {
#pragma unroll
        for (int h = 0; h < 2; ++h)
#pragma unroll
            for (int i = 0; i < 2; ++i) off[h][i] = (unsigned)(ent[h][i] >> 2) * (unsigned)RB + (unsigned)C[i] * 2u;
    }
    __device__ __forceinline__ void epi(const f32x4 (&acc)[2][2][4][2], const Unit& u, int wr, int wc, int fr, int fq) const {
        const float* rsp = rs2 + (size_t)u.e * LISTCAP + u.rb * 256;
        const int j0 = wc * 32 + 8 * fq;
        const float* bg = bgu + (size_t)u.e * 2048 + u.pn * 256 + j0;
        f32x4 bgv[2], buv[2];
#pragma unroll
        for (int n = 0; n < 2; ++n) { bgv[n] = *(const f32x4*)(bg + 4 * n); buv[n] = *(const f32x4*)(bg + 128 + 4 * n); }
#pragma unroll
        for (int ai = 0; ai < 2; ++ai)
#pragma unroll
            for (int m = 0; m < 4; ++m) { const int r = ai * 128 + wr * 64 + m * 16 + fr;
                if (r < u.rows) { const float sc = rsp[r] * W8_INV; const f32x2_t sc2 = (f32x2_t){sc, sc}; unsigned w[2];
#pragma unroll
                    for (int n = 0; n < 2; ++n) { f32x2_t a2[2];
#pragma unroll
                        for (int qp = 0; qp < 2; ++qp) {
                            f32x2_t gt = (f32x2_t){acc[ai][0][m][n][2 * qp], acc[ai][0][m][n][2 * qp + 1]} * sc2 + (f32x2_t){bgv[n][2 * qp], bgv[n][2 * qp + 1]};
                            f32x2_t up = (f32x2_t){acc[ai][1][m][n][2 * qp], acc[ai][1][m][n][2 * qp + 1]} * sc2 + (f32x2_t){buv[n][2 * qp], buv[n][2 * qp + 1]};
                            gt.x = fminf(gt.x, 7.f); gt.y = fminf(gt.y, 7.f); up.x = fminf(fmaxf(up.x, -7.f), 7.f); up.y = fminf(fmaxf(up.y, -7.f), 7.f);
                            const f32x2_t ex = gt * (f32x2_t){-1.702f * 1.4426950408889634f, -1.702f * 1.4426950408889634f};
                            const f32x2_t dn = (f32x2_t){__builtin_amdgcn_exp2f(ex.x), __builtin_amdgcn_exp2f(ex.y)} + (f32x2_t){1.f, 1.f};
                            a2[qp] = (up + (f32x2_t){1.f, 1.f}) * gt * (f32x2_t){frcp_(dn.x), frcp_(dn.y)}; }
                        w[n] = pk4_fp8(a2[0].x, a2[0].y, a2[1].x, a2[1].y); }
                    *(v2u*)(O + (size_t)(u.rt * 256 + r) * DE + u.pn * 128 + j0) = (v2u){w[0], w[1]}; } }
    }
};
struct ProbDown : ProbBase {
    MoeTab T; const unsigned char* A; const unsigned char* Bt; unsigned char* O; const int* list; const float* gw; const float* bd;
    __device__ __forceinline__ bool next(int i, Unit& u) const { int pm, pn; if (!S.next(i, pm, pn)) return false; u.rt = pm; u.pn = pn; moe_decode(T, pm, u); return true; }
    __device__ __forceinline__ const char* a_base(const Unit& u) const { return (const char*)A + (size_t)u.rt * 256 * RB; }
    __device__ __forceinline__ const char* b_base(const Unit& u) const { return (const char*)Bt + ((size_t)u.e * 1024 + (size_t)u.pn * 256) * RB; }
    __device__ __forceinline__ void a_off(const Unit&, const int (&R)[2], const int (&C)[2], unsigned (&off)[2][2]) const { lin_off(R, C, off); }
    __device__ __forceinline__ void epi(const f32x4 (&acc)[2][2][4][2], const Unit& u, int wr, int wc, int fr, int fq) const {
        const int* lp = list + (size_t)u.e * LISTCAP + u.rb * 256;
        const int c0 = u.pn * 256 + wc * 32 + 8 * fq;
        const float* gwp = gw + (size_t)u.e * LISTCAP + u.rb * 256;
        const float* bp = bd + (size_t)u.e * DM + c0;
        f32x4 bv[2][2];
#pragma unroll
        for (int bj = 0; bj < 2; ++bj)
#pragma unroll
            for (int n = 0; n < 2; ++n) bv[bj][n] = *(const f32x4*)(bp + bj * 128 + 4 * n);
#pragma unroll
        for (int ai = 0; ai < 2; ++ai)
#pragma unroll
            for (int m = 0; m < 4; ++m) { const int r = ai * 128 + wr * 64 + m * 16 + fr;
                if (r < u.rows) { const int ent = lp[r]; const float g = gwp[r]; unsigned char* rowp = O + (size_t)ent * DM + c0;
#pragma unroll
                    for (int bj = 0; bj < 2; ++bj) { const f32x4 v0 = (acc[ai][bj][m][0] * W8_INV + bv[bj][0]) * g, v1 = (acc[ai][bj][m][1] * W8_INV + bv[bj][1]) * g;
                        *(v2u*)(rowp + bj * 128) = (v2u){pk4_fp8(v0[0] * SLAB_SCALE, v0[1] * SLAB_SCALE, v0[2] * SLAB_SCALE, v0[3] * SLAB_SCALE), pk4_fp8(v1[0] * SLAB_SCALE, v1[1] * SLAB_SCALE, v1[2] * SLAB_SCALE, v1[3] * SLAB_SCALE)}; } } }
    }
};

typedef short v4i16_t __attribute__((ext_vector_type(4)));
__device__ __forceinline__ void tr_item(const float* W, int ldw, int k0, int nsrc0, bf16* WT, size_t drow0, int ldk, int dk0, const float* ks, const float* ns, LAS unsigned char* scr, int lane) {
    const int kr = lane >> 4, n4 = (lane & 15) * 4;
    f32x4 nsc = (f32x4){1.f, 1.f, 1.f, 1.f}; if (ns) nsc = *(const f32x4*)(ns + nsrc0 + n4);
    f32x4 v[16];
#pragma unroll
    for (int i = 0; i < 16; ++i) v[i] = *(const f32x4*)(W + (size_t)(k0 + 4 * i + kr) * ldw + nsrc0 + n4);
#pragma unroll
    for (int i = 0; i < 16; ++i) { f32x4 x = v[i] * nsc; if (ks) x = x * ks[k0 + 4 * i + kr];
        *(LAS v2u*)(scr + (4 * i + kr) * 192 + n4 * 2) = (v2u){pg8::cvt_pk_bf16(x.x, x.y), pg8::cvt_pk_bf16(x.z, x.w)}; }
    LDS_WAIT(); asm volatile("" ::: "memory");
    const int G = lane >> 4, li = lane & 15, q = li >> 2, p = li & 3;
    const LAS unsigned char* rb = scr + q * 192 + (16 * G + 4 * p) * 2;
    bf16* dst = WT + (drow0 + 16 * G + li) * (size_t)ldk + dk0 + k0;
#pragma unroll
    for (int kc = 0; kc < 8; ++kc) {
        const v4i16_t lo = __builtin_amdgcn_ds_read_tr16_b64_v4i16((LAS v4i16_t*)(rb + (8 * kc) * 192));
        const v4i16_t hi = __builtin_amdgcn_ds_read_tr16_b64_v4i16((LAS v4i16_t*)(rb + (8 * kc + 4) * 192));
        const v2u l2 = __builtin_bit_cast(v2u, lo), h2 = __builtin_bit_cast(v2u, hi);
        *(v4u*)(dst + 8 * kc) = (v4u){l2.x, l2.y, h2.x, h2.y};
    }
    LDS_WAIT(); asm volatile("" ::: "memory");
}

template <int KT, int NT>
__device__ __forceinline__ void tr_item8(const float* W, int ldw, int k0, int nsrc0, unsigned char* WT, size_t drow0, int ldk, const float* ks, float mul, LAS unsigned char* scr, int lane) {
    constexpr int LPR = NT / 4, RPL = 64 / LPR, PA = NT * 2 + 64;
    static_assert(KT * NT == 4096 && (PA / 4) % 32 == 16, "tile geometry");
    const int kr = lane / LPR, n4 = (lane % LPR) * 4;
    f32x4 v[16];
#pragma unroll
    for (int i = 0; i < 16; ++i) v[i] = *(const f32x4*)(W + (size_t)(k0 + RPL * i + kr) * ldw + nsrc0 + n4);
#pragma unroll
    for (int i = 0; i < 16; ++i) { const float sc = ks ? ks[k0 + RPL * i + kr] * mul : mul; const f32x4 x = v[i] * sc;
        *(LAS v2u*)(scr + (RPL * i + kr) * PA + n4 * 2) = (v2u){pg8::cvt_pk_bf16(x.x, x.y), pg8::cvt_pk_bf16(x.z, x.w)}; }
    LDS_WAIT(); asm volatile("" ::: "memory");
    const int G = lane >> 4, li = lane & 15, q = li >> 2, p = li & 3;
#pragma unroll
    for (int ps = 0; ps < NT / 64; ++ps) {
        const LAS unsigned char* rb = scr + q * PA + (16 * (G + 4 * ps) + 4 * p) * 2;
        unsigned char* dst = WT + (drow0 + 16 * (G + 4 * ps) + li) * (size_t)ldk + k0;
#pragma unroll
        for (int kq = 0; kq < KT / 16; ++kq) {
            v2u t[4];
#pragma unroll
            for (int u = 0; u < 4; ++u) t[u] = __builtin_bit_cast(v2u, __builtin_amdgcn_ds_read_tr16_b64_v4i16((LAS v4i16_t*)(rb + (16 * kq + 4 * u) * PA)));
            v4u o;
            o.x = pk4_fp8(bflo(t[0].x), bfhi(t[0].x), bflo(t[0].y), bfhi(t[0].y)); o.y = pk4_fp8(bflo(t[1].x), bfhi(t[1].x), bflo(t[1].y), bfhi(t[1].y));
            o.z = pk4_fp8(bflo(t[2].x), bfhi(t[2].x), bflo(t[2].y), bfhi(t[2].y)); o.w = pk4_fp8(bflo(t[3].x), bfhi(t[3].x), bflo(t[3].y), bfhi(t[3].y));
            *(v4u*)(dst + 16 * kq) = o;
        }
    }
    LDS_WAIT(); asm volatile("" ::: "memory");
}

constexpr int TRF_T1 = 128 * 192, TRF_T2 = 64 * 144, TRF_BYTES = TRF_T1 + TRF_T2;
__device__ __forceinline__ void tr_item8f(const float* W, int ldw, int k0, int nsrc0, unsigned char* WT, size_t drow0, int ldk, const float* ks, float mul, LAS unsigned char* scr, int lane) {
    const int kr = lane >> 4, n4 = (lane & 15) * 4;
#pragma unroll
    for (int hb = 0; hb < 2; ++hb) {
        f32x4 v[16];
#pragma unroll
        for (int i = 0; i < 16; ++i) v[i] = *(const f32x4*)(W + (size_t)(k0 + 64 * hb + 4 * i + kr) * ldw + nsrc0 + n4);
#pragma unroll
        for (int i = 0; i < 16; ++i) { const float sc = ks ? ks[k0 + 64 * hb + 4 * i + kr] * mul : mul; const f32x4 x = v[i] * sc;
            *(LAS v2u*)(scr + (64 * hb + 4 * i + kr) * 192 + n4 * 2) = (v2u){pg8::cvt_pk_bf16(x.x, x.y), pg8::cvt_pk_bf16(x.z, x.w)}; }
    }
    LDS_WAIT(); asm volatile("" ::: "memory");
    const int G = lane >> 4, li = lane & 15, q = li >> 2, p = li & 3;
    const LAS unsigned char* rb = scr + q * 192 + (16 * G + 4 * p) * 2;
    LAS unsigned char* t2 = scr + TRF_T1;
#pragma unroll
    for (int kq = 0; kq < 8; ++kq) {
        v2u t[4];
#pragma unroll
        for (int u = 0; u < 4; ++u) t[u] = __builtin_bit_cast(v2u, __builtin_amdgcn_ds_read_tr16_b64_v4i16((LAS v4i16_t*)(rb + (16 * kq + 4 * u) * 192)));
        v4u o;
        o.x = pk4_fp8(bflo(t[0].x), bfhi(t[0].x), bflo(t[0].y), bfhi(t[0].y)); o.y = pk4_fp8(bflo(t[1].x), bfhi(t[1].x), bflo(t[1].y), bfhi(t[1].y));
        o.z = pk4_fp8(bflo(t[2].x), bfhi(t[2].x), bflo(t[2].y), bfhi(t[2].y)); o.w = pk4_fp8(bflo(t[3].x), bfhi(t[3].x), bflo(t[3].y), bfhi(t[3].y));
        *(LAS v4u*)(t2 + (16 * G + li) * 144 + 16 * kq) = o;
    }
    LDS_WAIT(); asm volatile("" ::: "memory");
    const int r8 = lane >> 3, c8 = lane & 7;
#pragma unroll
    for (int j = 0; j < 8; ++j) { const v4u o = *(const LAS v4u*)(t2 + (8 * j + r8) * 144 + 16 * c8);
        *(v4u*)(WT + (drow0 + 8 * j + r8) * (size_t)ldk + k0 + 16 * c8) = o; }
    LDS_WAIT(); asm volatile("" ::: "memory");
}

constexpr int TRK = 128, TRN = 64;
constexpr int MOE_PREP_ITEMS = 32 * (1024 / TRK) * (2048 / TRN) + 32 * (1024 / TRK) * (1024 / TRN);
__device__ __forceinline__ void moe_weight_prep(Frame& F, int b0, int lo, int hi) {
    const float* fnw = F.in[10]; const float* w_gu = F.in[13]; const float* w_d = F.in[15];
    unsigned char* WguT = F.ws + WS_WGU; unsigned char* WdT = F.ws + WS_WD;
    constexpr int TW = 4;
    if (F.wave >= TW) return;
    LAS unsigned char* scr = F.lds + F.wave * TRF_BYTES;
    const int gw = ((int)blockIdx.x - b0) * TW + F.wave, NGW = (F.G - b0) * TW;
    constexpr int NKB = 1024 / TRK, NNB_GU = 2048 / TRN, NNB_D = 1024 / TRN, SEGN = 128 / TRN;
    constexpr int I_GU = 32 * NKB * NNB_GU;
    for (int it = lo + gw; it < hi; it += NGW) {
        int r = it;
        if (r < I_GU) { const int e = r / (NKB * NNB_GU), r2 = r % (NKB * NNB_GU), kb = r2 / NNB_GU, cb = r2 % NNB_GU;
            const int half = cb / (NNB_GU / 2), t = (cb % (NNB_GU / 2)) / SEGN, nb = cb % SEGN;
            tr_item8f(w_gu + (size_t)e * DM * 2048, 2048, kb * TRK, half * 1024 + t * 128 + nb * TRN, WguT, (size_t)e * 2048 + t * 256 + half * 128 + nb * TRN, DM, fnw, W8_SCALE, scr, F.lane); continue; } r -= I_GU;
        { const int e = r / (NKB * NNB_D), r2 = r % (NKB * NNB_D), kb = r2 / NNB_D, nb = r2 % NNB_D;
          tr_item8f(w_d + (size_t)e * DE * DM, DM, kb * TRK, nb * TRN, WdT, (size_t)e * 1024 + nb * TRN, DE, nullptr, W8_SCALE, scr, F.lane); }
    }
}
static_assert(4 * TRF_BYTES <= LDSCTL_OFF, "transposer LDS");
constexpr int MOE_PREP_SPLIT = 0;

__device__ __forceinline__ void phase_prep(Frame& F) {
    const float* x = F.in[0]; const float* anw = F.in[1]; const float* w_in = F.in[2]; const float* a_log = F.in[4]; const float* dt_bias = F.in[5];
    const float* pool_w = F.in[7]; const float* pool_scale = F.in[8]; const float* w_out = F.in[9]; const float* fnw = F.in[10];
    const float* w_router = F.in[11]; const float* w_gu = F.in[13]; const float* b_gu = F.in[14]; const float* w_d = F.in[15];
    bf16* WinT = (bf16*)(F.ws + WS_WIN); bf16* WoutT = (bf16*)(F.ws + WS_WOUT); bf16* WpoolT = (bf16*)(F.ws + WS_WPOOL);
    bf16* WguT = (bf16*)(F.ws + WS_WGU); bf16* WdT = (bf16*)(F.ws + WS_WD);
    bf16* WrI = (bf16*)(F.ws + WS_WR); float* bguP = (float*)(F.ws + WS_BGU);
    bf16* xb = (bf16*)(F.ws + WS_XB); float* rs1 = (float*)(F.ws + WS_RS1); float* betaA = (float*)(F.ws + WS_BETA); float* gA = (float*)(F.ws + WS_G);
    LAS unsigned char* scr = F.lds + F.wave * 12288;
    LAS float* W8T = (LAS float*)(F.lds + 98304);
    const int gw = F.vcu * NWAVES + F.wave, NGW = F.G * NWAVES;
    const int gt = F.vcu * 512 + F.tid, NGT = F.G * 512;
    for (int idx = F.tid; idx < 8192; idx += 512) { const int k = idx >> 3, c = idx & 7; W8T[c * 1024 + k] = anw[k] * w_in[(size_t)k * DIN + 2048 + c]; }
    __syncthreads();
    constexpr int I_IN1 = 16 * 32, I_OUT = 16 * 16;
    constexpr int NITEMS = I_IN1 + I_OUT;
    for (int it = gw; it < NITEMS; it += NGW) {
        int r = it;
        if (r < I_IN1) { const int kb = r / 32, nb = r % 32; tr_item(w_in, DIN, kb * 64, nb * 64, WinT, (size_t)nb * 64, DM, 0, anw, nullptr, scr, F.lane); continue; } r -= I_IN1;
        { const int kb = r / 16, nb = r % 16; tr_item(w_out, DM, kb * 64, nb * 64, WoutT, (size_t)nb * 64, DM, 0, nullptr, nullptr, scr, F.lane); }
    }
    __syncthreads();
    for (int task = blockIdx.x; task < 256; task += F.G) {
        const int g = task >> 6, kb = (task >> 2) & 15, dq = task & 3;
        LAS float* Wt = (LAS float*)F.lds;
        LAS float* Pw = (LAS float*)(F.lds + 33024);
        for (int idx = F.tid; idx < 64 * 32; idx += 512) { const int k = idx >> 5, c4 = (idx & 31) * 4; const f32x4 v = *(const f32x4*)(w_in + (size_t)(kb * 64 + k) * DIN + 2056 + g * 128 + c4);
            Wt[k * 129 + c4] = v.x; Wt[k * 129 + c4 + 1] = v.y; Wt[k * 129 + c4 + 2] = v.z; Wt[k * 129 + c4 + 3] = v.w; }
        for (int idx = F.tid; idx < 128 * 8; idx += 512) { const int c = idx >> 3, d4 = (idx & 7) * 4; *(LAS f32x4*)(Pw + c * 32 + d4) = *(const f32x4*)(pool_w + (size_t)g * 16384 + c * 128 + dq * 32 + d4); }
        __syncthreads();
        const int k = F.tid & 63, d4 = (F.tid >> 6) * 4;
        f32x4 acc = (f32x4){0.f, 0.f, 0.f, 0.f};
#pragma unroll 8
        for (int c = 0; c < 128; ++c) acc += *(const LAS f32x4*)(Pw + c * 32 + d4) * Wt[k * 129 + c];
        const int n0 = g * 128 + dq * 32 + d4; const f32x4 ps = *(const f32x4*)(pool_scale + n0); const float an = anw[kb * 64 + k];
        bf16* dst = WinT + (size_t)(2048 + n0) * DM + kb * 64 + k;
        dst[0] = (bf16)f2bf(acc.x * ps.x * an); dst[DM] = (bf16)f2bf(acc.y * ps.y * an); dst[2 * DM] = (bf16)f2bf(acc.z * ps.z * an); dst[3 * DM] = (bf16)f2bf(acc.w * ps.w * an);
        __syncthreads();
    }
    moe_weight_prep(F, 0, 0, MOE_PREP_SPLIT);
    for (int idx = gt; idx < NE * 2048; idx += NGT) { const int e = idx >> 11, r = idx & 2047, t = r >> 8, j = r & 255, half = j >> 7, jj = j & 127; bguP[idx] = b_gu[(size_t)e * 2048 + half * 1024 + t * 128 + jj]; }
    for (int idx = gt; idx < 64 * 64 * 8; idx += NGT) { const int j = idx & 7, ln = (idx >> 3) & 63, fr2 = idx >> 9, nb = fr2 & 1, ks = fr2 >> 1;
        const int k = 32 * ks + 8 * (ln >> 4) + j, e = 16 * nb + (ln & 15); const float v = fnw[k] * w_router[(size_t)k * NE + e];
        const unsigned hb = f2bf(v); const float hf = __builtin_bit_cast(float, hb << 16); const unsigned lb = f2bf(v - hf);
        WrI[((size_t)(fr2 * 2 + 0) * 64 + ln) * 8 + j] = (bf16)hb; WrI[((size_t)(fr2 * 2 + 1) * 64 + ln) * 8 + j] = (bf16)lb; }
    for (int m = gw; m < NTOK; m += NGW) {
        const f32x4* xr = (const f32x4*)(x + (size_t)m * DM) + F.lane;
        f32x4 v[4]; float ss = 0.f; float d8[8];
#pragma unroll
        for (int c = 0; c < 8; ++c) d8[c] = 0.f;
#pragma unroll
        for (int j = 0; j < 4; ++j) { v[j] = xr[64 * j]; ss += (v[j].x * v[j].x + v[j].y * v[j].y) + (v[j].z * v[j].z + v[j].w * v[j].w); }
#pragma unroll
        for (int c = 0; c < 8; ++c)
#pragma unroll
            for (int j = 0; j < 4; ++j) { const f32x4 w = *(const LAS f32x4*)(W8T + c * 1024 + 256 * j + 4 * F.lane); d8[c] += (v[j].x * w.x + v[j].y * w.y) + (v[j].z * w.z + v[j].w * w.w); }
        ss = wave_sum(ss);
#pragma unroll
        for (int c = 0; c < 8; ++c) d8[c] = wave_sum(d8[c]);
        const float rs = 1.f / sqrtf(ss * (1.f / DM) + 1e-6f);
        unsigned long long* o8 = (unsigned long long*)(xb + (size_t)m * DM) + F.lane;
#pragma unroll
        for (int j = 0; j < 4; ++j) o8[64 * j] = (unsigned long long)pk2(v[j].x, v[j].y) | ((unsigned long long)pk2(v[j].z, v[j].w) << 32);
        if (F.lane == 0) rs1[m] = rs;
        if (F.lane < 4) {
            float bl = 0.f, al = 0.f;
#pragma unroll
            for (int c = 0; c < 4; ++c) { bl = (F.lane == c) ? d8[c] : bl; al = (F.lane == c) ? d8[4 + c] : al; }
            bl *= rs; al *= rs;
            betaA[(size_t)m * 4 + F.lane] = 1.f / (1.f + expf(-bl));
            const float z = al + dt_bias[F.lane]; const float sp = z > 20.f ? z : log1pf(expf(z));
            gA[(size_t)m * 4 + F.lane] = -expf(a_log[F.lane]) * sp;
        }
    }
}

__device__ __forceinline__ void phase_mix(Frame& F) {
    const bf16* proj = (const bf16*)(F.ws + WS_PROJ); bf16* mixed = (bf16*)(F.ws + WS_CONCAT) + 512;
    const int gw = F.vcu * NWAVES + F.wave, NGW = F.G * NWAVES;
    const int ch = 8 * F.lane, gi = F.lane >> 4, win = 2 << gi, hal = win - 1;
    for (int rbk = gw; rbk < NTOK / 16; rbk += NGW) {
        const int m0 = rbk * 16, t0 = m0 % SEQ;
        v4u X[31];
#pragma unroll
        for (int k = 0; k < 31; ++k) { X[k] = (v4u){0u, 0u, 0u, 0u}; if (k >= 15 - hal && t0 - 15 + k >= 0) X[k] = *(const v4u*)(proj + (size_t)(m0 - 15 + k) * NPROJ + 2048 + ch); }
        float s[8];
#pragma unroll
        for (int q = 0; q < 8; ++q) s[q] = 0.f;
#pragma unroll
        for (int k = 0; k < 15; ++k) { s[0] += bflo(X[k].x); s[1] += bfhi(X[k].x); s[2] += bflo(X[k].y); s[3] += bfhi(X[k].y); s[4] += bflo(X[k].z); s[5] += bfhi(X[k].z); s[6] += bflo(X[k].w); s[7] += bfhi(X[k].w); }
#pragma unroll
        for (int r = 0; r < 16; ++r) {
            const v4u u = X[15 + r];
            const float p[8] = {bflo(u.x), bfhi(u.x), bflo(u.y), bfhi(u.y), bflo(u.z), bfhi(u.z), bflo(u.w), bfhi(u.w)};
#pragma unroll
            for (int q = 0; q < 8; ++q) s[q] += p[q];
            const int tt = t0 + r + 1; const float ic = 1.f / (float)(tt < win ? tt : win);
            v4u o; o.x = pk2(s[0] * ic - p[0], s[1] * ic - p[1]); o.y = pk2(s[2] * ic - p[2], s[3] * ic - p[3]); o.z = pk2(s[4] * ic - p[4], s[5] * ic - p[5]); o.w = pk2(s[6] * ic - p[6], s[7] * ic - p[7]);
            *(v4u*)(mixed + (size_t)(m0 + r) * DM + ch) = o;
            const v4u od = gi == 0 ? X[14 + r] : gi == 1 ? X[12 + r] : gi == 2 ? X[8 + r] : X[r];
            s[0] -= bflo(od.x); s[1] -= bfhi(od.x); s[2] -= bflo(od.y); s[3] -= bfhi(od.y); s[4] -= bflo(od.z); s[5] -= bfhi(od.z); s[6] -= bflo(od.w); s[7] -= bfhi(od.w);
        }
    }
}

typedef float f32x16 __attribute__((ext_vector_type(16)));
__device__ __forceinline__ bf16x8 pack8(const f32x4 a, const f32x4 b) {
    v4u w; w.x = cvt_pk_bf16(a[0], a[1]); w.y = cvt_pk_bf16(a[2], a[3]); w.z = cvt_pk_bf16(b[0], b[1]); w.w = cvt_pk_bf16(b[2], b[3]);
    return __builtin_bit_cast(bf16x8, w);
}
__device__ __forceinline__ void fmac_(float& acc, float a, float b) { asm("v_fmac_f32 %0, %1, %2" : "+v"(acc) : "v"(a), "v"(b)); }
__device__ __forceinline__ float bf2f(unsigned short u) { return __builtin_bit_cast(float, (unsigned)u << 16); }

constexpr int SOLVE_D = 5;
struct RQ { int i, j; };
__host__ __device__ constexpr int solve_nq(int i) { return (i + 3) / 4; }
__host__ __device__ constexpr RQ solve_adv(int i, int j, int d) { while (d-- > 0 && i < 64) { if (j + 1 < solve_nq(i)) ++j; else { ++i; j = 0; } } return RQ{i, j}; }
template <int I, int J> __device__ __forceinline__ void solve_step(float (&U)[64], const LAS float* Am, const f32x4 (&win)[SOLVE_D], float s0, float s1, float s2, float s3) {
    if constexpr (I < 64) {
        constexpr RQ P = solve_adv(I, J, SOLVE_D);
        f32x4 nw = (f32x4){0.f, 0.f, 0.f, 0.f};
        if constexpr (P.i < 64) nw = *(const LAS f32x4*)(Am + P.i * 64 + 4 * P.j);
        const f32x4 a = win[0];
        fmac_(s0, a.x, U[4 * J]); if constexpr (4 * J + 1 < I) fmac_(s1, a.y, U[4 * J + 1]); if constexpr (4 * J + 2 < I) fmac_(s2, a.z, U[4 * J + 2]); if constexpr (4 * J + 3 < I) fmac_(s3, a.w, U[4 * J + 3]);
        f32x4 nx[SOLVE_D];
#pragma unroll
        for (int q = 0; q + 1 < SOLVE_D; ++q) nx[q] = win[q + 1];
        nx[SOLVE_D - 1] = nw;
        __builtin_amdgcn_sched_barrier(0);
        if constexpr (J + 1 < solve_nq(I)) solve_step<I, J + 1>(U, Am, nx, s0, s1, s2, s3);
        else { U[I] -= (s0 + s1) + (s2 + s3); solve_step<I + 1, 0>(U, Am, nx, 0.f, 0.f, 0.f, 0.f); }
    }
}
__device__ __forceinline__ void solve_all(float (&U)[64], const LAS float* Am) {
    f32x4 win[SOLVE_D];
#pragma unroll
    for (int q = 0; q < SOLVE_D; ++q) { constexpr RQ dummy{0, 0}; (void)dummy; }
    { constexpr RQ p0 = solve_adv(1, 0, 0), p1 = solve_adv(1, 0, 1), p2 = solve_adv(1, 0, 2), p3 = solve_adv(1, 0, 3), p4 = solve_adv(1, 0, 4);
      win[0] = *(const LAS f32x4*)(Am + p0.i * 64 + 4 * p0.j); win[1] = *(const LAS f32x4*)(Am + p1.i * 64 + 4 * p1.j); win[2] = *(const LAS f32x4*)(Am + p2.i * 64 + 4 * p2.j);
      win[3] = *(const LAS f32x4*)(Am + p3.i * 64 + 4 * p3.j); win[4] = *(const LAS f32x4*)(Am + p4.i * 64 + 4 * p4.j); }
    static_assert(SOLVE_D == 5, "window priming is written for SOLVE_D = 5");
    solve_step<1, 0>(U, Am, win, 0.f, 0.f, 0.f, 0.f);
}

constexpr int CP_QN = 0, CP_KN = 17408, CP_VA = 34816, CP_QKL = 51200, CP_SC = 59392, CP_HALF = 60416, CP_CW = 2 * CP_HALF;
__device__ __forceinline__ void phase_chunk(Frame& F, int blk0, int nblk, int n_lo, int n_cnt) {
    const float* conv_w = F.in[3];
    const bf16* proj = (const bf16*)(F.ws + WS_PROJ);
    const float* betaA = (const float*)(F.ws + WS_BETA); const float* gA = (const float*)(F.ws + WS_G);
    float* gtotA = (float*)(F.ws + WS_GTOT);
    const int half = F.wave >> 2, hw = F.wave & 3;
    LAS unsigned char* L = F.lds + half * CP_HALF;
    LAS bf16* qn = (LAS bf16*)(L + CP_QN); LAS bf16* kn = (LAS bf16*)(L + CP_KN); LAS bf16* vn = (LAS bf16*)(L + CP_VA);
    LAS float* Am = (LAS float*)(L + CP_VA); LAS bf16* qkL = (LAS bf16*)(L + CP_QKL); LAS float* sc = (LAS float*)(L + CP_SC);
    LAS float* cwL = (LAS float*)(F.lds + CP_CW);
    for (int idx = F.tid; idx < 4 * 1536 / 4; idx += 512) *(LAS f32x4*)(cwL + 4 * idx) = *(const f32x4*)(conv_w + 4 * idx);
    __syncthreads();
    const int nunits = NB * NH * n_cnt, nrounds = (nunits + 2 * nblk - 1) / (2 * nblk);
#pragma unroll 1
    for (int it = 0; it < nrounds; ++it) {
        int tid_ = F.tid; asm volatile("" : "+v"(tid_));
        const int ht = tid_ & 255, lane = tid_ & 63, r16 = lane & 15, gq = lane >> 4;
        int v_ = (it * nblk + ((int)blockIdx.x - blk0)) * 2 + half; asm volatile("" : "+s"(v_));
        const bool live = v_ < nunits;
        const int bh = live ? v_ / n_cnt : 0, n = live ? n_lo + v_ % n_cnt : 0, b = bh >> 2, h = bh & 3; const int unit = bh * 64 + n;
        const size_t m0 = (size_t)b * SEQ + (size_t)n * 64;
        unsigned char* chunk = F.ws + WS_CHUNK + (size_t)unit * CH_BYTES;
        const int rq = ht >> 4, cg = ht & 15;
        v4u Xa[7], Xb[7]; float gi = 0.f, bi = 0.f;
#define CHUNK_LOADX(X, p_) do { _Pragma("unroll") for (int jj = 0; jj < 7; ++jj) { const int trow = n * 64 + 4 * rq - 3 + jj; const int trc = trow < 0 ? 0 : trow; \
            const v4u u_ = *(const v4u*)(proj + ((size_t)b * SEQ + trc) * NPROJ + (p_) * 512 + h * 128 + 8 * cg); const unsigned mk_ = trow < 0 ? 0u : 0xffffffffu; \
            X[jj] = (v4u){u_.x & mk_, u_.y & mk_, u_.z & mk_, u_.w & mk_}; } } while (0)
#define CHUNK_CONV(X, p_) do { const int col = (p_) * 512 + h * 128 + 8 * cg; float wv[4][8]; \
            _Pragma("unroll") for (int j = 0; j < 4; ++j) { const f32x4 w0 = *(const LAS f32x4*)(cwL + j * 1536 + col), w1 = *(const LAS f32x4*)(cwL + j * 1536 + col + 4); \
                wv[j][0] = w0.x; wv[j][1] = w0.y; wv[j][2] = w0.z; wv[j][3] = w0.w; wv[j][4] = w1.x; wv[j][5] = w1.y; wv[j][6] = w1.z; wv[j][7] = w1.w; } \
            _Pragma("unroll") for (int rr = 0; rr < 4; ++rr) { float y[8]; \
                _Pragma("unroll") for (int q = 0; q < 8; ++q) y[q] = 0.f; \
                _Pragma("unroll") for (int j = 0; j < 4; ++j) { const v4u u = X[rr + j]; \
                    fmac_(y[0], wv[j][0], bflo(u.x)); fmac_(y[1], wv[j][1], bfhi(u.x)); fmac_(y[2], wv[j][2], bflo(u.y)); fmac_(y[3], wv[j][3], bfhi(u.y)); \
                    fmac_(y[4], wv[j][4], bflo(u.z)); fmac_(y[5], wv[j][5], bfhi(u.z)); fmac_(y[6], wv[j][6], bflo(u.w)); fmac_(y[7], wv[j][7], bfhi(u.w)); } \
                float ss = 0.f; \
                _Pragma("unroll") for (int q = 0; q < 8; ++q) { y[q] = siluf_(y[q]); ss += y[q] * y[q]; } \
                float scl = 1.f; \
                if ((p_) < 2) { ss += __shfl_xor(ss, 1); ss += __shfl_xor(ss, 2); ss += __shfl_xor(ss, 4); ss += __shfl_xor(ss, 8); scl = frsq_(ss + 1e-6f); if ((p_) == 0) scl *= 0.08838834764831845f; } \
                v4u o; o.x = cvt_pk_bf16(y[0] * scl, y[1] * scl); o.y = cvt_pk_bf16(y[2] * scl, y[3] * scl); o.z = cvt_pk_bf16(y[4] * scl, y[5] * scl); o.w = cvt_pk_bf16(y[6] * scl, y[7] * scl); \
                const int row = 4 * rq + rr; \
                if ((p_) == 0) *(LAS v4u*)(qn + row * 136 + 8 * cg) = o; else if ((p_) == 1) *(LAS v4u*)(kn + row * 136 + 8 * cg) = o; else *(LAS v4u*)(vn + row * 128 + 8 * cg) = o; \
                __builtin_amdgcn_sched_barrier(0); } } while (0)
        if (live) { CHUNK_LOADX(Xa, 0); CHUNK_LOADX(Xb, 1); if (hw == 0) { gi = gA[(m0 + lane) * 4 + h]; bi = betaA[(m0 + lane) * 4 + h]; } }
        if (live && hw == 0) {
            float c = gi;
#pragma unroll
            for (int o = 1; o < 64; o <<= 1) { const float tt = __shfl_up(c, o); if (lane >= o) c += tt; }
            const float gl = __shfl(c, 63);
            sc[lane] = bi; sc[64 + lane] = c; sc[128 + lane] = fexp_(c); sc[192 + lane] = fexp_(gl - c);
            if (lane == 63) gtotA[unit] = fexp_(c);
        }
        if (live) { CHUNK_CONV(Xa, 0); CHUNK_LOADX(Xa, 2); CHUNK_CONV(Xb, 1); CHUNK_CONV(Xa, 2); }
#undef CHUNK_LOADX
#undef CHUNK_CONV
        __syncthreads();
        const int which = ht >> 7, c = ht & 127;
        float U[64];
        if (live) {
#pragma unroll
            for (int i = 0; i < 64; ++i) { const float bi = sc[i]; const float tv = which ? bf2f(kn[i * 136 + c]) * sc[128 + i] : bf2f(vn[i * 128 + c]); U[i] = tv * bi; }
        } else {
#pragma unroll
            for (int i = 0; i < 64; ++i) U[i] = 0.f;
        }
        __syncthreads();
        if (live) {
            const int ti = hw >> 1, tj = hw & 1, r = lane & 31, hh = lane >> 5;
            f32x16 KK, QK;
#pragma unroll
            for (int q = 0; q < 16; ++q) { KK[q] = 0.f; QK[q] = 0.f; }
#pragma unroll
            for (int ks = 0; ks < 8; ++ks) {
                const bf16x8 ak = *(const LAS bf16x8*)(kn + (ti * 32 + r) * 136 + 16 * ks + 8 * hh);
                const bf16x8 aq = *(const LAS bf16x8*)(qn + (ti * 32 + r) * 136 + 16 * ks + 8 * hh);
                const bf16x8 bb = *(const LAS bf16x8*)(kn + (tj * 32 + r) * 136 + 16 * ks + 8 * hh);
                KK = __builtin_amdgcn_mfma_f32_32x32x16_bf16(ak, bb, KK, 0, 0, 0);
                QK = __builtin_amdgcn_mfma_f32_32x32x16_bf16(aq, bb, QK, 0, 0, 0);
            }
            const int j = tj * 32 + r; const float gcj = sc[64 + j];
#pragma unroll
            for (int reg = 0; reg < 16; ++reg) { const int i = ti * 32 + (reg & 3) + 8 * (reg >> 2) + 4 * hh;
                const float dec = (i >= j) ? __expf(sc[64 + i] - gcj) : 0.f;
                Am[i * 64 + j] = (i > j) ? sc[i] * KK[reg] * dec : 0.f;
                qkL[i * 64 + j] = (bf16)f2bf((i >= j) ? QK[reg] * dec : 0.f); }
        }
        __syncthreads();
        if (live) {
#pragma unroll
            for (int fi = 0; fi < 4; ++fi) { const int f = hw * 4 + fi, mb = f >> 2, ks = f & 3, row = 16 * mb + r16; const float s = sc[128 + row];
                const v2u lo = *(const LAS v2u*)(qn + row * 136 + 32 * ks + 4 * gq), hi = *(const LAS v2u*)(qn + row * 136 + 32 * ks + 16 + 4 * gq);
                v4u o; o.x = pk2(bflo(lo.x) * s, bfhi(lo.x) * s); o.y = pk2(bflo(lo.y) * s, bfhi(lo.y) * s); o.z = pk2(bflo(hi.x) * s, bfhi(hi.x) * s); o.w = pk2(bflo(hi.y) * s, bfhi(hi.y) * s);
                *(v4u*)(chunk + CH_QD + (f * 64 + lane) * 16) = o; }
#pragma unroll
            for (int fi = 0; fi < 4; ++fi) { const int f = hw * 4 + fi, db = f >> 1, ksp = f & 1, dcol = 16 * db + r16; float e[8];
#pragma unroll
                for (int j = 0; j < 8; ++j) { const int i = 32 * ksp + 16 * (j >> 2) + 4 * gq + (j & 3); e[j] = bf2f(kn[i * 136 + dcol]) * sc[192 + i]; }
                v4u o; o.x = pk2(e[0], e[1]); o.y = pk2(e[2], e[3]); o.z = pk2(e[4], e[5]); o.w = pk2(e[6], e[7]);
                *(v4u*)(chunk + CH_KT + (f * 64 + lane) * 16) = o; }
#pragma unroll
            for (int fi = 0; fi < 2; ++fi) { const int f = hw * 2 + fi, mb = f >> 1, ksp = f & 1, row = 16 * mb + r16;
                const v2u lo = *(const LAS v2u*)(qkL + row * 64 + 32 * ksp + 4 * gq), hi = *(const LAS v2u*)(qkL + row * 64 + 32 * ksp + 16 + 4 * gq);
                *(v4u*)(chunk + CH_QK + (f * 64 + lane) * 16) = (v4u){lo.x, lo.y, hi.x, hi.y}; }
            solve_all(U, Am);
        }
        __syncthreads();
        if (live) {
            if (which == 0) {
                const int w8 = c >> 4, cl = c & 15;
                unsigned char* ub = F.ws + WS_UC + (size_t)unit * UC_BYTES;
#pragma unroll
                for (int g = 0; g < 4; ++g) {
                    v4u lo, hi;
                    lo.x = pk2(U[4 * g], U[4 * g + 1]); lo.y = pk2(U[4 * g + 2], U[4 * g + 3]); lo.z = pk2(U[16 + 4 * g], U[16 + 4 * g + 1]); lo.w = pk2(U[16 + 4 * g + 2], U[16 + 4 * g + 3]);
                    hi.x = pk2(U[32 + 4 * g], U[32 + 4 * g + 1]); hi.y = pk2(U[32 + 4 * g + 2], U[32 + 4 * g + 3]); hi.z = pk2(U[48 + 4 * g], U[48 + 4 * g + 1]); hi.w = pk2(U[48 + 4 * g + 2], U[48 + 4 * g + 3]);
                    v4u* dst = (v4u*)(ub + ((w8 * 64 + g * 16 + cl) * 32)); dst[0] = lo; dst[1] = hi;
                }
            } else {
#pragma unroll
                for (int i = 0; i < 64; ++i) qn[i * 136 + c] = (bf16)f2bf(U[i]);
            }
        }
        __syncthreads();
        if (live) {
#pragma unroll
            for (int fi = 0; fi < 4; ++fi) { const int f = hw * 4 + fi, mb = f >> 2, ks = f & 3, row = 16 * mb + r16;
                const v2u lo = *(const LAS v2u*)(qn + row * 136 + 32 * ks + 4 * gq), hi = *(const LAS v2u*)(qn + row * 136 + 32 * ks + 16 + 4 * gq);
                *(v4u*)(chunk + CH_WF + (f * 64 + lane) * 16) = (v4u){lo.x, lo.y, hi.x, hi.y}; }
        }
        __syncthreads();
    }
}

constexpr int SCAN_SPLIT = 32;
constexpr int SC_STAGED = 49152, SC_NLOAD = 16;
struct ScanU { v4u u0, u1; };
struct ScanQ { v4u q[8]; };
__device__ __forceinline__ void scan_issue_u(ScanU& R, const unsigned char* up) {
    asm volatile("global_load_dwordx4 %0, %1, off" : "=v"(R.u0) : "v"(up) : "memory");
    asm volatile("global_load_dwordx4 %0, %1, off offset:16" : "=v"(R.u1) : "v"(up) : "memory");
}
__device__ __forceinline__ void scan_issue_q(ScanQ& R, const unsigned char* qp) {
    asm volatile("global_load_dwordx4 %0, %1, off" : "=v"(R.q[0]) : "v"(qp) : "memory");
    asm volatile("global_load_dwordx4 %0, %1, off offset:1024" : "=v"(R.q[1]) : "v"(qp) : "memory");
    asm volatile("global_load_dwordx4 %0, %1, off offset:2048" : "=v"(R.q[2]) : "v"(qp) : "memory");
    asm volatile("global_load_dwordx4 %0, %1, off offset:3072" : "=v"(R.q[3]) : "v"(qp) : "memory");
    const unsigned char* qp2 = qp + 4096;
    asm volatile("global_load_dwordx4 %0, %1, off" : "=v"(R.q[4]) : "v"(qp2) : "memory");
    asm volatile("global_load_dwordx4 %0, %1, off offset:1024" : "=v"(R.q[5]) : "v"(qp2) : "memory");
    asm volatile("global_load_dwordx4 %0, %1, off offset:2048" : "=v"(R.q[6]) : "v"(qp2) : "memory");
    asm volatile("global_load_dwordx4 %0, %1, off offset:3072" : "=v"(R.q[7]) : "v"(qp2) : "memory");
}
#define SCAN_WAIT_REGS(U, Q, cnt) asm volatile("s_waitcnt vmcnt(" #cnt ")" : "+v"(U.u0), "+v"(U.u1), "+v"(Q.q[0]), "+v"(Q.q[1]), "+v"(Q.q[2]), "+v"(Q.q[3]), "+v"(Q.q[4]), "+v"(Q.q[5]), "+v"(Q.q[6]), "+v"(Q.q[7]) :: "memory")
template <class Bar> __device__ __forceinline__ void phase_scan(Frame& F, const Bar& mid_barrier) {
    const int bh = blockIdx.x, b = bh >> 2, h = bh & 3, w = F.wave, lane = F.lane, cl = lane & 15, gq = lane >> 4;
    const float* gtotA = (const float*)(F.ws + WS_GTOT);
    const int unit0 = bh * 64;
    const unsigned char* cbase = F.ws + WS_CHUNK + (size_t)unit0 * CH_BYTES;
    const unsigned char* ubase = F.ws + WS_UC + (size_t)unit0 * UC_BYTES + (w * 64 + lane) * 32;
    const unsigned char* qbase = cbase + CH_QK + lane * 16;
    bf16* op = (bf16*)(F.ws + WS_ORAW) + ((size_t)b * SEQ + cl) * 512 + h * 128 + 16 * w + 4 * gq;
    f32x4 Sacc[8]; bf16x8 Sb[4];
#pragma unroll
    for (int d = 0; d < 8; ++d) Sacc[d] = (f32x4){0.f, 0.f, 0.f, 0.f};
#pragma unroll
    for (int k = 0; k < 4; ++k) Sb[k] = (bf16x8){0, 0, 0, 0, 0, 0, 0, 0};
    v2u Ow[4];
#pragma unroll
    for (int mb = 0; mb < 4; ++mb) Ow[mb] = (v2u){0u, 0u};
    ScanU U0, U1, U2; ScanQ QA, QB;
#define SCAN_ISSUE(nn) do { const unsigned char* s_ = cbase + (size_t)(nn) * CH_BYTES + (w * 6) * 1024 + lane * 16; LAS unsigned char* d_ = F.lds + ((nn) % 3) * SC_STAGED + (w * 6) * 1024; \
        _Pragma("unroll") for (int k_ = 0; k_ < 6; ++k_) __builtin_amdgcn_global_load_lds((const unsigned*)(s_ + k_ * 1024), (LAS unsigned*)(d_ + k_ * 1024), 16, 0, 0); } while (0)
#define SCAN_STEP(n, UC, UN, Q, ISSUE2, WAITCNT) do { \
        SCAN_WAIT_REGS(UC, Q, WAITCNT); asm volatile("s_waitcnt lgkmcnt(0)" ::: "memory"); __builtin_amdgcn_s_barrier(); asm volatile("" ::: "memory"); \
        const float gt = __shfl(gtv, (n) & 31); \
        if (ISSUE2) { scan_issue_u(UN, ubase + (size_t)((n) + 2) * UC_BYTES); SCAN_ISSUE((n) + 2); } \
        if ((n) > 0) { _Pragma("unroll") for (int mb = 0; mb < 4; ++mb) *(v2u*)(op + (size_t)(((n) - 1) * 64 + 16 * mb) * 512) = Ow[mb]; } \
        const LAS unsigned char* B = F.lds + ((n) % 3) * SC_STAGED; \
        f32x4 P[4]; \
        _Pragma("unroll") for (int mb = 0; mb < 4; ++mb) { P[mb] = (f32x4){0.f, 0.f, 0.f, 0.f}; \
            _Pragma("unroll") for (int ks = 0; ks < 4; ++ks) P[mb] = __builtin_amdgcn_mfma_f32_16x16x32_bf16(SFRAG(CH_WF, mb * 4 + ks), Sb[ks], P[mb], 0, 0, 0); } \
        f32x4 vnw[4]; \
        vnw[0] = (f32x4){bflo(UC.u0.x), bfhi(UC.u0.x), bflo(UC.u0.y), bfhi(UC.u0.y)} - P[0]; \
        vnw[1] = (f32x4){bflo(UC.u0.z), bfhi(UC.u0.z), bflo(UC.u0.w), bfhi(UC.u0.w)} - P[1]; \
        vnw[2] = (f32x4){bflo(UC.u1.x), bfhi(UC.u1.x), bflo(UC.u1.y), bfhi(UC.u1.y)} - P[2]; \
        vnw[3] = (f32x4){bflo(UC.u1.z), bfhi(UC.u1.z), bflo(UC.u1.w), bfhi(UC.u1.w)} - P[3]; \
        bf16x8 Vb[2]; Vb[0] = pack8(vnw[0], vnw[1]); Vb[1] = pack8(vnw[2], vnw[3]); \
        _Pragma("unroll") for (int mb = 0; mb < 4; ++mb) { f32x4 OT = (f32x4){0.f, 0.f, 0.f, 0.f}; \
            _Pragma("unroll") for (int ks = 0; ks < 4; ++ks) OT = __builtin_amdgcn_mfma_f32_16x16x32_bf16(Sb[ks], SFRAG(CH_QD, mb * 4 + ks), OT, 0, 0, 0); \
            _Pragma("unroll") for (int ksp = 0; ksp < 2; ++ksp) OT = __builtin_amdgcn_mfma_f32_16x16x32_bf16(Vb[ksp], __builtin_bit_cast(bf16x8, Q.q[mb * 2 + ksp]), OT, 0, 0, 0); \
            Ow[mb] = (v2u){cvt_pk_bf16(OT[0], OT[1]), cvt_pk_bf16(OT[2], OT[3])}; } \
        asm volatile("s_nop 7" : "+v"(Q.q[0]), "+v"(Q.q[1]), "+v"(Q.q[2]), "+v"(Q.q[3]), "+v"(Q.q[4]), "+v"(Q.q[5]), "+v"(Q.q[6]), "+v"(Q.q[7]));     \
        if (ISSUE2) scan_issue_q(Q, qbase + (size_t)((n) + 2) * CH_BYTES); \
        _Pragma("unroll") for (int db = 0; db < 8; ++db) { Sacc[db] = Sacc[db] * gt; \
            _Pragma("unroll") for (int ksp = 0; ksp < 2; ++ksp) Sacc[db] = __builtin_amdgcn_mfma_f32_16x16x32_bf16(SFRAG(CH_KT, db * 2 + ksp), Vb[ksp], Sacc[db], 0, 0, 0); } \
        _Pragma("unroll") for (int ks = 0; ks < 4; ++ks) Sb[ks] = pack8(Sacc[2 * ks], Sacc[2 * ks + 1]); \
    } while (0)
#define SFRAG(off, f) (*(const LAS bf16x8*)(B + (off) + ((f) * 64 + lane) * 16))
    static_assert(CH_WF == 0 && CH_QD == 16384 && CH_KT == 32768 && CH_QK == SC_STAGED && SCAN_SPLIT % 6 == 2 && 2 * SCAN_SPLIT == 64, "staged part = the first 48 KiB of a chunk; a half = 5 x 6 + 2 steps");
#pragma unroll 1
    for (int part = 0; part < 2; ++part) {
        const int n0 = part * SCAN_SPLIT;
        float gtv = gtotA[unit0 + n0 + (lane & 31)];
        asm volatile("s_waitcnt vmcnt(0)" : "+v"(gtv) :: "memory");
        scan_issue_u(U0, ubase + (size_t)n0 * UC_BYTES); SCAN_ISSUE(n0); scan_issue_q(QA, qbase + (size_t)n0 * CH_BYTES);
        scan_issue_u(U1, ubase + (size_t)(n0 + 1) * UC_BYTES); SCAN_ISSUE(n0 + 1); scan_issue_q(QB, qbase + (size_t)(n0 + 1) * CH_BYTES);
#pragma unroll 1
        for (int n = n0; n < n0 + SCAN_SPLIT - 2; n += 6) {
            SCAN_STEP(n, U0, U2, QA, true, 16);
            SCAN_STEP(n + 1, U1, U0, QB, true, 16);
            SCAN_STEP(n + 2, U2, U1, QA, true, 16);
            SCAN_STEP(n + 3, U0, U2, QB, true, 16);
            SCAN_STEP(n + 4, U1, U0, QA, true, 16);
            SCAN_STEP(n + 5, U2, U1, QB, true, 16);
        }
        SCAN_STEP(n0 + SCAN_SPLIT - 2, U0, U2, QA, false, 16);
        SCAN_STEP(n0 + SCAN_SPLIT - 1, U1, U0, QB, false, 0);
        if (part == 0) mid_barrier();
    }
#undef SFRAG
#undef SCAN_STEP
#undef SCAN_ISSUE
#pragma unroll
    for (int mb = 0; mb < 4; ++mb) *(v2u*)(op + (size_t)(63 * 64 + 16 * mb) * 512) = Ow[mb];
    VM_WAIT(); __syncthreads();
}

__device__ __forceinline__ void phase_onorm(Frame& F) {
    const float* dnw = F.in[6]; const bf16* proj = (const bf16*)(F.ws + WS_PROJ); const bf16* oraw = (const bf16*)(F.ws + WS_ORAW); bf16* concat = (bf16*)(F.ws + WS_CONCAT);
    const int gw = F.vcu * NWAVES + F.wave, NGW = F.G * NWAVES, lane = F.lane;
    const int cc = 8 * (lane & 15);
    const f32x4 d0 = *(const f32x4*)(dnw + cc), d1 = *(const f32x4*)(dnw + cc + 4);
    for (int m = gw; m < NTOK; m += NGW) {
        const v4u o = *(const v4u*)(oraw + (size_t)m * 512 + 8 * lane);
        const v4u z = *(const v4u*)(proj + (size_t)m * NPROJ + 1536 + 8 * lane);
        const float ov[8] = {bflo(o.x), bfhi(o.x), bflo(o.y), bfhi(o.y), bflo(o.z), bfhi(o.z), bflo(o.w), bfhi(o.w)};
        const float zv[8] = {bflo(z.x), bfhi(z.x), bflo(z.y), bfhi(z.y), bflo(z.z), bfhi(z.z), bflo(z.w), bfhi(z.w)};
        float ss = 0.f;
#pragma unroll
        for (int q = 0; q < 8; ++q) ss += ov[q] * ov[q];
        ss += __shfl_xor(ss, 1); ss += __shfl_xor(ss, 2); ss += __shfl_xor(ss, 4); ss += __shfl_xor(ss, 8);
        const float rs = frsq_(ss * (1.f / 128.f) + 1e-6f);
        const float dv[8] = {d0.x, d0.y, d0.z, d0.w, d1.x, d1.y, d1.z, d1.w};
        float r[8];
#pragma unroll
        for (int q = 0; q < 8; ++q) r[q] = ov[q] * rs * dv[q] * siluf_(zv[q]);
        *(v4u*)(concat + (size_t)m * DM + 8 * lane) = (v4u){cvt_pk_bf16(r[0], r[1]), cvt_pk_bf16(r[2], r[3]), cvt_pk_bf16(r[4], r[5]), cvt_pk_bf16(r[6], r[7])};
    }
}

__device__ __forceinline__ void phase_route(Frame& F) {
    const bf16* x1 = (const bf16*)(F.ws + WS_X1); const float* b_router = F.in[12];
    unsigned char* x1b = F.ws + WS_X1B; float* rs2A = (float*)(F.ws + WS_RS2); int* list = (int*)(F.ws + WS_LIST);
    float* rsl = (float*)(F.ws + WS_RSL); float* gwl = (float*)(F.ws + WS_GWL);
    unsigned* cntw = (unsigned*)(F.ws + WS_CTL) + CW_CNT;
    LAS unsigned char* WI = F.lds;
    LAS unsigned* lcnt = (LAS unsigned*)(F.lds + TAB_OFF);
    { const v4u* src = (const v4u*)(F.ws + WS_WR);
      for (int idx = F.tid; idx < 131072 / 16; idx += 512) *(LAS v4u*)(WI + 16 * idx) = src[idx]; }
    const int lane = F.lane, c = lane & 15, g = lane >> 4;
    const int gw = F.vcu * NWAVES + F.wave, NGW = F.G * NWAVES, NT = NTOK / 16;
    const float bia0 = b_router[c], bia1 = b_router[16 + c];
    for (int t0 = 0; t0 < NT; t0 += NGW) {
        const int tile = t0 + gw; const bool live = tile < NT;
        if (F.tid < 64) lcnt[F.tid] = 0u;
        __syncthreads();
        int my_e = 0; float my_g = 0.f, my_rs = 0.f; unsigned my_rank = 0u; int my_ent = 0;
        if (live) {
            const int m0 = tile * 16;
            const bf16* xrow = x1 + (size_t)(m0 + c) * DM + 8 * g;
            unsigned char* xbrow = x1b + (size_t)(m0 + c) * DM + 8 * g;
            f32x4 acc0 = (f32x4){0.f, 0.f, 0.f, 0.f}, acc1 = acc0; float ssq = 0.f;
#pragma unroll 1
            for (int kb = 0; kb < 2; ++kb) {
                v4u xa[16];
#pragma unroll
                for (int q = 0; q < 16; ++q) xa[q] = *(const v4u*)(xrow + 32 * (kb * 16 + q));
#pragma unroll
                for (int q = 0; q < 16; ++q) { const int ks = kb * 16 + q; const v4u h = xa[q];
                    const float a0 = bflo(h.x), a1 = bfhi(h.x), a2 = bflo(h.y), a3 = bfhi(h.y), b0 = bflo(h.z), b1 = bfhi(h.z), b2 = bflo(h.w), b3 = bfhi(h.w);
                    ssq += (a0 * a0 + a1 * a1) + (a2 * a2 + a3 * a3) + (b0 * b0 + b1 * b1) + (b2 * b2 + b3 * b3);
                    *(v2u*)(xbrow + 32 * ks) = (v2u){pk4_fp8(a0, a1, a2, a3), pk4_fp8(b0, b1, b2, b3)};
                    const bf16x8 ah = __builtin_bit_cast(bf16x8, h);
                    const LAS unsigned char* fb = WI + (size_t)(ks * 4) * 1024 + lane * 16;
                    const bf16x8 b0h = *(const LAS bf16x8*)(fb), b0l = *(const LAS bf16x8*)(fb + 1024), b1h = *(const LAS bf16x8*)(fb + 2048), b1l = *(const LAS bf16x8*)(fb + 3072);
                    acc0 = __builtin_amdgcn_mfma_f32_16x16x32_bf16(ah, b0h, acc0, 0, 0, 0); acc0 = __builtin_amdgcn_mfma_f32_16x16x32_bf16(ah, b0l, acc0, 0, 0, 0);
                    acc1 = __builtin_amdgcn_mfma_f32_16x16x32_bf16(ah, b1h, acc1, 0, 0, 0); acc1 = __builtin_amdgcn_mfma_f32_16x16x32_bf16(ah, b1l, acc1, 0, 0, 0); }
            }
            ssq += __shfl_xor(ssq, 16); ssq += __shfl_xor(ssq, 32);
            const float rsr = frsq_(ssq * (1.f / DM) + 1e-6f);
            if (g == 0) rs2A[m0 + c] = rsr;
            float ge_[4]; int ee_[4];
#pragma unroll
            for (int reg = 0; reg < 4; ++reg) {
                const float rsw = __shfl(rsr, 4 * g + reg);
                float v0 = acc0[reg] * rsw + bia0, v1 = acc1[reg] * rsw + bia1;
                float tv[4]; int te[4];
#pragma unroll
                for (int s = 0; s < 4; ++s) {
                    float bv; int bi; if (v1 > v0) { bv = v1; bi = 16 + c; } else { bv = v0; bi = c; }
#pragma unroll
                    for (int o = 1; o < 16; o <<= 1) { const float ov = __shfl_xor(bv, o); const int oi = __shfl_xor(bi, o); if (ov > bv || (ov == bv && oi < bi)) { bv = ov; bi = oi; } }
                    tv[s] = bv; te[s] = bi; if (bi == c) v0 = -3.0e38f; if (bi == 16 + c) v1 = -3.0e38f;
                }
                const float e1 = fexp_(tv[1] - tv[0]), e2 = fexp_(tv[2] - tv[0]), e3 = fexp_(tv[3] - tv[0]); const float inv = frcp_(1.f + e1 + e2 + e3);
                const int s_ = c & 3; const float gsel = (s_ == 0 ? 1.f : s_ == 1 ? e1 : s_ == 2 ? e2 : e3) * inv; const int esel = s_ == 0 ? te[0] : s_ == 1 ? te[1] : s_ == 2 ? te[2] : te[3];
                ge_[reg] = gsel; ee_[reg] = esel;
            }
            const int rsel = c >> 2;
            my_g = rsel == 0 ? ge_[0] : rsel == 1 ? ge_[1] : rsel == 2 ? ge_[2] : ge_[3];
            my_e = rsel == 0 ? ee_[0] : rsel == 1 ? ee_[1] : rsel == 2 ? ee_[2] : ee_[3];
            my_ent = (m0 + 4 * g + rsel) * 4 + (c & 3);
            my_rs = __shfl(rsr, 4 * g + rsel);
            my_rank = __hip_atomic_fetch_add(lcnt + my_e, 1u, __ATOMIC_RELAXED, __HIP_MEMORY_SCOPE_WORKGROUP);
        }
        __syncthreads();
        if (F.tid < NE) { const unsigned n = lcnt[F.tid]; lcnt[32 + F.tid] = n ? __hip_atomic_fetch_add(cntw + 64 * F.tid, n, RLX_AGENT) : 0u; }
        __syncthreads();
        if (live) { const size_t pos = (size_t)my_e * LISTCAP + lcnt[32 + my_e] + my_rank; list[pos] = my_ent; rsl[pos] = my_rs; gwl[pos] = my_g; }
        __syncthreads();
    }
}

constexpr int TILE_TAB_OFF = pg8::STAGE_BYTES + 8192;
__device__ __forceinline__ int moe_tables(Frame& F, MoeTab& T) {
    LAS int* pref = (LAS int*)(F.lds + TAB_OFF); LAS int* cnt = pref + 40; LAS int* tile = (LAS int*)(F.lds + TILE_TAB_OFF);
    unsigned* cntw = (unsigned*)(F.ws + WS_CTL) + CW_CNT;
    if (F.tid == 0) { int acc = 0; for (int e = 0; e < NE; ++e) { const int c = (int)__hip_atomic_load(cntw + 64 * e, RLX_AGENT); cnt[e] = c; pref[e] = acc; acc += (c + 255) >> 8; } pref[NE] = acc; }
    __syncthreads();
    const int RT = pref[NE];
    for (int rt = F.tid; rt < RT; rt += NWAVES * 64) { int e = 0;
        for (int j = 1; j < NE; ++j) if (pref[j] <= rt) e = j;
        const int rb = rt - pref[e], left = cnt[e] - rb * 256;
        tile[rt] = (e << 24) | (rb << 12) | (left < 256 ? left : 256); }
    __syncthreads();
    T.pref = pref; T.cnt = cnt; T.tile = tile;
    return RT;
}

struct FinalRow { f32x4 v[4]; v2u sl[4][2]; };
__device__ __forceinline__ void final_load(FinalRow& R, const bf16* xrow, const unsigned char* srow) {
#pragma unroll
    for (int j = 0; j < 2; ++j) { const v4u h = *(const v4u*)(xrow + 512 * j);
        R.v[2 * j] = (f32x4){bflo(h.x), bfhi(h.x), bflo(h.y), bfhi(h.y)}; R.v[2 * j + 1] = (f32x4){bflo(h.z), bfhi(h.z), bflo(h.w), bfhi(h.w)}; }
#pragma unroll
    for (int s = 0; s < 4; ++s)
#pragma unroll
        for (int j = 0; j < 2; ++j) R.sl[s][j] = *(const v2u*)(srow + (size_t)s * DM + 512 * j);
}
__device__ __forceinline__ void final_finish(FinalRow& R, float* orow, const f32x4 (&wv)[4]) {
#pragma unroll
    for (int s = 0; s < 4; ++s)
#pragma unroll
        for (int j = 0; j < 2; ++j) { const v2u u = R.sl[s][j];
            const f32x2_t a0 = __builtin_amdgcn_cvt_pk_f32_fp8((int)u.x, false), a1 = __builtin_amdgcn_cvt_pk_f32_fp8((int)u.x, true), b0 = __builtin_amdgcn_cvt_pk_f32_fp8((int)u.y, false), b1 = __builtin_amdgcn_cvt_pk_f32_fp8((int)u.y, true);
            R.v[2 * j].x += a0.x * SLAB_INV; R.v[2 * j].y += a0.y * SLAB_INV; R.v[2 * j].z += a1.x * SLAB_INV; R.v[2 * j].w += a1.y * SLAB_INV;
            R.v[2 * j + 1].x += b0.x * SLAB_INV; R.v[2 * j + 1].y += b0.y * SLAB_INV; R.v[2 * j + 1].z += b1.x * SLAB_INV; R.v[2 * j + 1].w += b1.y * SLAB_INV; }
    float ss = 0.f;
#pragma unroll
    for (int j = 0; j < 4; ++j) ss += (R.v[j].x * R.v[j].x + R.v[j].y * R.v[j].y) + (R.v[j].z * R.v[j].z + R.v[j].w * R.v[j].w);
    ss = wave_sum(ss);
    const float rs = frsq_(ss * (1.f / DM) + 1e-6f);
#pragma unroll
    for (int j = 0; j < 2; ++j) { *(f32x4*)(orow + 512 * j) = R.v[2 * j] * rs * wv[2 * j]; *(f32x4*)(orow + 512 * j + 4) = R.v[2 * j + 1] * rs * wv[2 * j + 1]; }
}
__device__ __forceinline__ void phase_final(Frame& F, int dryrun) {
    const float* fw = F.in[17]; const unsigned char* slab = F.ws + WS_SLAB; float* out = F.out;
    const bf16* x1 = (const bf16*)(F.ws + WS_X1); (void)dryrun;
    const int gw = F.vcu * NWAVES + F.wave, NGW = F.G * NWAVES, lane = F.lane;
    f32x4 wv[4];
#pragma unroll
    for (int j = 0; j < 2; ++j) { wv[2 * j] = *(const f32x4*)(fw + 512 * j + 8 * lane); wv[2 * j + 1] = *(const f32x4*)(fw + 512 * j + 8 * lane + 4); }
    FinalRow A, B;
    int m = gw;
    if (m < NTOK) final_load(A, x1 + (size_t)m * DM + 8 * lane, slab + (size_t)m * 4 * DM + 8 * lane);
    for (; m < NTOK; m += 2 * NGW) {
        const int m1 = m + NGW, m2 = m + 2 * NGW;
        if (m1 < NTOK) final_load(B, x1 + (size_t)m1 * DM + 8 * lane, slab + (size_t)m1 * 4 * DM + 8 * lane);
        final_finish(A, out + (size_t)m * DM + 8 * lane, wv);
        if (m2 < NTOK) final_load(A, x1 + (size_t)m2 * DM + 8 * lane, slab + (size_t)m2 * 4 * DM + 8 * lane);
        if (m1 < NTOK) final_finish(B, out + (size_t)m1 * DM + 8 * lane, wv);
    }
}

struct Args { const float* in[18]; float* out; unsigned char* ws; int ph_lo, ph_hi, flag, breg; };
constexpr int NPHASE = 11;

__global__ void __launch_bounds__(NWAVES * 64, 2) mk_fwd(Args args) {
    extern __shared__ __attribute__((aligned(16))) unsigned char lds_raw[];
    Frame F;
    F.lds = (LAS unsigned char*)lds_raw;
    F.tid = threadIdx.x; F.lane = F.tid & 63; F.wave = __builtin_amdgcn_readfirstlane(F.tid >> 6);
    F.G = gridDim.x; { const int bx = blockIdx.x; F.vcu = (F.G % 8 == 0) ? (bx % 8) * (F.G / 8) + bx / 8 : bx; }
#pragma unroll
    for (int i = 0; i < 18; ++i) F.in[i] = args.in[i];
    F.out = args.out; F.ws = args.ws;
    volatile LAS unsigned* MISC = (volatile LAS unsigned*)(F.lds + MISC_OFF);
    for (int u = F.tid; u < (LDS_BYTES - LDSCTL_OFF) / 4; u += NWAVES * 64) ((LAS unsigned*)(F.lds + LDSCTL_OFF))[u] = 0u;
    __syncthreads();
    unsigned* ctl = (unsigned*)(F.ws + WS_CTL);
#if !MK_PER_PHASE
    XcdBarrier bar = xcd_barrier_post(ctl + CW_BAR, MISC + 8);
#define GRID_BAR() xcd_barrier(bar)
#else
#define GRID_BAR() do {} while (0)
#endif
    const int lo = args.ph_lo, hi = args.ph_hi;
#define IN(k) (lo <= (k) && (k) < hi)
#define SEAM(k) do { if (IN(k) && IN((k) + 1)) GRID_BAR(); } while (0)

#define RUNPH(k, ...) do { if (IN(k)) { __VA_ARGS__; } SEAM(k); } while (0)
    RUNPH(0, phase_prep(F));
    RUNPH(1, {
        ProbIn P; P.K = DM; P.RB = 2 * DM; P.S.init(NTOK / 256, NPROJ / 256, F.G, (int)blockIdx.x);
        P.A = (const bf16*)(F.ws + WS_XB); P.Bt = (const bf16*)(F.ws + WS_WIN); P.O = (bf16*)(F.ws + WS_PROJ); P.rs = (const float*)(F.ws + WS_RS1);
        pg8::gemm_phase(F.lds, P); });
    if (IN(2)) { phase_mix(F); __syncthreads(); }
    RUNPH(3, phase_chunk(F, 0, F.G, 0, SCAN_SPLIT));
    RUNPH(4, {
        const int nscan = NB * NH;
        unsigned* seam = ctl + CW_SEAM4 + 64 * args.breg;
        auto scan_wait = [&]() {
            asm volatile("s_waitcnt vmcnt(0)" ::: "memory"); __syncthreads();
            if (F.tid == 0) { const unsigned want = (unsigned)(F.G - nscan); unsigned sp = 0u;
                while (__hip_atomic_load(seam, RLX_AGENT) < want) { __builtin_amdgcn_s_sleep(2); if (++sp > (1u << 22)) break; }
                __builtin_amdgcn_fence(__ATOMIC_ACQUIRE, "agent"); asm volatile("s_waitcnt vmcnt(0)" ::: "memory"); }
            __syncthreads();
        };
        if ((int)blockIdx.x < nscan) phase_scan(F, scan_wait);
        else {
               phase_chunk(F, nscan, F.G - nscan, SCAN_SPLIT, 64 - SCAN_SPLIT);
               asm volatile("s_waitcnt vmcnt(0)" ::: "memory"); __syncthreads();
               if (F.tid == 0) { __builtin_amdgcn_fence(__ATOMIC_RELEASE, "agent"); asm volatile("s_waitcnt vmcnt(0)" ::: "memory"); __hip_atomic_fetch_add(seam, 1u, RLX_AGENT); }
               moe_weight_prep(F, nscan, MOE_PREP_SPLIT, MOE_PREP_ITEMS); } });
    RUNPH(5, phase_onorm(F));
    RUNPH(6, {
        ProbOut P; P.K = DM; P.RB = 2 * DM; P.S.init(NTOK / 256, DM / 256, F.G, (int)blockIdx.x);
        P.A = (const bf16*)(F.ws + WS_CONCAT); P.Bt = (const bf16*)(F.ws + WS_WOUT); P.X = (const bf16*)(F.ws + WS_XB); P.O = (bf16*)(F.ws + WS_X1);
        pg8::gemm_phase(F.lds, P); });
    RUNPH(7, phase_route(F));
    RUNPH(8, {
        ProbGU P; const int RT = moe_tables(F, P.T);
        P.K = DM; P.RB = DM; P.S.init(RT, 8, F.G, (int)blockIdx.x);
        P.A = F.ws + WS_X1B; P.Bt = F.ws + WS_WGU; P.O = F.ws + WS_ACT; P.list = (const int*)(F.ws + WS_LIST);
        P.rs2 = (const float*)(F.ws + WS_RSL); P.bgu = (const float*)(F.ws + WS_BGU);
        pg8::gemm_phase<ProbGU, true>(F.lds, P); });
    RUNPH(9, {
        ProbDown P; const int RT = moe_tables(F, P.T);
        P.K = DE; P.RB = DE; P.S.init(RT, 4, F.G, (int)blockIdx.x);
        P.A = F.ws + WS_ACT; P.Bt = F.ws + WS_WD; P.O = F.ws + WS_SLAB; P.list = (const int*)(F.ws + WS_LIST);
        P.gw = (const float*)(F.ws + WS_GWL); P.bd = F.in[16];
        pg8::gemm_phase<ProbDown, true>(F.lds, P); });
    RUNPH(10, phase_final(F, args.flag));
#undef RUNPH
#undef IN
#undef SEAM
}

extern "C" void kernel_launch(void* const* d_in, const int* in_sizes, int n_in, void* d_out, int out_size, void* d_ws, size_t ws_size, hipStream_t stream) {
    static int grid = 0;
    if (grid == 0) {
        if (n_in != 18 || in_sizes[0] != NTOK * DM || out_size != NTOK * DM || ws_size < WS_END) { fprintf(stderr, "kernel_launch: unexpected shapes (n_in %d, in0 %d, out %d, ws %zu)\n", n_in, n_in > 0 ? in_sizes[0] : -1, out_size, ws_size); grid = -1; return; }
        int dev = 0, cus = 0, per_cu = 0;
        if (hipGetDevice(&dev) != hipSuccess || hipDeviceGetAttribute(&cus, hipDeviceAttributeMultiprocessorCount, dev) != hipSuccess) { grid = -1; return; }
        if (hipFuncSetAttribute((const void*)mk_fwd, hipFuncAttributeMaxDynamicSharedMemorySize, LDS_BYTES) != hipSuccess) { fprintf(stderr, "kernel_launch: hipFuncSetAttribute failed\n"); grid = -1; return; }
        if (hipOccupancyMaxActiveBlocksPerMultiprocessor(&per_cu, (const void*)mk_fwd, NWAVES * 64, LDS_BYTES) != hipSuccess || per_cu < 1) { fprintf(stderr, "kernel_launch: occupancy query says %d\n", per_cu); per_cu = 1; }
        (void)hipGetLastError();
        grid = cus;
    }
    if (grid < 0) return;
    (void)hipMemsetAsync((char*)d_ws + WS_CTL, 0, CTL_ZERO_BYTES, stream);
    Args a{};
    for (int i = 0; i < 18; ++i) a.in[i] = (const float*)d_in[i];
    a.out = (float*)d_out; a.ws = (unsigned char*)d_ws;
#if MK_PER_PHASE
    for (int p = 0; p < NPHASE; ++p) { a.ph_lo = p; a.ph_hi = p + 1; const int nrep = 1 + REP_CNT * ((REP_MASK >> p) & 1);
        for (int r = 0; r < nrep; ++r) { a.flag = (p == NPHASE - 1 && r + 1 < nrep) ? 1 : 0; a.breg = r; hipLaunchKernelGGL(mk_fwd, dim3(grid), dim3(NWAVES * 64), LDS_BYTES, stream, a); } }
#else
    a.ph_lo = 0; a.ph_hi = NPHASE;
    hipLaunchKernelGGL(mk_fwd, dim3(grid), dim3(NWAVES * 64), LDS_BYTES, stream, a);
#endif
}
```

```cpp
#include <hip/hip_runtime.h>
#include <cstdio>
#include <cstdint>

#ifndef REP_MASK
#define REP_MASK 0
#endif
#ifndef REP_CNT
#define REP_CNT 1
#endif
#ifndef MK_PER_PHASE
#define MK_PER_PHASE 0
#endif

constexpr int NB = 8, SEQ = 4096, DM = 1024, NTOK = NB * SEQ;
constexpr int NH = 4, HD = 128, DDN = 512, DPOOL = 512, DIN = 2568, NPROJ = 2560;
constexpr int NE = 32, TOPK = 4, DE = 1024, NASSIGN = NTOK * TOPK;
constexpr int LISTCAP = NTOK;
constexpr int ACT_ROWS = NASSIGN + NE * 256;

constexpr size_t MiB = 1u << 20;
constexpr size_t WS_CTL = 0, CTL_ZERO_BYTES = 1 * MiB;
constexpr size_t WS_WIN = 1 * MiB;
constexpr size_t WS_WOUT = 6 * MiB;
constexpr size_t WS_WPOOL = 8 * MiB;
constexpr size_t WS_WR = 8 * MiB + 512 * 1024;
constexpr size_t WS_BGU = 8 * MiB + 768 * 1024;
constexpr size_t WS_RS1 = 9 * MiB;
constexpr size_t WS_BETA = 9 * MiB + 128 * 1024;
constexpr size_t WS_G = 9 * MiB + 640 * 1024;
constexpr size_t WS_RS2 = 10 * MiB + 256 * 1024;
constexpr size_t WS_GATEW = 10 * MiB + 512 * 1024;
constexpr size_t WS_LIST = 11 * MiB;
constexpr size_t WS_RSL = 800 * MiB;
constexpr size_t WS_GWL = 804 * MiB;
constexpr size_t WS_WGU = 16 * MiB;
constexpr size_t WS_WD = 144 * MiB;
constexpr size_t WS_XB = 208 * MiB;
constexpr size_t WS_PROJ = 272 * MiB;
constexpr size_t WS_CHUNK = 432 * MiB;
constexpr size_t WS_UC = 544 * MiB;
constexpr size_t WS_GTOT = 576 * MiB;
constexpr size_t WS_ORAW = 577 * MiB;
constexpr int CH_WF = 0, CH_QD = 16384, CH_KT = 32768, CH_QK = 49152, CH_BYTES = 57344, UC_BYTES = 16384;
constexpr size_t WS_MIXED = 688 * MiB;
constexpr size_t WS_CONCAT = 720 * MiB;
constexpr size_t WS_X1B = 208 * MiB;
constexpr size_t WS_ACT = 272 * MiB;
constexpr size_t WS_SLAB = 544 * MiB;
constexpr size_t WS_X1 = 808 * MiB;
constexpr size_t WS_END = 872 * MiB;
static_assert(WS_ACT + (size_t)ACT_ROWS * 2048 <= WS_SLAB, "act fits");
static_assert(WS_SLAB + (size_t)NASSIGN * 2048 <= WS_END, "slab fits");

constexpr int CW_BAR = 4096;
constexpr int CW_CNT = 16384;
constexpr int CW_SEAM4 = 20480;

constexpr int LDS_BYTES = 163840;
constexpr int LDSCTL_OFF = LDS_BYTES - 1024, MISC_OFF = LDSCTL_OFF + 320, TAB_OFF = LDSCTL_OFF + 512;
constexpr int NWAVES = 8;

#define GAS __attribute__((address_space(1)))
#define LAS __attribute__((address_space(3)))
typedef unsigned short bf16;
typedef unsigned v4u __attribute__((ext_vector_type(4)));
typedef unsigned v2u __attribute__((ext_vector_type(2)));
typedef float f32x4 __attribute__((ext_vector_type(4)));
typedef float f32x2 __attribute__((ext_vector_type(2)));
typedef short bf16x8 __attribute__((ext_vector_type(8)));
typedef GAS unsigned gu32;
#define RLX_AGENT __ATOMIC_RELAXED, __HIP_MEMORY_SCOPE_AGENT
#define LDS_WAIT() asm volatile("s_waitcnt lgkmcnt(0)" ::: "memory")
#define VM_WAIT() asm volatile("s_waitcnt vmcnt(0)" ::: "memory")

__device__ __forceinline__ unsigned f2bf(float f) { unsigned u = __builtin_bit_cast(unsigned, f); return (u + 0x7fffu + ((u >> 16) & 1u)) >> 16; }
__device__ __forceinline__ unsigned pk2(float lo, float hi) { return f2bf(lo) | (f2bf(hi) << 16); }
__device__ __forceinline__ float bflo(unsigned u) { return __builtin_bit_cast(float, u << 16); }
__device__ __forceinline__ float bfhi(unsigned u) { return __builtin_bit_cast(float, u & 0xffff0000u); }
__device__ __forceinline__ unsigned pk4_fp8(float a, float b, float c, float d) { int p = __builtin_amdgcn_cvt_pk_fp8_f32(a, b, 0, false); p = __builtin_amdgcn_cvt_pk_fp8_f32(c, d, p, true); return (unsigned)p; }
typedef float f32x2_t __attribute__((ext_vector_type(2)));
constexpr float SLAB_SCALE = 16.f, SLAB_INV = 1.f / 16.f;
constexpr float W8_SCALE = 32.f, W8_INV = 1.f / 32.f;
__device__ __forceinline__ float wave_sum(float v) {
#pragma unroll
    for (int o = 1; o < 64; o <<= 1) v += __shfl_xor(v, o);
    return v;
}
__device__ __forceinline__ float frcp_(float x) { return __builtin_amdgcn_rcpf(x); }
__device__ __forceinline__ float frsq_(float x) { return __builtin_amdgcn_rsqf(x); }
__device__ __forceinline__ float fexp_(float x) { return __builtin_amdgcn_exp2f(x * 1.4426950408889634f); }
__device__ __forceinline__ float sigmoidf_(float x) { return frcp_(1.f + fexp_(-x)); }
__device__ __forceinline__ float siluf_(float x) { return x * frcp_(1.f + fexp_(-x)); }

namespace pg8 {
constexpr int BM = 256, BK = 64, HALF = 128, HTB = HALF * BK * 2, STAGE_BYTES = 8 * HTB;
constexpr int EPI_TAB_OFF = STAGE_BYTES + 8192 + 4096, EPI_TAB_BYTES = 3072;
__device__ __forceinline__ int lds_byte(int r, int c) { const int st = (r >> 4) * 2 + (c >> 5), rr = r & 15, cc = c & 31, ob = rr * 64 + cc * 2; return st * 1024 + (ob ^ (((ob >> 9) & 1) << 5)); }
__device__ __forceinline__ void stage_rc(int b, int& R, int& C) { const int st = b / 1024, sb = b % 1024, swz = sb ^ (((sb >> 9) & 1) << 5); R = (st >> 1) * 16 + swz / 64; C = (st & 1) * 32 + (swz % 64) / 2; }
__device__ __forceinline__ int perm32(int rho) { const int n = rho >> 4, i = rho & 15; return 8 * (i >> 2) + 4 * n + (i & 3); }
typedef __bf16 bf16x2_t __attribute__((ext_vector_type(2)));
__device__ __forceinline__ unsigned cvt_pk_bf16(float lo, float hi) { const f32x2 v = {lo, hi}; const bf16x2_t b = __builtin_convertvector(v, bf16x2_t); return __builtin_bit_cast(unsigned, b); }

struct Unit { int rt, pn, e, rb, rows; };

struct Sched {
    int nM, nN, nwg, G, c;
    __device__ __forceinline__ void init(int nM_, int nN_, int G_, int c_) { nM = nM_; nN = nN_; nwg = nM * nN; G = G_; c = c_; }
    __device__ __forceinline__ bool next(int i, int& pm, int& pn) const {
        const long L = (long)i * G + c; if (L >= nwg) return false;
        int wgid = (int)L; { const int q = nwg / 8, r = nwg % 8, xcd = wgid % 8, off = wgid / 8; wgid = (xcd < r ? xcd * (q + 1) : r * (q + 1) + (xcd - r) * q) + off; }
        const int nig = 8 * nN, gid = wgid / nig, fm = gid * 8, gsz = (nM - fm) < 8 ? (nM - fm) : 8;
        pm = fm + ((wgid % nig) % gsz); pn = (wgid % nig) / gsz; return true;
    }
};

typedef int v8i_t __attribute__((ext_vector_type(8)));
template <class P, bool F8 = false>
__device__ __forceinline__ void gemm_phase(LAS unsigned char* lds, const P& p) {
    const int tid = threadIdx.x, wid = __builtin_amdgcn_readfirstlane(tid >> 6), lane = tid & 63, wr = wid >> 2, wc = wid & 3, fr = lane & 15, fq = lane >> 4;
    const int K = p.K, RB = F8 ? K : 2 * K, nt = RB / (BK * 2);
    unsigned voffB[2];
#pragma unroll
    for (int i = 0; i < 2; ++i) { int R_, C_; stage_rc(tid * 16 + i * 8192, R_, C_); const int Rb = (R_ & ~31) + perm32(R_ & 31); voffB[i] = (unsigned)(Rb * RB + C_ * 2); }
#define PG8_AOFF(unit, dst) do { int R[2], C[2]; asm volatile("" ::: "memory"); _Pragma("unroll") for (int i_ = 0; i_ < 2; ++i_) stage_rc(tid * 16 + i_ * 8192, R[i_], C[i_]); p.a_off(unit, R, C, dst); } while (0)
    const size_t kstep = (size_t)(BK * 2);
    const size_t hstep = (size_t)HALF * RB;
    const unsigned ldsw = (unsigned)wid * 1024u;
    const int aoff = lds_byte(wr * 64 + fr, fq * 8), boff = lds_byte(wc * 32 + fr, fq * 8);
#define PG8_SA(b, h) (((b) * 2 + (h)) * HTB)
#define PG8_SB(b, h) ((4 + (b) * 2 + (h)) * HTB)
#define PG8_STAGE(bufoff, gbase, voff) do { _Pragma("unroll") for (int _i = 0; _i < 2; ++_i) \
        __builtin_amdgcn_global_load_lds((const unsigned*)((const char*)(gbase) + (voff)[_i]), (LAS unsigned*)(lds + (bufoff) + ldsw + _i * 8192), 16, 0, 0); } while (0)
#define PG8_LDA(dst, b, h) do { _Pragma("unroll") for (int m = 0; m < 4; ++m) { const v4i_t l_ = *(const LAS v4i_t*)(lds + PG8_SA(b, h) + aoff + m * 2048), h_ = *(const LAS v4i_t*)(lds + PG8_SA(b, h) + aoff + m * 2048 + 1024); dst[m] = __builtin_shufflevector(l_, h_, 0, 1, 2, 3, 4, 5, 6, 7); } } while (0)
#define PG8_LDB(dst, b, h) do { _Pragma("unroll") for (int n = 0; n < 2; ++n) { const v4i_t l_ = *(const LAS v4i_t*)(lds + PG8_SB(b, h) + boff + n * 2048), h_ = *(const LAS v4i_t*)(lds + PG8_SB(b, h) + boff + n * 2048 + 1024); dst[n] = __builtin_shufflevector(l_, h_, 0, 1, 2, 3, 4, 5, 6, 7); } } while (0)
#define PG8_HALF(x, k) __builtin_bit_cast(bf16x8, __builtin_shufflevector(x, x, 4 * (k), 4 * (k) + 1, 4 * (k) + 2, 4 * (k) + 3))
#define PG8_MMA(ai, bj, At, Bt) do { __builtin_amdgcn_s_setprio(1); \
        if constexpr (F8) { _Pragma("unroll") for (int m = 0; m < 4; ++m) _Pragma("unroll") for (int n = 0; n < 2; ++n) \
            asm volatile("v_mfma_scale_f32_16x16x128_f8f6f4 %0, %1, %2, %0, %3, %3 op_sel_hi:[0,0,0]" : "+v"(acc[ai][bj][m][n]) : "v"(Bt[n]), "v"(At[m]), "v"(mxs)); } \
        else { _Pragma("unroll") for (int m = 0; m < 4; ++m) _Pragma("unroll") for (int n = 0; n < 2; ++n) { \
            acc[ai][bj][m][n] = __builtin_amdgcn_mfma_f32_16x16x32_bf16(PG8_HALF(Bt[n], 0), PG8_HALF(At[m], 0), acc[ai][bj][m][n], 0, 0, 0); \
            acc[ai][bj][m][n] = __builtin_amdgcn_mfma_f32_16x16x32_bf16(PG8_HALF(Bt[n], 1), PG8_HALF(At[m], 1), acc[ai][bj][m][n], 0, 0, 0); } } \
        __builtin_amdgcn_s_setprio(0); } while (0)
#define PG8_WAIT_V(n) asm volatile("s_waitcnt vmcnt(" #n ")" ::: "memory")
#define PG8_WAIT_L(n) asm volatile("s_waitcnt lgkmcnt(" #n ")" ::: "memory")
#define PG8_BAR __builtin_amdgcn_s_barrier()
#define PG8_SCHED __builtin_amdgcn_sched_barrier(0)
    Unit cur, nxt; int ui = 0;
    if (!p.next(0, cur)) return;
    unsigned mxs = 0x7f7f7f7fu; asm volatile("" : "+v"(mxs));
    f32x4 acc[2][2][4][2];
#pragma unroll
    for (int a = 0; a < 2; ++a)
#pragma unroll
        for (int b = 0; b < 2; ++b)
#pragma unroll
            for (int m = 0; m < 4; ++m)
#pragma unroll
                for (int n = 0; n < 2; ++n) acc[a][b][m][n] = (f32x4){0.f, 0.f, 0.f, 0.f};
    typedef int v4i_t __attribute__((ext_vector_type(4)));
    v8i_t At[4], B0[2], B1[2];
    unsigned oA[2][2];
    PG8_AOFF(cur, oA);
    const char* cA = p.a_base(cur); const char* cB = p.b_base(cur);
    PG8_STAGE(PG8_SB(0, 0), cB, voffB); PG8_STAGE(PG8_SB(0, 1), cB + hstep, voffB); PG8_STAGE(PG8_SA(0, 0), cA, oA[0]); PG8_STAGE(PG8_SA(0, 1), cA, oA[1]);
    if (wr == 1) PG8_BAR;
    PG8_WAIT_V(2); PG8_BAR;
    PG8_STAGE(PG8_SB(1, 0), cB + kstep, voffB); PG8_STAGE(PG8_SA(1, 0), cA + kstep, oA[0]); PG8_STAGE(PG8_SB(1, 1), cB + hstep + kstep, voffB);
    PG8_WAIT_V(6); PG8_BAR;
    LAS v4u* park = (LAS v4u*)(lds + STAGE_BYTES) + tid;
#define PG8_AIDX(unit, ent) do { int R[2], C[2]; asm volatile("" ::: "memory"); _Pragma("unroll") for (int i_ = 0; i_ < 2; ++i_) stage_rc(tid * 16 + i_ * 8192, R[i_], C[i_]); p.a_idx(unit, R, ent); } while (0)
#define PG8_AFIN(unit, ent, dst) do { int R[2], C[2]; asm volatile("" ::: "memory"); _Pragma("unroll") for (int i_ = 0; i_ < 2; ++i_) stage_rc(tid * 16 + i_ * 8192, R[i_], C[i_]); p.a_fin(unit, R, C, ent, dst); } while (0)
    Unit nn; int ent[2][2]; int ev[3];
    LAS unsigned char* etab = lds + EPI_TAB_OFF;
    p.e_idx(cur, tid, ev);
    bool has_next = p.next(1, nxt);
    if (has_next) PG8_AIDX(nxt, ent); else ent[0][0] = ent[0][1] = ent[1][0] = ent[1][1] = 0;
    for (;;) {
        const char* nA = cA; const char* nB = cB;
        p.e_put(etab + (ui & 1) * EPI_TAB_BYTES, tid, ev);
        { unsigned nO[2][2];
#pragma unroll
          for (int h = 0; h < 2; ++h)
#pragma unroll
              for (int i = 0; i < 2; ++i) nO[h][i] = oA[h][i];
          if (has_next) { nA = p.a_base(nxt); nB = p.b_base(nxt); PG8_AFIN(nxt, ent, nO); }
          *park = (v4u){nO[0][0], nO[0][1], nO[1][0], nO[1][1]}; }
        for (int t = 0; t < nt; t += 2) {
            const bool last = (t == nt - 2);
            const char* a1 = cA + (size_t)(t + 1) * kstep;
            const char* a2 = last ? nA : cA + (size_t)(t + 2) * kstep; const char* b2 = last ? nB : cB + (size_t)(t + 2) * kstep;
            const char* a3 = a2 + kstep; const char* b3 = b2 + kstep;
            unsigned o2[2][2];
#pragma unroll
            for (int h = 0; h < 2; ++h)
#pragma unroll
                for (int i = 0; i < 2; ++i) o2[h][i] = oA[h][i];
            if (last) { const v4u q_ = *park; o2[0][0] = q_.x; o2[0][1] = q_.y; o2[1][0] = q_.z; o2[1][1] = q_.w; }
            PG8_LDB(B0, 0, 0); PG8_LDB(B1, 0, 1); PG8_SCHED; PG8_LDA(At, 0, 0); PG8_STAGE(PG8_SA(1, 1), a1, oA[1]);
            PG8_WAIT_V(8); PG8_WAIT_L(0); PG8_BAR; PG8_MMA(0, 0, At, B0); PG8_MMA(0, 1, At, B1); PG8_BAR; PG8_SCHED;
            PG8_LDA(At, 0, 1); PG8_STAGE(PG8_SB(0, 0), b2, voffB); PG8_STAGE(PG8_SB(0, 1), b2 + hstep, voffB); PG8_STAGE(PG8_SA(0, 0), a2, o2[0]);
            PG8_WAIT_V(8); PG8_WAIT_L(0); PG8_BAR; PG8_MMA(1, 0, At, B0); PG8_MMA(1, 1, At, B1); PG8_BAR; PG8_SCHED;
            PG8_LDB(B0, 1, 0); PG8_LDB(B1, 1, 1); PG8_SCHED; PG8_LDA(At, 1, 0); PG8_STAGE(PG8_SA(0, 1), a2, o2[1]);
            PG8_WAIT_V(8); PG8_WAIT_L(0); PG8_BAR; PG8_MMA(0, 0, At, B0); PG8_MMA(0, 1, At, B1); PG8_BAR; PG8_SCHED;
            PG8_LDA(At, 1, 1); PG8_STAGE(PG8_SB(1, 0), b3, voffB); PG8_STAGE(PG8_SB(1, 1), b3 + hstep, voffB); PG8_STAGE(PG8_SA(1, 0), a3, o2[0]);
            PG8_WAIT_V(8); PG8_WAIT_L(0); PG8_BAR; PG8_MMA(1, 0, At, B0); PG8_MMA(1, 1, At, B1); PG8_BAR; PG8_SCHED;
        }
        const bool has_nn = has_next && p.next(ui + 2, nn);
        if (has_nn) PG8_AIDX(nn, ent);
        if (has_next) p.e_idx(nxt, tid, ev);
        if (wr == 0) PG8_BAR;
        if constexpr (F8) asm volatile("s_nop 15\n\ts_nop 15" ::: "memory");
        p.epi(acc, cur, wr, wc, fr, fq, etab + (ui & 1) * EPI_TAB_BYTES);
        if (!has_next) break;
#pragma unroll
        for (int a = 0; a < 2; ++a)
#pragma unroll
            for (int b = 0; b < 2; ++b)
#pragma unroll
                for (int m = 0; m < 4; ++m)
#pragma unroll
                    for (int n = 0; n < 2; ++n) acc[a][b][m][n] = (f32x4){0.f, 0.f, 0.f, 0.f};
        cur = nxt; nxt = nn; has_next = has_nn; cA = nA; cB = nB; ++ui;
        { const v4u q_ = *park; oA[0][0] = q_.x; oA[0][1] = q_.y; oA[1][0] = q_.z; oA[1][1] = q_.w; }
        if (wr == 1) PG8_BAR;
    }
    PG8_WAIT_V(0);
    PG8_BAR;
#undef PG8_SA
#undef PG8_SB
#undef PG8_STAGE
#undef PG8_LDA
#undef PG8_LDB
#undef PG8_MMA
#undef PG8_HALF
#undef PG8_AOFF
#undef PG8_AIDX
#undef PG8_AFIN
#undef PG8_WAIT_V
#undef PG8_WAIT_L
#undef PG8_BAR
#undef PG8_SCHED
}
}

#define XB_TMO      128
#define XB_XCNT(j)  (256  + 64 * (j))
#define XB_XSUB(j)  (1280 + 64 * (j))
#define XB_XGEN(j)  (2304 + 64 * (j))
#define XB_TOP      3328
#define XB_TOPGEN   3392
#define XCD_BAR_WORDS 3456
#define XB_SPIN_CAP (1u << 18)
__device__ __forceinline__ unsigned xb_ld(unsigned* p)              { return __hip_atomic_load(p, __ATOMIC_RELAXED, __HIP_MEMORY_SCOPE_AGENT); }
__device__ __forceinline__ unsigned xb_add(unsigned* p, unsigned v) { return __hip_atomic_fetch_add(p, v, __ATOMIC_RELAXED, __HIP_MEMORY_SCOPE_AGENT); }
__device__ __forceinline__ unsigned xb_xcc_id() { return (unsigned)__builtin_amdgcn_s_getreg((3 << 11) | 20) & 0xFu; }
#define XB_SPIN(cond, bar) do { unsigned _sp = 0; while (cond) { __builtin_amdgcn_s_sleep(1); \
    if ((++_sp & 255u) == 0u) { if (xb_ld(&(bar)[XB_TMO])) break; if (_sp > XB_SPIN_CAP) { atomicAdd(&(bar)[XB_TMO], 1u); break; } } } } while (0)
struct XcdBarrier { unsigned* bar; unsigned x; volatile LAS unsigned* st; };
__device__ __forceinline__ XcdBarrier xcd_barrier_post(unsigned* bar, volatile LAS unsigned* st) {
    XcdBarrier b; b.bar = bar; b.x = xb_xcc_id(); b.st = st;
    if (threadIdx.x == 0) (void)xb_add(&bar[XB_XCNT(b.x)], 1u);
    return b;
}
__device__ __forceinline__ void xcd_barrier_complete(unsigned* bar, unsigned x, unsigned& nloc, unsigned& nx) {
    const unsigned G = gridDim.x * gridDim.y * gridDim.z;
    unsigned sum, cnt, mine, sp = 0u;
    for (;;) {
        sum = 0u; cnt = 0u; mine = 0u;
#pragma unroll
        for (unsigned j = 0; j < 16; ++j) { const unsigned c = xb_ld(&bar[XB_XCNT(j)]); sum += c; cnt += (c > 0u) ? 1u : 0u; mine = (j == x) ? c : mine; }
        if (sum == G) break;
        __builtin_amdgcn_s_sleep(1);
        if ((++sp & 255u) == 0u) { if (xb_ld(&bar[XB_TMO])) break; if (sp > XB_SPIN_CAP) { atomicAdd(&bar[XB_TMO], 1u); break; } }
    }
    nloc = mine > 0u ? mine : 1u; nx = cnt > 0u ? cnt : 1u;
}
__device__ __forceinline__ void xcd_barrier(const XcdBarrier& b) {
    asm volatile("s_waitcnt vmcnt(0)" ::: "memory");
    __syncthreads();
    if (threadIdx.x == 0) {
        unsigned* bar = b.bar;
        __builtin_amdgcn_s_waitcnt(0);
        unsigned nloc = b.st[0], nx = b.st[1];
        if (nloc == 0u) { xcd_barrier_complete(bar, b.x, nloc, nx); b.st[0] = nloc; b.st[1] = nx; }
        const unsigned old = xb_add(&bar[XB_XSUB(b.x)], 1u);
        const unsigned gen = old / nloc;
        if (old + 1u == (gen + 1u) * nloc) {
            __builtin_amdgcn_fence(__ATOMIC_RELEASE, "agent");
            asm volatile("s_waitcnt vmcnt(0)" ::: "memory");
            const unsigned og = xb_add(&bar[XB_TOP], 1u);
            const unsigned tg = og / nx;
            if (og + 1u == (tg + 1u) * nx) xb_add(&bar[XB_TOPGEN], 1u);
            else XB_SPIN(xb_ld(&bar[XB_TOPGEN]) == tg, bar);
            __builtin_amdgcn_fence(__ATOMIC_ACQUIRE, "agent");
            xb_add(&bar[XB_XGEN(b.x)], 1u);
            asm volatile("s_waitcnt vmcnt(0)" ::: "memory");
        } else {
            XB_SPIN(xb_ld(&bar[XB_XGEN(b.x)]) == gen, bar);
            __builtin_amdgcn_fence(__ATOMIC_ACQUIRE, "agent");
            asm volatile("s_waitcnt vmcnt(0)" ::: "memory");
        }
    }
    __syncthreads();
}

struct Frame {
    LAS unsigned char* lds;
    int tid, lane, wave, vcu, G;
    const float* in[18];
    float* out;
    unsigned char* ws;
};
using pg8::Unit;
using pg8::cvt_pk_bf16;

struct ProbBase {
    int K; int RB; pg8::Sched S;
    __device__ __forceinline__ void e_idx(const Unit&, int, int (&ev)[3]) const { ev[0] = ev[1] = ev[2] = 0; }
    __device__ __forceinline__ void e_put(LAS unsigned char*, int, const int (&)[3]) const {}
    __device__ __forceinline__ void a_idx(const Unit&, const int (&)[2], int (&ent)[2][2]) const { ent[0][0] = ent[0][1] = ent[1][0] = ent[1][1] = 0; }
    __device__ __forceinline__ void a_fin(const Unit&, const int (&R)[2], const int (&C)[2], const int (&)[2][2], unsigned (&off)[2][2]) const { lin_off(R, C, off); }
    __device__ __forceinline__ void lin_off(const int (&R)[2], const int (&C)[2], unsigned (&off)[2][2]) const {
#pragma unroll
        for (int h = 0; h < 2; ++h)
#pragma unroll
            for (int i = 0; i < 2; ++i) off[h][i] = (unsigned)((h * 128 + R[i]) * RB + C[i] * 2);
    }
};
struct ProbIn : ProbBase {
    const bf16* A; const bf16* Bt; bf16* O; const float* rs;
    __device__ __forceinline__ bool next(int i, Unit& u) const { int pm, pn; if (!S.next(i, pm, pn)) return false; u.rt = pm; u.pn = pn; u.e = 0; u.rb = pm; u.rows = 256; return true; }
    __device__ __forceinline__ const char* a_base(const Unit& u) const { return (const char*)A + (size_t)u.rt * 256 * RB; }
    __device__ __forceinline__ const char* b_base(const Unit& u) const { return (const char*)Bt + (size_t)u.pn * 256 * RB; }
    __device__ __forceinline__ void a_off(const Unit&, const int (&R)[2], const int (&C)[2], unsigned (&off)[2][2]) const { lin_off(R, C, off); }
    __device__ __forceinline__ void e_idx(const Unit& u, int tid, int (&ev)[3]) const { ev[0] = (tid < 256) ? __float_as_int(rs[u.rt * 256 + tid]) : 0; ev[1] = ev[2] = 0; }
    __device__ __forceinline__ void e_put(LAS unsigned char* et, int tid, const int (&ev)[3]) const { if (tid < 256) *(LAS int*)(et + tid * 8) = ev[0]; }
    __device__ __forceinline__ void epi(const f32x4 (&acc)[2][2][4][2], const Unit& u, int wr, int wc, int fr, int fq, const LAS unsigned char* et) const {
        const int row0 = u.rt * 256 + wr * 64 + fr, col0 = u.pn * 256 + wc * 32 + 8 * fq;
#pragma unroll
        for (int ai = 0; ai < 2; ++ai)
#pragma unroll
            for (int m = 0; m < 4; ++m) { const int row = row0 + ai * 128 + m * 16; const float sc = *(const LAS float*)(et + (ai * 128 + wr * 64 + m * 16 + fr) * 8); bf16* rowp = O + (size_t)row * NPROJ + col0;
#pragma unroll
                for (int bj = 0; bj < 2; ++bj) { const f32x4 v0 = acc[ai][bj][m][0] * sc, v1 = acc[ai][bj][m][1] * sc; v4u w;
                    w.x = cvt_pk_bf16(v0[0], v0[1]); w.y = cvt_pk_bf16(v0[2], v0[3]); w.z = cvt_pk_bf16(v1[0], v1[1]); w.w = cvt_pk_bf16(v1[2], v1[3]);
                    *(v4u*)(rowp + bj * 128) = w; } }
    }
};
struct ProbPool : ProbBase {
    const bf16* A; const bf16* Bt; bf16* O;
    __device__ __forceinline__ bool next(int i, Unit& u) const { int pm, pn; if (!S.next(i, pm, pn)) return false; u.rt = pm; u.pn = pn; u.e = 0; u.rb = pm; u.rows = 256; return true; }
    __device__ __forceinline__ const char* a_base(const Unit& u) const { return (const char*)A + (size_t)u.rt * 256 * RB; }
    __device__ __forceinline__ const char* b_base(const Unit& u) const { return (const char*)Bt + (size_t)u.pn * 256 * RB; }
    __device__ __forceinline__ void a_off(const Unit&, const int (&R)[2], const int (&C)[2], unsigned (&off)[2][2]) const { lin_off(R, C, off); }
    __device__ __forceinline__ void epi(const f32x4 (&acc)[2][2][4][2], const Unit& u, int wr, int wc, int fr, int fq, const LAS unsigned char* et) const {
        const int row0 = u.rt * 256 + wr * 64 + fr, col0 = 512 + u.pn * 256 + wc * 32 + 8 * fq;
#pragma unroll
        for (int ai = 0; ai < 2; ++ai)
#pragma unroll
            for (int m = 0; m < 4; ++m) { const int row = row0 + ai * 128 + m * 16; bf16* rowp = O + (size_t)row * DM + col0;
#pragma unroll
                for (int bj = 0; bj < 2; ++bj) { const f32x4 v0 = acc[ai][bj][m][0], v1 = acc[ai][bj][m][1]; v4u w;
                    w.x = cvt_pk_bf16(v0[0], v0[1]); w.y = cvt_pk_bf16(v0[2], v0[3]); w.z = cvt_pk_bf16(v1[0], v1[1]); w.w = cvt_pk_bf16(v1[2], v1[3]);
                    *(v4u*)(rowp + bj * 128) = w; } }
    }
};
struct ProbOut : ProbBase {
    const bf16* A; const bf16* Bt; const bf16* X; bf16* O;
    __device__ __forceinline__ bool next(int i, Unit& u) const { int pm, pn; if (!S.next(i, pm, pn)) return false; u.rt = pm; u.pn = pn; u.e = 0; u.rb = pm; u.rows = 256; return true; }
    __device__ __forceinline__ const char* a_base(const Unit& u) const { return (const char*)A + (size_t)u.rt * 256 * RB; }
    __device__ __forceinline__ const char* b_base(const Unit& u) const { return (const char*)Bt + (size_t)u.pn * 256 * RB; }
    __device__ __forceinline__ void a_off(const Unit&, const int (&R)[2], const int (&C)[2], unsigned (&off)[2][2]) const { lin_off(R, C, off); }
    __device__ __forceinline__ void epi(const f32x4 (&acc)[2][2][4][2], const Unit& u, int wr, int wc, int fr, int fq, const LAS unsigned char* et) const {
        const int row0 = u.rt * 256 + wr * 64 + fr, col0 = u.pn * 256 + wc * 32 + 8 * fq;
#pragma unroll
        for (int ai = 0; ai < 2; ++ai)
#pragma unroll
            for (int m = 0; m < 4; ++m) { const size_t off = (size_t)(row0 + ai * 128 + m * 16) * DM + col0;
#pragma unroll
                for (int bj = 0; bj < 2; ++bj) { const v4u xv = *(const v4u*)(X + off + bj * 128); const f32x4 a = acc[ai][bj][m][0], b = acc[ai][bj][m][1];
                    *(v4u*)(O + off + bj * 128) = (v4u){cvt_pk_bf16(bflo(xv.x) + a.x, bfhi(xv.x) + a.y), cvt_pk_bf16(bflo(xv.y) + a.z, bfhi(xv.y) + a.w),
                                                        cvt_pk_bf16(bflo(xv.z) + b.x, bfhi(xv.z) + b.y), cvt_pk_bf16(bflo(xv.w) + b.z, bfhi(xv.w) + b.w)}; } }
    }
};
struct MoeTab { const LAS int* pref; const LAS int* cnt; const LAS int* tile; };
__device__ __forceinline__ void moe_decode(const MoeTab& T, int rt, Unit& u) {
    const int w = T.tile[rt];
    u.e = w >> 24; u.rb = (w >> 12) & 0xfff; u.rows = w & 0xfff;
}
struct ProbGU : ProbBase {
    MoeTab T; const unsigned char* A; const unsigned char* Bt; unsigned char* O; const int* list; const float* rs2; const float* bgu;
    __device__ __forceinline__ bool next(int i, Unit& u) const { int pm, pn; if (!S.next(i, pm, pn)) return false; u.rt = pm; u.pn = pn; moe_decode(T, pm, u); return true; }
    __device__ __forceinline__ const char* a_base(const Unit&) const { return (const char*)A; }
    __device__ __forceinline__ const char* b_base(const Unit& u) const { return (const char*)Bt + ((size_t)u.e * 2048 + (size_t)u.pn * 256) * RB; }
    __device__ __forceinline__ void a_off(const Unit& u, const int (&R)[2], const int (&C)[2], unsigned (&off)[2][2]) const { int ent[2][2]; a_idx(u, R, ent); a_fin(u, R, C, ent, off); }
    __device__ __forceinline__ void e_idx(const Unit& u, int tid, int (&ev)[3]) const {
        if (tid < 256) { ev[0] = __float_as_int(rs2[(size_t)u.e * LISTCAP + u.rb * 256 + tid]); ev[1] = __float_as_int(bgu[(size_t)u.e * 2048 + u.pn * 256 + tid]); } else { ev[0] = ev[1] = 0; } ev[2] = 0; }
    __device__ __forceinline__ void e_put(LAS unsigned char* et, int tid, const int (&ev)[3]) const { if (tid < 256) { *(LAS int*)(et + tid * 8) = ev[0]; *(LAS int*)(et + 2048 + tid * 4) = ev[1]; } }
    __device__ __forceinline__ void a_idx(const Unit& u, const int (&R)[2], int (&ent)[2][2]) const {
        const int* lp = list + (size_t)u.e * LISTCAP + u.rb * 256;
#pragma unroll
        for (int h = 0; h < 2; ++h)
#pragma unroll
            for (int i = 0; i < 2; ++i) { const int r = h * 128 + R[i]; ent[h][i] = (r < u.rows) ? lp[r] : 0; }
    }
    __device__ __forceinline__ void a_fin(const Unit&, const int (&)[2], const int (&C)[2], const int (&ent)[2][2], unsigned (&off)[2][2]) const {
#pragma unroll
        for (int h = 0; h < 2; ++h)
#pragma unroll
            for (int i = 0; i < 2; ++i) off[h][i] = (unsigned)(ent[h][i] >> 2) * (unsigned)RB + (unsigned)C[i] * 2u;
    }
    __device__ __forceinline__ void epi(const f32x4 (&acc)[2][2][4][2], const Unit& u, int wr, int wc, int fr, int fq, const LAS unsigned char* et) const {
        const int j0 = wc * 32 + 8 * fq;
        const LAS float* bg = (const LAS float*)(et + 2048) + j0;
        f32x4 bgv[2], buv[2];
#pragma unroll
        for (int n = 0; n < 2; ++n) { bgv[n] = *(const LAS f32x4*)(bg + 4 * n); buv[n] = *(const LAS f32x4*)(bg + 128 + 4 * n); }
#pragma unroll
        for (int ai = 0; ai < 2; ++ai)
#pragma unroll
            for (int m = 0; m < 4; ++m) { const int r = ai * 128 + wr * 64 + m * 16 + fr;
                if (r < u.rows) { const float sc = *(const LAS float*)(et + r * 8) * W8_INV; const f32x2_t sc2 = (f32x2_t){sc, sc}; unsigned w[2];
#pragma unroll
                    for (int n = 0; n < 2; ++n) { f32x2_t a2[2];
#pragma unroll
                        for (int qp = 0; qp < 2; ++qp) {
                            f32x2_t gt = (f32x2_t){acc[ai][0][m][n][2 * qp], acc[ai][0][m][n][2 * qp + 1]} * sc2 + (f32x2_t){bgv[n][2 * qp], bgv[n][2 * qp + 1]};
                            f32x2_t up = (f32x2_t){acc[ai][1][m][n][2 * qp], acc[ai][1][m][n][2 * qp + 1]} * sc2 + (f32x2_t){buv[n][2 * qp], buv[n][2 * qp + 1]};
                            gt.x = fminf(gt.x, 7.f); gt.y = fminf(gt.y, 7.f); up.x = fminf(fmaxf(up.x, -7.f), 7.f); up.y = fminf(fmaxf(up.y, -7.f), 7.f);
                            const f32x2_t ex = gt * (f32x2_t){-1.702f * 1.4426950408889634f, -1.702f * 1.4426950408889634f};
                            const f32x2_t dn = (f32x2_t){__builtin_amdgcn_exp2f(ex.x), __builtin_amdgcn_exp2f(ex.y)} + (f32x2_t){1.f, 1.f};
                            a2[qp] = (up + (f32x2_t){1.f, 1.f}) * gt * (f32x2_t){frcp_(dn.x), frcp_(dn.y)}; }
                        w[n] = pk4_fp8(a2[0].x, a2[0].y, a2[1].x, a2[1].y); }
                    *(v2u*)(O + (size_t)(u.rt * 256 + r) * DE + u.pn * 128 + j0) = (v2u){w[0], w[1]}; } }
    }
};
struct ProbDown : ProbBase {
    MoeTab T; const unsigned char* A; const unsigned char* Bt; unsigned char* O; const int* list; const float* gw; const float* bd;
    __device__ __forceinline__ bool next(int i, Unit& u) const { int pm, pn; if (!S.next(i, pm, pn)) return false; u.rt = pm; u.pn = pn; moe_decode(T, pm, u); return true; }
    __device__ __forceinline__ const char* a_base(const Unit& u) const { return (const char*)A + (size_t)u.rt * 256 * RB; }
    __device__ __forceinline__ const char* b_base(const Unit& u) const { return (const char*)Bt + ((size_t)u.e * 1024 + (size_t)u.pn * 256) * RB; }
    __device__ __forceinline__ void a_off(const Unit&, const int (&R)[2], const int (&C)[2], unsigned (&off)[2][2]) const { lin_off(R, C, off); }
    __device__ __forceinline__ void e_idx(const Unit& u, int tid, int (&ev)[3]) const {
        if (tid < 256) { const size_t pos = (size_t)u.e * LISTCAP + u.rb * 256 + tid; ev[0] = list[pos]; ev[1] = __float_as_int(gw[pos]); ev[2] = __float_as_int(bd[(size_t)u.e * DM + u.pn * 256 + tid]); } else { ev[0] = ev[1] = ev[2] = 0; } }
    __device__ __forceinline__ void e_put(LAS unsigned char* et, int tid, const int (&ev)[3]) const { if (tid < 256) { *(LAS v2u*)(et + tid * 8) = (v2u){(unsigned)ev[0], (unsigned)ev[1]}; *(LAS int*)(et + 2048 + tid * 4) = ev[2]; } }
    __device__ __forceinline__ void epi(const f32x4 (&acc)[2][2][4][2], const Unit& u, int wr, int wc, int fr, int fq, const LAS unsigned char* et) const {
        const int c0 = u.pn * 256 + wc * 32 + 8 * fq;
        const LAS float* bp = (const LAS float*)(et + 2048) + wc * 32 + 8 * fq;
        f32x4 bv[2][2];
#pragma unroll
        for (int bj = 0; bj < 2; ++bj)
#pragma unroll
            for (int n = 0; n < 2; ++n) bv[bj][n] = *(const LAS f32x4*)(bp + bj * 128 + 4 * n);
#pragma unroll
        for (int ai = 0; ai < 2; ++ai)
#pragma unroll
            for (int m = 0; m < 4; ++m) { const int r = ai * 128 + wr * 64 + m * 16 + fr;
                if (r < u.rows) { const v2u eg = *(const LAS v2u*)(et + r * 8); const int ent = (int)eg.x; const float g = __uint_as_float(eg.y); unsigned char* rowp = O + (size_t)ent * DM + c0;
#pragma unroll
                    for (int bj = 0; bj < 2; ++bj) { const f32x4 v0 = (acc[ai][bj][m][0] * W8_INV + bv[bj][0]) * g, v1 = (acc[ai][bj][m][1] * W8_INV + bv[bj][1]) * g;
                        *(v2u*)(rowp + bj * 128) = (v2u){pk4_fp8(v0[0] * SLAB_SCALE, v0[1] * SLAB_SCALE, v0[2] * SLAB_SCALE, v0[3] * SLAB_SCALE), pk4_fp8(v1[0] * SLAB_SCALE, v1[1] * SLAB_SCALE, v1[2] * SLAB_SCALE, v1[3] * SLAB_SCALE)}; } } }
    }
};

typedef short v4i16_t __attribute__((ext_vector_type(4)));
__device__ __forceinline__ void tr_item(const float* W, int ldw, int k0, int nsrc0, bf16* WT, size_t drow0, int ldk, int dk0, const float* ks, const float* ns, LAS unsigned char* scr, int lane) {
    const int kr = lane >> 4, n4 = (lane & 15) * 4;
    f32x4 nsc = (f32x4){1.f, 1.f, 1.f, 1.f}; if (ns) nsc = *(const f32x4*)(ns + nsrc0 + n4);
    f32x4 v[16];
#pragma unroll
    for (int i = 0; i < 16; ++i) v[i] = *(const f32x4*)(W + (size_t)(k0 + 4 * i + kr) * ldw + nsrc0 + n4);
#pragma unroll
    for (int i = 0; i < 16; ++i) { f32x4 x = v[i] * nsc; if (ks) x = x * ks[k0 + 4 * i + kr];
        *(LAS v2u*)(scr + (4 * i + kr) * 192 + n4 * 2) = (v2u){pg8::cvt_pk_bf16(x.x, x.y), pg8::cvt_pk_bf16(x.z, x.w)}; }
    LDS_WAIT(); asm volatile("" ::: "memory");
    const int G = lane >> 4, li = lane & 15, q = li >> 2, p = li & 3;
    const LAS unsigned char* rb = scr + q * 192 + (16 * G + 4 * p) * 2;
    bf16* dst = WT + (drow0 + 16 * G + li) * (size_t)ldk + dk0 + k0;
#pragma unroll
    for (int kc = 0; kc < 8; ++kc) {
        const v4i16_t lo = __builtin_amdgcn_ds_read_tr16_b64_v4i16((LAS v4i16_t*)(rb + (8 * kc) * 192));
        const v4i16_t hi = __builtin_amdgcn_ds_read_tr16_b64_v4i16((LAS v4i16_t*)(rb + (8 * kc + 4) * 192));
        const v2u l2 = __builtin_bit_cast(v2u, lo), h2 = __builtin_bit_cast(v2u, hi);
        *(v4u*)(dst + 8 * kc) = (v4u){l2.x, l2.y, h2.x, h2.y};
    }
    LDS_WAIT(); asm volatile("" ::: "memory");
}

template <int KT, int NT>
__device__ __forceinline__ void tr_item8(const float* W, int ldw, int k0, int nsrc0, unsigned char* WT, size_t drow0, int ldk, const float* ks, float mul, LAS unsigned char* scr, int lane) {
    constexpr int LPR = NT / 4, RPL = 64 / LPR, PA = NT * 2 + 64;
    static_assert(KT * NT == 4096 && (PA / 4) % 32 == 16, "tile geometry");
    const int kr = lane / LPR, n4 = (lane % LPR) * 4;
    f32x4 v[16];
#pragma unroll
    for (int i = 0; i < 16; ++i) v[i] = *(const f32x4*)(W + (size_t)(k0 + RPL * i + kr) * ldw + nsrc0 + n4);
#pragma unroll
    for (int i = 0; i < 16; ++i) { const float sc = ks ? ks[k0 + RPL * i + kr] * mul : mul; const f32x4 x = v[i] * sc;
        *(LAS v2u*)(scr + (RPL * i + kr) * PA + n4 * 2) = (v2u){pg8::cvt_pk_bf16(x.x, x.y), pg8::cvt_pk_bf16(x.z, x.w)}; }
    LDS_WAIT(); asm volatile("" ::: "memory");
    const int G = lane >> 4, li = lane & 15, q = li >> 2, p = li & 3;
#pragma unroll
    for (int ps = 0; ps < NT / 64; ++ps) {
        const LAS unsigned char* rb = scr + q * PA + (16 * (G + 4 * ps) + 4 * p) * 2;
        unsigned char* dst = WT + (drow0 + 16 * (G + 4 * ps) + li) * (size_t)ldk + k0;
#pragma unroll
        for (int kq = 0; kq < KT / 16; ++kq) {
            v2u t[4];
#pragma unroll
            for (int u = 0; u < 4; ++u) t[u] = __builtin_bit_cast(v2u, __builtin_amdgcn_ds_read_tr16_b64_v4i16((LAS v4i16_t*)(rb + (16 * kq + 4 * u) * PA)));
            v4u o;
            o.x = pk4_fp8(bflo(t[0].x), bfhi(t[0].x), bflo(t[0].y), bfhi(t[0].y)); o.y = pk4_fp8(bflo(t[1].x), bfhi(t[1].x), bflo(t[1].y), bfhi(t[1].y));
            o.z = pk4_fp8(bflo(t[2].x), bfhi(t[2].x), bflo(t[2].y), bfhi(t[2].y)); o.w = pk4_fp8(bflo(t[3].x), bfhi(t[3].x), bflo(t[3].y), bfhi(t[3].y));
            *(v4u*)(dst + 16 * kq) = o;
        }
    }
    LDS_WAIT(); asm volatile("" ::: "memory");
}

constexpr int TRF_T1 = 128 * 192, TRF_T2 = 64 * 144, TRF_BYTES = TRF_T1 + TRF_T2;
__device__ __forceinline__ void tr_item8f(const float* W, int ldw, int k0, int nsrc0, unsigned char* WT, size_t drow0, int ldk, const float* ks, float mul, LAS unsigned char* scr, int lane) {
    const int kr = lane >> 4, n4 = (lane & 15) * 4;
#pragma unroll
    for (int hb = 0; hb < 2; ++hb) {
        f32x4 v[16];
#pragma unroll
        for (int i = 0; i < 16; ++i) v[i] = *(const f32x4*)(W + (size_t)(k0 + 64 * hb + 4 * i + kr) * ldw + nsrc0 + n4);
#pragma unroll
        for (int i = 0; i < 16; ++i) { const float sc = ks ? ks[k0 + 64 * hb + 4 * i + kr] * mul : mul; const f32x4 x = v[i] * sc;
            *(LAS v2u*)(scr + (64 * hb + 4 * i + kr) * 192 + n4 * 2) = (v2u){pg8::cvt_pk_bf16(x.x, x.y), pg8::cvt_pk_bf16(x.z, x.w)}; }
    }
    LDS_WAIT(); asm volatile("" ::: "memory");
    const int G = lane >> 4, li = lane & 15, q = li >> 2, p = li & 3;
    const LAS unsigned char* rb = scr + q * 192 + (16 * G + 4 * p) * 2;
    LAS unsigned char* t2 = scr + TRF_T1;
#pragma unroll
    for (int kq = 0; kq < 8; ++kq) {
        v2u t[4];
#pragma unroll
        for (int u = 0; u < 4; ++u) t[u] = __builtin_bit_cast(v2u, __builtin_amdgcn_ds_read_tr16_b64_v4i16((LAS v4i16_t*)(rb + (16 * kq + 4 * u) * 192)));
        v4u o;
        o.x = pk4_fp8(bflo(t[0].x), bfhi(t[0].x), bflo(t[0].y), bfhi(t[0].y)); o.y = pk4_fp8(bflo(t[1].x), bfhi(t[1].x), bflo(t[1].y), bfhi(t[1].y));
        o.z = pk4_fp8(bflo(t[2].x), bfhi(t[2].x), bflo(t[2].y), bfhi(t[2].y)); o.w = pk4_fp8(bflo(t[3].x), bfhi(t[3].x), bflo(t[3].y), bfhi(t[3].y));
        *(LAS v4u*)(t2 + (16 * G + li) * 144 + 16 * kq) = o;
    }
    LDS_WAIT(); asm volatile("" ::: "memory");
    const int r8 = lane >> 3, c8 = lane & 7;
#pragma unroll
    for (int j = 0; j < 8; ++j) { const v4u o = *(const LAS v4u*)(t2 + (8 * j + r8) * 144 + 16 * c8);
        *(v4u*)(WT + (drow0 + 8 * j + r8) * (size_t)ldk + k0 + 16 * c8) = o; }
    LDS_WAIT(); asm volatile("" ::: "memory");
}

constexpr int TRK = 128, TRN = 64;
constexpr int MOE_PREP_ITEMS = 32 * (1024 / TRK) * (2048 / TRN) + 32 * (1024 / TRK) * (1024 / TRN);
__device__ __forceinline__ void moe_weight_prep(Frame& F, int b0, int lo, int hi) {
    const float* fnw = F.in[10]; const float* w_gu = F.in[13]; const float* w_d = F.in[15];
    unsigned char* WguT = F.ws + WS_WGU; unsigned char* WdT = F.ws + WS_WD;
    constexpr int TW = 4;
    if (F.wave >= TW) return;
    LAS unsigned char* scr = F.lds + F.wave * TRF_BYTES;
    const int gw = ((int)blockIdx.x - b0) * TW + F.wave, NGW = (F.G - b0) * TW;
    constexpr int NKB = 1024 / TRK, NNB_GU = 2048 / TRN, NNB_D = 1024 / TRN, SEGN = 128 / TRN;
    constexpr int I_GU = 32 * NKB * NNB_GU;
    for (int it = lo + gw; it < hi; it += NGW) {
        int r = it;
        if (r < I_GU) { const int e = r / (NKB * NNB_GU), r2 = r % (NKB * NNB_GU), kb = r2 / NNB_GU, cb = r2 % NNB_GU;
            const int half = cb / (NNB_GU / 2), t = (cb % (NNB_GU / 2)) / SEGN, nb = cb % SEGN;
            tr_item8f(w_gu + (size_t)e * DM * 2048, 2048, kb * TRK, half * 1024 + t * 128 + nb * TRN, WguT, (size_t)e * 2048 + t * 256 + half * 128 + nb * TRN, DM, fnw, W8_SCALE, scr, F.lane); continue; } r -= I_GU;
        { const int e = r / (NKB * NNB_D), r2 = r % (NKB * NNB_D), kb = r2 / NNB_D, nb = r2 % NNB_D;
          tr_item8f(w_d + (size_t)e * DE * DM, DM, kb * TRK, nb * TRN, WdT, (size_t)e * 1024 + nb * TRN, DE, nullptr, W8_SCALE, scr, F.lane); }
    }
}
static_assert(4 * TRF_BYTES <= LDSCTL_OFF, "transposer LDS");
constexpr int MOE_PREP_SPLIT = 0;

__device__ __forceinline__ void phase_prep(Frame& F) {
    const float* x = F.in[0]; const float* anw = F.in[1]; const float* w_in = F.in[2]; const float* a_log = F.in[4]; const float* dt_bias = F.in[5];
    const float* pool_w = F.in[7]; const float* pool_scale = F.in[8]; const float* w_out = F.in[9]; const float* fnw = F.in[10];
    const float* w_router = F.in[11]; const float* w_gu = F.in[13]; const float* b_gu = F.in[14]; const float* w_d = F.in[15];
    bf16* WinT = (bf16*)(F.ws + WS_WIN); bf16* WoutT = (bf16*)(F.ws + WS_WOUT); bf16* WpoolT = (bf16*)(F.ws + WS_WPOOL);
    bf16* WguT = (bf16*)(F.ws + WS_WGU); bf16* WdT = (bf16*)(F.ws + WS_WD);
    bf16* WrI = (bf16*)(F.ws + WS_WR); float* bguP = (float*)(F.ws + WS_BGU);
    bf16* xb = (bf16*)(F.ws + WS_XB); float* rs1 = (float*)(F.ws + WS_RS1); float* betaA = (float*)(F.ws + WS_BETA); float* gA = (float*)(F.ws + WS_G);
    LAS unsigned char* scr = F.lds + F.wave * 12288;
    LAS float* W8T = (LAS float*)(F.lds + 98304);
    const int gw = F.vcu * NWAVES + F.wave, NGW = F.G * NWAVES;
    const int gt = F.vcu * 512 + F.tid, NGT = F.G * 512;
    for (int idx = F.tid; idx < 8192; idx += 512) { const int k = idx >> 3, c = idx & 7; W8T[c * 1024 + k] = anw[k] * w_in[(size_t)k * DIN + 2048 + c]; }
    __syncthreads();
    constexpr int I_IN1 = 16 * 32, I_OUT = 16 * 16;
    constexpr int NITEMS = I_IN1 + I_OUT;
    for (int it = gw; it < NITEMS; it += NGW) {
        int r = it;
        if (r < I_IN1) { const int kb = r / 32, nb = r % 32; tr_item(w_in, DIN, kb * 64, nb * 64, WinT, (size_t)nb * 64, DM, 0, anw, nullptr, scr, F.lane); continue; } r -= I_IN1;
        { const int kb = r / 16, nb = r % 16; tr_item(w_out, DM, kb * 64, nb * 64, WoutT, (size_t)nb * 64, DM, 0, nullptr, nullptr, scr, F.lane); }
    }
    __syncthreads();
    for (int task = blockIdx.x; task < 256; task += F.G) {
        const int g = task >> 6, kb = (task >> 2) & 15, dq = task & 3;
        LAS float* Wt = (LAS float*)F.lds;
        LAS float* Pw = (LAS float*)(F.lds + 33024);
        for (int idx = F.tid; idx < 64 * 32; idx += 512) { const int k = idx >> 5, c4 = (idx & 31) * 4; const f32x4 v = *(const f32x4*)(w_in + (size_t)(kb * 64 + k) * DIN + 2056 + g * 128 + c4);
            Wt[k * 129 + c4] = v.x; Wt[k * 129 + c4 + 1] = v.y; Wt[k * 129 + c4 + 2] = v.z; Wt[k * 129 + c4 + 3] = v.w; }
        for (int idx = F.tid; idx < 128 * 8; idx += 512) { const int c = idx >> 3, d4 = (idx & 7) * 4; *(LAS f32x4*)(Pw + c * 32 + d4) = *(const f32x4*)(pool_w + (size_t)g * 16384 + c * 128 + dq * 32 + d4); }
        __syncthreads();
        const int k = F.tid & 63, d4 = (F.tid >> 6) * 4;
        f32x4 acc = (f32x4){0.f, 0.f, 0.f, 0.f};
#pragma unroll 8
        for (int c = 0; c < 128; ++c) acc += *(const LAS f32x4*)(Pw + c * 32 + d4) * Wt[k * 129 + c];
        const int n0 = g * 128 + dq * 32 + d4; const f32x4 ps = *(const f32x4*)(pool_scale + n0); const float an = anw[kb * 64 + k];
        bf16* dst = WinT + (size_t)(2048 + n0) * DM + kb * 64 + k;
        dst[0] = (bf16)f2bf(acc.x * ps.x * an); dst[DM] = (bf16)f2bf(acc.y * ps.y * an); dst[2 * DM] = (bf16)f2bf(acc.z * ps.z * an); dst[3 * DM] = (bf16)f2bf(acc.w * ps.w * an);
        __syncthreads();
    }
    moe_weight_prep(F, 0, 0, MOE_PREP_SPLIT);
    for (int idx = gt; idx < NE * 2048; idx += NGT) { const int e = idx >> 11, r = idx & 2047, t = r >> 8, j = r & 255, half = j >> 7, jj = j & 127; bguP[idx] = b_gu[(size_t)e * 2048 + half * 1024 + t * 128 + jj]; }
    for (int idx = gt; idx < 64 * 64 * 8; idx += NGT) { const int j = idx & 7, ln = (idx >> 3) & 63, fr2 = idx >> 9, nb = fr2 & 1, ks = fr2 >> 1;
        const int k = 32 * ks + 8 * (ln >> 4) + j, e = 16 * nb + (ln & 15); const float v = fnw[k] * w_router[(size_t)k * NE + e];
        const unsigned hb = f2bf(v); const float hf = __builtin_bit_cast(float, hb << 16); const unsigned lb = f2bf(v - hf);
        WrI[((size_t)(fr2 * 2 + 0) * 64 + ln) * 8 + j] = (bf16)hb; WrI[((size_t)(fr2 * 2 + 1) * 64 + ln) * 8 + j] = (bf16)lb; }
    for (int m = gw; m < NTOK; m += NGW) {
        const f32x4* xr = (const f32x4*)(x + (size_t)m * DM) + F.lane;
        f32x4 v[4]; float ss = 0.f; float d8[8];
#pragma unroll
        for (int c = 0; c < 8; ++c) d8[c] = 0.f;
#pragma unroll
        for (int j = 0; j < 4; ++j) { v[j] = xr[64 * j]; ss += (v[j].x * v[j].x + v[j].y * v[j].y) + (v[j].z * v[j].z + v[j].w * v[j].w); }
#pragma unroll
        for (int c = 0; c < 8; ++c)
#pragma unroll
            for (int j = 0; j < 4; ++j) { const f32x4 w = *(const LAS f32x4*)(W8T + c * 1024 + 256 * j + 4 * F.lane); d8[c] += (v[j].x * w.x + v[j].y * w.y) + (v[j].z * w.z + v[j].w * w.w); }
        ss = wave_sum(ss);
#pragma unroll
        for (int c = 0; c < 8; ++c) d8[c] = wave_sum(d8[c]);
        const float rs = 1.f / sqrtf(ss * (1.f / DM) + 1e-6f);
        unsigned long long* o8 = (unsigned long long*)(xb + (size_t)m * DM) + F.lane;
#pragma unroll
        for (int j = 0; j < 4; ++j) o8[64 * j] = (unsigned long long)pk2(v[j].x, v[j].y) | ((unsigned long long)pk2(v[j].z, v[j].w) << 32);
        if (F.lane == 0) rs1[m] = rs;
        if (F.lane < 4) {
            float bl = 0.f, al = 0.f;
#pragma unroll
            for (int c = 0; c < 4; ++c) { bl = (F.lane == c) ? d8[c] : bl; al = (F.lane == c) ? d8[4 + c] : al; }
            bl *= rs; al *= rs;
            betaA[(size_t)m * 4 + F.lane] = 1.f / (1.f + expf(-bl));
            const float z = al + dt_bias[F.lane]; const float sp = z > 20.f ? z : log1pf(expf(z));
            gA[(size_t)m * 4 + F.lane] = -expf(a_log[F.lane]) * sp;
        }
    }
}

__device__ __forceinline__ void phase_mix(Frame& F) {
    const bf16* proj = (const bf16*)(F.ws + WS_PROJ); bf16* mixed = (bf16*)(F.ws + WS_CONCAT) + 512;
    const int gw = F.vcu * NWAVES + F.wave, NGW = F.G * NWAVES;
    const int ch = 8 * F.lane, gi = F.lane >> 4, win = 2 << gi, hal = win - 1;
    for (int rbk = gw; rbk < NTOK / 16; rbk += NGW) {
        const int m0 = rbk * 16, t0 = m0 % SEQ;
        v4u X[31];
#pragma unroll
        for (int k = 0; k < 31; ++k) { X[k] = (v4u){0u, 0u, 0u, 0u}; if (k >= 15 - hal && t0 - 15 + k >= 0) X[k] = *(const v4u*)(proj + (size_t)(m0 - 15 + k) * NPROJ + 2048 + ch); }
        float s[8];
#pragma unroll
        for (int q = 0; q < 8; ++q) s[q] = 0.f;
#pragma unroll
        for (int k = 0; k < 15; ++k) { s[0] += bflo(X[k].x); s[1] += bfhi(X[k].x); s[2] += bflo(X[k].y); s[3] += bfhi(X[k].y); s[4] += bflo(X[k].z); s[5] += bfhi(X[k].z); s[6] += bflo(X[k].w); s[7] += bfhi(X[k].w); }
#pragma unroll
        for (int r = 0; r < 16; ++r) {
            const v4u u = X[15 + r];
            const float p[8] = {bflo(u.x), bfhi(u.x), bflo(u.y), bfhi(u.y), bflo(u.z), bfhi(u.z), bflo(u.w), bfhi(u.w)};
#pragma unroll
            for (int q = 0; q < 8; ++q) s[q] += p[q];
            const int tt = t0 + r + 1; const float ic = 1.f / (float)(tt < win ? tt : win);
            v4u o; o.x = pk2(s[0] * ic - p[0], s[1] * ic - p[1]); o.y = pk2(s[2] * ic - p[2], s[3] * ic - p[3]); o.z = pk2(s[4] * ic - p[4], s[5] * ic - p[5]); o.w = pk2(s[6] * ic - p[6], s[7] * ic - p[7]);
            *(v4u*)(mixed + (size_t)(m0 + r) * DM + ch) = o;
            const v4u od = gi == 0 ? X[14 + r] : gi == 1 ? X[12 + r] : gi == 2 ? X[8 + r] : X[r];
            s[0] -= bflo(od.x); s[1] -= bfhi(od.x); s[2] -= bflo(od.y); s[3] -= bfhi(od.y); s[4] -= bflo(od.z); s[5] -= bfhi(od.z); s[6] -= bflo(od.w); s[7] -= bfhi(od.w);
        }
    }
}

typedef float f32x16 __attribute__((ext_vector_type(16)));
__device__ __forceinline__ bf16x8 pack8(const f32x4 a, const f32x4 b) {
    v4u w; w.x = cvt_pk_bf16(a[0], a[1]); w.y = cvt_pk_bf16(a[2], a[3]); w.z = cvt_pk_bf16(b[0], b[1]); w.w = cvt_pk_bf16(b[2], b[3]);
    return __builtin_bit_cast(bf16x8, w);
}
__device__ __forceinline__ void fmac_(float& acc, float a, float b) { asm("v_fmac_f32 %0, %1, %2" : "+v"(acc) : "v"(a), "v"(b)); }
__device__ __forceinline__ float bf2f(unsigned short u) { return __builtin_bit_cast(float, (unsigned)u << 16); }

constexpr int SOLVE_D = 5;
struct RQ { int i, j; };
__host__ __device__ constexpr int solve_nq(int i) { return (i + 3) / 4; }
__host__ __device__ constexpr RQ solve_adv(int i, int j, int d) { while (d-- > 0 && i < 64) { if (j + 1 < solve_nq(i)) ++j; else { ++i; j = 0; } } return RQ{i, j}; }
template <int I, int J> __device__ __forceinline__ void solve_step(float (&U)[64], const LAS float* Am, const f32x4 (&win)[SOLVE_D], float s0, float s1, float s2, float s3) {
    if constexpr (I < 64) {
        constexpr RQ P = solve_adv(I, J, SOLVE_D);
        f32x4 nw = (f32x4){0.f, 0.f, 0.f, 0.f};
        if constexpr (P.i < 64) nw = *(const LAS f32x4*)(Am + P.i * 64 + 4 * P.j);
        const f32x4 a = win[0];
        fmac_(s0, a.x, U[4 * J]); if constexpr (4 * J + 1 < I) fmac_(s1, a.y, U[4 * J + 1]); if constexpr (4 * J + 2 < I) fmac_(s2, a.z, U[4 * J + 2]); if constexpr (4 * J + 3 < I) fmac_(s3, a.w, U[4 * J + 3]);
        f32x4 nx[SOLVE_D];
#pragma unroll
        for (int q = 0; q + 1 < SOLVE_D; ++q) nx[q] = win[q + 1];
        nx[SOLVE_D - 1] = nw;
        __builtin_amdgcn_sched_barrier(0);
        if constexpr (J + 1 < solve_nq(I)) solve_step<I, J + 1>(U, Am, nx, s0, s1, s2, s3);
        else { U[I] -= (s0 + s1) + (s2 + s3); solve_step<I + 1, 0>(U, Am, nx, 0.f, 0.f, 0.f, 0.f); }
    }
}
__device__ __forceinline__ void solve_all(float (&U)[64], const LAS float* Am) {
    f32x4 win[SOLVE_D];
#pragma unroll
    for (int q = 0; q < SOLVE_D; ++q) { constexpr RQ dummy{0, 0}; (void)dummy; }
    { constexpr RQ p0 = solve_adv(1, 0, 0), p1 = solve_adv(1, 0, 1), p2 = solve_adv(1, 0, 2), p3 = solve_adv(1, 0, 3), p4 = solve_adv(1, 0, 4);
      win[0] = *(const LAS f32x4*)(Am + p0.i * 64 + 4 * p0.j); win[1] = *(const LAS f32x4*)(Am + p1.i * 64 + 4 * p1.j); win[2] = *(const LAS f32x4*)(Am + p2.i * 64 + 4 * p2.j);
      win[3] = *(const LAS f32x4*)(Am + p3.i * 64 + 4 * p3.j); win[4] = *(const LAS f32x4*)(Am + p4.i * 64 + 4 * p4.j); }
    static_assert(SOLVE_D == 5, "window priming is written for SOLVE_D = 5");
    solve_step<1, 0>(U, Am, win, 0.f, 0.f, 0.f, 0.f);
}

constexpr int CP_QN = 0, CP_KN = 17408, CP_VA = 34816, CP_QKL = 51200, CP_SC = 59392, CP_HALF = 60416, CP_CW = 2 * CP_HALF;
__device__ __forceinline__ void phase_chunk(Frame& F, int blk0, int nblk, int n_lo, int n_cnt) {
    const float* conv_w = F.in[3];
    const bf16* proj = (const bf16*)(F.ws + WS_PROJ);
    const float* betaA = (const float*)(F.ws + WS_BETA); const float* gA = (const float*)(F.ws + WS_G);
    float* gtotA = (float*)(F.ws + WS_GTOT);
    const int half = F.wave >> 2, hw = F.wave & 3;
    LAS unsigned char* L = F.lds + half * CP_HALF;
    LAS bf16* qn = (LAS bf16*)(L + CP_QN); LAS bf16* kn = (LAS bf16*)(L + CP_KN); LAS bf16* vn = (LAS bf16*)(L + CP_VA);
    LAS float* Am = (LAS float*)(L + CP_VA); LAS bf16* qkL = (LAS bf16*)(L + CP_QKL); LAS float* sc = (LAS float*)(L + CP_SC);
    LAS float* cwL = (LAS float*)(F.lds + CP_CW);
    for (int idx = F.tid; idx < 4 * 1536 / 4; idx += 512) *(LAS f32x4*)(cwL + 4 * idx) = *(const f32x4*)(conv_w + 4 * idx);
    __syncthreads();
    const int nunits = NB * NH * n_cnt, nrounds = (nunits + 2 * nblk - 1) / (2 * nblk);
#pragma unroll 1
    for (int it = 0; it < nrounds; ++it) {
        int tid_ = F.tid; asm volatile("" : "+v"(tid_));
        const int ht = tid_ & 255, lane = tid_ & 63, r16 = lane & 15, gq = lane >> 4;
        int v_ = (it * nblk + ((int)blockIdx.x - blk0)) * 2 + half; asm volatile("" : "+s"(v_));
        const bool live = v_ < nunits;
        const int bh = live ? v_ / n_cnt : 0, n = live ? n_lo + v_ % n_cnt : 0, b = bh >> 2, h = bh & 3; const int unit = bh * 64 + n;
        const size_t m0 = (size_t)b * SEQ + (size_t)n * 64;
        unsigned char* chunk = F.ws + WS_CHUNK + (size_t)unit * CH_BYTES;
        const int rq = ht >> 4, cg = ht & 15;
        v4u Xa[7], Xb[7]; float gi = 0.f, bi = 0.f;
#define CHUNK_LOADX(X, p_) do { _Pragma("unroll") for (int jj = 0; jj < 7; ++jj) { const int trow = n * 64 + 4 * rq - 3 + jj; const int trc = trow < 0 ? 0 : trow; \
            const v4u u_ = *(const v4u*)(proj + ((size_t)b * SEQ + trc) * NPROJ + (p_) * 512 + h * 128 + 8 * cg); const unsigned mk_ = trow < 0 ? 0u : 0xffffffffu; \
            X[jj] = (v4u){u_.x & mk_, u_.y & mk_, u_.z & mk_, u_.w & mk_}; } } while (0)
#define CHUNK_CONV(X, p_) do { const int col = (p_) * 512 + h * 128 + 8 * cg; float wv[4][8]; \
            _Pragma("unroll") for (int j = 0; j < 4; ++j) { const f32x4 w0 = *(const LAS f32x4*)(cwL + j * 1536 + col), w1 = *(const LAS f32x4*)(cwL + j * 1536 + col + 4); \
                wv[j][0] = w0.x; wv[j][1] = w0.y; wv[j][2] = w0.z; wv[j][3] = w0.w; wv[j][4] = w1.x; wv[j][5] = w1.y; wv[j][6] = w1.z; wv[j][7] = w1.w; } \
            _Pragma("unroll") for (int rr = 0; rr < 4; ++rr) { float y[8]; \
                _Pragma("unroll") for (int q = 0; q < 8; ++q) y[q] = 0.f; \
                _Pragma("unroll") for (int j = 0; j < 4; ++j) { const v4u u = X[rr + j]; \
                    fmac_(y[0], wv[j][0], bflo(u.x)); fmac_(y[1], wv[j][1], bfhi(u.x)); fmac_(y[2], wv[j][2], bflo(u.y)); fmac_(y[3], wv[j][3], bfhi(u.y)); \
                    fmac_(y[4], wv[j][4], bflo(u.z)); fmac_(y[5], wv[j][5], bfhi(u.z)); fmac_(y[6], wv[j][6], bflo(u.w)); fmac_(y[7], wv[j][7], bfhi(u.w)); } \
                float ss = 0.f; \
                _Pragma("unroll") for (int q = 0; q < 8; ++q) { y[q] = siluf_(y[q]); ss += y[q] * y[q]; } \
                float scl = 1.f; \
                if ((p_) < 2) { ss += __shfl_xor(ss, 1); ss += __shfl_xor(ss, 2); ss += __shfl_xor(ss, 4); ss += __shfl_xor(ss, 8); scl = frsq_(ss + 1e-6f); if ((p_) == 0) scl *= 0.08838834764831845f; } \
                v4u o; o.x = cvt_pk_bf16(y[0] * scl, y[1] * scl); o.y = cvt_pk_bf16(y[2] * scl, y[3] * scl); o.z = cvt_pk_bf16(y[4] * scl, y[5] * scl); o.w = cvt_pk_bf16(y[6] * scl, y[7] * scl); \
                const int row = 4 * rq + rr; \
                if ((p_) == 0) *(LAS v4u*)(qn + row * 136 + 8 * cg) = o; else if ((p_) == 1) *(LAS v4u*)(kn + row * 136 + 8 * cg) = o; else *(LAS v4u*)(vn + row * 128 + 8 * cg) = o; \
                __builtin_amdgcn_sched_barrier(0); } } while (0)
        if (live) { CHUNK_LOADX(Xa, 0); CHUNK_LOADX(Xb, 1); if (hw == 0) { gi = gA[(m0 + lane) * 4 + h]; bi = betaA[(m0 + lane) * 4 + h]; } }
        if (live && hw == 0) {
            float c = gi;
#pragma unroll
            for (int o = 1; o < 64; o <<= 1) { const float tt = __shfl_up(c, o); if (lane >= o) c += tt; }
            const float gl = __shfl(c, 63);
            sc[lane] = bi; sc[64 + lane] = c; sc[128 + lane] = fexp_(c); sc[192 + lane] = fexp_(gl - c);
            if (lane == 63) gtotA[unit] = fexp_(c);
        }
        if (live) { CHUNK_CONV(Xa, 0); CHUNK_LOADX(Xa, 2); CHUNK_CONV(Xb, 1); CHUNK_CONV(Xa, 2); }
#undef CHUNK_LOADX
#undef CHUNK_CONV
        __syncthreads();
        const int which = ht >> 7, c = ht & 127;
        float U[64];
        if (live) {
#pragma unroll
            for (int i = 0; i < 64; ++i) { const float bi = sc[i]; const float tv = which ? bf2f(kn[i * 136 + c]) * sc[128 + i] : bf2f(vn[i * 128 + c]); U[i] = tv * bi; }
        } else {
#pragma unroll
            for (int i = 0; i < 64; ++i) U[i] = 0.f;
        }
        __syncthreads();
        if (live) {
            const int ti = hw >> 1, tj = hw & 1, r = lane & 31, hh = lane >> 5;
            f32x16 KK, QK;
#pragma unroll
            for (int q = 0; q < 16; ++q) { KK[q] = 0.f; QK[q] = 0.f; }
#pragma unroll
            for (int ks = 0; ks < 8; ++ks) {
                const bf16x8 ak = *(const LAS bf16x8*)(kn + (ti * 32 + r) * 136 + 16 * ks + 8 * hh);
                const bf16x8 aq = *(const LAS bf16x8*)(qn + (ti * 32 + r) * 136 + 16 * ks + 8 * hh);
                const bf16x8 bb = *(const LAS bf16x8*)(kn + (tj * 32 + r) * 136 + 16 * ks + 8 * hh);
                KK = __builtin_amdgcn_mfma_f32_32x32x16_bf16(ak, bb, KK, 0, 0, 0);
                QK = __builtin_amdgcn_mfma_f32_32x32x16_bf16(aq, bb, QK, 0, 0, 0);
            }
            const int j = tj * 32 + r; const float gcj = sc[64 + j];
#pragma unroll
            for (int reg = 0; reg < 16; ++reg) { const int i = ti * 32 + (reg & 3) + 8 * (reg >> 2) + 4 * hh;
                const float dec = (i >= j) ? __expf(sc[64 + i] - gcj) : 0.f;
                Am[i * 64 + j] = (i > j) ? sc[i] * KK[reg] * dec : 0.f;
                qkL[i * 64 + j] = (bf16)f2bf((i >= j) ? QK[reg] * dec : 0.f); }
        }
        __syncthreads();
        if (live) {
#pragma unroll
            for (int fi = 0; fi < 4; ++fi) { const int f = hw * 4 + fi, mb = f >> 2, ks = f & 3, row = 16 * mb + r16; const float s = sc[128 + row];
                const v2u lo = *(const LAS v2u*)(qn + row * 136 + 32 * ks + 4 * gq), hi = *(const LAS v2u*)(qn + row * 136 + 32 * ks + 16 + 4 * gq);
                v4u o; o.x = pk2(bflo(lo.x) * s, bfhi(lo.x) * s); o.y = pk2(bflo(lo.y) * s, bfhi(lo.y) * s); o.z = pk2(bflo(hi.x) * s, bfhi(hi.x) * s); o.w = pk2(bflo(hi.y) * s, bfhi(hi.y) * s);
                *(v4u*)(chunk + CH_QD + (f * 64 + lane) * 16) = o; }
#pragma unroll
            for (int fi = 0; fi < 4; ++fi) { const int f = hw * 4 + fi, db = f >> 1, ksp = f & 1, dcol = 16 * db + r16; float e[8];
#pragma unroll
                for (int j = 0; j < 8; ++j) { const int i = 32 * ksp + 16 * (j >> 2) + 4 * gq + (j & 3); e[j] = bf2f(kn[i * 136 + dcol]) * sc[192 + i]; }
                v4u o; o.x = pk2(e[0], e[1]); o.y = pk2(e[2], e[3]); o.z = pk2(e[4], e[5]); o.w = pk2(e[6], e[7]);
                *(v4u*)(chunk + CH_KT + (f * 64 + lane) * 16) = o; }
#pragma unroll
            for (int fi = 0; fi < 2; ++fi) { const int f = hw * 2 + fi, mb = f >> 1, ksp = f & 1, row = 16 * mb + r16;
                const v2u lo = *(const LAS v2u*)(qkL + row * 64 + 32 * ksp + 4 * gq), hi = *(const LAS v2u*)(qkL + row * 64 + 32 * ksp + 16 + 4 * gq);
                *(v4u*)(chunk + CH_QK + (f * 64 + lane) * 16) = (v4u){lo.x, lo.y, hi.x, hi.y}; }
            solve_all(U, Am);
        }
        __syncthreads();
        if (live) {
            if (which == 0) {
                const int w8 = c >> 4, cl = c & 15;
                unsigned char* ub = F.ws + WS_UC + (size_t)unit * UC_BYTES;
#pragma unroll
                for (int g = 0; g < 4; ++g) {
                    v4u lo, hi;
                    lo.x = pk2(U[4 * g], U[4 * g + 1]); lo.y = pk2(U[4 * g + 2], U[4 * g + 3]); lo.z = pk2(U[16 + 4 * g], U[16 + 4 * g + 1]); lo.w = pk2(U[16 + 4 * g + 2], U[16 + 4 * g + 3]);
                    hi.x = pk2(U[32 + 4 * g], U[32 + 4 * g + 1]); hi.y = pk2(U[32 + 4 * g + 2], U[32 + 4 * g + 3]); hi.z = pk2(U[48 + 4 * g], U[48 + 4 * g + 1]); hi.w = pk2(U[48 + 4 * g + 2], U[48 + 4 * g + 3]);
                    v4u* dst = (v4u*)(ub + ((w8 * 64 + g * 16 + cl) * 32)); dst[0] = lo; dst[1] = hi;
                }
            } else {
#pragma unroll
                for (int i = 0; i < 64; ++i) qn[i * 136 + c] = (bf16)f2bf(U[i]);
            }
        }
        __syncthreads();
        if (live) {
#pragma unroll
            for (int fi = 0; fi < 4; ++fi) { const int f = hw * 4 + fi, mb = f >> 2, ks = f & 3, row = 16 * mb + r16;
                const v2u lo = *(const LAS v2u*)(qn + row * 136 + 32 * ks + 4 * gq), hi = *(const LAS v2u*)(qn + row * 136 + 32 * ks + 16 + 4 * gq);
                *(v4u*)(chunk + CH_WF + (f * 64 + lane) * 16) = (v4u){lo.x, lo.y, hi.x, hi.y}; }
        }
        __syncthreads();
    }
}

constexpr int SCAN_SPLIT = 32;
constexpr int SC_STAGED = 49152, SC_NLOAD = 16;
struct ScanU { v4u u0, u1; };
struct ScanQ { v4u q[8]; };
__device__ __forceinline__ void scan_issue_u(ScanU& R, const unsigned char* up) {
    asm volatile("global_load_dwordx4 %0, %1, off" : "=v"(R.u0) : "v"(up) : "memory");
    asm volatile("global_load_dwordx4 %0, %1, off offset:16" : "=v"(R.u1) : "v"(up) : "memory");
}
__device__ __forceinline__ void scan_issue_q(ScanQ& R, const unsigned char* qp) {
    asm volatile("global_load_dwordx4 %0, %1, off" : "=v"(R.q[0]) : "v"(qp) : "memory");
    asm volatile("global_load_dwordx4 %0, %1, off offset:1024" : "=v"(R.q[1]) : "v"(qp) : "memory");
    asm volatile("global_load_dwordx4 %0, %1, off offset:2048" : "=v"(R.q[2]) : "v"(qp) : "memory");
    asm volatile("global_load_dwordx4 %0, %1, off offset:3072" : "=v"(R.q[3]) : "v"(qp) : "memory");
    const unsigned char* qp2 = qp + 4096;
    asm volatile("global_load_dwordx4 %0, %1, off" : "=v"(R.q[4]) : "v"(qp2) : "memory");
    asm volatile("global_load_dwordx4 %0, %1, off offset:1024" : "=v"(R.q[5]) : "v"(qp2) : "memory");
    asm volatile("global_load_dwordx4 %0, %1, off offset:2048" : "=v"(R.q[6]) : "v"(qp2) : "memory");
    asm volatile("global_load_dwordx4 %0, %1, off offset:3072" : "=v"(R.q[7]) : "v"(qp2) : "memory");
}
#define SCAN_WAIT_REGS(U, Q, cnt) asm volatile("s_waitcnt vmcnt(" #cnt ")" : "+v"(U.u0), "+v"(U.u1), "+v"(Q.q[0]), "+v"(Q.q[1]), "+v"(Q.q[2]), "+v"(Q.q[3]), "+v"(Q.q[4]), "+v"(Q.q[5]), "+v"(Q.q[6]), "+v"(Q.q[7]) :: "memory")
template <class Bar> __device__ __forceinline__ void phase_scan(Frame& F, const Bar& mid_barrier) {
    const int bh = blockIdx.x, b = bh >> 2, h = bh & 3, w = F.wave, lane = F.lane, cl = lane & 15, gq = lane >> 4;
    const float* gtotA = (const float*)(F.ws + WS_GTOT);
    const int unit0 = bh * 64;
    const unsigned char* cbase = F.ws + WS_CHUNK + (size_t)unit0 * CH_BYTES;
    const unsigned char* ubase = F.ws + WS_UC + (size_t)unit0 * UC_BYTES + (w * 64 + lane) * 32;
    const unsigned char* qbase = cbase + CH_QK + lane * 16;
    bf16* op = (bf16*)(F.ws + WS_ORAW) + ((size_t)b * SEQ + cl) * 512 + h * 128 + 16 * w + 4 * gq;
    f32x4 Sacc[8]; bf16x8 Sb[4];
#pragma unroll
    for (int d = 0; d < 8; ++d) Sacc[d] = (f32x4){0.f, 0.f, 0.f, 0.f};
#pragma unroll
    for (int k = 0; k < 4; ++k) Sb[k] = (bf16x8){0, 0, 0, 0, 0, 0, 0, 0};
    v2u Ow[4];
#pragma unroll
    for (int mb = 0; mb < 4; ++mb) Ow[mb] = (v2u){0u, 0u};
    ScanU U0, U1, U2; ScanQ QA, QB;
#define SCAN_ISSUE(nn) do { const unsigned char* s_ = cbase + (size_t)(nn) * CH_BYTES + (w * 6) * 1024 + lane * 16; LAS unsigned char* d_ = F.lds + ((nn) % 3) * SC_STAGED + (w * 6) * 1024; \
        _Pragma("unroll") for (int k_ = 0; k_ < 6; ++k_) __builtin_amdgcn_global_load_lds((const unsigned*)(s_ + k_ * 1024), (LAS unsigned*)(d_ + k_ * 1024), 16, 0, 0); } while (0)
#define SCAN_STEP(n, UC, UN, Q, ISSUE2, WAITCNT) do { \
        SCAN_WAIT_REGS(UC, Q, WAITCNT); asm volatile("s_waitcnt lgkmcnt(0)" ::: "memory"); __builtin_amdgcn_s_barrier(); asm volatile("" ::: "memory"); \
        const float gt = __shfl(gtv, (n) & 31); \
        if (ISSUE2) { scan_issue_u(UN, ubase + (size_t)((n) + 2) * UC_BYTES); SCAN_ISSUE((n) + 2); } \
        if ((n) > 0) { _Pragma("unroll") for (int mb = 0; mb < 4; ++mb) *(v2u*)(op + (size_t)(((n) - 1) * 64 + 16 * mb) * 512) = Ow[mb]; } \
        const LAS unsigned char* B = F.lds + ((n) % 3) * SC_STAGED; \
        f32x4 P[4]; \
        _Pragma("unroll") for (int mb = 0; mb < 4; ++mb) { P[mb] = (f32x4){0.f, 0.f, 0.f, 0.f}; \
            _Pragma("unroll") for (int ks = 0; ks < 4; ++ks) P[mb] = __builtin_amdgcn_mfma_f32_16x16x32_bf16(SFRAG(CH_WF, mb * 4 + ks), Sb[ks], P[mb], 0, 0, 0); } \
        f32x4 vnw[4]; \
        vnw[0] = (f32x4){bflo(UC.u0.x), bfhi(UC.u0.x), bflo(UC.u0.y), bfhi(UC.u0.y)} - P[0]; \
        vnw[1] = (f32x4){bflo(UC.u0.z), bfhi(UC.u0.z), bflo(UC.u0.w), bfhi(UC.u0.w)} - P[1]; \
        vnw[2] = (f32x4){bflo(UC.u1.x), bfhi(UC.u1.x), bflo(UC.u1.y), bfhi(UC.u1.y)} - P[2]; \
        vnw[3] = (f32x4){bflo(UC.u1.z), bfhi(UC.u1.z), bflo(UC.u1.w), bfhi(UC.u1.w)} - P[3]; \
        bf16x8 Vb[2]; Vb[0] = pack8(vnw[0], vnw[1]); Vb[1] = pack8(vnw[2], vnw[3]); \
        _Pragma("unroll") for (int mb = 0; mb < 4; ++mb) { f32x4 OT = (f32x4){0.f, 0.f, 0.f, 0.f}; \
            _Pragma("unroll") for (int ks = 0; ks < 4; ++ks) OT = __builtin_amdgcn_mfma_f32_16x16x32_bf16(Sb[ks], SFRAG(CH_QD, mb * 4 + ks), OT, 0, 0, 0); \
            _Pragma("unroll") for (int ksp = 0; ksp < 2; ++ksp) OT = __builtin_amdgcn_mfma_f32_16x16x32_bf16(Vb[ksp], __builtin_bit_cast(bf16x8, Q.q[mb * 2 + ksp]), OT, 0, 0, 0); \
            Ow[mb] = (v2u){cvt_pk_bf16(OT[0], OT[1]), cvt_pk_bf16(OT[2], OT[3])}; } \
        asm volatile("s_nop 7" : "+v"(Q.q[0]), "+v"(Q.q[1]), "+v"(Q.q[2]), "+v"(Q.q[3]), "+v"(Q.q[4]), "+v"(Q.q[5]), "+v"(Q.q[6]), "+v"(Q.q[7]));     \
        if (ISSUE2) scan_issue_q(Q, qbase + (size_t)((n) + 2) * CH_BYTES); \
        _Pragma("unroll") for (int db = 0; db < 8; ++db) { Sacc[db] = Sacc[db] * gt; \
            _Pragma("unroll") for (int ksp = 0; ksp < 2; ++ksp) Sacc[db] = __builtin_amdgcn_mfma_f32_16x16x32_bf16(SFRAG(CH_KT, db * 2 + ksp), Vb[ksp], Sacc[db], 0, 0, 0); } \
        _Pragma("unroll") for (int ks = 0; ks < 4; ++ks) Sb[ks] = pack8(Sacc[2 * ks], Sacc[2 * ks + 1]); \
    } while (0)
#define SFRAG(off, f) (*(const LAS bf16x8*)(B + (off) + ((f) * 64 + lane) * 16))
    static_assert(CH_WF == 0 && CH_QD == 16384 && CH_KT == 32768 && CH_QK == SC_STAGED && SCAN_SPLIT % 6 == 2 && 2 * SCAN_SPLIT == 64, "staged part = the first 48 KiB of a chunk; a half = 5 x 6 + 2 steps");
#pragma unroll 1
    for (int part = 0; part < 2; ++part) {
        const int n0 = part * SCAN_SPLIT;
        float gtv = gtotA[unit0 + n0 + (lane & 31)];
        asm volatile("s_waitcnt vmcnt(0)" : "+v"(gtv) :: "memory");
        scan_issue_u(U0, ubase + (size_t)n0 * UC_BYTES); SCAN_ISSUE(n0); scan_issue_q(QA, qbase + (size_t)n0 * CH_BYTES);
        scan_issue_u(U1, ubase + (size_t)(n0 + 1) * UC_BYTES); SCAN_ISSUE(n0 + 1); scan_issue_q(QB, qbase + (size_t)(n0 + 1) * CH_BYTES);
#pragma unroll 1
        for (int n = n0; n < n0 + SCAN_SPLIT - 2; n += 6) {
            SCAN_STEP(n, U0, U2, QA, true, 16);
            SCAN_STEP(n + 1, U1, U0, QB, true, 16);
            SCAN_STEP(n + 2, U2, U1, QA, true, 16);
            SCAN_STEP(n + 3, U0, U2, QB, true, 16);
            SCAN_STEP(n + 4, U1, U0, QA, true, 16);
            SCAN_STEP(n + 5, U2, U1, QB, true, 16);
        }
        SCAN_STEP(n0 + SCAN_SPLIT - 2, U0, U2, QA, false, 16);
        SCAN_STEP(n0 + SCAN_SPLIT - 1, U1, U0, QB, false, 0);
        if (part == 0) mid_barrier();
    }
#undef SFRAG
#undef SCAN_STEP
#undef SCAN_ISSUE
#pragma unroll
    for (int mb = 0; mb < 4; ++mb) *(v2u*)(op + (size_t)(63 * 64 + 16 * mb) * 512) = Ow[mb];
    VM_WAIT(); __syncthreads();
}

__device__ __forceinline__ void phase_onorm(Frame& F) {
    const float* dnw = F.in[6]; const bf16* proj = (const bf16*)(F.ws + WS_PROJ); const bf16* oraw = (const bf16*)(F.ws + WS_ORAW); bf16* concat = (bf16*)(F.ws + WS_CONCAT);
    const int gw = F.vcu * NWAVES + F.wave, NGW = F.G * NWAVES, lane = F.lane;
    const int cc = 8 * (lane & 15);
    const f32x4 d0 = *(const f32x4*)(dnw + cc), d1 = *(const f32x4*)(dnw + cc + 4);
    for (int m = gw; m < NTOK; m += NGW) {
        const v4u o = *(const v4u*)(oraw + (size_t)m * 512 + 8 * lane);
        const v4u z = *(const v4u*)(proj + (size_t)m * NPROJ + 1536 + 8 * lane);
        const float ov[8] = {bflo(o.x), bfhi(o.x), bflo(o.y), bfhi(o.y), bflo(o.z), bfhi(o.z), bflo(o.w), bfhi(o.w)};
        const float zv[8] = {bflo(z.x), bfhi(z.x), bflo(z.y), bfhi(z.y), bflo(z.z), bfhi(z.z), bflo(z.w), bfhi(z.w)};
        float ss = 0.f;
#pragma unroll
        for (int q = 0; q < 8; ++q) ss += ov[q] * ov[q];
        ss += __shfl_xor(ss, 1); ss += __shfl_xor(ss, 2); ss += __shfl_xor(ss, 4); ss += __shfl_xor(ss, 8);
        const float rs = frsq_(ss * (1.f / 128.f) + 1e-6f);
        const float dv[8] = {d0.x, d0.y, d0.z, d0.w, d1.x, d1.y, d1.z, d1.w};
        float r[8];
#pragma unroll
        for (int q = 0; q < 8; ++q) r[q] = ov[q] * rs * dv[q] * siluf_(zv[q]);
        *(v4u*)(concat + (size_t)m * DM + 8 * lane) = (v4u){cvt_pk_bf16(r[0], r[1]), cvt_pk_bf16(r[2], r[3]), cvt_pk_bf16(r[4], r[5]), cvt_pk_bf16(r[6], r[7])};
    }
}

__device__ __forceinline__ void phase_route(Frame& F) {
    const bf16* x1 = (const bf16*)(F.ws + WS_X1); const float* b_router = F.in[12];
    unsigned char* x1b = F.ws + WS_X1B; float* rs2A = (float*)(F.ws + WS_RS2); int* list = (int*)(F.ws + WS_LIST);
    float* rsl = (float*)(F.ws + WS_RSL); float* gwl = (float*)(F.ws + WS_GWL);
    unsigned* cntw = (unsigned*)(F.ws + WS_CTL) + CW_CNT;
    LAS unsigned char* WI = F.lds;
    LAS unsigned* lcnt = (LAS unsigned*)(F.lds + TAB_OFF);
    { const v4u* src = (const v4u*)(F.ws + WS_WR);
      for (int idx = F.tid; idx < 131072 / 16; idx += 512) *(LAS v4u*)(WI + 16 * idx) = src[idx]; }
    const int lane = F.lane, c = lane & 15, g = lane >> 4;
    const int gw = F.vcu * NWAVES + F.wave, NGW = F.G * NWAVES, NT = NTOK / 16;
    const float bia0 = b_router[c], bia1 = b_router[16 + c];
    for (int t0 = 0; t0 < NT; t0 += NGW) {
        const int tile = t0 + gw; const bool live = tile < NT;
        if (F.tid < 64) lcnt[F.tid] = 0u;
        __syncthreads();
        int my_e = 0; float my_g = 0.f, my_rs = 0.f; unsigned my_rank = 0u; int my_ent = 0;
        if (live) {
            const int m0 = tile * 16;
            const bf16* xrow = x1 + (size_t)(m0 + c) * DM + 8 * g;
            unsigned char* xbrow = x1b + (size_t)(m0 + c) * DM + 8 * g;
            f32x4 acc0 = (f32x4){0.f, 0.f, 0.f, 0.f}, acc1 = acc0; float ssq = 0.f;
#pragma unroll 1
            for (int kb = 0; kb < 2; ++kb) {
                v4u xa[16];
#pragma unroll
                for (int q = 0; q < 16; ++q) xa[q] = *(const v4u*)(xrow + 32 * (kb * 16 + q));
#pragma unroll
                for (int q = 0; q < 16; ++q) { const int ks = kb * 16 + q; const v4u h = xa[q];
                    const float a0 = bflo(h.x), a1 = bfhi(h.x), a2 = bflo(h.y), a3 = bfhi(h.y), b0 = bflo(h.z), b1 = bfhi(h.z), b2 = bflo(h.w), b3 = bfhi(h.w);
                    ssq += (a0 * a0 + a1 * a1) + (a2 * a2 + a3 * a3) + (b0 * b0 + b1 * b1) + (b2 * b2 + b3 * b3);
                    *(v2u*)(xbrow + 32 * ks) = (v2u){pk4_fp8(a0, a1, a2, a3), pk4_fp8(b0, b1, b2, b3)};
                    const bf16x8 ah = __builtin_bit_cast(bf16x8, h);
                    const LAS unsigned char* fb = WI + (size_t)(ks * 4) * 1024 + lane * 16;
                    const bf16x8 b0h = *(const LAS bf16x8*)(fb), b0l = *(const LAS bf16x8*)(fb + 1024), b1h = *(const LAS bf16x8*)(fb + 2048), b1l = *(const LAS bf16x8*)(fb + 3072);
                    acc0 = __builtin_amdgcn_mfma_f32_16x16x32_bf16(ah, b0h, acc0, 0, 0, 0); acc0 = __builtin_amdgcn_mfma_f32_16x16x32_bf16(ah, b0l, acc0, 0, 0, 0);
                    acc1 = __builtin_amdgcn_mfma_f32_16x16x32_bf16(ah, b1h, acc1, 0, 0, 0); acc1 = __builtin_amdgcn_mfma_f32_16x16x32_bf16(ah, b1l, acc1, 0, 0, 0); }
            }
            ssq += __shfl_xor(ssq, 16); ssq += __shfl_xor(ssq, 32);
            const float rsr = frsq_(ssq * (1.f / DM) + 1e-6f);
            if (g == 0) rs2A[m0 + c] = rsr;
            float ge_[4]; int ee_[4];
#pragma unroll
            for (int reg = 0; reg < 4; ++reg) {
                const float rsw = __shfl(rsr, 4 * g + reg);
                float v0 = acc0[reg] * rsw + bia0, v1 = acc1[reg] * rsw + bia1;
                float tv[4]; int te[4];
#pragma unroll
                for (int s = 0; s < 4; ++s) {
                    float bv; int bi; if (v1 > v0) { bv = v1; bi = 16 + c; } else { bv = v0; bi = c; }
#pragma unroll
                    for (int o = 1; o < 16; o <<= 1) { const float ov = __shfl_xor(bv, o); const int oi = __shfl_xor(bi, o); if (ov > bv || (ov == bv && oi < bi)) { bv = ov; bi = oi; } }
                    tv[s] = bv; te[s] = bi; if (bi == c) v0 = -3.0e38f; if (bi == 16 + c) v1 = -3.0e38f;
                }
                const float e1 = fexp_(tv[1] - tv[0]), e2 = fexp_(tv[2] - tv[0]), e3 = fexp_(tv[3] - tv[0]); const float inv = frcp_(1.f + e1 + e2 + e3);
                const int s_ = c & 3; const float gsel = (s_ == 0 ? 1.f : s_ == 1 ? e1 : s_ == 2 ? e2 : e3) * inv; const int esel = s_ == 0 ? te[0] : s_ == 1 ? te[1] : s_ == 2 ? te[2] : te[3];
                ge_[reg] = gsel; ee_[reg] = esel;
            }
            const int rsel = c >> 2;
            my_g = rsel == 0 ? ge_[0] : rsel == 1 ? ge_[1] : rsel == 2 ? ge_[2] : ge_[3];
            my_e = rsel == 0 ? ee_[0] : rsel == 1 ? ee_[1] : rsel == 2 ? ee_[2] : ee_[3];
            my_ent = (m0 + 4 * g + rsel) * 4 + (c & 3);
            my_rs = __shfl(rsr, 4 * g + rsel);
            my_rank = __hip_atomic_fetch_add(lcnt + my_e, 1u, __ATOMIC_RELAXED, __HIP_MEMORY_SCOPE_WORKGROUP);
        }
        __syncthreads();
        if (F.tid < NE) { const unsigned n = lcnt[F.tid]; lcnt[32 + F.tid] = n ? __hip_atomic_fetch_add(cntw + 64 * F.tid, n, RLX_AGENT) : 0u; }
        __syncthreads();
        if (live) { const size_t pos = (size_t)my_e * LISTCAP + lcnt[32 + my_e] + my_rank; list[pos] = my_ent; rsl[pos] = my_rs; gwl[pos] = my_g; }
        __syncthreads();
    }
}

constexpr int TILE_TAB_OFF = pg8::STAGE_BYTES + 8192;
__device__ __forceinline__ int moe_tables(Frame& F, MoeTab& T) {
    LAS int* pref = (LAS int*)(F.lds + TAB_OFF); LAS int* cnt = pref + 40; LAS int* tile = (LAS int*)(F.lds + TILE_TAB_OFF);
    unsigned* cntw = (unsigned*)(F.ws + WS_CTL) + CW_CNT;
    if (F.tid == 0) { int acc = 0; for (int e = 0; e < NE; ++e) { const int c = (int)__hip_atomic_load(cntw + 64 * e, RLX_AGENT); cnt[e] = c; pref[e] = acc; acc += (c + 255) >> 8; } pref[NE] = acc; }
    __syncthreads();
    const int RT = pref[NE];
    for (int rt = F.tid; rt < RT; rt += NWAVES * 64) { int e = 0;
        for (int j = 1; j < NE; ++j) if (pref[j] <= rt) e = j;
        const int rb = rt - pref[e], left = cnt[e] - rb * 256;
        tile[rt] = (e << 24) | (rb << 12) | (left < 256 ? left : 256); }
    __syncthreads();
    T.pref = pref; T.cnt = cnt; T.tile = tile;
    return RT;
}

struct FinalRow { f32x4 v[4]; v2u sl[4][2]; };
__device__ __forceinline__ void final_load(FinalRow& R, const bf16* xrow, const unsigned char* srow) {
#pragma unroll
    for (int j = 0; j < 2; ++j) { const v4u h = *(const v4u*)(xrow + 512 * j);
        R.v[2 * j] = (f32x4){bflo(h.x), bfhi(h.x), bflo(h.y), bfhi(h.y)}; R.v[2 * j + 1] = (f32x4){bflo(h.z), bfhi(h.z), bflo(h.w), bfhi(h.w)}; }
#pragma unroll
    for (int s = 0; s < 4; ++s)
#pragma unroll
        for (int j = 0; j < 2; ++j) R.sl[s][j] = *(const v2u*)(srow + (size_t)s * DM + 512 * j);
}
__device__ __forceinline__ void final_finish(FinalRow& R, float* orow, const f32x4 (&wv)[4]) {
#pragma unroll
    for (int s = 0; s < 4; ++s)
#pragma unroll
        for (int j = 0; j < 2; ++j) { const v2u u = R.sl[s][j];
            const f32x2_t a0 = __builtin_amdgcn_cvt_pk_f32_fp8((int)u.x, false), a1 = __builtin_amdgcn_cvt_pk_f32_fp8((int)u.x, true), b0 = __builtin_amdgcn_cvt_pk_f32_fp8((int)u.y, false), b1 = __builtin_amdgcn_cvt_pk_f32_fp8((int)u.y, true);
            R.v[2 * j].x += a0.x * SLAB_INV; R.v[2 * j].y += a0.y * SLAB_INV; R.v[2 * j].z += a1.x * SLAB_INV; R.v[2 * j].w += a1.y * SLAB_INV;
            R.v[2 * j + 1].x += b0.x * SLAB_INV; R.v[2 * j + 1].y += b0.y * SLAB_INV; R.v[2 * j + 1].z += b1.x * SLAB_INV; R.v[2 * j + 1].w += b1.y * SLAB_INV; }
    float ss = 0.f;
#pragma unroll
    for (int j = 0; j < 4; ++j) ss += (R.v[j].x * R.v[j].x + R.v[j].y * R.v[j].y) + (R.v[j].z * R.v[j].z + R.v[j].w * R.v[j].w);
    ss = wave_sum(ss);
    const float rs = frsq_(ss * (1.f / DM) + 1e-6f);
#pragma unroll
    for (int j = 0; j < 2; ++j) { *(f32x4*)(orow + 512 * j) = R.v[2 * j] * rs * wv[2 * j]; *(f32x4*)(orow + 512 * j + 4) = R.v[2 * j + 1] * rs * wv[2 * j + 1]; }
}
__device__ __forceinline__ void phase_final(Frame& F, int dryrun) {
    const float* fw = F.in[17]; const unsigned char* slab = F.ws + WS_SLAB; float* out = F.out;
    const bf16* x1 = (const bf16*)(F.ws + WS_X1); (void)dryrun;
    const int gw = F.vcu * NWAVES + F.wave, NGW = F.G * NWAVES, lane = F.lane;
    f32x4 wv[4];
#pragma unroll
    for (int j = 0; j < 2; ++j) { wv[2 * j] = *(const f32x4*)(fw + 512 * j + 8 * lane); wv[2 * j + 1] = *(const f32x4*)(fw + 512 * j + 8 * lane + 4); }
    FinalRow A, B;
    int m = gw;
    if (m < NTOK) final_load(A, x1 + (size_t)m * DM + 8 * lane, slab + (size_t)m * 4 * DM + 8 * lane);
    for (; m < NTOK; m += 2 * NGW) {
        const int m1 = m + NGW, m2 = m + 2 * NGW;
        if (m1 < NTOK) final_load(B, x1 + (size_t)m1 * DM + 8 * lane, slab + (size_t)m1 * 4 * DM + 8 * lane);
        final_finish(A, out + (size_t)m * DM + 8 * lane, wv);
        if (m2 < NTOK) final_load(A, x1 + (size_t)m2 * DM + 8 * lane, slab + (size_t)m2 * 4 * DM + 8 * lane);
        if (m1 < NTOK) final_finish(B, out + (size_t)m1 * DM + 8 * lane, wv);
    }
}

struct Args { const float* in[18]; float* out; unsigned char* ws; int ph_lo, ph_hi, flag, breg; };
constexpr int NPHASE = 11;

__global__ void __launch_bounds__(NWAVES * 64, 2) mk_fwd(Args args) {
    extern __shared__ __attribute__((aligned(16))) unsigned char lds_raw[];
    Frame F;
    F.lds = (LAS unsigned char*)lds_raw;
    F.tid = threadIdx.x; F.lane = F.tid & 63; F.wave = __builtin_amdgcn_readfirstlane(F.tid >> 6);
    F.G = gridDim.x; { const int bx = blockIdx.x; F.vcu = (F.G % 8 == 0) ? (bx % 8) * (F.G / 8) + bx / 8 : bx; }
#pragma unroll
    for (int i = 0; i < 18; ++i) F.in[i] = args.in[i];
    F.out = args.out; F.ws = args.ws;
    volatile LAS unsigned* MISC = (volatile LAS unsigned*)(F.lds + MISC_OFF);
    for (int u = F.tid; u < (LDS_BYTES - LDSCTL_OFF) / 4; u += NWAVES * 64) ((LAS unsigned*)(F.lds + LDSCTL_OFF))[u] = 0u;
    __syncthreads();
    unsigned* ctl = (unsigned*)(F.ws + WS_CTL);
#if !MK_PER_PHASE
    XcdBarrier bar = xcd_barrier_post(ctl + CW_BAR, MISC + 8);
#define GRID_BAR() xcd_barrier(bar)
#else
#define GRID_BAR() do {} while (0)
#endif
    const int lo = args.ph_lo, hi = args.ph_hi;
#define IN(k) (lo <= (k) && (k) < hi)
#define SEAM(k) do { if (IN(k) && IN((k) + 1)) GRID_BAR(); } while (0)

#define RUNPH(k, ...) do { if (IN(k)) { __VA_ARGS__; } SEAM(k); } while (0)
    RUNPH(0, phase_prep(F));
    RUNPH(1, {
        ProbIn P; P.K = DM; P.RB = 2 * DM; P.S.init(NTOK / 256, NPROJ / 256, F.G, (int)blockIdx.x);
        P.A = (const bf16*)(F.ws + WS_XB); P.Bt = (const bf16*)(F.ws + WS_WIN); P.O = (bf16*)(F.ws + WS_PROJ); P.rs = (const float*)(F.ws + WS_RS1);
        pg8::gemm_phase(F.lds, P); });
    if (IN(2)) { phase_mix(F); __syncthreads(); }
    RUNPH(3, phase_chunk(F, 0, F.G, 0, SCAN_SPLIT));
    RUNPH(4, {
        const int nscan = NB * NH;
        unsigned* seam = ctl + CW_SEAM4 + 64 * args.breg;
        auto scan_wait = [&]() {
            asm volatile("s_waitcnt vmcnt(0)" ::: "memory"); __syncthreads();
            if (F.tid == 0) { const unsigned want = (unsigned)(F.G - nscan); unsigned sp = 0u;
                while (__hip_atomic_load(seam, RLX_AGENT) < want) { __builtin_amdgcn_s_sleep(2); if (++sp > (1u << 22)) break; }
                __builtin_amdgcn_fence(__ATOMIC_ACQUIRE, "agent"); asm volatile("s_waitcnt vmcnt(0)" ::: "memory"); }
            __syncthreads();
        };
        if ((int)blockIdx.x < nscan) phase_scan(F, scan_wait);
        else {
               phase_chunk(F, nscan, F.G - nscan, SCAN_SPLIT, 64 - SCAN_SPLIT);
               asm volatile("s_waitcnt vmcnt(0)" ::: "memory"); __syncthreads();
               if (F.tid == 0) { __builtin_amdgcn_fence(__ATOMIC_RELEASE, "agent"); asm volatile("s_waitcnt vmcnt(0)" ::: "memory"); __hip_atomic_fetch_add(seam, 1u, RLX_AGENT); }
               moe_weight_prep(F, nscan, MOE_PREP_SPLIT, MOE_PREP_ITEMS); } });
    RUNPH(5, phase_onorm(F));
    RUNPH(6, {
        ProbOut P; P.K = DM; P.RB = 2 * DM; P.S.init(NTOK / 256, DM / 256, F.G, (int)blockIdx.x);
        P.A = (const bf16*)(F.ws + WS_CONCAT); P.Bt = (const bf16*)(F.ws + WS_WOUT); P.X = (const bf16*)(F.ws + WS_XB); P.O = (bf16*)(F.ws + WS_X1);
        pg8::gemm_phase(F.lds, P); });
    RUNPH(7, phase_route(F));
    RUNPH(8, {
        ProbGU P; const int RT = moe_tables(F, P.T);
        P.K = DM; P.RB = DM; P.S.init(RT, 8, F.G, (int)blockIdx.x);
        P.A = F.ws + WS_X1B; P.Bt = F.ws + WS_WGU; P.O = F.ws + WS_ACT; P.list = (const int*)(F.ws + WS_LIST);
        P.rs2 = (const float*)(F.ws + WS_RSL); P.bgu = (const float*)(F.ws + WS_BGU);
        pg8::gemm_phase<ProbGU, true>(F.lds, P); });
    RUNPH(9, {
        ProbDown P; const int RT = moe_tables(F, P.T);
        P.K = DE; P.RB = DE; P.S.init(RT, 4, F.G, (int)blockIdx.x);
        P.A = F.ws + WS_ACT; P.Bt = F.ws + WS_WD; P.O = F.ws + WS_SLAB; P.list = (const int*)(F.ws + WS_LIST);
        P.gw = (const float*)(F.ws + WS_GWL); P.bd = F.in[16];
        pg8::gemm_phase<ProbDown, true>(F.lds, P); });
    RUNPH(10, phase_final(F, args.flag));
#undef RUNPH
#undef IN
#undef SEAM
}

extern "C" void kernel_launch(void* const* d_in, const int* in_sizes, int n_in, void* d_out, int out_size, void* d_ws, size_t ws_size, hipStream_t stream) {
    static int grid = 0;
    if (grid == 0) {
        if (n_in != 18 || in_sizes[0] != NTOK * DM || out_size != NTOK * DM || ws_size < WS_END) { fprintf(stderr, "kernel_launch: unexpected shapes (n_in %d, in0 %d, out %d, ws %zu)\n", n_in, n_in > 0 ? in_sizes[0] : -1, out_size, ws_size); grid = -1; return; }
        int dev = 0, cus = 0, per_cu = 0;
        if (hipGetDevice(&dev) != hipSuccess || hipDeviceGetAttribute(&cus, hipDeviceAttributeMultiprocessorCount, dev) != hipSuccess) { grid = -1; return; }
        if (hipFuncSetAttribute((const void*)mk_fwd, hipFuncAttributeMaxDynamicSharedMemorySize, LDS_BYTES) != hipSuccess) { fprintf(stderr, "kernel_launch: hipFuncSetAttribute failed\n"); grid = -1; return; }
        if (hipOccupancyMaxActiveBlocksPerMultiprocessor(&per_cu, (const void*)mk_fwd, NWAVES * 64, LDS_BYTES) != hipSuccess || per_cu < 1) { fprintf(stderr, "kernel_launch: occupancy query says %d\n", per_cu); per_cu = 1; }
        (void)hipGetLastError();
        grid = cus;
    }
    if (grid < 0) return;
    (void)hipMemsetAsync((char*)d_ws + WS_CTL, 0, CTL_ZERO_BYTES, stream);
    Args a{};
    for (int i = 0; i < 18; ++i) a.in[i] = (const float*)d_in[i];
    a.out = (float*)d_out; a.ws = (unsigned char*)d_ws;
#if MK_PER_PHASE
    for (int p = 0; p < NPHASE; ++p) { a.ph_lo = p; a.ph_hi = p + 1; const int nrep = 1 + REP_CNT * ((REP_MASK >> p) & 1);
        for (int r = 0; r < nrep; ++r) { a.flag = (p == NPHASE - 1 && r + 1 < nrep) ? 1 : 0; a.breg = r; hipLaunchKernelGGL(mk_fwd, dim3(grid), dim3(NWAVES * 64), LDS_BYTES, stream, a); } }
#else
    a.ph_lo = 0; a.ph_hi = NPHASE;
    hipLaunchKernelGGL(mk_fwd, dim3(grid), dim3(NWAVES * 64), LDS_BYTES, stream, a);
#endif
}
```

```cpp
#include <hip/hip_runtime.h>
#include <cstdio>
#include <cstdint>

#ifndef REP_MASK
#define REP_MASK 0
#endif
#ifndef REP_CNT
#define REP_CNT 1
#endif
#ifndef MK_PER_PHASE
#define MK_PER_PHASE 0
#endif

constexpr int NB = 8, SEQ = 4096, DM = 1024, NTOK = NB * SEQ;
constexpr int NH = 4, HD = 128, DDN = 512, DPOOL = 512, DIN = 2568, NPROJ = 2560;
constexpr int NE = 32, TOPK = 4, DE = 1024, NASSIGN = NTOK * TOPK;
constexpr int LISTCAP = NTOK;
constexpr int ACT_ROWS = NASSIGN + NE * 256;

constexpr size_t MiB = 1u << 20;
constexpr size_t WS_CTL = 0, CTL_ZERO_BYTES = 1 * MiB;
constexpr size_t WS_WIN = 1 * MiB;
constexpr size_t WS_WOUT = 6 * MiB;
constexpr size_t WS_WPOOL = 8 * MiB;
constexpr size_t WS_WR = 8 * MiB + 512 * 1024;
constexpr size_t WS_BGU = 8 * MiB + 768 * 1024;
constexpr size_t WS_RS1 = 9 * MiB;
constexpr size_t WS_BETA = 9 * MiB + 128 * 1024;
constexpr size_t WS_G = 9 * MiB + 640 * 1024;
constexpr size_t WS_RS2 = 10 * MiB + 256 * 1024;
constexpr size_t WS_GATEW = 10 * MiB + 512 * 1024;
constexpr size_t WS_LIST = 11 * MiB;
constexpr size_t WS_RSL = 800 * MiB;
constexpr size_t WS_GWL = 804 * MiB;
constexpr size_t WS_WGU = 16 * MiB;
constexpr size_t WS_WD = 144 * MiB;
constexpr size_t WS_XB = 208 * MiB;
constexpr size_t WS_PROJ = 272 * MiB;
constexpr size_t WS_CHUNK = 432 * MiB;
constexpr size_t WS_UC = 544 * MiB;
constexpr size_t WS_GTOT = 576 * MiB;
constexpr size_t WS_ORAW = 577 * MiB;
constexpr int CH_WF = 0, CH_QD = 16384, CH_KT = 32768, CH_QK = 49152, CH_BYTES = 57344, UC_BYTES = 16384;
constexpr size_t WS_MIXED = 688 * MiB;
constexpr size_t WS_CONCAT = 720 * MiB;
constexpr size_t WS_X1B = 208 * MiB;
constexpr size_t WS_ACT = 272 * MiB;
constexpr size_t WS_SLAB = 544 * MiB;
constexpr size_t WS_X1 = 808 * MiB;
constexpr size_t WS_END = 872 * MiB;
static_assert(WS_ACT + (size_t)ACT_ROWS * 2048 <= WS_SLAB, "act fits");
static_assert(WS_SLAB + (size_t)NASSIGN * 2048 <= WS_END, "slab fits");

constexpr int CW_BAR = 4096;
constexpr int CW_CNT = 16384;
constexpr int CW_SEAM4 = 20480;

constexpr int LDS_BYTES = 163840;
constexpr int LDSCTL_OFF = LDS_BYTES - 1024, MISC_OFF = LDSCTL_OFF + 320, TAB_OFF = LDSCTL_OFF + 512;
constexpr int NWAVES = 8;

#define GAS __attribute__((address_space(1)))
#define LAS __attribute__((address_space(3)))
typedef unsigned short bf16;
typedef unsigned v4u __attribute__((ext_vector_type(4)));
typedef unsigned v2u __attribute__((ext_vector_type(2)));
typedef float f32x4 __attribute__((ext_vector_type(4)));
typedef float f32x2 __attribute__((ext_vector_type(2)));
typedef short bf16x8 __attribute__((ext_vector_type(8)));
typedef GAS unsigned gu32;
#define RLX_AGENT __ATOMIC_RELAXED, __HIP_MEMORY_SCOPE_AGENT
#define LDS_WAIT() asm volatile("s_waitcnt lgkmcnt(0)" ::: "memory")
#define VM_WAIT() asm volatile("s_waitcnt vmcnt(0)" ::: "memory")

__device__ __forceinline__ unsigned f2bf(float f) { unsigned u = __builtin_bit_cast(unsigned, f); return (u + 0x7fffu + ((u >> 16) & 1u)) >> 16; }
__device__ __forceinline__ unsigned pk2(float lo, float hi) { return f2bf(lo) | (f2bf(hi) << 16); }
__device__ __forceinline__ float bflo(unsigned u) { return __builtin_bit_cast(float, u << 16); }
__device__ __forceinline__ float bfhi(unsigned u) { return __builtin_bit_cast(float, u & 0xffff0000u); }
__device__ __forceinline__ unsigned pk4_fp8(float a, float b, float c, float d) { int p = __builtin_amdgcn_cvt_pk_fp8_f32(a, b, 0, false); p = __builtin_amdgcn_cvt_pk_fp8_f32(c, d, p, true); return (unsigned)p; }
typedef float f32x2_t __attribute__((ext_vector_type(2)));
constexpr float SLAB_SCALE = 16.f, SLAB_INV = 1.f / 16.f;
constexpr float W8_SCALE = 32.f, W8_INV = 1.f / 32.f;
__device__ __forceinline__ float wave_sum(float v) {
#pragma unroll
    for (int o = 1; o < 64; o <<= 1) v += __shfl_xor(v, o);
    return v;
}
__device__ __forceinline__ float frcp_(float x) { return __builtin_amdgcn_rcpf(x); }
__device__ __forceinline__ float frsq_(float x) { return __builtin_amdgcn_rsqf(x); }
__device__ __forceinline__ float fexp_(float x) { return __builtin_amdgcn_exp2f(x * 1.4426950408889634f); }
__device__ __forceinline__ float sigmoidf_(float x) { return frcp_(1.f + fexp_(-x)); }
__device__ __forceinline__ float siluf_(float x) { return x * frcp_(1.f + fexp_(-x)); }

namespace pg8 {
constexpr int BM = 256, BK = 64, HALF = 128, HTB = HALF * BK * 2, STAGE_BYTES = 8 * HTB;
constexpr int EPI_TAB_OFF = STAGE_BYTES + 8192 + 4096, EPI_TAB_BYTES = 3072;
__device__ __forceinline__ int lds_byte(int r, int c) { const int st = (r >> 4) * 2 + (c >> 5), rr = r & 15, cc = c & 31, ob = rr * 64 + cc * 2; return st * 1024 + (ob ^ (((ob >> 9) & 1) << 5)); }
__device__ __forceinline__ void stage_rc(int b, int& R, int& C) { const int st = b / 1024, sb = b % 1024, swz = sb ^ (((sb >> 9) & 1) << 5); R = (st >> 1) * 16 + swz / 64; C = (st & 1) * 32 + (swz % 64) / 2; }
__device__ __forceinline__ int perm32(int rho) { const int n = rho >> 4, i = rho & 15; return 8 * (i >> 2) + 4 * n + (i & 3); }
typedef __bf16 bf16x2_t __attribute__((ext_vector_type(2)));
__device__ __forceinline__ unsigned cvt_pk_bf16(float lo, float hi) { const f32x2 v = {lo, hi}; const bf16x2_t b = __builtin_convertvector(v, bf16x2_t); return __builtin_bit_cast(unsigned, b); }

struct Unit { int rt, pn, e, rb, rows; };

struct Sched {
    int nM, nN, nwg, G, c;
    __device__ __forceinline__ void init(int nM_, int nN_, int G_, int c_) { nM = nM_; nN = nN_; nwg = nM * nN; G = G_; c = c_; }
    __device__ __forceinline__ bool next(int i, int& pm, int& pn) const {
        const long L = (long)i * G + c; if (L >= nwg) return false;
        int wgid = (int)L; { const int q = nwg / 8, r = nwg % 8, xcd = wgid % 8, off = wgid / 8; wgid = (xcd < r ? xcd * (q + 1) : r * (q + 1) + (xcd - r) * q) + off; }
        const int nig = 8 * nN, gid = wgid / nig, fm = gid * 8, gsz = (nM - fm) < 8 ? (nM - fm) : 8;
        pm = fm + ((wgid % nig) % gsz); pn = (wgid % nig) / gsz; return true;
    }
};

typedef int v8i_t __attribute__((ext_vector_type(8)));
template <class P, bool F8 = false>
__device__ __forceinline__ void gemm_phase(LAS unsigned char* lds, const P& p) {
    const int tid = threadIdx.x, wid = __builtin_amdgcn_readfirstlane(tid >> 6), lane = tid & 63, wr = wid >> 2, wc = wid & 3, fr = lane & 15, fq = lane >> 4;
    const int K = p.K, RB = F8 ? K : 2 * K, nt = RB / (BK * 2);
    unsigned voffB[2];
#pragma unroll
    for (int i = 0; i < 2; ++i) { int R_, C_; stage_rc(tid * 16 + i * 8192, R_, C_); const int Rb = (R_ & ~31) + perm32(R_ & 31); voffB[i] = (unsigned)(Rb * RB + C_ * 2); }
#define PG8_AOFF(unit, dst) do { int R[2], C[2]; asm volatile("" ::: "memory"); _Pragma("unroll") for (int i_ = 0; i_ < 2; ++i_) stage_rc(tid * 16 + i_ * 8192, R[i_], C[i_]); p.a_off(unit, R, C, dst); } while (0)
    const size_t kstep = (size_t)(BK * 2);
    const size_t hstep = (size_t)HALF * RB;
    const unsigned ldsw = (unsigned)wid * 1024u;
    const int aoff = lds_byte(wr * 64 + fr, fq * 8), boff = lds_byte(wc * 32 + fr, fq * 8);
#define PG8_SA(b, h) (((b) * 2 + (h)) * HTB)
#define PG8_SB(b, h) ((4 + (b) * 2 + (h)) * HTB)
#define PG8_STAGE(bufoff, gbase, voff) do { _Pragma("unroll") for (int _i = 0; _i < 2; ++_i) \
        __builtin_amdgcn_global_load_lds((const unsigned*)((const char*)(gbase) + (voff)[_i]), (LAS unsigned*)(lds + (bufoff) + ldsw + _i * 8192), 16, 0, 0); } while (0)
#define PG8_LDA(dst, b, h) do { _Pragma("unroll") for (int m = 0; m < 4; ++m) { const v4i_t l_ = *(const LAS v4i_t*)(lds + PG8_SA(b, h) + aoff + m * 2048), h_ = *(const LAS v4i_t*)(lds + PG8_SA(b, h) + aoff + m * 2048 + 1024); dst[m] = __builtin_shufflevector(l_, h_, 0, 1, 2, 3, 4, 5, 6, 7); } } while (0)
#define PG8_LDB(dst, b, h) do { _Pragma("unroll") for (int n = 0; n < 2; ++n) { const v4i_t l_ = *(const LAS v4i_t*)(lds + PG8_SB(b, h) + boff + n * 2048), h_ = *(const LAS v4i_t*)(lds + PG8_SB(b, h) + boff + n * 2048 + 1024); dst[n] = __builtin_shufflevector(l_, h_, 0, 1, 2, 3, 4, 5, 6, 7); } } while (0)
#define PG8_HALF(x, k) __builtin_bit_cast(bf16x8, __builtin_shufflevector(x, x, 4 * (k), 4 * (k) + 1, 4 * (k) + 2, 4 * (k) + 3))
#define PG8_MMA(ai, bj, At, Bt) do { __builtin_amdgcn_s_setprio(1); \
        if constexpr (F8) { _Pragma("unroll") for (int m = 0; m < 4; ++m) _Pragma("unroll") for (int n = 0; n < 2; ++n) \
            asm volatile("v_mfma_scale_f32_16x16x128_f8f6f4 %0, %1, %2, %0, %3, %3 op_sel_hi:[0,0,0]" : "+v"(acc[ai][bj][m][n]) : "v"(Bt[n]), "v"(At[m]), "v"(mxs)); } \
        else { _Pragma("unroll") for (int m = 0; m < 4; ++m) _Pragma("unroll") for (int n = 0; n < 2; ++n) { \
            acc[ai][bj][m][n] = __builtin_amdgcn_mfma_f32_16x16x32_bf16(PG8_HALF(Bt[n], 0), PG8_HALF(At[m], 0), acc[ai][bj][m][n], 0, 0, 0); \
            acc[ai][bj][m][n] = __builtin_amdgcn_mfma_f32_16x16x32_bf16(PG8_HALF(Bt[n], 1), PG8_HALF(At[m], 1), acc[ai][bj][m][n], 0, 0, 0); } } \
        __builtin_amdgcn_s_setprio(0); } while (0)
#define PG8_WAIT_V(n) asm volatile("s_waitcnt vmcnt(" #n ")" ::: "memory")
#define PG8_WAIT_L(n) asm volatile("s_waitcnt lgkmcnt(" #n ")" ::: "memory")
#define PG8_BAR __builtin_amdgcn_s_barrier()
#define PG8_SCHED __builtin_amdgcn_sched_barrier(0)
    Unit cur, nxt; int ui = 0;
    if (!p.next(0, cur)) return;
    unsigned mxs = 0x7f7f7f7fu; asm volatile("" : "+v"(mxs));
    f32x4 acc[2][2][4][2];
#pragma unroll
    for (int a = 0; a < 2; ++a)
#pragma unroll
        for (int b = 0; b < 2; ++b)
#pragma unroll
            for (int m = 0; m < 4; ++m)
#pragma unroll
                for (int n = 0; n < 2; ++n) acc[a][b][m][n] = (f32x4){0.f, 0.f, 0.f, 0.f};
    typedef int v4i_t __attribute__((ext_vector_type(4)));
    v8i_t At[4], B0[2], B1[2];
    unsigned oA[2][2];
    PG8_AOFF(cur, oA);
    const char* cA = p.a_base(cur); const char* cB = p.b_base(cur);
    PG8_STAGE(PG8_SB(0, 0), cB, voffB); PG8_STAGE(PG8_SB(0, 1), cB + hstep, voffB); PG8_STAGE(PG8_SA(0, 0), cA, oA[0]); PG8_STAGE(PG8_SA(0, 1), cA, oA[1]);
    if (wr == 1) PG8_BAR;
    PG8_WAIT_V(2); PG8_BAR;
    PG8_STAGE(PG8_SB(1, 0), cB + kstep, voffB); PG8_STAGE(PG8_SA(1, 0), cA + kstep, oA[0]); PG8_STAGE(PG8_SB(1, 1), cB + hstep + kstep, voffB);
    PG8_WAIT_V(6); PG8_BAR;
    LAS v4u* park = (LAS v4u*)(lds + STAGE_BYTES) + tid;
#define PG8_AIDX(unit, ent) do { int R[2], C[2]; asm volatile("" ::: "memory"); _Pragma("unroll") for (int i_ = 0; i_ < 2; ++i_) stage_rc(tid * 16 + i_ * 8192, R[i_], C[i_]); p.a_idx(unit, R, ent); } while (0)
#define PG8_AFIN(unit, ent, dst) do { int R[2], C[2]; asm volatile("" ::: "memory"); _Pragma("unroll") for (int i_ = 0; i_ < 2; ++i_) stage_rc(tid * 16 + i_ * 8192, R[i_], C[i_]); p.a_fin(unit, R, C, ent, dst); } while (0)
    Unit nn; int ent[2][2]; int ev[3];
    LAS unsigned char* etab = lds + EPI_TAB_OFF;
    p.e_idx(cur, tid, ev);
    bool has_next = p.next(1, nxt);
    if (has_next) PG8_AIDX(nxt, ent); else ent[0][0] = ent[0][1] = ent[1][0] = ent[1][1] = 0;
    for (;;) {
        const char* nA = cA; const char* nB = cB;
        p.e_put(etab + (ui & 1) * EPI_TAB_BYTES, tid, ev);
        { unsigned nO[2][2];
#pragma unroll
          for (int h = 0; h < 2; ++h)
#pragma unroll
              for (int i = 0; i < 2; ++i) nO[h][i] = oA[h][i];
          if (has_next) { nA = p.a_base(nxt); nB = p.b_base(nxt); PG8_AFIN(nxt, ent, nO); }
          *park = (v4u){nO[0][0], nO[0][1], nO[1][0], nO[1][1]}; }
        for (int t = 0; t < nt; t += 2) {
            const bool last = (t == nt - 2);
            const char* a1 = cA + (size_t)(t + 1) * kstep;
            const char* a2 = last ? nA : cA + (size_t)(t + 2) * kstep; const char* b2 = last ? nB : cB + (size_t)(t + 2) * kstep;
            const char* a3 = a2 + kstep; const char* b3 = b2 + kstep;
            unsigned o2[2][2];
#pragma unroll
            for (int h = 0; h < 2; ++h)
#pragma unroll
                for (int i = 0; i < 2; ++i) o2[h][i] = oA[h][i];
            if (last) { const v4u q_ = *park; o2[0][0] = q_.x; o2[0][1] = q_.y; o2[1][0] = q_.z; o2[1][1] = q_.w; }
            PG8_LDB(B0, 0, 0); PG8_LDB(B1, 0, 1); PG8_SCHED; PG8_LDA(At, 0, 0); PG8_STAGE(PG8_SA(1, 1), a1, oA[1]);
            PG8_WAIT_V(8); PG8_WAIT_L(0); PG8_BAR; PG8_MMA(0, 0, At, B0); PG8_MMA(0, 1, At, B1); PG8_BAR; PG8_SCHED;
            PG8_LDA(At, 0, 1); PG8_STAGE(PG8_SB(0, 0), b2, voffB); PG8_STAGE(PG8_SB(0, 1), b2 + hstep, voffB); PG8_STAGE(PG8_SA(0, 0), a2, o2[0]);
            PG8_WAIT_V(8); PG8_WAIT_L(0); PG8_BAR; PG8_MMA(1, 0, At, B0); PG8_MMA(1, 1, At, B1); PG8_BAR; PG8_SCHED;
            PG8_LDB(B0, 1, 0); PG8_LDB(B1, 1, 1); PG8_SCHED; PG8_LDA(At, 1, 0); PG8_STAGE(PG8_SA(0, 1), a2, o2[1]);
            PG8_WAIT_V(8); PG8_WAIT_L(0); PG8_BAR; PG8_MMA(0, 0, At, B0); PG8_MMA(0, 1, At, B1); PG8_BAR; PG8_SCHED;
            PG8_LDA(At, 1, 1); PG8_STAGE(PG8_SB(1, 0), b3, voffB); PG8_STAGE(PG8_SB(1, 1), b3 + hstep, voffB); PG8_STAGE(PG8_SA(1, 0), a3, o2[0]);
            PG8_WAIT_V(8); PG8_WAIT_L(0); PG8_BAR; PG8_MMA(1, 0, At, B0); PG8_MMA(1, 1, At, B1); PG8_BAR; PG8_SCHED;
        }
        const bool has_nn = has_next && p.next(ui + 2, nn);
        if (has_nn) PG8_AIDX(nn, ent);
        if (has_next) p.e_idx(nxt, tid, ev);
        if (wr == 0) PG8_BAR;
        if constexpr (F8) asm volatile("s_nop 15\n\ts_nop 15" ::: "memory");
        p.epi(acc, cur, wr, wc, fr, fq, etab + (ui & 1) * EPI_TAB_BYTES);
        if (!has_next) break;
#pragma unroll
        for (int a = 0; a < 2; ++a)
#pragma unroll
            for (int b = 0; b < 2; ++b)
#pragma unroll
                for (int m = 0; m < 4; ++m)
#pragma unroll
                    for (int n = 0; n < 2; ++n) acc[a][b][m][n] = (f32x4){0.f, 0.f, 0.f, 0.f};
        cur = nxt; nxt = nn; has_next = has_nn; cA = nA; cB = nB; ++ui;
        { const v4u q_ = *park; oA[0][0] = q_.x; oA[0][1] = q_.y; oA[1][0] = q_.z; oA[1][1] = q_.w; }
        if (wr == 1) PG8_BAR;
    }
    PG8_WAIT_V(0);
    PG8_BAR;
#undef PG8_SA
#undef PG8_SB
#undef PG8_STAGE
#undef PG8_LDA
#undef PG8_LDB
#undef PG8_MMA
#undef PG8_HALF
#undef PG8_AOFF
#undef PG8_AIDX
#undef PG8_AFIN
#undef PG8_WAIT_V
#undef PG8_WAIT_L
#undef PG8_BAR
#undef PG8_SCHED
}
}

#define XB_TMO      128
#define XB_XCNT(j)  (256  + 64 * (j))
#define XB_XSUB(j)  (1280 + 64 * (j))
#define XB_XGEN(j)  (2304 + 64 * (j))
#define XB_TOP      3328
#define XB_TOPGEN   3392
#define XCD_BAR_WORDS 3456
#define XB_SPIN_CAP (1u << 18)
__device__ __forceinline__ unsigned xb_ld(unsigned* p)              { return __hip_atomic_load(p, __ATOMIC_RELAXED, __HIP_MEMORY_SCOPE_AGENT); }
__device__ __forceinline__ unsigned xb_add(unsigned* p, unsigned v) { return __hip_atomic_fetch_add(p, v, __ATOMIC_RELAXED, __HIP_MEMORY_SCOPE_AGENT); }
__device__ __forceinline__ unsigned xb_xcc_id() { return (unsigned)__builtin_amdgcn_s_getreg((3 << 11) | 20) & 0xFu; }
#define XB_SPIN(cond, bar) do { unsigned _sp = 0; while (cond) { __builtin_amdgcn_s_sleep(1); \
    if ((++_sp & 255u) == 0u) { if (xb_ld(&(bar)[XB_TMO])) break; if (_sp > XB_SPIN_CAP) { atomicAdd(&(bar)[XB_TMO], 1u); break; } } } } while (0)
struct XcdBarrier { unsigned* bar; unsigned x; volatile LAS unsigned* st; };
__device__ __forceinline__ XcdBarrier xcd_barrier_post(unsigned* bar, volatile LAS unsigned* st) {
    XcdBarrier b; b.bar = bar; b.x = xb_xcc_id(); b.st = st;
    if (threadIdx.x == 0) (void)xb_add(&bar[XB_XCNT(b.x)], 1u);
    return b;
}
__device__ __forceinline__ void xcd_barrier_complete(unsigned* bar, unsigned x, unsigned& nloc, unsigned& nx) {
    const unsigned G = gridDim.x * gridDim.y * gridDim.z;
    unsigned sum, cnt, mine, sp = 0u;
    for (;;) {
        sum = 0u; cnt = 0u; mine = 0u;
#pragma unroll
        for (unsigned j = 0; j < 16; ++j) { const unsigned c = xb_ld(&bar[XB_XCNT(j)]); sum += c; cnt += (c > 0u) ? 1u : 0u; mine = (j == x) ? c : mine; }
        if (sum == G) break;
        __builtin_amdgcn_s_sleep(1);
        if ((++sp & 255u) == 0u) { if (xb_ld(&bar[XB_TMO])) break; if (sp > XB_SPIN_CAP) { atomicAdd(&bar[XB_TMO], 1u); break; } }
    }
    nloc = mine > 0u ? mine : 1u; nx = cnt > 0u ? cnt : 1u;
}
__device__ __forceinline__ void xcd_barrier(const XcdBarrier& b) {
    asm volatile("s_waitcnt vmcnt(0)" ::: "memory");
    __syncthreads();
    if (threadIdx.x == 0) {
        unsigned* bar = b.bar;
        __builtin_amdgcn_s_waitcnt(0);
        unsigned nloc = b.st[0], nx = b.st[1];
        if (nloc == 0u) { xcd_barrier_complete(bar, b.x, nloc, nx); b.st[0] = nloc; b.st[1] = nx; }
        const unsigned old = xb_add(&bar[XB_XSUB(b.x)], 1u);
        const unsigned gen = old / nloc;
        if (old + 1u == (gen + 1u) * nloc) {
            __builtin_amdgcn_fence(__ATOMIC_RELEASE, "agent");
            asm volatile("s_waitcnt vmcnt(0)" ::: "memory");
            const unsigned og = xb_add(&bar[XB_TOP], 1u);
            const unsigned tg = og / nx;
            if (og + 1u == (tg + 1u) * nx) xb_add(&bar[XB_TOPGEN], 1u);
            else XB_SPIN(xb_ld(&bar[XB_TOPGEN]) == tg, bar);
            __builtin_amdgcn_fence(__ATOMIC_ACQUIRE, "agent");
            xb_add(&bar[XB_XGEN(b.x)], 1u);
            asm volatile("s_waitcnt vmcnt(0)" ::: "memory");
        } else {
            XB_SPIN(xb_ld(&bar[XB_XGEN(b.x)]) == gen, bar);
            __builtin_amdgcn_fence(__ATOMIC_ACQUIRE, "agent");
            asm volatile("s_waitcnt vmcnt(0)" ::: "memory");
        }
    }
    __syncthreads();
}

struct Frame {
    LAS unsigned char* lds;
    int tid, lane, wave, vcu, G;
    const float* in[18];
    float* out;
    unsigned char* ws;
};
using pg8::Unit;
using pg8::cvt_pk_bf16;

struct ProbBase {
    int K; int RB; pg8::Sched S;
    __device__ __forceinline__ void e_idx(const Unit&, int, int (&ev)[3]) const { ev[0] = ev[1] = ev[2] = 0; }
    __device__ __forceinline__ void e_put(LAS unsigned char*, int, const int (&)[3]) const {}
    __device__ __forceinline__ void a_idx(const Unit&, const int (&)[2], int (&ent)[2][2]) const { ent[0][0] = ent[0][1] = ent[1][0] = ent[1][1] = 0; }
    __device__ __forceinline__ void a_fin(const Unit&, const int (&R)[2], const int (&C)[2], const int (&)[2][2], unsigned (&off)[2][2]) const { lin_off(R, C, off); }
    __device__ __forceinline__ void lin_off(const int (&R)[2], const int (&C)[2], unsigned (&off)[2][2]) const {
#pragma unroll
        for (int h = 0; h < 2; ++h)
#pragma unroll
            for (int i = 0; i < 2; ++i) off[h][i] = (unsigned)((h * 128 + R[i]) * RB + C[i] * 2);
    }
};
struct ProbIn : ProbBase {
    const bf16* A; const bf16* Bt; bf16* O; const float* rs;
    __device__ __forceinline__ bool next(int i, Unit& u) const { int pm, pn; if (!S.next(i, pm, pn)) return false; u.rt = pm; u.pn = pn; u.e = 0; u.rb = pm; u.rows = 256; return true; }
    __device__ __forceinline__ const char* a_base(const Unit& u) const { return (const char*)A + (size_t)u.rt * 256 * RB; }
    __device__ __forceinline__ const char* b_base(const Unit& u) const { return (const char*)Bt + (size_t)u.pn * 256 * RB; }
    __device__ __forceinline__ void a_off(const Unit&, const int (&R)[2], const int (&C)[2], unsigned (&off)[2][2]) const { lin_off(R, C, off); }
    __device__ __forceinline__ void e_idx(const Unit& u, int tid, int (&ev)[3]) const { ev[0] = (tid < 256) ? __float_as_int(rs[u.rt * 256 + tid]) : 0; ev[1] = ev[2] = 0; }
    __device__ __forceinline__ void e_put(LAS unsigned char* et, int tid, const int (&ev)[3]) const { if (tid < 256) *(LAS int*)(et + tid * 8) = ev[0]; }
    __device__ __forceinline__ void epi(const f32x4 (&acc)[2][2][4][2], const Unit& u, int wr, int wc, int fr, int fq, const LAS unsigned char* et) const {
        const int row0 = u.rt * 256 + wr * 64 + fr, col0 = u.pn * 256 + wc * 32 + 8 * fq;
#pragma unroll
        for (int ai = 0; ai < 2; ++ai)
#pragma unroll
            for (int m = 0; m < 4; ++m) { const int row = row0 + ai * 128 + m * 16; const float sc = *(const LAS float*)(et + (ai * 128 + wr * 64 + m * 16 + fr) * 8); bf16* rowp = O + (size_t)row * NPROJ + col0;
#pragma unroll
                for (int bj = 0; bj < 2; ++bj) { const f32x4 v0 = acc[ai][bj][m][0] * sc, v1 = acc[ai][bj][m][1] * sc; v4u w;
                    w.x = cvt_pk_bf16(v0[0], v0[1]); w.y = cvt_pk_bf16(v0[2], v0[3]); w.z = cvt_pk_bf16(v1[0], v1[1]); w.w = cvt_pk_bf16(v1[2], v1[3]);
                    *(v4u*)(rowp + bj * 128) = w; } }
    }
};
struct ProbPool : ProbBase {
    const bf16* A; const bf16* Bt; bf16* O;
    __device__ __forceinline__ bool next(int i, Unit& u) const { int pm, pn; if (!S.next(i, pm, pn)) return false; u.rt = pm; u.pn = pn; u.e = 0; u.rb = pm; u.rows = 256; return true; }
    __device__ __forceinline__ const char* a_base(const Unit& u) const { return (const char*)A + (size_t)u.rt * 256 * RB; }
    __device__ __forceinline__ const char* b_base(const Unit& u) const { return (const char*)Bt + (size_t)u.pn * 256 * RB; }
    __device__ __forceinline__ void a_off(const Unit&, const int (&R)[2], const int (&C)[2], unsigned (&off)[2][2]) const { lin_off(R, C, off); }
    __device__ __forceinline__ void epi(const f32x4 (&acc)[2][2][4][2], const Unit& u, int wr, int wc, int fr, int fq, const LAS unsigned char* et) const {
        const int row0 = u.rt * 256 + wr * 64 + fr, col0 = 512 + u.pn * 256 + wc * 32 + 8 * fq;
#pragma unroll
        for (int ai = 0; ai < 2; ++ai)
#pragma unroll
            for (int m = 0; m < 4; ++m) { const int row = row0 + ai * 128 + m * 16; bf16* rowp = O + (size_t)row * DM + col0;
#pragma unroll
                for (int bj = 0; bj < 2; ++bj) { const f32x4 v0 = acc[ai][bj][m][0], v1 = acc[ai][bj][m][1]; v4u w;
                    w.x = cvt_pk_bf16(v0[0], v0[1]); w.y = cvt_pk_bf16(v0[2], v0[3]); w.z = cvt_pk_bf16(v1[0], v1[1]); w.w = cvt_pk_bf16(v1[2], v1[3]);
                    *(v4u*)(rowp + bj * 128) = w; } }
    }
};
struct ProbOut : ProbBase {
    const bf16* A; const bf16* Bt; const bf16* X; bf16* O;
    __device__ __forceinline__ bool next(int i, Unit& u) const { int pm, pn; if (!S.next(i, pm, pn)) return false; u.rt = pm; u.pn = pn; u.e = 0; u.rb = pm; u.rows = 256; return true; }
    __device__ __forceinline__ const char* a_base(const Unit& u) const { return (const char*)A + (size_t)u.rt * 256 * RB; }
    __device__ __forceinline__ const char* b_base(const Unit& u) const { return (const char*)Bt + (size_t)u.pn * 256 * RB; }
    __device__ __forceinline__ void a_off(const Unit&, const int (&R)[2], const int (&C)[2], unsigned (&off)[2][2]) const { lin_off(R, C, off); }
    __device__ __forceinline__ void epi(const f32x4 (&acc)[2][2][4][2], const Unit& u, int wr, int wc, int fr, int fq, const LAS unsigned char* et) const {
        const int row0 = u.rt * 256 + wr * 64 + fr, col0 = u.pn * 256 + wc * 32 + 8 * fq;
#pragma unroll
        for (int ai = 0; ai < 2; ++ai)
#pragma unroll
            for (int m = 0; m < 4; ++m) { const size_t off = (size_t)(row0 + ai * 128 + m * 16) * DM + col0;
#pragma unroll
                for (int bj = 0; bj < 2; ++bj) { const v4u xv = *(const v4u*)(X + off + bj * 128); const f32x4 a = acc[ai][bj][m][0], b = acc[ai][bj][m][1];
                    *(v4u*)(O + off + bj * 128) = (v4u){cvt_pk_bf16(bflo(xv.x) + a.x, bfhi(xv.x) + a.y), cvt_pk_bf16(bflo(xv.y) + a.z, bfhi(xv.y) + a.w),
                                                        cvt_pk_bf16(bflo(xv.z) + b.x, bfhi(xv.z) + b.y), cvt_pk_bf16(bflo(xv.w) + b.z, bfhi(xv.w) + b.w)}; } }
    }
};
struct MoeTab { const LAS int* pref; const LAS int* cnt; const LAS int* tile; };
__device__ __forceinline__ void moe_decode(const MoeTab& T, int rt, Unit& u) {
    const int w = T.tile[rt];
    u.e = w >> 24; u.rb = (w >> 12) & 0xfff; u.rows = w & 0xfff;
}
struct ProbGU : ProbBase {
    MoeTab T; const unsigned char* A; const unsigned char* Bt; unsigned char* O; const int* list; const float* rs2; const float* bgu;
    __device__ __forceinline__ bool next(int i, Unit& u) const { int pm, pn; if (!S.next(i, pm, pn)) return false; u.rt = pm; u.pn = pn; moe_decode(T, pm, u); return true; }
    __device__ __forceinline__ const char* a_base(const Unit&) const { return (const char*)A; }
    __device__ __forceinline__ const char* b_base(const Unit& u) const { return (const char*)Bt + ((size_t)u.e * 2048 + (size_t)u.pn * 256) * RB; }
    __device__ __forceinline__ void a_off(const Unit& u, const int (&R)[2], const int (&C)[2], unsigned (&off)[2][2]) const { int ent[2][2]; a_idx(u, R, ent); a_fin(u, R, C, ent, off); }
    __device__ __forceinline__ void e_idx(const Unit& u, int tid, int (&ev)[3]) const {
        if (tid < 256) { ev[0] = __float_as_int(rs2[(size_t)u.e * LISTCAP + u.rb * 256 + tid]); ev[1] = __float_as_int(bgu[(size_t)u.e * 2048 + u.pn * 256 + tid]); } else { ev[0] = ev[1] = 0; } ev[2] = 0; }
    __device__ __forceinline__ void e_put(LAS unsigned char* et, int tid, const int (&ev)[3]) const { if (tid < 256) { *(LAS int*)(et + tid * 8) = ev[0]; *(LAS int*)(et + 2048 + tid * 4) = ev[1]; } }
    __device__ __forceinline__ void a_idx(const Unit& u, const int (&R)[2], int (&ent)[2][2]) const {
        const int* lp = list + (size_t)u.e * LISTCAP + u.rb * 256;
#pragma unroll
        for (int h = 0; h < 2; ++h)
#pragma unroll
            for (int i = 0; i < 2; ++i) { const int r = h * 128 + R[i]; ent[h][i] = (r < u.rows) ? lp[r] : 0; }
    }
    __device__ __forceinline__ void a_fin(const Unit&, const int (&)[2], const int (&C)[2], const int (&ent)[2][2], unsigned (&off)[2][2]) const {
#pragma unroll
        for (int h = 0; h < 2; ++h)
#pragma unroll
            for (int i = 0; i < 2; ++i) off[h][i] = (unsigned)(ent[h][i] >> 2) * (unsigned)RB + (unsigned)C[i] * 2u;
    }
    __device__ __forceinline__ void epi(const f32x4 (&acc)[2][2][4][2], const Unit& u, int wr, int wc, int fr, int fq, const LAS unsigned char* et) const {
        const int j0 = wc * 32 + 8 * fq;
        const LAS float* bg = (const LAS float*)(et + 2048) + j0;
        f32x4 bgv[2], buv[2];
#pragma unroll
        for (int n = 0; n < 2; ++n) { bgv[n] = *(const LAS f32x4*)(bg + 4 * n); buv[n] = *(const LAS f32x4*)(bg + 128 + 4 * n); }
#pragma unroll
        for (int ai = 0; ai < 2; ++ai)
#pragma unroll
            for (int m = 0; m < 4; ++m) { const int r = ai * 128 + wr * 64 + m * 16 + fr;
                if (r < u.rows) { const float sc = *(const LAS float*)(et + r * 8) * W8_INV; const f32x2_t sc2 = (f32x2_t){sc, sc}; unsigned w[2];
#pragma unroll
                    for (int n = 0; n < 2; ++n) { f32x2_t a2[2];
#pragma unroll
                        for (int qp = 0; qp < 2; ++qp) {
                            f32x2_t gt = (f32x2_t){acc[ai][0][m][n][2 * qp], acc[ai][0][m][n][2 * qp + 1]} * sc2 + (f32x2_t){bgv[n][2 * qp], bgv[n][2 * qp + 1]};
                            f32x2_t up = (f32x2_t){acc[ai][1][m][n][2 * qp], acc[ai][1][m][n][2 * qp + 1]} * sc2 + (f32x2_t){buv[n][2 * qp], buv[n][2 * qp + 1]};
                            gt.x = fminf(gt.x, 7.f); gt.y = fminf(gt.y, 7.f); up.x = fminf(fmaxf(up.x, -7.f), 7.f); up.y = fminf(fmaxf(up.y, -7.f), 7.f);
                            const f32x2_t ex = gt * (f32x2_t){-1.702f * 1.4426950408889634f, -1.702f * 1.4426950408889634f};
                            const f32x2_t dn = (f32x2_t){__builtin_amdgcn_exp2f(ex.x), __builtin_amdgcn_exp2f(ex.y)} + (f32x2_t){1.f, 1.f};
                            a2[qp] = (up + (f32x2_t){1.f, 1.f}) * gt * (f32x2_t){frcp_(dn.x), frcp_(dn.y)}; }
                        w[n] = pk4_fp8(a2[0].x, a2[0].y, a2[1].x, a2[1].y); }
                    *(v2u*)(O + (size_t)(u.rt * 256 + r) * DE + u.pn * 128 + j0) = (v2u){w[0], w[1]}; } }
    }
};
struct ProbDown : ProbBase {
    MoeTab T; const unsigned char* A; const unsigned char* Bt; unsigned char* O; const int* list; const float* gw; const float* bd;
    __device__ __forceinline__ bool next(int i, Unit& u) const { int pm, pn; if (!S.next(i, pm, pn)) return false; u.rt = pm; u.pn = pn; moe_decode(T, pm, u); return true; }
    __device__ __forceinline__ const char* a_base(const Unit& u) const { return (const char*)A + (size_t)u.rt * 256 * RB; }
    __device__ __forceinline__ const char* b_base(const Unit& u) const { return (const char*)Bt + ((size_t)u.e * 1024 + (size_t)u.pn * 256) * RB; }
    __device__ __forceinline__ void a_off(const Unit&, const int (&R)[2], const int (&C)[2], unsigned (&off)[2][2]) const { lin_off(R, C, off); }
    __device__ __forceinline__ void e_idx(const Unit& u, int tid, int (&ev)[3]) const {
        if (tid < 256) { const size_t pos = (size_t)u.e * LISTCAP + u.rb * 256 + tid; ev[0] = list[pos]; ev[1] = __float_as_int(gw[pos]); ev[2] = __float_as_int(bd[(size_t)u.e * DM + u.pn * 256 + tid]); } else { ev[0] = ev[1] = ev[2] = 0; } }
    __device__ __forceinline__ void e_put(LAS unsigned char* et, int tid, const int (&ev)[3]) const { if (tid < 256) { *(LAS v2u*)(et + tid * 8) = (v2u){(unsigned)ev[0], (unsigned)ev[1]}; *(LAS int*)(et + 2048 + tid * 4) = ev[2]; } }
    __device__ __forceinline__ void epi(const f32x4 (&acc)[2][2][4][2], const Unit& u, int wr, int wc, int fr, int fq, const LAS unsigned char* et) const {
        const int c0 = u.pn * 256 + wc * 32 + 8 * fq;
        const LAS float* bp = (const LAS float*)(et + 2048) + wc * 32 + 8 * fq;
        f32x4 bv[2][2];
#pragma unroll
        for (int bj = 0; bj < 2; ++bj)
#pragma unroll
            for (int n = 0; n < 2; ++n) bv[bj][n] = *(const LAS f32x4*)(bp + bj * 128 + 4 * n);
#pragma unroll
        for (int ai = 0; ai < 2; ++ai)
#pragma unroll
            for (int m = 0; m < 4; ++m) { const int r = ai * 128 + wr * 64 + m * 16 + fr;
                if (r < u.rows) { const v2u eg = *(const LAS v2u*)(et + r * 8); const int ent = (int)eg.x; const float g = __uint_as_float(eg.y); unsigned char* rowp = O + (size_t)ent * DM + c0;
#pragma unroll
                    for (int bj = 0; bj < 2; ++bj) { const f32x4 v0 = (acc[ai][bj][m][0] * W8_INV + bv[bj][0]) * g, v1 = (acc[ai][bj][m][1] * W8_INV + bv[bj][1]) * g;
                        *(v2u*)(rowp + bj * 128) = (v2u){pk4_fp8(v0[0] * SLAB_SCALE, v0[1] * SLAB_SCALE, v0[2] * SLAB_SCALE, v0[3] * SLAB_SCALE), pk4_fp8(v1[0] * SLAB_SCALE, v1[1] * SLAB_SCALE, v1[2] * SLAB_SCALE, v1[3] * SLAB_SCALE)}; } } }
    }
};

typedef short v4i16_t __attribute__((ext_vector_type(4)));
__device__ __forceinline__ void tr_item(const float* W, int ldw, int k0, int nsrc0, bf16* WT, size_t drow0, int ldk, int dk0, const float* ks, const float* ns, LAS unsigned char* scr, int lane) {
    const int kr = lane >> 4, n4 = (lane & 15) * 4;
    f32x4 nsc = (f32x4){1.f, 1.f, 1.f, 1.f}; if (ns) nsc = *(const f32x4*)(ns + nsrc0 + n4);
    f32x4 v[16];
#pragma unroll
    for (int i = 0; i < 16; ++i) v[i] = *(const f32x4*)(W + (size_t)(k0 + 4 * i + kr) * ldw + nsrc0 + n4);
#pragma unroll
    for (int i = 0; i < 16; ++i) { f32x4 x = v[i] * nsc; if (ks) x = x * ks[k0 + 4 * i + kr];
        *(LAS v2u*)(scr + (4 * i + kr) * 192 + n4 * 2) = (v2u){pg8::cvt_pk_bf16(x.x, x.y), pg8::cvt_pk_bf16(x.z, x.w)}; }
    LDS_WAIT(); asm volatile("" ::: "memory");
    const int G = lane >> 4, li = lane & 15, q = li >> 2, p = li & 3;
    const LAS unsigned char* rb = scr + q * 192 + (16 * G + 4 * p) * 2;
    bf16* dst = WT + (drow0 + 16 * G + li) * (size_t)ldk + dk0 + k0;
#pragma unroll
    for (int kc = 0; kc < 8; ++kc) {
        const v4i16_t lo = __builtin_amdgcn_ds_read_tr16_b64_v4i16((LAS v4i16_t*)(rb + (8 * kc) * 192));
        const v4i16_t hi = __builtin_amdgcn_ds_read_tr16_b64_v4i16((LAS v4i16_t*)(rb + (8 * kc + 4) * 192));
        const v2u l2 = __builtin_bit_cast(v2u, lo), h2 = __builtin_bit_cast(v2u, hi);
        *(v4u*)(dst + 8 * kc) = (v4u){l2.x, l2.y, h2.x, h2.y};
    }
    LDS_WAIT(); asm volatile("" ::: "memory");
}

template <int KT, int NT>
__device__ __forceinline__ void tr_item8(const float* W, int ldw, int k0, int nsrc0, unsigned char* WT, size_t drow0, int ldk, const float* ks, float mul, LAS unsigned char* scr, int lane) {
    constexpr int LPR = NT / 4, RPL = 64 / LPR, PA = NT * 2 + 64;
    static_assert(KT * NT == 4096 && (PA / 4) % 32 == 16, "tile geometry");
    const int kr = lane / LPR, n4 = (lane % LPR) * 4;
    f32x4 v[16];
#pragma unroll
    for (int i = 0; i < 16; ++i) v[i] = *(const f32x4*)(W + (size_t)(k0 + RPL * i + kr) * ldw + nsrc0 + n4);
#pragma unroll
    for (int i = 0; i < 16; ++i) { const float sc = ks ? ks[k0 + RPL * i + kr] * mul : mul; const f32x4 x = v[i] * sc;
        *(LAS v2u*)(scr + (RPL * i + kr) * PA + n4 * 2) = (v2u){pg8::cvt_pk_bf16(x.x, x.y), pg8::cvt_pk_bf16(x.z, x.w)}; }
    LDS_WAIT(); asm volatile("" ::: "memory");
    const int G = lane >> 4, li = lane & 15, q = li >> 2, p = li & 3;
#pragma unroll
    for (int ps = 0; ps < NT / 64; ++ps) {
        const LAS unsigned char* rb = scr + q * PA + (16 * (G + 4 * ps) + 4 * p) * 2;
        unsigned char* dst = WT + (drow0 + 16 * (G + 4 * ps) + li) * (size_t)ldk + k0;
#pragma unroll
        for (int kq = 0; kq < KT / 16; ++kq) {
            v2u t[4];
#pragma unroll
            for (int u = 0; u < 4; ++u) t[u] = __builtin_bit_cast(v2u, __builtin_amdgcn_ds_read_tr16_b64_v4i16((LAS v4i16_t*)(rb + (16 * kq + 4 * u) * PA)));
            v4u o;
            o.x = pk4_fp8(bflo(t[0].x), bfhi(t[0].x), bflo(t[0].y), bfhi(t[0].y)); o.y = pk4_fp8(bflo(t[1].x), bfhi(t[1].x), bflo(t[1].y), bfhi(t[1].y));
            o.z = pk4_fp8(bflo(t[2].x), bfhi(t[2].x), bflo(t[2].y), bfhi(t[2].y)); o.w = pk4_fp8(bflo(t[3].x), bfhi(t[3].x), bflo(t[3].y), bfhi(t[3].y));
            *(v4u*)(dst + 16 * kq) = o;
        }
    }
    LDS_WAIT(); asm volatile("" ::: "memory");
}

constexpr int TRF_T1 = 128 * 192, TRF_T2 = 64 * 144, TRF_BYTES = TRF_T1 + TRF_T2;
__device__ __forceinline__ void tr_item8f(const float* W, int ldw, int k0, int nsrc0, unsigned char* WT, size_t drow0, int ldk, const float* ks, float mul, LAS unsigned char* scr, int lane) {
    const int kr = lane >> 4, n4 = (lane & 15) * 4;
#pragma unroll
    for (int hb = 0; hb < 2; ++hb) {
        f32x4 v[16];
#pragma unroll
        for (int i = 0; i < 16; ++i) v[i] = __builtin_nontemporal_load((const f32x4*)(W + (size_t)(k0 + 64 * hb + 4 * i + kr) * ldw + nsrc0 + n4));
#pragma unroll
        for (int i = 0; i < 16; ++i) { const float sc = ks ? ks[k0 + 64 * hb + 4 * i + kr] * mul : mul; const f32x4 x = v[i] * sc;
            *(LAS v2u*)(scr + (64 * hb + 4 * i + kr) * 192 + n4 * 2) = (v2u){pg8::cvt_pk_bf16(x.x, x.y), pg8::cvt_pk_bf16(x.z, x.w)}; }
    }
    LDS_WAIT(); asm volatile("" ::: "memory");
    const int G = lane >> 4, li = lane & 15, q = li >> 2, p = li & 3;
    const LAS unsigned char* rb = scr + q * 192 + (16 * G + 4 * p) * 2;
    LAS unsigned char* t2 = scr + TRF_T1;
#pragma unroll
    for (int kq = 0; kq < 8; ++kq) {
        v2u t[4];
#pragma unroll
        for (int u = 0; u < 4; ++u) t[u] = __builtin_bit_cast(v2u, __builtin_amdgcn_ds_read_tr16_b64_v4i16((LAS v4i16_t*)(rb + (16 * kq + 4 * u) * 192)));
        v4u o;
        o.x = pk4_fp8(bflo(t[0].x), bfhi(t[0].x), bflo(t[0].y), bfhi(t[0].y)); o.y = pk4_fp8(bflo(t[1].x), bfhi(t[1].x), bflo(t[1].y), bfhi(t[1].y));
        o.z = pk4_fp8(bflo(t[2].x), bfhi(t[2].x), bflo(t[2].y), bfhi(t[2].y)); o.w = pk4_fp8(bflo(t[3].x), bfhi(t[3].x), bflo(t[3].y), bfhi(t[3].y));
        *(LAS v4u*)(t2 + (16 * G + li) * 144 + 16 * kq) = o;
    }
    LDS_WAIT(); asm volatile("" ::: "memory");
    const int r8 = lane >> 3, c8 = lane & 7;
#pragma unroll
    for (int j = 0; j < 8; ++j) { const v4u o = *(const LAS v4u*)(t2 + (8 * j + r8) * 144 + 16 * c8);
        *(v4u*)(WT + (drow0 + 8 * j + r8) * (size_t)ldk + k0 + 16 * c8) = o; }
    LDS_WAIT(); asm volatile("" ::: "memory");
}

constexpr int TRK = 128, TRN = 64;
constexpr int MOE_PREP_ITEMS = 32 * (1024 / TRK) * (2048 / TRN) + 32 * (1024 / TRK) * (1024 / TRN);
__device__ __forceinline__ void moe_weight_prep(Frame& F, int b0, int lo, int hi) {
    const float* fnw = F.in[10]; const float* w_gu = F.in[13]; const float* w_d = F.in[15];
    unsigned char* WguT = F.ws + WS_WGU; unsigned char* WdT = F.ws + WS_WD;
    constexpr int TW = 4;
    if (F.wave >= TW) return;
    LAS unsigned char* scr = F.lds + F.wave * TRF_BYTES;
    const int gw = ((int)blockIdx.x - b0) * TW + F.wave, NGW = (F.G - b0) * TW;
    constexpr int NKB = 1024 / TRK, NNB_GU = 2048 / TRN, NNB_D = 1024 / TRN, SEGN = 128 / TRN;
    constexpr int I_GU = 32 * NKB * NNB_GU;
    for (int it = lo + gw; it < hi; it += NGW) {
        int r = it;
        if (r < I_GU) { const int e = r / (NKB * NNB_GU), r2 = r % (NKB * NNB_GU), kb = r2 / NNB_GU, cb = r2 % NNB_GU;
            const int half = cb / (NNB_GU / 2), t = (cb % (NNB_GU / 2)) / SEGN, nb = cb % SEGN;
            tr_item8f(w_gu + (size_t)e * DM * 2048, 2048, kb * TRK, half * 1024 + t * 128 + nb * TRN, WguT, (size_t)e * 2048 + t * 256 + half * 128 + nb * TRN, DM, fnw, W8_SCALE, scr, F.lane); continue; } r -= I_GU;
        { const int e = r / (NKB * NNB_D), r2 = r % (NKB * NNB_D), kb = r2 / NNB_D, nb = r2 % NNB_D;
          tr_item8f(w_d + (size_t)e * DE * DM, DM, kb * TRK, nb * TRN, WdT, (size_t)e * 1024 + nb * TRN, DE, nullptr, W8_SCALE, scr, F.lane); }
    }
}
static_assert(4 * TRF_BYTES <= LDSCTL_OFF, "transposer LDS");
constexpr int MOE_PREP_SPLIT = 0;

__device__ __forceinline__ void phase_prep(Frame& F) {
    const float* x = F.in[0]; const float* anw = F.in[1]; const float* w_in = F.in[2]; const float* a_log = F.in[4]; const float* dt_bias = F.in[5];
    const float* pool_w = F.in[7]; const float* pool_scale = F.in[8]; const float* w_out = F.in[9]; const float* fnw = F.in[10];
    const float* w_router = F.in[11]; const float* w_gu = F.in[13]; const float* b_gu = F.in[14]; const float* w_d = F.in[15];
    bf16* WinT = (bf16*)(F.ws + WS_WIN); bf16* WoutT = (bf16*)(F.ws + WS_WOUT); bf16* WpoolT = (bf16*)(F.ws + WS_WPOOL);
    bf16* WguT = (bf16*)(F.ws + WS_WGU); bf16* WdT = (bf16*)(F.ws + WS_WD);
    bf16* WrI = (bf16*)(F.ws + WS_WR); float* bguP = (float*)(F.ws + WS_BGU);
    bf16* xb = (bf16*)(F.ws + WS_XB); float* rs1 = (float*)(F.ws + WS_RS1); float* betaA = (float*)(F.ws + WS_BETA); float* gA = (float*)(F.ws + WS_G);
    LAS unsigned char* scr = F.lds + F.wave * 12288;
    LAS float* W8T = (LAS float*)(F.lds + 98304);
    const int gw = F.vcu * NWAVES + F.wave, NGW = F.G * NWAVES;
    const int gt = F.vcu * 512 + F.tid, NGT = F.G * 512;
    for (int idx = F.tid; idx < 8192; idx += 512) { const int k = idx >> 3, c = idx & 7; W8T[c * 1024 + k] = anw[k] * w_in[(size_t)k * DIN + 2048 + c]; }
    __syncthreads();
    constexpr int I_IN1 = 16 * 32, I_OUT = 16 * 16;
    constexpr int NITEMS = I_IN1 + I_OUT;
    for (int it = gw; it < NITEMS; it += NGW) {
        int r = it;
        if (r < I_IN1) { const int kb = r / 32, nb = r % 32; tr_item(w_in, DIN, kb * 64, nb * 64, WinT, (size_t)nb * 64, DM, 0, anw, nullptr, scr, F.lane); continue; } r -= I_IN1;
        { const int kb = r / 16, nb = r % 16; tr_item(w_out, DM, kb * 64, nb * 64, WoutT, (size_t)nb * 64, DM, 0, nullptr, nullptr, scr, F.lane); }
    }
    __syncthreads();
    for (int task = blockIdx.x; task < 256; task += F.G) {
        const int g = task >> 6, kb = (task >> 2) & 15, dq = task & 3;
        LAS float* Wt = (LAS float*)F.lds;
        LAS float* Pw = (LAS float*)(F.lds + 33024);
        for (int idx = F.tid; idx < 64 * 32; idx += 512) { const int k = idx >> 5, c4 = (idx & 31) * 4; const f32x4 v = *(const f32x4*)(w_in + (size_t)(kb * 64 + k) * DIN + 2056 + g * 128 + c4);
            Wt[k * 129 + c4] = v.x; Wt[k * 129 + c4 + 1] = v.y; Wt[k * 129 + c4 + 2] = v.z; Wt[k * 129 + c4 + 3] = v.w; }
        for (int idx = F.tid; idx < 128 * 8; idx += 512) { const int c = idx >> 3, d4 = (idx & 7) * 4; *(LAS f32x4*)(Pw + c * 32 + d4) = *(const f32x4*)(pool_w + (size_t)g * 16384 + c * 128 + dq * 32 + d4); }
        __syncthreads();
        const int k = F.tid & 63, d4 = (F.tid >> 6) * 4;
        f32x4 acc = (f32x4){0.f, 0.f, 0.f, 0.f};
#pragma unroll 8
        for (int c = 0; c < 128; ++c) acc += *(const LAS f32x4*)(Pw + c * 32 + d4) * Wt[k * 129 + c];
        const int n0 = g * 128 + dq * 32 + d4; const f32x4 ps = *(const f32x4*)(pool_scale + n0); const float an = anw[kb * 64 + k];
        bf16* dst = WinT + (size_t)(2048 + n0) * DM + kb * 64 + k;
        dst[0] = (bf16)f2bf(acc.x * ps.x * an); dst[DM] = (bf16)f2bf(acc.y * ps.y * an); dst[2 * DM] = (bf16)f2bf(acc.z * ps.z * an); dst[3 * DM] = (bf16)f2bf(acc.w * ps.w * an);
        __syncthreads();
    }
    moe_weight_prep(F, 0, 0, MOE_PREP_SPLIT);
    for (int idx = gt; idx < NE * 2048; idx += NGT) { const int e = idx >> 11, r = idx & 2047, t = r >> 8, j = r & 255, half = j >> 7, jj = j & 127; bguP[idx] = b_gu[(size_t)e * 2048 + half * 1024 + t * 128 + jj]; }
    for (int idx = gt; idx < 64 * 64 * 8; idx += NGT) { const int j = idx & 7, ln = (idx >> 3) & 63, fr2 = idx >> 9, nb = fr2 & 1, ks = fr2 >> 1;
        const int k = 32 * ks + 8 * (ln >> 4) + j, e = 16 * nb + (ln & 15); const float v = fnw[k] * w_router[(size_t)k * NE + e];
        const unsigned hb = f2bf(v); const float hf = __builtin_bit_cast(float, hb << 16); const unsigned lb = f2bf(v - hf);
        WrI[((size_t)(fr2 * 2 + 0) * 64 + ln) * 8 + j] = (bf16)hb; WrI[((size_t)(fr2 * 2 + 1) * 64 + ln) * 8 + j] = (bf16)lb; }
    for (int m = gw; m < NTOK; m += NGW) {
        const f32x4* xr = (const f32x4*)(x + (size_t)m * DM) + F.lane;
        f32x4 v[4]; float ss = 0.f; float d8[8];
#pragma unroll
        for (int c = 0; c < 8; ++c) d8[c] = 0.f;
#pragma unroll
        for (int j = 0; j < 4; ++j) { v[j] = xr[64 * j]; ss += (v[j].x * v[j].x + v[j].y * v[j].y) + (v[j].z * v[j].z + v[j].w * v[j].w); }
#pragma unroll
        for (int c = 0; c < 8; ++c)
#pragma unroll
            for (int j = 0; j < 4; ++j) { const f32x4 w = *(const LAS f32x4*)(W8T + c * 1024 + 256 * j + 4 * F.lane); d8[c] += (v[j].x * w.x + v[j].y * w.y) + (v[j].z * w.z + v[j].w * w.w); }
        ss = wave_sum(ss);
#pragma unroll
        for (int c = 0; c < 8; ++c) d8[c] = wave_sum(d8[c]);
        const float rs = 1.f / sqrtf(ss * (1.f / DM) + 1e-6f);
        unsigned long long* o8 = (unsigned long long*)(xb + (size_t)m * DM) + F.lane;
#pragma unroll
        for (int j = 0; j < 4; ++j) o8[64 * j] = (unsigned long long)pk2(v[j].x, v[j].y) | ((unsigned long long)pk2(v[j].z, v[j].w) << 32);
        if (F.lane == 0) rs1[m] = rs;
        if (F.lane < 4) {
            float bl = 0.f, al = 0.f;
#pragma unroll
            for (int c = 0; c < 4; ++c) { bl = (F.lane == c) ? d8[c] : bl; al = (F.lane == c) ? d8[4 + c] : al; }
            bl *= rs; al *= rs;
            betaA[(size_t)m * 4 + F.lane] = 1.f / (1.f + expf(-bl));
            const float z = al + dt_bias[F.lane]; const float sp = z > 20.f ? z : log1pf(expf(z));
            gA[(size_t)m * 4 + F.lane] = -expf(a_log[F.lane]) * sp;
        }
    }
}

__device__ __forceinline__ void phase_mix(Frame& F) {
    const bf16* proj = (const bf16*)(F.ws + WS_PROJ); bf16* mixed = (bf16*)(F.ws + WS_CONCAT) + 512;
    const int gw = F.vcu * NWAVES + F.wave, NGW = F.G * NWAVES;
    const int ch = 8 * F.lane, gi = F.lane >> 4, win = 2 << gi, hal = win - 1;
    for (int rbk = gw; rbk < NTOK / 16; rbk += NGW) {
        const int m0 = rbk * 16, t0 = m0 % SEQ;
        v4u X[31];
#pragma unroll
        for (int k = 0; k < 31; ++k) { X[k] = (v4u){0u, 0u, 0u, 0u}; if (k >= 15 - hal && t0 - 15 + k >= 0) X[k] = *(const v4u*)(proj + (size_t)(m0 - 15 + k) * NPROJ + 2048 + ch); }
        float s[8];
#pragma unroll
        for (int q = 0; q < 8; ++q) s[q] = 0.f;
#pragma unroll
        for (int k = 0; k < 15; ++k) { s[0] += bflo(X[k].x); s[1] += bfhi(X[k].x); s[2] += bflo(X[k].y); s[3] += bfhi(X[k].y); s[4] += bflo(X[k].z); s[5] += bfhi(X[k].z); s[6] += bflo(X[k].w); s[7] += bfhi(X[k].w); }
#pragma unroll
        for (int r = 0; r < 16; ++r) {
            const v4u u = X[15 + r];
            const float p[8] = {bflo(u.x), bfhi(u.x), bflo(u.y), bfhi(u.y), bflo(u.z), bfhi(u.z), bflo(u.w), bfhi(u.w)};
#pragma unroll
            for (int q = 0; q < 8; ++q) s[q] += p[q];
            const int tt = t0 + r + 1; const float ic = 1.f / (float)(tt < win ? tt : win);
            v4u o; o.x = pk2(s[0] * ic - p[0], s[1] * ic - p[1]); o.y = pk2(s[2] * ic - p[2], s[3] * ic - p[3]); o.z = pk2(s[4] * ic - p[4], s[5] * ic - p[5]); o.w = pk2(s[6] * ic - p[6], s[7] * ic - p[7]);
            *(v4u*)(mixed + (size_t)(m0 + r) * DM + ch) = o;
            const v4u od = gi == 0 ? X[14 + r] : gi == 1 ? X[12 + r] : gi == 2 ? X[8 + r] : X[r];
            s[0] -= bflo(od.x); s[1] -= bfhi(od.x); s[2] -= bflo(od.y); s[3] -= bfhi(od.y); s[4] -= bflo(od.z); s[5] -= bfhi(od.z); s[6] -= bflo(od.w); s[7] -= bfhi(od.w);
        }
    }
}

typedef float f32x16 __attribute__((ext_vector_type(16)));
__device__ __forceinline__ bf16x8 pack8(const f32x4 a, const f32x4 b) {
    v4u w; w.x = cvt_pk_bf16(a[0], a[1]); w.y = cvt_pk_bf16(a[2], a[3]); w.z = cvt_pk_bf16(b[0], b[1]); w.w = cvt_pk_bf16(b[2], b[3]);
    return __builtin_bit_cast(bf16x8, w);
}
__device__ __forceinline__ void fmac_(float& acc, float a, float b) { asm("v_fmac_f32 %0, %1, %2" : "+v"(acc) : "v"(a), "v"(b)); }
__device__ __forceinline__ float bf2f(unsigned short u) { return __builtin_bit_cast(float, (unsigned)u << 16); }

constexpr int SOLVE_D = 5;
struct RQ { int i, j; };
__host__ __device__ constexpr int solve_nq(int i) { return (i + 3) / 4; }
__host__ __device__ constexpr RQ solve_adv(int i, int j, int d) { while (d-- > 0 && i < 64) { if (j + 1 < solve_nq(i)) ++j; else { ++i; j = 0; } } return RQ{i, j}; }
template <int I, int J> __device__ __forceinline__ void solve_step(float (&U)[64], const LAS float* Am, const f32x4 (&win)[SOLVE_D], float s0, float s1, float s2, float s3) {
    if constexpr (I < 64) {
        constexpr RQ P = solve_adv(I, J, SOLVE_D);
        f32x4 nw = (f32x4){0.f, 0.f, 0.f, 0.f};
        if constexpr (P.i < 64) nw = *(const LAS f32x4*)(Am + P.i * 64 + 4 * P.j);
        const f32x4 a = win[0];
        fmac_(s0, a.x, U[4 * J]); if constexpr (4 * J + 1 < I) fmac_(s1, a.y, U[4 * J + 1]); if constexpr (4 * J + 2 < I) fmac_(s2, a.z, U[4 * J + 2]); if constexpr (4 * J + 3 < I) fmac_(s3, a.w, U[4 * J + 3]);
        f32x4 nx[SOLVE_D];
#pragma unroll
        for (int q = 0; q + 1 < SOLVE_D; ++q) nx[q] = win[q + 1];
        nx[SOLVE_D - 1] = nw;
        __builtin_amdgcn_sched_barrier(0);
        if constexpr (J + 1 < solve_nq(I)) solve_step<I, J + 1>(U, Am, nx, s0, s1, s2, s3);
        else { U[I] -= (s0 + s1) + (s2 + s3); solve_step<I + 1, 0>(U, Am, nx, 0.f, 0.f, 0.f, 0.f); }
    }
}
__device__ __forceinline__ void solve_all(float (&U)[64], const LAS float* Am) {
    f32x4 win[SOLVE_D];
#pragma unroll
    for (int q = 0; q < SOLVE_D; ++q) { constexpr RQ dummy{0, 0}; (void)dummy; }
    { constexpr RQ p0 = solve_adv(1, 0, 0), p1 = solve_adv(1, 0, 1), p2 = solve_adv(1, 0, 2), p3 = solve_adv(1, 0, 3), p4 = solve_adv(1, 0, 4);
      win[0] = *(const LAS f32x4*)(Am + p0.i * 64 + 4 * p0.j); win[1] = *(const LAS f32x4*)(Am + p1.i * 64 + 4 * p1.j); win[2] = *(const LAS f32x4*)(Am + p2.i * 64 + 4 * p2.j);
      win[3] = *(const LAS f32x4*)(Am + p3.i * 64 + 4 * p3.j); win[4] = *(const LAS f32x4*)(Am + p4.i * 64 + 4 * p4.j); }
    static_assert(SOLVE_D == 5, "window priming is written for SOLVE_D = 5");
    solve_step<1, 0>(U, Am, win, 0.f, 0.f, 0.f, 0.f);
}

constexpr int CP_QN = 0, CP_KN = 17408, CP_VA = 34816, CP_QKL = 51200, CP_SC = 59392, CP_HALF = 60416, CP_CW = 2 * CP_HALF;
__device__ __forceinline__ void phase_chunk(Frame& F, int blk0, int nblk, int n_lo, int n_cnt) {
    const float* conv_w = F.in[3];
    const bf16* proj = (const bf16*)(F.ws + WS_PROJ);
    const float* betaA = (const float*)(F.ws + WS_BETA); const float* gA = (const float*)(F.ws + WS_G);
    float* gtotA = (float*)(F.ws + WS_GTOT);
    const int half = F.wave >> 2, hw = F.wave & 3;
    LAS unsigned char* L = F.lds + half * CP_HALF;
    LAS bf16* qn = (LAS bf16*)(L + CP_QN); LAS bf16* kn = (LAS bf16*)(L + CP_KN); LAS bf16* vn = (LAS bf16*)(L + CP_VA);
    LAS float* Am = (LAS float*)(L + CP_VA); LAS bf16* qkL = (LAS bf16*)(L + CP_QKL); LAS float* sc = (LAS float*)(L + CP_SC);
    LAS float* cwL = (LAS float*)(F.lds + CP_CW);
    for (int idx = F.tid; idx < 4 * 1536 / 4; idx += 512) *(LAS f32x4*)(cwL + 4 * idx) = *(const f32x4*)(conv_w + 4 * idx);
    __syncthreads();
    const int nunits = NB * NH * n_cnt, nrounds = (nunits + 2 * nblk - 1) / (2 * nblk);
#pragma unroll 1
    for (int it = 0; it < nrounds; ++it) {
        int tid_ = F.tid; asm volatile("" : "+v"(tid_));
        const int ht = tid_ & 255, lane = tid_ & 63, r16 = lane & 15, gq = lane >> 4;
        int v_ = (it * nblk + ((int)blockIdx.x - blk0)) * 2 + half; asm volatile("" : "+s"(v_));
        const bool live = v_ < nunits;
        const int bh = live ? v_ / n_cnt : 0, n = live ? n_lo + v_ % n_cnt : 0, b = bh >> 2, h = bh & 3; const int unit = bh * 64 + n;
        const size_t m0 = (size_t)b * SEQ + (size_t)n * 64;
        unsigned char* chunk = F.ws + WS_CHUNK + (size_t)unit * CH_BYTES;
        const int rq = ht >> 4, cg = ht & 15;
        v4u Xa[7], Xb[7]; float gi = 0.f, bi = 0.f;
#define CHUNK_LOADX(X, p_) do { _Pragma("unroll") for (int jj = 0; jj < 7; ++jj) { const int trow = n * 64 + 4 * rq - 3 + jj; const int trc = trow < 0 ? 0 : trow; \
            const v4u u_ = *(const v4u*)(proj + ((size_t)b * SEQ + trc) * NPROJ + (p_) * 512 + h * 128 + 8 * cg); const unsigned mk_ = trow < 0 ? 0u : 0xffffffffu; \
            X[jj] = (v4u){u_.x & mk_, u_.y & mk_, u_.z & mk_, u_.w & mk_}; } } while (0)
#define CHUNK_CONV(X, p_) do { const int col = (p_) * 512 + h * 128 + 8 * cg; float wv[4][8]; \
            _Pragma("unroll") for (int j = 0; j < 4; ++j) { const f32x4 w0 = *(const LAS f32x4*)(cwL + j * 1536 + col), w1 = *(const LAS f32x4*)(cwL + j * 1536 + col + 4); \
                wv[j][0] = w0.x; wv[j][1] = w0.y; wv[j][2] = w0.z; wv[j][3] = w0.w; wv[j][4] = w1.x; wv[j][5] = w1.y; wv[j][6] = w1.z; wv[j][7] = w1.w; } \
            _Pragma("unroll") for (int rr = 0; rr < 4; ++rr) { float y[8]; \
                _Pragma("unroll") for (int q = 0; q < 8; ++q) y[q] = 0.f; \
                _Pragma("unroll") for (int j = 0; j < 4; ++j) { const v4u u = X[rr + j]; \
                    fmac_(y[0], wv[j][0], bflo(u.x)); fmac_(y[1], wv[j][1], bfhi(u.x)); fmac_(y[2], wv[j][2], bflo(u.y)); fmac_(y[3], wv[j][3], bfhi(u.y)); \
                    fmac_(y[4], wv[j][4], bflo(u.z)); fmac_(y[5], wv[j][5], bfhi(u.z)); fmac_(y[6], wv[j][6], bflo(u.w)); fmac_(y[7], wv[j][7], bfhi(u.w)); } \
                float ss = 0.f; \
                _Pragma("unroll") for (int q = 0; q < 8; ++q) { y[q] = siluf_(y[q]); ss += y[q] * y[q]; } \
                float scl = 1.f; \
                if ((p_) < 2) { ss += __shfl_xor(ss, 1); ss += __shfl_xor(ss, 2); ss += __shfl_xor(ss, 4); ss += __shfl_xor(ss, 8); scl = frsq_(ss + 1e-6f); if ((p_) == 0) scl *= 0.08838834764831845f; } \
                v4u o; o.x = cvt_pk_bf16(y[0] * scl, y[1] * scl); o.y = cvt_pk_bf16(y[2] * scl, y[3] * scl); o.z = cvt_pk_bf16(y[4] * scl, y[5] * scl); o.w = cvt_pk_bf16(y[6] * scl, y[7] * scl); \
                const int row = 4 * rq + rr; \
                if ((p_) == 0) *(LAS v4u*)(qn + row * 136 + 8 * cg) = o; else if ((p_) == 1) *(LAS v4u*)(kn + row * 136 + 8 * cg) = o; else *(LAS v4u*)(vn + row * 128 + 8 * cg) = o; \
                __builtin_amdgcn_sched_barrier(0); } } while (0)
        if (live) { CHUNK_LOADX(Xa, 0); CHUNK_LOADX(Xb, 1); if (hw == 0) { gi = gA[(m0 + lane) * 4 + h]; bi = betaA[(m0 + lane) * 4 + h]; } }
        if (live && hw == 0) {
            float c = gi;
#pragma unroll
            for (int o = 1; o < 64; o <<= 1) { const float tt = __shfl_up(c, o); if (lane >= o) c += tt; }
            const float gl = __shfl(c, 63);
            sc[lane] = bi; sc[64 + lane] = c; sc[128 + lane] = fexp_(c); sc[192 + lane] = fexp_(gl - c);
            if (lane == 63) gtotA[unit] = fexp_(c);
        }
        if (live) { CHUNK_CONV(Xa, 0); CHUNK_LOADX(Xa, 2); CHUNK_CONV(Xb, 1); CHUNK_CONV(Xa, 2); }
#undef CHUNK_LOADX
#undef CHUNK_CONV
        __syncthreads();
        const int which = ht >> 7, c = ht & 127;
        float U[64];
        if (live) {
#pragma unroll
            for (int i = 0; i < 64; ++i) { const float bi = sc[i]; const float tv = which ? bf2f(kn[i * 136 + c]) * sc[128 + i] : bf2f(vn[i * 128 + c]); U[i] = tv * bi; }
        } else {
#pragma unroll
            for (int i = 0; i < 64; ++i) U[i] = 0.f;
        }
        __syncthreads();
        if (live) {
            const int ti = hw >> 1, tj = hw & 1, r = lane & 31, hh = lane >> 5;
            f32x16 KK, QK;
#pragma unroll
            for (int q = 0; q < 16; ++q) { KK[q] = 0.f; QK[q] = 0.f; }
#pragma unroll
            for (int ks = 0; ks < 8; ++ks) {
                const bf16x8 ak = *(const LAS bf16x8*)(kn + (ti * 32 + r) * 136 + 16 * ks + 8 * hh);
                const bf16x8 aq = *(const LAS bf16x8*)(qn + (ti * 32 + r) * 136 + 16 * ks + 8 * hh);
                const bf16x8 bb = *(const LAS bf16x8*)(kn + (tj * 32 + r) * 136 + 16 * ks + 8 * hh);
                KK = __builtin_amdgcn_mfma_f32_32x32x16_bf16(ak, bb, KK, 0, 0, 0);
                QK = __builtin_amdgcn_mfma_f32_32x32x16_bf16(aq, bb, QK, 0, 0, 0);
            }
            const int j = tj * 32 + r; const float gcj = sc[64 + j];
#pragma unroll
            for (int reg = 0; reg < 16; ++reg) { const int i = ti * 32 + (reg & 3) + 8 * (reg >> 2) + 4 * hh;
                const float dec = (i >= j) ? __expf(sc[64 + i] - gcj) : 0.f;
                Am[i * 64 + j] = (i > j) ? sc[i] * KK[reg] * dec : 0.f;
                qkL[i * 64 + j] = (bf16)f2bf((i >= j) ? QK[reg] * dec : 0.f); }
        }
        __syncthreads();
        if (live) {
#pragma unroll
            for (int fi = 0; fi < 4; ++fi) { const int f = hw * 4 + fi, mb = f >> 2, ks = f & 3, row = 16 * mb + r16; const float s = sc[128 + row];
                const v2u lo = *(const LAS v2u*)(qn + row * 136 + 32 * ks + 4 * gq), hi = *(const LAS v2u*)(qn + row * 136 + 32 * ks + 16 + 4 * gq);
                v4u o; o.x = pk2(bflo(lo.x) * s, bfhi(lo.x) * s); o.y = pk2(bflo(lo.y) * s, bfhi(lo.y) * s); o.z = pk2(bflo(hi.x) * s, bfhi(hi.x) * s); o.w = pk2(bflo(hi.y) * s, bfhi(hi.y) * s);
                *(v4u*)(chunk + CH_QD + (f * 64 + lane) * 16) = o; }
#pragma unroll
            for (int fi = 0; fi < 4; ++fi) { const int f = hw * 4 + fi, db = f >> 1, ksp = f & 1, dcol = 16 * db + r16; float e[8];
#pragma unroll
                for (int j = 0; j < 8; ++j) { const int i = 32 * ksp + 16 * (j >> 2) + 4 * gq + (j & 3); e[j] = bf2f(kn[i * 136 + dcol]) * sc[192 + i]; }
                v4u o; o.x = pk2(e[0], e[1]); o.y = pk2(e[2], e[3]); o.z = pk2(e[4], e[5]); o.w = pk2(e[6], e[7]);
                *(v4u*)(chunk + CH_KT + (f * 64 + lane) * 16) = o; }
#pragma unroll
            for (int fi = 0; fi < 2; ++fi) { const int f = hw * 2 + fi, mb = f >> 1, ksp = f & 1, row = 16 * mb + r16;
                const v2u lo = *(const LAS v2u*)(qkL + row * 64 + 32 * ksp + 4 * gq), hi = *(const LAS v2u*)(qkL + row * 64 + 32 * ksp + 16 + 4 * gq);
                *(v4u*)(chunk + CH_QK + (f * 64 + lane) * 16) = (v4u){lo.x, lo.y, hi.x, hi.y}; }
            solve_all(U, Am);
        }
        __syncthreads();
        if (live) {
            if (which == 0) {
                const int w8 = c >> 4, cl = c & 15;
                unsigned char* ub = F.ws + WS_UC + (size_t)unit * UC_BYTES;
#pragma unroll
                for (int g = 0; g < 4; ++g) {
                    v4u lo, hi;
                    lo.x = pk2(U[4 * g], U[4 * g + 1]); lo.y = pk2(U[4 * g + 2], U[4 * g + 3]); lo.z = pk2(U[16 + 4 * g], U[16 + 4 * g + 1]); lo.w = pk2(U[16 + 4 * g + 2], U[16 + 4 * g + 3]);
                    hi.x = pk2(U[32 + 4 * g], U[32 + 4 * g + 1]); hi.y = pk2(U[32 + 4 * g + 2], U[32 + 4 * g + 3]); hi.z = pk2(U[48 + 4 * g], U[48 + 4 * g + 1]); hi.w = pk2(U[48 + 4 * g + 2], U[48 + 4 * g + 3]);
                    v4u* dst = (v4u*)(ub + ((w8 * 64 + g * 16 + cl) * 32)); dst[0] = lo; dst[1] = hi;
                }
            } else {
#pragma unroll
                for (int i = 0; i < 64; ++i) qn[i * 136 + c] = (bf16)f2bf(U[i]);
            }
        }
        __syncthreads();
        if (live) {
#pragma unroll
            for (int fi = 0; fi < 4; ++fi) { const int f = hw * 4 + fi, mb = f >> 2, ks = f & 3, row = 16 * mb + r16;
                const v2u lo = *(const LAS v2u*)(qn + row * 136 + 32 * ks + 4 * gq), hi = *(const LAS v2u*)(qn + row * 136 + 32 * ks + 16 + 4 * gq);
                *(v4u*)(chunk + CH_WF + (f * 64 + lane) * 16) = (v4u){lo.x, lo.y, hi.x, hi.y}; }
        }
        __syncthreads();
    }
}

constexpr int SCAN_SPLIT = 32;
constexpr int SC_STAGED = 49152, SC_NLOAD = 16;
struct ScanU { v4u u0, u1; };
struct ScanQ { v4u q[8]; };
__device__ __forceinline__ void scan_issue_u(ScanU& R, const unsigned char* up) {
    asm volatile("global_load_dwordx4 %0, %1, off" : "=v"(R.u0) : "v"(up) : "memory");
    asm volatile("global_load_dwordx4 %0, %1, off offset:16" : "=v"(R.u1) : "v"(up) : "memory");
}
__device__ __forceinline__ void scan_issue_q(ScanQ& R, const unsigned char* qp) {
    asm volatile("global_load_dwordx4 %0, %1, off" : "=v"(R.q[0]) : "v"(qp) : "memory");
    asm volatile("global_load_dwordx4 %0, %1, off offset:1024" : "=v"(R.q[1]) : "v"(qp) : "memory");
    asm volatile("global_load_dwordx4 %0, %1, off offset:2048" : "=v"(R.q[2]) : "v"(qp) : "memory");
    asm volatile("global_load_dwordx4 %0, %1, off offset:3072" : "=v"(R.q[3]) : "v"(qp) : "memory");
    const unsigned char* qp2 = qp + 4096;
    asm volatile("global_load_dwordx4 %0, %1, off" : "=v"(R.q[4]) : "v"(qp2) : "memory");
    asm volatile("global_load_dwordx4 %0, %1, off offset:1024" : "=v"(R.q[5]) : "v"(qp2) : "memory");
    asm volatile("global_load_dwordx4 %0, %1, off offset:2048" : "=v"(R.q[6]) : "v"(qp2) : "memory");
    asm volatile("global_load_dwordx4 %0, %1, off offset:3072" : "=v"(R.q[7]) : "v"(qp2) : "memory");
}
#define SCAN_WAIT_REGS(U, Q, cnt) asm volatile("s_waitcnt vmcnt(" #cnt ")" : "+v"(U.u0), "+v"(U.u1), "+v"(Q.q[0]), "+v"(Q.q[1]), "+v"(Q.q[2]), "+v"(Q.q[3]), "+v"(Q.q[4]), "+v"(Q.q[5]), "+v"(Q.q[6]), "+v"(Q.q[7]) :: "memory")
template <class Bar> __device__ __forceinline__ void phase_scan(Frame& F, const Bar& mid_barrier) {
    const int bh = blockIdx.x, b = bh >> 2, h = bh & 3, w = F.wave, lane = F.lane, cl = lane & 15, gq = lane >> 4;
    const float* gtotA = (const float*)(F.ws + WS_GTOT);
    const int unit0 = bh * 64;
    const unsigned char* cbase = F.ws + WS_CHUNK + (size_t)unit0 * CH_BYTES;
    const unsigned char* ubase = F.ws + WS_UC + (size_t)unit0 * UC_BYTES + (w * 64 + lane) * 32;
    const unsigned char* qbase = cbase + CH_QK + lane * 16;
    bf16* op = (bf16*)(F.ws + WS_ORAW) + ((size_t)b * SEQ + cl) * 512 + h * 128 + 16 * w + 4 * gq;
    f32x4 Sacc[8]; bf16x8 Sb[4];
#pragma unroll
    for (int d = 0; d < 8; ++d) Sacc[d] = (f32x4){0.f, 0.f, 0.f, 0.f};
#pragma unroll
    for (int k = 0; k < 4; ++k) Sb[k] = (bf16x8){0, 0, 0, 0, 0, 0, 0, 0};
    v2u Ow[4];
#pragma unroll
    for (int mb = 0; mb < 4; ++mb) Ow[mb] = (v2u){0u, 0u};
    ScanU U0, U1, U2; ScanQ QA, QB;
#define SCAN_ISSUE(nn) do { const unsigned char* s_ = cbase + (size_t)(nn) * CH_BYTES + (w * 6) * 1024 + lane * 16; LAS unsigned char* d_ = F.lds + ((nn) % 3) * SC_STAGED + (w * 6) * 1024; \
        _Pragma("unroll") for (int k_ = 0; k_ < 6; ++k_) __builtin_amdgcn_global_load_lds((const unsigned*)(s_ + k_ * 1024), (LAS unsigned*)(d_ + k_ * 1024), 16, 0, 0); } while (0)
#define SCAN_STEP(n, UC, UN, Q, ISSUE2, WAITCNT) do { \
        SCAN_WAIT_REGS(UC, Q, WAITCNT); asm volatile("s_waitcnt lgkmcnt(0)" ::: "memory"); __builtin_amdgcn_s_barrier(); asm volatile("" ::: "memory"); \
        const float gt = __shfl(gtv, (n) & 31); \
        if (ISSUE2) { scan_issue_u(UN, ubase + (size_t)((n) + 2) * UC_BYTES); SCAN_ISSUE((n) + 2); } \
        if ((n) > 0) { _Pragma("unroll") for (int mb = 0; mb < 4; ++mb) *(v2u*)(op + (size_t)(((n) - 1) * 64 + 16 * mb) * 512) = Ow[mb]; } \
        const LAS unsigned char* B = F.lds + ((n) % 3) * SC_STAGED; \
        f32x4 P[4]; \
        _Pragma("unroll") for (int mb = 0; mb < 4; ++mb) { P[mb] = (f32x4){0.f, 0.f, 0.f, 0.f}; \
            _Pragma("unroll") for (int ks = 0; ks < 4; ++ks) P[mb] = __builtin_amdgcn_mfma_f32_16x16x32_bf16(SFRAG(CH_WF, mb * 4 + ks), Sb[ks], P[mb], 0, 0, 0); } \
        f32x4 vnw[4]; \
        vnw[0] = (f32x4){bflo(UC.u0.x), bfhi(UC.u0.x), bflo(UC.u0.y), bfhi(UC.u0.y)} - P[0]; \
        vnw[1] = (f32x4){bflo(UC.u0.z), bfhi(UC.u0.z), bflo(UC.u0.w), bfhi(UC.u0.w)} - P[1]; \
        vnw[2] = (f32x4){bflo(UC.u1.x), bfhi(UC.u1.x), bflo(UC.u1.y), bfhi(UC.u1.y)} - P[2]; \
        vnw[3] = (f32x4){bflo(UC.u1.z), bfhi(UC.u1.z), bflo(UC.u1.w), bfhi(UC.u1.w)} - P[3]; \
        bf16x8 Vb[2]; Vb[0] = pack8(vnw[0], vnw[1]); Vb[1] = pack8(vnw[2], vnw[3]); \
        _Pragma("unroll") for (int mb = 0; mb < 4; ++mb) { f32x4 OT = (f32x4){0.f, 0.f, 0.f, 0.f}; \
            _Pragma("unroll") for (int ks = 0; ks < 4; ++ks) OT = __builtin_amdgcn_mfma_f32_16x16x32_bf16(Sb[ks], SFRAG(CH_QD, mb * 4 + ks), OT, 0, 0, 0); \
            _Pragma("unroll") for (int ksp = 0; ksp < 2; ++ksp) OT = __builtin_amdgcn_mfma_f32_16x16x32_bf16(Vb[ksp], __builtin_bit_cast(bf16x8, Q.q[mb * 2 + ksp]), OT, 0, 0, 0); \
            Ow[mb] = (v2u){cvt_pk_bf16(OT[0], OT[1]), cvt_pk_bf16(OT[2], OT[3])}; } \
        asm volatile("s_nop 7" : "+v"(Q.q[0]), "+v"(Q.q[1]), "+v"(Q.q[2]), "+v"(Q.q[3]), "+v"(Q.q[4]), "+v"(Q.q[5]), "+v"(Q.q[6]), "+v"(Q.q[7]));     \
        if (ISSUE2) scan_issue_q(Q, qbase + (size_t)((n) + 2) * CH_BYTES); \
        _Pragma("unroll") for (int db = 0; db < 8; ++db) { Sacc[db] = Sacc[db] * gt; \
            _Pragma("unroll") for (int ksp = 0; ksp < 2; ++ksp) Sacc[db] = __builtin_amdgcn_mfma_f32_16x16x32_bf16(SFRAG(CH_KT, db * 2 + ksp), Vb[ksp], Sacc[db], 0, 0, 0); } \
        _Pragma("unroll") for (int ks = 0; ks < 4; ++ks) Sb[ks] = pack8(Sacc[2 * ks], Sacc[2 * ks + 1]); \
    } while (0)
#define SFRAG(off, f) (*(const LAS bf16x8*)(B + (off) + ((f) * 64 + lane) * 16))
    static_assert(CH_WF == 0 && CH_QD == 16384 && CH_KT == 32768 && CH_QK == SC_STAGED && SCAN_SPLIT % 6 == 2 && 2 * SCAN_SPLIT == 64, "staged part = the first 48 KiB of a chunk; a half = 5 x 6 + 2 steps");
#pragma unroll 1
    for (int part = 0; part < 2; ++part) {
        const int n0 = part * SCAN_SPLIT;
        float gtv = gtotA[unit0 + n0 + (lane & 31)];
        asm volatile("s_waitcnt vmcnt(0)" : "+v"(gtv) :: "memory");
        scan_issue_u(U0, ubase + (size_t)n0 * UC_BYTES); SCAN_ISSUE(n0); scan_issue_q(QA, qbase + (size_t)n0 * CH_BYTES);
        scan_issue_u(U1, ubase + (size_t)(n0 + 1) * UC_BYTES); SCAN_ISSUE(n0 + 1); scan_issue_q(QB, qbase + (size_t)(n0 + 1) * CH_BYTES);
#pragma unroll 1
        for (int n = n0; n < n0 + SCAN_SPLIT - 2; n += 6) {
            SCAN_STEP(n, U0, U2, QA, true, 16);
            SCAN_STEP(n + 1, U1, U0, QB, true, 16);
            SCAN_STEP(n + 2, U2, U1, QA, true, 16);
            SCAN_STEP(n + 3, U0, U2, QB, true, 16);
            SCAN_STEP(n + 4, U1, U0, QA, true, 16);
            SCAN_STEP(n + 5, U2, U1, QB, true, 16);
        }
        SCAN_STEP(n0 + SCAN_SPLIT - 2, U0, U2, QA, false, 16);
        SCAN_STEP(n0 + SCAN_SPLIT - 1, U1, U0, QB, false, 0);
        if (part == 0) mid_barrier();
    }
#undef SFRAG
#undef SCAN_STEP
#undef SCAN_ISSUE
#pragma unroll
    for (int mb = 0; mb < 4; ++mb) *(v2u*)(op + (size_t)(63 * 64 + 16 * mb) * 512) = Ow[mb];
    VM_WAIT(); __syncthreads();
}

__device__ __forceinline__ void phase_onorm(Frame& F) {
    const float* dnw = F.in[6]; const bf16* proj = (const bf16*)(F.ws + WS_PROJ); const bf16* oraw = (const bf16*)(F.ws + WS_ORAW); bf16* concat = (bf16*)(F.ws + WS_CONCAT);
    const int gw = F.vcu * NWAVES + F.wave, NGW = F.G * NWAVES, lane = F.lane;
    const int cc = 8 * (lane & 15);
    const f32x4 d0 = *(const f32x4*)(dnw + cc), d1 = *(const f32x4*)(dnw + cc + 4);
    for (int m = gw; m < NTOK; m += NGW) {
        const v4u o = *(const v4u*)(oraw + (size_t)m * 512 + 8 * lane);
        const v4u z = *(const v4u*)(proj + (size_t)m * NPROJ + 1536 + 8 * lane);
        const float ov[8] = {bflo(o.x), bfhi(o.x), bflo(o.y), bfhi(o.y), bflo(o.z), bfhi(o.z), bflo(o.w), bfhi(o.w)};
        const float zv[8] = {bflo(z.x), bfhi(z.x), bflo(z.y), bfhi(z.y), bflo(z.z), bfhi(z.z), bflo(z.w), bfhi(z.w)};
        float ss = 0.f;
#pragma unroll
        for (int q = 0; q < 8; ++q) ss += ov[q] * ov[q];
        ss += __shfl_xor(ss, 1); ss += __shfl_xor(ss, 2); ss += __shfl_xor(ss, 4); ss += __shfl_xor(ss, 8);
        const float rs = frsq_(ss * (1.f / 128.f) + 1e-6f);
        const float dv[8] = {d0.x, d0.y, d0.z, d0.w, d1.x, d1.y, d1.z, d1.w};
        float r[8];
#pragma unroll
        for (int q = 0; q < 8; ++q) r[q] = ov[q] * rs * dv[q] * siluf_(zv[q]);
        *(v4u*)(concat + (size_t)m * DM + 8 * lane) = (v4u){cvt_pk_bf16(r[0], r[1]), cvt_pk_bf16(r[2], r[3]), cvt_pk_bf16(r[4], r[5]), cvt_pk_bf16(r[6], r[7])};
    }
}

__device__ __forceinline__ void phase_route(Frame& F) {
    const bf16* x1 = (const bf16*)(F.ws + WS_X1); const float* b_router = F.in[12];
    unsigned char* x1b = F.ws + WS_X1B; float* rs2A = (float*)(F.ws + WS_RS2); int* list = (int*)(F.ws + WS_LIST);
    float* rsl = (float*)(F.ws + WS_RSL); float* gwl = (float*)(F.ws + WS_GWL);
    unsigned* cntw = (unsigned*)(F.ws + WS_CTL) + CW_CNT;
    LAS unsigned char* WI = F.lds;
    LAS unsigned* lcnt = (LAS unsigned*)(F.lds + TAB_OFF);
    { const v4u* src = (const v4u*)(F.ws + WS_WR);
      for (int idx = F.tid; idx < 131072 / 16; idx += 512) *(LAS v4u*)(WI + 16 * idx) = src[idx]; }
    const int lane = F.lane, c = lane & 15, g = lane >> 4;
    const int gw = F.vcu * NWAVES + F.wave, NGW = F.G * NWAVES, NT = NTOK / 16;
    const float bia0 = b_router[c], bia1 = b_router[16 + c];
    for (int t0 = 0; t0 < NT; t0 += NGW) {
        const int tile = t0 + gw; const bool live = tile < NT;
        if (F.tid < 64) lcnt[F.tid] = 0u;
        __syncthreads();
        int my_e = 0; float my_g = 0.f, my_rs = 0.f; unsigned my_rank = 0u; int my_ent = 0;
        if (live) {
            const int m0 = tile * 16;
            const bf16* xrow = x1 + (size_t)(m0 + c) * DM + 8 * g;
            unsigned char* xbrow = x1b + (size_t)(m0 + c) * DM + 8 * g;
            f32x4 acc0 = (f32x4){0.f, 0.f, 0.f, 0.f}, acc1 = acc0; float ssq = 0.f;
#pragma unroll 1
            for (int kb = 0; kb < 2; ++kb) {
                v4u xa[16];
#pragma unroll
                for (int q = 0; q < 16; ++q) xa[q] = *(const v4u*)(xrow + 32 * (kb * 16 + q));
#pragma unroll
                for (int q = 0; q < 16; ++q) { const int ks = kb * 16 + q; const v4u h = xa[q];
                    const float a0 = bflo(h.x), a1 = bfhi(h.x), a2 = bflo(h.y), a3 = bfhi(h.y), b0 = bflo(h.z), b1 = bfhi(h.z), b2 = bflo(h.w), b3 = bfhi(h.w);
                    ssq += (a0 * a0 + a1 * a1) + (a2 * a2 + a3 * a3) + (b0 * b0 + b1 * b1) + (b2 * b2 + b3 * b3);
                    *(v2u*)(xbrow + 32 * ks) = (v2u){pk4_fp8(a0, a1, a2, a3), pk4_fp8(b0, b1, b2, b3)};
                    const bf16x8 ah = __builtin_bit_cast(bf16x8, h);
                    const LAS unsigned char* fb = WI + (size_t)(ks * 4) * 1024 + lane * 16;
                    const bf16x8 b0h = *(const LAS bf16x8*)(fb), b0l = *(const LAS bf16x8*)(fb + 1024), b1h = *(const LAS bf16x8*)(fb + 2048), b1l = *(const LAS bf16x8*)(fb + 3072);
                    acc0 = __builtin_amdgcn_mfma_f32_16x16x32_bf16(ah, b0h, acc0, 0, 0, 0); acc0 = __builtin_amdgcn_mfma_f32_16x16x32_bf16(ah, b0l, acc0, 0, 0, 0);
                    acc1 = __builtin_amdgcn_mfma_f32_16x16x32_bf16(ah, b1h, acc1, 0, 0, 0); acc1 = __builtin_amdgcn_mfma_f32_16x16x32_bf16(ah, b1l, acc1, 0, 0, 0); }
            }
            ssq += __shfl_xor(ssq, 16); ssq += __shfl_xor(ssq, 32);
            const float rsr = frsq_(ssq * (1.f / DM) + 1e-6f);
            if (g == 0) rs2A[m0 + c] = rsr;
            float ge_[4]; int ee_[4];
#pragma unroll
            for (int reg = 0; reg < 4; ++reg) {
                const float rsw = __shfl(rsr, 4 * g + reg);
                float v0 = acc0[reg] * rsw + bia0, v1 = acc1[reg] * rsw + bia1;
                float tv[4]; int te[4];
#pragma unroll
                for (int s = 0; s < 4; ++s) {
                    float bv; int bi; if (v1 > v0) { bv = v1; bi = 16 + c; } else { bv = v0; bi = c; }
#pragma unroll
                    for (int o = 1; o < 16; o <<= 1) { const float ov = __shfl_xor(bv, o); const int oi = __shfl_xor(bi, o); if (ov > bv || (ov == bv && oi < bi)) { bv = ov; bi = oi; } }
                    tv[s] = bv; te[s] = bi; if (bi == c) v0 = -3.0e38f; if (bi == 16 + c) v1 = -3.0e38f;
                }
                const float e1 = fexp_(tv[1] - tv[0]), e2 = fexp_(tv[2] - tv[0]), e3 = fexp_(tv[3] - tv[0]); const float inv = frcp_(1.f + e1 + e2 + e3);
                const int s_ = c & 3; const float gsel = (s_ == 0 ? 1.f : s_ == 1 ? e1 : s_ == 2 ? e2 : e3) * inv; const int esel = s_ == 0 ? te[0] : s_ == 1 ? te[1] : s_ == 2 ? te[2] : te[3];
                ge_[reg] = gsel; ee_[reg] = esel;
            }
            const int rsel = c >> 2;
            my_g = rsel == 0 ? ge_[0] : rsel == 1 ? ge_[1] : rsel == 2 ? ge_[2] : ge_[3];
            my_e = rsel == 0 ? ee_[0] : rsel == 1 ? ee_[1] : rsel == 2 ? ee_[2] : ee_[3];
            my_ent = (m0 + 4 * g + rsel) * 4 + (c & 3);
            my_rs = __shfl(rsr, 4 * g + rsel);
            my_rank = __hip_atomic_fetch_add(lcnt + my_e, 1u, __ATOMIC_RELAXED, __HIP_MEMORY_SCOPE_WORKGROUP);
        }
        __syncthreads();
        if (F.tid < NE) { const unsigned n = lcnt[F.tid]; lcnt[32 + F.tid] = n ? __hip_atomic_fetch_add(cntw + 64 * F.tid, n, RLX_AGENT) : 0u; }
        __syncthreads();
        if (live) { const size_t pos = (size_t)my_e * LISTCAP + lcnt[32 + my_e] + my_rank; list[pos] = my_ent; rsl[pos] = my_rs; gwl[pos] = my_g; }
        __syncthreads();
    }
}

constexpr int TILE_TAB_OFF = pg8::STAGE_BYTES + 8192;
__device__ __forceinline__ int moe_tables(Frame& F, MoeTab& T) {
    LAS int* pref = (LAS int*)(F.lds + TAB_OFF); LAS int* cnt = pref + 40; LAS int* tile = (LAS int*)(F.lds + TILE_TAB_OFF);
    unsigned* cntw = (unsigned*)(F.ws + WS_CTL) + CW_CNT;
    if (F.tid == 0) { int acc = 0; for (int e = 0; e < NE; ++e) { const int c = (int)__hip_atomic_load(cntw + 64 * e, RLX_AGENT); cnt[e] = c; pref[e] = acc; acc += (c + 255) >> 8; } pref[NE] = acc; }
    __syncthreads();
    const int RT = pref[NE];
    for (int rt = F.tid; rt < RT; rt += NWAVES * 64) { int e = 0;
        for (int j = 1; j < NE; ++j) if (pref[j] <= rt) e = j;
        const int rb = rt - pref[e], left = cnt[e] - rb * 256;
        tile[rt] = (e << 24) | (rb << 12) | (left < 256 ? left : 256); }
    __syncthreads();
    T.pref = pref; T.cnt = cnt; T.tile = tile;
    return RT;
}

struct FinalRow { f32x4 v[4]; v2u sl[4][2]; };
__device__ __forceinline__ void final_load(FinalRow& R, const bf16* xrow, const unsigned char* srow) {
#pragma unroll
    for (int j = 0; j < 2; ++j) { const v4u h = *(const v4u*)(xrow + 512 * j);
        R.v[2 * j] = (f32x4){bflo(h.x), bfhi(h.x), bflo(h.y), bfhi(h.y)}; R.v[2 * j + 1] = (f32x4){bflo(h.z), bfhi(h.z), bflo(h.w), bfhi(h.w)}; }
#pragma unroll
    for (int s = 0; s < 4; ++s)
#pragma unroll
        for (int j = 0; j < 2; ++j) R.sl[s][j] = *(const v2u*)(srow + (size_t)s * DM + 512 * j);
}
__device__ __forceinline__ void final_finish(FinalRow& R, float* orow, const f32x4 (&wv)[4]) {
#pragma unroll
    for (int s = 0; s < 4; ++s)
#pragma unroll
        for (int j = 0; j < 2; ++j) { const v2u u = R.sl[s][j];
            const f32x2_t a0 = __builtin_amdgcn_cvt_pk_f32_fp8((int)u.x, false), a1 = __builtin_amdgcn_cvt_pk_f32_fp8((int)u.x, true), b0 = __builtin_amdgcn_cvt_pk_f32_fp8((int)u.y, false), b1 = __builtin_amdgcn_cvt_pk_f32_fp8((int)u.y, true);
            R.v[2 * j].x += a0.x * SLAB_INV; R.v[2 * j].y += a0.y * SLAB_INV; R.v[2 * j].z += a1.x * SLAB_INV; R.v[2 * j].w += a1.y * SLAB_INV;
            R.v[2 * j + 1].x += b0.x * SLAB_INV; R.v[2 * j + 1].y += b0.y * SLAB_INV; R.v[2 * j + 1].z += b1.x * SLAB_INV; R.v[2 * j + 1].w += b1.y * SLAB_INV; }
    float ss = 0.f;
#pragma unroll
    for (int j = 0; j < 4; ++j) ss += (R.v[j].x * R.v[j].x + R.v[j].y * R.v[j].y) + (R.v[j].z * R.v[j].z + R.v[j].w * R.v[j].w);
    ss = wave_sum(ss);
    const float rs = frsq_(ss * (1.f / DM) + 1e-6f);
#pragma unroll
    for (int j = 0; j < 2; ++j) { *(f32x4*)(orow + 512 * j) = R.v[2 * j] * rs * wv[2 * j]; *(f32x4*)(orow + 512 * j + 4) = R.v[2 * j + 1] * rs * wv[2 * j + 1]; }
}
__device__ __forceinline__ void phase_final(Frame& F, int dryrun) {
    const float* fw = F.in[17]; const unsigned char* slab = F.ws + WS_SLAB; float* out = F.out;
    const bf16* x1 = (const bf16*)(F.ws + WS_X1); (void)dryrun;
    const int gw = F.vcu * NWAVES + F.wave, NGW = F.G * NWAVES, lane = F.lane;
    f32x4 wv[4];
#pragma unroll
    for (int j = 0; j < 2; ++j) { wv[2 * j] = *(const f32x4*)(fw + 512 * j + 8 * lane); wv[2 * j + 1] = *(const f32x4*)(fw + 512 * j + 8 * lane + 4); }
    FinalRow A, B;
    int m = gw;
    if (m < NTOK) final_load(A, x1 + (size_t)m * DM + 8 * lane, slab + (size_t)m * 4 * DM + 8 * lane);
    for (; m < NTOK; m += 2 * NGW) {
        const int m1 = m + NGW, m2 = m + 2 * NGW;
        if (m1 < NTOK) final_load(B, x1 + (size_t)m1 * DM + 8 * lane, slab + (size_t)m1 * 4 * DM + 8 * lane);
        final_finish(A, out + (size_t)m * DM + 8 * lane, wv);
        if (m2 < NTOK) final_load(A, x1 + (size_t)m2 * DM + 8 * lane, slab + (size_t)m2 * 4 * DM + 8 * lane);
        if (m1 < NTOK) final_finish(B, out + (size_t)m1 * DM + 8 * lane, wv);
    }
}

struct Args { const float* in[18]; float* out; unsigned char* ws; int ph_lo, ph_hi, flag, breg; };
constexpr int NPHASE = 11;

__global__ void __launch_bounds__(NWAVES * 64, 2) mk_fwd(Args args) {
    extern __shared__ __attribute__((aligned(16))) unsigned char lds_raw[];
    Frame F;
    F.lds = (LAS unsigned char*)lds_raw;
    F.tid = threadIdx.x; F.lane = F.tid & 63; F.wave = __builtin_amdgcn_readfirstlane(F.tid >> 6);
    F.G = gridDim.x; { const int bx = blockIdx.x; F.vcu = (F.G % 8 == 0) ? (bx % 8) * (F.G / 8) + bx / 8 : bx; }
#pragma unroll
    for (int i = 0; i < 18; ++i) F.in[i] = args.in[i];
    F.out = args.out; F.ws = args.ws;
    volatile LAS unsigned* MISC = (volatile LAS unsigned*)(F.lds + MISC_OFF);
    for (int u = F.tid; u < (LDS_BYTES - LDSCTL_OFF) / 4; u += NWAVES * 64) ((LAS unsigned*)(F.lds + LDSCTL_OFF))[u] = 0u;
    __syncthreads();
    unsigned* ctl = (unsigned*)(F.ws + WS_CTL);
#if !MK_PER_PHASE
    XcdBarrier bar = xcd_barrier_post(ctl + CW_BAR, MISC + 8);
#define GRID_BAR() xcd_barrier(bar)
#else
#define GRID_BAR() do {} while (0)
#endif
    const int lo = args.ph_lo, hi = args.ph_hi;
#define IN(k) (lo <= (k) && (k) < hi)
#define SEAM(k) do { if (IN(k) && IN((k) + 1)) GRID_BAR(); } while (0)

#define RUNPH(k, ...) do { if (IN(k)) { __VA_ARGS__; } SEAM(k); } while (0)
    RUNPH(0, phase_prep(F));
    RUNPH(1, {
        ProbIn P; P.K = DM; P.RB = 2 * DM; P.S.init(NTOK / 256, NPROJ / 256, F.G, (int)blockIdx.x);
        P.A = (const bf16*)(F.ws + WS_XB); P.Bt = (const bf16*)(F.ws + WS_WIN); P.O = (bf16*)(F.ws + WS_PROJ); P.rs = (const float*)(F.ws + WS_RS1);
        pg8::gemm_phase(F.lds, P); });
    if (IN(2)) { phase_mix(F); __syncthreads(); }
    RUNPH(3, phase_chunk(F, 0, F.G, 0, SCAN_SPLIT));
    RUNPH(4, {
        const int nscan = NB * NH;
        unsigned* seam = ctl + CW_SEAM4 + 64 * args.breg;
        auto scan_wait = [&]() {
            asm volatile("s_waitcnt vmcnt(0)" ::: "memory"); __syncthreads();
            if (F.tid == 0) { const unsigned want = (unsigned)(F.G - nscan); unsigned sp = 0u;
                while (__hip_atomic_load(seam, RLX_AGENT) < want) { __builtin_amdgcn_s_sleep(2); if (++sp > (1u << 22)) break; }
                __builtin_amdgcn_fence(__ATOMIC_ACQUIRE, "agent"); asm volatile("s_waitcnt vmcnt(0)" ::: "memory"); }
            __syncthreads();
        };
        if ((int)blockIdx.x < nscan) phase_scan(F, scan_wait);
        else {
               phase_chunk(F, nscan, F.G - nscan, SCAN_SPLIT, 64 - SCAN_SPLIT);
               asm volatile("s_waitcnt vmcnt(0)" ::: "memory"); __syncthreads();
               if (F.tid == 0) { __builtin_amdgcn_fence(__ATOMIC_RELEASE, "agent"); asm volatile("s_waitcnt vmcnt(0)" ::: "memory"); __hip_atomic_fetch_add(seam, 1u, RLX_AGENT); }
               moe_weight_prep(F, nscan, MOE_PREP_SPLIT, MOE_PREP_ITEMS); } });
    RUNPH(5, phase_onorm(F));
    RUNPH(6, {
        ProbOut P; P.K = DM; P.RB = 2 * DM; P.S.init(NTOK / 256, DM / 256, F.G, (int)blockIdx.x);
        P.A = (const bf16*)(F.ws + WS_CONCAT); P.Bt = (const bf16*)(F.ws + WS_WOUT); P.X = (const bf16*)(F.ws + WS_XB); P.O = (bf16*)(F.ws + WS_X1);
        pg8::gemm_phase(F.lds, P); });
    RUNPH(7, phase_route(F));
    RUNPH(8, {
        ProbGU P; const int RT = moe_tables(F, P.T);
        P.K = DM; P.RB = DM; P.S.init(RT, 8, F.G, (int)blockIdx.x);
        P.A = F.ws + WS_X1B; P.Bt = F.ws + WS_WGU; P.O = F.ws + WS_ACT; P.list = (const int*)(F.ws + WS_LIST);
        P.rs2 = (const float*)(F.ws + WS_RSL); P.bgu = (const float*)(F.ws + WS_BGU);
        pg8::gemm_phase<ProbGU, true>(F.lds, P); });
    RUNPH(9, {
        ProbDown P; const int RT = moe_tables(F, P.T);
        P.K = DE; P.RB = DE; P.S.init(RT, 4, F.G, (int)blockIdx.x);
        P.A = F.ws + WS_ACT; P.Bt = F.ws + WS_WD; P.O = F.ws + WS_SLAB; P.list = (const int*)(F.ws + WS_LIST);
        P.gw = (const float*)(F.ws + WS_GWL); P.bd = F.in[16];
        pg8::gemm_phase<ProbDown, true>(F.lds, P); });
    RUNPH(10, phase_final(F, args.flag));
#undef RUNPH
#undef IN
#undef SEAM
}

extern "C" void kernel_launch(void* const* d_in, const int* in_sizes, int n_in, void* d_out, int out_size, void* d_ws, size_t ws_size, hipStream_t stream) {
    static int grid = 0;
    if (grid == 0) {
        if (n_in != 18 || in_sizes[0] != NTOK * DM || out_size != NTOK * DM || ws_size < WS_END) { fprintf(stderr, "kernel_launch: unexpected shapes (n_in %d, in0 %d, out %d, ws %zu)\n", n_in, n_in > 0 ? in_sizes[0] : -1, out_size, ws_size); grid = -1; return; }
        int dev = 0, cus = 0, per_cu = 0;
        if (hipGetDevice(&dev) != hipSuccess || hipDeviceGetAttribute(&cus, hipDeviceAttributeMultiprocessorCount, dev) != hipSuccess) { grid = -1; return; }
        if (hipFuncSetAttribute((const void*)mk_fwd, hipFuncAttributeMaxDynamicSharedMemorySize, LDS_BYTES) != hipSuccess) { fprintf(stderr, "kernel_launch: hipFuncSetAttribute failed\n"); grid = -1; return; }
        if (hipOccupancyMaxActiveBlocksPerMultiprocessor(&per_cu, (const void*)mk_fwd, NWAVES * 64, LDS_BYTES) != hipSuccess || per_cu < 1) { fprintf(stderr, "kernel_launch: occupancy query says %d\n", per_cu); per_cu = 1; }
        (void)hipGetLastError();
        grid = cus;
    }
    if (grid < 0) return;
    (void)hipMemsetAsync((char*)d_ws + WS_CTL, 0, CTL_ZERO_BYTES, stream);
    Args a{};
    for (int i = 0; i < 18; ++i) a.in[i] = (const float*)d_in[i];
    a.out = (float*)d_out; a.ws = (unsigned char*)d_ws;
#if MK_PER_PHASE
    for (int p = 0; p < NPHASE; ++p) { a.ph_lo = p; a.ph_hi = p + 1; const int nrep = 1 + REP_CNT * ((REP_MASK >> p) & 1);
        for (int r = 0; r < nrep; ++r) { a.flag = (p == NPHASE - 1 && r + 1 < nrep) ? 1 : 0; a.breg = r; hipLaunchKernelGGL(mk_fwd, dim3(grid), dim3(NWAVES * 64), LDS_BYTES, stream, a); } }
#else
    a.ph_lo = 0; a.ph_hi = NPHASE;
    hipLaunchKernelGGL(mk_fwd, dim3(grid), dim3(NWAVES * 64), LDS_BYTES, stream, a);
#endif
}
```

```cpp
#include <hip/hip_runtime.h>
#include <cstdio>
#include <cstdint>

#ifndef REP_MASK
#define REP_MASK 0
#endif
#ifndef REP_CNT
#define REP_CNT 1
#endif
#ifndef MK_PER_PHASE
#define MK_PER_PHASE 0
#endif

constexpr int NB = 8, SEQ = 4096, DM = 1024, NTOK = NB * SEQ;
constexpr int NH = 4, HD = 128, DDN = 512, DPOOL = 512, DIN = 2568, NPROJ = 2560;
constexpr int NE = 32, TOPK = 4, DE = 1024, NASSIGN = NTOK * TOPK;
constexpr int LISTCAP = NTOK;
constexpr int ACT_ROWS = NASSIGN + NE * 256;

constexpr size_t MiB = 1u << 20;
constexpr size_t WS_CTL = 0, CTL_ZERO_BYTES = 1 * MiB;
constexpr size_t WS_WIN = 1 * MiB;
constexpr size_t WS_WOUT = 6 * MiB;
constexpr size_t WS_WPOOL = 8 * MiB;
constexpr size_t WS_WR = 8 * MiB + 512 * 1024;
constexpr size_t WS_BGU = 8 * MiB + 768 * 1024;
constexpr size_t WS_RS1 = 9 * MiB;
constexpr size_t WS_BETA = 9 * MiB + 128 * 1024;
constexpr size_t WS_G = 9 * MiB + 640 * 1024;
constexpr size_t WS_RS2 = 10 * MiB + 256 * 1024;
constexpr size_t WS_GATEW = 10 * MiB + 512 * 1024;
constexpr size_t WS_LIST = 11 * MiB;
constexpr size_t WS_RSL = 800 * MiB;
constexpr size_t WS_GWL = 804 * MiB;
constexpr size_t WS_WGU = 16 * MiB;
constexpr size_t WS_WD = 144 * MiB;
constexpr size_t WS_XB = 208 * MiB;
constexpr size_t WS_PROJ = 272 * MiB;
constexpr size_t WS_CHUNK = 432 * MiB;
constexpr size_t WS_UC = 544 * MiB;
constexpr size_t WS_GTOT = 576 * MiB;
constexpr size_t WS_ORAW = 577 * MiB;
constexpr int CH_WF = 0, CH_QD = 16384, CH_KT = 32768, CH_QK = 49152, CH_BYTES = 57344, UC_BYTES = 16384;
constexpr size_t WS_MIXED = 688 * MiB;
constexpr size_t WS_CONCAT = 720 * MiB;
constexpr size_t WS_X1B = 208 * MiB;
constexpr size_t WS_ACT = 272 * MiB;
constexpr size_t WS_SLAB = 544 * MiB;
constexpr size_t WS_X1 = 808 * MiB;
constexpr size_t WS_END = 872 * MiB;
static_assert(WS_ACT + (size_t)ACT_ROWS * 2048 <= WS_SLAB, "act fits");
static_assert(WS_SLAB + (size_t)NASSIGN * 2048 <= WS_END, "slab fits");

constexpr int CW_BAR = 4096;
constexpr int CW_CNT = 16384;
constexpr int CW_SEAM4 = 20480;

constexpr int LDS_BYTES = 163840;
constexpr int LDSCTL_OFF = LDS_BYTES - 1024, MISC_OFF = LDSCTL_OFF + 320, TAB_OFF = LDSCTL_OFF + 512;
constexpr int NWAVES = 8;

#define GAS __attribute__((address_space(1)))
#define LAS __attribute__((address_space(3)))
typedef unsigned short bf16;
typedef unsigned v4u __attribute__((ext_vector_type(4)));
typedef unsigned v2u __attribute__((ext_vector_type(2)));
typedef float f32x4 __attribute__((ext_vector_type(4)));
typedef float f32x2 __attribute__((ext_vector_type(2)));
typedef short bf16x8 __attribute__((ext_vector_type(8)));
typedef GAS unsigned gu32;
#define RLX_AGENT __ATOMIC_RELAXED, __HIP_MEMORY_SCOPE_AGENT
#define LDS_WAIT() asm volatile("s_waitcnt lgkmcnt(0)" ::: "memory")
#define VM_WAIT() asm volatile("s_waitcnt vmcnt(0)" ::: "memory")

__device__ __forceinline__ unsigned f2bf(float f) { unsigned u = __builtin_bit_cast(unsigned, f); return (u + 0x7fffu + ((u >> 16) & 1u)) >> 16; }
__device__ __forceinline__ unsigned pk2(float lo, float hi) { return f2bf(lo) | (f2bf(hi) << 16); }
__device__ __forceinline__ float bflo(unsigned u) { return __builtin_bit_cast(float, u << 16); }
__device__ __forceinline__ float bfhi(unsigned u) { return __builtin_bit_cast(float, u & 0xffff0000u); }
__device__ __forceinline__ unsigned pk4_fp8(float a, float b, float c, float d) { int p = __builtin_amdgcn_cvt_pk_fp8_f32(a, b, 0, false); p = __builtin_amdgcn_cvt_pk_fp8_f32(c, d, p, true); return (unsigned)p; }
typedef float f32x2_t __attribute__((ext_vector_type(2)));
constexpr float SLAB_SCALE = 16.f, SLAB_INV = 1.f / 16.f;
constexpr float W8_SCALE = 32.f, W8_INV = 1.f / 32.f;
__device__ __forceinline__ float wave_sum(float v) {
#pragma unroll
    for (int o = 1; o < 64; o <<= 1) v += __shfl_xor(v, o);
    return v;
}
__device__ __forceinline__ float frcp_(float x) { return __builtin_amdgcn_rcpf(x); }
__device__ __forceinline__ float frsq_(float x) { return __builtin_amdgcn_rsqf(x); }
__device__ __forceinline__ float fexp_(float x) { return __builtin_amdgcn_exp2f(x * 1.4426950408889634f); }
__device__ __forceinline__ float sigmoidf_(float x) { return frcp_(1.f + fexp_(-x)); }
__device__ __forceinline__ float siluf_(float x) { return x * frcp_(1.f + fexp_(-x)); }

namespace pg8 {
constexpr int BM = 256, BK = 64, HALF = 128, HTB = HALF * BK * 2, STAGE_BYTES = 8 * HTB;
constexpr int EPI_TAB_OFF = STAGE_BYTES + 8192 + 4096, EPI_TAB_BYTES = 3072;
__device__ __forceinline__ int lds_byte(int r, int c) { const int st = (r >> 4) * 2 + (c >> 5), rr = r & 15, cc = c & 31, ob = rr * 64 + cc * 2; return st * 1024 + (ob ^ (((ob >> 9) & 1) << 5)); }
__device__ __forceinline__ void stage_rc(int b, int& R, int& C) { const int st = b / 1024, sb = b % 1024, swz = sb ^ (((sb >> 9) & 1) << 5); R = (st >> 1) * 16 + swz / 64; C = (st & 1) * 32 + (swz % 64) / 2; }
__device__ __forceinline__ int perm32(int rho) { const int n = rho >> 4, i = rho & 15; return 8 * (i >> 2) + 4 * n + (i & 3); }
typedef __bf16 bf16x2_t __attribute__((ext_vector_type(2)));
__device__ __forceinline__ unsigned cvt_pk_bf16(float lo, float hi) { const f32x2 v = {lo, hi}; const bf16x2_t b = __builtin_convertvector(v, bf16x2_t); return __builtin_bit_cast(unsigned, b); }

struct Unit { int rt, pn, e, rb, rows; };

struct Sched {
    int nM, nN, nwg, G, c;
    __device__ __forceinline__ void init(int nM_, int nN_, int G_, int c_) { nM = nM_; nN = nN_; nwg = nM * nN; G = G_; c = c_; }
    __device__ __forceinline__ bool next(int i, int& pm, int& pn) const {
        const long L = (long)i * G + c; if (L >= nwg) return false;
        int wgid = (int)L; { const int q = nwg / 8, r = nwg % 8, xcd = wgid % 8, off = wgid / 8; wgid = (xcd < r ? xcd * (q + 1) : r * (q + 1) + (xcd - r) * q) + off; }
        const int nig = 8 * nN, gid = wgid / nig, fm = gid * 8, gsz = (nM - fm) < 8 ? (nM - fm) : 8;
        pm = fm + ((wgid % nig) % gsz); pn = (wgid % nig) / gsz; return true;
    }
};

typedef int v8i_t __attribute__((ext_vector_type(8)));
template <class P, bool F8 = false>
__device__ __forceinline__ void gemm_phase(LAS unsigned char* lds, const P& p) {
    const int tid = threadIdx.x, wid = __builtin_amdgcn_readfirstlane(tid >> 6), lane = tid & 63, wr = wid >> 2, wc = wid & 3, fr = lane & 15, fq = lane >> 4;
    const int K = p.K, RB = F8 ? K : 2 * K, nt = RB / (BK * 2);
    unsigned voffB[2];
#pragma unroll
    for (int i = 0; i < 2; ++i) { int R_, C_; stage_rc(tid * 16 + i * 8192, R_, C_); const int Rb = (R_ & ~31) + perm32(R_ & 31); voffB[i] = (unsigned)(Rb * RB + C_ * 2); }
#define PG8_AOFF(unit, dst) do { int R[2], C[2]; asm volatile("" ::: "memory"); _Pragma("unroll") for (int i_ = 0; i_ < 2; ++i_) stage_rc(tid * 16 + i_ * 8192, R[i_], C[i_]); p.a_off(unit, R, C, dst); } while (0)
    const size_t kstep = (size_t)(BK * 2);
    const size_t hstep = (size_t)HALF * RB;
    const unsigned ldsw = (unsigned)wid * 1024u;
    const int aoff = lds_byte(wr * 64 + fr, fq * 8), boff = lds_byte(wc * 32 + fr, fq * 8);
#define PG8_SA(b, h) (((b) * 2 + (h)) * HTB)
#define PG8_SB(b, h) ((4 + (b) * 2 + (h)) * HTB)
#define PG8_STAGE(bufoff, gbase, voff) do { _Pragma("unroll") for (int _i = 0; _i < 2; ++_i) \
        __builtin_amdgcn_global_load_lds((const unsigned*)((const char*)(gbase) + (voff)[_i]), (LAS unsigned*)(lds + (bufoff) + ldsw + _i * 8192), 16, 0, 0); } while (0)
#define PG8_LDA(dst, b, h) do { _Pragma("unroll") for (int m = 0; m < 4; ++m) { const v4i_t l_ = *(const LAS v4i_t*)(lds + PG8_SA(b, h) + aoff + m * 2048), h_ = *(const LAS v4i_t*)(lds + PG8_SA(b, h) + aoff + m * 2048 + 1024); dst[m] = __builtin_shufflevector(l_, h_, 0, 1, 2, 3, 4, 5, 6, 7); } } while (0)
#define PG8_LDB(dst, b, h) do { _Pragma("unroll") for (int n = 0; n < 2; ++n) { const v4i_t l_ = *(const LAS v4i_t*)(lds + PG8_SB(b, h) + boff + n * 2048), h_ = *(const LAS v4i_t*)(lds + PG8_SB(b, h) + boff + n * 2048 + 1024); dst[n] = __builtin_shufflevector(l_, h_, 0, 1, 2, 3, 4, 5, 6, 7); } } while (0)
#define PG8_HALF(x, k) __builtin_bit_cast(bf16x8, __builtin_shufflevector(x, x, 4 * (k), 4 * (k) + 1, 4 * (k) + 2, 4 * (k) + 3))
#define PG8_MMA(ai, bj, At, Bt) do { __builtin_amdgcn_s_setprio(1); \
        if constexpr (F8) { _Pragma("unroll") for (int m = 0; m < 4; ++m) _Pragma("unroll") for (int n = 0; n < 2; ++n) \
            asm volatile("v_mfma_scale_f32_16x16x128_f8f6f4 %0, %1, %2, %0, %3, %3 op_sel_hi:[0,0,0]" : "+v"(acc[ai][bj][m][n]) : "v"(Bt[n]), "v"(At[m]), "v"(mxs)); } \
        else { _Pragma("unroll") for (int m = 0; m < 4; ++m) _Pragma("unroll") for (int n = 0; n < 2; ++n) { \
            acc[ai][bj][m][n] = __builtin_amdgcn_mfma_f32_16x16x32_bf16(PG8_HALF(Bt[n], 0), PG8_HALF(At[m], 0), acc[ai][bj][m][n], 0, 0, 0); \
            acc[ai][bj][m][n] = __builtin_amdgcn_mfma_f32_16x16x32_bf16(PG8_HALF(Bt[n], 1), PG8_HALF(At[m], 1), acc[ai][bj][m][n], 0, 0, 0); } } \
        __builtin_amdgcn_s_setprio(0); } while (0)
#define PG8_WAIT_V(n) asm volatile("s_waitcnt vmcnt(" #n ")" ::: "memory")
#define PG8_WAIT_L(n) asm volatile("s_waitcnt lgkmcnt(" #n ")" ::: "memory")
#define PG8_BAR __builtin_amdgcn_s_barrier()
#define PG8_SCHED __builtin_amdgcn_sched_barrier(0)
    Unit cur, nxt; int ui = 0;
    if (!p.next(0, cur)) return;
    unsigned mxs = 0x7f7f7f7fu; asm volatile("" : "+v"(mxs));
    f32x4 acc[2][2][4][2];
#pragma unroll
    for (int a = 0; a < 2; ++a)
#pragma unroll
        for (int b = 0; b < 2; ++b)
#pragma unroll
            for (int m = 0; m < 4; ++m)
#pragma unroll
                for (int n = 0; n < 2; ++n) acc[a][b][m][n] = (f32x4){0.f, 0.f, 0.f, 0.f};
    typedef int v4i_t __attribute__((ext_vector_type(4)));
    v8i_t At[4], B0[2], B1[2];
    unsigned oA[2][2];
    PG8_AOFF(cur, oA);
    const char* cA = p.a_base(cur); const char* cB = p.b_base(cur);
    PG8_STAGE(PG8_SB(0, 0), cB, voffB); PG8_STAGE(PG8_SB(0, 1), cB + hstep, voffB); PG8_STAGE(PG8_SA(0, 0), cA, oA[0]); PG8_STAGE(PG8_SA(0, 1), cA, oA[1]);
    if (wr == 1) PG8_BAR;
    PG8_WAIT_V(2); PG8_BAR;
    PG8_STAGE(PG8_SB(1, 0), cB + kstep, voffB); PG8_STAGE(PG8_SA(1, 0), cA + kstep, oA[0]); PG8_STAGE(PG8_SB(1, 1), cB + hstep + kstep, voffB);
    PG8_WAIT_V(6); PG8_BAR;
    LAS v4u* park = (LAS v4u*)(lds + STAGE_BYTES) + tid;
#define PG8_AIDX(unit, ent) do { int R[2], C[2]; asm volatile("" ::: "memory"); _Pragma("unroll") for (int i_ = 0; i_ < 2; ++i_) stage_rc(tid * 16 + i_ * 8192, R[i_], C[i_]); p.a_idx(unit, R, ent); } while (0)
#define PG8_AFIN(unit, ent, dst) do { int R[2], C[2]; asm volatile("" ::: "memory"); _Pragma("unroll") for (int i_ = 0; i_ < 2; ++i_) stage_rc(tid * 16 + i_ * 8192, R[i_], C[i_]); p.a_fin(unit, R, C, ent, dst); } while (0)
    Unit nn; int ent[2][2]; int ev[3];
    LAS unsigned char* etab = lds + EPI_TAB_OFF;
    p.e_idx(cur, tid, ev);
    bool has_next = p.next(1, nxt);
    if (has_next) PG8_AIDX(nxt, ent); else ent[0][0] = ent[0][1] = ent[1][0] = ent[1][1] = 0;
    for (;;) {
        const char* nA = cA; const char* nB = cB;
        p.e_put(etab + (ui & 1) * EPI_TAB_BYTES, tid, ev);
        { unsigned nO[2][2];
#pragma unroll
          for (int h = 0; h < 2; ++h)
#pragma unroll
              for (int i = 0; i < 2; ++i) nO[h][i] = oA[h][i];
          if (has_next) { nA = p.a_base(nxt); nB = p.b_base(nxt); PG8_AFIN(nxt, ent, nO); }
          *park = (v4u){nO[0][0], nO[0][1], nO[1][0], nO[1][1]}; }
        for (int t = 0; t < nt; t += 2) {
            const bool last = (t == nt - 2);
            const char* a1 = cA + (size_t)(t + 1) * kstep;
            const char* a2 = last ? nA : cA + (size_t)(t + 2) * kstep; const char* b2 = last ? nB : cB + (size_t)(t + 2) * kstep;
            const char* a3 = a2 + kstep; const char* b3 = b2 + kstep;
            unsigned o2[2][2];
#pragma unroll
            for (int h = 0; h < 2; ++h)
#pragma unroll
                for (int i = 0; i < 2; ++i) o2[h][i] = oA[h][i];
            if (last) { const v4u q_ = *park; o2[0][0] = q_.x; o2[0][1] = q_.y; o2[1][0] = q_.z; o2[1][1] = q_.w; }
            PG8_LDB(B0, 0, 0); PG8_LDB(B1, 0, 1); PG8_SCHED; PG8_LDA(At, 0, 0); PG8_STAGE(PG8_SA(1, 1), a1, oA[1]);
            PG8_WAIT_V(8); PG8_WAIT_L(0); PG8_BAR; PG8_MMA(0, 0, At, B0); PG8_MMA(0, 1, At, B1); PG8_BAR; PG8_SCHED;
            PG8_LDA(At, 0, 1); PG8_STAGE(PG8_SB(0, 0), b2, voffB); PG8_STAGE(PG8_SB(0, 1), b2 + hstep, voffB); PG8_STAGE(PG8_SA(0, 0), a2, o2[0]);
            PG8_WAIT_V(8); PG8_WAIT_L(0); PG8_BAR; PG8_MMA(1, 0, At, B0); PG8_MMA(1, 1, At, B1); PG8_BAR; PG8_SCHED;
            PG8_LDB(B0, 1, 0); PG8_LDB(B1, 1, 1); PG8_SCHED; PG8_LDA(At, 1, 0); PG8_STAGE(PG8_SA(0, 1), a2, o2[1]);
            PG8_WAIT_V(8); PG8_WAIT_L(0); PG8_BAR; PG8_MMA(0, 0, At, B0); PG8_MMA(0, 1, At, B1); PG8_BAR; PG8_SCHED;
            PG8_LDA(At, 1, 1); PG8_STAGE(PG8_SB(1, 0), b3, voffB); PG8_STAGE(PG8_SB(1, 1), b3 + hstep, voffB); PG8_STAGE(PG8_SA(1, 0), a3, o2[0]);
            PG8_WAIT_V(8); PG8_WAIT_L(0); PG8_BAR; PG8_MMA(1, 0, At, B0); PG8_MMA(1, 1, At, B1); PG8_BAR; PG8_SCHED;
        }
        const bool has_nn = has_next && p.next(ui + 2, nn);
        if (has_nn) PG8_AIDX(nn, ent);
        if (has_next) p.e_idx(nxt, tid, ev);
        if (wr == 0) PG8_BAR;
        if constexpr (F8) asm volatile("s_nop 15\n\ts_nop 15" ::: "memory");
        p.epi(acc, cur, wr, wc, fr, fq, etab + (ui & 1) * EPI_TAB_BYTES);
        if (!has_next) break;
#pragma unroll
        for (int a = 0; a < 2; ++a)
#pragma unroll
            for (int b = 0; b < 2; ++b)
#pragma unroll
                for (int m = 0; m < 4; ++m)
#pragma unroll
                    for (int n = 0; n < 2; ++n) acc[a][b][m][n] = (f32x4){0.f, 0.f, 0.f, 0.f};
        cur = nxt; nxt = nn; has_next = has_nn; cA = nA; cB = nB; ++ui;
        { const v4u q_ = *park; oA[0][0] = q_.x; oA[0][1] = q_.y; oA[1][0] = q_.z; oA[1][1] = q_.w; }
        if (wr == 1) PG8_BAR;
    }
    PG8_WAIT_V(0);
    PG8_BAR;
#undef PG8_SA
#undef PG8_SB
#undef PG8_STAGE
#undef PG8_LDA
#undef PG8_LDB
#undef PG8_MMA
#undef PG8_HALF
#undef PG8_AOFF
#undef PG8_AIDX
#undef PG8_AFIN
#undef PG8_WAIT_V
#undef PG8_WAIT_L
#undef PG8_BAR
#undef PG8_SCHED
}
}

#define XB_TMO      128
#define XB_XCNT(j)  (256  + 64 * (j))
#define XB_XSUB(j)  (1280 + 64 * (j))
#define XB_XGEN(j)  (2304 + 64 * (j))
#define XB_TOP      3328
#define XB_TOPGEN   3392
#define XCD_BAR_WORDS 3456
#define XB_SPIN_CAP (1u << 18)
__device__ __forceinline__ unsigned xb_ld(unsigned* p)              { return __hip_atomic_load(p, __ATOMIC_RELAXED, __HIP_MEMORY_SCOPE_AGENT); }
__device__ __forceinline__ unsigned xb_add(unsigned* p, unsigned v) { return __hip_atomic_fetch_add(p, v, __ATOMIC_RELAXED, __HIP_MEMORY_SCOPE_AGENT); }
__device__ __forceinline__ unsigned xb_xcc_id() { return (unsigned)__builtin_amdgcn_s_getreg((3 << 11) | 20) & 0xFu; }
#define XB_SPIN(cond, bar) do { unsigned _sp = 0; while (cond) { __builtin_amdgcn_s_sleep(1); \
    if ((++_sp & 255u) == 0u) { if (xb_ld(&(bar)[XB_TMO])) break; if (_sp > XB_SPIN_CAP) { atomicAdd(&(bar)[XB_TMO], 1u); break; } } } } while (0)
struct XcdBarrier { unsigned* bar; unsigned x; volatile LAS unsigned* st; };
__device__ __forceinline__ XcdBarrier xcd_barrier_post(unsigned* bar, volatile LAS unsigned* st) {
    XcdBarrier b; b.bar = bar; b.x = xb_xcc_id(); b.st = st;
    if (threadIdx.x == 0) (void)xb_add(&bar[XB_XCNT(b.x)], 1u);
    return b;
}
__device__ __forceinline__ void xcd_barrier_complete(unsigned* bar, unsigned x, unsigned& nloc, unsigned& nx) {
    const unsigned G = gridDim.x * gridDim.y * gridDim.z;
    unsigned sum, cnt, mine, sp = 0u;
    for (;;) {
        sum = 0u; cnt = 0u; mine = 0u;
#pragma unroll
        for (unsigned j = 0; j < 16; ++j) { const unsigned c = xb_ld(&bar[XB_XCNT(j)]); sum += c; cnt += (c > 0u) ? 1u : 0u; mine = (j == x) ? c : mine; }
        if (sum == G) break;
        __builtin_amdgcn_s_sleep(1);
        if ((++sp & 255u) == 0u) { if (xb_ld(&bar[XB_TMO])) break; if (sp > XB_SPIN_CAP) { atomicAdd(&bar[XB_TMO], 1u); break; } }
    }
    nloc = mine > 0u ? mine : 1u; nx = cnt > 0u ? cnt : 1u;
}
__device__ __forceinline__ void xcd_barrier(const XcdBarrier& b) {
    asm volatile("s_waitcnt vmcnt(0)" ::: "memory");
    __syncthreads();
    if (threadIdx.x == 0) {
        unsigned* bar = b.bar;
        __builtin_amdgcn_s_waitcnt(0);
        unsigned nloc = b.st[0], nx = b.st[1];
        if (nloc == 0u) { xcd_barrier_complete(bar, b.x, nloc, nx); b.st[0] = nloc; b.st[1] = nx; }
        const unsigned old = xb_add(&bar[XB_XSUB(b.x)], 1u);
        const unsigned gen = old / nloc;
        if (old + 1u == (gen + 1u) * nloc) {
            __builtin_amdgcn_fence(__ATOMIC_RELEASE, "agent");
            asm volatile("s_waitcnt vmcnt(0)" ::: "memory");
            const unsigned og = xb_add(&bar[XB_TOP], 1u);
            const unsigned tg = og / nx;
            if (og + 1u == (tg + 1u) * nx) xb_add(&bar[XB_TOPGEN], 1u);
            else XB_SPIN(xb_ld(&bar[XB_TOPGEN]) == tg, bar);
            __builtin_amdgcn_fence(__ATOMIC_ACQUIRE, "agent");
            xb_add(&bar[XB_XGEN(b.x)], 1u);
            asm volatile("s_waitcnt vmcnt(0)" ::: "memory");
        } else {
            XB_SPIN(xb_ld(&bar[XB_XGEN(b.x)]) == gen, bar);
            __builtin_amdgcn_fence(__ATOMIC_ACQUIRE, "agent");
            asm volatile("s_waitcnt vmcnt(0)" ::: "memory");
        }
    }
    __syncthreads();
}

struct Frame {
    LAS unsigned char* lds;
    int tid, lane, wave, vcu, G;
    const float* in[18];
    float* out;
    unsigned char* ws;
};
using pg8::Unit;
using pg8::cvt_pk_bf16;

struct ProbBase {
    int K; int RB; pg8::Sched S;
    __device__ __forceinline__ void e_idx(const Unit&, int, int (&ev)[3]) const { ev[0] = ev[1] = ev[2] = 0; }
    __device__ __forceinline__ void e_put(LAS unsigned char*, int, const int (&)[3]) const {}
    __device__ __forceinline__ void a_idx(const Unit&, const int (&)[2], int (&ent)[2][2]) const { ent[0][0] = ent[0][1] = ent[1][0] = ent[1][1] = 0; }
    __device__ __forceinline__ void a_fin(const Unit&, const int (&R)[2], const int (&C)[2], const int (&)[2][2], unsigned (&off)[2][2]) const { lin_off(R, C, off); }
    __device__ __forceinline__ void lin_off(const int (&R)[2], const int (&C)[2], unsigned (&off)[2][2]) const {
#pragma unroll
        for (int h = 0; h < 2; ++h)
#pragma unroll
            for (int i = 0; i < 2; ++i) off[h][i] = (unsigned)((h * 128 + R[i]) * RB + C[i] * 2);
    }
};
struct ProbIn : ProbBase {
    const bf16* A; const bf16* Bt; bf16* O; const float* rs;
    __device__ __forceinline__ bool next(int i, Unit& u) const { int pm, pn; if (!S.next(i, pm, pn)) return false; u.rt = pm; u.pn = pn; u.e = 0; u.rb = pm; u.rows = 256; return true; }
    __device__ __forceinline__ const char* a_base(const Unit& u) const { return (const char*)A + (size_t)u.rt * 256 * RB; }
    __device__ __forceinline__ const char* b_base(const Unit& u) const { return (const char*)Bt + (size_t)u.pn * 256 * RB; }
    __device__ __forceinline__ void a_off(const Unit&, const int (&R)[2], const int (&C)[2], unsigned (&off)[2][2]) const { lin_off(R, C, off); }
    __device__ __forceinline__ void e_idx(const Unit& u, int tid, int (&ev)[3]) const { ev[0] = (tid < 256) ? __float_as_int(rs[u.rt * 256 + tid]) : 0; ev[1] = ev[2] = 0; }
    __device__ __forceinline__ void e_put(LAS unsigned char* et, int tid, const int (&ev)[3]) const { if (tid < 256) *(LAS int*)(et + tid * 8) = ev[0]; }
    __device__ __forceinline__ void epi(const f32x4 (&acc)[2][2][4][2], const Unit& u, int wr, int wc, int fr, int fq, const LAS unsigned char* et) const {
        const int row0 = u.rt * 256 + wr * 64 + fr, col0 = u.pn * 256 + wc * 32 + 8 * fq;
#pragma unroll
        for (int ai = 0; ai < 2; ++ai)
#pragma unroll
            for (int m = 0; m < 4; ++m) { const int row = row0 + ai * 128 + m * 16; const float sc = *(const LAS float*)(et + (ai * 128 + wr * 64 + m * 16 + fr) * 8); bf16* rowp = O + (size_t)row * NPROJ + col0;
#pragma unroll
                for (int bj = 0; bj < 2; ++bj) { const f32x4 v0 = acc[ai][bj][m][0] * sc, v1 = acc[ai][bj][m][1] * sc; v4u w;
                    w.x = cvt_pk_bf16(v0[0], v0[1]); w.y = cvt_pk_bf16(v0[2], v0[3]); w.z = cvt_pk_bf16(v1[0], v1[1]); w.w = cvt_pk_bf16(v1[2], v1[3]);
                    *(v4u*)(rowp + bj * 128) = w; } }
    }
};
struct ProbPool : ProbBase {
    const bf16* A; const bf16* Bt; bf16* O;
    __device__ __forceinline__ bool next(int i, Unit& u) const { int pm, pn; if (!S.next(i, pm, pn)) return false; u.rt = pm; u.pn = pn; u.e = 0; u.rb = pm; u.rows = 256; return true; }
    __device__ __forceinline__ const char* a_base(const Unit& u) const { return (const char*)A + (size_t)u.rt * 256 * RB; }
    __device__ __forceinline__ const char* b_base(const Unit& u) const { return (const char*)Bt + (size_t)u.pn * 256 * RB; }
    __device__ __forceinline__ void a_off(const Unit&, const int (&R)[2], const int (&C)[2], unsigned (&off)[2][2]) const { lin_off(R, C, off); }
    __device__ __forceinline__ void epi(const f32x4 (&acc)[2][2][4][2], const Unit& u, int wr, int wc, int fr, int fq, const LAS unsigned char* et) const {
        const int row0 = u.rt * 256 + wr * 64 + fr, col0 = 512 + u.pn * 256 + wc * 32 + 8 * fq;
#pragma unroll
        for (int ai = 0; ai < 2; ++ai)
#pragma unroll
            for (int m = 0; m < 4; ++m) { const int row = row0 + ai * 128 + m * 16; bf16* rowp = O + (size_t)row * DM + col0;
#pragma unroll
                for (int bj = 0; bj < 2; ++bj) { const f32x4 v0 = acc[ai][bj][m][0], v1 = acc[ai][bj][m][1]; v4u w;
                    w.x = cvt_pk_bf16(v0[0], v0[1]); w.y = cvt_pk_bf16(v0[2], v0[3]); w.z = cvt_pk_bf16(v1[0], v1[1]); w.w = cvt_pk_bf16(v1[2], v1[3]);
                    *(v4u*)(rowp + bj * 128) = w; } }
    }
};
struct ProbOut : ProbBase {
    const bf16* A; const bf16* Bt; const bf16* X; bf16* O;
    __device__ __forceinline__ bool next(int i, Unit& u) const { int pm, pn; if (!S.next(i, pm, pn)) return false; u.rt = pm; u.pn = pn; u.e = 0; u.rb = pm; u.rows = 256; return true; }
    __device__ __forceinline__ const char* a_base(const Unit& u) const { return (const char*)A + (size_t)u.rt * 256 * RB; }
    __device__ __forceinline__ const char* b_base(const Unit& u) const { return (const char*)Bt + (size_t)u.pn * 256 * RB; }
    __device__ __forceinline__ void a_off(const Unit&, const int (&R)[2], const int (&C)[2], unsigned (&off)[2][2]) const { lin_off(R, C, off); }
    __device__ __forceinline__ void epi(const f32x4 (&acc)[2][2][4][2], const Unit& u, int wr, int wc, int fr, int fq, const LAS unsigned char* et) const {
        const int row0 = u.rt * 256 + wr * 64 + fr, col0 = u.pn * 256 + wc * 32 + 8 * fq;
#pragma unroll
        for (int ai = 0; ai < 2; ++ai)
#pragma unroll
            for (int m = 0; m < 4; ++m) { const size_t off = (size_t)(row0 + ai * 128 + m * 16) * DM + col0;
#pragma unroll
                for (int bj = 0; bj < 2; ++bj) { const v4u xv = *(const v4u*)(X + off + bj * 128); const f32x4 a = acc[ai][bj][m][0], b = acc[ai][bj][m][1];
                    *(v4u*)(O + off + bj * 128) = (v4u){cvt_pk_bf16(bflo(xv.x) + a.x, bfhi(xv.x) + a.y), cvt_pk_bf16(bflo(xv.y) + a.z, bfhi(xv.y) + a.w),
                                                        cvt_pk_bf16(bflo(xv.z) + b.x, bfhi(xv.z) + b.y), cvt_pk_bf16(bflo(xv.w) + b.z, bfhi(xv.w) + b.w)}; } }
    }
};
struct MoeTab { const LAS int* pref; const LAS int* cnt; const LAS int* tile; };
__device__ __forceinline__ void moe_decode(const MoeTab& T, int rt, Unit& u) {
    const int w = T.tile[rt];
    u.e = w >> 24; u.rb = (w >> 12) & 0xfff; u.rows = w & 0xfff;
}
struct ProbGU : ProbBase {
    MoeTab T; const unsigned char* A; const unsigned char* Bt; unsigned char* O; const int* list; const float* rs2; const float* bgu;
    __device__ __forceinline__ bool next(int i, Unit& u) const { int pm, pn; if (!S.next(i, pm, pn)) return false; u.rt = pm; u.pn = pn; moe_decode(T, pm, u); return true; }
    __device__ __forceinline__ const char* a_base(const Unit&) const { return (const char*)A; }
    __device__ __forceinline__ const char* b_base(const Unit& u) const { return (const char*)Bt + ((size_t)u.e * 2048 + (size_t)u.pn * 256) * RB; }
    __device__ __forceinline__ void a_off(const Unit& u, const int (&R)[2], const int (&C)[2], unsigned (&off)[2][2]) const { int ent[2][2]; a_idx(u, R, ent); a_fin(u, R, C, ent, off); }
    __device__ __forceinline__ void e_idx(const Unit& u, int tid, int (&ev)[3]) const {
        if (tid < 256) { ev[0] = __float_as_int(rs2[(size_t)u.e * LISTCAP + u.rb * 256 + tid]); ev[1] = __float_as_int(bgu[(size_t)u.e * 2048 + u.pn * 256 + tid]); } else { ev[0] = ev[1] = 0; } ev[2] = 0; }
    __device__ __forceinline__ void e_put(LAS unsigned char* et, int tid, const int (&ev)[3]) const { if (tid < 256) { *(LAS int*)(et + tid * 8) = ev[0]; *(LAS int*)(et + 2048 + tid * 4) = ev[1]; } }
    __device__ __forceinline__ void a_idx(const Unit& u, const int (&R)[2], int (&ent)[2][2]) const {
        const int* lp = list + (size_t)u.e * LISTCAP + u.rb * 256;
#pragma unroll
        for (int h = 0; h < 2; ++h)
#pragma unroll
            for (int i = 0; i < 2; ++i) { const int r = h * 128 + R[i]; ent[h][i] = (r < u.rows) ? lp[r] : 0; }
    }
    __device__ __forceinline__ void a_fin(const Unit&, const int (&)[2], const int (&C)[2], const int (&ent)[2][2], unsigned (&off)[2][2]) const {
#pragma unroll
        for (int h = 0; h < 2; ++h)
#pragma unroll
            for (int i = 0; i < 2; ++i) off[h][i] = (unsigned)(ent[h][i] >> 2) * (unsigned)RB + (unsigned)C[i] * 2u;
    }
    __device__ __forceinline__ void epi(const f32x4 (&acc)[2][2][4][2], const Unit& u, int wr, int wc, int fr, int fq, const LAS unsigned char* et) const {
        const int j0 = wc * 32 + 8 * fq;
        const LAS float* bg = (const LAS float*)(et + 2048) + j0;
        f32x4 bgv[2], buv[2];
#pragma unroll
        for (int n = 0; n < 2; ++n) { bgv[n] = *(const LAS f32x4*)(bg + 4 * n); buv[n] = *(const LAS f32x4*)(bg + 128 + 4 * n); }
#pragma unroll
        for (int ai = 0; ai < 2; ++ai)
#pragma unroll
            for (int m = 0; m < 4; ++m) { const int r = ai * 128 + wr * 64 + m * 16 + fr;
                if (r < u.rows) { const float sc = *(const LAS float*)(et + r * 8) * W8_INV; const f32x2_t sc2 = (f32x2_t){sc, sc}; unsigned w[2];
#pragma unroll
                    for (int n = 0; n < 2; ++n) { f32x2_t a2[2];
#pragma unroll
                        for (int qp = 0; qp < 2; ++qp) {
                            f32x2_t gt = (f32x2_t){acc[ai][0][m][n][2 * qp], acc[ai][0][m][n][2 * qp + 1]} * sc2 + (f32x2_t){bgv[n][2 * qp], bgv[n][2 * qp + 1]};
                            f32x2_t up = (f32x2_t){acc[ai][1][m][n][2 * qp], acc[ai][1][m][n][2 * qp + 1]} * sc2 + (f32x2_t){buv[n][2 * qp], buv[n][2 * qp + 1]};
                            gt.x = fminf(gt.x, 7.f); gt.y = fminf(gt.y, 7.f); up.x = fminf(fmaxf(up.x, -7.f), 7.f); up.y = fminf(fmaxf(up.y, -7.f), 7.f);
                            const f32x2_t ex = gt * (f32x2_t){-1.702f * 1.4426950408889634f, -1.702f * 1.4426950408889634f};
                            const f32x2_t dn = (f32x2_t){__builtin_amdgcn_exp2f(ex.x), __builtin_amdgcn_exp2f(ex.y)} + (f32x2_t){1.f, 1.f};
                            a2[qp] = (up + (f32x2_t){1.f, 1.f}) * gt * (f32x2_t){frcp_(dn.x), frcp_(dn.y)}; }
                        w[n] = pk4_fp8(a2[0].x, a2[0].y, a2[1].x, a2[1].y); }
                    *(v2u*)(O + (size_t)(u.rt * 256 + r) * DE + u.pn * 128 + j0) = (v2u){w[0], w[1]}; } }
    }
};
struct ProbDown : ProbBase {
    MoeTab T; const unsigned char* A; const unsigned char* Bt; unsigned char* O; const int* list; const float* gw; const float* bd;
    __device__ __forceinline__ bool next(int i, Unit& u) const { int pm, pn; if (!S.next(i, pm, pn)) return false; u.rt = pm; u.pn = pn; moe_decode(T, pm, u); return true; }
    __device__ __forceinline__ const char* a_base(const Unit& u) const { return (const char*)A + (size_t)u.rt * 256 * RB; }
    __device__ __forceinline__ const char* b_base(const Unit& u) const { return (const char*)Bt + ((size_t)u.e * 1024 + (size_t)u.pn * 256) * RB; }
    __device__ __forceinline__ void a_off(const Unit&, const int (&R)[2], const int (&C)[2], unsigned (&off)[2][2]) const { lin_off(R, C, off); }
    __device__ __forceinline__ void e_idx(const Unit& u, int tid, int (&ev)[3]) const {
        if (tid < 256) { const size_t pos = (size_t)u.e * LISTCAP + u.rb * 256 + tid; ev[0] = list[pos]; ev[1] = __float_as_int(gw[pos]); ev[2] = __float_as_int(bd[(size_t)u.e * DM + u.pn * 256 + tid]); } else { ev[0] = ev[1] = ev[2] = 0; } }
    __device__ __forceinline__ void e_put(LAS unsigned char* et, int tid, const int (&ev)[3]) const { if (tid < 256) { *(LAS v2u*)(et + tid * 8) = (v2u){(unsigned)ev[0], (unsigned)ev[1]}; *(LAS int*)(et + 2048 + tid * 4) = ev[2]; } }
    __device__ __forceinline__ void epi(const f32x4 (&acc)[2][2][4][2], const Unit& u, int wr, int wc, int fr, int fq, const LAS unsigned char* et) const {
        const int c0 = u.pn * 256 + wc * 32 + 8 * fq;
        const LAS float* bp = (const LAS float*)(et + 2048) + wc * 32 + 8 * fq;
        f32x4 bv[2][2];
#pragma unroll
        for (int bj = 0; bj < 2; ++bj)
#pragma unroll
            for (int n = 0; n < 2; ++n) bv[bj][n] = *(const LAS f32x4*)(bp + bj * 128 + 4 * n);
#pragma unroll
        for (int ai = 0; ai < 2; ++ai)
#pragma unroll
            for (int m = 0; m < 4; ++m) { const int r = ai * 128 + wr * 64 + m * 16 + fr;
                if (r < u.rows) { const v2u eg = *(const LAS v2u*)(et + r * 8); const int ent = (int)eg.x; const float g = __uint_as_float(eg.y); unsigned char* rowp = O + (size_t)ent * DM + c0;
#pragma unroll
                    for (int bj = 0; bj < 2; ++bj) { const f32x4 v0 = (acc[ai][bj][m][0] * W8_INV + bv[bj][0]) * g, v1 = (acc[ai][bj][m][1] * W8_INV + bv[bj][1]) * g;
                        *(v2u*)(rowp + bj * 128) = (v2u){pk4_fp8(v0[0] * SLAB_SCALE, v0[1] * SLAB_SCALE, v0[2] * SLAB_SCALE, v0[3] * SLAB_SCALE), pk4_fp8(v1[0] * SLAB_SCALE, v1[1] * SLAB_SCALE, v1[2] * SLAB_SCALE, v1[3] * SLAB_SCALE)}; } } }
    }
};

typedef short v4i16_t __attribute__((ext_vector_type(4)));
__device__ __forceinline__ void tr_item(const float* W, int ldw, int k0, int nsrc0, bf16* WT, size_t drow0, int ldk, int dk0, const float* ks, const float* ns, LAS unsigned char* scr, int lane) {
    const int kr = lane >> 4, n4 = (lane & 15) * 4;
    f32x4 nsc = (f32x4){1.f, 1.f, 1.f, 1.f}; if (ns) nsc = *(const f32x4*)(ns + nsrc0 + n4);
    f32x4 v[16];
#pragma unroll
    for (int i = 0; i < 16; ++i) v[i] = *(const f32x4*)(W + (size_t)(k0 + 4 * i + kr) * ldw + nsrc0 + n4);
#pragma unroll
    for (int i = 0; i < 16; ++i) { f32x4 x = v[i] * nsc; if (ks) x = x * ks[k0 + 4 * i + kr];
        *(LAS v2u*)(scr + (4 * i + kr) * 192 + n4 * 2) = (v2u){pg8::cvt_pk_bf16(x.x, x.y), pg8::cvt_pk_bf16(x.z, x.w)}; }
    LDS_WAIT(); asm volatile("" ::: "memory");
    const int G = lane >> 4, li = lane & 15, q = li >> 2, p = li & 3;
    const LAS unsigned char* rb = scr + q * 192 + (16 * G + 4 * p) * 2;
    bf16* dst = WT + (drow0 + 16 * G + li) * (size_t)ldk + dk0 + k0;
#pragma unroll
    for (int kc = 0; kc < 8; ++kc) {
        const v4i16_t lo = __builtin_amdgcn_ds_read_tr16_b64_v4i16((LAS v4i16_t*)(rb + (8 * kc) * 192));
        const v4i16_t hi = __builtin_amdgcn_ds_read_tr16_b64_v4i16((LAS v4i16_t*)(rb + (8 * kc + 4) * 192));
        const v2u l2 = __builtin_bit_cast(v2u, lo), h2 = __builtin_bit_cast(v2u, hi);
        *(v4u*)(dst + 8 * kc) = (v4u){l2.x, l2.y, h2.x, h2.y};
    }
    LDS_WAIT(); asm volatile("" ::: "memory");
}

template <int KT, int NT>
__device__ __forceinline__ void tr_item8(const float* W, int ldw, int k0, int nsrc0, unsigned char* WT, size_t drow0, int ldk, const float* ks, float mul, LAS unsigned char* scr, int lane) {
    constexpr int LPR = NT / 4, RPL = 64 / LPR, PA = NT * 2 + 64;
    static_assert(KT * NT == 4096 && (PA / 4) % 32 == 16, "tile geometry");
    const int kr = lane / LPR, n4 = (lane % LPR) * 4;
    f32x4 v[16];
#pragma unroll
    for (int i = 0; i < 16; ++i) v[i] = *(const f32x4*)(W + (size_t)(k0 + RPL * i + kr) * ldw + nsrc0 + n4);
#pragma unroll
    for (int i = 0; i < 16; ++i) { const float sc = ks ? ks[k0 + RPL * i + kr] * mul : mul; const f32x4 x = v[i] * sc;
        *(LAS v2u*)(scr + (RPL * i + kr) * PA + n4 * 2) = (v2u){pg8::cvt_pk_bf16(x.x, x.y), pg8::cvt_pk_bf16(x.z, x.w)}; }
    LDS_WAIT(); asm volatile("" ::: "memory");
    const int G = lane >> 4, li = lane & 15, q = li >> 2, p = li & 3;
#pragma unroll
    for (int ps = 0; ps < NT / 64; ++ps) {
        const LAS unsigned char* rb = scr + q * PA + (16 * (G + 4 * ps) + 4 * p) * 2;
        unsigned char* dst = WT + (drow0 + 16 * (G + 4 * ps) + li) * (size_t)ldk + k0;
#pragma unroll
        for (int kq = 0; kq < KT / 16; ++kq) {
            v2u t[4];
#pragma unroll
            for (int u = 0; u < 4; ++u) t[u] = __builtin_bit_cast(v2u, __builtin_amdgcn_ds_read_tr16_b64_v4i16((LAS v4i16_t*)(rb + (16 * kq + 4 * u) * PA)));
            v4u o;
            o.x = pk4_fp8(bflo(t[0].x), bfhi(t[0].x), bflo(t[0].y), bfhi(t[0].y)); o.y = pk4_fp8(bflo(t[1].x), bfhi(t[1].x), bflo(t[1].y), bfhi(t[1].y));
            o.z = pk4_fp8(bflo(t[2].x), bfhi(t[2].x), bflo(t[2].y), bfhi(t[2].y)); o.w = pk4_fp8(bflo(t[3].x), bfhi(t[3].x), bflo(t[3].y), bfhi(t[3].y));
            *(v4u*)(dst + 16 * kq) = o;
        }
    }
    LDS_WAIT(); asm volatile("" ::: "memory");
}

constexpr int TRF_T1 = 128 * 192, TRF_T2 = 64 * 144, TRF_BYTES = TRF_T1 + TRF_T2;
__device__ __forceinline__ void tr_item8f(const float* W, int ldw, int k0, int nsrc0, unsigned char* WT, size_t drow0, int ldk, const float* ks, float mul, LAS unsigned char* scr, int lane) {
    const int kr = lane >> 4, n4 = (lane & 15) * 4;
#pragma unroll
    for (int hb = 0; hb < 2; ++hb) {
        f32x4 v[16];
#pragma unroll
        for (int i = 0; i < 16; ++i) v[i] = __builtin_nontemporal_load((const f32x4*)(W + (size_t)(k0 + 64 * hb + 4 * i + kr) * ldw + nsrc0 + n4));
#pragma unroll
        for (int i = 0; i < 16; ++i) { const float sc = ks ? ks[k0 + 64 * hb + 4 * i + kr] * mul : mul; const f32x4 x = v[i] * sc;
            *(LAS v2u*)(scr + (64 * hb + 4 * i + kr) * 192 + n4 * 2) = (v2u){pg8::cvt_pk_bf16(x.x, x.y), pg8::cvt_pk_bf16(x.z, x.w)}; }
    }
    LDS_WAIT(); asm volatile("" ::: "memory");
    const int G = lane >> 4, li = lane & 15, q = li >> 2, p = li & 3;
    const LAS unsigned char* rb = scr + q * 192 + (16 * G + 4 * p) * 2;
    LAS unsigned char* t2 = scr + TRF_T1;
#pragma unroll
    for (int kq = 0; kq < 8; ++kq) {
        v2u t[4];
#pragma unroll
        for (int u = 0; u < 4; ++u) t[u] = __builtin_bit_cast(v2u, __builtin_amdgcn_ds_read_tr16_b64_v4i16((LAS v4i16_t*)(rb + (16 * kq + 4 * u) * 192)));
        v4u o;
        o.x = pk4_fp8(bflo(t[0].x), bfhi(t[0].x), bflo(t[0].y), bfhi(t[0].y)); o.y = pk4_fp8(bflo(t[1].x), bfhi(t[1].x), bflo(t[1].y), bfhi(t[1].y));
        o.z = pk4_fp8(bflo(t[2].x), bfhi(t[2].x), bflo(t[2].y), bfhi(t[2].y)); o.w = pk4_fp8(bflo(t[3].x), bfhi(t[3].x), bflo(t[3].y), bfhi(t[3].y));
        *(LAS v4u*)(t2 + (16 * G + li) * 144 + 16 * kq) = o;
    }
    LDS_WAIT(); asm volatile("" ::: "memory");
    const int r8 = lane >> 3, c8 = lane & 7;
#pragma unroll
    for (int j = 0; j < 8; ++j) { const v4u o = *(const LAS v4u*)(t2 + (8 * j + r8) * 144 + 16 * c8);
        __builtin_nontemporal_store(o, (v4u*)(WT + (drow0 + 8 * j + r8) * (size_t)ldk + k0 + 16 * c8)); }
    LDS_WAIT(); asm volatile("" ::: "memory");
}

constexpr int TRK = 128, TRN = 64;
constexpr int MOE_PREP_ITEMS = 32 * (1024 / TRK) * (2048 / TRN) + 32 * (1024 / TRK) * (1024 / TRN);
__device__ __forceinline__ void moe_weight_prep(Frame& F, int b0, int lo, int hi) {
    const float* fnw = F.in[10]; const float* w_gu = F.in[13]; const float* w_d = F.in[15];
    unsigned char* WguT = F.ws + WS_WGU; unsigned char* WdT = F.ws + WS_WD;
    constexpr int TW = 4;
    if (F.wave >= TW) return;
    LAS unsigned char* scr = F.lds + F.wave * TRF_BYTES;
    const int gw = ((int)blockIdx.x - b0) * TW + F.wave, NGW = (F.G - b0) * TW;
    constexpr int NKB = 1024 / TRK, NNB_GU = 2048 / TRN, NNB_D = 1024 / TRN, SEGN = 128 / TRN;
    constexpr int I_GU = 32 * NKB * NNB_GU;
    for (int it = lo + gw; it < hi; it += NGW) {
        int r = it;
        if (r < I_GU) { const int e = r / (NKB * NNB_GU), r2 = r % (NKB * NNB_GU), kb = r2 / NNB_GU, cb = r2 % NNB_GU;
            const int half = cb / (NNB_GU / 2), t = (cb % (NNB_GU / 2)) / SEGN, nb = cb % SEGN;
            tr_item8f(w_gu + (size_t)e * DM * 2048, 2048, kb * TRK, half * 1024 + t * 128 + nb * TRN, WguT, (size_t)e * 2048 + t * 256 + half * 128 + nb * TRN, DM, fnw, W8_SCALE, scr, F.lane); continue; } r -= I_GU;
        { const int e = r / (NKB * NNB_D), r2 = r % (NKB * NNB_D), kb = r2 / NNB_D, nb = r2 % NNB_D;
          tr_item8f(w_d + (size_t)e * DE * DM, DM, kb * TRK, nb * TRN, WdT, (size_t)e * 1024 + nb * TRN, DE, nullptr, W8_SCALE, scr, F.lane); }
    }
}
static_assert(4 * TRF_BYTES <= LDSCTL_OFF, "transposer LDS");
constexpr int MOE_PREP_SPLIT = 0;

__device__ __forceinline__ void phase_prep(Frame& F) {
    const float* x = F.in[0]; const float* anw = F.in[1]; const float* w_in = F.in[2]; const float* a_log = F.in[4]; const float* dt_bias = F.in[5];
    const float* pool_w = F.in[7]; const float* pool_scale = F.in[8]; const float* w_out = F.in[9]; const float* fnw = F.in[10];
    const float* w_router = F.in[11]; const float* w_gu = F.in[13]; const float* b_gu = F.in[14]; const float* w_d = F.in[15];
    bf16* WinT = (bf16*)(F.ws + WS_WIN); bf16* WoutT = (bf16*)(F.ws + WS_WOUT); bf16* WpoolT = (bf16*)(F.ws + WS_WPOOL);
    bf16* WguT = (bf16*)(F.ws + WS_WGU); bf16* WdT = (bf16*)(F.ws + WS_WD);
    bf16* WrI = (bf16*)(F.ws + WS_WR); float* bguP = (float*)(F.ws + WS_BGU);
    bf16* xb = (bf16*)(F.ws + WS_XB); float* rs1 = (float*)(F.ws + WS_RS1); float* betaA = (float*)(F.ws + WS_BETA); float* gA = (float*)(F.ws + WS_G);
    LAS unsigned char* scr = F.lds + F.wave * 12288;
    LAS float* W8T = (LAS float*)(F.lds + 98304);
    const int gw = F.vcu * NWAVES + F.wave, NGW = F.G * NWAVES;
    const int gt = F.vcu * 512 + F.tid, NGT = F.G * 512;
    for (int idx = F.tid; idx < 8192; idx += 512) { const int k = idx >> 3, c = idx & 7; W8T[c * 1024 + k] = anw[k] * w_in[(size_t)k * DIN + 2048 + c]; }
    __syncthreads();
    constexpr int I_IN1 = 16 * 32, I_OUT = 16 * 16;
    constexpr int NITEMS = I_IN1 + I_OUT;
    for (int it = gw; it < NITEMS; it += NGW) {
        int r = it;
        if (r < I_IN1) { const int kb = r / 32, nb = r % 32; tr_item(w_in, DIN, kb * 64, nb * 64, WinT, (size_t)nb * 64, DM, 0, anw, nullptr, scr, F.lane); continue; } r -= I_IN1;
        { const int kb = r / 16, nb = r % 16; tr_item(w_out, DM, kb * 64, nb * 64, WoutT, (size_t)nb * 64, DM, 0, nullptr, nullptr, scr, F.lane); }
    }
    __syncthreads();
    for (int task = blockIdx.x; task < 256; task += F.G) {
        const int g = task >> 6, kb = (task >> 2) & 15, dq = task & 3;
        LAS float* Wt = (LAS float*)F.lds;
        LAS float* Pw = (LAS float*)(F.lds + 33024);
        for (int idx = F.tid; idx < 64 * 32; idx += 512) { const int k = idx >> 5, c4 = (idx & 31) * 4; const f32x4 v = *(const f32x4*)(w_in + (size_t)(kb * 64 + k) * DIN + 2056 + g * 128 + c4);
            Wt[k * 129 + c4] = v.x; Wt[k * 129 + c4 + 1] = v.y; Wt[k * 129 + c4 + 2] = v.z; Wt[k * 129 + c4 + 3] = v.w; }
        for (int idx = F.tid; idx < 128 * 8; idx += 512) { const int c = idx >> 3, d4 = (idx & 7) * 4; *(LAS f32x4*)(Pw + c * 32 + d4) = *(const f32x4*)(pool_w + (size_t)g * 16384 + c * 128 + dq * 32 + d4); }
        __syncthreads();
        const int k = F.tid & 63, d4 = (F.tid >> 6) * 4;
        f32x4 acc = (f32x4){0.f, 0.f, 0.f, 0.f};
#pragma unroll 8
        for (int c = 0; c < 128; ++c) acc += *(const LAS f32x4*)(Pw + c * 32 + d4) * Wt[k * 129 + c];
        const int n0 = g * 128 + dq * 32 + d4; const f32x4 ps = *(const f32x4*)(pool_scale + n0); const float an = anw[kb * 64 + k];
        bf16* dst = WinT + (size_t)(2048 + n0) * DM + kb * 64 + k;
        dst[0] = (bf16)f2bf(acc.x * ps.x * an); dst[DM] = (bf16)f2bf(acc.y * ps.y * an); dst[2 * DM] = (bf16)f2bf(acc.z * ps.z * an); dst[3 * DM] = (bf16)f2bf(acc.w * ps.w * an);
        __syncthreads();
    }
    moe_weight_prep(F, 0, 0, MOE_PREP_SPLIT);
    for (int idx = gt; idx < NE * 2048; idx += NGT) { const int e = idx >> 11, r = idx & 2047, t = r >> 8, j = r & 255, half = j >> 7, jj = j & 127; bguP[idx] = b_gu[(size_t)e * 2048 + half * 1024 + t * 128 + jj]; }
    for (int idx = gt; idx < 64 * 64 * 8; idx += NGT) { const int j = idx & 7, ln = (idx >> 3) & 63, fr2 = idx >> 9, nb = fr2 & 1, ks = fr2 >> 1;
        const int k = 32 * ks + 8 * (ln >> 4) + j, e = 16 * nb + (ln & 15); const float v = fnw[k] * w_router[(size_t)k * NE + e];
        const unsigned hb = f2bf(v); const float hf = __builtin_bit_cast(float, hb << 16); const unsigned lb = f2bf(v - hf);
        WrI[((size_t)(fr2 * 2 + 0) * 64 + ln) * 8 + j] = (bf16)hb; WrI[((size_t)(fr2 * 2 + 1) * 64 + ln) * 8 + j] = (bf16)lb; }
    for (int m = gw; m < NTOK; m += NGW) {
        const f32x4* xr = (const f32x4*)(x + (size_t)m * DM) + F.lane;
        f32x4 v[4]; float ss = 0.f; float d8[8];
#pragma unroll
        for (int c = 0; c < 8; ++c) d8[c] = 0.f;
#pragma unroll
        for (int j = 0; j < 4; ++j) { v[j] = xr[64 * j]; ss += (v[j].x * v[j].x + v[j].y * v[j].y) + (v[j].z * v[j].z + v[j].w * v[j].w); }
#pragma unroll
        for (int c = 0; c < 8; ++c)
#pragma unroll
            for (int j = 0; j < 4; ++j) { const f32x4 w = *(const LAS f32x4*)(W8T + c * 1024 + 256 * j + 4 * F.lane); d8[c] += (v[j].x * w.x + v[j].y * w.y) + (v[j].z * w.z + v[j].w * w.w); }
        ss = wave_sum(ss);
#pragma unroll
        for (int c = 0; c < 8; ++c) d8[c] = wave_sum(d8[c]);
        const float rs = 1.f / sqrtf(ss * (1.f / DM) + 1e-6f);
        unsigned long long* o8 = (unsigned long long*)(xb + (size_t)m * DM) + F.lane;
#pragma unroll
        for (int j = 0; j < 4; ++j) o8[64 * j] = (unsigned long long)pk2(v[j].x, v[j].y) | ((unsigned long long)pk2(v[j].z, v[j].w) << 32);
        if (F.lane == 0) rs1[m] = rs;
        if (F.lane < 4) {
            float bl = 0.f, al = 0.f;
#pragma unroll
            for (int c = 0; c < 4; ++c) { bl = (F.lane == c) ? d8[c] : bl; al = (F.lane == c) ? d8[4 + c] : al; }
            bl *= rs; al *= rs;
            betaA[(size_t)m * 4 + F.lane] = 1.f / (1.f + expf(-bl));
            const float z = al + dt_bias[F.lane]; const float sp = z > 20.f ? z : log1pf(expf(z));
            gA[(size_t)m * 4 + F.lane] = -expf(a_log[F.lane]) * sp;
        }
    }
}

__device__ __forceinline__ void phase_mix(Frame& F) {
    const bf16* proj = (const bf16*)(F.ws + WS_PROJ); bf16* mixed = (bf16*)(F.ws + WS_CONCAT) + 512;
    const int gw = F.vcu * NWAVES + F.wave, NGW = F.G * NWAVES;
    const int ch = 8 * F.lane, gi = F.lane >> 4, win = 2 << gi, hal = win - 1;
    for (int rbk = gw; rbk < NTOK / 16; rbk += NGW) {
        const int m0 = rbk * 16, t0 = m0 % SEQ;
        v4u X[31];
#pragma unroll
        for (int k = 0; k < 31; ++k) { X[k] = (v4u){0u, 0u, 0u, 0u}; if (k >= 15 - hal && t0 - 15 + k >= 0) X[k] = *(const v4u*)(proj + (size_t)(m0 - 15 + k) * NPROJ + 2048 + ch); }
        float s[8];
#pragma unroll
        for (int q = 0; q < 8; ++q) s[q] = 0.f;
#pragma unroll
        for (int k = 0; k < 15; ++k) { s[0] += bflo(X[k].x); s[1] += bfhi(X[k].x); s[2] += bflo(X[k].y); s[3] += bfhi(X[k].y); s[4] += bflo(X[k].z); s[5] += bfhi(X[k].z); s[6] += bflo(X[k].w); s[7] += bfhi(X[k].w); }
#pragma unroll
        for (int r = 0; r < 16; ++r) {
            const v4u u = X[15 + r];
            const float p[8] = {bflo(u.x), bfhi(u.x), bflo(u.y), bfhi(u.y), bflo(u.z), bfhi(u.z), bflo(u.w), bfhi(u.w)};
#pragma unroll
            for (int q = 0; q < 8; ++q) s[q] += p[q];
            const int tt = t0 + r + 1; const float ic = 1.f / (float)(tt < win ? tt : win);
            v4u o; o.x = pk2(s[0] * ic - p[0], s[1] * ic - p[1]); o.y = pk2(s[2] * ic - p[2], s[3] * ic - p[3]); o.z = pk2(s[4] * ic - p[4], s[5] * ic - p[5]); o.w = pk2(s[6] * ic - p[6], s[7] * ic - p[7]);
            *(v4u*)(mixed + (size_t)(m0 + r) * DM + ch) = o;
            const v4u od = gi == 0 ? X[14 + r] : gi == 1 ? X[12 + r] : gi == 2 ? X[8 + r] : X[r];
            s[0] -= bflo(od.x); s[1] -= bfhi(od.x); s[2] -= bflo(od.y); s[3] -= bfhi(od.y); s[4] -= bflo(od.z); s[5] -= bfhi(od.z); s[6] -= bflo(od.w); s[7] -= bfhi(od.w);
        }
    }
}

typedef float f32x16 __attribute__((ext_vector_type(16)));
__device__ __forceinline__ bf16x8 pack8(const f32x4 a, const f32x4 b) {
    v4u w; w.x = cvt_pk_bf16(a[0], a[1]); w.y = cvt_pk_bf16(a[2], a[3]); w.z = cvt_pk_bf16(b[0], b[1]); w.w = cvt_pk_bf16(b[2], b[3]);
    return __builtin_bit_cast(bf16x8, w);
}
__device__ __forceinline__ void fmac_(float& acc, float a, float b) { asm("v_fmac_f32 %0, %1, %2" : "+v"(acc) : "v"(a), "v"(b)); }
__device__ __forceinline__ float bf2f(unsigned short u) { return __builtin_bit_cast(float, (unsigned)u << 16); }

constexpr int SOLVE_D = 5;
struct RQ { int i, j; };
__host__ __device__ constexpr int solve_nq(int i) { return (i + 3) / 4; }
__host__ __device__ constexpr RQ solve_adv(int i, int j, int d) { while (d-- > 0 && i < 64) { if (j + 1 < solve_nq(i)) ++j; else { ++i; j = 0; } } return RQ{i, j}; }
template <int I, int J> __device__ __forceinline__ void solve_step(float (&U)[64], const LAS float* Am, const f32x4 (&win)[SOLVE_D], float s0, float s1, float s2, float s3) {
    if constexpr (I < 64) {
        constexpr RQ P = solve_adv(I, J, SOLVE_D);
        f32x4 nw = (f32x4){0.f, 0.f, 0.f, 0.f};
        if constexpr (P.i < 64) nw = *(const LAS f32x4*)(Am + P.i * 64 + 4 * P.j);
        const f32x4 a = win[0];
        fmac_(s0, a.x, U[4 * J]); if constexpr (4 * J + 1 < I) fmac_(s1, a.y, U[4 * J + 1]); if constexpr (4 * J + 2 < I) fmac_(s2, a.z, U[4 * J + 2]); if constexpr (4 * J + 3 < I) fmac_(s3, a.w, U[4 * J + 3]);
        f32x4 nx[SOLVE_D];
#pragma unroll
        for (int q = 0; q + 1 < SOLVE_D; ++q) nx[q] = win[q + 1];
        nx[SOLVE_D - 1] = nw;
        __builtin_amdgcn_sched_barrier(0);
        if constexpr (J + 1 < solve_nq(I)) solve_step<I, J + 1>(U, Am, nx, s0, s1, s2, s3);
        else { U[I] -= (s0 + s1) + (s2 + s3); solve_step<I + 1, 0>(U, Am, nx, 0.f, 0.f, 0.f, 0.f); }
    }
}
__device__ __forceinline__ void solve_all(float (&U)[64], const LAS float* Am) {
    f32x4 win[SOLVE_D];
#pragma unroll
    for (int q = 0; q < SOLVE_D; ++q) { constexpr RQ dummy{0, 0}; (void)dummy; }
    { constexpr RQ p0 = solve_adv(1, 0, 0), p1 = solve_adv(1, 0, 1), p2 = solve_adv(1, 0, 2), p3 = solve_adv(1, 0, 3), p4 = solve_adv(1, 0, 4);
      win[0] = *(const LAS f32x4*)(Am + p0.i * 64 + 4 * p0.j); win[1] = *(const LAS f32x4*)(Am + p1.i * 64 + 4 * p1.j); win[2] = *(const LAS f32x4*)(Am + p2.i * 64 + 4 * p2.j);
      win[3] = *(const LAS f32x4*)(Am + p3.i * 64 + 4 * p3.j); win[4] = *(const LAS f32x4*)(Am + p4.i * 64 + 4 * p4.j); }
    static_assert(SOLVE_D == 5, "window priming is written for SOLVE_D = 5");
    solve_step<1, 0>(U, Am, win, 0.f, 0.f, 0.f, 0.f);
}

constexpr int CP_QN = 0, CP_KN = 17408, CP_VA = 34816, CP_QKL = 51200, CP_SC = 59392, CP_HALF = 60416, CP_CW = 2 * CP_HALF;
__device__ __forceinline__ void phase_chunk(Frame& F, int blk0, int nblk, int n_lo, int n_cnt) {
    const float* conv_w = F.in[3];
    const bf16* proj = (const bf16*)(F.ws + WS_PROJ);
    const float* betaA = (const float*)(F.ws + WS_BETA); const float* gA = (const float*)(F.ws + WS_G);
    float* gtotA = (float*)(F.ws + WS_GTOT);
    const int half = F.wave >> 2, hw = F.wave & 3;
    LAS unsigned char* L = F.lds + half * CP_HALF;
    LAS bf16* qn = (LAS bf16*)(L + CP_QN); LAS bf16* kn = (LAS bf16*)(L + CP_KN); LAS bf16* vn = (LAS bf16*)(L + CP_VA);
    LAS float* Am = (LAS float*)(L + CP_VA); LAS bf16* qkL = (LAS bf16*)(L + CP_QKL); LAS float* sc = (LAS float*)(L + CP_SC);
    LAS float* cwL = (LAS float*)(F.lds + CP_CW);
    for (int idx = F.tid; idx < 4 * 1536 / 4; idx += 512) *(LAS f32x4*)(cwL + 4 * idx) = *(const f32x4*)(conv_w + 4 * idx);
    __syncthreads();
    const int nunits = NB * NH * n_cnt, nrounds = (nunits + 2 * nblk - 1) / (2 * nblk);
#pragma unroll 1
    for (int it = 0; it < nrounds; ++it) {
        int tid_ = F.tid; asm volatile("" : "+v"(tid_));
        const int ht = tid_ & 255, lane = tid_ & 63, r16 = lane & 15, gq = lane >> 4;
        int v_ = (it * nblk + ((int)blockIdx.x - blk0)) * 2 + half; asm volatile("" : "+s"(v_));
        const bool live = v_ < nunits;
        const int bh = live ? v_ / n_cnt : 0, n = live ? n_lo + v_ % n_cnt : 0, b = bh >> 2, h = bh & 3; const int unit = bh * 64 + n;
        const size_t m0 = (size_t)b * SEQ + (size_t)n * 64;
        unsigned char* chunk = F.ws + WS_CHUNK + (size_t)unit * CH_BYTES;
        const int rq = ht >> 4, cg = ht & 15;
        v4u Xa[7], Xb[7]; float gi = 0.f, bi = 0.f;
#define CHUNK_LOADX(X, p_) do { _Pragma("unroll") for (int jj = 0; jj < 7; ++jj) { const int trow = n * 64 + 4 * rq - 3 + jj; const int trc = trow < 0 ? 0 : trow; \
            const v4u u_ = *(const v4u*)(proj + ((size_t)b * SEQ + trc) * NPROJ + (p_) * 512 + h * 128 + 8 * cg); const unsigned mk_ = trow < 0 ? 0u : 0xffffffffu; \
            X[jj] = (v4u){u_.x & mk_, u_.y & mk_, u_.z & mk_, u_.w & mk_}; } } while (0)
#define CHUNK_CONV(X, p_) do { const int col = (p_) * 512 + h * 128 + 8 * cg; float wv[4][8]; \
            _Pragma("unroll") for (int j = 0; j < 4; ++j) { const f32x4 w0 = *(const LAS f32x4*)(cwL + j * 1536 + col), w1 = *(const LAS f32x4*)(cwL + j * 1536 + col + 4); \
                wv[j][0] = w0.x; wv[j][1] = w0.y; wv[j][2] = w0.z; wv[j][3] = w0.w; wv[j][4] = w1.x; wv[j][5] = w1.y; wv[j][6] = w1.z; wv[j][7] = w1.w; } \
            _Pragma("unroll") for (int rr = 0; rr < 4; ++rr) { float y[8]; \
                _Pragma("unroll") for (int q = 0; q < 8; ++q) y[q] = 0.f; \
                _Pragma("unroll") for (int j = 0; j < 4; ++j) { const v4u u = X[rr + j]; \
                    fmac_(y[0], wv[j][0], bflo(u.x)); fmac_(y[1], wv[j][1], bfhi(u.x)); fmac_(y[2], wv[j][2], bflo(u.y)); fmac_(y[3], wv[j][3], bfhi(u.y)); \
                    fmac_(y[4], wv[j][4], bflo(u.z)); fmac_(y[5], wv[j][5], bfhi(u.z)); fmac_(y[6], wv[j][6], bflo(u.w)); fmac_(y[7], wv[j][7], bfhi(u.w)); } \
                float ss = 0.f; \
                _Pragma("unroll") for (int q = 0; q < 8; ++q) { y[q] = siluf_(y[q]); ss += y[q] * y[q]; } \
                float scl = 1.f; \
                if ((p_) < 2) { ss += __shfl_xor(ss, 1); ss += __shfl_xor(ss, 2); ss += __shfl_xor(ss, 4); ss += __shfl_xor(ss, 8); scl = frsq_(ss + 1e-6f); if ((p_) == 0) scl *= 0.08838834764831845f; } \
                v4u o; o.x = cvt_pk_bf16(y[0] * scl, y[1] * scl); o.y = cvt_pk_bf16(y[2] * scl, y[3] * scl); o.z = cvt_pk_bf16(y[4] * scl, y[5] * scl); o.w = cvt_pk_bf16(y[6] * scl, y[7] * scl); \
                const int row = 4 * rq + rr; \
                if ((p_) == 0) *(LAS v4u*)(qn + row * 136 + 8 * cg) = o; else if ((p_) == 1) *(LAS v4u*)(kn + row * 136 + 8 * cg) = o; else *(LAS v4u*)(vn + row * 128 + 8 * cg) = o; \
                __builtin_amdgcn_sched_barrier(0); } } while (0)
        if (live) { CHUNK_LOADX(Xa, 0); CHUNK_LOADX(Xb, 1); if (hw == 0) { gi = gA[(m0 + lane) * 4 + h]; bi = betaA[(m0 + lane) * 4 + h]; } }
        if (live && hw == 0) {
            float c = gi;
#pragma unroll
            for (int o = 1; o < 64; o <<= 1) { const float tt = __shfl_up(c, o); if (lane >= o) c += tt; }
            const float gl = __shfl(c, 63);
            sc[lane] = bi; sc[64 + lane] = c; sc[128 + lane] = fexp_(c); sc[192 + lane] = fexp_(gl - c);
            if (lane == 63) gtotA[unit] = fexp_(c);
        }
        if (live) { CHUNK_CONV(Xa, 0); CHUNK_LOADX(Xa, 2); CHUNK_CONV(Xb, 1); CHUNK_CONV(Xa, 2); }
#undef CHUNK_LOADX
#undef CHUNK_CONV
        __syncthreads();
        const int which = ht >> 7, c = ht & 127;
        float U[64];
        if (live) {
#pragma unroll
            for (int i = 0; i < 64; ++i) { const float bi = sc[i]; const float tv = which ? bf2f(kn[i * 136 + c]) * sc[128 + i] : bf2f(vn[i * 128 + c]); U[i] = tv * bi; }
        } else {
#pragma unroll
            for (int i = 0; i < 64; ++i) U[i] = 0.f;
        }
        __syncthreads();
        if (live) {
            const int ti = hw >> 1, tj = hw & 1, r = lane & 31, hh = lane >> 5;
            f32x16 KK, QK;
#pragma unroll
            for (int q = 0; q < 16; ++q) { KK[q] = 0.f; QK[q] = 0.f; }
#pragma unroll
            for (int ks = 0; ks < 8; ++ks) {
                const bf16x8 ak = *(const LAS bf16x8*)(kn + (ti * 32 + r) * 136 + 16 * ks + 8 * hh);
                const bf16x8 aq = *(const LAS bf16x8*)(qn + (ti * 32 + r) * 136 + 16 * ks + 8 * hh);
                const bf16x8 bb = *(const LAS bf16x8*)(kn + (tj * 32 + r) * 136 + 16 * ks + 8 * hh);
                KK = __builtin_amdgcn_mfma_f32_32x32x16_bf16(ak, bb, KK, 0, 0, 0);
                QK = __builtin_amdgcn_mfma_f32_32x32x16_bf16(aq, bb, QK, 0, 0, 0);
            }
            const int j = tj * 32 + r; const float gcj = sc[64 + j];
#pragma unroll
            for (int reg = 0; reg < 16; ++reg) { const int i = ti * 32 + (reg & 3) + 8 * (reg >> 2) + 4 * hh;
                const float dec = (i >= j) ? __expf(sc[64 + i] - gcj) : 0.f;
                Am[i * 64 + j] = (i > j) ? sc[i] * KK[reg] * dec : 0.f;
                qkL[i * 64 + j] = (bf16)f2bf((i >= j) ? QK[reg] * dec : 0.f); }
        }
        __syncthreads();
        if (live) {
#pragma unroll
            for (int fi = 0; fi < 4; ++fi) { const int f = hw * 4 + fi, mb = f >> 2, ks = f & 3, row = 16 * mb + r16; const float s = sc[128 + row];
                const v2u lo = *(const LAS v2u*)(qn + row * 136 + 32 * ks + 4 * gq), hi = *(const LAS v2u*)(qn + row * 136 + 32 * ks + 16 + 4 * gq);
                v4u o; o.x = pk2(bflo(lo.x) * s, bfhi(lo.x) * s); o.y = pk2(bflo(lo.y) * s, bfhi(lo.y) * s); o.z = pk2(bflo(hi.x) * s, bfhi(hi.x) * s); o.w = pk2(bflo(hi.y) * s, bfhi(hi.y) * s);
                *(v4u*)(chunk + CH_QD + (f * 64 + lane) * 16) = o; }
#pragma unroll
            for (int fi = 0; fi < 4; ++fi) { const int f = hw * 4 + fi, db = f >> 1, ksp = f & 1, dcol = 16 * db + r16; float e[8];
#pragma unroll
                for (int j = 0; j < 8; ++j) { const int i = 32 * ksp + 16 * (j >> 2) + 4 * gq + (j & 3); e[j] = bf2f(kn[i * 136 + dcol]) * sc[192 + i]; }
                v4u o; o.x = pk2(e[0], e[1]); o.y = pk2(e[2], e[3]); o.z = pk2(e[4], e[5]); o.w = pk2(e[6], e[7]);
                *(v4u*)(chunk + CH_KT + (f * 64 + lane) * 16) = o; }
#pragma unroll
            for (int fi = 0; fi < 2; ++fi) { const int f = hw * 2 + fi, mb = f >> 1, ksp = f & 1, row = 16 * mb + r16;
                const v2u lo = *(const LAS v2u*)(qkL + row * 64 + 32 * ksp + 4 * gq), hi = *(const LAS v2u*)(qkL + row * 64 + 32 * ksp + 16 + 4 * gq);
                *(v4u*)(chunk + CH_QK + (f * 64 + lane) * 16) = (v4u){lo.x, lo.y, hi.x, hi.y}; }
            solve_all(U, Am);
        }
        __syncthreads();
        if (live) {
            if (which == 0) {
                const int w8 = c >> 4, cl = c & 15;
                unsigned char* ub = F.ws + WS_UC + (size_t)unit * UC_BYTES;
#pragma unroll
                for (int g = 0; g < 4; ++g) {
                    v4u lo, hi;
                    lo.x = pk2(U[4 * g], U[4 * g + 1]); lo.y = pk2(U[4 * g + 2], U[4 * g + 3]); lo.z = pk2(U[16 + 4 * g], U[16 + 4 * g + 1]); lo.w = pk2(U[16 + 4 * g + 2], U[16 + 4 * g + 3]);
                    hi.x = pk2(U[32 + 4 * g], U[32 + 4 * g + 1]); hi.y = pk2(U[32 + 4 * g + 2], U[32 + 4 * g + 3]); hi.z = pk2(U[48 + 4 * g], U[48 + 4 * g + 1]); hi.w = pk2(U[48 + 4 * g + 2], U[48 + 4 * g + 3]);
                    v4u* dst = (v4u*)(ub + ((w8 * 64 + g * 16 + cl) * 32)); dst[0] = lo; dst[1] = hi;
                }
            } else {
#pragma unroll
                for (int i = 0; i < 64; ++i) qn[i * 136 + c] = (bf16)f2bf(U[i]);
            }
        }
        __syncthreads();
        if (live) {
#pragma unroll
            for (int fi = 0; fi < 4; ++fi) { const int f = hw * 4 + fi, mb = f >> 2, ks = f & 3, row = 16 * mb + r16;
                const v2u lo = *(const LAS v2u*)(qn + row * 136 + 32 * ks + 4 * gq), hi = *(const LAS v2u*)(qn + row * 136 + 32 * ks + 16 + 4 * gq);
                *(v4u*)(chunk + CH_WF + (f * 64 + lane) * 16) = (v4u){lo.x, lo.y, hi.x, hi.y}; }
        }
        __syncthreads();
    }
}

constexpr int SCAN_SPLIT = 32;
constexpr int SC_STAGED = 49152, SC_NLOAD = 16;
struct ScanU { v4u u0, u1; };
struct ScanQ { v4u q[8]; };
__device__ __forceinline__ void scan_issue_u(ScanU& R, const unsigned char* up) {
    asm volatile("global_load_dwordx4 %0, %1, off" : "=v"(R.u0) : "v"(up) : "memory");
    asm volatile("global_load_dwordx4 %0, %1, off offset:16" : "=v"(R.u1) : "v"(up) : "memory");
}
__device__ __forceinline__ void scan_issue_q(ScanQ& R, const unsigned char* qp) {
    asm volatile("global_load_dwordx4 %0, %1, off" : "=v"(R.q[0]) : "v"(qp) : "memory");
    asm volatile("global_load_dwordx4 %0, %1, off offset:1024" : "=v"(R.q[1]) : "v"(qp) : "memory");
    asm volatile("global_load_dwordx4 %0, %1, off offset:2048" : "=v"(R.q[2]) : "v"(qp) : "memory");
    asm volatile("global_load_dwordx4 %0, %1, off offset:3072" : "=v"(R.q[3]) : "v"(qp) : "memory");
    const unsigned char* qp2 = qp + 4096;
    asm volatile("global_load_dwordx4 %0, %1, off" : "=v"(R.q[4]) : "v"(qp2) : "memory");
    asm volatile("global_load_dwordx4 %0, %1, off offset:1024" : "=v"(R.q[5]) : "v"(qp2) : "memory");
    asm volatile("global_load_dwordx4 %0, %1, off offset:2048" : "=v"(R.q[6]) : "v"(qp2) : "memory");
    asm volatile("global_load_dwordx4 %0, %1, off offset:3072" : "=v"(R.q[7]) : "v"(qp2) : "memory");
}
#define SCAN_WAIT_REGS(U, Q, cnt) asm volatile("s_waitcnt vmcnt(" #cnt ")" : "+v"(U.u0), "+v"(U.u1), "+v"(Q.q[0]), "+v"(Q.q[1]), "+v"(Q.q[2]), "+v"(Q.q[3]), "+v"(Q.q[4]), "+v"(Q.q[5]), "+v"(Q.q[6]), "+v"(Q.q[7]) :: "memory")
template <class Bar> __device__ __forceinline__ void phase_scan(Frame& F, const Bar& mid_barrier) {
    const int bh = blockIdx.x, b = bh >> 2, h = bh & 3, w = F.wave, lane = F.lane, cl = lane & 15, gq = lane >> 4;
    const float* gtotA = (const float*)(F.ws + WS_GTOT);
    const int unit0 = bh * 64;
    const unsigned char* cbase = F.ws + WS_CHUNK + (size_t)unit0 * CH_BYTES;
    const unsigned char* ubase = F.ws + WS_UC + (size_t)unit0 * UC_BYTES + (w * 64 + lane) * 32;
    const unsigned char* qbase = cbase + CH_QK + lane * 16;
    bf16* op = (bf16*)(F.ws + WS_ORAW) + ((size_t)b * SEQ + cl) * 512 + h * 128 + 16 * w + 4 * gq;
    f32x4 Sacc[8]; bf16x8 Sb[4];
#pragma unroll
    for (int d = 0; d < 8; ++d) Sacc[d] = (f32x4){0.f, 0.f, 0.f, 0.f};
#pragma unroll
    for (int k = 0; k < 4; ++k) Sb[k] = (bf16x8){0, 0, 0, 0, 0, 0, 0, 0};
    v2u Ow[4];
#pragma unroll
    for (int mb = 0; mb < 4; ++mb) Ow[mb] = (v2u){0u, 0u};
    ScanU U0, U1, U2; ScanQ QA, QB;
#define SCAN_ISSUE(nn) do { const unsigned char* s_ = cbase + (size_t)(nn) * CH_BYTES + (w * 6) * 1024 + lane * 16; LAS unsigned char* d_ = F.lds + ((nn) % 3) * SC_STAGED + (w * 6) * 1024; \
        _Pragma("unroll") for (int k_ = 0; k_ < 6; ++k_) __builtin_amdgcn_global_load_lds((const unsigned*)(s_ + k_ * 1024), (LAS unsigned*)(d_ + k_ * 1024), 16, 0, 0); } while (0)
#define SCAN_STEP(n, UC, UN, Q, ISSUE2, WAITCNT) do { \
        SCAN_WAIT_REGS(UC, Q, WAITCNT); asm volatile("s_waitcnt lgkmcnt(0)" ::: "memory"); __builtin_amdgcn_s_barrier(); asm volatile("" ::: "memory"); \
        const float gt = __shfl(gtv, (n) & 31); \
        if (ISSUE2) { scan_issue_u(UN, ubase + (size_t)((n) + 2) * UC_BYTES); SCAN_ISSUE((n) + 2); } \
        if ((n) > 0) { _Pragma("unroll") for (int mb = 0; mb < 4; ++mb) *(v2u*)(op + (size_t)(((n) - 1) * 64 + 16 * mb) * 512) = Ow[mb]; } \
        const LAS unsigned char* B = F.lds + ((n) % 3) * SC_STAGED; \
        f32x4 P[4]; \
        _Pragma("unroll") for (int mb = 0; mb < 4; ++mb) { P[mb] = (f32x4){0.f, 0.f, 0.f, 0.f}; \
            _Pragma("unroll") for (int ks = 0; ks < 4; ++ks) P[mb] = __builtin_amdgcn_mfma_f32_16x16x32_bf16(SFRAG(CH_WF, mb * 4 + ks), Sb[ks], P[mb], 0, 0, 0); } \
        f32x4 vnw[4]; \
        vnw[0] = (f32x4){bflo(UC.u0.x), bfhi(UC.u0.x), bflo(UC.u0.y), bfhi(UC.u0.y)} - P[0]; \
        vnw[1] = (f32x4){bflo(UC.u0.z), bfhi(UC.u0.z), bflo(UC.u0.w), bfhi(UC.u0.w)} - P[1]; \
        vnw[2] = (f32x4){bflo(UC.u1.x), bfhi(UC.u1.x), bflo(UC.u1.y), bfhi(UC.u1.y)} - P[2]; \
        vnw[3] = (f32x4){bflo(UC.u1.z), bfhi(UC.u1.z), bflo(UC.u1.w), bfhi(UC.u1.w)} - P[3]; \
        bf16x8 Vb[2]; Vb[0] = pack8(vnw[0], vnw[1]); Vb[1] = pack8(vnw[2], vnw[3]); \
        _Pragma("unroll") for (int mb = 0; mb < 4; ++mb) { f32x4 OT = (f32x4){0.f, 0.f, 0.f, 0.f}; \
            _Pragma("unroll") for (int ks = 0; ks < 4; ++ks) OT = __builtin_amdgcn_mfma_f32_16x16x32_bf16(Sb[ks], SFRAG(CH_QD, mb * 4 + ks), OT, 0, 0, 0); \
            _Pragma("unroll") for (int ksp = 0; ksp < 2; ++ksp) OT = __builtin_amdgcn_mfma_f32_16x16x32_bf16(Vb[ksp], __builtin_bit_cast(bf16x8, Q.q[mb * 2 + ksp]), OT, 0, 0, 0); \
            Ow[mb] = (v2u){cvt_pk_bf16(OT[0], OT[1]), cvt_pk_bf16(OT[2], OT[3])}; } \
        asm volatile("s_nop 7" : "+v"(Q.q[0]), "+v"(Q.q[1]), "+v"(Q.q[2]), "+v"(Q.q[3]), "+v"(Q.q[4]), "+v"(Q.q[5]), "+v"(Q.q[6]), "+v"(Q.q[7]));     \
        if (ISSUE2) scan_issue_q(Q, qbase + (size_t)((n) + 2) * CH_BYTES); \
        _Pragma("unroll") for (int db = 0; db < 8; ++db) { Sacc[db] = Sacc[db] * gt; \
            _Pragma("unroll") for (int ksp = 0; ksp < 2; ++ksp) Sacc[db] = __builtin_amdgcn_mfma_f32_16x16x32_bf16(SFRAG(CH_KT, db * 2 + ksp), Vb[ksp], Sacc[db], 0, 0, 0); } \
        _Pragma("unroll") for (int ks = 0; ks < 4; ++ks) Sb[ks] = pack8(Sacc[2 * ks], Sacc[2 * ks + 1]); \
    } while (0)
#define SFRAG(off, f) (*(const LAS bf16x8*)(B + (off) + ((f) * 64 + lane) * 16))
    static_assert(CH_WF == 0 && CH_QD == 16384 && CH_KT == 32768 && CH_QK == SC_STAGED && SCAN_SPLIT % 6 == 2 && 2 * SCAN_SPLIT == 64, "staged part = the first 48 KiB of a chunk; a half = 5 x 6 + 2 steps");
#pragma unroll 1
    for (int part = 0; part < 2; ++part) {
        const int n0 = part * SCAN_SPLIT;
        float gtv = gtotA[unit0 + n0 + (lane & 31)];
        asm volatile("s_waitcnt vmcnt(0)" : "+v"(gtv) :: "memory");
        scan_issue_u(U0, ubase + (size_t)n0 * UC_BYTES); SCAN_ISSUE(n0); scan_issue_q(QA, qbase + (size_t)n0 * CH_BYTES);
        scan_issue_u(U1, ubase + (size_t)(n0 + 1) * UC_BYTES); SCAN_ISSUE(n0 + 1); scan_issue_q(QB, qbase + (size_t)(n0 + 1) * CH_BYTES);
#pragma unroll 1
        for (int n = n0; n < n0 + SCAN_SPLIT - 2; n += 6) {
            SCAN_STEP(n, U0, U2, QA, true, 16);
            SCAN_STEP(n + 1, U1, U0, QB, true, 16);
            SCAN_STEP(n + 2, U2, U1, QA, true, 16);
            SCAN_STEP(n + 3, U0, U2, QB, true, 16);
            SCAN_STEP(n + 4, U1, U0, QA, true, 16);
            SCAN_STEP(n + 5, U2, U1, QB, true, 16);
        }
        SCAN_STEP(n0 + SCAN_SPLIT - 2, U0, U2, QA, false, 16);
        SCAN_STEP(n0 + SCAN_SPLIT - 1, U1, U0, QB, false, 0);
        if (part == 0) mid_barrier();
    }
#undef SFRAG
#undef SCAN_STEP
#undef SCAN_ISSUE
#pragma unroll
    for (int mb = 0; mb < 4; ++mb) *(v2u*)(op + (size_t)(63 * 64 + 16 * mb) * 512) = Ow[mb];
    VM_WAIT(); __syncthreads();
}

__device__ __forceinline__ void phase_onorm(Frame& F) {
    const float* dnw = F.in[6]; const bf16* proj = (const bf16*)(F.ws + WS_PROJ); const bf16* oraw = (const bf16*)(F.ws + WS_ORAW); bf16* concat = (bf16*)(F.ws + WS_CONCAT);
    const int gw = F.vcu * NWAVES + F.wave, NGW = F.G * NWAVES, lane = F.lane;
    const int cc = 8 * (lane & 15);
    const f32x4 d0 = *(const f32x4*)(dnw + cc), d1 = *(const f32x4*)(dnw + cc + 4);
    for (int m = gw; m < NTOK; m += NGW) {
        const v4u o = *(const v4u*)(oraw + (size_t)m * 512 + 8 * lane);
        const v4u z = *(const v4u*)(proj + (size_t)m * NPROJ + 1536 + 8 * lane);
        const float ov[8] = {bflo(o.x), bfhi(o.x), bflo(o.y), bfhi(o.y), bflo(o.z), bfhi(o.z), bflo(o.w), bfhi(o.w)};
        const float zv[8] = {bflo(z.x), bfhi(z.x), bflo(z.y), bfhi(z.y), bflo(z.z), bfhi(z.z), bflo(z.w), bfhi(z.w)};
        float ss = 0.f;
#pragma unroll
        for (int q = 0; q < 8; ++q) ss += ov[q] * ov[q];
        ss += __shfl_xor(ss, 1); ss += __shfl_xor(ss, 2); ss += __shfl_xor(ss, 4); ss += __shfl_xor(ss, 8);
        const float rs = frsq_(ss * (1.f / 128.f) + 1e-6f);
        const float dv[8] = {d0.x, d0.y, d0.z, d0.w, d1.x, d1.y, d1.z, d1.w};
        float r[8];
#pragma unroll
        for (int q = 0; q < 8; ++q) r[q] = ov[q] * rs * dv[q] * siluf_(zv[q]);
        *(v4u*)(concat + (size_t)m * DM + 8 * lane) = (v4u){cvt_pk_bf16(r[0], r[1]), cvt_pk_bf16(r[2], r[3]), cvt_pk_bf16(r[4], r[5]), cvt_pk_bf16(r[6], r[7])};
    }
}

__device__ __forceinline__ void phase_route(Frame& F) {
    const bf16* x1 = (const bf16*)(F.ws + WS_X1); const float* b_router = F.in[12];
    unsigned char* x1b = F.ws + WS_X1B; float* rs2A = (float*)(F.ws + WS_RS2); int* list = (int*)(F.ws + WS_LIST);
    float* rsl = (float*)(F.ws + WS_RSL); float* gwl = (float*)(F.ws + WS_GWL);
    unsigned* cntw = (unsigned*)(F.ws + WS_CTL) + CW_CNT;
    LAS unsigned char* WI = F.lds;
    LAS unsigned* lcnt = (LAS unsigned*)(F.lds + TAB_OFF);
    { const v4u* src = (const v4u*)(F.ws + WS_WR);
      for (int idx = F.tid; idx < 131072 / 16; idx += 512) *(LAS v4u*)(WI + 16 * idx) = src[idx]; }
    const int lane = F.lane, c = lane & 15, g = lane >> 4;
    const int gw = F.vcu * NWAVES + F.wave, NGW = F.G * NWAVES, NT = NTOK / 16;
    const float bia0 = b_router[c], bia1 = b_router[16 + c];
    for (int t0 = 0; t0 < NT; t0 += NGW) {
        const int tile = t0 + gw; const bool live = tile < NT;
        if (F.tid < 64) lcnt[F.tid] = 0u;
        __syncthreads();
        int my_e = 0; float my_g = 0.f, my_rs = 0.f; unsigned my_rank = 0u; int my_ent = 0;
        if (live) {
            const int m0 = tile * 16;
            const bf16* xrow = x1 + (size_t)(m0 + c) * DM + 8 * g;
            unsigned char* xbrow = x1b + (size_t)(m0 + c) * DM + 8 * g;
            f32x4 acc0 = (f32x4){0.f, 0.f, 0.f, 0.f}, acc1 = acc0; float ssq = 0.f;
#pragma unroll 1
            for (int kb = 0; kb < 2; ++kb) {
                v4u xa[16];
#pragma unroll
                for (int q = 0; q < 16; ++q) xa[q] = *(const v4u*)(xrow + 32 * (kb * 16 + q));
#pragma unroll
                for (int q = 0; q < 16; ++q) { const int ks = kb * 16 + q; const v4u h = xa[q];
                    const float a0 = bflo(h.x), a1 = bfhi(h.x), a2 = bflo(h.y), a3 = bfhi(h.y), b0 = bflo(h.z), b1 = bfhi(h.z), b2 = bflo(h.w), b3 = bfhi(h.w);
                    ssq += (a0 * a0 + a1 * a1) + (a2 * a2 + a3 * a3) + (b0 * b0 + b1 * b1) + (b2 * b2 + b3 * b3);
                    *(v2u*)(xbrow + 32 * ks) = (v2u){pk4_fp8(a0, a1, a2, a3), pk4_fp8(b0, b1, b2, b3)};
                    const bf16x8 ah = __builtin_bit_cast(bf16x8, h);
                    const LAS unsigned char* fb = WI + (size_t)(ks * 4) * 1024 + lane * 16;
                    const bf16x8 b0h = *(const LAS bf16x8*)(fb), b0l = *(const LAS bf16x8*)(fb + 1024), b1h = *(const LAS bf16x8*)(fb + 2048), b1l = *(const LAS bf16x8*)(fb + 3072);
                    acc0 = __builtin_amdgcn_mfma_f32_16x16x32_bf16(ah, b0h, acc0, 0, 0, 0); acc0 = __builtin_amdgcn_mfma_f32_16x16x32_bf16(ah, b0l, acc0, 0, 0, 0);
                    acc1 = __builtin_amdgcn_mfma_f32_16x16x32_bf16(ah, b1h, acc1, 0, 0, 0); acc1 = __builtin_amdgcn_mfma_f32_16x16x32_bf16(ah, b1l, acc1, 0, 0, 0); }
            }
            ssq += __shfl_xor(ssq, 16); ssq += __shfl_xor(ssq, 32);
            const float rsr = frsq_(ssq * (1.f / DM) + 1e-6f);
            if (g == 0) rs2A[m0 + c] = rsr;
            float ge_[4]; int ee_[4];
#pragma unroll
            for (int reg = 0; reg < 4; ++reg) {
                const float rsw = __shfl(rsr, 4 * g + reg);
                float v0 = acc0[reg] * rsw + bia0, v1 = acc1[reg] * rsw + bia1;
                float tv[4]; int te[4];
#pragma unroll
                for (int s = 0; s < 4; ++s) {
                    float bv; int bi; if (v1 > v0) { bv = v1; bi = 16 + c; } else { bv = v0; bi = c; }
#pragma unroll
                    for (int o = 1; o < 16; o <<= 1) { const float ov = __shfl_xor(bv, o); const int oi = __shfl_xor(bi, o); if (ov > bv || (ov == bv && oi < bi)) { bv = ov; bi = oi; } }
                    tv[s] = bv; te[s] = bi; if (bi == c) v0 = -3.0e38f; if (bi == 16 + c) v1 = -3.0e38f;
                }
                const float e1 = fexp_(tv[1] - tv[0]), e2 = fexp_(tv[2] - tv[0]), e3 = fexp_(tv[3] - tv[0]); const float inv = frcp_(1.f + e1 + e2 + e3);
                const int s_ = c & 3; const float gsel = (s_ == 0 ? 1.f : s_ == 1 ? e1 : s_ == 2 ? e2 : e3) * inv; const int esel = s_ == 0 ? te[0] : s_ == 1 ? te[1] : s_ == 2 ? te[2] : te[3];
                ge_[reg] = gsel; ee_[reg] = esel;
            }
            const int rsel = c >> 2;
            my_g = rsel == 0 ? ge_[0] : rsel == 1 ? ge_[1] : rsel == 2 ? ge_[2] : ge_[3];
            my_e = rsel == 0 ? ee_[0] : rsel == 1 ? ee_[1] : rsel == 2 ? ee_[2] : ee_[3];
            my_ent = (m0 + 4 * g + rsel) * 4 + (c & 3);
            my_rs = __shfl(rsr, 4 * g + rsel);
            my_rank = __hip_atomic_fetch_add(lcnt + my_e, 1u, __ATOMIC_RELAXED, __HIP_MEMORY_SCOPE_WORKGROUP);
        }
        __syncthreads();
        if (F.tid < NE) { const unsigned n = lcnt[F.tid]; lcnt[32 + F.tid] = n ? __hip_atomic_fetch_add(cntw + 64 * F.tid, n, RLX_AGENT) : 0u; }
        __syncthreads();
        if (live) { const size_t pos = (size_t)my_e * LISTCAP + lcnt[32 + my_e] + my_rank; list[pos] = my_ent; rsl[pos] = my_rs; gwl[pos] = my_g; }
        __syncthreads();
    }
}

constexpr int TILE_TAB_OFF = pg8::STAGE_BYTES + 8192;
__device__ __forceinline__ int moe_tables(Frame& F, MoeTab& T) {
    LAS int* pref = (LAS int*)(F.lds + TAB_OFF); LAS int* cnt = pref + 40; LAS int* tile = (LAS int*)(F.lds + TILE_TAB_OFF);
    unsigned* cntw = (unsigned*)(F.ws + WS_CTL) + CW_CNT;
    if (F.tid == 0) { int acc = 0; for (int e = 0; e < NE; ++e) { const int c = (int)__hip_atomic_load(cntw + 64 * e, RLX_AGENT); cnt[e] = c; pref[e] = acc; acc += (c + 255) >> 8; } pref[NE] = acc; }
    __syncthreads();
    const int RT = pref[NE];
    for (int rt = F.tid; rt < RT; rt += NWAVES * 64) { int e = 0;
        for (int j = 1; j < NE; ++j) if (pref[j] <= rt) e = j;
        const int rb = rt - pref[e], left = cnt[e] - rb * 256;
        tile[rt] = (e << 24) | (rb << 12) | (left < 256 ? left : 256); }
    __syncthreads();
    T.pref = pref; T.cnt = cnt; T.tile = tile;
    return RT;
}

struct FinalRow { f32x4 v[4]; v2u sl[4][2]; };
__device__ __forceinline__ void final_load(FinalRow& R, const bf16* xrow, const unsigned char* srow) {
#pragma unroll
    for (int j = 0; j < 2; ++j) { const v4u h = *(const v4u*)(xrow + 512 * j);
        R.v[2 * j] = (f32x4){bflo(h.x), bfhi(h.x), bflo(h.y), bfhi(h.y)}; R.v[2 * j + 1] = (f32x4){bflo(h.z), bfhi(h.z), bflo(h.w), bfhi(h.w)}; }
#pragma unroll
    for (int s = 0; s < 4; ++s)
#pragma unroll
        for (int j = 0; j < 2; ++j) R.sl[s][j] = *(const v2u*)(srow + (size_t)s * DM + 512 * j);
}
__device__ __forceinline__ void final_finish(FinalRow& R, float* orow, const f32x4 (&wv)[4]) {
#pragma unroll
    for (int s = 0; s < 4; ++s)
#pragma unroll
        for (int j = 0; j < 2; ++j) { const v2u u = R.sl[s][j];
            const f32x2_t a0 = __builtin_amdgcn_cvt_pk_f32_fp8((int)u.x, false), a1 = __builtin_amdgcn_cvt_pk_f32_fp8((int)u.x, true), b0 = __builtin_amdgcn_cvt_pk_f32_fp8((int)u.y, false), b1 = __builtin_amdgcn_cvt_pk_f32_fp8((int)u.y, true);
            R.v[2 * j].x += a0.x * SLAB_INV; R.v[2 * j].y += a0.y * SLAB_INV; R.v[2 * j].z += a1.x * SLAB_INV; R.v[2 * j].w += a1.y * SLAB_INV;
            R.v[2 * j + 1].x += b0.x * SLAB_INV; R.v[2 * j + 1].y += b0.y * SLAB_INV; R.v[2 * j + 1].z += b1.x * SLAB_INV; R.v[2 * j + 1].w += b1.y * SLAB_INV; }
    float ss = 0.f;
#pragma unroll
    for (int j = 0; j < 4; ++j) ss += (R.v[j].x * R.v[j].x + R.v[j].y * R.v[j].y) + (R.v[j].z * R.v[j].z + R.v[j].w * R.v[j].w);
    ss = wave_sum(ss);
    const float rs = frsq_(ss * (1.f / DM) + 1e-6f);
#pragma unroll
    for (int j = 0; j < 2; ++j) { *(f32x4*)(orow + 512 * j) = R.v[2 * j] * rs * wv[2 * j]; *(f32x4*)(orow + 512 * j + 4) = R.v[2 * j + 1] * rs * wv[2 * j + 1]; }
}
__device__ __forceinline__ void phase_final(Frame& F, int dryrun) {
    const float* fw = F.in[17]; const unsigned char* slab = F.ws + WS_SLAB; float* out = F.out;
    const bf16* x1 = (const bf16*)(F.ws + WS_X1); (void)dryrun;
    const int gw = F.vcu * NWAVES + F.wave, NGW = F.G * NWAVES, lane = F.lane;
    f32x4 wv[4];
#pragma unroll
    for (int j = 0; j < 2; ++j) { wv[2 * j] = *(const f32x4*)(fw + 512 * j + 8 * lane); wv[2 * j + 1] = *(const f32x4*)(fw + 512 * j + 8 * lane + 4); }
    FinalRow A, B;
    int m = gw;
    if (m < NTOK) final_load(A, x1 + (size_t)m * DM + 8 * lane, slab + (size_t)m * 4 * DM + 8 * lane);
    for (; m < NTOK; m += 2 * NGW) {
        const int m1 = m + NGW, m2 = m + 2 * NGW;
        if (m1 < NTOK) final_load(B, x1 + (size_t)m1 * DM + 8 * lane, slab + (size_t)m1 * 4 * DM + 8 * lane);
        final_finish(A, out + (size_t)m * DM + 8 * lane, wv);
        if (m2 < NTOK) final_load(A, x1 + (size_t)m2 * DM + 8 * lane, slab + (size_t)m2 * 4 * DM + 8 * lane);
        if (m1 < NTOK) final_finish(B, out + (size_t)m1 * DM + 8 * lane, wv);
    }
}

struct Args { const float* in[18]; float* out; unsigned char* ws; int ph_lo, ph_hi, flag, breg; };
constexpr int NPHASE = 11;

__global__ void __launch_bounds__(NWAVES * 64, 2) mk_fwd(Args args) {
    extern __shared__ __attribute__((aligned(16))) unsigned char lds_raw[];
    Frame F;
    F.lds = (LAS unsigned char*)lds_raw;
    F.tid = threadIdx.x; F.lane = F.tid & 63; F.wave = __builtin_amdgcn_readfirstlane(F.tid >> 6);
    F.G = gridDim.x; { const int bx = blockIdx.x; F.vcu = (F.G % 8 == 0) ? (bx % 8) * (F.G / 8) + bx / 8 : bx; }
#pragma unroll
    for (int i = 0; i < 18; ++i) F.in[i] = args.in[i];
    F.out = args.out; F.ws = args.ws;
    volatile LAS unsigned* MISC = (volatile LAS unsigned*)(F.lds + MISC_OFF);
    for (int u = F.tid; u < (LDS_BYTES - LDSCTL_OFF) / 4; u += NWAVES * 64) ((LAS unsigned*)(F.lds + LDSCTL_OFF))[u] = 0u;
    __syncthreads();
    unsigned* ctl = (unsigned*)(F.ws + WS_CTL);
#if !MK_PER_PHASE
    XcdBarrier bar = xcd_barrier_post(ctl + CW_BAR, MISC + 8);
#define GRID_BAR() xcd_barrier(bar)
#else
#define GRID_BAR() do {} while (0)
#endif
    const int lo = args.ph_lo, hi = args.ph_hi;
#define IN(k) (lo <= (k) && (k) < hi)
#define SEAM(k) do { if (IN(k) && IN((k) + 1)) GRID_BAR(); } while (0)

#define RUNPH(k, ...) do { if (IN(k)) { __VA_ARGS__; } SEAM(k); } while (0)
    RUNPH(0, phase_prep(F));
    RUNPH(1, {
        ProbIn P; P.K = DM; P.RB = 2 * DM; P.S.init(NTOK / 256, NPROJ / 256, F.G, (int)blockIdx.x);
        P.A = (const bf16*)(F.ws + WS_XB); P.Bt = (const bf16*)(F.ws + WS_WIN); P.O = (bf16*)(F.ws + WS_PROJ); P.rs = (const float*)(F.ws + WS_RS1);
        pg8::gemm_phase(F.lds, P); });
    if (IN(2)) { phase_mix(F); __syncthreads(); }
    RUNPH(3, phase_chunk(F, 0, F.G, 0, SCAN_SPLIT));
    RUNPH(4, {
        const int nscan = NB * NH;
        unsigned* seam = ctl + CW_SEAM4 + 64 * args.breg;
        auto scan_wait = [&]() {
            asm volatile("s_waitcnt vmcnt(0)" ::: "memory"); __syncthreads();
            if (F.tid == 0) { const unsigned want = (unsigned)(F.G - nscan); unsigned sp = 0u;
                while (__hip_atomic_load(seam, RLX_AGENT) < want) { __builtin_amdgcn_s_sleep(2); if (++sp > (1u << 22)) break; }
                __builtin_amdgcn_fence(__ATOMIC_ACQUIRE, "agent"); asm volatile("s_waitcnt vmcnt(0)" ::: "memory"); }
            __syncthreads();
        };
        if ((int)blockIdx.x < nscan) phase_scan(F, scan_wait);
        else {
               phase_chunk(F, nscan, F.G - nscan, SCAN_SPLIT, 64 - SCAN_SPLIT);
               asm volatile("s_waitcnt vmcnt(0)" ::: "memory"); __syncthreads();
               if (F.tid == 0) { __builtin_amdgcn_fence(__ATOMIC_RELEASE, "agent"); asm volatile("s_waitcnt vmcnt(0)" ::: "memory"); __hip_atomic_fetch_add(seam, 1u, RLX_AGENT); }
               moe_weight_prep(F, nscan, MOE_PREP_SPLIT, MOE_PREP_ITEMS); } });
    RUNPH(5, phase_onorm(F));
    RUNPH(6, {
        ProbOut P; P.K = DM; P.RB = 2 * DM; P.S.init(NTOK / 256, DM / 256, F.G, (int)blockIdx.x);
        P.A = (const bf16*)(F.ws + WS_CONCAT); P.Bt = (const bf16*)(F.ws + WS_WOUT); P.X = (const bf16*)(F.ws + WS_XB); P.O = (bf16*)(F.ws + WS_X1);
        pg8::gemm_phase(F.lds, P); });
    RUNPH(7, phase_route(F));
    RUNPH(8, {
        ProbGU P; const int RT = moe_tables(F, P.T);
        P.K = DM; P.RB = DM; P.S.init(RT, 8, F.G, (int)blockIdx.x);
        P.A = F.ws + WS_X1B; P.Bt = F.ws + WS_WGU; P.O = F.ws + WS_ACT; P.list = (const int*)(F.ws + WS_LIST);
        P.rs2 = (const float*)(F.ws + WS_RSL); P.bgu = (const float*)(F.ws + WS_BGU);
        pg8::gemm_phase<ProbGU, true>(F.lds, P); });
    RUNPH(9, {
        ProbDown P; const int RT = moe_tables(F, P.T);
        P.K = DE; P.RB = DE; P.S.init(RT, 4, F.G, (int)blockIdx.x);
        P.A = F.ws + WS_ACT; P.Bt = F.ws + WS_WD; P.O = F.ws + WS_SLAB; P.list = (const int*)(F.ws + WS_LIST);
        P.gw = (const float*)(F.ws + WS_GWL); P.bd = F.in[16];
        pg8::gemm_phase<ProbDown, true>(F.lds, P); });
    RUNPH(10, phase_final(F, args.flag));
#undef RUNPH
#undef IN
#undef SEAM
}

extern "C" void kernel_launch(void* const* d_in, const int* in_sizes, int n_in, void* d_out, int out_size, void* d_ws, size_t ws_size, hipStream_t stream) {
    static int grid = 0;
    if (grid == 0) {
        if (n_in != 18 || in_sizes[0] != NTOK * DM || out_size != NTOK * DM || ws_size < WS_END) { fprintf(stderr, "kernel_launch: unexpected shapes (n_in %d, in0 %d, out %d, ws %zu)\n", n_in, n_in > 0 ? in_sizes[0] : -1, out_size, ws_size); grid = -1; return; }
        int dev = 0, cus = 0, per_cu = 0;
        if (hipGetDevice(&dev) != hipSuccess || hipDeviceGetAttribute(&cus, hipDeviceAttributeMultiprocessorCount, dev) != hipSuccess) { grid = -1; return; }
        if (hipFuncSetAttribute((const void*)mk_fwd, hipFuncAttributeMaxDynamicSharedMemorySize, LDS_BYTES) != hipSuccess) { fprintf(stderr, "kernel_launch: hipFuncSetAttribute failed\n"); grid = -1; return; }
        if (hipOccupancyMaxActiveBlocksPerMultiprocessor(&per_cu, (const void*)mk_fwd, NWAVES * 64, LDS_BYTES) != hipSuccess || per_cu < 1) { fprintf(stderr, "kernel_launch: occupancy query says %d\n", per_cu); per_cu = 1; }
        (void)hipGetLastError();
        grid = cus;
    }
    if (grid < 0) return;
    (void)hipMemsetAsync((char*)d_ws + WS_CTL, 0, CTL_ZERO_BYTES, stream);
    Args a{};
    for (int i = 0; i < 18; ++i) a.in[i] = (const float*)d_in[i];
    a.out = (float*)d_out; a.ws = (unsigned char*)d_ws;
#if MK_PER_PHASE
    for (int p = 0; p < NPHASE; ++p) { a.ph_lo = p; a.ph_hi = p + 1; const int nrep = 1 + REP_CNT * ((REP_MASK >> p) & 1);
        for (int r = 0; r < nrep; ++r) { a.flag = (p == NPHASE - 1 && r + 1 < nrep) ? 1 : 0; a.breg = r; hipLaunchKernelGGL(mk_fwd, dim3(grid), dim3(NWAVES * 64), LDS_BYTES, stream, a); } }
#else
    a.ph_lo = 0; a.ph_hi = NPHASE;
    hipLaunchKernelGGL(mk_fwd, dim3(grid), dim3(NWAVES * 64), LDS_BYTES, stream, a);
#endif
}
```
